# Optimizing an MI355X kernel written in HIP

```python
import math
import jax, jax.numpy as jnp
from jax import lax
import numpy as np

D_MODEL = 1024
BATCH = 4
SEQ = 4096
DEPTH = 2

GRID_W = 64
CTX_LEN = 256
HEAD_DIM = 64
AXIS_PAIRS = HEAD_DIM // 4
ROPE_THETA = 10000.0
Q_BLOCK = 128
EPS = 1e-6
NEG_INF = -1e30

A_HEADS = 4
A_V_DIM = 2 * HEAD_DIM
B_HEADS = 8
B_KV_HEADS = 2
C_HEADS = 8
C_KV_HEADS = 2
WINDOW = 128

A_QK_W = A_HEADS * 2 * HEAD_DIM
A_V_W = A_HEADS * A_V_DIM
B_Q_W = B_HEADS * HEAD_DIM
B_KV_W = B_KV_HEADS * HEAD_DIM
C_Q_W = C_HEADS * HEAD_DIM
C_KV_W = C_KV_HEADS * HEAD_DIM
N_BRANCH = 3
BRANCH_W = 512
GATE_W = N_BRANCH * D_MODEL
IN_SIZES = (A_QK_W, A_QK_W, A_V_W, B_Q_W, B_KV_W, B_KV_W, C_Q_W, C_KV_W, C_KV_W, GATE_W)
IN_COLS = A_QK_W + A_QK_W + A_V_W + B_Q_W + B_KV_W + B_KV_W + C_Q_W + C_KV_W + C_KV_W + GATE_W

N_EXPERTS = 32
TOP_K = 4
D_FF_EXPERT = D_MODEL
SWIGLU_LIMIT = 7.0
SWIGLU_ALPHA = 1.702
MOE_BLOCK = 128

kernel_name = "hybrid_diffattn_gqa_swa_moe_dit_block"


def rms_norm(x, g):
    xf = x.astype(jnp.float32)
    y = xf * lax.rsqrt(jnp.mean(xf * xf, axis=-1, keepdims=True) + EPS)
    return (y * g.astype(jnp.float32)).astype(x.dtype)


def axial_rope_tables(n_tokens, dtype):
    rows = n_tokens // GRID_W
    row = jnp.repeat(jnp.arange(rows, dtype=jnp.float32), GRID_W)
    col = jnp.tile(jnp.arange(GRID_W, dtype=jnp.float32), rows)
    inv_freq = ROPE_THETA ** (-jnp.arange(AXIS_PAIRS, dtype=jnp.float32) / AXIS_PAIRS)
    ang_r = row[:, None] * inv_freq
    ang_c = col[:, None] * inv_freq
    ang = jnp.concatenate([ang_r, ang_r, ang_c, ang_c], axis=-1)
    return jnp.cos(ang).astype(dtype), jnp.sin(ang).astype(dtype)


def apply_rope(x, cos, sin):
    bshape = (cos.shape[0],) + (1,) * (x.ndim - 3) + (HEAD_DIM,)
    xr = x.reshape(x.shape[:-1] + (2, 2, AXIS_PAIRS))
    rot = jnp.stack([-xr[..., 1, :], xr[..., 0, :]], axis=-2).reshape(x.shape)
    return x * cos.reshape(bshape) + rot * sin.reshape(bshape)


def over_query_blocks(fn, q):
    b, s = q.shape[:2]
    nb = s // Q_BLOCK
    qb = jnp.moveaxis(q.reshape((b, nb, Q_BLOCK) + q.shape[2:]), 1, 0)
    ob = lax.map(lambda a: fn(a[0], a[1]), (qb, jnp.arange(nb)))
    ob = jnp.moveaxis(ob, 0, 1)
    return ob.reshape((b, s) + ob.shape[3:])


def diff_attend(q, k, v, lam):
    s = jnp.einsum('bqhmd,bkhmd->bhmqk', q, k).astype(jnp.float32) * (HEAD_DIM ** -0.5)
    p = jax.nn.softmax(s, axis=-1)
    a = (p[:, :, 0] - lam * p[:, :, 1]).astype(v.dtype)
    return jnp.einsum('bhqk,bkhe->bqhe', a, v)


def gqa_attend(q, k, v):
    s = jnp.einsum('bqngd,bknd->bngqk', q, k).astype(jnp.float32) * (HEAD_DIM ** -0.5)
    p = jax.nn.softmax(s, axis=-1).astype(v.dtype)
    return jnp.einsum('bngqk,bknd->bqngd', p, v)


def sink_attend(q, segments, sink):
    scores = []
    for k, v, mask in segments:
        s = jnp.einsum('bqngd,bknd->bngqk', q, k).astype(jnp.float32) * (HEAD_DIM ** -0.5)
        if mask is not None:
            s = jnp.where(mask, s, NEG_INF)
        scores.append(s)
    b, nq = q.shape[:2]
    n, g = sink.shape
    sink_col = jnp.broadcast_to(sink.astype(jnp.float32)[None, :, :, None, None], (b, n, g, nq, 1))
    p = jax.nn.softmax(jnp.concatenate(scores + [sink_col], axis=-1), axis=-1)
    out = None
    offset = 0
    for k, v, _ in segments:
        kl = k.shape[1]
        o = jnp.einsum('bngqk,bknd->bqngd', p[..., offset:offset + kl].astype(v.dtype), v)
        out = o if out is None else out + o
        offset += kl
    return out


def split_projection(p):
    b, t = p.shape[:2]
    aq, ak, av, bq, bk, bv, cq, ck, cv, gl = jnp.split(p, np.cumsum(IN_SIZES)[:-1].tolist(), axis=-1)
    return (aq.reshape(b, t, A_HEADS, 2, HEAD_DIM),
            ak.reshape(b, t, A_HEADS, 2, HEAD_DIM),
            av.reshape(b, t, A_HEADS, A_V_DIM),
            bq.reshape(b, t, B_KV_HEADS, B_HEADS // B_KV_HEADS, HEAD_DIM),
            bk.reshape(b, t, B_KV_HEADS, HEAD_DIM),
            bv.reshape(b, t, B_KV_HEADS, HEAD_DIM),
            cq.reshape(b, t, C_KV_HEADS, C_HEADS // C_KV_HEADS, HEAD_DIM),
            ck.reshape(b, t, C_KV_HEADS, HEAD_DIM),
            cv.reshape(b, t, C_KV_HEADS, HEAD_DIM),
            gl)


def merge_branches(ya, yb, yc, gate_logits, w_branch, w_out):
    b, t = ya.shape[:2]
    ys = jnp.stack([ya.reshape(b, t, BRANCH_W), yb.reshape(b, t, BRANCH_W), yc.reshape(b, t, BRANCH_W)], axis=2)
    proj = jnp.einsum('btie,ied->btid', ys, w_branch)
    gates = jax.nn.sigmoid(gate_logits.reshape(b, t, N_BRANCH, D_MODEL))
    return jnp.sum(gates * proj, axis=2) @ w_out


def token_mixers(h_lat, h_ctx, w_in, lam_vec, lam_init, subln_g, qk_g, sink, w_branch, w_out, cos, sin, need_ctx):
    n_lat = h_lat.shape[1]
    aq, ak, av, bq, bk, bv, cq, ck, cv, gl = split_projection(h_lat @ w_in)
    aq_c, ak_c, av_c, bq_c, bk_c, bv_c, cq_c, ck_c, cv_c, gl_c = split_projection(h_ctx @ w_in)
    bq, bq_c = rms_norm(bq, qk_g[0]), rms_norm(bq_c, qk_g[0])
    bk, bk_c = rms_norm(bk, qk_g[1]), rms_norm(bk_c, qk_g[1])
    aq, ak = apply_rope(aq, cos, sin), apply_rope(ak, cos, sin)
    bq, bk = apply_rope(bq, cos, sin), apply_rope(bk, cos, sin)
    cq, ck = apply_rope(cq, cos, sin), apply_rope(ck, cos, sin)
    lv = lam_vec.astype(jnp.float32)
    lam = jnp.exp(jnp.sum(lv[0] * lv[1])) - jnp.exp(jnp.sum(lv[2] * lv[3])) + lam_init
    sink_ng = sink.reshape(C_KV_HEADS, C_HEADS // C_KV_HEADS)

    ak_all = jnp.concatenate([ak, ak_c], axis=1)
    av_all = jnp.concatenate([av, av_c], axis=1)
    ya = over_query_blocks(lambda qb, i: diff_attend(qb, ak_all, av_all, lam), aq)
    ya = rms_norm(ya, subln_g) * (1.0 - lam_init)

    bk_all = jnp.concatenate([bk, bk_c], axis=1)
    bv_all = jnp.concatenate([bv, bv_c], axis=1)
    yb = over_query_blocks(lambda qb, i: gqa_attend(qb, bk_all, bv_all), bq)

    span = Q_BLOCK + 2 * WINDOW
    ck_pad = jnp.pad(ck, ((0, 0), (WINDOW, WINDOW), (0, 0), (0, 0)))
    cv_pad = jnp.pad(cv, ((0, 0), (WINDOW, WINDOW), (0, 0), (0, 0)))

    def window_block(qblk, i):
        start = i * Q_BLOCK
        kw = lax.dynamic_slice_in_dim(ck_pad, start, span, axis=1)
        vw = lax.dynamic_slice_in_dim(cv_pad, start, span, axis=1)
        qpos = start + jnp.arange(Q_BLOCK)
        kpos = start - WINDOW + jnp.arange(span)
        mask = (jnp.abs(qpos[:, None] - kpos[None, :]) <= WINDOW) & (kpos >= 0)[None, :] & (kpos < n_lat)[None, :]
        return sink_attend(qblk, [(kw, vw, mask), (ck_c, cv_c, None)], sink_ng)

    yc = over_query_blocks(window_block, cq)
    y_lat = merge_branches(ya, yb, yc, gl, w_branch, w_out)

    if not need_ctx:
        return y_lat, None
    ya_c = rms_norm(diff_attend(aq_c, ak_c, av_c, lam), subln_g) * (1.0 - lam_init)
    yb_c = gqa_attend(bq_c, bk_c, bv_c)
    yc_c = sink_attend(cq_c, [(ck_c, cv_c, None)], sink_ng)
    y_ctx = merge_branches(ya_c, yb_c, yc_c, gl_c, w_branch, w_out)
    return y_lat, y_ctx


def moe_ffn(h, router_w, router_b, w1, b1, w2, b2):
    n, d = h.shape
    logits = (h @ router_w + router_b).astype(jnp.float32)
    top_val, top_idx = lax.top_k(logits, TOP_K)
    comb = jax.nn.softmax(top_val, axis=-1).astype(h.dtype)
    n_slots = n * TOP_K
    flat_e = top_idx.reshape(-1).astype(jnp.int32)
    order = jnp.argsort(flat_e)
    sorted_e = flat_e[order]
    counts = jnp.bincount(flat_e, length=N_EXPERTS).astype(jnp.int32)
    padded = (counts + MOE_BLOCK - 1) // MOE_BLOCK * MOE_BLOCK
    start = jnp.cumsum(counts) - counts
    pad_end = jnp.cumsum(padded)
    pad_start = pad_end - padded
    dest = (pad_start[sorted_e] + jnp.arange(n_slots, dtype=jnp.int32) - start[sorted_e]).astype(jnp.int32)
    n_blocks = -(-n_slots // MOE_BLOCK) + N_EXPERTS
    rows = n_blocks * MOE_BLOCK
    row_tok = jnp.zeros((rows,), jnp.int32).at[dest].set((order // TOP_K).astype(jnp.int32))
    block_e = jnp.minimum(jnp.searchsorted(pad_end, jnp.arange(n_blocks, dtype=jnp.int32) * MOE_BLOCK, side='right'), N_EXPERTS - 1)
    xb = h[row_tok].reshape(n_blocks, MOE_BLOCK, d)

    def expert_block(args):
        xe, e = args
        gu = xe @ w1[e] + b1[e]
        gate, up = jnp.split(gu, 2, axis=-1)
        gate = jnp.minimum(gate, SWIGLU_LIMIT)
        up = jnp.clip(up, -SWIGLU_LIMIT, SWIGLU_LIMIT)
        act = (up + 1.0) * (gate * jax.nn.sigmoid(SWIGLU_ALPHA * gate))
        return act @ w2[e] + b2[e]

    yb = lax.map(expert_block, (xb, block_e)).reshape(rows, d)
    slot_row = jnp.zeros((n_slots,), jnp.int32).at[order].set(dest)
    y = yb[slot_row].reshape(n, TOP_K, d)
    return jnp.einsum('nk,nkd->nd', comb, y)


def setup_inputs(seed: int = 0) -> dict:
    key = jax.random.key(seed)
    ks = jax.random.split(key, 20)
    f32 = jnp.float32
    D = D_MODEL

    def nrm(k, shape, scale):
        return jax.random.normal(k, shape, f32) * scale

    return {
        "x": nrm(ks[0], (BATCH, SEQ, D), 1.0),
        "c": nrm(ks[1], (BATCH, D), 1.0),
        "ctx": nrm(ks[2], (BATCH, CTX_LEN, D), 1.0),
        "c_ctx": nrm(ks[3], (D,), 1.0),
        "ada_w": nrm(ks[4], (DEPTH, D, 6 * D), 0.5 * D ** -0.5),
        "ada_b": nrm(ks[5], (DEPTH, 6 * D), 0.01),
        "norm_g": 1.0 + nrm(ks[6], (DEPTH, 4, D), 0.05),
        "w_in": nrm(ks[7], (DEPTH, D, IN_COLS), D ** -0.5),
        "diff_lambda": nrm(ks[8], (DEPTH, 4, HEAD_DIM), 0.1),
        "diff_subln": 1.0 + nrm(ks[9], (DEPTH, A_V_DIM), 0.05),
        "qk_norm": 1.0 + nrm(ks[10], (DEPTH, 2, HEAD_DIM), 0.05),
        "sink": nrm(ks[11], (DEPTH, C_HEADS), 1.0),
        "w_branch": nrm(ks[12], (DEPTH, N_BRANCH, BRANCH_W, D), BRANCH_W ** -0.5),
        "w_out": nrm(ks[13], (DEPTH, D, D), D ** -0.5),
        "router_w": nrm(ks[14], (DEPTH, D, N_EXPERTS), D ** -0.5),
        "router_b": nrm(ks[15], (DEPTH, N_EXPERTS), 0.01),
        "w1": nrm(ks[16], (DEPTH, N_EXPERTS, D, 2 * D_FF_EXPERT), D ** -0.5),
        "b1": nrm(ks[17], (DEPTH, N_EXPERTS, 2 * D_FF_EXPERT), 0.01),
        "w2": nrm(ks[18], (DEPTH, N_EXPERTS, D_FF_EXPERT, D), D_FF_EXPERT ** -0.5),
        "b2": nrm(ks[19], (DEPTH, N_EXPERTS, D), 0.01),
    }


def reference(x, c, ctx, c_ctx, ada_w, ada_b, norm_g, w_in, diff_lambda, diff_subln, qk_norm, sink,
              w_branch, w_out, router_w, router_b, w1, b1, w2, b2):
    b, s, d = x.shape
    cos, sin = axial_rope_tables(s, x.dtype)
    for l in range(DEPTH):
        last = l == DEPTH - 1
        lam_init = 0.8 - 0.6 * math.exp(-0.3 * l)
        mod_lat = (jax.nn.silu(c) @ ada_w[l] + ada_b[l])[:, None, :]
        mod_ctx = (jax.nn.silu(c_ctx) @ ada_w[l] + ada_b[l])[None, None, :]
        sh_m, sc_m, g_m, sh_f, sc_f, g_f = jnp.split(mod_lat, 6, axis=-1)
        csh_m, csc_m, cg_m, csh_f, csc_f, cg_f = jnp.split(mod_ctx, 6, axis=-1)

        h_lat = rms_norm(x, norm_g[l, 0]) * (1.0 + sc_m) + sh_m
        h_ctx = rms_norm(ctx, norm_g[l, 0]) * (1.0 + csc_m) + csh_m
        y_lat, y_ctx = token_mixers(h_lat, h_ctx, w_in[l], diff_lambda[l], lam_init, diff_subln[l], qk_norm[l],
                                    sink[l], w_branch[l], w_out[l], cos, sin, not last)
        x = x + g_m * rms_norm(y_lat, norm_g[l, 1])

        h_lat = rms_norm(x, norm_g[l, 2]) * (1.0 + sc_f) + sh_f
        if last:
            y = moe_ffn(h_lat.reshape(b * s, d), router_w[l], router_b[l], w1[l], b1[l], w2[l], b2[l])
            x = x + g_f * rms_norm(y.reshape(b, s, d), norm_g[l, 3])
        else:
            ctx = ctx + cg_m * rms_norm(y_ctx, norm_g[l, 1])
            h_ctx = rms_norm(ctx, norm_g[l, 2]) * (1.0 + csc_f) + csh_f
            tokens = jnp.concatenate([h_lat.reshape(b * s, d), h_ctx.reshape(-1, d)], axis=0)
            y = moe_ffn(tokens, router_w[l], router_b[l], w1[l], b1[l], w2[l], b2[l])
            x = x + g_f * rms_norm(y[:b * s].reshape(b, s, d), norm_g[l, 3])
            ctx = ctx + cg_f * rms_norm(y[b * s:].reshape(ctx.shape), norm_g[l, 3])
    return x
```

```cpp
#include <hip/hip_runtime.h>
#include <cstdio>
#include <cstdint>

#define LAS __attribute__((address_space(3)))
#define GAS __attribute__((address_space(1)))

__device__ __forceinline__ int lane_now() { int l = (int)__builtin_amdgcn_mbcnt_hi(~0u, __builtin_amdgcn_mbcnt_lo(~0u, 0u)); asm volatile("" : "+v"(l)); return l; }

namespace pg8 {
#define PG8_LAS __attribute__((address_space(3)))
typedef unsigned short bf16_t;
typedef short bf16x8 __attribute__((ext_vector_type(8)));
typedef float f32x4 __attribute__((ext_vector_type(4)));
typedef float f32x2 __attribute__((ext_vector_type(2)));
typedef unsigned u32x4 __attribute__((ext_vector_type(4)));
typedef unsigned u32x2 __attribute__((ext_vector_type(2)));
constexpr int BM = 256, BK = 64, HALF = 128, HTB = HALF * BK * 2  , STAGE_BYTES = 8 * HTB, NXCD = 8, WGM = 8;

__host__ __device__ __forceinline__ int lds_byte(int r, int c) { const int st = (r >> 4) * 2 + (c >> 5), rr = r & 15, cc = c & 31, ob = rr * 64 + cc * 2; return st * 1024 + (ob ^ (((ob >> 9) & 1) << 5)); }
__host__ __device__ __forceinline__ void stage_rc(int b, int& R, int& C) { const int st = b / 1024, sb = b % 1024, swz = sb ^ (((sb >> 9) & 1) << 5); R = (st >> 1) * 16 + swz / 64; C = (st & 1) * 32 + (swz % 64) / 2; }
__host__ __device__ __forceinline__ int perm32(int rho) { const int n = rho >> 4, i = rho & 15; return 8 * (i >> 2) + 4 * n + (i & 3); }

struct Unit { int pm, pn; };
struct Gemm { const bf16_t* A; const bf16_t* Bt; int M, N, K; };

struct StaticOrder {
    int nM, nN, nwg, G, c;
    __host__ __device__ void init(int M, int N, int G_, int c_) { nM = M / BM; nN = N / BM; nwg = nM * nN; G = G_; c = c_; }
    __host__ __device__ bool next(int i, Unit& u) const {
        const long L = (long)i * G + c; if (L >= nwg) return false;
        int wgid = (int)L; { const int q = nwg / NXCD, r = nwg % NXCD, xcd = wgid % NXCD, off = wgid / NXCD; wgid = (xcd < r ? xcd * (q + 1) : r * (q + 1) + (xcd - r) * q) + off; }
        const int nig = WGM * nN, gid = wgid / nig, fm = gid * WGM, gsz = (nM - fm) < WGM ? (nM - fm) : WGM;
        u.pm = fm + ((wgid % nig) % gsz); u.pn = (wgid % nig) / gsz; return true;
    }
    __device__ __forceinline__ unsigned a_row(const Unit&, int) const { return 0u; }
};

__device__ __forceinline__ unsigned cvt_pk_bf16(float lo, float hi) { unsigned r; asm volatile("v_cvt_pk_bf16_f32 %0, %1, %2" : "=v"(r) : "v"(lo), "v"(hi)); return r; }

typedef int v8i32 __attribute__((ext_vector_type(8)));
typedef int v4i32 __attribute__((ext_vector_type(4)));
__device__ __forceinline__ v8i32 cat8(bf16x8 lo, bf16x8 hi) { const v4i32 a = __builtin_bit_cast(v4i32, lo), b = __builtin_bit_cast(v4i32, hi); return (v8i32){a[0], a[1], a[2], a[3], b[0], b[1], b[2], b[3]}; }
__device__ __forceinline__ void mfma_f8(f32x4& acc, v8i32 a, v8i32 b, int sc) {
    asm volatile("v_mfma_scale_f32_16x16x128_f8f6f4 %0, %1, %2, %0, %3, %3 op_sel_hi:[0,0,0]" : "+v"(acc) : "v"(a), "v"(b), "v"(sc)); }
template <class E> struct epi_chain { static constexpr bool v = false; };
template <class E> struct epi_dup { static constexpr int v = 0; };
template <class Epi, class Sched, bool GATHER, bool FP8 = false>
__device__ __forceinline__ void gemm_phase(PG8_LAS unsigned char* lds, const Gemm g, const Sched& S, const Epi& E, const int wave0) {
    const int lane = lane_now(), tid = wave0 * 64 + lane, wid = wave0, wr = wid >> 2, wc = wid & 3, fr = lane & 15, fq = lane >> 4;
    const int K = g.K, nt = K / BK;
    unsigned voffA[2], voffB[2]; int RA[2], CA[2];
#pragma unroll
    for (int i = 0; i < 2; ++i) { int R, C; stage_rc(tid * 16 + i * 8192, R, C); const int Rb = Epi::PERM ? ((R & ~31) + perm32(R & 31)) : R;
        RA[i] = R; CA[i] = C; voffA[i] = (unsigned)(R * K + C) * 2u; voffB[i] = (unsigned)(Rb * K + C) * 2u; }
    const size_t kstep = (size_t)(BK * 2);
    const size_t hstep = (size_t)HALF * K * 2;
    const size_t tstep = 2 * hstep;
    const unsigned ldsw = (unsigned)wid * 1024u;
    const int aoff = lds_byte(wr * 64 + fr, fq * 8), boff = lds_byte(wc * 32 + fr, fq * 8);
#define PG8_SA(b, h) (((b) * 2 + (h)) * HTB)
#define PG8_SB(b, h) ((4 + (b) * 2 + (h)) * HTB)
#define PG8_STAGE2(bufoff, gbase, o0, o1) do { \
        __builtin_amdgcn_global_load_lds((const unsigned*)((const char*)(gbase) + (o0)), (PG8_LAS unsigned*)(lds + (bufoff) + ldsw), 16, 0, 0); \
        __builtin_amdgcn_global_load_lds((const unsigned*)((const char*)(gbase) + (o1)), (PG8_LAS unsigned*)(lds + (bufoff) + ldsw + 8192), 16, 0, 0); } while (0)
#define PG8_STB(bufoff, gbase) PG8_STAGE2(bufoff, gbase, voffB[0], voffB[1])
#define PG8_STA(bufoff, ptr, h, OC) do { if constexpr (GATHER) PG8_STAGE2(bufoff, ptr, OC[h][0], OC[h][1]); else PG8_STAGE2(bufoff, (ptr) + ((h) ? hstep : (size_t)0), voffA[0], voffA[1]); } while (0)
#define PG8_LDA(dst, b, h) do { _Pragma("unroll") for (int m = 0; m < 4; ++m) _Pragma("unroll") for (int k = 0; k < 2; ++k) dst[m][k] = *(const PG8_LAS bf16x8*)(lds + PG8_SA(b, h) + aoff + m * 2048 + k * 1024); } while (0)
#define PG8_LDB(dst, b, h) do { _Pragma("unroll") for (int n = 0; n < 2; ++n) _Pragma("unroll") for (int k = 0; k < 2; ++k) dst[n][k] = *(const PG8_LAS bf16x8*)(lds + PG8_SB(b, h) + boff + n * 2048 + k * 1024); } while (0)
#define PG8_MMA(ai, bj, At, Bt) do { __builtin_amdgcn_s_setprio(1); \
        if constexpr (FP8) { _Pragma("unroll") for (int m = 0; m < 4; ++m) _Pragma("unroll") for (int n = 0; n < 2; ++n) \
            mfma_f8(acc[ai][bj][m][n], cat8(Bt[n][0], Bt[n][1]), cat8(At[m][0], At[m][1]), sc8); } \
        else { _Pragma("unroll") for (int m = 0; m < 4; ++m) _Pragma("unroll") for (int n = 0; n < 2; ++n) _Pragma("unroll") for (int k = 0; k < 2; ++k) \
            acc[ai][bj][m][n] = __builtin_amdgcn_mfma_f32_16x16x32_bf16(Bt[n][k], At[m][k], acc[ai][bj][m][n], 0, 0, 0); } \
        __builtin_amdgcn_s_setprio(0); } while (0)
#define PG8_WAIT_V(n) asm volatile("s_waitcnt vmcnt(" #n ")" ::: "memory")
#define PG8_WAIT_L(n) asm volatile("s_waitcnt lgkmcnt(" #n ")" ::: "memory")
#define PG8_BAR __builtin_amdgcn_s_barrier()
#define PG8_SCHED __builtin_amdgcn_sched_barrier(0)
    Unit cur, nxt; int ui = 0;
    if (!S.next(0, cur)) return;
    f32x4 acc[2][2][4][2];
#pragma unroll
    for (int a = 0; a < 2; ++a)
#pragma unroll
        for (int b = 0; b < 2; ++b)
#pragma unroll
            for (int m = 0; m < 4; ++m)
#pragma unroll
                for (int n = 0; n < 2; ++n) acc[a][b][m][n] = (f32x4){0.f, 0.f, 0.f, 0.f};
    bf16x8 At[4][2], B0[2][2], B1[2][2];
    int sc8 = 0x7f7f7f7f; asm volatile("" : "+v"(sc8));
    unsigned vC[2][2] = {{0u, 0u}, {0u, 0u}}, vN[2][2] = {{0u, 0u}, {0u, 0u}};
    if constexpr (GATHER) {
#pragma unroll
        for (int h = 0; h < 2; ++h)
#pragma unroll
            for (int i = 0; i < 2; ++i) vC[h][i] = (S.a_row(cur, h * HALF + RA[i]) * (unsigned)K + (unsigned)CA[i]) * 2u;
    }
    const char* Ab = (const char*)g.A;
    const char* cA = GATHER ? Ab : Ab + (size_t)cur.pm * tstep; const char* cB = (const char*)g.Bt + (size_t)cur.pn * tstep;
    PG8_STB(PG8_SB(0, 0), cB); PG8_STB(PG8_SB(0, 1), cB + hstep); PG8_STA(PG8_SA(0, 0), cA, 0, vC); PG8_STA(PG8_SA(0, 1), cA, 1, vC);
    if (wr == 1) PG8_BAR;
    PG8_WAIT_V(2); PG8_BAR;
    PG8_STB(PG8_SB(1, 0), cB + kstep); PG8_STA(PG8_SA(1, 0), cA + kstep, 0, vC); PG8_STB(PG8_SB(1, 1), cB + hstep + kstep);
    PG8_WAIT_V(6); PG8_BAR;
    for (;;) {
        const bool has_next = S.next(ui + 1, nxt);
        const char* nA = GATHER ? Ab : (has_next ? Ab + (size_t)nxt.pm * tstep : cA); const char* nB = has_next ? (const char*)g.Bt + (size_t)nxt.pn * tstep : cB;
        if constexpr (GATHER) {
            if (has_next) {
#pragma unroll
                for (int h = 0; h < 2; ++h)
#pragma unroll
                    for (int i = 0; i < 2; ++i) vN[h][i] = (S.a_row(nxt, h * HALF + RA[i]) * (unsigned)K + (unsigned)CA[i]) * 2u;
            } else {
#pragma unroll
                for (int h = 0; h < 2; ++h)
#pragma unroll
                    for (int i = 0; i < 2; ++i) vN[h][i] = vC[h][i];
            }
        }
        for (int t = 0; t < nt; t += 2) {
            const bool last = (t == nt - 2);
            const char* a1 = cA + (size_t)(t + 1) * kstep;
            const char* a2 = last ? nA : cA + (size_t)(t + 2) * kstep; const char* b2 = last ? nB : cB + (size_t)(t + 2) * kstep;
            const char* a3 = a2 + kstep; const char* b3 = b2 + kstep;
            unsigned v2[2][2];
#pragma unroll
            for (int h = 0; h < 2; ++h)
#pragma unroll
                for (int i = 0; i < 2; ++i) v2[h][i] = last ? vN[h][i] : vC[h][i];
            PG8_LDB(B0, 0, 0); PG8_LDB(B1, 0, 1); PG8_SCHED; PG8_LDA(At, 0, 0); PG8_STA(PG8_SA(1, 1), a1, 1, vC);
            PG8_WAIT_V(8); PG8_WAIT_L(0); PG8_BAR; PG8_MMA(0, 0, At, B0); PG8_MMA(0, 1, At, B1); PG8_BAR; PG8_SCHED;
            PG8_LDA(At, 0, 1); PG8_STB(PG8_SB(0, 0), b2); PG8_STB(PG8_SB(0, 1), b2 + hstep); PG8_STA(PG8_SA(0, 0), a2, 0, v2);
            PG8_WAIT_V(8); PG8_WAIT_L(0); PG8_BAR; PG8_MMA(1, 0, At, B0); PG8_MMA(1, 1, At, B1); PG8_BAR; PG8_SCHED;
            PG8_LDB(B0, 1, 0); PG8_LDB(B1, 1, 1); PG8_SCHED; PG8_LDA(At, 1, 0); PG8_STA(PG8_SA(0, 1), a2, 1, v2);
            PG8_WAIT_V(8); PG8_WAIT_L(0); PG8_BAR; PG8_MMA(0, 0, At, B0); PG8_MMA(0, 1, At, B1); PG8_BAR; PG8_SCHED;
            PG8_LDA(At, 1, 1); PG8_STB(PG8_SB(1, 0), b3); PG8_STB(PG8_SB(1, 1), b3 + hstep); PG8_STA(PG8_SA(1, 0), a3, 0, v2);
            PG8_WAIT_V(8); PG8_WAIT_L(0); PG8_BAR; PG8_MMA(1, 0, At, B0); PG8_MMA(1, 1, At, B1); PG8_BAR; PG8_SCHED;
        }
        if (wr == 0) PG8_BAR;
        if constexpr (FP8) {
            asm volatile("s_nop 15\n\ts_nop 15" ::: "memory");
#pragma unroll
            for (int a = 0; a < 2; ++a)
#pragma unroll
                for (int b = 0; b < 2; ++b)
#pragma unroll
                    for (int m = 0; m < 4; ++m)
#pragma unroll
                        for (int n = 0; n < 2; ++n) asm volatile("" : "+v"(acc[a][b][m][n]));
        }
        E(acc, cur, wr, wc, fr, fq);
        if constexpr (epi_dup<Epi>::v) { asm volatile("" ::: "memory"); E(acc, cur, wr, wc, fr, fq); }
        if (!has_next) break;
        bool keep_acc = false; if constexpr (epi_chain<Epi>::v) keep_acc = E.keep(cur);
        if (!keep_acc) {
#pragma unroll
        for (int a = 0; a < 2; ++a)
#pragma unroll
            for (int b = 0; b < 2; ++b)
#pragma unroll
                for (int m = 0; m < 4; ++m)
#pragma unroll
                    for (int n = 0; n < 2; ++n) acc[a][b][m][n] = (f32x4){0.f, 0.f, 0.f, 0.f};
        }
        cur = nxt; cA = nA; cB = nB; ++ui;
        if constexpr (GATHER) {
#pragma unroll
            for (int h = 0; h < 2; ++h)
#pragma unroll
                for (int i = 0; i < 2; ++i) vC[h][i] = vN[h][i];
        }
        if (wr == 1) PG8_BAR;
    }
    PG8_WAIT_V(0);
    PG8_BAR;
#undef PG8_SA
#undef PG8_SB
#undef PG8_STAGE2
#undef PG8_STB
#undef PG8_STA
#undef PG8_LDA
#undef PG8_LDB
#undef PG8_MMA
#undef PG8_WAIT_V
#undef PG8_WAIT_L
#undef PG8_BAR
#undef PG8_SCHED
}
}

namespace att {
typedef unsigned short bf16_t;
using bf16x8 = __attribute__((ext_vector_type(8))) short;
using s16x4  = __attribute__((ext_vector_type(4))) short;
using f32x16 = __attribute__((ext_vector_type(16))) float;
using u32x4  = __attribute__((ext_vector_type(4))) unsigned;
constexpr int NW = 8, QBLK = 32, KVBLK = 64;
constexpr float SCALE = 0.125f;
#ifndef ATT_SGB
#define ATT_SGB 1
#endif
#ifndef ATT_PROBE
#define ATT_PROBE 0
#endif
constexpr float THR = 8.f;
constexpr int SHM_V = KVBLK * 128 * 2, SHM_K = KVBLK * 128 * 2;
constexpr int SHM_ATTN = 2 * SHM_V + 2 * SHM_K + NW * 64 * 4;
#define KSWZ(row, colB) ((row) * 256 + ((colB) ^ (((row) & 7) << 4)))
#define SBAR() __builtin_amdgcn_sched_barrier(0)
#define SGB(mask, n) __builtin_amdgcn_sched_group_barrier((mask), (n), 0)
#define S1_PIPE() do { if (ATT_SGB) { SGB(0x100, 4); _Pragma("unroll") for (int i_ = 0; i_ < 8; ++i_) { SGB(0x008, 1); SGB(0x002, 13); if ((i_ & 1) && i_ < 5) SGB(0x100, 2); } } } while (0)
__device__ __forceinline__ int crow(int r, int hi) { return (r & 3) + 8 * (r >> 2) + 4 * hi; }
typedef float f32x2_a __attribute__((ext_vector_type(2))); typedef __bf16 bf16x2_a __attribute__((ext_vector_type(2)));
__device__ __forceinline__ unsigned cvtpk(float lo, float hi) { const f32x2_a v = {lo, hi}; const bf16x2_a b = __builtin_convertvector(v, bf16x2_a); return __builtin_bit_cast(unsigned, b); }
__device__ __forceinline__ unsigned short f2bf(float f) { return (unsigned short)(cvtpk(f, 0.f) & 0xffffu); }

__device__ __forceinline__ void partialSM(f32x16& p0, f32x16& p1, float& m_reg, float& mn, float& alpha, bool domask, int dq) {
  constexpr float C = SCALE * 1.4426950408889634f;
  if (domask) {
#pragma unroll
    for (int r = 0; r < 16; ++r) { const int d0 = dq + (r & 3) + 8 * (r >> 2), d1 = d0 + 32;
      if (d0 > 128 || d0 < -128) p0[r] = -1e30f; if (d1 > 128 || d1 < -128) p1[r] = -1e30f; }
  }
  float pmax = p0[0];
#pragma unroll
  for (int r = 1; r < 16; ++r) pmax = fmaxf(pmax, p0[r]);
#pragma unroll
  for (int r = 0; r < 16; ++r) pmax = fmaxf(pmax, p1[r]);
  { auto rr = __builtin_amdgcn_permlane32_swap(__float_as_uint(pmax), __float_as_uint(pmax), false, false);
    pmax = fmaxf(__uint_as_float(rr[0]), __uint_as_float(rr[1])); }
  if (__builtin_expect(__all(pmax - m_reg <= THR / SCALE), 1)) { mn = m_reg; alpha = 1.f; }
  else { mn = fmaxf(m_reg, pmax); alpha = __builtin_amdgcn_exp2f((m_reg - mn) * C); m_reg = mn; }
  const float mnC = -mn * C;
#pragma unroll
  for (int r = 0; r < 16; ++r) p0[r] = fmaf(p0[r], C, mnC);
#pragma unroll
  for (int r = 0; r < 16; ++r) p1[r] = fmaf(p1[r], C, mnC);
#pragma unroll
  for (int r = 0; r < 16; ++r) { if (ATT_PROBE == 3) { float x2 = p0[r]; asm volatile("" : "+v"(x2)); p0[r] = 0.5f * (__builtin_amdgcn_exp2f(p0[r]) + __builtin_amdgcn_exp2f(x2)); } else p0[r] = __builtin_amdgcn_exp2f(p0[r]); }
}
__device__ __forceinline__ void finishSM(f32x16& p0, f32x16& p1, float alpha, float& l_reg, bf16x8& pa0, bf16x8& pa1, bf16x8& pa2, bf16x8& pa3, float pscale = 1.0f) {
#pragma unroll
  for (int r = 0; r < 16; ++r) { if (ATT_PROBE == 3) { float x2 = p1[r]; asm volatile("" : "+v"(x2)); p1[r] = 0.5f * (__builtin_amdgcn_exp2f(p1[r]) + __builtin_amdgcn_exp2f(x2)); } else p1[r] = __builtin_amdgcn_exp2f(p1[r]); }
  float ps = 0;
#pragma unroll
  for (int r = 0; r < 16; ++r) ps += p0[r];
#pragma unroll
  for (int r = 0; r < 16; ++r) ps += p1[r];
  { auto rr = __builtin_amdgcn_permlane32_swap(__float_as_uint(ps), __float_as_uint(ps), false, false);
    ps = __uint_as_float(rr[0]) + __uint_as_float(rr[1]); }
  l_reg = l_reg * alpha + ps;
  if (pscale != 1.0f) {
#pragma unroll
    for (int r = 0; r < 16; ++r) { p0[r] *= pscale; p1[r] *= pscale; } }
#define PK4(P, BASE, OUT) do { unsigned a0 = cvtpk(P[BASE + 0], P[BASE + 1]), a1 = cvtpk(P[BASE + 2], P[BASE + 3]);   \
    unsigned b0 = cvtpk(P[BASE + 4], P[BASE + 5]), b1 = cvtpk(P[BASE + 6], P[BASE + 7]);                              \
    auto r0 = __builtin_amdgcn_permlane32_swap(a0, b0, false, false); auto r1 = __builtin_amdgcn_permlane32_swap(a1, b1, false, false); \
    u32x4 w = {r0[0], r1[0], r0[1], r1[1]}; OUT = *reinterpret_cast<bf16x8*>(&w); } while (0)
  PK4(p0, 0, pa0); PK4(p0, 8, pa1); PK4(p1, 0, pa2); PK4(p1, 8, pa3);
#undef PK4
}
__device__ __forceinline__ void qkt(f32x16& p0, f32x16& p1, const char* Ks, const bf16x8* qr, int r32, int hi, int kcolB) {
  p0 = f32x16{}; p1 = f32x16{};
#pragma unroll
  for (int d0 = 0; d0 < 4; ++d0) { const int cb = kcolB + (d0 * 16 + hi * 8) * 2;
    bf16x8 b0 = *reinterpret_cast<const bf16x8*>(Ks + KSWZ(r32, cb));
    bf16x8 b1 = *reinterpret_cast<const bf16x8*>(Ks + KSWZ(32 + r32, cb));
    p0 = __builtin_amdgcn_mfma_f32_32x32x16_bf16(b0, qr[d0], p0, 0, 0, 0);
    p1 = __builtin_amdgcn_mfma_f32_32x32x16_bf16(b1, qr[d0], p1, 0, 0, 0); }
}
__device__ __forceinline__ int v_st(int k, int c) { const int kk = (k & ~0xC) | ((k & 4) << 1) | ((k & 8) >> 1); return ((kk >> 3) * 4 + (c >> 5)) * 512 + ((kk & 7) * 32 + (c & 31)) * 2; }
__device__ __forceinline__ int v_rd_base(int lane) { return ((lane & 3) << 3) | (((lane >> 2) & 3) << 6) | (((lane >> 4) & 1) << 5) | (((lane >> 5) & 1) << 8); }
constexpr int v_rd_off(int d0, int ks, int half) { return d0 * 512 + ks * 4096 + half * 2048; }
template <int OFF> __device__ __forceinline__ s16x4 tr_read(int vb) {
  s16x4 r; asm volatile("ds_read_b64_tr_b16 %0, %1 offset:%2" : "=&v"(r) : "v"(vb), "i"(OFF) : "memory"); return r;
}
template <int D0> __device__ __forceinline__ void pv_one(f32x16& od, int vb, bf16x8 pa0, bf16x8 pa1, bf16x8 pa2, bf16x8 pa3) {
  const s16x4 l0 = tr_read<v_rd_off(D0, 0, 0)>(vb), h0 = tr_read<v_rd_off(D0, 0, 1)>(vb), l1 = tr_read<v_rd_off(D0, 1, 0)>(vb), h1 = tr_read<v_rd_off(D0, 1, 1)>(vb);
  const s16x4 l2 = tr_read<v_rd_off(D0, 2, 0)>(vb), h2 = tr_read<v_rd_off(D0, 2, 1)>(vb), l3 = tr_read<v_rd_off(D0, 3, 0)>(vb), h3 = tr_read<v_rd_off(D0, 3, 1)>(vb);
  asm volatile("s_waitcnt lgkmcnt(0)" ::: "memory"); SBAR();
#define PK(L, H) (bf16x8){L[0], L[1], L[2], L[3], H[0], H[1], H[2], H[3]}
  od = __builtin_amdgcn_mfma_f32_32x32x16_bf16(pa0, PK(l0, h0), od, 0, 0, 0);
  od = __builtin_amdgcn_mfma_f32_32x32x16_bf16(pa1, PK(l1, h1), od, 0, 0, 0);
  od = __builtin_amdgcn_mfma_f32_32x32x16_bf16(pa2, PK(l2, h2), od, 0, 0, 0);
  od = __builtin_amdgcn_mfma_f32_32x32x16_bf16(pa3, PK(l3, h3), od, 0, 0, 0);
#undef PK
}
template <bool DIFF> __device__ __forceinline__ void pv_all(f32x16* o, int vb, bf16x8 pa0, bf16x8 pa1, bf16x8 pa2, bf16x8 pa3) {
  pv_one<0>(o[0], vb, pa0, pa1, pa2, pa3); pv_one<1>(o[1], vb, pa0, pa1, pa2, pa3);
  if constexpr (DIFF) { pv_one<2>(o[2], vb, pa0, pa1, pa2, pa3); pv_one<3>(o[3], vb, pa0, pa1, pa2, pa3); }
}

struct UnitArgs {
  const GAS bf16_t* Q;
  int qg1;
  const GAS bf16_t* K;
  const GAS bf16_t* V;
  int ldk;
  int s1, n1, s2, n2;
  int qpos0;
  float sink0, sink1;
  int use_sink;
  GAS bf16_t* O;
  int og1;
  float lam, post;
  const GAS float* subg;
};

template <bool DIFF, bool MASK>
__device__ __forceinline__ void attn_unit(const UnitArgs& A, char* lds, const int wave0) {
  constexpr int NO = DIFF ? 4 : 2;
  const int lane = lane_now(), tid = wave0 * 64 + lane, wid = wave0, r32 = lane & 31, hi = lane >> 5;
  const int mg = wid >> 2, wq = wid & 3;
  char* V_lds = lds; char* K_lds = lds + 2 * SHM_V;
  float* ws = (float*)(lds + 2 * SHM_V + 2 * SHM_K) + wid * 64; float* li_l = ws; float* al_l = ws + 32;
  float m_reg = -1e30f, l_reg = 0.f;
  if (!DIFF && A.use_sink) { m_reg = (mg ? A.sink1 : A.sink0) * (1.0f / SCALE); l_reg = 1.f; }
  f32x16 o[NO];
#pragma unroll
  for (int d = 0; d < NO; ++d) o[d] = f32x16{};
  bf16x8 qr[4];
  const GAS bf16_t* Qw = A.Q + (mg ? A.qg1 : 0) + (long)(wq * QBLK + r32) * 512 + hi * 8;
#pragma unroll
  for (int d0 = 0; d0 < 4; ++d0) qr[d0] = *(const GAS bf16x8*)(Qw + d0 * 16);
  const int sr = tid >> 4, sc = (tid & 15) * 8, vst0 = v_st(sr, sc), vst1 = v_st(32 + sr, sc);
  const int vb0 = (int)(uintptr_t)V_lds + v_rd_base(lane) + ((!DIFF && mg) ? 1024 : 0);
  const int kcolB = mg * 128;
  const int ldk = A.ldk;
  const GAS bf16_t* Kh = A.K; const GAS bf16_t* Vh = A.V;
  const int NT = A.n1 + A.n2;
  const int qposl = A.qpos0 + wq * QBLK + r32;
  constexpr bool maskunit = MASK;
#define KST(j) ((j) < A.n1 ? A.s1 + (j) * KVBLK : A.s2 + ((j) - A.n1) * KVBLK)
  struct { bf16x8 vs0, vs1, ks0, ks1; } sr_[2];
#define SLOAD(i, k0) do { const long k0_ = (k0); sr_[i].vs0 = *(const GAS bf16x8*)(&Vh[(k0_ + sr) * ldk + sc]); sr_[i].vs1 = *(const GAS bf16x8*)(&Vh[(k0_ + 32 + sr) * ldk + sc]); \
    sr_[i].ks0 = *(const GAS bf16x8*)(&Kh[(k0_ + sr) * ldk + sc]); sr_[i].ks1 = *(const GAS bf16x8*)(&Kh[(k0_ + 32 + sr) * ldk + sc]); } while (0)
#define SWRITE(b, i) do { *(bf16x8*)(V_lds + (b) * SHM_V + vst0) = sr_[i].vs0;          \
    *(bf16x8*)(V_lds + (b) * SHM_V + vst1) = sr_[i].vs1; const int kc = sc * 2;               \
    *(bf16x8*)(K_lds + (b) * SHM_K + KSWZ(sr, kc)) = sr_[i].ks0;                       \
    *(bf16x8*)(K_lds + (b) * SHM_K + KSWZ(32 + sr, kc)) = sr_[i].ks1; } while (0)
#define SWAIT() asm volatile("s_waitcnt vmcnt(4)" ::: "memory")
#define RESC(a) do { if (__any((a) < 1.f)) { if (hi == 0) al_l[r32] = (a); asm volatile("s_waitcnt lgkmcnt(0)" ::: "memory"); \
    _Pragma("unroll") for (int d = 0; d < NO; ++d) _Pragma("unroll") for (int r = 0; r < 16; ++r) o[d][r] *= al_l[crow(r, hi)]; } } while (0)
#define MASKARGS(j) (maskunit && (j) >= A.n1), (KST(j) - qposl + 4 * hi)
  f32x16 pA0, pA1, pB0, pB1; float mnA, mnB, alA, alB; bf16x8 pa0, pa1, pa2, pa3;
  constexpr int SE = 0, SO = 1;
  __syncthreads();
  SLOAD(SE, KST(0)); asm volatile("s_waitcnt vmcnt(0)" ::: "memory"); SWRITE(0, SE); __syncthreads();
  qkt(pA0, pA1, K_lds, qr, r32, hi, kcolB); partialSM(pA0, pA1, m_reg, mnA, alA, MASKARGS(0));
  SLOAD(SO, KST(1)); if (2 < NT) SLOAD(SE, KST(2));
  SWAIT(); SWRITE(1, SO); __syncthreads();
  for (int j = 1; j + 1 < NT; j += 2) {
    SBAR(); qkt(pB0, pB1, K_lds + SHM_K, qr, r32, hi, kcolB);
    if (ATT_PROBE == 1) { asm volatile("" : "+v"(pB0), "+v"(pB1)); qkt(pB0, pB1, K_lds + SHM_K, qr, r32, hi, kcolB); }
    finishSM(pA0, pA1, alA, l_reg, pa0, pa1, pa2, pa3, ATT_PROBE == 2 ? 0.5f : 1.0f); S1_PIPE(); SBAR();
    SLOAD(SO, KST(j + 2)); SBAR();
    if (ATT_PROBE == 2) pv_all<DIFF>(o, vb0, pa0, pa1, pa2, pa3);
    pv_all<DIFF>(o, vb0, pa0, pa1, pa2, pa3); partialSM(pB0, pB1, m_reg, mnB, alB, MASKARGS(j));
    __syncthreads(); SWAIT(); SWRITE(0, SE); if (ATT_PROBE == 4) { asm volatile("" ::: "memory"); SWRITE(0, SE); }
    RESC(alB); __syncthreads();
    SBAR(); qkt(pA0, pA1, K_lds, qr, r32, hi, kcolB);
    if (ATT_PROBE == 1) { asm volatile("" : "+v"(pA0), "+v"(pA1)); qkt(pA0, pA1, K_lds, qr, r32, hi, kcolB); }
    finishSM(pB0, pB1, alB, l_reg, pa0, pa1, pa2, pa3, ATT_PROBE == 2 ? 0.5f : 1.0f); S1_PIPE(); SBAR();
    if (j + 3 < NT) SLOAD(SE, KST(j + 3)); SBAR();
    if (ATT_PROBE == 2) pv_all<DIFF>(o, vb0 + SHM_V, pa0, pa1, pa2, pa3);
    pv_all<DIFF>(o, vb0 + SHM_V, pa0, pa1, pa2, pa3); partialSM(pA0, pA1, m_reg, mnA, alA, MASKARGS(j + 1));
    __syncthreads(); SWAIT(); SWRITE(1, SO); if (ATT_PROBE == 4) { asm volatile("" ::: "memory"); SWRITE(1, SO); }
    RESC(alA); __syncthreads();
  }
  SBAR(); qkt(pB0, pB1, K_lds + SHM_K, qr, r32, hi, kcolB);
  finishSM(pA0, pA1, alA, l_reg, pa0, pa1, pa2, pa3); SBAR();
  pv_all<DIFF>(o, vb0, pa0, pa1, pa2, pa3); partialSM(pB0, pB1, m_reg, mnB, alB, MASKARGS(NT - 1));
  __syncthreads(); RESC(alB);
  finishSM(pB0, pB1, alB, l_reg, pa0, pa1, pa2, pa3); SBAR();
  pv_all<DIFF>(o, vb0 + SHM_V, pa0, pa1, pa2, pa3);
  if (hi == 0) li_l[r32] = l_reg; asm volatile("s_waitcnt lgkmcnt(0)" ::: "memory");
  float rli[16];
#pragma unroll
  for (int r = 0; r < 16; ++r) rli[r] = __builtin_amdgcn_rcpf(li_l[crow(r, hi)]);
  if constexpr (!DIFF) {
    GAS bf16_t* Ow = A.O + (mg ? A.og1 : 0) + (long)(wq * QBLK) * 512;
#pragma unroll
    for (int r = 0; r < 16; ++r) { const int orow = crow(r, hi);
#pragma unroll
      for (int d0 = 0; d0 < 2; ++d0) Ow[(long)orow * 512 + d0 * 32 + r32] = f2bf(o[d0][r] * rli[r]); }
  } else {
    float* ex = (float*)lds;
    __syncthreads();
    if (mg == 1) {
#pragma unroll
      for (int d0 = 0; d0 < 4; ++d0)
#pragma unroll
        for (int r = 0; r < 16; ++r) ex[(wq * 64 + d0 * 16 + r) * 64 + lane] = o[d0][r] * rli[r];
    }
    __syncthreads();
    if (mg == 0) {
      GAS bf16_t* Ow = A.O + (long)(wq * QBLK) * 512;
      float gsub[4];
#pragma unroll
      for (int d0 = 0; d0 < 4; ++d0) gsub[d0] = A.subg[d0 * 32 + r32] * A.post;
#pragma unroll
      for (int r = 0; r < 16; ++r) {
        float v[4]; float ss = 0.f;
#pragma unroll
        for (int d0 = 0; d0 < 4; ++d0) { v[d0] = o[d0][r] * rli[r] - A.lam * ex[(wq * 64 + d0 * 16 + r) * 64 + lane]; ss += v[d0] * v[d0]; }
        ss += __shfl_xor(ss, 1); ss += __shfl_xor(ss, 2); ss += __shfl_xor(ss, 4); ss += __shfl_xor(ss, 8); ss += __shfl_xor(ss, 16);
        const float rn = __builtin_amdgcn_rsqf(ss * (1.0f / 128.0f) + 1e-6f);
        const int orow = crow(r, hi);
#pragma unroll
        for (int d0 = 0; d0 < 4; ++d0) Ow[(long)orow * 512 + d0 * 32 + r32] = f2bf(v[d0] * rn * gsub[d0]);
      }
    }
  }
#undef KST
#undef SLOAD
#undef SWRITE
#undef SWAIT
#undef RESC
#undef MASKARGS
}
#undef KSWZ
}
#include <hip/hip_bf16.h>
namespace att64 {
using bf16=__hip_bfloat16;
using bf16x8=__attribute__((ext_vector_type(8)))short;
using s16x4=__attribute__((ext_vector_type(4)))short;
using f32x16=__attribute__((ext_vector_type(16)))float;
using u32x4=__attribute__((ext_vector_type(4)))unsigned;
constexpr int D=64;
constexpr int NW=8,QBLK=32,QB=QBLK*NW,KVBLK=64;
__device__ __forceinline__ int crow(int r,int hi){return (r&3)+8*(r>>2)+4*hi;}
#define SBAR() __builtin_amdgcn_sched_barrier(0)
__device__ __forceinline__ void bmask(f32x16&p0,f32x16&p1,int dq){
  const float NEG=-INFINITY;
  #pragma unroll
  for(int r=0;r<16;++r){const int d0=dq+(r&3)+8*(r>>2),d1=d0+32; if(d0>128||d0<-128)p0[r]=NEG; if(d1>128||d1<-128)p1[r]=NEG;}
}
constexpr int NSLOT=3, SLOTB=8192;
constexpr int LDS_K=0, LDS_V=NSLOT*SLOTB, LDS_WS=2*NSLOT*SLOTB, LDS_OST=LDS_WS+NW*64*4, LDS_BYTES=LDS_OST+NW*4096;
constexpr float C2=0.125f*1.4426950408889634f;
__device__ __forceinline__ void glds16(const void*gsrc,unsigned lds_dst){unsigned keep;
  asm volatile("s_mov_b32 %0, m0\n\ts_mov_b32 m0, %2\n\ts_nop 0\n\tglobal_load_lds_dwordx4 %1, off\n\ts_mov_b32 m0, %0":"=&s"(keep):"v"(gsrc),"s"(lds_dst):"memory");}
__device__ __forceinline__ float max3f(float a,float b,float c){float r;asm("v_max3_f32 %0, %1, %2, %3":"=v"(r):"v"(a),"v"(b),"v"(c));return r;}
__device__ __forceinline__ float max2f(float a,float b){float r;asm("v_max_f32_e32 %0, %1, %2":"=v"(r):"v"(a),"v"(b));return r;}
__device__ __forceinline__ float fadd_s(float a,float b){float r;asm("v_add_f32_e32 %0, %1, %2":"=v"(r):"v"(a),"v"(b));return r;}
__device__ __forceinline__ float fsub_s(float a,float b){float r;asm("v_sub_f32_e32 %0, %1, %2":"=v"(r):"v"(a),"v"(b));return r;}
typedef float f32x2_t __attribute__((ext_vector_type(2))); typedef __bf16 bf16x2_t __attribute__((ext_vector_type(2)));
__device__ __forceinline__ unsigned cvtpk_s(float lo,float hi){f32x2_t v={lo,hi};bf16x2_t b=__builtin_convertvector(v,bf16x2_t);return __builtin_bit_cast(unsigned,b);}
#define WAIT_BAR(N) asm volatile("s_waitcnt vmcnt(" #N ") lgkmcnt(0)\n\ts_barrier":::"memory")

__device__ __forceinline__ void qkt(f32x16&p0,f32x16&p1,const char*Kslot,const bf16x8*qr,const f32x16&negm,int r32,int hi){
  const char*kb=Kslot+hi*1024+r32*16;
  #pragma unroll
  for(int d0=0;d0<4;++d0){
    const bf16x8 b0=*reinterpret_cast<const bf16x8*>(kb+d0*2048);
    const bf16x8 b1=*reinterpret_cast<const bf16x8*>(kb+d0*2048+512);
    if(d0==0){p0=__builtin_amdgcn_mfma_f32_32x32x16_bf16(b0,qr[0],negm,0,0,0);p1=__builtin_amdgcn_mfma_f32_32x32x16_bf16(b1,qr[0],negm,0,0,0);}
    else{p0=__builtin_amdgcn_mfma_f32_32x32x16_bf16(b0,qr[d0],p0,0,0,0);p1=__builtin_amdgcn_mfma_f32_32x32x16_bf16(b1,qr[d0],p1,0,0,0);}}
}
typedef __attribute__((address_space(3))) const char* lds_cptr;
typedef short v4i16_t __attribute__((ext_vector_type(4)));
__device__ __forceinline__ void kload8(bf16x8*kf,lds_cptr kp){
  kf[0]=*(const __attribute__((address_space(3))) bf16x8*)(kp);      kf[1]=*(const __attribute__((address_space(3))) bf16x8*)(kp+512);
  kf[2]=*(const __attribute__((address_space(3))) bf16x8*)(kp+2048); kf[3]=*(const __attribute__((address_space(3))) bf16x8*)(kp+2560);
  kf[4]=*(const __attribute__((address_space(3))) bf16x8*)(kp+4096); kf[5]=*(const __attribute__((address_space(3))) bf16x8*)(kp+4608);
  kf[6]=*(const __attribute__((address_space(3))) bf16x8*)(kp+6144); kf[7]=*(const __attribute__((address_space(3))) bf16x8*)(kp+6656);
}
__device__ __forceinline__ void kload2(bf16x8*kf,lds_cptr kp,int j){ kf[2*j]=*(const __attribute__((address_space(3))) bf16x8*)(kp+j*2048); kf[2*j+1]=*(const __attribute__((address_space(3))) bf16x8*)(kp+j*2048+512); }
__device__ __forceinline__ s16x4 vtr(lds_cptr p){ return __builtin_bit_cast(s16x4,__builtin_amdgcn_ds_read_tr16_b64_v4i16((__attribute__((address_space(3))) v4i16_t*)p)); }
__device__ __forceinline__ float rowmax(const f32x16&p0,const f32x16&p1){
  float a=max3f(p0[0],p0[1],p1[0]),b=max3f(p0[2],p0[3],p1[1]);a=max3f(a,p1[2],p1[3]);
  #pragma unroll
  for(int r=4;r<16;r+=4){a=max3f(a,p0[r],p0[r+1]);b=max3f(b,p0[r+2],p0[r+3]);a=max3f(a,p1[r],p1[r+1]);b=max3f(b,p1[r+2],p1[r+3]);}
  const float m=max2f(a,b);
  auto rr=__builtin_amdgcn_permlane32_swap(__float_as_uint(m),__float_as_uint(m),false,false);
  return max2f(__uint_as_float(rr[0]),__uint_as_float(rr[1]));
}
__device__ __forceinline__ void pv(f32x16*o,int vb,bf16x8 pa0,bf16x8 pa1,bf16x8 pa2,bf16x8 pa3){
  #pragma unroll
  for(int d0=0;d0<2;++d0){s16x4 lo[4],hi[4];
    #pragma unroll
    for(int ks=0;ks<4;++ks){
      asm volatile("ds_read_b64_tr_b16 %0,%1 offset:%c2":"=&v"(lo[ks]):"v"(vb),"i"(d0*4096+ks*1024):"memory");
      asm volatile("ds_read_b64_tr_b16 %0,%1 offset:%c2":"=&v"(hi[ks]):"v"(vb),"i"(d0*4096+ks*1024+512):"memory");}
    asm volatile("s_waitcnt lgkmcnt(0)":::"memory");SBAR();
    #define PK(k) (bf16x8){lo[k][0],lo[k][1],lo[k][2],lo[k][3],hi[k][0],hi[k][1],hi[k][2],hi[k][3]}
    o[d0]=__builtin_amdgcn_mfma_f32_32x32x16_bf16(pa0,PK(0),o[d0],0,0,0);
    o[d0]=__builtin_amdgcn_mfma_f32_32x32x16_bf16(pa1,PK(1),o[d0],0,0,0);
    o[d0]=__builtin_amdgcn_mfma_f32_32x32x16_bf16(pa2,PK(2),o[d0],0,0,0);
    o[d0]=__builtin_amdgcn_mfma_f32_32x32x16_bf16(pa3,PK(3),o[d0],0,0,0);
    #undef PK
  }
}

#ifndef ATTN_STORE16
#define ATTN_STORE16(p,v) (*(u32x4*)(p)=(v))
#endif
template<int THRL,bool MASK,bool PAIR> __device__ __forceinline__ void attn_unit(const bf16*Qu,int qp,const bf16*__restrict__ Kh,const bf16*__restrict__ Vh,int kvp,int NT,int n1,int s2,int kpos2,int qpos0,int use_sink,float sink_l2,float sink_l2b,bf16*Ou,int op,char*shm,const int wave0){
  const int lane=lane_now(),tid=wave0*64+lane,r32=lane&31,hi=lane>>5; const int wid=wave0;
  const int wrow=PAIR?(wid&3):wid, whead=PAIR?(wid>>2):0;
  const bf16*Qw=Qu+(long)(wrow*QBLK)*qp+whead*D;
  const unsigned lds0=(unsigned)(uintptr_t)shm;
  float*wsf=(float*)(shm+LDS_WS)+wid*64;
  const bf16*ksrc=Kh+(long)lane*kvp+wid*8;
  const bf16*vsrc=Vh+(long)(16*(wid&3)+(lane>>2))*kvp+(wid>>2)*32+(lane&3)*8;
  const unsigned kdst=lds0+LDS_K+wid*1024, vdst=lds0+LDS_V+wid*1024;
  #define KROW(t) ((t)<n1?(t)*KVBLK:s2+((t)-n1)*KVBLK)
  #define DMA_K(t,slot) glds16(ksrc+(long)KROW(t)*kvp,(unsigned)__builtin_amdgcn_readfirstlane(kdst+(slot)))
  #define DMA_V(t,slot) glds16(vsrc+(long)KROW(t)*kvp,(unsigned)__builtin_amdgcn_readfirstlane(vdst+(slot)))
  const int vb0=(int)(lds0+LDS_V)+((lane>>4)&1)*32+(lane&3)*8+(4*hi+((lane&15)>>2))*64;
  const char*Kbase=shm+LDS_K; bf16x8 kf[8];
  const lds_cptr shm3=(lds_cptr)shm; const lds_cptr kp0=shm3+LDS_K+hi*1024+r32*16; const lds_cptr vp0=shm3+LDS_V+((lane>>4)&1)*32+(lane&3)*8+(4*hi+((lane&15)>>2))*64;
  DMA_K(0,0);DMA_V(0,0);DMA_K(1,SLOTB);
  bf16x8 qr[4];
  #pragma unroll
  for(int d0=0;d0<4;++d0)qr[d0]=*reinterpret_cast<const bf16x8*>(&Qw[(long)r32*qp+d0*16+hi*8]);
  float mhat=0.f,l_reg=0.f;f32x16 o[2];o[0]=f32x16{};o[1]=f32x16{};f32x16 negm=f32x16{};asm volatile("":"+v"(negm));
  const int dqb=kpos2-(qpos0+wrow*QBLK+r32)+4*hi;
  #define CMASK(P0,P1,t) do{ if(MASK&&(t)>=n1) bmask(P0,P1,dqb+((t)-n1)*KVBLK); }while(0)
  bool resc=false;
  #define START(P0,P1) do{ const float rm=rowmax(P0,P1); resc=false; \
    { const float dl=rm; mhat=fadd_s(mhat,dl); \
      _Pragma("unroll") for(int r=0;r<16;++r){P0[r]=fsub_s(P0[r],dl);P1[r]=fsub_s(P1[r],dl);} \
      _Pragma("unroll") for(int r=0;r<16;++r)negm[r]=-mhat; asm volatile("":"+v"(negm)); } \
    _Pragma("unroll") for(int r=0;r<16;++r)P0[r]=__builtin_amdgcn_exp2f(P0[r]); }while(0)
  #define RESC() do{ if(resc){ asm volatile("s_waitcnt lgkmcnt(0)":::"memory"); \
      _Pragma("unroll") for(int d_=0;d_<2;++d_) _Pragma("unroll") for(int r=0;r<16;++r)o[d_][r]*=wsf[crow(r,hi)]; } }while(0)
  f32x16 pA0,pA1,pB0,pB1;
  int sl_prev=0,sl_cur=0,sl_next=SLOTB;
  #define ROT() do{sl_prev=sl_cur;sl_cur=sl_next;sl_next=(sl_next==(NSLOT-1)*SLOTB)?0:sl_next+SLOTB;}while(0)
  DMA_K(2,2*SLOTB);
  WAIT_BAR(3);
  qkt(pA0,pA1,Kbase,qr,f32x16{},r32,hi);asm volatile("s_nop 15\n\ts_nop 7":"+v"(pA0),"+v"(pA1));CMASK(pA0,pA1,0);
  START(pA0,pA1);
  _Pragma("unroll") for(int r=0;r<16;++r)pA1[r]=__builtin_amdgcn_exp2f(pA1[r]);
  WAIT_BAR(0);
  DMA_K(3,0);DMA_V(1,SLOTB);
  ROT();
  kload8(kf,kp0+sl_cur);
  WAIT_BAR(2);
  s16x4 vlo[8],vhi[8]; u32x4 pw0,pw1,pw2,pw3;
  #define PKW(P,B) cvtpk_s(P[B],P[B+1])
  #define PAF(k) __builtin_bit_cast(bf16x8,pw##k)
  #define VFR(i) (bf16x8){vlo[i][0],vlo[i][1],vlo[i][2],vlo[i][3],vhi[i][0],vhi[i][1],vhi[i][2],vhi[i][3]}
  #define PIN(x) asm volatile("":"+v"(x))
  #define MX3(a,b,c) __builtin_fmaxf(__builtin_fmaxf((a),(b)),(c))
  #define GAPA(MF,A0,A1,A2,A3,W0,W1,PW) do{ MF; sacc+=A0; sacc+=A1; sacc+=A2; sacc+=A3; PIN(sacc); W0; W1; PIN(PW); SBAR(); }while(0)
  #define EX(v) __builtin_amdgcn_exp2f(v)
  #define GAPB(MF,X,B) do{ MF; X[B]=EX(X[B]); X[B+1]=EX(X[B+1]); X[B+2]=EX(X[B+2]); X[B+3]=EX(X[B+3]); PIN(X); SBAR(); }while(0)
  #define VRD(i) do{ vlo[i]=vtr(vp_+(((i)>>2)*4096+((i)&3)*1024)); vhi[i]=vtr(vp_+(((i)>>2)*4096+((i)&3)*1024+512)); }while(0)
  #define KRD(G,j) do{ if(G){ kload2(kf,kp0+sl_next,j); SBAR(); } }while(0)
  #define STEP(C0,C1,P0,P1,t,GK,GV,GL) do{ SBAR(); \
    const lds_cptr vp_=vp0+sl_prev; \
    VRD(0); SBAR(); float sacc=(P0[0]+P0[1]); \
    GAPA(C0=__builtin_amdgcn_mfma_f32_32x32x16_bf16(kf[0],qr[0],negm,0,0,0), P0[2],P0[3],P0[4],P0[5],     pw0[0]=PKW(P0,0), pw0[1]=PKW(P0,2), pw0); \
    VRD(4); SBAR(); GAPA(C1=__builtin_amdgcn_mfma_f32_32x32x16_bf16(kf[1],qr[0],negm,0,0,0), P0[6],P0[7],P0[8],P0[9],     pw0[2]=PKW(P0,4), pw0[3]=PKW(P0,6), pw0); \
    VRD(1); SBAR(); GAPA(C0=__builtin_amdgcn_mfma_f32_32x32x16_bf16(kf[2],qr[1],C0,0,0,0),   P0[10],P0[11],P0[12],P0[13], pw1[0]=PKW(P0,8), pw1[1]=PKW(P0,10), pw1); \
    VRD(5); SBAR(); GAPA(C1=__builtin_amdgcn_mfma_f32_32x32x16_bf16(kf[3],qr[1],C1,0,0,0),   P0[14],P0[15],P1[0],P1[1],   pw1[2]=PKW(P0,12),pw1[3]=PKW(P0,14), pw1); \
    VRD(2); SBAR(); GAPA(C0=__builtin_amdgcn_mfma_f32_32x32x16_bf16(kf[4],qr[2],C0,0,0,0),   P1[2],P1[3],P1[4],P1[5],     pw2[0]=PKW(P1,0), pw2[1]=PKW(P1,2), pw2); \
    VRD(6); SBAR(); GAPA(C1=__builtin_amdgcn_mfma_f32_32x32x16_bf16(kf[5],qr[2],C1,0,0,0),   P1[6],P1[7],P1[8],P1[9],     pw2[2]=PKW(P1,4), pw2[3]=PKW(P1,6), pw2); \
    VRD(3); SBAR(); GAPA(C0=__builtin_amdgcn_mfma_f32_32x32x16_bf16(kf[6],qr[3],C0,0,0,0),   P1[10],P1[11],P1[12],P1[13], pw3[0]=PKW(P1,8), pw3[1]=PKW(P1,10), pw3); \
    VRD(7); SBAR(); GAPA(C1=__builtin_amdgcn_mfma_f32_32x32x16_bf16(kf[7],qr[3],C1,0,0,0),   P1[14],P1[15],0.f,0.f,       pw3[2]=PKW(P1,12),pw3[3]=PKW(P1,14), pw3); \
    l_reg+=sacc; \
    if(GK){DMA_K((t)+3,sl_cur);} if(GV){DMA_V((t)+1,sl_next);} \
    CMASK(C0,C1,t); \
    { float a=MX3(C0[0],C0[1],C1[0]),b=MX3(C0[2],C0[3],C1[1]); a=MX3(a,C1[2],C1[3]); \
      _Pragma("unroll") for(int r=4;r<16;r+=4){a=MX3(a,C0[r],C0[r+1]);b=MX3(b,C0[r+2],C0[r+3]);a=MX3(a,C1[r],C1[r+1]);b=MX3(b,C1[r+2],C1[r+3]);} \
      float rm=__builtin_fmaxf(a,b); { auto rr=__builtin_amdgcn_permlane32_swap(__float_as_uint(rm),__float_as_uint(rm),false,false); rm=__builtin_fmaxf(__uint_as_float(rr[0]),__uint_as_float(rr[1])); } \
      resc=false;                                              \
      if(__builtin_expect(__any(rm>(float)THRL),0)){ const float dl=__builtin_fmaxf(rm,0.f); mhat+=dl; \
        _Pragma("unroll") for(int r=0;r<16;++r){C0[r]-=dl;C1[r]-=dl;} \
        _Pragma("unroll") for(int r=0;r<16;++r)negm[r]=-mhat; asm volatile("":"+v"(negm)); \
        const float f=__builtin_amdgcn_exp2f(-dl); l_reg*=f; if(hi==0)wsf[r32]=f; resc=true; } } \
    SBAR(); \
    GAPB(o[0]=__builtin_amdgcn_mfma_f32_32x32x16_bf16(PAF(0),VFR(0),o[0],0,0,0), C0,0); \
    GAPB(o[1]=__builtin_amdgcn_mfma_f32_32x32x16_bf16(PAF(0),VFR(4),o[1],0,0,0), C0,4); \
    KRD(GL,0); GAPB(o[0]=__builtin_amdgcn_mfma_f32_32x32x16_bf16(PAF(1),VFR(1),o[0],0,0,0), C0,8); \
    KRD(GL,1); GAPB(o[1]=__builtin_amdgcn_mfma_f32_32x32x16_bf16(PAF(1),VFR(5),o[1],0,0,0), C0,12); \
    KRD(GL,2); GAPB(o[0]=__builtin_amdgcn_mfma_f32_32x32x16_bf16(PAF(2),VFR(2),o[0],0,0,0), C1,0); \
    KRD(GL,3); GAPB(o[1]=__builtin_amdgcn_mfma_f32_32x32x16_bf16(PAF(2),VFR(6),o[1],0,0,0), C1,4); \
    GAPB(o[0]=__builtin_amdgcn_mfma_f32_32x32x16_bf16(PAF(3),VFR(3),o[0],0,0,0), C1,8); \
    GAPB(o[1]=__builtin_amdgcn_mfma_f32_32x32x16_bf16(PAF(3),VFR(7),o[1],0,0,0), C1,12); \
    }while(0)
  int t=1;
  for(;t+5<NT;t+=2){
    STEP(pB0,pB1,pA0,pA1,t,true,true,true);     WAIT_BAR(2); RESC(); ROT();
    STEP(pA0,pA1,pB0,pB1,t+1,true,true,true);   WAIT_BAR(2); RESC(); ROT();
  }
  #define ENDW(tt) do{ if((tt)+3<NT){WAIT_BAR(2);} else if((tt)+2<NT){WAIT_BAR(1);} else {WAIT_BAR(0);} }while(0)
  for(;t+1<NT;t+=2){
    STEP(pB0,pB1,pA0,pA1,t,(t+3<NT),(t+1<NT),(t+1<NT));       ENDW(t);   RESC(); ROT();
    STEP(pA0,pA1,pB0,pB1,t+1,(t+4<NT),(t+2<NT),(t+2<NT));     ENDW(t+1); RESC(); ROT();
  }
  STEP(pB0,pB1,pA0,pA1,NT-1,false,false,false); RESC();
  { float sacc=pB0[0]+pB0[1]; _Pragma("unroll") for(int r=2;r<16;++r)sacc+=pB0[r]; _Pragma("unroll") for(int r=0;r<16;++r)sacc+=pB1[r]; l_reg+=sacc;
    pw0=(u32x4){PKW(pB0,0),PKW(pB0,2),PKW(pB0,4),PKW(pB0,6)};pw1=(u32x4){PKW(pB0,8),PKW(pB0,10),PKW(pB0,12),PKW(pB0,14)};pw2=(u32x4){PKW(pB1,0),PKW(pB1,2),PKW(pB1,4),PKW(pB1,6)};pw3=(u32x4){PKW(pB1,8),PKW(pB1,10),PKW(pB1,12),PKW(pB1,14)};
    SBAR(); pv(o,vb0+sl_cur,PAF(0),PAF(1),PAF(2),PAF(3)); }
  #undef PKW
  #undef PAF
  #undef VFR
  #undef PIN
  #undef MX3
  #undef GAPA
  #undef GAPB
  #undef EX
  #undef VRD
  #undef KRD
  #undef STEP
  #undef ENDW
  {auto rr=__builtin_amdgcn_permlane32_swap(__float_as_uint(l_reg),__float_as_uint(l_reg),false,false);l_reg=__uint_as_float(rr[0])+__uint_as_float(rr[1]);}
  if(use_sink) l_reg+=__builtin_amdgcn_exp2f(fminf((whead?sink_l2b:sink_l2)-mhat,120.f));
  if(hi==0)wsf[32+r32]=l_reg;asm volatile("s_waitcnt lgkmcnt(0)":::"memory");
  float rli[16];
  #pragma unroll
  for(int r=0;r<16;++r)rli[r]=__builtin_amdgcn_rcpf(wsf[32+crow(r,hi)]);
  bf16*Ow=Ou+(long)(wrow*QBLK)*op+whead*D;
  { bf16*stg=(bf16*)(shm+LDS_OST)+wid*2048;
    #pragma unroll
    for(int r=0;r<16;++r){const int orow=crow(r,hi);
      #pragma unroll
      for(int d0=0;d0<2;++d0)stg[orow*64+d0*32+r32]=__float2bfloat16(o[d0][r]*rli[r]);}
    asm volatile("s_waitcnt lgkmcnt(0)":::"memory");
    #pragma unroll
    for(int i=0;i<4;++i){const int row=i*8+(lane>>3),ch=lane&7; const u32x4 v=*(const u32x4*)(stg+row*64+ch*8); ATTN_STORE16(Ow+(long)row*op+ch*8,v);} }
  asm volatile("s_waitcnt lgkmcnt(0)\n\ts_barrier":::"memory");
  #undef KROW
  #undef DMA_K
  #undef DMA_V
  #undef CMASK
  #undef START
  #undef RESC
  #undef ROT
}
#undef SBAR
#undef WAIT_BAR
}
namespace att128 {
using att64::bf16; using att64::bf16x8; using att64::s16x4; using att64::f32x16; using att64::u32x4; using att64::lds_cptr;
using att64::crow; using att64::glds16; using att64::cvtpk_s; using att64::kload8; using att64::kload2; using att64::vtr; using att64::rowmax; using att64::qkt; using att64::fadd_s; using att64::fsub_s;
typedef float f32x4v __attribute__((ext_vector_type(4)));
constexpr int D=64,NW=8,QBLK=32,KVBLK=64;
constexpr int NSLOT=3, SLOTB=8192;
constexpr int LDS_K=0, LDS_V=NSLOT*SLOTB, LDS_WS=LDS_V+2*NSLOT*SLOTB, LDS_O1=LDS_WS+NW*64*4, LDS_BYTES=LDS_O1+NW*8192;
#define SBAR() __builtin_amdgcn_sched_barrier(0)
#define WAIT_BAR(N) asm volatile("s_waitcnt vmcnt(" #N ") lgkmcnt(0)\n\ts_barrier":::"memory")
__device__ __forceinline__ void pv4(f32x16*o,int vb,bf16x8 pa0,bf16x8 pa1,bf16x8 pa2,bf16x8 pa3){
  #pragma unroll
  for(int d0=0;d0<4;++d0){s16x4 lo[4],hi[4];
    #pragma unroll
    for(int ks=0;ks<4;++ks){
      asm volatile("ds_read_b64_tr_b16 %0,%1 offset:%c2":"=&v"(lo[ks]):"v"(vb),"i"(d0*4096+ks*1024):"memory");
      asm volatile("ds_read_b64_tr_b16 %0,%1 offset:%c2":"=&v"(hi[ks]):"v"(vb),"i"(d0*4096+ks*1024+512):"memory");}
    asm volatile("s_waitcnt lgkmcnt(0)":::"memory");SBAR();
    #define PK(k) (bf16x8){lo[k][0],lo[k][1],lo[k][2],lo[k][3],hi[k][0],hi[k][1],hi[k][2],hi[k][3]}
    o[d0]=__builtin_amdgcn_mfma_f32_32x32x16_bf16(pa0,PK(0),o[d0],0,0,0);
    o[d0]=__builtin_amdgcn_mfma_f32_32x32x16_bf16(pa1,PK(1),o[d0],0,0,0);
    o[d0]=__builtin_amdgcn_mfma_f32_32x32x16_bf16(pa2,PK(2),o[d0],0,0,0);
    o[d0]=__builtin_amdgcn_mfma_f32_32x32x16_bf16(pa3,PK(3),o[d0],0,0,0);
    #undef PK
  }
}
template<int THRL> __device__ __forceinline__ void attn_unit(const bf16*Qu,int qp,const bf16*__restrict__ Kh,const bf16*__restrict__ Vh,int kvp,int NT,int second,float lam,const GAS float*subg,float post,bf16*Ou,int op,char*shm,const int wave0){
  const int lane=lane_now(),r32=lane&31,hi=lane>>5; const int wid=wave0;
  const bf16*Qw=Qu+(long)(wid*QBLK)*qp;
  const unsigned lds0=(unsigned)(uintptr_t)shm;
  float*wsf=(float*)(shm+LDS_WS)+wid*64;
  const bf16*ksrc=Kh+(long)lane*kvp+wid*8;
  const bf16*vsrc=Vh+(long)(16*(wid&3)+(lane>>2))*kvp+(wid>>2)*32+(lane&3)*8;
  const unsigned kdst=lds0+LDS_K+wid*1024, vdst=lds0+LDS_V+wid*1024;
  #define DMA_K(t,slot) glds16(ksrc+(long)((t)*KVBLK)*kvp,(unsigned)__builtin_amdgcn_readfirstlane(kdst+(slot)))
  #define DMA_V(t,slot) do{ glds16(vsrc+(long)((t)*KVBLK)*kvp,(unsigned)__builtin_amdgcn_readfirstlane(vdst+2*(slot))); glds16(vsrc+(long)((t)*KVBLK)*kvp+64,(unsigned)__builtin_amdgcn_readfirstlane(vdst+2*(slot)+8192)); }while(0)
  const int vb0=(int)(lds0+LDS_V)+((lane>>4)&1)*32+(lane&3)*8+(4*hi+((lane&15)>>2))*64;
  const char*Kbase=shm+LDS_K; bf16x8 kf[8];
  const lds_cptr shm3=(lds_cptr)shm; const lds_cptr kp0=shm3+LDS_K+hi*1024+r32*16; const lds_cptr vp0=shm3+LDS_V+((lane>>4)&1)*32+(lane&3)*8+(4*hi+((lane&15)>>2))*64;
  DMA_K(0,0);DMA_V(0,0);DMA_K(1,SLOTB);
  bf16x8 qr[4];
  #pragma unroll
  for(int d0=0;d0<4;++d0)qr[d0]=*reinterpret_cast<const bf16x8*>(&Qw[(long)r32*qp+d0*16+hi*8]);
  float mhat=0.f,l_reg=0.f;f32x16 o[4];o[0]=f32x16{};o[1]=f32x16{};o[2]=f32x16{};o[3]=f32x16{};
  bool resc=false;
  #define START(P0,P1) do{ const float rm=rowmax(P0,P1); resc=false; \
    { const float dl=rm; mhat=fadd_s(mhat,dl); \
      _Pragma("unroll") for(int r=0;r<16;++r){P0[r]=fsub_s(P0[r],dl);P1[r]=fsub_s(P1[r],dl);} \
      } \
    _Pragma("unroll") for(int r=0;r<16;++r)P0[r]=__builtin_amdgcn_exp2f(P0[r]); }while(0)
  #define RESC() do{ if(resc){ asm volatile("s_waitcnt lgkmcnt(0)":::"memory"); \
      _Pragma("unroll") for(int r=0;r<16;++r){ const float f_=wsf[crow(r,hi)]; o[0][r]*=f_;o[1][r]*=f_;o[2][r]*=f_;o[3][r]*=f_; } } }while(0)
  f32x16 pA0,pA1,pB0,pB1;
  int sl_prev=0,sl_cur=0,sl_next=SLOTB;
  #define ROT() do{sl_prev=sl_cur;sl_cur=sl_next;sl_next=(sl_next==(NSLOT-1)*SLOTB)?0:sl_next+SLOTB;}while(0)
  DMA_K(2,2*SLOTB);
  WAIT_BAR(4);
  qkt(pA0,pA1,Kbase,qr,f32x16{},r32,hi);asm volatile("s_nop 15\n\ts_nop 7":"+v"(pA0),"+v"(pA1));
  START(pA0,pA1);
  _Pragma("unroll") for(int r=0;r<16;++r)pA1[r]=__builtin_amdgcn_exp2f(pA1[r]);
  WAIT_BAR(0);
  DMA_K(3,0);DMA_V(1,SLOTB);
  ROT();
  kload8(kf,kp0+sl_cur);
  WAIT_BAR(3);
  s16x4 vlo[16],vhi[16]; u32x4 pw0,pw1,pw2,pw3;
  #define PKW(P,B) cvtpk_s(P[B],P[B+1])
  #define PAF(k) __builtin_bit_cast(bf16x8,pw##k)
  #define VFR(i) (bf16x8){vlo[i][0],vlo[i][1],vlo[i][2],vlo[i][3],vhi[i][0],vhi[i][1],vhi[i][2],vhi[i][3]}
  #define PIN(x) asm volatile("":"+v"(x))
  #define MX3(a,b,c) __builtin_fmaxf(__builtin_fmaxf((a),(b)),(c))
  #define GAPA(MF,A0,A1,A2,A3,W0,W1,PW) do{ MF; sacc+=A0; sacc+=A1; sacc+=A2; sacc+=A3; PIN(sacc); W0; W1; PIN(PW); SBAR(); }while(0)
  #define EX(v) __builtin_amdgcn_exp2f(v)
  #define GAPB(MF,X,B) do{ MF; X[B]=EX(X[B]); X[B+1]=EX(X[B+1]); PIN(X); SBAR(); }while(0)
  #define VRD(n) do{ vlo[n]=vtr(vp_+(((n)&3)*4096+((n)>>2)*1024)); vhi[n]=vtr(vp_+(((n)&3)*4096+((n)>>2)*1024+512)); }while(0)
  #define KRD(G,j) do{ if(G){ kload2(kf,kp0+sl_next,j); SBAR(); } }while(0)
  #define PVM(n,k) o[(n)&3]=__builtin_amdgcn_mfma_f32_32x32x16_bf16(PAF(k),VFR(n),o[(n)&3],0,0,0)
  #define STEP(C0,C1,P0,P1,t,GK,GV,GL) do{ SBAR(); \
    const lds_cptr vp_=vp0+2*sl_prev; \
    VRD(0); SBAR(); float sacc=(P0[0]+P0[1]); \
    GAPA(C0=__builtin_amdgcn_mfma_f32_32x32x16_bf16(kf[0],qr[0],f32x16{},0,0,0), P0[2],P0[3],P0[4],P0[5],     pw0[0]=PKW(P0,0), pw0[1]=PKW(P0,2), pw0); \
    VRD(1); SBAR(); GAPA(C1=__builtin_amdgcn_mfma_f32_32x32x16_bf16(kf[1],qr[0],f32x16{},0,0,0), P0[6],P0[7],P0[8],P0[9],     pw0[2]=PKW(P0,4), pw0[3]=PKW(P0,6), pw0); \
    VRD(2); SBAR(); GAPA(C0=__builtin_amdgcn_mfma_f32_32x32x16_bf16(kf[2],qr[1],C0,0,0,0),   P0[10],P0[11],P0[12],P0[13], pw1[0]=PKW(P0,8), pw1[1]=PKW(P0,10), pw1); \
    VRD(3); SBAR(); GAPA(C1=__builtin_amdgcn_mfma_f32_32x32x16_bf16(kf[3],qr[1],C1,0,0,0),   P0[14],P0[15],P1[0],P1[1],   pw1[2]=PKW(P0,12),pw1[3]=PKW(P0,14), pw1); \
    VRD(4); SBAR(); GAPA(C0=__builtin_amdgcn_mfma_f32_32x32x16_bf16(kf[4],qr[2],C0,0,0,0),   P1[2],P1[3],P1[4],P1[5],     pw2[0]=PKW(P1,0), pw2[1]=PKW(P1,2), pw2); \
    VRD(5); SBAR(); GAPA(C1=__builtin_amdgcn_mfma_f32_32x32x16_bf16(kf[5],qr[2],C1,0,0,0),   P1[6],P1[7],P1[8],P1[9],     pw2[2]=PKW(P1,4), pw2[3]=PKW(P1,6), pw2); \
    VRD(6); SBAR(); GAPA(C0=__builtin_amdgcn_mfma_f32_32x32x16_bf16(kf[6],qr[3],C0,0,0,0),   P1[10],P1[11],P1[12],P1[13], pw3[0]=PKW(P1,8), pw3[1]=PKW(P1,10), pw3); \
    VRD(7); SBAR(); GAPA(C1=__builtin_amdgcn_mfma_f32_32x32x16_bf16(kf[7],qr[3],C1,0,0,0),   P1[14],P1[15],0.f,0.f,       pw3[2]=PKW(P1,12),pw3[3]=PKW(P1,14), pw3); \
    l_reg+=sacc; \
    if(GK){DMA_K((t)+3,sl_cur);} if(GV){DMA_V((t)+1,sl_next);} \
    { float a=MX3(C0[0],C0[1],C1[0]),b=MX3(C0[2],C0[3],C1[1]); a=MX3(a,C1[2],C1[3]); \
      _Pragma("unroll") for(int r=4;r<16;r+=4){a=MX3(a,C0[r],C0[r+1]);b=MX3(b,C0[r+2],C0[r+3]);a=MX3(a,C1[r],C1[r+1]);b=MX3(b,C1[r+2],C1[r+3]);} \
      float rm=__builtin_fmaxf(a,b); { auto rr=__builtin_amdgcn_permlane32_swap(__float_as_uint(rm),__float_as_uint(rm),false,false); rm=__builtin_fmaxf(__uint_as_float(rr[0]),__uint_as_float(rr[1])); } \
      rm-=mhat; \
      resc=false; \
      if(__builtin_expect(__any(rm>(float)THRL),0)){ const float dl=__builtin_fmaxf(rm,0.f); mhat+=dl; \
        const float f=__builtin_amdgcn_exp2f(-dl); l_reg*=f; if(hi==0)wsf[r32]=f; resc=true; } \
      _Pragma("unroll") for(int r=0;r<16;++r){C0[r]-=mhat;C1[r]-=mhat;} } \
    SBAR(); \
    VRD(8);  SBAR(); GAPB(PVM(0,0),C0,0); \
    VRD(9);  SBAR(); GAPB(PVM(1,0),C0,2); \
    VRD(10); SBAR(); GAPB(PVM(2,0),C0,4); \
    VRD(11); SBAR(); GAPB(PVM(3,0),C0,6); \
    VRD(12); SBAR(); GAPB(PVM(4,1),C0,8); \
    VRD(13); SBAR(); GAPB(PVM(5,1),C0,10); \
    VRD(14); SBAR(); GAPB(PVM(6,1),C0,12); \
    VRD(15); SBAR(); GAPB(PVM(7,1),C0,14); \
    KRD(GL,0); GAPB(PVM(8,2),C1,0); \
    KRD(GL,1); GAPB(PVM(9,2),C1,2); \
    KRD(GL,2); GAPB(PVM(10,2),C1,4); \
    KRD(GL,3); GAPB(PVM(11,2),C1,6); \
    GAPB(PVM(12,3),C1,8); \
    GAPB(PVM(13,3),C1,10); \
    GAPB(PVM(14,3),C1,12); \
    GAPB(PVM(15,3),C1,14); \
    }while(0)
  int t=1;
  for(;t+5<NT;t+=2){
    STEP(pB0,pB1,pA0,pA1,t,true,true,true);     WAIT_BAR(3); RESC(); ROT();
    STEP(pA0,pA1,pB0,pB1,t+1,true,true,true);   WAIT_BAR(3); RESC(); ROT();
  }
  #define ENDW(tt) do{ if((tt)+3<NT){WAIT_BAR(3);} else if((tt)+2<NT){WAIT_BAR(2);} else {WAIT_BAR(0);} }while(0)
  for(;t+1<NT;t+=2){
    STEP(pB0,pB1,pA0,pA1,t,(t+3<NT),(t+1<NT),(t+1<NT));       ENDW(t);   RESC(); ROT();
    STEP(pA0,pA1,pB0,pB1,t+1,(t+4<NT),(t+2<NT),(t+2<NT));     ENDW(t+1); RESC(); ROT();
  }
  STEP(pB0,pB1,pA0,pA1,NT-1,false,false,false); RESC();
  { float sacc=pB0[0]+pB0[1]; _Pragma("unroll") for(int r=2;r<16;++r)sacc+=pB0[r]; _Pragma("unroll") for(int r=0;r<16;++r)sacc+=pB1[r]; l_reg+=sacc;
    pw0=(u32x4){PKW(pB0,0),PKW(pB0,2),PKW(pB0,4),PKW(pB0,6)};pw1=(u32x4){PKW(pB0,8),PKW(pB0,10),PKW(pB0,12),PKW(pB0,14)};pw2=(u32x4){PKW(pB1,0),PKW(pB1,2),PKW(pB1,4),PKW(pB1,6)};pw3=(u32x4){PKW(pB1,8),PKW(pB1,10),PKW(pB1,12),PKW(pB1,14)};
    SBAR(); pv4(o,vb0+2*sl_cur,PAF(0),PAF(1),PAF(2),PAF(3)); }
  #undef PKW
  #undef PAF
  #undef VFR
  #undef MX3
  #undef GAPA
  #undef GAPB
  #undef EX
  #undef VRD
  #undef KRD
  #undef PVM
  #undef STEP
  #undef ENDW
  {auto rr=__builtin_amdgcn_permlane32_swap(__float_as_uint(l_reg),__float_as_uint(l_reg),false,false);l_reg=__uint_as_float(rr[0])+__uint_as_float(rr[1]);}
  if(hi==0)wsf[32+r32]=l_reg;asm volatile("s_waitcnt lgkmcnt(0)":::"memory");
  typedef unsigned u32x2v __attribute__((ext_vector_type(2)));
  u32x2v*sp=(u32x2v*)(shm+LDS_O1+wid*8192)+lane;
  if(!second){
    #pragma unroll
    for(int r=0;r<16;++r){ const float rl=__builtin_amdgcn_rcpf(wsf[32+crow(r,hi)]); const u32x2v v={cvtpk_s(o[0][r]*rl,o[1][r]*rl),cvtpk_s(o[2][r]*rl,o[3][r]*rl)}; sp[r*64]=v; }
  } else {
    float g4[4];
    #pragma unroll
    for(int d0=0;d0<4;++d0)g4[d0]=subg[d0*32+r32]*post;
    #pragma unroll
    for(int r=0;r<16;++r){ const float rl=__builtin_amdgcn_rcpf(wsf[32+crow(r,hi)])*lam; const u32x2v av=sp[r*64];
      const float a0=__uint_as_float(av[0]<<16),a1=__uint_as_float(av[0]&0xffff0000u),a2=__uint_as_float(av[1]<<16),a3=__uint_as_float(av[1]&0xffff0000u);
      float v0=a0-o[0][r]*rl,v1=a1-o[1][r]*rl,v2=a2-o[2][r]*rl,v3=a3-o[3][r]*rl; float ss=(v0*v0+v1*v1)+(v2*v2+v3*v3);
      ss+=__shfl_xor(ss,1);ss+=__shfl_xor(ss,2);ss+=__shfl_xor(ss,4);ss+=__shfl_xor(ss,8);ss+=__shfl_xor(ss,16);
      const float rn=__builtin_amdgcn_rsqf(ss*(1.0f/128.0f)+1e-6f);
      o[0][r]=v0*rn*g4[0];o[1][r]=v1*rn*g4[1];o[2][r]=v2*rn*g4[2];o[3][r]=v3*rn*g4[3]; }
    bf16*Ow=Ou+(long)(wid*QBLK)*op;
    bf16*stg=(bf16*)(shm+LDS_O1+wid*8192);
    asm volatile("s_waitcnt lgkmcnt(0)":::"memory");
    #pragma unroll
    for(int r=0;r<16;++r){const int orow=crow(r,hi);
      #pragma unroll
      for(int d0=0;d0<4;++d0)stg[orow*128+d0*32+r32]=__float2bfloat16(o[d0][r]);}
    asm volatile("s_waitcnt lgkmcnt(0)":::"memory");
    #pragma unroll
    for(int i=0;i<8;++i){const int row=i*4+(lane>>4),ch=lane&15; const u32x4 v=*(const u32x4*)(stg+row*128+ch*8); ATTN_STORE16(Ow+(long)row*op+ch*8,v);}
  }
  asm volatile("s_waitcnt lgkmcnt(0)\n\ts_barrier":::"memory");
  #undef PIN
  #undef DMA_K
  #undef DMA_V
  #undef START
  #undef RESC
  #undef ROT
}
#undef SBAR
#undef WAIT_BAR
}

typedef unsigned short bf16;
typedef float f32x4 __attribute__((ext_vector_type(4)));
typedef unsigned u32x4 __attribute__((ext_vector_type(4)));
typedef unsigned u32x2 __attribute__((ext_vector_type(2)));
constexpr int D = 1024, NBATCH = 4, SEQ = 4096, CTXL = 256, DEPTH = 2;
constexpr int MLAT = NBATCH * SEQ, MCTX = NBATCH * CTXL, MTOT = MLAT + MCTX;
constexpr int KVR = SEQ + CTXL;
constexpr int NIN = 6144, NE = 32, TOPK = 4, NWAVES = 8;
constexpr int MAXTILES = 304;
constexpr float EPS = 1e-6f;

constexpr size_t al256(size_t x) { return (x + 255) / 256 * 256; }
constexpr size_t WS_CTL = 0, CTL_BYTES = 1u << 20;
constexpr size_t WS_MOD = WS_CTL + CTL_BYTES;
constexpr size_t WS_ROPEC = WS_MOD + al256((size_t)DEPTH * 5 * NIN * 4);
constexpr size_t WS_ROPES = WS_ROPEC + 4096;
constexpr size_t WS_LAM = WS_ROPES + 4096;
constexpr size_t WS_PV = WS_LAM + 256;
constexpr size_t WS_WIN = WS_PV + (size_t)DEPTH * 5 * 4 * D * 4;
constexpr size_t WS_WB = WS_WIN + (size_t)DEPTH * NIN * D * 2;
constexpr size_t WS_WO = WS_WB + (size_t)DEPTH * 3 * D * 512 * 2;
constexpr size_t WS_W1 = WS_WO + (size_t)DEPTH * D * D * 2;
constexpr size_t WS_W2 = WS_W1 + (size_t)DEPTH * NE * 2048 * D * 2;
constexpr size_t WS_X = WS_W2 + (size_t)DEPTH * NE * D * D * 2;
constexpr size_t WS_H = WS_X + (size_t)MTOT * D * 4;
constexpr size_t WS_QA = WS_H + (size_t)MTOT * D * 2;
constexpr size_t WS_QB = WS_QA + (size_t)MTOT * 512 * 2;
constexpr size_t WS_QC = WS_QB + (size_t)MTOT * 512 * 2;
constexpr size_t WS_KA = WS_QC + (size_t)MTOT * 512 * 2;
constexpr size_t WS_VA = WS_KA + (size_t)NBATCH * KVR * 512 * 2;
constexpr size_t WS_KB = WS_VA + (size_t)NBATCH * KVR * 512 * 2;
constexpr size_t WS_VB = WS_KB + (size_t)NBATCH * KVR * 128 * 2;
constexpr size_t WS_KC = WS_VB + (size_t)NBATCH * KVR * 128 * 2;
constexpr size_t WS_VC = WS_KC + (size_t)NBATCH * KVR * 128 * 2;
constexpr size_t WS_GT = WS_VC + (size_t)NBATCH * KVR * 128 * 2;
constexpr size_t WS_YS = WS_GT + (size_t)MTOT * 3072 * 2;
constexpr size_t WS_TMP = WS_YS + (size_t)3 * MTOT * 512 * 2;
constexpr size_t WS_MG = WS_TMP + (size_t)MTOT * D * 4;
constexpr size_t WS_Y = WS_MG + (size_t)MTOT * D * 2;
constexpr size_t WS_H2 = WS_Y + (size_t)MTOT * D * 4;
constexpr size_t WS_SE = WS_H2 + (size_t)MTOT * D * 2;
constexpr size_t WS_SR = WS_SE + (size_t)MTOT * 4 * 4;
constexpr size_t WS_SW = WS_SR + (size_t)MTOT * 4 * 4;
constexpr size_t WS_LIST = WS_SW + (size_t)MTOT * 4 * 4;
constexpr size_t WS_ACT = WS_LIST + (size_t)NE * MTOT * 4;
constexpr size_t WS_YS2 = WS_ACT + (size_t)MAXTILES * 256 * D * 2;
constexpr size_t WS_EX = WS_YS2 + (size_t)MAXTILES * 256 * D * 2;
constexpr size_t WS_END = WS_EX + (size_t)DEPTH * 256 * 131072;
static_assert(WS_WIN % 256 == 0 && WS_X % 256 == 0 && WS_SE % 256 == 0 && WS_ACT % 256 == 0, "alignment");

constexpr int CW_BAR = 4096;
constexpr int CW_Q = 16384;
constexpr int CW_CNT = 8192;

constexpr int RING_BYTES = 141312, MISC_OFF = RING_BYTES, LDS_BYTES = MISC_OFF + 8192;
constexpr int MW_Q = 12; constexpr int MW_BAR = 0, MW_TB = 16, MW_CNT = 64, MW_HIST = 128, MW_BASE = 160, MW_PT = 192, MW_SLOT = 256;

#define LDS_WAIT() asm volatile("s_waitcnt lgkmcnt(0)" ::: "memory")
#define VM_WAIT() asm volatile("s_waitcnt vmcnt(0)" ::: "memory")
__device__ __forceinline__ unsigned f2bf(float f) { unsigned u = __builtin_bit_cast(unsigned, f); return (u + 0x7fffu + ((u >> 16) & 1u)) >> 16; }
typedef float f32x2_t __attribute__((ext_vector_type(2))); typedef __bf16 bf16x2_t __attribute__((ext_vector_type(2)));
__device__ __forceinline__ unsigned pk2(float lo, float hi) { const f32x2_t v = {lo, hi}; const bf16x2_t b = __builtin_convertvector(v, bf16x2_t); return __builtin_bit_cast(unsigned, b); }
__device__ __forceinline__ unsigned pk4f8(float a, float b, float c, float d) {
    int r = __builtin_amdgcn_cvt_pk_fp8_f32(a, b, 0, false); r = __builtin_amdgcn_cvt_pk_fp8_f32(c, d, r, true); return (unsigned)r; }
constexpr float W8_SCALE = 64.0f, W8_INV = 1.0f / 64.0f;
__device__ __forceinline__ float bflo(unsigned w) { return __builtin_bit_cast(float, w << 16); }
__device__ __forceinline__ float bfhi(unsigned w) { return __builtin_bit_cast(float, w & 0xffff0000u); }
template <int CTRL> __device__ __forceinline__ float dppf(float v) { return __builtin_bit_cast(float, __builtin_amdgcn_update_dpp(0, __builtin_bit_cast(int, v), CTRL, 0xf, 0xf, true)); }
template <int CTRL> __device__ __forceinline__ int dppi(int v) { return __builtin_amdgcn_update_dpp(0, v, CTRL, 0xf, 0xf, true); }
__device__ __forceinline__ float rdl(float v, int l) { return __builtin_bit_cast(float, __builtin_amdgcn_readlane(__builtin_bit_cast(int, v), l)); }
__device__ __forceinline__ float wave_sum(float v) {
    v += dppf<0xB1>(v); v += dppf<0x4E>(v); v += dppf<0x141>(v); v += dppf<0x140>(v);
    return (rdl(v, 0) + rdl(v, 16)) + (rdl(v, 32) + rdl(v, 48));
}
__device__ __forceinline__ float sigmoid255_(float x) { return __builtin_amdgcn_rcpf(__builtin_fmaf(__builtin_amdgcn_exp2f(-1.4426950408889634f * x), 1.0f / 255.0f, 1.0f / 255.0f)); }
__device__ __forceinline__ float sigmoidf_(float x) { return __builtin_amdgcn_rcpf(1.0f + __builtin_amdgcn_exp2f(-1.4426950408889634f * x)); }

__device__ __forceinline__ unsigned char* ldp(volatile LAS unsigned* MISC, int i) {
    const unsigned lo = (unsigned)__builtin_amdgcn_readfirstlane((int)MISC[MW_PT + 2 * i]), hi = (unsigned)__builtin_amdgcn_readfirstlane((int)MISC[MW_PT + 2 * i + 1]);
    return (unsigned char*)(((unsigned long long)hi << 32) | lo);
}
typedef const GAS float* gcfp; typedef GAS float* gfp; typedef const GAS unsigned short* gcbp; typedef GAS unsigned short* gbp;
#define INP(i) ((const GAS float*)ldp(MISC, (i)))
#define WSP(T, off) ((GAS T*)(ldp(MISC, 21) + (off)))
#define XB_TMO      128
#define XB_XCNT(j)  (256  + 64 * (j))
#define XB_XSUB(j)  (1280 + 64 * (j))
#define XB_XGEN(j)  (2304 + 64 * (j))
#define XB_TOP      3328
#define XB_TOPGEN   3392
#define XCD_BAR_WORDS 3456
#define XB_SPIN_CAP (1u << 18)

__device__ __forceinline__ unsigned xb_ld(unsigned* p)              { return __hip_atomic_load(p, __ATOMIC_RELAXED, __HIP_MEMORY_SCOPE_AGENT); }
__device__ __forceinline__ unsigned xb_add(unsigned* p, unsigned v) { return __hip_atomic_fetch_add(p, v, __ATOMIC_RELAXED, __HIP_MEMORY_SCOPE_AGENT); }
__device__ __forceinline__ unsigned xb_xcc_id() { return (unsigned)__builtin_amdgcn_s_getreg((3 << 11) | 20) & 0xFu; }
#define XB_SPIN(cond, bar) do { unsigned _sp = 0; while (cond) { __builtin_amdgcn_s_sleep(1); \
    if ((++_sp & 255u) == 0u) { if (xb_ld(&(bar)[XB_TMO])) break; if (_sp > XB_SPIN_CAP) { atomicAdd(&(bar)[XB_TMO], 1u); break; } } } } while (0)

struct XcdBarrier {
    unsigned* bar; unsigned x;
    volatile LAS unsigned* st;
};

__device__ __forceinline__ XcdBarrier xcd_barrier_post(unsigned* bar, volatile LAS unsigned* st) {
    XcdBarrier b; b.bar = bar; b.x = xb_xcc_id(); b.st = st;
    if (threadIdx.x == 0) (void)xb_add(&bar[XB_XCNT(b.x)], 1u);
    return b;
}
__device__ __forceinline__ void xcd_barrier_complete(unsigned* bar, unsigned x, unsigned& nloc, unsigned& nx) {
    const unsigned G = gridDim.x * gridDim.y * gridDim.z;
    unsigned sum, cnt, mine, sp = 0u;
    for (;;) {
        sum = 0u; cnt = 0u; mine = 0u;
#pragma unroll
        for (unsigned j = 0; j < 16; ++j) { const unsigned c = xb_ld(&bar[XB_XCNT(j)]); sum += c; cnt += (c > 0u) ? 1u : 0u; mine = (j == x) ? c : mine; }
        if (sum == G) break;
        __builtin_amdgcn_s_sleep(1);
        if ((++sp & 255u) == 0u) { if (xb_ld(&bar[XB_TMO])) break; if (sp > XB_SPIN_CAP) { atomicAdd(&bar[XB_TMO], 1u); break; } }
    }
    nloc = mine > 0u ? mine : 1u; nx = cnt > 0u ? cnt : 1u;
}

__device__ __forceinline__ void xcd_barrier(const XcdBarrier& b, const int tid_now) {
    asm volatile("s_waitcnt vmcnt(0)" ::: "memory");
    __syncthreads();
    if (tid_now == 0) {
        unsigned long long bp_ = (unsigned long long)b.bar; asm volatile("" : "+s"(bp_)); unsigned* bar = (unsigned*)bp_;
        unsigned bx_ = b.x; asm volatile("" : "+s"(bx_));
        __builtin_amdgcn_s_waitcnt(0);
        unsigned nloc = b.st[0], nx = b.st[1];
        if (nloc == 0u) { xcd_barrier_complete(bar, bx_, nloc, nx); b.st[0] = nloc; b.st[1] = nx; }
        const unsigned old = xb_add(&bar[XB_XSUB(bx_)], 1u);
        const unsigned gen = old / nloc;
        if (old + 1u == (gen + 1u) * nloc) {
            __builtin_amdgcn_fence(__ATOMIC_RELEASE, "agent");
            asm volatile("s_waitcnt vmcnt(0)" ::: "memory");
            const unsigned og = xb_add(&bar[XB_TOP], 1u);
            const unsigned tg = og / nx;
            if (og + 1u == (tg + 1u) * nx) xb_add(&bar[XB_TOPGEN], 1u);
            else XB_SPIN(xb_ld(&bar[XB_TOPGEN]) == tg, bar);
            __builtin_amdgcn_fence(__ATOMIC_ACQUIRE, "agent");
            xb_add(&bar[XB_XGEN(bx_)], 1u);
            asm volatile("s_waitcnt vmcnt(0)" ::: "memory");
        } else {
            XB_SPIN(xb_ld(&bar[XB_XGEN(bx_)]) == gen, bar);
            __builtin_amdgcn_fence(__ATOMIC_ACQUIRE, "agent");
            asm volatile("s_waitcnt vmcnt(0)" ::: "memory");
        }
    }
    __syncthreads();
}

using pg8::Unit;
__host__ __device__ __forceinline__ int in_src_col(int nbd) {
    const int pn = nbd >> 3, blk = nbd & 7, bj = blk >> 2, wc = blk & 3;
    if (pn <= 8) { const int hs = pn * 4 + wc; int base;
        if (hs < 8) base = hs * 64; else if (hs < 16) base = 512 + (hs - 8) * 64; else if (hs < 24) base = 1536 + (hs - 16) * 64;
        else if (hs < 32) base = 2304 + (hs - 24) * 64; else if (hs < 34) base = 2048 + (hs - 32) * 64; else base = 2816 + (hs - 34) * 64;
        return base + 32 * bj; }
    if (pn <= 10) return 1024 + (pn - 9) * 256 + blk * 32;
    if (pn == 11) return blk < 4 ? 2176 + blk * 32 : 2944 + (blk - 4) * 32;
    return 3072 + (pn - 12) * 256 + blk * 32;
}
struct EpiInproj {
    static constexpr bool PERM = false;
    volatile LAS unsigned* MISC; int l;
    __device__ __forceinline__ void operator()(const f32x4 (&acc)[2][2][4][2], const Unit& u, int wr, int wc, int fr, int fq) const {
        auto QA = WSP(bf16, WS_QA); auto QB = WSP(bf16, WS_QB); auto QC = WSP(bf16, WS_QC); auto KA = WSP(bf16, WS_KA); auto VA = WSP(bf16, WS_VA);
        auto KB = WSP(bf16, WS_KB); auto VB = WSP(bf16, WS_VB); auto KC = WSP(bf16, WS_KC); auto VC = WSP(bf16, WS_VC); auto GT = WSP(bf16, WS_GT);
        auto ropec = WSP(float, WS_ROPEC); auto ropes = WSP(float, WS_ROPES); auto qkg = INP(10) + l * 128;
        const int pn = u.pn; const bool ctx = u.pm >= (MLAT / 256);
#pragma unroll
        for (int ai = 0; ai < 2; ++ai)
#pragma unroll
            for (int m = 0; m < 4; ++m) {
                const int r = u.pm * 256 + ai * 128 + wr * 64 + m * 16 + fr;
                int kvrow, t = 0;
                if (!ctx) { t = r & (SEQ - 1); kvrow = (r >> 12) * KVR + t; } else { const int rr = r - MLAT; kvrow = (rr >> 8) * KVR + SEQ + (rr & 255); }
                if (pn <= 8) {
                    float v[2][2][4];
#pragma unroll
                    for (int bj = 0; bj < 2; ++bj)
#pragma unroll
                        for (int n = 0; n < 2; ++n)
#pragma unroll
                            for (int j = 0; j < 4; ++j) v[bj][n][j] = acc[ai][bj][m][n][j];
                    const int hs = pn * 4 + wc;
                    const bool isbq = (pn == 4 || pn == 5), isbk = (pn == 8 && wc < 2);
                    if (isbq || isbk) {
                        float ss = 0.f;
#pragma unroll
                        for (int bj = 0; bj < 2; ++bj)
#pragma unroll
                            for (int n = 0; n < 2; ++n)
#pragma unroll
                                for (int j = 0; j < 4; ++j) ss += v[bj][n][j] * v[bj][n][j];
                        ss += __shfl_xor(ss, 16); ss += __shfl_xor(ss, 32);
                        const float rn = __builtin_amdgcn_rsqf(ss * (1.0f / 64.0f) + EPS);
                        gcfp g = qkg + (isbk ? 64 : 0);
#pragma unroll
                        for (int bj = 0; bj < 2; ++bj)
#pragma unroll
                            for (int n = 0; n < 2; ++n) { const f32x4 gv = *(const GAS f32x4*)(g + 32 * bj + 16 * n + 4 * fq);
#pragma unroll
                                for (int j = 0; j < 4; ++j) v[bj][n][j] = v[bj][n][j] * rn * gv[j]; }
                    }
                    if (!ctx) {
#pragma unroll
                        for (int bj = 0; bj < 2; ++bj) { const int pos = bj ? (t & 63) : (t >> 6);
                            const f32x4 cs = *(const GAS f32x4*)(ropec + pos * 16 + 4 * fq), sn = *(const GAS f32x4*)(ropes + pos * 16 + 4 * fq);
#pragma unroll
                            for (int j = 0; j < 4; ++j) { const float x0 = v[bj][0][j], x1 = v[bj][1][j];
                                v[bj][0][j] = x0 * cs[j] - x1 * sn[j]; v[bj][1][j] = x1 * cs[j] + x0 * sn[j]; } }
                    }
                    if (isbq || pn == 6 || pn == 7 || (pn < 2 && !ctx)) {
#pragma unroll
                        for (int bj = 0; bj < 2; ++bj)
#pragma unroll
                            for (int n = 0; n < 2; ++n)
#pragma unroll
                                for (int j = 0; j < 4; ++j) v[bj][n][j] *= att64::C2; }
                    gbp dst;
                    if (pn < 2) dst = QA + (size_t)r * 512 + hs * 64;
                    else if (pn < 4) dst = KA + (size_t)kvrow * 512 + (hs - 8) * 64;
                    else if (pn < 6) dst = QB + (size_t)r * 512 + (hs - 16) * 64;
                    else if (pn < 8) dst = QC + (size_t)r * 512 + (hs - 24) * 64;
                    else if (wc < 2) dst = KB + (size_t)kvrow * 128 + wc * 64;
                    else dst = KC + (size_t)kvrow * 128 + (wc - 2) * 64;
#pragma unroll
                    for (int bj = 0; bj < 2; ++bj) { u32x4 w; w.x = pk2(v[bj][0][0], v[bj][0][1]); w.y = pk2(v[bj][0][2], v[bj][0][3]); w.z = pk2(v[bj][1][0], v[bj][1][1]); w.w = pk2(v[bj][1][2], v[bj][1][3]);
                        *(GAS u32x4*)(dst + 32 * bj + 8 * fq) = w; }
                } else if (pn <= 11) {
#pragma unroll
                    for (int bj = 0; bj < 2; ++bj) { const int c = 128 * bj + 32 * wc + 8 * fq; const f32x4 x = acc[ai][bj][m][0], y = acc[ai][bj][m][1];
                            gbp dst = (pn < 11) ? VA + (size_t)kvrow * 512 + (pn - 9) * 256 + c : ((bj == 0) ? VB : VC) + (size_t)kvrow * 128 + (c & 127);
                            u32x4 w; w.x = pk2(x[0], x[1]); w.y = pk2(x[2], x[3]); w.z = pk2(y[0], y[1]); w.w = pk2(y[2], y[3]); *(GAS u32x4*)dst = w; }
                } else {
#pragma unroll
                    for (int bj = 0; bj < 2; ++bj) { const int c = 128 * bj + 32 * wc + 8 * fq; const f32x4 x = acc[ai][bj][m][0], y = acc[ai][bj][m][1];
                            u32x2 w = {0u, 0u};
#pragma unroll
                            for (int j = 0; j < 4; ++j) { w.x = __builtin_amdgcn_cvt_pk_u8_f32(sigmoid255_(x[j]), (unsigned)j, w.x); w.y = __builtin_amdgcn_cvt_pk_u8_f32(sigmoid255_(y[j]), (unsigned)j, w.y); }
                            *(GAS u32x2*)((GAS unsigned char*)GT + (size_t)r * 3072 + (pn - 12) * 256 + c) = w; }
                }
            }
    }
};

#if defined(EPIDUP_INPROJ)
namespace pg8 { template <> struct epi_dup<::EpiInproj> { static constexpr int v = 1; }; }
#endif
struct MergeOrder {
    int ntiles, G, vcu;
    __device__ __forceinline__ bool next(int i, Unit& u) const { const int rnd = i / 3, sub = i - rnd * 3; const int tl = rnd * G + vcu; if (tl >= ntiles) return false;
        u.pm = sub * (MTOT / 256) + (tl >> 2); u.pn = sub * 4 + (tl & 3); return true; }
    __device__ __forceinline__ unsigned a_row(const Unit&, int) const { return 0u; }
};
struct EpiMerge {
    static constexpr bool PERM = true;
    volatile LAS unsigned* MISC;
    __device__ __forceinline__ bool keep(const Unit& u) const { return (u.pn >> 2) < 2; }
    __device__ __forceinline__ void operator()(f32x4 (&acc)[2][2][4][2], const Unit& u, int wr, int wc, int fr, int fq) const {
        const auto GT = WSP(bf16, WS_GT); auto MG = WSP(bf16, WS_MG);
        const int sub = u.pn >> 2, pnr = u.pn & 3, pmr = u.pm - sub * (MTOT / 256);
        constexpr float GMIN = 1e-24f;
#pragma unroll
        for (int ai = 0; ai < 2; ++ai)
#pragma unroll
            for (int m = 0; m < 4; ++m) { const size_t row = (size_t)pmr * 256 + ai * 128 + wr * 64 + m * 16 + fr;
#pragma unroll
                for (int bj = 0; bj < 2; ++bj) { const int col = pnr * 256 + bj * 128 + wc * 32 + 8 * fq;
                    const u32x2 gw = *(const GAS u32x2*)((const GAS unsigned char*)GT + row * 3072 + sub * 1024 + col);
                    float g[8] = {(float)(gw.x & 0xffu), (float)((gw.x >> 8) & 0xffu), (float)((gw.x >> 16) & 0xffu), (float)(gw.x >> 24), (float)(gw.y & 0xffu), (float)((gw.y >> 8) & 0xffu), (float)((gw.y >> 16) & 0xffu), (float)(gw.y >> 24)};
                    if (sub > 0) {
#pragma unroll
                        for (int k = 0; k < 8; ++k) g[k] = fmaxf(g[k], GMIN); }
                    if (sub < 2) {
                        const u32x2 gn = *(const GAS u32x2*)((const GAS unsigned char*)GT + row * 3072 + (sub + 1) * 1024 + col);
                        const float d[8] = {(float)(gn.x & 0xffu), (float)((gn.x >> 8) & 0xffu), (float)((gn.x >> 16) & 0xffu), (float)(gn.x >> 24), (float)(gn.y & 0xffu), (float)((gn.y >> 8) & 0xffu), (float)((gn.y >> 16) & 0xffu), (float)(gn.y >> 24)};
#pragma unroll
                        for (int k = 0; k < 8; ++k) g[k] *= __builtin_amdgcn_rcpf(fmaxf(d[k], GMIN));
                    }
                    f32x4 v0 = acc[ai][bj][m][0], v1 = acc[ai][bj][m][1];
                    v0[0] *= g[0]; v0[1] *= g[1]; v0[2] *= g[2]; v0[3] *= g[3]; v1[0] *= g[4]; v1[1] *= g[5]; v1[2] *= g[6]; v1[3] *= g[7];
                    if (sub < 2) { acc[ai][bj][m][0] = v0; acc[ai][bj][m][1] = v1; }
                    else { v0 *= (1.0f / 255.0f); v1 *= (1.0f / 255.0f); u32x4 w; w.x = pk2(v0[0], v0[1]); w.y = pk2(v0[2], v0[3]); w.z = pk2(v1[0], v1[1]); w.w = pk2(v1[2], v1[3]); *(GAS u32x4*)(MG + row * 1024 + col) = w; } } }
    }
};
namespace pg8 { template <> struct epi_chain<::EpiMerge> { static constexpr bool v = true; }; }
struct EpiOut {
    static constexpr bool PERM = true;
    volatile LAS unsigned* MISC;
    __device__ __forceinline__ void operator()(const f32x4 (&acc)[2][2][4][2], const Unit& u, int wr, int wc, int fr, int fq) const {
        auto Y = WSP(bf16, WS_Y);
#pragma unroll
        for (int ai = 0; ai < 2; ++ai)
#pragma unroll
            for (int m = 0; m < 4; ++m) { gbp rowp = Y + ((size_t)u.pm * 256 + ai * 128 + wr * 64 + m * 16 + fr) * 1024 + u.pn * 256 + wc * 32 + 8 * fq;
#pragma unroll
                for (int bj = 0; bj < 2; ++bj) { const f32x4 v0 = acc[ai][bj][m][0], v1 = acc[ai][bj][m][1];
                    u32x4 w; w.x = pk2(v0[0], v0[1]); w.y = pk2(v0[2], v0[3]); w.z = pk2(v1[0], v1[1]); w.w = pk2(v1[2], v1[3]); *(GAS u32x4*)(rowp + bj * 128) = w; } }
    }
};
template <int NP> struct MoeOrder {
    const LAS int* tb; const LAS int* cn; const GAS int* list; int G, bid, vcu, U, chunk, per;
    __device__ __forceinline__ void init(const LAS int* tb_, const LAS int* cn_, const GAS int* list_, int G_, int bid_) {
        tb = tb_; cn = cn_; list = list_; G = G_; bid = bid_; U = tb_[NE] * NP;
        if (G_ % 8 == 0) { per = G_ / 8; vcu = (bid_ % 8) * per + bid_ / 8; chunk = (U + 7) / 8; } else { per = G_; vcu = bid_; chunk = U; }
    }
    __device__ __forceinline__ bool next(int i, Unit& u) const {
        const int x = vcu / per, j = i * per + (vcu % per); if (j >= chunk) return false;
        const int id = x * chunk + j; if (id >= U) return false;
        const int T = id / NP, pnl = id - T * NP; int e = 0;
#pragma unroll
        for (int q = 1; q < NE; ++q) e += (T >= tb[q]) ? 1 : 0;
        e = __builtin_amdgcn_readfirstlane(e);
        u.pm = T; u.pn = e * NP + pnl; return true;
    }
    __device__ __forceinline__ unsigned a_row(const Unit& u, int r) const {
        const int e = u.pn / NP; int idx = (u.pm - tb[e]) * 256 + r; const int c = cn[e]; idx = idx < c ? idx : c - 1;
        return (unsigned)list[(size_t)e * MTOT + idx];
    }
};
template <bool F8> struct EpiSwiglu {
    static constexpr bool PERM = true;
    volatile LAS unsigned* MISC; int l;
    __device__ __forceinline__ void operator()(const f32x4 (&acc)[2][2][4][2], const Unit& u, int wr, int wc, int fr, int fq) const {
        auto ACT = WSP(bf16, WS_ACT); auto b1 = INP(17) + (size_t)l * NE * 2048;
        const int e = u.pn >> 3, pnl = u.pn & 7; const int col = pnl * 128 + wc * 32 + 8 * fq;
        gcfp bg = b1 + (size_t)e * 2048 + col; gcfp bu = bg + 1024;
        const f32x4 bg0 = *(const GAS f32x4*)bg, bg1 = *(const GAS f32x4*)(bg + 4), bu0 = *(const GAS f32x4*)bu, bu1 = *(const GAS f32x4*)(bu + 4);
#pragma unroll
        for (int ai = 0; ai < 2; ++ai)
#pragma unroll
            for (int m = 0; m < 4; ++m) { const size_t row = (size_t)u.pm * 256 + ai * 128 + wr * 64 + m * 16 + fr;
                float a[8];
#pragma unroll
                for (int n = 0; n < 2; ++n)
#pragma unroll
                    for (int j = 0; j < 4; ++j) { constexpr float SC = F8 ? W8_INV : 1.0f; float gt = acc[ai][0][m][n][j] * SC + (n ? bg1[j] : bg0[j]), up = acc[ai][1][m][n][j] * SC + (n ? bu1[j] : bu0[j]);
                        gt = fminf(gt, 7.0f); up = fminf(fmaxf(up, -7.0f), 7.0f);
                        a[n * 4 + j] = (up + 1.0f) * (gt * sigmoidf_(1.702f * gt)); }
                if constexpr (F8) { u32x2 w; w.x = pk4f8(a[0], a[1], a[2], a[3]); w.y = pk4f8(a[4], a[5], a[6], a[7]); *(GAS u32x2*)((GAS unsigned char*)ACT + row * 1024 + col) = w; }
                else { u32x4 w; w.x = pk2(a[0], a[1]); w.y = pk2(a[2], a[3]); w.z = pk2(a[4], a[5]); w.w = pk2(a[6], a[7]);
                *(GAS u32x4*)(ACT + row * 1024 + col) = w; } }
    }
};
#if defined(EPIDUP_MOE1)
namespace pg8 { template <> struct epi_dup<::EpiSwiglu<true>> { static constexpr int v = 1; }; }
#endif
template <bool F8> struct EpiMoe2 {
    static constexpr bool PERM = true;
    volatile LAS unsigned* MISC; int l;
    __device__ __forceinline__ void operator()(const f32x4 (&acc)[2][2][4][2], const Unit& u, int wr, int wc, int fr, int fq) const {
        auto YS2 = WSP(bf16, WS_YS2); auto b2 = INP(19) + (size_t)l * NE * D;
        const int e = u.pn >> 2, pnl = u.pn & 3;
#pragma unroll
        for (int bj = 0; bj < 2; ++bj) { const int col = pnl * 256 + bj * 128 + wc * 32 + 8 * fq;
            const f32x4 c0 = *(const GAS f32x4*)(b2 + (size_t)e * 1024 + col), c1 = *(const GAS f32x4*)(b2 + (size_t)e * 1024 + col + 4);
#pragma unroll
            for (int ai = 0; ai < 2; ++ai)
#pragma unroll
                for (int m = 0; m < 4; ++m) { const size_t row = (size_t)u.pm * 256 + ai * 128 + wr * 64 + m * 16 + fr;
                    constexpr float SC = F8 ? W8_INV : 1.0f; const f32x4 v0 = acc[ai][bj][m][0] * SC + c0, v1 = acc[ai][bj][m][1] * SC + c1;
                    u32x4 w; w.x = pk2(v0[0], v0[1]); w.y = pk2(v0[2], v0[3]); w.z = pk2(v1[0], v1[1]); w.w = pk2(v1[2], v1[3]);
                    *(GAS u32x4*)(YS2 + row * 1024 + col) = w; } }
    }
};

#if defined(EPIDUP_MOE2)
namespace pg8 { template <> struct epi_dup<::EpiMoe2<true>> { static constexpr int v = 1; }; }
#endif

struct Args { const float* in[20]; float* out; unsigned char* ws; int ph_lo, ph_hi; };

#ifndef MOE_F8_FROM
#define MOE_F8_FROM 0
#endif
__device__ __forceinline__ int sgpr_launder(int x) { asm volatile("" : "+s"(x)); return x; }
struct CvtItem { gcfp W; gbp WT; int N, k0, n0, Kd, rowd, f8; };
__device__ __forceinline__ void cvt_load(const CvtItem& I, int lane, float (&v)[32]) {
    const GAS char* base = (const GAS char*)(I.W + (size_t)I.k0 * I.N + I.n0);
    unsigned off = (unsigned)((lane >> 5) * I.N + (lane & 31)) * 4u; const unsigned step = (unsigned)I.N * 8u;
#pragma unroll
    for (int i = 0; i < 32; ++i) { v[i] = __builtin_nontemporal_load((const GAS float*)(base + off)); off += step; }
}
__device__ __forceinline__ void cvt_store(const CvtItem& I, int lane, const float (&v)[32], LAS float* scr) {
#pragma unroll
    for (int i = 0; i < 32; ++i) { const int kk = 2 * i + (lane >> 5); scr[kk * 33 + (lane & 31)] = v[i]; }
    LDS_WAIT(); asm volatile("" ::: "memory");
    const int c = lane & 7;
#pragma unroll
    for (int j = 0; j < 4; ++j) { const int n = (lane >> 3) + 8 * j; const LAS float* s = scr + (8 * c) * 33 + n;
        if (I.f8 & 1) { u32x2 o; o.x = pk4f8(s[0 * 33] * W8_SCALE, s[1 * 33] * W8_SCALE, s[2 * 33] * W8_SCALE, s[3 * 33] * W8_SCALE); o.y = pk4f8(s[4 * 33] * W8_SCALE, s[5 * 33] * W8_SCALE, s[6 * 33] * W8_SCALE, s[7 * 33] * W8_SCALE);
            __builtin_nontemporal_store(o, (GAS u32x2*)((GAS char*)I.WT + (size_t)I.rowd * I.Kd + I.k0 + (unsigned)(n * I.Kd + 8 * c))); }
        else { u32x4 o; o.x = pk2(s[0 * 33], s[1 * 33]); o.y = pk2(s[2 * 33], s[3 * 33]); o.z = pk2(s[4 * 33], s[5 * 33]); o.w = pk2(s[6 * 33], s[7 * 33]);
        const int nd = (I.f8 & 2) ? 16 * ((n >> 2) & 1) + 4 * (n >> 3) + (n & 3) : n;
        __builtin_nontemporal_store(o, (GAS u32x4*)((GAS char*)(I.WT + (size_t)I.rowd * I.Kd + I.k0) + (unsigned)(nd * I.Kd + 8 * c) * 2u)); } }
    LDS_WAIT(); asm volatile("" ::: "memory");
}

__device__ __forceinline__ void ld_row(gcfp p, int lane, f32x4 (&v)[4]) {
#pragma unroll
    for (int j = 0; j < 4; ++j) v[j] = *(const GAS f32x4*)(p + 4 * lane + 256 * j);
}
__device__ __forceinline__ void ld_row_bf(gcbp p, int lane, f32x4 (&v)[4]) {
#pragma unroll
    for (int j = 0; j < 4; ++j) { const u32x2 w = *(const GAS u32x2*)(p + 4 * lane + 256 * j); v[j] = (f32x4){bflo(w.x), bfhi(w.x), bflo(w.y), bfhi(w.y)}; }
}
__device__ __forceinline__ float sumsq_row(const f32x4 (&v)[4]) {
    float s = 0.f;
#pragma unroll
    for (int j = 0; j < 4; ++j) s += (v[j][0] * v[j][0] + v[j][1] * v[j][1]) + (v[j][2] * v[j][2] + v[j][3] * v[j][3]);
    return wave_sum(s);
}
template <bool F8 = false> __device__ __forceinline__ void norm_mod_row(const f32x4 (&x)[4], gcfp g, gcfp sc, gcfp sh, int lane, f32x4 (&h)[4], gbp dst) {
    const float rn = 1.0f / sqrtf(sumsq_row(x) * (1.0f / D) + EPS);
#pragma unroll
    for (int j = 0; j < 4; ++j) { const int c = 4 * lane + 256 * j; const f32x4 gv = *(const GAS f32x4*)(g + c), sv = *(const GAS f32x4*)(sc + c), hv = *(const GAS f32x4*)(sh + c);
        h[j] = (x[j] * rn) * gv * (1.0f + sv) + hv;
        if constexpr (F8) { *(GAS unsigned*)((GAS unsigned char*)dst + c) = pk4f8(h[j][0], h[j][1], h[j][2], h[j][3]); }
        else { u32x2 w; w.x = pk2(h[j][0], h[j][1]); w.y = pk2(h[j][2], h[j][3]); *(GAS u32x2*)(dst + c) = w; } }
}

constexpr int CVT_I_IN = 16 * 192, CVT_I_WB = 3 * 8 * 32, CVT_I_WO = 16 * 32, CVT_I_W1 = NE * 16 * 64, CVT_I_W2 = NE * 16 * 32, CVT_I_L = CVT_I_IN + CVT_I_WB + CVT_I_WO + CVT_I_W1 + CVT_I_W2;
constexpr int CVT_P0_END = CVT_I_IN + CVT_I_WB + CVT_I_WO, CVT_END = DEPTH * CVT_I_L, CVT_REST = CVT_END - CVT_P0_END;
constexpr int CVT_T1_END = CVT_P0_END + (CVT_REST * 21) / 100, CVT_T3_END = CVT_T1_END + (CVT_REST * 48) / 100;
static_assert(CVT_T3_END >= CVT_I_L, "layer 0's expert weights are converted before its expert GEMMs");
__device__ __forceinline__ void cvt_range(volatile LAS unsigned* MISC, LAS unsigned char* ldsl, int first, int last, int gw, int NGW, int wave, int lane) {
    auto w_in = INP(7); auto w_branch = INP(12); auto w_out = INP(13); auto w1 = INP(16); auto w2 = INP(18);
    auto WIN = WSP(bf16, WS_WIN); auto WB = WSP(bf16, WS_WB); auto WO = WSP(bf16, WS_WO); auto W1 = WSP(bf16, WS_W1); auto W2 = WSP(bf16, WS_W2);
    LAS float* scr = (LAS float*)(ldsl + wave * 16384);
    constexpr int I_IN = CVT_I_IN, I_WB = CVT_I_WB, I_WO = CVT_I_WO, I_W1 = CVT_I_W1, I_W2 = CVT_I_W2, I_L = CVT_I_L;
#define CVT_DECODE(it_, I_) do { const int l_ = (it_) / I_L; int r_ = (it_) - l_ * I_L; \
            if (r_ < I_IN) { const int kb = r_ / 192, nbd = r_ % 192; I_ = CvtItem{w_in + (size_t)l_ * D * NIN, WIN + (size_t)l_ * NIN * D, NIN, 64 * kb, in_src_col(nbd), D, 32 * nbd, (nbd >= 72) ? 2 : 0}; break; } r_ -= I_IN; \
            if (r_ < I_WB) { const int i = r_ / 256, rr = r_ % 256, kb = rr / 32, nb = rr % 32; I_ = CvtItem{w_branch + (size_t)(l_ * 3 + i) * 512 * D, WB + (size_t)(l_ * 3 + i) * D * 512, D, 64 * kb, 32 * nb, 512, 32 * nb, 0}; break; } r_ -= I_WB; \
            if (r_ < I_WO) { const int kb = r_ / 32, nb = r_ % 32; I_ = CvtItem{w_out + (size_t)l_ * D * D, WO + (size_t)l_ * D * D, D, 64 * kb, 32 * nb, D, 32 * nb, 0}; break; } r_ -= I_WO; \
            if (r_ < I_W1) { const int e = r_ / 1024, rr = r_ % 1024, kb = rr / 64, nbd = rr % 64; const int pn = nbd >> 3, blk = nbd & 7, bj = blk >> 2, q = blk & 3; \
                const bool f8_ = (l_ >= MOE_F8_FROM);     \
                I_ = CvtItem{w1 + (size_t)(l_ * NE + e) * D * 2048, f8_ ? (gbp)((GAS char*)(W1 + (size_t)l_ * NE * 2048 * D) + (size_t)e * 2048 * D) : W1 + (size_t)(l_ * NE + e) * 2048 * D, 2048, 64 * kb, bj * 1024 + 128 * pn + 32 * q, D, 32 * nbd, f8_ ? 1 : 0}; break; } r_ -= I_W1; \
            { const int e = r_ / 512, rr = r_ % 512, kb = rr / 32, nb = rr % 32; const bool f8_ = (l_ >= MOE_F8_FROM); \
              I_ = CvtItem{w2 + (size_t)(l_ * NE + e) * D * D, f8_ ? (gbp)((GAS char*)(W2 + (size_t)l_ * NE * D * D) + (size_t)e * D * D) : W2 + (size_t)(l_ * NE + e) * D * D, D, 64 * kb, 32 * nb, D, 32 * nb, f8_ ? 1 : 0}; } } while (0)
        {
            int it = first + gw; CvtItem Iq[4]; float v[4][32];
#define CVT_PRE(k, itx) do { if ((itx) < last) { CVT_DECODE((itx), Iq[k]); cvt_load(Iq[k], lane, v[k]); } } while (0)
#define CVT_STG(k) { CVT_PRE(((k) + 3) & 3, it + 3 * NGW); cvt_store(Iq[k], lane, v[k], scr); it += NGW; if (it >= last) break; }
            CVT_PRE(0, it); CVT_PRE(1, it + NGW); CVT_PRE(2, it + 2 * NGW);
            if (it < last) for (;;) { CVT_STG(0) CVT_STG(1) CVT_STG(2) CVT_STG(3) }
#undef CVT_PRE
#undef CVT_STG
        }
#undef CVT_DECODE
}

#ifndef DISMASK
#define DISMASK 0
#endif
#define EN(k) (((DISMASK >> (k)) & 1) == 0)
#ifndef TOKPROBE
#define TOKPROBE 0
#endif
#ifndef DUPMASK
#ifndef INPROJ_STAGGER
#define INPROJ_STAGGER 2
#endif
#ifndef A128DUP
#define A128DUP 0
#endif
#define DUPMASK 0
#endif
#define REPS(k) ((((DUPMASK) >> (k)) & 1) ? 2 : 1)
__device__ __forceinline__ void ld_prod(gcfp a, gcfp b, int lane, f32x4 (&o)[4]) {
#pragma unroll
    for (int j = 0; j < 4; ++j) o[j] = *(const GAS f32x4*)(a + 4 * lane + 256 * j) * *(const GAS f32x4*)(b + 4 * lane + 256 * j);
}
__device__ __forceinline__ void ld_scale(gcfp g, gcfp sc, int lane, f32x4 (&A)[4]) {
#pragma unroll
    for (int j = 0; j < 4; ++j) A[j] = *(const GAS f32x4*)(g + 4 * lane + 256 * j) * (1.0f + *(const GAS f32x4*)(sc + 4 * lane + 256 * j));
}
template <bool F8 = false> __device__ __forceinline__ void norm_affine_row(const f32x4 (&x)[4], const f32x4 (&A)[4], int lane, f32x4 (&h)[4], gbp dst) {
    const float rn = __builtin_amdgcn_rsqf(sumsq_row(x) * (1.0f / D) + EPS);
#pragma unroll
    for (int j = 0; j < 4; ++j) { const int c = 4 * lane + 256 * j; h[j] = (x[j] * rn) * A[j] + h[j];
        if constexpr (F8) { *(GAS unsigned*)((GAS unsigned char*)dst + c) = pk4f8(h[j][0], h[j][1], h[j][2], h[j][3]); }
        else { u32x2 w; w.x = pk2(h[j][0], h[j][1]); w.y = pk2(h[j][2], h[j][3]); *(GAS u32x2*)(dst + c) = w; } }
}
__global__ void __launch_bounds__(NWAVES * 64, 2) mk_fwd(Args args) {
    extern __shared__ __attribute__((aligned(16))) unsigned char lds[];
    LAS unsigned char* ldsl = (LAS unsigned char*)lds;
    volatile LAS unsigned* MISC = (volatile LAS unsigned*)(ldsl + MISC_OFF);
    const int tid = threadIdx.x; const int wave0 = __builtin_amdgcn_readfirstlane(tid >> 6);
#define TIDNOW() (wave0 * 64 + lane_now())
    const int G = gridDim.x, bid = blockIdx.x;
    const int vcu = (G % 8 == 0) ? (bid % 8) * (G / 8) + bid / 8 : bid;
    const int G0 = G, bid0 = bid, vcu0 = vcu, wave00 = wave0;
#define IDS_NOW const int G = sgpr_launder(G0), bid = sgpr_launder(bid0), vcu = sgpr_launder(vcu0), wave0 = sgpr_launder(wave00); (void)G; (void)bid; (void)vcu; (void)wave0
    unsigned* ctl = (unsigned*)(GAS unsigned*)(args.ws + WS_CTL);
    for (int u = tid; u < (LDS_BYTES - MISC_OFF) / 4; u += NWAVES * 64) MISC[u] = 0u;
    __syncthreads();
    if (tid == 0) {
#pragma unroll
        for (int i = 0; i < 22; ++i) { const unsigned long long pv = i < 20 ? (unsigned long long)args.in[i] : (i == 20 ? (unsigned long long)args.out : (unsigned long long)args.ws);
            MISC[MW_PT + 2 * i] = (unsigned)pv; MISC[MW_PT + 2 * i + 1] = (unsigned)(pv >> 32); }
    }
    __syncthreads();
    XcdBarrier bar = xcd_barrier_post(ctl + CW_BAR, MISC + MW_BAR);
    const int lo = args.ph_lo, hi = args.ph_hi;
#define IN(k) (sgpr_launder(lo) <= (k) && (k) < sgpr_launder(hi))
#define SEAM(k) do { if (IN(k) && IN((k) + 1)) xcd_barrier(bar, TIDNOW()); } while (0)

    const int NGW = G * NWAVES;
#define PHASE_IDS const int lane = lane_now(), tid = wave0 * 64 + lane, wave = wave0, gw = vcu * NWAVES + wave; (void)gw; (void)lane

    for (int rep_ = 0; rep_ < REPS(0); ++rep_) { if (rep_) xcd_barrier(bar, TIDNOW());
    if (IN(0) && EN(0)) {
        IDS_NOW;
        PHASE_IDS;
        auto c_in = INP(1); auto cctx_in = INP(3); auto ada_w = INP(4); auto ada_b = INP(5);
        auto diff_lambda = INP(8);
        auto MOD = WSP(float, WS_MOD); auto ROPEC = WSP(float, WS_ROPEC); auto ROPES = WSP(float, WS_ROPES); auto LAMV = WSP(float, WS_LAM);
        if (bid < 2 * 96) {
            const int l = bid / 96, nb = bid % 96;
            LAS float* sl = (LAS float*)(ldsl + wave * 2560);
            LAS float* part = (LAS float*)(ldsl + 32768);
            for (int idx = lane; idx < 640; idx += 64) { const int r = idx >> 7, kk = idx & 127, k = wave * 128 + kk; const float cv = r < 4 ? c_in[r * D + k] : cctx_in[k]; sl[idx] = cv / (1.0f + __expf(-cv)); }
            LDS_WAIT(); asm volatile("" ::: "memory");
            float a[5];
#pragma unroll
            for (int r = 0; r < 5; ++r) a[r] = 0.f;
            gcfp wp = ada_w + ((size_t)l * D + wave * 128) * NIN + nb * 64 + lane;
#pragma unroll 16
            for (int kk = 0; kk < 128; ++kk) { const float wv = wp[(size_t)kk * NIN];
#pragma unroll
                for (int r = 0; r < 5; ++r) a[r] += wv * sl[r * 128 + kk]; }
#pragma unroll
            for (int r = 0; r < 5; ++r) part[(wave * 5 + r) * 64 + lane] = a[r];
            __syncthreads();
            for (int idx = tid; idx < 320; idx += NWAVES * 64) { const int r = idx >> 6, cc = idx & 63; float s = ada_b[l * NIN + nb * 64 + cc];
#pragma unroll
                for (int w = 0; w < 8; ++w) s += part[(w * 5 + r) * 64 + cc];
                MOD[((size_t)l * 5 + r) * NIN + nb * 64 + cc] = s; }
            __syncthreads();
        }
        if (bid == G - 1) {
            for (int idx = tid; idx < 1024; idx += NWAVES * 64) { const int pos = idx >> 4, p = idx & 15; const float inv = powf(10000.0f, -(float)p / 16.0f); const float ang = (float)pos * inv;
                ROPEC[idx] = cosf(ang); ROPES[idx] = sinf(ang); }
            if (wave < 2) { gcfp lv = diff_lambda + wave * 256;
                const float s1 = wave_sum(lv[lane] * lv[64 + lane]), s2 = wave_sum(lv[128 + lane] * lv[192 + lane]);
                const float lam_init = 0.8f - 0.6f * expf(-0.3f * (float)wave);
                if (lane == 0) LAMV[wave] = expf(s1) - expf(s2) + lam_init; }
        }
        cvt_range(MISC, ldsl, 0, CVT_P0_END, gw, NGW, wave, lane);
    }
    }
    SEAM(0);
    if (IN(1) && EN(1)) {
        IDS_NOW;
        PHASE_IDS;
        auto x_in = INP(0); auto ctx_in = INP(2); auto norm_g = INP(6);
        auto MOD = WSP(float, WS_MOD); auto X = WSP(float, WS_X); auto H = WSP(bf16, WS_H);
        {
            auto PV = WSP(float, WS_PV);
            for (int idx = bid * (NWAVES * 64) + tid; idx < DEPTH * 5 * D; idx += G * NWAVES * 64) { const int l_ = idx / (5 * D), mr_ = (idx / D) % 5, d_ = idx % D;
                gcfp md_ = MOD + ((size_t)l_ * 5 + mr_) * NIN; gcfp ng_ = norm_g + (size_t)l_ * 4 * D; gfp pv_ = PV + ((size_t)l_ * 5 + mr_) * 4 * D;
                pv_[d_] = md_[2 * D + d_] * ng_[D + d_]; pv_[D + d_] = ng_[2 * D + d_] * (1.0f + md_[4 * D + d_]); pv_[2 * D + d_] = md_[5 * D + d_] * ng_[3 * D + d_]; pv_[3 * D + d_] = ng_[d_] * (1.0f + md_[D + d_]); }
        }
        {
            const int RPB = (MTOT + G - 1) / G, r0 = bid * RPB;
            int i = wave; bool have = (i < RPB && r0 + i < MTOT); f32x4 xn[4], A2[4]; int mrc = -1;
#define P1SRC(r_) ((r_) < MLAT ? x_in + (size_t)(r_) * D : ctx_in + (size_t)((r_) - MLAT) * D)
            if (have) ld_row(P1SRC(r0 + i), lane, xn);
            while (have) {
                const int r = r0 + i; f32x4 xv[4], hv[4];
#pragma unroll
                for (int j = 0; j < 4; ++j) xv[j] = xn[j];
                const int inx = i + NWAVES; const bool hn = (inx < RPB && r0 + inx < MTOT);
                if (hn) ld_row(P1SRC(r0 + inx), lane, xn);
                const int mr = r < MLAT ? (r >> 12) : 4;
                gcfp md = MOD + (size_t)mr * NIN; ld_row(md, lane, hv);
                if (mr != mrc) { ld_scale(norm_g, md + 1024, lane, A2); mrc = mr; }
                norm_affine_row(xv, A2, lane, hv, H + (size_t)r * D);
                i = inx; have = hn;
            }
#undef P1SRC
        }
    }
    SEAM(1);

    for (int l = 0; l < DEPTH; ++l) {
        const int pb = 2 + 8 * l; const bool lastl = (l == DEPTH - 1);
        const int ML = lastl ? MLAT : MTOT;
        unsigned* cntg = ctl + CW_CNT + l * 32 * 64;
        for (int rep_ = 0; rep_ < (l == 0 ? REPS(2) : 1); ++rep_) { if (rep_) xcd_barrier(bar, TIDNOW());
        if (IN(pb + 0) && EN(2)) {
            IDS_NOW;
            auto H = WSP(bf16, WS_H); auto WIN = WSP(bf16, WS_WIN);
            pg8::Gemm g{(const bf16*)H, (const bf16*)(WIN + (size_t)l * NIN * D), MTOT, NIN, D}; pg8::StaticOrder S; S.init(MTOT, NIN, G, bid);
            EpiInproj E{MISC, l};
            { const int c0s = (MTOT / 256) * (NIN / 256) - ((MTOT / 256) * (NIN / 256) / G) * G;
              if (c0s > 0 && bid >= c0s) { const int nsl = INPROJ_STAGGER * (1 + (bid - c0s) % 3); for (int i_ = 0; i_ < nsl; ++i_) __builtin_amdgcn_s_sleep(64); } }
            pg8::gemm_phase<EpiInproj, pg8::StaticOrder, false>(ldsl, g, S, E, wave0);
            { const int nfull = (MTOT / 256) * (NIN / 256) / G, c0 = (MTOT / 256) * (NIN / 256) - nfull * G;
              if (l == 0 && c0 > 0 && bid >= c0) { const int tc = TIDNOW(); const int wv = wave0;
                  cvt_range(MISC, ldsl, CVT_P0_END, CVT_T1_END, (bid - c0) * NWAVES + wv, (G - c0) * NWAVES, wv, tc & 63); } }
        }
        }
        SEAM(pb + 0);
        for (int rep_ = 0; rep_ < (l == 0 ? REPS(3) : 1); ++rep_) { if (rep_) xcd_barrier(bar, TIDNOW());
        if (IN(pb + 1) && EN(3)) {
            IDS_NOW;
            auto diff_subln = INP(9); auto sink = INP(11); auto LAMV = WSP(float, WS_LAM);
            auto QA = WSP(bf16, WS_QA); auto QB = WSP(bf16, WS_QB); auto QC = WSP(bf16, WS_QC);
            auto KA = WSP(bf16, WS_KA); auto VA = WSP(bf16, WS_VA); auto KB = WSP(bf16, WS_KB); auto VB = WSP(bf16, WS_VB); auto KC = WSP(bf16, WS_KC); auto VC = WSP(bf16, WS_VC);
            auto YS = WSP(bf16, WS_YS);
            const int NU = lastl ? 1536 : 1632;
            const float lam = LAMV[l]; const float post = 1.0f - (0.8f - 0.6f * expf(-0.3f * (float)l));
            {
                for (int rp_ = 0; rp_ < ((A128DUP && l == 0) ? 2 : 1); ++rp_)
                for (int pr = vcu; pr < 256; pr += G) {
                    const int b = pr >> 6, hh = (pr >> 4) & 3, q0 = b * SEQ + (pr & 15) * 256;
                    const size_t kv0 = (size_t)b * KVR * 512 + hh * 128;
                    for (int mp = 0; mp < 2; ++mp) {
                        __syncthreads();
                        att128::attn_unit<8>((const att64::bf16*)(const bf16*)(QA + (size_t)q0 * 512 + hh * 128 + mp * 64), 512, (const att64::bf16*)(const bf16*)(KA + kv0 + mp * 64), (const att64::bf16*)(const bf16*)(VA + kv0), 512, 68, mp,
                                             lam, diff_subln + l * 128, post, (att64::bf16*)(bf16*)(YS + (size_t)q0 * 512 + hh * 128), 512, (char*)lds, wave0);
                    }
                }
            }
            for (int i = 0;; ++i) {
                const int L = 512 + i * G + vcu; if (L >= NU) break;
                int type, b, hh, qb, qrow; bool isctx;
                if (L < 1536) { type = L / 512; const int idx = L % 512; b = idx >> 7; hh = (idx >> 5) & 3; qb = idx & 31; qrow = b * SEQ + qb * 128; isctx = false; }
                else { const int e = L - 1536; type = e / 32; const int idx = e % 32; b = idx >> 3; hh = (idx >> 1) & 3; qb = idx & 1; qrow = MLAT + b * CTXL + qb * 128; isctx = true; }
                if (type != 0) {
                    __syncthreads();
                    const int idx = isctx ? (L - 1536) % 32 : L % 512;
                    if (type == 1) {
                        const int b1 = isctx ? idx >> 3 : idx >> 7, head = isctx ? idx & 7 : (idx >> 4) & 7, q0 = isctx ? MLAT + b1 * CTXL : b1 * SEQ + (idx & 15) * 256;
                        const size_t kv0 = ((size_t)b1 * KVR + (isctx ? SEQ : 0)) * 128 + (head >> 2) * 64; const int nt = isctx ? 4 : 68;
                        att64::attn_unit<8, false, false>((const att64::bf16*)(const bf16*)(QB + (size_t)q0 * 512 + head * 64), 512, (const att64::bf16*)(const bf16*)(KB + kv0), (const att64::bf16*)(const bf16*)(VB + kv0), 128, nt, nt, 0, 0, 0, 0, 0.f, 0.f,
                                                         (att64::bf16*)(bf16*)(YS + (size_t)MTOT * 512 + (size_t)q0 * 512 + head * 64), 512, (char*)lds, wave0);
                    } else {
                        const int b1 = isctx ? idx >> 3 : idx >> 7, hp = isctx ? (idx >> 1) & 3 : (idx >> 5) & 3, qbl = isctx ? idx & 1 : idx & 31;
                        const int head = 2 * hp, q0 = isctx ? MLAT + b1 * CTXL + qbl * 128 : b1 * SEQ + qbl * 128;
                        const size_t kv0 = ((size_t)b1 * KVR + SEQ) * 128 + (head >> 2) * 64; const float sl2a = sink[l * 8 + head] * 1.4426950408889634f, sl2b = sink[l * 8 + head + 1] * 1.4426950408889634f;
                        const att64::bf16* qp_ = (const att64::bf16*)(const bf16*)(QC + (size_t)q0 * 512 + head * 64); att64::bf16* op_ = (att64::bf16*)(bf16*)(YS + (size_t)2 * MTOT * 512 + (size_t)q0 * 512 + head * 64);
                        if (isctx) att64::attn_unit<8, false, true>(qp_, 512, (const att64::bf16*)(const bf16*)(KC + kv0), (const att64::bf16*)(const bf16*)(VC + kv0), 128, 4, 4, 0, 0, 0, 1, sl2a, sl2b, op_, 512, (char*)lds, wave0);
                        else { const int qpos = qbl * 128; const int klo = qpos - 128 < 0 ? 0 : qpos - 128, khi = qpos + 256 > SEQ ? SEQ : qpos + 256; const int n2 = (khi - klo) / 64;
                            att64::attn_unit<8, true, true>(qp_, 512, (const att64::bf16*)(const bf16*)(KC + kv0), (const att64::bf16*)(const bf16*)(VC + kv0), 128, 4 + n2, 4, klo - SEQ, klo, qpos, 1, sl2a, sl2b, op_, 512, (char*)lds, wave0); }
                    }
                    continue;
                }
                att::UnitArgs A;
                A.s1 = isctx ? SEQ : 0; A.n1 = isctx ? 4 : 68; A.s2 = 0; A.n2 = 0; A.qpos0 = -1; A.use_sink = 0; A.sink0 = 0.f; A.sink1 = 0.f; A.lam = lam; A.post = post; A.subg = diff_subln + l * 128;
                {
                    A.Q = QA + (size_t)qrow * 512 + hh * 128; A.qg1 = 64; A.K = KA + (size_t)b * KVR * 512 + hh * 128; A.V = VA + (size_t)b * KVR * 512 + hh * 128; A.ldk = 512;
                    A.O = YS + (size_t)qrow * 512 + hh * 128; A.og1 = 0;
                    att::attn_unit<true, false>(A, (char*)lds, wave0);
                }
            }
        }
        }
        SEAM(pb + 1);
        for (int rep_ = 0; rep_ < (l == 0 ? REPS(4) : 1); ++rep_) { if (rep_) xcd_barrier(bar, TIDNOW());
        if (IN(pb + 2) && EN(4)) {
            IDS_NOW;
            auto YS = WSP(bf16, WS_YS); auto WB = WSP(bf16, WS_WB);
            pg8::Gemm g{(const bf16*)YS, (const bf16*)(WB + (size_t)l * 3 * D * 512), 3 * MTOT, 3 * D, 512}; MergeOrder S{(ML / 256) * 4, G, vcu};
            EpiMerge E{MISC};
            pg8::gemm_phase<EpiMerge, MergeOrder, false>(ldsl, g, S, E, wave0);
            { const int c0 = (ML / 256) * 4 - G;
              if (l == 0 && c0 > 0 && c0 < G && vcu >= c0) { const int tc = TIDNOW(); const int wv = wave0;
                  cvt_range(MISC, ldsl, CVT_T1_END, CVT_T3_END, (vcu - c0) * NWAVES + wv, (G - c0) * NWAVES, wv, tc & 63); } }
        }
        }
        SEAM(pb + 2);
        for (int rep_ = 0; rep_ < (l == 0 ? REPS(5) : 1); ++rep_) { if (rep_) xcd_barrier(bar, TIDNOW());
        if (IN(pb + 3) && EN(5)) {
            IDS_NOW;
            auto MG = WSP(bf16, WS_MG); auto WO = WSP(bf16, WS_WO);
            pg8::Gemm g{(const bf16*)MG, (const bf16*)(WO + (size_t)l * D * D), ML, D, D}; pg8::StaticOrder S; S.init(ML, D, G, bid);
            EpiOut E{MISC};
            pg8::gemm_phase<EpiOut, pg8::StaticOrder, false>(ldsl, g, S, E, wave0);
            { const int c0 = (ML / 256) * 4 - G;
              if (l == 0 && c0 > 0 && c0 < G && bid >= c0) { const int tc = TIDNOW(); const int wv = wave0;
                  cvt_range(MISC, ldsl, CVT_T3_END, CVT_END, (bid - c0) * NWAVES + wv, (G - c0) * NWAVES, wv, tc & 63); } }
        }
        }
        SEAM(pb + 3);
        if (IN(pb + 4) && EN(6)) {
            IDS_NOW;
            PHASE_IDS;
            auto norm_g = INP(6); auto router_w = INP(14); auto router_b = INP(15);
            gcfp ng = norm_g + (size_t)l * 4 * D; auto modl = WSP(float, WS_MOD) + (size_t)l * 5 * NIN;
            auto Y = WSP(bf16, WS_Y); auto X = WSP(float, WS_X); auto H2 = WSP(bf16, WS_H2); auto x_in0 = INP(0); auto ctx_in0 = INP(2);
            auto SE = WSP(int, WS_SE); auto SR = WSP(int, WS_SR); auto SW = WSP(float, WS_SW); auto LIST = WSP(int, WS_LIST);
            LAS f32x4* rwL = (LAS f32x4*)ldsl;
            gcfp rw = router_w + (size_t)l * D * NE;
            {
                f32x4 tw[16];
#pragma unroll
                for (int k = 0; k < 16; ++k) { const int idx = tid + k * (NWAVES * 64); const int d = idx >> 3, q = idx & 7; tw[k] = *(const GAS f32x4*)(rw + (size_t)d * NE + q * 4); }
#pragma unroll
                for (int k = 0; k < 16; ++k) { const int idx = tid + k * (NWAVES * 64); const int d = idx >> 3, q = idx & 7; const int rowp = (d & 3) * 256 + (d >> 2);
                    rwL[rowp * 8 + (q ^ ((rowp >> 1) & 7))] = tw[k]; }
            }
            volatile LAS unsigned* hist = MISC + MW_HIST; volatile LAS unsigned* gbase = MISC + MW_BASE; volatile LAS unsigned* slotw = MISC + MW_SLOT + wave * (9 * 4 * 3);
            if (tid < NE) hist[tid] = 0u;
            __syncthreads();
            const int RPB = (ML + G - 1) / G; const int r0 = bid * RPB;
            int nti = 0;
#if TOKPROBE & 1
            for (int rep1 = (l == 0) ? 0 : 1; rep1 < 2; ++rep1) { const bool dry1 = rep1 == 0; gfp Xo = dry1 ? (gfp)WSP(float, WS_TMP) : (gfp)X; gbp H2o = dry1 ? (gbp)WSP(bf16, WS_ACT) : (gbp)H2; nti = 0;
#else
            { gfp Xo = (gfp)X; gbp H2o = (gbp)H2; constexpr bool dry1 = false;
#endif
            {
            int i = wave; bool have = (i < RPB && r0 + i < ML);
            u32x2 yn[4]; auto PVl = WSP(float, WS_PV) + (size_t)l * 5 * 4 * D;
#define YLD(r_) do { _Pragma("unroll") for (int j = 0; j < 4; ++j) yn[j] = *(const GAS u32x2*)(Y + (size_t)(r_) * D + 4 * lane + 256 * j); } while (0)
#define XSRC(r_) (l == 0 ? ((r_) < MLAT ? x_in0 + (size_t)(r_) * D : ctx_in0 + (size_t)((r_) - MLAT) * D) : (gcfp)(X + (size_t)(r_) * D))
            if (have) { YLD(r0 + i); }
            while (have) {
                const int r = r0 + i; const int mr = r < MLAT ? (r >> 12) : 4;
                gcfp md = modl + (size_t)mr * NIN; gcfp pv = PVl + (size_t)mr * 4 * D; f32x4 yv[4], xv[4], hv[4], A1[4], A2[4];
                ld_row(XSRC(r), lane, xv); ld_row(pv, lane, A1); ld_row(pv + D, lane, A2); ld_row(md + 3 * D, lane, hv);

#pragma unroll
                for (int j = 0; j < 4; ++j) yv[j] = (f32x4){bflo(yn[j].x), bfhi(yn[j].x), bflo(yn[j].y), bfhi(yn[j].y)};
                const int inx = i + NWAVES; const bool hn = (inx < RPB && r0 + inx < ML);
                if (hn) { YLD(r0 + inx); }
                const float rny = __builtin_amdgcn_rsqf(sumsq_row(yv) * (1.0f / D) + EPS);
#pragma unroll
                for (int j = 0; j < 4; ++j) { const int c = 4 * lane + 256 * j; xv[j] = xv[j] + A1[j] * (yv[j] * rny); *(GAS f32x4*)(Xo + (size_t)r * D + c) = xv[j]; }
                if (l >= MOE_F8_FROM) norm_affine_row<true>(xv, A2, lane, hv, (gbp)((GAS unsigned char*)H2o + (size_t)r * D));
                else norm_affine_row<false>(xv, A2, lane, hv, H2o + (size_t)r * D);
                float a[32];
#pragma unroll
                for (int q = 0; q < 32; ++q) a[q] = 0.f;
                const int sw = (lane >> 1) & 7;
                {
                    f32x4 wA[8], wB[8];
#define RW_LD(W, blk) do { const int rowp_ = ((blk) & 3) * 256 + 64 * ((blk) >> 2) + lane; _Pragma("unroll") for (int q = 0; q < 8; ++q) W[q] = rwL[rowp_ * 8 + (q ^ sw)]; } while (0)
#define RW_FMA(W, blk) do { const float hval_ = hv[(blk) >> 2][(blk) & 3]; _Pragma("unroll") for (int q = 0; q < 8; ++q) { a[4 * q + 0] += hval_ * W[q][0]; a[4 * q + 1] += hval_ * W[q][1]; a[4 * q + 2] += hval_ * W[q][2]; a[4 * q + 3] += hval_ * W[q][3]; } } while (0)
                    RW_LD(wA, 0);
#pragma unroll
                    for (int blk = 0; blk < 16; blk += 2) { RW_LD(wB, blk + 1); RW_FMA(wA, blk); __builtin_amdgcn_sched_barrier(0); if (blk + 2 < 16) RW_LD(wA, blk + 2); RW_FMA(wB, blk + 1); __builtin_amdgcn_sched_barrier(0); }
#undef RW_LD
#undef RW_FMA
                }
#define RS(N, MASK) do { const bool up = (lane & (MASK)) != 0; _Pragma("unroll") for (int q = 0; q < (N) / 2; ++q) { const float keep = up ? a[(N) / 2 + q] : a[q]; const float send = up ? a[q] : a[(N) / 2 + q]; a[q] = keep + __shfl_xor(send, (MASK)); } } while (0)
                RS(32, 32); RS(16, 16); RS(8, 8); RS(4, 4); RS(2, 2);
#undef RS
                const int myE = (lane >> 1) & 31;
                float val = a[0] + dppf<0xB1>(a[0]) + router_b[l * NE + myE];
                float tv[4]; int te[4];
#define BETTER(ov, oe, bv, be) ((ov) > (bv) || ((ov) == (bv) && (oe) < (be)))
#define TSTEP(CTRL) do { const float ov = dppf<CTRL>(bv); const int oe = dppi<CTRL>(be); if (BETTER(ov, oe, bv, be)) { bv = ov; be = oe; } } while (0)
#pragma unroll
                for (int k = 0; k < 4; ++k) { float bv = val; int be = myE;
                    TSTEP(0x4E); TSTEP(0x141); TSTEP(0x140);
                    float v0 = rdl(bv, 0), v1 = rdl(bv, 16), v2 = rdl(bv, 32), v3 = rdl(bv, 48);
                    int e0 = __builtin_amdgcn_readlane(be, 0), e1 = __builtin_amdgcn_readlane(be, 16), e2 = __builtin_amdgcn_readlane(be, 32), e3 = __builtin_amdgcn_readlane(be, 48);
                    if (BETTER(v1, e1, v0, e0)) { v0 = v1; e0 = e1; } if (BETTER(v3, e3, v2, e2)) { v2 = v3; e2 = e3; } if (BETTER(v2, e2, v0, e0)) { v0 = v2; e0 = e2; }
                    tv[k] = v0; te[k] = e0; if (myE == e0) val = -INFINITY; }
#undef TSTEP
#undef BETTER
                const float e1 = __expf(tv[1] - tv[0]), e2 = __expf(tv[2] - tv[0]), e3 = __expf(tv[3] - tv[0]); const float inv = 1.0f / (1.0f + e1 + e2 + e3);
                if (lane < 4) { const int ek = lane == 0 ? te[0] : lane == 1 ? te[1] : lane == 2 ? te[2] : te[3]; const float wk = (lane == 0 ? 1.0f : lane == 1 ? e1 : lane == 2 ? e2 : e3) * inv;
                    const unsigned lr = __hip_atomic_fetch_add((LAS unsigned*)((dry1 ? gbase : hist) + ek), 1u, __ATOMIC_RELAXED, __HIP_MEMORY_SCOPE_WORKGROUP);
                    slotw[(nti * 4 + lane) * 3 + 0] = (unsigned)ek; slotw[(nti * 4 + lane) * 3 + 1] = lr; slotw[(nti * 4 + lane) * 3 + 2] = __builtin_bit_cast(unsigned, wk); }
                i = inx; have = hn; ++nti;
            }
            }
            }
            __syncthreads();
            if (tid < NE) { const unsigned hcount = hist[tid]; gbase[tid] = hcount ? __hip_atomic_fetch_add(cntg + tid * 64, hcount, __ATOMIC_RELAXED, __HIP_MEMORY_SCOPE_AGENT) : 0u; }
            __syncthreads();
            nti = 0;
            for (int i = wave; i < RPB && r0 + i < ML; i += NWAVES, ++nti) {
                const int r = r0 + i;
                if (lane < 4) { const unsigned ek = slotw[(nti * 4 + lane) * 3 + 0], lr = slotw[(nti * 4 + lane) * 3 + 1], wkb = slotw[(nti * 4 + lane) * 3 + 2];
                    const unsigned rank = gbase[ek] + lr;
                    LIST[(size_t)ek * MTOT + rank] = r; SE[r * 4 + lane] = (int)ek; SR[r * 4 + lane] = (int)rank; SW[r * 4 + lane] = __builtin_bit_cast(float, wkb); }
            }
            __syncthreads();
        }
        SEAM(pb + 4);
        LAS int* tb = (LAS int*)(ldsl + MISC_OFF) + MW_TB; LAS int* cn = (LAS int*)(ldsl + MISC_OFF) + MW_CNT;
        if (IN(pb + 5) || IN(pb + 6) || IN(pb + 7)) {
            IDS_NOW;
            __syncthreads();
            const int tid = TIDNOW();
            if (tid < NE) cn[tid] = (int)__hip_atomic_load(cntg + tid * 64, __ATOMIC_RELAXED, __HIP_MEMORY_SCOPE_AGENT);
            __syncthreads();
            if (tid == 0) { int accu = 0; for (int e = 0; e < NE; ++e) { tb[e] = accu; accu += (cn[e] + 255) >> 8; } tb[NE] = accu; }
            __syncthreads();
        }
        for (int rep_ = 0; rep_ < (l == 0 ? REPS(7) : 1); ++rep_) { if (rep_) xcd_barrier(bar, TIDNOW());
        if (IN(pb + 5) && EN(7)) {
            IDS_NOW;
            auto H2 = WSP(bf16, WS_H2); auto W1 = WSP(bf16, WS_W1); auto LIST = WSP(int, WS_LIST);
            MoeOrder<8> S; S.init(tb, cn, LIST, G, bid);
            if (l >= MOE_F8_FROM) { pg8::Gemm g{(const bf16*)H2, (const bf16*)(W1 + (size_t)l * NE * 2048 * D), MTOT, NE * 2048, D / 2}; EpiSwiglu<true> E{MISC, l};
                pg8::gemm_phase<EpiSwiglu<true>, MoeOrder<8>, true, true>(ldsl, g, S, E, wave0); }
            else { pg8::Gemm g{(const bf16*)H2, (const bf16*)(W1 + (size_t)l * NE * 2048 * D), MTOT, NE * 2048, D}; EpiSwiglu<false> E{MISC, l};
                pg8::gemm_phase<EpiSwiglu<false>, MoeOrder<8>, true, false>(ldsl, g, S, E, wave0); }
        }
        }
        SEAM(pb + 5);
        for (int rep_ = 0; rep_ < (l == 0 ? REPS(8) : 1); ++rep_) { if (rep_) xcd_barrier(bar, TIDNOW());
        if (IN(pb + 6) && EN(8)) {
            IDS_NOW;
            auto ACT = WSP(bf16, WS_ACT); auto W2 = WSP(bf16, WS_W2); auto LIST = WSP(int, WS_LIST);
            MoeOrder<4> S; S.init(tb, cn, LIST, G, bid);
            if (l >= MOE_F8_FROM) { pg8::Gemm g{(const bf16*)ACT, (const bf16*)(W2 + (size_t)l * NE * D * D), MAXTILES * 256, NE * D, D / 2}; EpiMoe2<true> E{MISC, l};
                pg8::gemm_phase<EpiMoe2<true>, MoeOrder<4>, false, true>(ldsl, g, S, E, wave0); }
            else { pg8::Gemm g{(const bf16*)ACT, (const bf16*)(W2 + (size_t)l * NE * D * D), MAXTILES * 256, NE * D, D}; EpiMoe2<false> E{MISC, l};
                pg8::gemm_phase<EpiMoe2<false>, MoeOrder<4>, false, false>(ldsl, g, S, E, wave0); }
        }
        }
        SEAM(pb + 6);
        if (IN(pb + 7) && EN(9)) {
            IDS_NOW;
            PHASE_IDS;
            auto norm_g = INP(6); gcfp ng = norm_g + (size_t)l * 4 * D; auto MOD = WSP(float, WS_MOD); gcfp modl = MOD + (size_t)l * 5 * NIN;
            auto X = WSP(float, WS_X); auto H = WSP(bf16, WS_H); auto YS2 = WSP(bf16, WS_YS2); gfp outp = (gfp)ldp(MISC, 20);
            auto SE = WSP(int, WS_SE); auto SR = WSP(int, WS_SR); auto SW = WSP(float, WS_SW);
            for (int rep2 = ((TOKPROBE & 2) && l == 0) ? 0 : 1; rep2 < 2; ++rep2) { const bool dry2 = rep2 == 0; gfp Xo = dry2 ? (gfp)WSP(float, WS_TMP) : (gfp)X; gbp Ho = dry2 ? (gbp)WSP(bf16, WS_MG) : (gbp)H;
            for (int rb = gw; rb < ML; rb += 16 * NGW) {
                const int myr = rb + (lane >> 2) * NGW; const bool vld = myr < ML;
                const int se = vld ? SE[myr * 4 + (lane & 3)] : 0, sr = vld ? SR[myr * 4 + (lane & 3)] : 0; const float swt = vld ? SW[myr * 4 + (lane & 3)] : 0.f;
                const int yrow = tb[se] * 256 + sr;
                u32x2 yn[4][4]; f32x4 xn[4];
#define T2_LOAD(ri_) do { const int r_ = rb + (ri_) * NGW; _Pragma("unroll") for (int k = 0; k < 4; ++k) { const int yr_ = __builtin_amdgcn_readlane(yrow, (ri_) * 4 + k); gcbp yp = YS2 + (size_t)yr_ * D; \
                    _Pragma("unroll") for (int j = 0; j < 4; ++j) yn[k][j] = *(const GAS u32x2*)(yp + 4 * lane + 256 * j); } ld_row(X + (size_t)r_ * D, lane, xn); } while (0)
                int ri = 0;
                if (rb < ML) T2_LOAD(0);
                while (ri < 16 && rb + ri * NGW < ML) {
                    const int r = rb + ri * NGW; const int mr = r < MLAT ? (r >> 12) : 4; gcfp md = modl + (size_t)mr * NIN;
                    f32x4 yv[4], xv[4];
#pragma unroll
                    for (int j = 0; j < 4; ++j) { yv[j] = (f32x4){0.f, 0.f, 0.f, 0.f}; xv[j] = xn[j]; }
#pragma unroll
                    for (int k = 0; k < 4; ++k) { const float wk = rdl(swt, ri * 4 + k);
#pragma unroll
                        for (int j = 0; j < 4; ++j) { const u32x2 w = yn[k][j]; yv[j][0] += wk * bflo(w.x); yv[j][1] += wk * bfhi(w.x); yv[j][2] += wk * bflo(w.y); yv[j][3] += wk * bfhi(w.y); } }
                    if (ri + 1 < 16 && rb + (ri + 1) * NGW < ML) T2_LOAD(ri + 1);
                    const float rny = 1.0f / sqrtf(sumsq_row(yv) * (1.0f / D) + EPS);
#pragma unroll
                    for (int j = 0; j < 4; ++j) { const int c = 4 * lane + 256 * j; const f32x4 g3 = *(const GAS f32x4*)(ng + 3 * D + c), gf = *(const GAS f32x4*)(md + 5 * D + c);
                        xv[j] = xv[j] + gf * ((yv[j] * rny) * g3);
                        if (lastl) *(GAS f32x4*)(outp + (size_t)r * D + c) = xv[j]; else *(GAS f32x4*)(Xo + (size_t)r * D + c) = xv[j]; }
                    if (!lastl) { f32x4 hv[4]; gcfp mdn = MOD + ((size_t)(l + 1) * 5 + mr) * NIN;
                        norm_mod_row(xv, norm_g + (size_t)(l + 1) * 4 * D, mdn + 1024, mdn, lane, hv, Ho + (size_t)r * D); }
                    ++ri;
                }
#undef T2_LOAD
            }
            if (dry2) { asm volatile("s_waitcnt vmcnt(0)" ::: "memory"); __syncthreads(); } }
        }
        if (!lastl) SEAM(pb + 7);
    }
#undef IN
#undef SEAM
}

constexpr int N_PHASES = 2 + 8 * DEPTH;
#ifndef MK_CUTS
#define MK_CUTS 0
#endif
extern "C" void kernel_launch(void* const* d_in, const int* in_sizes, int n_in, void* d_out, int out_size, void* d_ws, size_t ws_size, hipStream_t stream) {
    static int grid = 0;
    if (grid == 0) {
        if (n_in != 20 || out_size != MLAT * D || ws_size < WS_END) { fprintf(stderr, "kernel_launch: unexpected shapes (n_in %d out %d ws %zu need %zu)\n", n_in, out_size, ws_size, (size_t)WS_END); grid = -1; return; }
        int dev = 0, cus = 0, per_cu = 0;
        if (hipGetDevice(&dev) != hipSuccess || hipDeviceGetAttribute(&cus, hipDeviceAttributeMultiprocessorCount, dev) != hipSuccess) { grid = -1; return; }
        if (hipFuncSetAttribute((const void*)mk_fwd, hipFuncAttributeMaxDynamicSharedMemorySize, LDS_BYTES) != hipSuccess) { fprintf(stderr, "kernel_launch: hipFuncSetAttribute failed\n"); grid = -1; return; }
        if (hipOccupancyMaxActiveBlocksPerMultiprocessor(&per_cu, (const void*)mk_fwd, NWAVES * 64, LDS_BYTES) != hipSuccess || per_cu < 1) { fprintf(stderr, "kernel_launch: occupancy query reports %d\n", per_cu); }
        (void)hipGetLastError();
        grid = cus;
    }
    if (grid < 0) return;
    if (hipMemsetAsync((char*)d_ws + WS_CTL, 0, CTL_BYTES, stream) != hipSuccess) return;
    Args a{};
    for (int i = 0; i < 20; ++i) a.in[i] = (const float*)d_in[i];
    a.out = (float*)d_out; a.ws = (unsigned char*)d_ws;
#if MK_CUTS
    for (int p = 0; p < N_PHASES; ++p) { a.ph_lo = p; a.ph_hi = p + 1; hipLaunchKernelGGL(mk_fwd, dim3(grid), dim3(NWAVES * 64), LDS_BYTES, stream, a); }
#else
    a.ph_lo = 0; a.ph_hi = N_PHASES;
    hipLaunchKernelGGL(mk_fwd, dim3(grid), dim3(NWAVES * 64), LDS_BYTES, stream, a);
#endif
    const hipError_t le = hipPeekAtLastError();
    if (le != hipSuccess) fprintf(stderr, "kernel_launch: launch failed: %s\n", hipGetErrorName(le));
}
```

```cpp
#include <hip/hip_runtime.h>
#include <cstdio>
#include <cstdint>

#define LAS __attribute__((address_space(3)))
#define GAS __attribute__((address_space(1)))

__device__ __forceinline__ int lane_now() { int l = (int)__builtin_amdgcn_mbcnt_hi(~0u, __builtin_amdgcn_mbcnt_lo(~0u, 0u)); asm volatile("" : "+v"(l)); return l; }

namespace pg8 {
#define PG8_LAS __attribute__((address_space(3)))
typedef unsigned short bf16_t;
typedef short bf16x8 __attribute__((ext_vector_type(8)));
typedef float f32x4 __attribute__((ext_vector_type(4)));
typedef float f32x2 __attribute__((ext_vector_type(2)));
typedef unsigned u32x4 __attribute__((ext_vector_type(4)));
typedef unsigned u32x2 __attribute__((ext_vector_type(2)));
constexpr int BM = 256, BK = 64, HALF = 128, HTB = HALF * BK * 2  , STAGE_BYTES = 8 * HTB, NXCD = 8, WGM = 8;

__host__ __device__ __forceinline__ int lds_byte(int r, int c) { const int st = (r >> 4) * 2 + (c >> 5), rr = r & 15, cc = c & 31, ob = rr * 64 + cc * 2; return st * 1024 + (ob ^ (((ob >> 9) & 1) << 5)); }
__host__ __device__ __forceinline__ void stage_rc(int b, int& R, int& C) { const int st = b / 1024, sb = b % 1024, swz = sb ^ (((sb >> 9) & 1) << 5); R = (st >> 1) * 16 + swz / 64; C = (st & 1) * 32 + (swz % 64) / 2; }
__host__ __device__ __forceinline__ int perm32(int rho) { const int n = rho >> 4, i = rho & 15; return 8 * (i >> 2) + 4 * n + (i & 3); }

struct Unit { int pm, pn; };
struct Gemm { const bf16_t* A; const bf16_t* Bt; int M, N, K; };

struct StaticOrder {
    int nM, nN, nwg, G, c;
    __host__ __device__ void init(int M, int N, int G_, int c_) { nM = M / BM; nN = N / BM; nwg = nM * nN; G = G_; c = c_; }
    __host__ __device__ bool next(int i, Unit& u) const {
        const long L = (long)i * G + c; if (L >= nwg) return false;
        int wgid = (int)L; { const int q = nwg / NXCD, r = nwg % NXCD, xcd = wgid % NXCD, off = wgid / NXCD; wgid = (xcd < r ? xcd * (q + 1) : r * (q + 1) + (xcd - r) * q) + off; }
        const int nig = WGM * nN, gid = wgid / nig, fm = gid * WGM, gsz = (nM - fm) < WGM ? (nM - fm) : WGM;
        u.pm = fm + ((wgid % nig) % gsz); u.pn = (wgid % nig) / gsz; return true;
    }
    __device__ __forceinline__ unsigned a_row(const Unit&, int) const { return 0u; }
};

__device__ __forceinline__ unsigned cvt_pk_bf16(float lo, float hi) { unsigned r; asm volatile("v_cvt_pk_bf16_f32 %0, %1, %2" : "=v"(r) : "v"(lo), "v"(hi)); return r; }

typedef int v8i32 __attribute__((ext_vector_type(8)));
typedef int v4i32 __attribute__((ext_vector_type(4)));
__device__ __forceinline__ v8i32 cat8(bf16x8 lo, bf16x8 hi) { const v4i32 a = __builtin_bit_cast(v4i32, lo), b = __builtin_bit_cast(v4i32, hi); return (v8i32){a[0], a[1], a[2], a[3], b[0], b[1], b[2], b[3]}; }
__device__ __forceinline__ void mfma_f8(f32x4& acc, v8i32 a, v8i32 b, int sc) {
    asm volatile("v_mfma_scale_f32_16x16x128_f8f6f4 %0, %1, %2, %0, %3, %3 op_sel_hi:[0,0,0]" : "+v"(acc) : "v"(a), "v"(b), "v"(sc)); }
template <class E> struct epi_chain { static constexpr bool v = false; };
template <class E> struct epi_dup { static constexpr int v = 0; };
template <class Epi, class Sched, bool GATHER, bool FP8 = false>
__device__ __forceinline__ void gemm_phase(PG8_LAS unsigned char* lds, const Gemm g, const Sched& S, const Epi& E, const int wave0) {
    const int lane = lane_now(), tid = wave0 * 64 + lane, wid = wave0, wr = wid >> 2, wc = wid & 3, fr = lane & 15, fq = lane >> 4;
    const int K = g.K, nt = K / BK;
    unsigned voffA[2], voffB[2]; int RA[2], CA[2];
#pragma unroll
    for (int i = 0; i < 2; ++i) { int R, C; stage_rc(tid * 16 + i * 8192, R, C); const int Rb = Epi::PERM ? ((R & ~31) + perm32(R & 31)) : R;
        RA[i] = R; CA[i] = C; voffA[i] = (unsigned)(R * K + C) * 2u; voffB[i] = (unsigned)(Rb * K + C) * 2u; }
    const size_t kstep = (size_t)(BK * 2);
    const size_t hstep = (size_t)HALF * K * 2;
    const size_t tstep = 2 * hstep;
    const unsigned ldsw = (unsigned)wid * 1024u;
    const int aoff = lds_byte(wr * 64 + fr, fq * 8), boff = lds_byte(wc * 32 + fr, fq * 8);
#define PG8_SA(b, h) (((b) * 2 + (h)) * HTB)
#define PG8_SB(b, h) ((4 + (b) * 2 + (h)) * HTB)
#define PG8_STAGE2(bufoff, gbase, o0, o1) do { \
        __builtin_amdgcn_global_load_lds((const unsigned*)((const char*)(gbase) + (o0)), (PG8_LAS unsigned*)(lds + (bufoff) + ldsw), 16, 0, 0); \
        __builtin_amdgcn_global_load_lds((const unsigned*)((const char*)(gbase) + (o1)), (PG8_LAS unsigned*)(lds + (bufoff) + ldsw + 8192), 16, 0, 0); } while (0)
#define PG8_STB(bufoff, gbase) PG8_STAGE2(bufoff, gbase, voffB[0], voffB[1])
#define PG8_STA(bufoff, ptr, h, OC) do { if constexpr (GATHER) PG8_STAGE2(bufoff, ptr, OC[h][0], OC[h][1]); else PG8_STAGE2(bufoff, (ptr) + ((h) ? hstep : (size_t)0), voffA[0], voffA[1]); } while (0)
#define PG8_LDA(dst, b, h) do { _Pragma("unroll") for (int m = 0; m < 4; ++m) _Pragma("unroll") for (int k = 0; k < 2; ++k) dst[m][k] = *(const PG8_LAS bf16x8*)(lds + PG8_SA(b, h) + aoff + m * 2048 + k * 1024); } while (0)
#define PG8_LDB(dst, b, h) do { _Pragma("unroll") for (int n = 0; n < 2; ++n) _Pragma("unroll") for (int k = 0; k < 2; ++k) dst[n][k] = *(const PG8_LAS bf16x8*)(lds + PG8_SB(b, h) + boff + n * 2048 + k * 1024); } while (0)
#define PG8_MMA(ai, bj, At, Bt) do { __builtin_amdgcn_s_setprio(1); \
        if constexpr (FP8) { _Pragma("unroll") for (int m = 0; m < 4; ++m) _Pragma("unroll") for (int n = 0; n < 2; ++n) \
            mfma_f8(acc[ai][bj][m][n], cat8(Bt[n][0], Bt[n][1]), cat8(At[m][0], At[m][1]), sc8); } \
        else { _Pragma("unroll") for (int m = 0; m < 4; ++m) _Pragma("unroll") for (int n = 0; n < 2; ++n) _Pragma("unroll") for (int k = 0; k < 2; ++k) \
            acc[ai][bj][m][n] = __builtin_amdgcn_mfma_f32_16x16x32_bf16(Bt[n][k], At[m][k], acc[ai][bj][m][n], 0, 0, 0); } \
        __builtin_amdgcn_s_setprio(0); } while (0)
#define PG8_WAIT_V(n) asm volatile("s_waitcnt vmcnt(" #n ")" ::: "memory")
#define PG8_WAIT_L(n) asm volatile("s_waitcnt lgkmcnt(" #n ")" ::: "memory")
#define PG8_BAR __builtin_amdgcn_s_barrier()
#define PG8_SCHED __builtin_amdgcn_sched_barrier(0)
    Unit cur, nxt; int ui = 0;
    if (!S.next(0, cur)) return;
    f32x4 acc[2][2][4][2];
#pragma unroll
    for (int a = 0; a < 2; ++a)
#pragma unroll
        for (int b = 0; b < 2; ++b)
#pragma unroll
            for (int m = 0; m < 4; ++m)
#pragma unroll
                for (int n = 0; n < 2; ++n) acc[a][b][m][n] = (f32x4){0.f, 0.f, 0.f, 0.f};
    bf16x8 At[4][2], B0[2][2], B1[2][2];
    int sc8 = 0x7f7f7f7f; asm volatile("" : "+v"(sc8));
    unsigned vC[2][2] = {{0u, 0u}, {0u, 0u}}, vN[2][2] = {{0u, 0u}, {0u, 0u}};
    if constexpr (GATHER) {
#pragma unroll
        for (int h = 0; h < 2; ++h)
#pragma unroll
            for (int i = 0; i < 2; ++i) vC[h][i] = (S.a_row(cur, h * HALF + RA[i]) * (unsigned)K + (unsigned)CA[i]) * 2u;
    }
    const char* Ab = (const char*)g.A;
    const char* cA = GATHER ? Ab : Ab + (size_t)cur.pm * tstep; const char* cB = (const char*)g.Bt + (size_t)cur.pn * tstep;
    PG8_STB(PG8_SB(0, 0), cB); PG8_STB(PG8_SB(0, 1), cB + hstep); PG8_STA(PG8_SA(0, 0), cA, 0, vC); PG8_STA(PG8_SA(0, 1), cA, 1, vC);
    if (wr == 1) PG8_BAR;
    PG8_WAIT_V(2); PG8_BAR;
    PG8_STB(PG8_SB(1, 0), cB + kstep); PG8_STA(PG8_SA(1, 0), cA + kstep, 0, vC); PG8_STB(PG8_SB(1, 1), cB + hstep + kstep);
    PG8_WAIT_V(6); PG8_BAR;
    for (;;) {
        const bool has_next = S.next(ui + 1, nxt);
        const char* nA = GATHER ? Ab : (has_next ? Ab + (size_t)nxt.pm * tstep : cA); const char* nB = has_next ? (const char*)g.Bt + (size_t)nxt.pn * tstep : cB;
        if constexpr (GATHER) {
            if (has_next) {
#pragma unroll
                for (int h = 0; h < 2; ++h)
#pragma unroll
                    for (int i = 0; i < 2; ++i) vN[h][i] = (S.a_row(nxt, h * HALF + RA[i]) * (unsigned)K + (unsigned)CA[i]) * 2u;
            } else {
#pragma unroll
                for (int h = 0; h < 2; ++h)
#pragma unroll
                    for (int i = 0; i < 2; ++i) vN[h][i] = vC[h][i];
            }
        }
        for (int t = 0; t < nt; t += 2) {
            const bool last = (t == nt - 2);
            const char* a1 = cA + (size_t)(t + 1) * kstep;
            const char* a2 = last ? nA : cA + (size_t)(t + 2) * kstep; const char* b2 = last ? nB : cB + (size_t)(t + 2) * kstep;
            const char* a3 = a2 + kstep; const char* b3 = b2 + kstep;
            unsigned v2[2][2];
#pragma unroll
            for (int h = 0; h < 2; ++h)
#pragma unroll
                for (int i = 0; i < 2; ++i) v2[h][i] = last ? vN[h][i] : vC[h][i];
            PG8_LDB(B0, 0, 0); PG8_LDB(B1, 0, 1); PG8_SCHED; PG8_LDA(At, 0, 0); PG8_STA(PG8_SA(1, 1), a1, 1, vC);
            PG8_WAIT_V(8); PG8_WAIT_L(0); PG8_BAR; PG8_MMA(0, 0, At, B0); PG8_MMA(0, 1, At, B1); PG8_BAR; PG8_SCHED;
            PG8_LDA(At, 0, 1); PG8_STB(PG8_SB(0, 0), b2); PG8_STB(PG8_SB(0, 1), b2 + hstep); PG8_STA(PG8_SA(0, 0), a2, 0, v2);
            PG8_WAIT_V(8); PG8_WAIT_L(0); PG8_BAR; PG8_MMA(1, 0, At, B0); PG8_MMA(1, 1, At, B1); PG8_BAR; PG8_SCHED;
            PG8_LDB(B0, 1, 0); PG8_LDB(B1, 1, 1); PG8_SCHED; PG8_LDA(At, 1, 0); PG8_STA(PG8_SA(0, 1), a2, 1, v2);
            PG8_WAIT_V(8); PG8_WAIT_L(0); PG8_BAR; PG8_MMA(0, 0, At, B0); PG8_MMA(0, 1, At, B1); PG8_BAR; PG8_SCHED;
            PG8_LDA(At, 1, 1); PG8_STB(PG8_SB(1, 0), b3); PG8_STB(PG8_SB(1, 1), b3 + hstep); PG8_STA(PG8_SA(1, 0), a3, 0, v2);
            PG8_WAIT_V(8); PG8_WAIT_L(0); PG8_BAR; PG8_MMA(1, 0, At, B0); PG8_MMA(1, 1, At, B1); PG8_BAR; PG8_SCHED;
        }
        if (wr == 0) PG8_BAR;
        if constexpr (FP8) {
            asm volatile("s_nop 15\n\ts_nop 15" ::: "memory");
#pragma unroll
            for (int a = 0; a < 2; ++a)
#pragma unroll
                for (int b = 0; b < 2; ++b)
#pragma unroll
                    for (int m = 0; m < 4; ++m)
#pragma unroll
                        for (int n = 0; n < 2; ++n) asm volatile("" : "+v"(acc[a][b][m][n]));
        }
        E(acc, cur, wr, wc, fr, fq);
        if constexpr (epi_dup<Epi>::v) { asm volatile("" ::: "memory"); E(acc, cur, wr, wc, fr, fq); }
        if (!has_next) break;
        bool keep_acc = false; if constexpr (epi_chain<Epi>::v) keep_acc = E.keep(cur);
        if (!keep_acc) {
#pragma unroll
        for (int a = 0; a < 2; ++a)
#pragma unroll
            for (int b = 0; b < 2; ++b)
#pragma unroll
                for (int m = 0; m < 4; ++m)
#pragma unroll
                    for (int n = 0; n < 2; ++n) acc[a][b][m][n] = (f32x4){0.f, 0.f, 0.f, 0.f};
        }
        cur = nxt; cA = nA; cB = nB; ++ui;
        if constexpr (GATHER) {
#pragma unroll
            for (int h = 0; h < 2; ++h)
#pragma unroll
                for (int i = 0; i < 2; ++i) vC[h][i] = vN[h][i];
        }
        if (wr == 1) PG8_BAR;
    }
    PG8_WAIT_V(0);
    PG8_BAR;
#undef PG8_SA
#undef PG8_SB
#undef PG8_STAGE2
#undef PG8_STB
#undef PG8_STA
#undef PG8_LDA
#undef PG8_LDB
#undef PG8_MMA
#undef PG8_WAIT_V
#undef PG8_WAIT_L
#undef PG8_BAR
#undef PG8_SCHED
}
}

namespace att {
typedef unsigned short bf16_t;
using bf16x8 = __attribute__((ext_vector_type(8))) short;
using s16x4  = __attribute__((ext_vector_type(4))) short;
using f32x16 = __attribute__((ext_vector_type(16))) float;
using u32x4  = __attribute__((ext_vector_type(4))) unsigned;
constexpr int NW = 8, QBLK = 32, KVBLK = 64;
constexpr float SCALE = 0.125f;
#ifndef ATT_SGB
#define ATT_SGB 1
#endif
#ifndef ATT_PROBE
#define ATT_PROBE 0
#endif
constexpr float THR = 8.f;
constexpr int SHM_V = KVBLK * 128 * 2, SHM_K = KVBLK * 128 * 2;
constexpr int SHM_ATTN = 2 * SHM_V + 2 * SHM_K + NW * 64 * 4;
#define KSWZ(row, colB) ((row) * 256 + ((colB) ^ (((row) & 7) << 4)))
#define SBAR() __builtin_amdgcn_sched_barrier(0)
#define SGB(mask, n) __builtin_amdgcn_sched_group_barrier((mask), (n), 0)
#define S1_PIPE() do { if (ATT_SGB) { SGB(0x100, 4); _Pragma("unroll") for (int i_ = 0; i_ < 8; ++i_) { SGB(0x008, 1); SGB(0x002, 13); if ((i_ & 1) && i_ < 5) SGB(0x100, 2); } } } while (0)
__device__ __forceinline__ int crow(int r, int hi) { return (r & 3) + 8 * (r >> 2) + 4 * hi; }
typedef float f32x2_a __attribute__((ext_vector_type(2))); typedef __bf16 bf16x2_a __attribute__((ext_vector_type(2)));
__device__ __forceinline__ unsigned cvtpk(float lo, float hi) { const f32x2_a v = {lo, hi}; const bf16x2_a b = __builtin_convertvector(v, bf16x2_a); return __builtin_bit_cast(unsigned, b); }
__device__ __forceinline__ unsigned short f2bf(float f) { return (unsigned short)(cvtpk(f, 0.f) & 0xffffu); }

__device__ __forceinline__ void partialSM(f32x16& p0, f32x16& p1, float& m_reg, float& mn, float& alpha, bool domask, int dq) {
  constexpr float C = SCALE * 1.4426950408889634f;
  if (domask) {
#pragma unroll
    for (int r = 0; r < 16; ++r) { const int d0 = dq + (r & 3) + 8 * (r >> 2), d1 = d0 + 32;
      if (d0 > 128 || d0 < -128) p0[r] = -1e30f; if (d1 > 128 || d1 < -128) p1[r] = -1e30f; }
  }
  float pmax = p0[0];
#pragma unroll
  for (int r = 1; r < 16; ++r) pmax = fmaxf(pmax, p0[r]);
#pragma unroll
  for (int r = 0; r < 16; ++r) pmax = fmaxf(pmax, p1[r]);
  { auto rr = __builtin_amdgcn_permlane32_swap(__float_as_uint(pmax), __float_as_uint(pmax), false, false);
    pmax = fmaxf(__uint_as_float(rr[0]), __uint_as_float(rr[1])); }
  if (__builtin_expect(__all(pmax - m_reg <= THR / SCALE), 1)) { mn = m_reg; alpha = 1.f; }
  else { mn = fmaxf(m_reg, pmax); alpha = __builtin_amdgcn_exp2f((m_reg - mn) * C); m_reg = mn; }
  const float mnC = -mn * C;
#pragma unroll
  for (int r = 0; r < 16; ++r) p0[r] = fmaf(p0[r], C, mnC);
#pragma unroll
  for (int r = 0; r < 16; ++r) p1[r] = fmaf(p1[r], C, mnC);
#pragma unroll
  for (int r = 0; r < 16; ++r) { if (ATT_PROBE == 3) { float x2 = p0[r]; asm volatile("" : "+v"(x2)); p0[r] = 0.5f * (__builtin_amdgcn_exp2f(p0[r]) + __builtin_amdgcn_exp2f(x2)); } else p0[r] = __builtin_amdgcn_exp2f(p0[r]); }
}
__device__ __forceinline__ void finishSM(f32x16& p0, f32x16& p1, float alpha, float& l_reg, bf16x8& pa0, bf16x8& pa1, bf16x8& pa2, bf16x8& pa3, float pscale = 1.0f) {
#pragma unroll
  for (int r = 0; r < 16; ++r) { if (ATT_PROBE == 3) { float x2 = p1[r]; asm volatile("" : "+v"(x2)); p1[r] = 0.5f * (__builtin_amdgcn_exp2f(p1[r]) + __builtin_amdgcn_exp2f(x2)); } else p1[r] = __builtin_amdgcn_exp2f(p1[r]); }
  float ps = 0;
#pragma unroll
  for (int r = 0; r < 16; ++r) ps += p0[r];
#pragma unroll
  for (int r = 0; r < 16; ++r) ps += p1[r];
  { auto rr = __builtin_amdgcn_permlane32_swap(__float_as_uint(ps), __float_as_uint(ps), false, false);
    ps = __uint_as_float(rr[0]) + __uint_as_float(rr[1]); }
  l_reg = l_reg * alpha + ps;
  if (pscale != 1.0f) {
#pragma unroll
    for (int r = 0; r < 16; ++r) { p0[r] *= pscale; p1[r] *= pscale; } }
#define PK4(P, BASE, OUT) do { unsigned a0 = cvtpk(P[BASE + 0], P[BASE + 1]), a1 = cvtpk(P[BASE + 2], P[BASE + 3]);   \
    unsigned b0 = cvtpk(P[BASE + 4], P[BASE + 5]), b1 = cvtpk(P[BASE + 6], P[BASE + 7]);                              \
    auto r0 = __builtin_amdgcn_permlane32_swap(a0, b0, false, false); auto r1 = __builtin_amdgcn_permlane32_swap(a1, b1, false, false); \
    u32x4 w = {r0[0], r1[0], r0[1], r1[1]}; OUT = *reinterpret_cast<bf16x8*>(&w); } while (0)
  PK4(p0, 0, pa0); PK4(p0, 8, pa1); PK4(p1, 0, pa2); PK4(p1, 8, pa3);
#undef PK4
}
__device__ __forceinline__ void qkt(f32x16& p0, f32x16& p1, const char* Ks, const bf16x8* qr, int r32, int hi, int kcolB) {
  p0 = f32x16{}; p1 = f32x16{};
#pragma unroll
  for (int d0 = 0; d0 < 4; ++d0) { const int cb = kcolB + (d0 * 16 + hi * 8) * 2;
    bf16x8 b0 = *reinterpret_cast<const bf16x8*>(Ks + KSWZ(r32, cb));
    bf16x8 b1 = *reinterpret_cast<const bf16x8*>(Ks + KSWZ(32 + r32, cb));
    p0 = __builtin_amdgcn_mfma_f32_32x32x16_bf16(b0, qr[d0], p0, 0, 0, 0);
    p1 = __builtin_amdgcn_mfma_f32_32x32x16_bf16(b1, qr[d0], p1, 0, 0, 0); }
}
__device__ __forceinline__ int v_st(int k, int c) { const int kk = (k & ~0xC) | ((k & 4) << 1) | ((k & 8) >> 1); return ((kk >> 3) * 4 + (c >> 5)) * 512 + ((kk & 7) * 32 + (c & 31)) * 2; }
__device__ __forceinline__ int v_rd_base(int lane) { return ((lane & 3) << 3) | (((lane >> 2) & 3) << 6) | (((lane >> 4) & 1) << 5) | (((lane >> 5) & 1) << 8); }
constexpr int v_rd_off(int d0, int ks, int half) { return d0 * 512 + ks * 4096 + half * 2048; }
template <int OFF> __device__ __forceinline__ s16x4 tr_read(int vb) {
  s16x4 r; asm volatile("ds_read_b64_tr_b16 %0, %1 offset:%2" : "=&v"(r) : "v"(vb), "i"(OFF) : "memory"); return r;
}
template <int D0> __device__ __forceinline__ void pv_one(f32x16& od, int vb, bf16x8 pa0, bf16x8 pa1, bf16x8 pa2, bf16x8 pa3) {
  const s16x4 l0 = tr_read<v_rd_off(D0, 0, 0)>(vb), h0 = tr_read<v_rd_off(D0, 0, 1)>(vb), l1 = tr_read<v_rd_off(D0, 1, 0)>(vb), h1 = tr_read<v_rd_off(D0, 1, 1)>(vb);
  const s16x4 l2 = tr_read<v_rd_off(D0, 2, 0)>(vb), h2 = tr_read<v_rd_off(D0, 2, 1)>(vb), l3 = tr_read<v_rd_off(D0, 3, 0)>(vb), h3 = tr_read<v_rd_off(D0, 3, 1)>(vb);
  asm volatile("s_waitcnt lgkmcnt(0)" ::: "memory"); SBAR();
#define PK(L, H) (bf16x8){L[0], L[1], L[2], L[3], H[0], H[1], H[2], H[3]}
  od = __builtin_amdgcn_mfma_f32_32x32x16_bf16(pa0, PK(l0, h0), od, 0, 0, 0);
  od = __builtin_amdgcn_mfma_f32_32x32x16_bf16(pa1, PK(l1, h1), od, 0, 0, 0);
  od = __builtin_amdgcn_mfma_f32_32x32x16_bf16(pa2, PK(l2, h2), od, 0, 0, 0);
  od = __builtin_amdgcn_mfma_f32_32x32x16_bf16(pa3, PK(l3, h3), od, 0, 0, 0);
#undef PK
}
template <bool DIFF> __device__ __forceinline__ void pv_all(f32x16* o, int vb, bf16x8 pa0, bf16x8 pa1, bf16x8 pa2, bf16x8 pa3) {
  pv_one<0>(o[0], vb, pa0, pa1, pa2, pa3); pv_one<1>(o[1], vb, pa0, pa1, pa2, pa3);
  if constexpr (DIFF) { pv_one<2>(o[2], vb, pa0, pa1, pa2, pa3); pv_one<3>(o[3], vb, pa0, pa1, pa2, pa3); }
}

struct UnitArgs {
  const GAS bf16_t* Q;
  int qg1;
  const GAS bf16_t* K;
  const GAS bf16_t* V;
  int ldk;
  int s1, n1, s2, n2;
  int qpos0;
  float sink0, sink1;
  int use_sink;
  GAS bf16_t* O;
  int og1;
  float lam, post;
  const GAS float* subg;
};

template <bool DIFF, bool MASK>
__device__ __forceinline__ void attn_unit(const UnitArgs& A, char* lds, const int wave0) {
  constexpr int NO = DIFF ? 4 : 2;
  const int lane = lane_now(), tid = wave0 * 64 + lane, wid = wave0, r32 = lane & 31, hi = lane >> 5;
  const int mg = wid >> 2, wq = wid & 3;
  char* V_lds = lds; char* K_lds = lds + 2 * SHM_V;
  float* ws = (float*)(lds + 2 * SHM_V + 2 * SHM_K) + wid * 64; float* li_l = ws; float* al_l = ws + 32;
  float m_reg = -1e30f, l_reg = 0.f;
  if (!DIFF && A.use_sink) { m_reg = (mg ? A.sink1 : A.sink0) * (1.0f / SCALE); l_reg = 1.f; }
  f32x16 o[NO];
#pragma unroll
  for (int d = 0; d < NO; ++d) o[d] = f32x16{};
  bf16x8 qr[4];
  const GAS bf16_t* Qw = A.Q + (mg ? A.qg1 : 0) + (long)(wq * QBLK + r32) * 512 + hi * 8;
#pragma unroll
  for (int d0 = 0; d0 < 4; ++d0) qr[d0] = *(const GAS bf16x8*)(Qw + d0 * 16);
  const int sr = tid >> 4, sc = (tid & 15) * 8, vst0 = v_st(sr, sc), vst1 = v_st(32 + sr, sc);
  const int vb0 = (int)(uintptr_t)V_lds + v_rd_base(lane) + ((!DIFF && mg) ? 1024 : 0);
  const int kcolB = mg * 128;
  const int ldk = A.ldk;
  const GAS bf16_t* Kh = A.K; const GAS bf16_t* Vh = A.V;
  const int NT = A.n1 + A.n2;
  const int qposl = A.qpos0 + wq * QBLK + r32;
  constexpr bool maskunit = MASK;
#define KST(j) ((j) < A.n1 ? A.s1 + (j) * KVBLK : A.s2 + ((j) - A.n1) * KVBLK)
  struct { bf16x8 vs0, vs1, ks0, ks1; } sr_[2];
#define SLOAD(i, k0) do { const long k0_ = (k0); sr_[i].vs0 = *(const GAS bf16x8*)(&Vh[(k0_ + sr) * ldk + sc]); sr_[i].vs1 = *(const GAS bf16x8*)(&Vh[(k0_ + 32 + sr) * ldk + sc]); \
    sr_[i].ks0 = *(const GAS bf16x8*)(&Kh[(k0_ + sr) * ldk + sc]); sr_[i].ks1 = *(const GAS bf16x8*)(&Kh[(k0_ + 32 + sr) * ldk + sc]); } while (0)
#define SWRITE(b, i) do { *(bf16x8*)(V_lds + (b) * SHM_V + vst0) = sr_[i].vs0;          \
    *(bf16x8*)(V_lds + (b) * SHM_V + vst1) = sr_[i].vs1; const int kc = sc * 2;               \
    *(bf16x8*)(K_lds + (b) * SHM_K + KSWZ(sr, kc)) = sr_[i].ks0;                       \
    *(bf16x8*)(K_lds + (b) * SHM_K + KSWZ(32 + sr, kc)) = sr_[i].ks1; } while (0)
#define SWAIT() asm volatile("s_waitcnt vmcnt(4)" ::: "memory")
#define RESC(a) do { if (__any((a) < 1.f)) { if (hi == 0) al_l[r32] = (a); asm volatile("s_waitcnt lgkmcnt(0)" ::: "memory"); \
    _Pragma("unroll") for (int d = 0; d < NO; ++d) _Pragma("unroll") for (int r = 0; r < 16; ++r) o[d][r] *= al_l[crow(r, hi)]; } } while (0)
#define MASKARGS(j) (maskunit && (j) >= A.n1), (KST(j) - qposl + 4 * hi)
  f32x16 pA0, pA1, pB0, pB1; float mnA, mnB, alA, alB; bf16x8 pa0, pa1, pa2, pa3;
  constexpr int SE = 0, SO = 1;
  __syncthreads();
  SLOAD(SE, KST(0)); asm volatile("s_waitcnt vmcnt(0)" ::: "memory"); SWRITE(0, SE); __syncthreads();
  qkt(pA0, pA1, K_lds, qr, r32, hi, kcolB); partialSM(pA0, pA1, m_reg, mnA, alA, MASKARGS(0));
  SLOAD(SO, KST(1)); if (2 < NT) SLOAD(SE, KST(2));
  SWAIT(); SWRITE(1, SO); __syncthreads();
  for (int j = 1; j + 1 < NT; j += 2) {
    SBAR(); qkt(pB0, pB1, K_lds + SHM_K, qr, r32, hi, kcolB);
    if (ATT_PROBE == 1) { asm volatile("" : "+v"(pB0), "+v"(pB1)); qkt(pB0, pB1, K_lds + SHM_K, qr, r32, hi, kcolB); }
    finishSM(pA0, pA1, alA, l_reg, pa0, pa1, pa2, pa3, ATT_PROBE == 2 ? 0.5f : 1.0f); S1_PIPE(); SBAR();
    SLOAD(SO, KST(j + 2)); SBAR();
    if (ATT_PROBE == 2) pv_all<DIFF>(o, vb0, pa0, pa1, pa2, pa3);
    pv_all<DIFF>(o, vb0, pa0, pa1, pa2, pa3); partialSM(pB0, pB1, m_reg, mnB, alB, MASKARGS(j));
    __syncthreads(); SWAIT(); SWRITE(0, SE); if (ATT_PROBE == 4) { asm volatile("" ::: "memory"); SWRITE(0, SE); }
    RESC(alB); __syncthreads();
    SBAR(); qkt(pA0, pA1, K_lds, qr, r32, hi, kcolB);
    if (ATT_PROBE == 1) { asm volatile("" : "+v"(pA0), "+v"(pA1)); qkt(pA0, pA1, K_lds, qr, r32, hi, kcolB); }
    finishSM(pB0, pB1, alB, l_reg, pa0, pa1, pa2, pa3, ATT_PROBE == 2 ? 0.5f : 1.0f); S1_PIPE(); SBAR();
    if (j + 3 < NT) SLOAD(SE, KST(j + 3)); SBAR();
    if (ATT_PROBE == 2) pv_all<DIFF>(o, vb0 + SHM_V, pa0, pa1, pa2, pa3);
    pv_all<DIFF>(o, vb0 + SHM_V, pa0, pa1, pa2, pa3); partialSM(pA0, pA1, m_reg, mnA, alA, MASKARGS(j + 1));
    __syncthreads(); SWAIT(); SWRITE(1, SO); if (ATT_PROBE == 4) { asm volatile("" ::: "memory"); SWRITE(1, SO); }
    RESC(alA); __syncthreads();
  }
  SBAR(); qkt(pB0, pB1, K_lds + SHM_K, qr, r32, hi, kcolB);
  finishSM(pA0, pA1, alA, l_reg, pa0, pa1, pa2, pa3); SBAR();
  pv_all<DIFF>(o, vb0, pa0, pa1, pa2, pa3); partialSM(pB0, pB1, m_reg, mnB, alB, MASKARGS(NT - 1));
  __syncthreads(); RESC(alB);
  finishSM(pB0, pB1, alB, l_reg, pa0, pa1, pa2, pa3); SBAR();
  pv_all<DIFF>(o, vb0 + SHM_V, pa0, pa1, pa2, pa3);
  if (hi == 0) li_l[r32] = l_reg; asm volatile("s_waitcnt lgkmcnt(0)" ::: "memory");
  float rli[16];
#pragma unroll
  for (int r = 0; r < 16; ++r) rli[r] = __builtin_amdgcn_rcpf(li_l[crow(r, hi)]);
  if constexpr (!DIFF) {
    GAS bf16_t* Ow = A.O + (mg ? A.og1 : 0) + (long)(wq * QBLK) * 512;
#pragma unroll
    for (int r = 0; r < 16; ++r) { const int orow = crow(r, hi);
#pragma unroll
      for (int d0 = 0; d0 < 2; ++d0) Ow[(long)orow * 512 + d0 * 32 + r32] = f2bf(o[d0][r] * rli[r]); }
  } else {
    float* ex = (float*)lds;
    __syncthreads();
    if (mg == 1) {
#pragma unroll
      for (int d0 = 0; d0 < 4; ++d0)
#pragma unroll
        for (int r = 0; r < 16; ++r) ex[(wq * 64 + d0 * 16 + r) * 64 + lane] = o[d0][r] * rli[r];
    }
    __syncthreads();
    if (mg == 0) {
      GAS bf16_t* Ow = A.O + (long)(wq * QBLK) * 512;
      float gsub[4];
#pragma unroll
      for (int d0 = 0; d0 < 4; ++d0) gsub[d0] = A.subg[d0 * 32 + r32] * A.post;
#pragma unroll
      for (int r = 0; r < 16; ++r) {
        float v[4]; float ss = 0.f;
#pragma unroll
        for (int d0 = 0; d0 < 4; ++d0) { v[d0] = o[d0][r] * rli[r] - A.lam * ex[(wq * 64 + d0 * 16 + r) * 64 + lane]; ss += v[d0] * v[d0]; }
        ss += __shfl_xor(ss, 1); ss += __shfl_xor(ss, 2); ss += __shfl_xor(ss, 4); ss += __shfl_xor(ss, 8); ss += __shfl_xor(ss, 16);
        const float rn = __builtin_amdgcn_rsqf(ss * (1.0f / 128.0f) + 1e-6f);
        const int orow = crow(r, hi);
#pragma unroll
        for (int d0 = 0; d0 < 4; ++d0) Ow[(long)orow * 512 + d0 * 32 + r32] = f2bf(v[d0] * rn * gsub[d0]);
      }
    }
  }
#undef KST
#undef SLOAD
#undef SWRITE
#undef SWAIT
#undef RESC
#undef MASKARGS
}
#undef KSWZ
}
#include <hip/hip_bf16.h>
namespace att64 {
using bf16=__hip_bfloat16;
using bf16x8=__attribute__((ext_vector_type(8)))short;
using s16x4=__attribute__((ext_vector_type(4)))short;
using f32x16=__attribute__((ext_vector_type(16)))float;
using u32x4=__attribute__((ext_vector_type(4)))unsigned;
constexpr int D=64;
constexpr int NW=8,QBLK=32,QB=QBLK*NW,KVBLK=64;
__device__ __forceinline__ int crow(int r,int hi){return (r&3)+8*(r>>2)+4*hi;}
#define SBAR() __builtin_amdgcn_sched_barrier(0)
__device__ __forceinline__ void bmask(f32x16&p0,f32x16&p1,int dq){
  const float NEG=-INFINITY;
  #pragma unroll
  for(int r=0;r<16;++r){const int d0=dq+(r&3)+8*(r>>2),d1=d0+32; if(d0>128||d0<-128)p0[r]=NEG; if(d1>128||d1<-128)p1[r]=NEG;}
}
constexpr int NSLOT=3, SLOTB=8192;
constexpr int LDS_K=0, LDS_V=NSLOT*SLOTB, LDS_WS=2*NSLOT*SLOTB, LDS_OST=LDS_WS+NW*64*4, LDS_BYTES=LDS_OST+NW*4096;
constexpr float C2=0.125f*1.4426950408889634f;
__device__ __forceinline__ void glds16(const void*gsrc,unsigned lds_dst){unsigned keep;
  asm volatile("s_mov_b32 %0, m0\n\ts_mov_b32 m0, %2\n\ts_nop 0\n\tglobal_load_lds_dwordx4 %1, off\n\ts_mov_b32 m0, %0":"=&s"(keep):"v"(gsrc),"s"(lds_dst):"memory");}
__device__ __forceinline__ float max3f(float a,float b,float c){float r;asm("v_max3_f32 %0, %1, %2, %3":"=v"(r):"v"(a),"v"(b),"v"(c));return r;}
__device__ __forceinline__ float max2f(float a,float b){float r;asm("v_max_f32_e32 %0, %1, %2":"=v"(r):"v"(a),"v"(b));return r;}
__device__ __forceinline__ float fadd_s(float a,float b){float r;asm("v_add_f32_e32 %0, %1, %2":"=v"(r):"v"(a),"v"(b));return r;}
__device__ __forceinline__ float fsub_s(float a,float b){float r;asm("v_sub_f32_e32 %0, %1, %2":"=v"(r):"v"(a),"v"(b));return r;}
typedef float f32x2_t __attribute__((ext_vector_type(2))); typedef __bf16 bf16x2_t __attribute__((ext_vector_type(2)));
__device__ __forceinline__ unsigned cvtpk_s(float lo,float hi){f32x2_t v={lo,hi};bf16x2_t b=__builtin_convertvector(v,bf16x2_t);return __builtin_bit_cast(unsigned,b);}
#define WAIT_BAR(N) asm volatile("s_waitcnt vmcnt(" #N ") lgkmcnt(0)\n\ts_barrier":::"memory")

__device__ __forceinline__ void qkt(f32x16&p0,f32x16&p1,const char*Kslot,const bf16x8*qr,const f32x16&negm,int r32,int hi){
  const char*kb=Kslot+hi*1024+r32*16;
  #pragma unroll
  for(int d0=0;d0<4;++d0){
    const bf16x8 b0=*reinterpret_cast<const bf16x8*>(kb+d0*2048);
    const bf16x8 b1=*reinterpret_cast<const bf16x8*>(kb+d0*2048+512);
    if(d0==0){p0=__builtin_amdgcn_mfma_f32_32x32x16_bf16(b0,qr[0],negm,0,0,0);p1=__builtin_amdgcn_mfma_f32_32x32x16_bf16(b1,qr[0],negm,0,0,0);}
    else{p0=__builtin_amdgcn_mfma_f32_32x32x16_bf16(b0,qr[d0],p0,0,0,0);p1=__builtin_amdgcn_mfma_f32_32x32x16_bf16(b1,qr[d0],p1,0,0,0);}}
}
typedef __attribute__((address_space(3))) const char* lds_cptr;
typedef short v4i16_t __attribute__((ext_vector_type(4)));
__device__ __forceinline__ void kload8(bf16x8*kf,lds_cptr kp){
  kf[0]=*(const __attribute__((address_space(3))) bf16x8*)(kp);      kf[1]=*(const __attribute__((address_space(3))) bf16x8*)(kp+512);
  kf[2]=*(const __attribute__((address_space(3))) bf16x8*)(kp+2048); kf[3]=*(const __attribute__((address_space(3))) bf16x8*)(kp+2560);
  kf[4]=*(const __attribute__((address_space(3))) bf16x8*)(kp+4096); kf[5]=*(const __attribute__((address_space(3))) bf16x8*)(kp+4608);
  kf[6]=*(const __attribute__((address_space(3))) bf16x8*)(kp+6144); kf[7]=*(const __attribute__((address_space(3))) bf16x8*)(kp+6656);
}
__device__ __forceinline__ void kload2(bf16x8*kf,lds_cptr kp,int j){ kf[2*j]=*(const __attribute__((address_space(3))) bf16x8*)(kp+j*2048); kf[2*j+1]=*(const __attribute__((address_space(3))) bf16x8*)(kp+j*2048+512); }
__device__ __forceinline__ s16x4 vtr(lds_cptr p){ return __builtin_bit_cast(s16x4,__builtin_amdgcn_ds_read_tr16_b64_v4i16((__attribute__((address_space(3))) v4i16_t*)p)); }
__device__ __forceinline__ float rowmax(const f32x16&p0,const f32x16&p1){
  float a=max3f(p0[0],p0[1],p1[0]),b=max3f(p0[2],p0[3],p1[1]);a=max3f(a,p1[2],p1[3]);
  #pragma unroll
  for(int r=4;r<16;r+=4){a=max3f(a,p0[r],p0[r+1]);b=max3f(b,p0[r+2],p0[r+3]);a=max3f(a,p1[r],p1[r+1]);b=max3f(b,p1[r+2],p1[r+3]);}
  const float m=max2f(a,b);
  auto rr=__builtin_amdgcn_permlane32_swap(__float_as_uint(m),__float_as_uint(m),false,false);
  return max2f(__uint_as_float(rr[0]),__uint_as_float(rr[1]));
}
__device__ __forceinline__ void pv(f32x16*o,int vb,bf16x8 pa0,bf16x8 pa1,bf16x8 pa2,bf16x8 pa3){
  #pragma unroll
  for(int d0=0;d0<2;++d0){s16x4 lo[4],hi[4];
    #pragma unroll
    for(int ks=0;ks<4;++ks){
      asm volatile("ds_read_b64_tr_b16 %0,%1 offset:%c2":"=&v"(lo[ks]):"v"(vb),"i"(d0*4096+ks*1024):"memory");
      asm volatile("ds_read_b64_tr_b16 %0,%1 offset:%c2":"=&v"(hi[ks]):"v"(vb),"i"(d0*4096+ks*1024+512):"memory");}
    asm volatile("s_waitcnt lgkmcnt(0)":::"memory");SBAR();
    #define PK(k) (bf16x8){lo[k][0],lo[k][1],lo[k][2],lo[k][3],hi[k][0],hi[k][1],hi[k][2],hi[k][3]}
    o[d0]=__builtin_amdgcn_mfma_f32_32x32x16_bf16(pa0,PK(0),o[d0],0,0,0);
    o[d0]=__builtin_amdgcn_mfma_f32_32x32x16_bf16(pa1,PK(1),o[d0],0,0,0);
    o[d0]=__builtin_amdgcn_mfma_f32_32x32x16_bf16(pa2,PK(2),o[d0],0,0,0);
    o[d0]=__builtin_amdgcn_mfma_f32_32x32x16_bf16(pa3,PK(3),o[d0],0,0,0);
    #undef PK
  }
}

#ifndef ATTN_STORE16
#define ATTN_STORE16(p,v) (*(u32x4*)(p)=(v))
#endif
template<int THRL,bool MASK,bool PAIR> __device__ __forceinline__ void attn_unit(const bf16*Qu,int qp,const bf16*__restrict__ Kh,const bf16*__restrict__ Vh,int kvp,int NT,int n1,int s2,int kpos2,int qpos0,int use_sink,float sink_l2,float sink_l2b,bf16*Ou,int op,char*shm,const int wave0){
  const int lane=lane_now(),tid=wave0*64+lane,r32=lane&31,hi=lane>>5; const int wid=wave0;
  const int wrow=PAIR?(wid&3):wid, whead=PAIR?(wid>>2):0;
  const bf16*Qw=Qu+(long)(wrow*QBLK)*qp+whead*D;
  const unsigned lds0=(unsigned)(uintptr_t)shm;
  float*wsf=(float*)(shm+LDS_WS)+wid*64;
  const bf16*ksrc=Kh+(long)lane*kvp+wid*8;
  const bf16*vsrc=Vh+(long)(16*(wid&3)+(lane>>2))*kvp+(wid>>2)*32+(lane&3)*8;
  const unsigned kdst=lds0+LDS_K+wid*1024, vdst=lds0+LDS_V+wid*1024;
  #define KROW(t) ((t)<n1?(t)*KVBLK:s2+((t)-n1)*KVBLK)
  #define DMA_K(t,slot) glds16(ksrc+(long)KROW(t)*kvp,(unsigned)__builtin_amdgcn_readfirstlane(kdst+(slot)))
  #define DMA_V(t,slot) glds16(vsrc+(long)KROW(t)*kvp,(unsigned)__builtin_amdgcn_readfirstlane(vdst+(slot)))
  const int vb0=(int)(lds0+LDS_V)+((lane>>4)&1)*32+(lane&3)*8+(4*hi+((lane&15)>>2))*64;
  const char*Kbase=shm+LDS_K; bf16x8 kf[8];
  const lds_cptr shm3=(lds_cptr)shm; const lds_cptr kp0=shm3+LDS_K+hi*1024+r32*16; const lds_cptr vp0=shm3+LDS_V+((lane>>4)&1)*32+(lane&3)*8+(4*hi+((lane&15)>>2))*64;
  DMA_K(0,0);DMA_V(0,0);DMA_K(1,SLOTB);
  bf16x8 qr[4];
  #pragma unroll
  for(int d0=0;d0<4;++d0)qr[d0]=*reinterpret_cast<const bf16x8*>(&Qw[(long)r32*qp+d0*16+hi*8]);
  float mhat=0.f,l_reg=0.f;f32x16 o[2];o[0]=f32x16{};o[1]=f32x16{};f32x16 negm=f32x16{};asm volatile("":"+v"(negm));
  const int dqb=kpos2-(qpos0+wrow*QBLK+r32)+4*hi;
  #define CMASK(P0,P1,t) do{ if(MASK&&(t)>=n1) bmask(P0,P1,dqb+((t)-n1)*KVBLK); }while(0)
  bool resc=false;
  #define START(P0,P1) do{ const float rm=rowmax(P0,P1); resc=false; \
    { const float dl=rm; mhat=fadd_s(mhat,dl); \
      _Pragma("unroll") for(int r=0;r<16;++r){P0[r]=fsub_s(P0[r],dl);P1[r]=fsub_s(P1[r],dl);} \
      _Pragma("unroll") for(int r=0;r<16;++r)negm[r]=-mhat; asm volatile("":"+v"(negm)); } \
    _Pragma("unroll") for(int r=0;r<16;++r)P0[r]=__builtin_amdgcn_exp2f(P0[r]); }while(0)
  #define RESC() do{ if(resc){ asm volatile("s_waitcnt lgkmcnt(0)":::"memory"); \
      _Pragma("unroll") for(int d_=0;d_<2;++d_) _Pragma("unroll") for(int r=0;r<16;++r)o[d_][r]*=wsf[crow(r,hi)]; } }while(0)
  f32x16 pA0,pA1,pB0,pB1;
  int sl_prev=0,sl_cur=0,sl_next=SLOTB;
  #define ROT() do{sl_prev=sl_cur;sl_cur=sl_next;sl_next=(sl_next==(NSLOT-1)*SLOTB)?0:sl_next+SLOTB;}while(0)
  DMA_K(2,2*SLOTB);
  WAIT_BAR(3);
  qkt(pA0,pA1,Kbase,qr,f32x16{},r32,hi);asm volatile("s_nop 15\n\ts_nop 7":"+v"(pA0),"+v"(pA1));CMASK(pA0,pA1,0);
  START(pA0,pA1);
  _Pragma("unroll") for(int r=0;r<16;++r)pA1[r]=__builtin_amdgcn_exp2f(pA1[r]);
  WAIT_BAR(0);
  DMA_K(3,0);DMA_V(1,SLOTB);
  ROT();
  kload8(kf,kp0+sl_cur);
  WAIT_BAR(2);
  s16x4 vlo[8],vhi[8]; u32x4 pw0,pw1,pw2,pw3;
  #define PKW(P,B) cvtpk_s(P[B],P[B+1])
  #define PAF(k) __builtin_bit_cast(bf16x8,pw##k)
  #define VFR(i) (bf16x8){vlo[i][0],vlo[i][1],vlo[i][2],vlo[i][3],vhi[i][0],vhi[i][1],vhi[i][2],vhi[i][3]}
  #define PIN(x) asm volatile("":"+v"(x))
  #define MX3(a,b,c) __builtin_fmaxf(__builtin_fmaxf((a),(b)),(c))
  #define GAPA(MF,A0,A1,A2,A3,W0,W1,PW) do{ MF; sacc+=A0; sacc+=A1; sacc+=A2; sacc+=A3; PIN(sacc); W0; W1; PIN(PW); SBAR(); }while(0)
  #define EX(v) __builtin_amdgcn_exp2f(v)
  #define GAPB(MF,X,B) do{ MF; X[B]=EX(X[B]); X[B+1]=EX(X[B+1]); X[B+2]=EX(X[B+2]); X[B+3]=EX(X[B+3]); PIN(X); SBAR(); }while(0)
  #define VRD(i) do{ vlo[i]=vtr(vp_+(((i)>>2)*4096+((i)&3)*1024)); vhi[i]=vtr(vp_+(((i)>>2)*4096+((i)&3)*1024+512)); }while(0)
  #define KRD(G,j) do{ if(G){ kload2(kf,kp0+sl_next,j); SBAR(); } }while(0)
  #define STEP(C0,C1,P0,P1,t,GK,GV,GL) do{ SBAR(); \
    const lds_cptr vp_=vp0+sl_prev; \
    VRD(0); SBAR(); float sacc=(P0[0]+P0[1]); \
    GAPA(C0=__builtin_amdgcn_mfma_f32_32x32x16_bf16(kf[0],qr[0],negm,0,0,0), P0[2],P0[3],P0[4],P0[5],     pw0[0]=PKW(P0,0), pw0[1]=PKW(P0,2), pw0); \
    VRD(4); SBAR(); GAPA(C1=__builtin_amdgcn_mfma_f32_32x32x16_bf16(kf[1],qr[0],negm,0,0,0), P0[6],P0[7],P0[8],P0[9],     pw0[2]=PKW(P0,4), pw0[3]=PKW(P0,6), pw0); \
    VRD(1); SBAR(); GAPA(C0=__builtin_amdgcn_mfma_f32_32x32x16_bf16(kf[2],qr[1],C0,0,0,0),   P0[10],P0[11],P0[12],P0[13], pw1[0]=PKW(P0,8), pw1[1]=PKW(P0,10), pw1); \
    VRD(5); SBAR(); GAPA(C1=__builtin_amdgcn_mfma_f32_32x32x16_bf16(kf[3],qr[1],C1,0,0,0),   P0[14],P0[15],P1[0],P1[1],   pw1[2]=PKW(P0,12),pw1[3]=PKW(P0,14), pw1); \
    VRD(2); SBAR(); GAPA(C0=__builtin_amdgcn_mfma_f32_32x32x16_bf16(kf[4],qr[2],C0,0,0,0),   P1[2],P1[3],P1[4],P1[5],     pw2[0]=PKW(P1,0), pw2[1]=PKW(P1,2), pw2); \
    VRD(6); SBAR(); GAPA(C1=__builtin_amdgcn_mfma_f32_32x32x16_bf16(kf[5],qr[2],C1,0,0,0),   P1[6],P1[7],P1[8],P1[9],     pw2[2]=PKW(P1,4), pw2[3]=PKW(P1,6), pw2); \
    VRD(3); SBAR(); GAPA(C0=__builtin_amdgcn_mfma_f32_32x32x16_bf16(kf[6],qr[3],C0,0,0,0),   P1[10],P1[11],P1[12],P1[13], pw3[0]=PKW(P1,8), pw3[1]=PKW(P1,10), pw3); \
    VRD(7); SBAR(); GAPA(C1=__builtin_amdgcn_mfma_f32_32x32x16_bf16(kf[7],qr[3],C1,0,0,0),   P1[14],P1[15],0.f,0.f,       pw3[2]=PKW(P1,12),pw3[3]=PKW(P1,14), pw3); \
    l_reg+=sacc; \
    if(GK){DMA_K((t)+3,sl_cur);} if(GV){DMA_V((t)+1,sl_next);} \
    CMASK(C0,C1,t); \
    { float a=MX3(C0[0],C0[1],C1[0]),b=MX3(C0[2],C0[3],C1[1]); a=MX3(a,C1[2],C1[3]); \
      _Pragma("unroll") for(int r=4;r<16;r+=4){a=MX3(a,C0[r],C0[r+1]);b=MX3(b,C0[r+2],C0[r+3]);a=MX3(a,C1[r],C1[r+1]);b=MX3(b,C1[r+2],C1[r+3]);} \
      float rm=__builtin_fmaxf(a,b); { auto rr=__builtin_amdgcn_permlane32_swap(__float_as_uint(rm),__float_as_uint(rm),false,false); rm=__builtin_fmaxf(__uint_as_float(rr[0]),__uint_as_float(rr[1])); } \
      resc=false;                                              \
      if(__builtin_expect(__any(rm>(float)THRL),0)){ const float dl=__builtin_fmaxf(rm,0.f); mhat+=dl; \
        _Pragma("unroll") for(int r=0;r<16;++r){C0[r]-=dl;C1[r]-=dl;} \
        _Pragma("unroll") for(int r=0;r<16;++r)negm[r]=-mhat; asm volatile("":"+v"(negm)); \
        const float f=__builtin_amdgcn_exp2f(-dl); l_reg*=f; if(hi==0)wsf[r32]=f; resc=true; } } \
    SBAR(); \
    GAPB(o[0]=__builtin_amdgcn_mfma_f32_32x32x16_bf16(PAF(0),VFR(0),o[0],0,0,0), C0,0); \
    GAPB(o[1]=__builtin_amdgcn_mfma_f32_32x32x16_bf16(PAF(0),VFR(4),o[1],0,0,0), C0,4); \
    KRD(GL,0); GAPB(o[0]=__builtin_amdgcn_mfma_f32_32x32x16_bf16(PAF(1),VFR(1),o[0],0,0,0), C0,8); \
    KRD(GL,1); GAPB(o[1]=__builtin_amdgcn_mfma_f32_32x32x16_bf16(PAF(1),VFR(5),o[1],0,0,0), C0,12); \
    KRD(GL,2); GAPB(o[0]=__builtin_amdgcn_mfma_f32_32x32x16_bf16(PAF(2),VFR(2),o[0],0,0,0), C1,0); \
    KRD(GL,3); GAPB(o[1]=__builtin_amdgcn_mfma_f32_32x32x16_bf16(PAF(2),VFR(6),o[1],0,0,0), C1,4); \
    GAPB(o[0]=__builtin_amdgcn_mfma_f32_32x32x16_bf16(PAF(3),VFR(3),o[0],0,0,0), C1,8); \
    GAPB(o[1]=__builtin_amdgcn_mfma_f32_32x32x16_bf16(PAF(3),VFR(7),o[1],0,0,0), C1,12); \
    }while(0)
  int t=1;
  for(;t+5<NT;t+=2){
    STEP(pB0,pB1,pA0,pA1,t,true,true,true);     WAIT_BAR(2); RESC(); ROT();
    STEP(pA0,pA1,pB0,pB1,t+1,true,true,true);   WAIT_BAR(2); RESC(); ROT();
  }
  #define ENDW(tt) do{ if((tt)+3<NT){WAIT_BAR(2);} else if((tt)+2<NT){WAIT_BAR(1);} else {WAIT_BAR(0);} }while(0)
  for(;t+1<NT;t+=2){
    STEP(pB0,pB1,pA0,pA1,t,(t+3<NT),(t+1<NT),(t+1<NT));       ENDW(t);   RESC(); ROT();
    STEP(pA0,pA1,pB0,pB1,t+1,(t+4<NT),(t+2<NT),(t+2<NT));     ENDW(t+1); RESC(); ROT();
  }
  STEP(pB0,pB1,pA0,pA1,NT-1,false,false,false); RESC();
  { float sacc=pB0[0]+pB0[1]; _Pragma("unroll") for(int r=2;r<16;++r)sacc+=pB0[r]; _Pragma("unroll") for(int r=0;r<16;++r)sacc+=pB1[r]; l_reg+=sacc;
    pw0=(u32x4){PKW(pB0,0),PKW(pB0,2),PKW(pB0,4),PKW(pB0,6)};pw1=(u32x4){PKW(pB0,8),PKW(pB0,10),PKW(pB0,12),PKW(pB0,14)};pw2=(u32x4){PKW(pB1,0),PKW(pB1,2),PKW(pB1,4),PKW(pB1,6)};pw3=(u32x4){PKW(pB1,8),PKW(pB1,10),PKW(pB1,12),PKW(pB1,14)};
    SBAR(); pv(o,vb0+sl_cur,PAF(0),PAF(1),PAF(2),PAF(3)); }
  #undef PKW
  #undef PAF
  #undef VFR
  #undef PIN
  #undef MX3
  #undef GAPA
  #undef GAPB
  #undef EX
  #undef VRD
  #undef KRD
  #undef STEP
  #undef ENDW
  {auto rr=__builtin_amdgcn_permlane32_swap(__float_as_uint(l_reg),__float_as_uint(l_reg),false,false);l_reg=__uint_as_float(rr[0])+__uint_as_float(rr[1]);}
  if(use_sink) l_reg+=__builtin_amdgcn_exp2f(fminf((whead?sink_l2b:sink_l2)-mhat,120.f));
  if(hi==0)wsf[32+r32]=l_reg;asm volatile("s_waitcnt lgkmcnt(0)":::"memory");
  float rli[16];
  #pragma unroll
  for(int r=0;r<16;++r)rli[r]=__builtin_amdgcn_rcpf(wsf[32+crow(r,hi)]);
  bf16*Ow=Ou+(long)(wrow*QBLK)*op+whead*D;
  { bf16*stg=(bf16*)(shm+LDS_OST)+wid*2048;
    #pragma unroll
    for(int r=0;r<16;++r){const int orow=crow(r,hi);
      #pragma unroll
      for(int d0=0;d0<2;++d0)stg[orow*64+d0*32+r32]=__float2bfloat16(o[d0][r]*rli[r]);}
    asm volatile("s_waitcnt lgkmcnt(0)":::"memory");
    #pragma unroll
    for(int i=0;i<4;++i){const int row=i*8+(lane>>3),ch=lane&7; const u32x4 v=*(const u32x4*)(stg+row*64+ch*8); ATTN_STORE16(Ow+(long)row*op+ch*8,v);} }
  asm volatile("s_waitcnt lgkmcnt(0)\n\ts_barrier":::"memory");
  #undef KROW
  #undef DMA_K
  #undef DMA_V
  #undef CMASK
  #undef START
  #undef RESC
  #undef ROT
}
#undef SBAR
#undef WAIT_BAR
}
namespace att128 {
using att64::bf16; using att64::bf16x8; using att64::s16x4; using att64::f32x16; using att64::u32x4; using att64::lds_cptr;
using att64::crow; using att64::glds16; using att64::cvtpk_s; using att64::kload8; using att64::kload2; using att64::vtr; using att64::rowmax; using att64::qkt; using att64::fadd_s; using att64::fsub_s;
typedef float f32x4v __attribute__((ext_vector_type(4)));
constexpr int D=64,NW=8,QBLK=32,KVBLK=64;
constexpr int NSLOT=3, SLOTB=8192;
constexpr int LDS_K=0, LDS_V=NSLOT*SLOTB, LDS_WS=LDS_V+2*NSLOT*SLOTB, LDS_O1=LDS_WS+NW*64*4, LDS_BYTES=LDS_O1+NW*8192;
#define SBAR() __builtin_amdgcn_sched_barrier(0)
#define WAIT_BAR(N) asm volatile("s_waitcnt vmcnt(" #N ") lgkmcnt(0)\n\ts_barrier":::"memory")
__device__ __forceinline__ void pv4(f32x16*o,int vb,bf16x8 pa0,bf16x8 pa1,bf16x8 pa2,bf16x8 pa3){
  #pragma unroll
  for(int d0=0;d0<4;++d0){s16x4 lo[4],hi[4];
    #pragma unroll
    for(int ks=0;ks<4;++ks){
      asm volatile("ds_read_b64_tr_b16 %0,%1 offset:%c2":"=&v"(lo[ks]):"v"(vb),"i"(d0*4096+ks*1024):"memory");
      asm volatile("ds_read_b64_tr_b16 %0,%1 offset:%c2":"=&v"(hi[ks]):"v"(vb),"i"(d0*4096+ks*1024+512):"memory");}
    asm volatile("s_waitcnt lgkmcnt(0)":::"memory");SBAR();
    #define PK(k) (bf16x8){lo[k][0],lo[k][1],lo[k][2],lo[k][3],hi[k][0],hi[k][1],hi[k][2],hi[k][3]}
    o[d0]=__builtin_amdgcn_mfma_f32_32x32x16_bf16(pa0,PK(0),o[d0],0,0,0);
    o[d0]=__builtin_amdgcn_mfma_f32_32x32x16_bf16(pa1,PK(1),o[d0],0,0,0);
    o[d0]=__builtin_amdgcn_mfma_f32_32x32x16_bf16(pa2,PK(2),o[d0],0,0,0);
    o[d0]=__builtin_amdgcn_mfma_f32_32x32x16_bf16(pa3,PK(3),o[d0],0,0,0);
    #undef PK
  }
}
template<int THRL> __device__ __forceinline__ void attn_unit(const bf16*Qu,int qp,const bf16*__restrict__ Kh,const bf16*__restrict__ Vh,int kvp,int NT,int second,float lam,const GAS float*subg,float post,bf16*Ou,int op,char*shm,const int wave0){
  const int lane=lane_now(),r32=lane&31,hi=lane>>5; const int wid=wave0;
  const bf16*Qw=Qu+(long)(wid*QBLK)*qp;
  const unsigned lds0=(unsigned)(uintptr_t)shm;
  float*wsf=(float*)(shm+LDS_WS)+wid*64;
  const bf16*ksrc=Kh+(long)lane*kvp+wid*8;
  const bf16*vsrc=Vh+(long)(16*(wid&3)+(lane>>2))*kvp+(wid>>2)*32+(lane&3)*8;
  const unsigned kdst=lds0+LDS_K+wid*1024, vdst=lds0+LDS_V+wid*1024;
  #define DMA_K(t,slot) glds16(ksrc+(long)((t)*KVBLK)*kvp,(unsigned)__builtin_amdgcn_readfirstlane(kdst+(slot)))
  #define DMA_V(t,slot) do{ glds16(vsrc+(long)((t)*KVBLK)*kvp,(unsigned)__builtin_amdgcn_readfirstlane(vdst+2*(slot))); glds16(vsrc+(long)((t)*KVBLK)*kvp+64,(unsigned)__builtin_amdgcn_readfirstlane(vdst+2*(slot)+8192)); }while(0)
  const int vb0=(int)(lds0+LDS_V)+((lane>>4)&1)*32+(lane&3)*8+(4*hi+((lane&15)>>2))*64;
  const char*Kbase=shm+LDS_K; bf16x8 kf[8];
  const lds_cptr shm3=(lds_cptr)shm; const lds_cptr kp0=shm3+LDS_K+hi*1024+r32*16; const lds_cptr vp0=shm3+LDS_V+((lane>>4)&1)*32+(lane&3)*8+(4*hi+((lane&15)>>2))*64;
  DMA_K(0,0);DMA_V(0,0);DMA_K(1,SLOTB);
  bf16x8 qr[4];
  #pragma unroll
  for(int d0=0;d0<4;++d0)qr[d0]=*reinterpret_cast<const bf16x8*>(&Qw[(long)r32*qp+d0*16+hi*8]);
  float mhat=0.f,l_reg=0.f;f32x16 o[4];o[0]=f32x16{};o[1]=f32x16{};o[2]=f32x16{};o[3]=f32x16{};
  bool resc=false;
  #define START(P0,P1) do{ const float rm=rowmax(P0,P1); resc=false; \
    { const float dl=rm; mhat=fadd_s(mhat,dl); \
      _Pragma("unroll") for(int r=0;r<16;++r){P0[r]=fsub_s(P0[r],dl);P1[r]=fsub_s(P1[r],dl);} \
      } \
    _Pragma("unroll") for(int r=0;r<16;++r)P0[r]=__builtin_amdgcn_exp2f(P0[r]); }while(0)
  #define RESC() do{ if(resc){ asm volatile("s_waitcnt lgkmcnt(0)":::"memory"); \
      _Pragma("unroll") for(int r=0;r<16;++r){ const float f_=wsf[crow(r,hi)]; o[0][r]*=f_;o[1][r]*=f_;o[2][r]*=f_;o[3][r]*=f_; } } }while(0)
  f32x16 pA0,pA1,pB0,pB1;
  int sl_prev=0,sl_cur=0,sl_next=SLOTB;
  #define ROT() do{sl_prev=sl_cur;sl_cur=sl_next;sl_next=(sl_next==(NSLOT-1)*SLOTB)?0:sl_next+SLOTB;}while(0)
  DMA_K(2,2*SLOTB);
  WAIT_BAR(4);
  qkt(pA0,pA1,Kbase,qr,f32x16{},r32,hi);asm volatile("s_nop 15\n\ts_nop 7":"+v"(pA0),"+v"(pA1));
  START(pA0,pA1);
  _Pragma("unroll") for(int r=0;r<16;++r)pA1[r]=__builtin_amdgcn_exp2f(pA1[r]);
  WAIT_BAR(0);
  DMA_K(3,0);DMA_V(1,SLOTB);
  ROT();
  kload8(kf,kp0+sl_cur);
  WAIT_BAR(3);
  s16x4 vlo[16],vhi[16]; u32x4 pw0,pw1,pw2,pw3;
  #define PKW(P,B) cvtpk_s(P[B],P[B+1])
  #define PAF(k) __builtin_bit_cast(bf16x8,pw##k)
  #define VFR(i) (bf16x8){vlo[i][0],vlo[i][1],vlo[i][2],vlo[i][3],vhi[i][0],vhi[i][1],vhi[i][2],vhi[i][3]}
  #define PIN(x) asm volatile("":"+v"(x))
  #define MX3(a,b,c) __builtin_fmaxf(__builtin_fmaxf((a),(b)),(c))
  #define GAPA(MF,A0,A1,A2,A3,W0,W1,PW) do{ MF; sacc+=A0; sacc+=A1; sacc+=A2; sacc+=A3; PIN(sacc); W0; W1; PIN(PW); SBAR(); }while(0)
  #define EX(v) __builtin_amdgcn_exp2f(v)
  #define GAPB(MF,X,B) do{ MF; X[B]=EX(X[B]); X[B+1]=EX(X[B+1]); PIN(X); SBAR(); }while(0)
  #define VRD(n) do{ vlo[n]=vtr(vp_+(((n)&3)*4096+((n)>>2)*1024)); vhi[n]=vtr(vp_+(((n)&3)*4096+((n)>>2)*1024+512)); }while(0)
  #define KRD(G,j) do{ if(G){ kload2(kf,kp0+sl_next,j); SBAR(); } }while(0)
  #define PVM(n,k) o[(n)&3]=__builtin_amdgcn_mfma_f32_32x32x16_bf16(PAF(k),VFR(n),o[(n)&3],0,0,0)
  #define STEP(C0,C1,P0,P1,t,GK,GV,GL) do{ SBAR(); \
    const lds_cptr vp_=vp0+2*sl_prev; \
    VRD(0); SBAR(); float sacc=(P0[0]+P0[1]); \
    GAPA(C0=__builtin_amdgcn_mfma_f32_32x32x16_bf16(kf[0],qr[0],f32x16{},0,0,0), P0[2],P0[3],P0[4],P0[5],     pw0[0]=PKW(P0,0), pw0[1]=PKW(P0,2), pw0); \
    VRD(1); SBAR(); GAPA(C1=__builtin_amdgcn_mfma_f32_32x32x16_bf16(kf[1],qr[0],f32x16{},0,0,0), P0[6],P0[7],P0[8],P0[9],     pw0[2]=PKW(P0,4), pw0[3]=PKW(P0,6), pw0); \
    VRD(2); SBAR(); GAPA(C0=__builtin_amdgcn_mfma_f32_32x32x16_bf16(kf[2],qr[1],C0,0,0,0),   P0[10],P0[11],P0[12],P0[13], pw1[0]=PKW(P0,8), pw1[1]=PKW(P0,10), pw1); \
    VRD(3); SBAR(); GAPA(C1=__builtin_amdgcn_mfma_f32_32x32x16_bf16(kf[3],qr[1],C1,0,0,0),   P0[14],P0[15],P1[0],P1[1],   pw1[2]=PKW(P0,12),pw1[3]=PKW(P0,14), pw1); \
    VRD(4); SBAR(); GAPA(C0=__builtin_amdgcn_mfma_f32_32x32x16_bf16(kf[4],qr[2],C0,0,0,0),   P1[2],P1[3],P1[4],P1[5],     pw2[0]=PKW(P1,0), pw2[1]=PKW(P1,2), pw2); \
    VRD(5); SBAR(); GAPA(C1=__builtin_amdgcn_mfma_f32_32x32x16_bf16(kf[5],qr[2],C1,0,0,0),   P1[6],P1[7],P1[8],P1[9],     pw2[2]=PKW(P1,4), pw2[3]=PKW(P1,6), pw2); \
    VRD(6); SBAR(); GAPA(C0=__builtin_amdgcn_mfma_f32_32x32x16_bf16(kf[6],qr[3],C0,0,0,0),   P1[10],P1[11],P1[12],P1[13], pw3[0]=PKW(P1,8), pw3[1]=PKW(P1,10), pw3); \
    VRD(7); SBAR(); GAPA(C1=__builtin_amdgcn_mfma_f32_32x32x16_bf16(kf[7],qr[3],C1,0,0,0),   P1[14],P1[15],0.f,0.f,       pw3[2]=PKW(P1,12),pw3[3]=PKW(P1,14), pw3); \
    l_reg+=sacc; \
    if(GK){DMA_K((t)+3,sl_cur);} if(GV){DMA_V((t)+1,sl_next);} \
    { float a=MX3(C0[0],C0[1],C1[0]),b=MX3(C0[2],C0[3],C1[1]); a=MX3(a,C1[2],C1[3]); \
      _Pragma("unroll") for(int r=4;r<16;r+=4){a=MX3(a,C0[r],C0[r+1]);b=MX3(b,C0[r+2],C0[r+3]);a=MX3(a,C1[r],C1[r+1]);b=MX3(b,C1[r+2],C1[r+3]);} \
      float rm=__builtin_fmaxf(a,b); { auto rr=__builtin_amdgcn_permlane32_swap(__float_as_uint(rm),__float_as_uint(rm),false,false); rm=__builtin_fmaxf(__uint_as_float(rr[0]),__uint_as_float(rr[1])); } \
      rm-=mhat; \
      resc=false; \
      if(__builtin_expect(__any(rm>(float)THRL),0)){ const float dl=__builtin_fmaxf(rm,0.f); mhat+=dl; \
        const float f=__builtin_amdgcn_exp2f(-dl); l_reg*=f; if(hi==0)wsf[r32]=f; resc=true; } \
      _Pragma("unroll") for(int r=0;r<16;++r){C0[r]-=mhat;C1[r]-=mhat;} } \
    SBAR(); \
    VRD(8);  SBAR(); GAPB(PVM(0,0),C0,0); \
    VRD(9);  SBAR(); GAPB(PVM(1,0),C0,2); \
    VRD(10); SBAR(); GAPB(PVM(2,0),C0,4); \
    VRD(11); SBAR(); GAPB(PVM(3,0),C0,6); \
    VRD(12); SBAR(); GAPB(PVM(4,1),C0,8); \
    VRD(13); SBAR(); GAPB(PVM(5,1),C0,10); \
    VRD(14); SBAR(); GAPB(PVM(6,1),C0,12); \
    VRD(15); SBAR(); GAPB(PVM(7,1),C0,14); \
    KRD(GL,0); GAPB(PVM(8,2),C1,0); \
    KRD(GL,1); GAPB(PVM(9,2),C1,2); \
    KRD(GL,2); GAPB(PVM(10,2),C1,4); \
    KRD(GL,3); GAPB(PVM(11,2),C1,6); \
    GAPB(PVM(12,3),C1,8); \
    GAPB(PVM(13,3),C1,10); \
    GAPB(PVM(14,3),C1,12); \
    GAPB(PVM(15,3),C1,14); \
    }while(0)
  int t=1;
  for(;t+5<NT;t+=2){
    STEP(pB0,pB1,pA0,pA1,t,true,true,true);     WAIT_BAR(3); RESC(); ROT();
    STEP(pA0,pA1,pB0,pB1,t+1,true,true,true);   WAIT_BAR(3); RESC(); ROT();
  }
  #define ENDW(tt) do{ if((tt)+3<NT){WAIT_BAR(3);} else if((tt)+2<NT){WAIT_BAR(2);} else {WAIT_BAR(0);} }while(0)
  for(;t+1<NT;t+=2){
    STEP(pB0,pB1,pA0,pA1,t,(t+3<NT),(t+1<NT),(t+1<NT));       ENDW(t);   RESC(); ROT();
    STEP(pA0,pA1,pB0,pB1,t+1,(t+4<NT),(t+2<NT),(t+2<NT));     ENDW(t+1); RESC(); ROT();
  }
  STEP(pB0,pB1,pA0,pA1,NT-1,false,false,false); RESC();
  { float sacc=pB0[0]+pB0[1]; _Pragma("unroll") for(int r=2;r<16;++r)sacc+=pB0[r]; _Pragma("unroll") for(int r=0;r<16;++r)sacc+=pB1[r]; l_reg+=sacc;
    pw0=(u32x4){PKW(pB0,0),PKW(pB0,2),PKW(pB0,4),PKW(pB0,6)};pw1=(u32x4){PKW(pB0,8),PKW(pB0,10),PKW(pB0,12),PKW(pB0,14)};pw2=(u32x4){PKW(pB1,0),PKW(pB1,2),PKW(pB1,4),PKW(pB1,6)};pw3=(u32x4){PKW(pB1,8),PKW(pB1,10),PKW(pB1,12),PKW(pB1,14)};
    SBAR(); pv4(o,vb0+2*sl_cur,PAF(0),PAF(1),PAF(2),PAF(3)); }
  #undef PKW
  #undef PAF
  #undef VFR
  #undef MX3
  #undef GAPA
  #undef GAPB
  #undef EX
  #undef VRD
  #undef KRD
  #undef PVM
  #undef STEP
  #undef ENDW
  {auto rr=__builtin_amdgcn_permlane32_swap(__float_as_uint(l_reg),__float_as_uint(l_reg),false,false);l_reg=__uint_as_float(rr[0])+__uint_as_float(rr[1]);}
  if(hi==0)wsf[32+r32]=l_reg;asm volatile("s_waitcnt lgkmcnt(0)":::"memory");
  typedef unsigned u32x2v __attribute__((ext_vector_type(2)));
  u32x2v*sp=(u32x2v*)(shm+LDS_O1+wid*8192)+lane;
  if(!second){
    #pragma unroll
    for(int r=0;r<16;++r){ const float rl=__builtin_amdgcn_rcpf(wsf[32+crow(r,hi)]); const u32x2v v={cvtpk_s(o[0][r]*rl,o[1][r]*rl),cvtpk_s(o[2][r]*rl,o[3][r]*rl)}; sp[r*64]=v; }
  } else {
    float g4[4];
    #pragma unroll
    for(int d0=0;d0<4;++d0)g4[d0]=subg[d0*32+r32]*post;
    #pragma unroll
    for(int r=0;r<16;++r){ const float rl=__builtin_amdgcn_rcpf(wsf[32+crow(r,hi)])*lam; const u32x2v av=sp[r*64];
      const float a0=__uint_as_float(av[0]<<16),a1=__uint_as_float(av[0]&0xffff0000u),a2=__uint_as_float(av[1]<<16),a3=__uint_as_float(av[1]&0xffff0000u);
      float v0=a0-o[0][r]*rl,v1=a1-o[1][r]*rl,v2=a2-o[2][r]*rl,v3=a3-o[3][r]*rl; float ss=(v0*v0+v1*v1)+(v2*v2+v3*v3);
      ss+=__shfl_xor(ss,1);ss+=__shfl_xor(ss,2);ss+=__shfl_xor(ss,4);ss+=__shfl_xor(ss,8);ss+=__shfl_xor(ss,16);
      const float rn=__builtin_amdgcn_rsqf(ss*(1.0f/128.0f)+1e-6f);
      o[0][r]=v0*rn*g4[0];o[1][r]=v1*rn*g4[1];o[2][r]=v2*rn*g4[2];o[3][r]=v3*rn*g4[3]; }
    bf16*Ow=Ou+(long)(wid*QBLK)*op;
    bf16*stg=(bf16*)(shm+LDS_O1+wid*8192);
    asm volatile("s_waitcnt lgkmcnt(0)":::"memory");
    #pragma unroll
    for(int r=0;r<16;++r){const int orow=crow(r,hi);
      #pragma unroll
      for(int d0=0;d0<4;++d0)stg[orow*128+d0*32+r32]=__float2bfloat16(o[d0][r]);}
    asm volatile("s_waitcnt lgkmcnt(0)":::"memory");
    #pragma unroll
    for(int i=0;i<8;++i){const int row=i*4+(lane>>4),ch=lane&15; const u32x4 v=*(const u32x4*)(stg+row*128+ch*8); ATTN_STORE16(Ow+(long)row*op+ch*8,v);}
  }
  asm volatile("s_waitcnt lgkmcnt(0)\n\ts_barrier":::"memory");
  #undef PIN
  #undef DMA_K
  #undef DMA_V
  #undef START
  #undef RESC
  #undef ROT
}
#undef SBAR
#undef WAIT_BAR
}

typedef unsigned short bf16;
typedef float f32x4 __attribute__((ext_vector_type(4)));
typedef unsigned u32x4 __attribute__((ext_vector_type(4)));
typedef unsigned u32x2 __attribute__((ext_vector_type(2)));
constexpr int D = 1024, NBATCH = 4, SEQ = 4096, CTXL = 256, DEPTH = 2;
constexpr int MLAT = NBATCH * SEQ, MCTX = NBATCH * CTXL, MTOT = MLAT + MCTX;
constexpr int KVR = SEQ + CTXL;
constexpr int NIN = 6144, NE = 32, TOPK = 4, NWAVES = 8;
constexpr int MAXTILES = 304;
constexpr float EPS = 1e-6f;

constexpr size_t al256(size_t x) { return (x + 255) / 256 * 256; }
constexpr size_t WS_CTL = 0, CTL_BYTES = 1u << 20;
constexpr size_t WS_MOD = WS_CTL + CTL_BYTES;
constexpr size_t WS_ROPEC = WS_MOD + al256((size_t)DEPTH * 5 * NIN * 4);
constexpr size_t WS_ROPES = WS_ROPEC + 4096;
constexpr size_t WS_LAM = WS_ROPES + 4096;
constexpr size_t WS_PV = WS_LAM + 256;
constexpr size_t WS_WIN = WS_PV + (size_t)DEPTH * 5 * 4 * D * 4;
constexpr size_t WS_WB = WS_WIN + (size_t)DEPTH * NIN * D * 2;
constexpr size_t WS_WO = WS_WB + (size_t)DEPTH * 3 * D * 512 * 2;
constexpr size_t WS_W1 = WS_WO + (size_t)DEPTH * D * D * 2;
constexpr size_t WS_W2 = WS_W1 + (size_t)DEPTH * NE * 2048 * D * 2;
constexpr size_t WS_X = WS_W2 + (size_t)DEPTH * NE * D * D * 2;
constexpr size_t WS_H = WS_X + (size_t)MTOT * D * 4;
constexpr size_t WS_QA = WS_H + (size_t)MTOT * D * 2;
constexpr size_t WS_QB = WS_QA + (size_t)MTOT * 512 * 2;
constexpr size_t WS_QC = WS_QB + (size_t)MTOT * 512 * 2;
constexpr size_t WS_KA = WS_QC + (size_t)MTOT * 512 * 2;
constexpr size_t WS_VA = WS_KA + (size_t)NBATCH * KVR * 512 * 2;
constexpr size_t WS_KB = WS_VA + (size_t)NBATCH * KVR * 512 * 2;
constexpr size_t WS_VB = WS_KB + (size_t)NBATCH * KVR * 128 * 2;
constexpr size_t WS_KC = WS_VB + (size_t)NBATCH * KVR * 128 * 2;
constexpr size_t WS_VC = WS_KC + (size_t)NBATCH * KVR * 128 * 2;
constexpr size_t WS_GT = WS_VC + (size_t)NBATCH * KVR * 128 * 2;
constexpr size_t WS_YS = WS_GT + (size_t)MTOT * 3072 * 2;
constexpr size_t WS_TMP = WS_YS + (size_t)3 * MTOT * 512 * 2;
constexpr size_t WS_MG = WS_TMP + (size_t)MTOT * D * 4;
constexpr size_t WS_Y = WS_MG + (size_t)MTOT * D * 2;
constexpr size_t WS_H2 = WS_Y + (size_t)MTOT * D * 4;
constexpr size_t WS_SE = WS_H2 + (size_t)MTOT * D * 2;
constexpr size_t WS_SR = WS_SE + (size_t)MTOT * 4 * 4;
constexpr size_t WS_SW = WS_SR + (size_t)MTOT * 4 * 4;
constexpr size_t WS_LIST = WS_SW + (size_t)MTOT * 4 * 4;
constexpr size_t WS_ACT = WS_LIST + (size_t)NE * MTOT * 4;
constexpr size_t WS_YS2 = WS_ACT + (size_t)MAXTILES * 256 * D * 2;
constexpr size_t WS_EX = WS_YS2 + (size_t)MAXTILES * 256 * D * 2;
constexpr size_t WS_END = WS_EX + (size_t)DEPTH * 256 * 131072;
static_assert(WS_WIN % 256 == 0 && WS_X % 256 == 0 && WS_SE % 256 == 0 && WS_ACT % 256 == 0, "alignment");

constexpr int CW_BAR = 4096;
constexpr int CW_Q = 16384;
constexpr int CW_CNT = 8192;

constexpr int RING_BYTES = 141312, MISC_OFF = RING_BYTES, LDS_BYTES = MISC_OFF + 8192;
constexpr int MW_Q = 12; constexpr int MW_BAR = 0, MW_TB = 16, MW_CNT = 64, MW_HIST = 128, MW_BASE = 160, MW_PT = 192, MW_SLOT = 256;

#define LDS_WAIT() asm volatile("s_waitcnt lgkmcnt(0)" ::: "memory")
#define VM_WAIT() asm volatile("s_waitcnt vmcnt(0)" ::: "memory")
__device__ __forceinline__ unsigned f2bf(float f) { unsigned u = __builtin_bit_cast(unsigned, f); return (u + 0x7fffu + ((u >> 16) & 1u)) >> 16; }
typedef float f32x2_t __attribute__((ext_vector_type(2))); typedef __bf16 bf16x2_t __attribute__((ext_vector_type(2)));
__device__ __forceinline__ unsigned pk2(float lo, float hi) { const f32x2_t v = {lo, hi}; const bf16x2_t b = __builtin_convertvector(v, bf16x2_t); return __builtin_bit_cast(unsigned, b); }
__device__ __forceinline__ unsigned pk4f8(float a, float b, float c, float d) {
    int r = __builtin_amdgcn_cvt_pk_fp8_f32(a, b, 0, false); r = __builtin_amdgcn_cvt_pk_fp8_f32(c, d, r, true); return (unsigned)r; }
constexpr float W8_SCALE = 64.0f, W8_INV = 1.0f / 64.0f;
__device__ __forceinline__ float bflo(unsigned w) { return __builtin_bit_cast(float, w << 16); }
__device__ __forceinline__ float bfhi(unsigned w) { return __builtin_bit_cast(float, w & 0xffff0000u); }
template <int CTRL> __device__ __forceinline__ float dppf(float v) { return __builtin_bit_cast(float, __builtin_amdgcn_update_dpp(0, __builtin_bit_cast(int, v), CTRL, 0xf, 0xf, true)); }
template <int CTRL> __device__ __forceinline__ int dppi(int v) { return __builtin_amdgcn_update_dpp(0, v, CTRL, 0xf, 0xf, true); }
__device__ __forceinline__ float rdl(float v, int l) { return __builtin_bit_cast(float, __builtin_amdgcn_readlane(__builtin_bit_cast(int, v), l)); }
__device__ __forceinline__ float wave_sum(float v) {
    v += dppf<0xB1>(v); v += dppf<0x4E>(v); v += dppf<0x141>(v); v += dppf<0x140>(v);
    return (rdl(v, 0) + rdl(v, 16)) + (rdl(v, 32) + rdl(v, 48));
}
__device__ __forceinline__ float sigmoid255_(float x) { return __builtin_amdgcn_rcpf(__builtin_fmaf(__builtin_amdgcn_exp2f(-1.4426950408889634f * x), 1.0f / 255.0f, 1.0f / 255.0f)); }
__device__ __forceinline__ float sigmoidf_(float x) { return __builtin_amdgcn_rcpf(1.0f + __builtin_amdgcn_exp2f(-1.4426950408889634f * x)); }

__device__ __forceinline__ unsigned char* ldp(volatile LAS unsigned* MISC, int i) {
    const unsigned lo = (unsigned)__builtin_amdgcn_readfirstlane((int)MISC[MW_PT + 2 * i]), hi = (unsigned)__builtin_amdgcn_readfirstlane((int)MISC[MW_PT + 2 * i + 1]);
    return (unsigned char*)(((unsigned long long)hi << 32) | lo);
}
typedef const GAS float* gcfp; typedef GAS float* gfp; typedef const GAS unsigned short* gcbp; typedef GAS unsigned short* gbp;
#define INP(i) ((const GAS float*)ldp(MISC, (i)))
#define WSP(T, off) ((GAS T*)(ldp(MISC, 21) + (off)))
#define XB_TMO      128
#define XB_XCNT(j)  (256  + 64 * (j))
#define XB_XSUB(j)  (1280 + 64 * (j))
#define XB_XGEN(j)  (2304 + 64 * (j))
#define XB_TOP      3328
#define XB_TOPGEN   3392
#define XCD_BAR_WORDS 3456
#define XB_SPIN_CAP (1u << 18)

__device__ __forceinline__ unsigned xb_ld(unsigned* p)              { return __hip_atomic_load(p, __ATOMIC_RELAXED, __HIP_MEMORY_SCOPE_AGENT); }
__device__ __forceinline__ unsigned xb_add(unsigned* p, unsigned v) { return __hip_atomic_fetch_add(p, v, __ATOMIC_RELAXED, __HIP_MEMORY_SCOPE_AGENT); }
__device__ __forceinline__ unsigned xb_xcc_id() { return (unsigned)__builtin_amdgcn_s_getreg((3 << 11) | 20) & 0xFu; }
#define XB_SPIN(cond, bar) do { unsigned _sp = 0; while (cond) { __builtin_amdgcn_s_sleep(1); \
    if ((++_sp & 255u) == 0u) { if (xb_ld(&(bar)[XB_TMO])) break; if (_sp > XB_SPIN_CAP) { atomicAdd(&(bar)[XB_TMO], 1u); break; } } } } while (0)

struct XcdBarrier {
    unsigned* bar; unsigned x;
    volatile LAS unsigned* st;
};

__device__ __forceinline__ XcdBarrier xcd_barrier_post(unsigned* bar, volatile LAS unsigned* st) {
    XcdBarrier b; b.bar = bar; b.x = xb_xcc_id(); b.st = st;
    if (threadIdx.x == 0) (void)xb_add(&bar[XB_XCNT(b.x)], 1u);
    return b;
}
__device__ __forceinline__ void xcd_barrier_complete(unsigned* bar, unsigned x, unsigned& nloc, unsigned& nx) {
    const unsigned G = gridDim.x * gridDim.y * gridDim.z;
    unsigned sum, cnt, mine, sp = 0u;
    for (;;) {
        sum = 0u; cnt = 0u; mine = 0u;
#pragma unroll
        for (unsigned j = 0; j < 16; ++j) { const unsigned c = xb_ld(&bar[XB_XCNT(j)]); sum += c; cnt += (c > 0u) ? 1u : 0u; mine = (j == x) ? c : mine; }
        if (sum == G) break;
        __builtin_amdgcn_s_sleep(1);
        if ((++sp & 255u) == 0u) { if (xb_ld(&bar[XB_TMO])) break; if (sp > XB_SPIN_CAP) { atomicAdd(&bar[XB_TMO], 1u); break; } }
    }
    nloc = mine > 0u ? mine : 1u; nx = cnt > 0u ? cnt : 1u;
}

__device__ __forceinline__ void xcd_barrier(const XcdBarrier& b, const int tid_now) {
    asm volatile("s_waitcnt vmcnt(0)" ::: "memory");
    __syncthreads();
    if (tid_now == 0) {
        unsigned long long bp_ = (unsigned long long)b.bar; asm volatile("" : "+s"(bp_)); unsigned* bar = (unsigned*)bp_;
        unsigned bx_ = b.x; asm volatile("" : "+s"(bx_));
        __builtin_amdgcn_s_waitcnt(0);
        unsigned nloc = b.st[0], nx = b.st[1];
        if (nloc == 0u) { xcd_barrier_complete(bar, bx_, nloc, nx); b.st[0] = nloc; b.st[1] = nx; }
        const unsigned old = xb_add(&bar[XB_XSUB(bx_)], 1u);
        const unsigned gen = old / nloc;
        if (old + 1u == (gen + 1u) * nloc) {
            __builtin_amdgcn_fence(__ATOMIC_RELEASE, "agent");
            asm volatile("s_waitcnt vmcnt(0)" ::: "memory");
            const unsigned og = xb_add(&bar[XB_TOP], 1u);
            const unsigned tg = og / nx;
            if (og + 1u == (tg + 1u) * nx) xb_add(&bar[XB_TOPGEN], 1u);
            else XB_SPIN(xb_ld(&bar[XB_TOPGEN]) == tg, bar);
            __builtin_amdgcn_fence(__ATOMIC_ACQUIRE, "agent");
            xb_add(&bar[XB_XGEN(bx_)], 1u);
            asm volatile("s_waitcnt vmcnt(0)" ::: "memory");
        } else {
            XB_SPIN(xb_ld(&bar[XB_XGEN(bx_)]) == gen, bar);
            __builtin_amdgcn_fence(__ATOMIC_ACQUIRE, "agent");
            asm volatile("s_waitcnt vmcnt(0)" ::: "memory");
        }
    }
    __syncthreads();
}

using pg8::Unit;
__host__ __device__ __forceinline__ int in_src_col(int nbd) {
    const int pn = nbd >> 3, blk = nbd & 7, bj = blk >> 2, wc = blk & 3;
    if (pn <= 8) { const int hs = pn * 4 + wc; int base;
        if (hs < 8) base = hs * 64; else if (hs < 16) base = 512 + (hs - 8) * 64; else if (hs < 24) base = 1536 + (hs - 16) * 64;
        else if (hs < 32) base = 2304 + (hs - 24) * 64; else if (hs < 34) base = 2048 + (hs - 32) * 64; else base = 2816 + (hs - 34) * 64;
        return base + 32 * bj; }
    if (pn <= 10) return 1024 + (pn - 9) * 256 + blk * 32;
    if (pn == 11) return blk < 4 ? 2176 + blk * 32 : 2944 + (blk - 4) * 32;
    return 3072 + (pn - 12) * 256 + blk * 32;
}
struct EpiInproj {
    static constexpr bool PERM = false;
    volatile LAS unsigned* MISC; int l;
    __device__ __forceinline__ void operator()(const f32x4 (&acc)[2][2][4][2], const Unit& u, int wr, int wc, int fr, int fq) const {
        auto QA = WSP(bf16, WS_QA); auto QB = WSP(bf16, WS_QB); auto QC = WSP(bf16, WS_QC); auto KA = WSP(bf16, WS_KA); auto VA = WSP(bf16, WS_VA);
        auto KB = WSP(bf16, WS_KB); auto VB = WSP(bf16, WS_VB); auto KC = WSP(bf16, WS_KC); auto VC = WSP(bf16, WS_VC); auto GT = WSP(bf16, WS_GT);
        auto ropec = WSP(float, WS_ROPEC); auto ropes = WSP(float, WS_ROPES); auto qkg = INP(10) + l * 128;
        const int pn = u.pn; const bool ctx = u.pm >= (MLAT / 256);
#pragma unroll
        for (int ai = 0; ai < 2; ++ai)
#pragma unroll
            for (int m = 0; m < 4; ++m) {
                const int r = u.pm * 256 + ai * 128 + wr * 64 + m * 16 + fr;
                int kvrow, t = 0;
                if (!ctx) { t = r & (SEQ - 1); kvrow = (r >> 12) * KVR + t; } else { const int rr = r - MLAT; kvrow = (rr >> 8) * KVR + SEQ + (rr & 255); }
                if (pn <= 8) {
                    float v[2][2][4];
#pragma unroll
                    for (int bj = 0; bj < 2; ++bj)
#pragma unroll
                        for (int n = 0; n < 2; ++n)
#pragma unroll
                            for (int j = 0; j < 4; ++j) v[bj][n][j] = acc[ai][bj][m][n][j];
                    const int hs = pn * 4 + wc;
                    const bool isbq = (pn == 4 || pn == 5), isbk = (pn == 8 && wc < 2);
                    if (isbq || isbk) {
                        float ss = 0.f;
#pragma unroll
                        for (int bj = 0; bj < 2; ++bj)
#pragma unroll
                            for (int n = 0; n < 2; ++n)
#pragma unroll
                                for (int j = 0; j < 4; ++j) ss += v[bj][n][j] * v[bj][n][j];
                        ss += __shfl_xor(ss, 16); ss += __shfl_xor(ss, 32);
                        const float rn = __builtin_amdgcn_rsqf(ss * (1.0f / 64.0f) + EPS);
                        gcfp g = qkg + (isbk ? 64 : 0);
#pragma unroll
                        for (int bj = 0; bj < 2; ++bj)
#pragma unroll
                            for (int n = 0; n < 2; ++n) { const f32x4 gv = *(const GAS f32x4*)(g + 32 * bj + 16 * n + 4 * fq);
#pragma unroll
                                for (int j = 0; j < 4; ++j) v[bj][n][j] = v[bj][n][j] * rn * gv[j]; }
                    }
                    if (!ctx) {
#pragma unroll
                        for (int bj = 0; bj < 2; ++bj) { const int pos = bj ? (t & 63) : (t >> 6);
                            const f32x4 cs = *(const GAS f32x4*)(ropec + pos * 16 + 4 * fq), sn = *(const GAS f32x4*)(ropes + pos * 16 + 4 * fq);
#pragma unroll
                            for (int j = 0; j < 4; ++j) { const float x0 = v[bj][0][j], x1 = v[bj][1][j];
                                v[bj][0][j] = x0 * cs[j] - x1 * sn[j]; v[bj][1][j] = x1 * cs[j] + x0 * sn[j]; } }
                    }
                    if (isbq || pn == 6 || pn == 7 || (pn < 2 && !ctx)) {
#pragma unroll
                        for (int bj = 0; bj < 2; ++bj)
#pragma unroll
                            for (int n = 0; n < 2; ++n)
#pragma unroll
                                for (int j = 0; j < 4; ++j) v[bj][n][j] *= att64::C2; }
                    gbp dst;
                    if (pn < 2) dst = QA + (size_t)r * 512 + hs * 64;
                    else if (pn < 4) dst = KA + (size_t)kvrow * 512 + (hs - 8) * 64;
                    else if (pn < 6) dst = QB + (size_t)r * 512 + (hs - 16) * 64;
                    else if (pn < 8) dst = QC + (size_t)r * 512 + (hs - 24) * 64;
                    else if (wc < 2) dst = KB + (size_t)kvrow * 128 + wc * 64;
                    else dst = KC + (size_t)kvrow * 128 + (wc - 2) * 64;
#pragma unroll
                    for (int bj = 0; bj < 2; ++bj) { u32x4 w; w.x = pk2(v[bj][0][0], v[bj][0][1]); w.y = pk2(v[bj][0][2], v[bj][0][3]); w.z = pk2(v[bj][1][0], v[bj][1][1]); w.w = pk2(v[bj][1][2], v[bj][1][3]);
                        *(GAS u32x4*)(dst + 32 * bj + 8 * fq) = w; }
                } else if (pn <= 11) {
#pragma unroll
                    for (int bj = 0; bj < 2; ++bj) { const int c = 128 * bj + 32 * wc + 8 * fq; const f32x4 x = acc[ai][bj][m][0], y = acc[ai][bj][m][1];
                            gbp dst = (pn < 11) ? VA + (size_t)kvrow * 512 + (pn - 9) * 256 + c : ((bj == 0) ? VB : VC) + (size_t)kvrow * 128 + (c & 127);
                            u32x4 w; w.x = pk2(x[0], x[1]); w.y = pk2(x[2], x[3]); w.z = pk2(y[0], y[1]); w.w = pk2(y[2], y[3]); *(GAS u32x4*)dst = w; }
                } else {
#pragma unroll
                    for (int bj = 0; bj < 2; ++bj) { const int c = 128 * bj + 32 * wc + 8 * fq; const f32x4 x = acc[ai][bj][m][0], y = acc[ai][bj][m][1];
                            u32x2 w = {0u, 0u};
#pragma unroll
                            for (int j = 0; j < 4; ++j) { w.x = __builtin_amdgcn_cvt_pk_u8_f32(sigmoid255_(x[j]), (unsigned)j, w.x); w.y = __builtin_amdgcn_cvt_pk_u8_f32(sigmoid255_(y[j]), (unsigned)j, w.y); }
                            *(GAS u32x2*)((GAS unsigned char*)GT + (size_t)r * 3072 + (pn - 12) * 256 + c) = w; }
                }
            }
    }
};

#if defined(EPIDUP_INPROJ)
namespace pg8 { template <> struct epi_dup<::EpiInproj> { static constexpr int v = 1; }; }
#endif
struct MergeOrder {
    int ntiles, G, vcu;
    __device__ __forceinline__ bool next(int i, Unit& u) const { const int rnd = i / 3, sub = i - rnd * 3; const int tl = rnd * G + vcu; if (tl >= ntiles) return false;
        u.pm = sub * (MTOT / 256) + (tl >> 2); u.pn = sub * 4 + (tl & 3); return true; }
    __device__ __forceinline__ unsigned a_row(const Unit&, int) const { return 0u; }
};
struct EpiMerge {
    static constexpr bool PERM = true;
    volatile LAS unsigned* MISC;
    __device__ __forceinline__ bool keep(const Unit& u) const { return (u.pn >> 2) < 2; }
    __device__ __forceinline__ void operator()(f32x4 (&acc)[2][2][4][2], const Unit& u, int wr, int wc, int fr, int fq) const {
        const auto GT = WSP(bf16, WS_GT); auto MG = WSP(bf16, WS_MG);
        const int sub = u.pn >> 2, pnr = u.pn & 3, pmr = u.pm - sub * (MTOT / 256);
        constexpr float GMIN = 1e-24f;
        const int subn = sub < 2 ? sub + 1 : sub;
        const GAS unsigned char* gbase = (const GAS unsigned char*)GT + ((size_t)pmr * 256 + wr * 64 + fr) * 3072 + pnr * 256 + wc * 32 + 8 * fq;
        u32x2 gw[2][4][2], gn[2][4][2];
#pragma unroll
        for (int ai = 0; ai < 2; ++ai)
#pragma unroll
            for (int m = 0; m < 4; ++m)
#pragma unroll
                for (int bj = 0; bj < 2; ++bj) { const GAS unsigned char* p = gbase + (size_t)(ai * 128 + m * 16) * 3072 + bj * 128;
                    gw[ai][m][bj] = *(const GAS u32x2*)(p + sub * 1024); gn[ai][m][bj] = *(const GAS u32x2*)(p + subn * 1024); }
        const float nmin = sub > 0 ? GMIN : 0.0f;
        const bool last = sub == 2;
#pragma unroll
        for (int ai = 0; ai < 2; ++ai)
#pragma unroll
            for (int m = 0; m < 4; ++m)
#pragma unroll
                for (int bj = 0; bj < 2; ++bj) {
                    const u32x2 a = gw[ai][m][bj], b = gn[ai][m][bj];
                    float g[8] = {(float)(a.x & 0xffu), (float)((a.x >> 8) & 0xffu), (float)((a.x >> 16) & 0xffu), (float)(a.x >> 24), (float)(a.y & 0xffu), (float)((a.y >> 8) & 0xffu), (float)((a.y >> 16) & 0xffu), (float)(a.y >> 24)};
                    const float d[8] = {(float)(b.x & 0xffu), (float)((b.x >> 8) & 0xffu), (float)((b.x >> 16) & 0xffu), (float)(b.x >> 24), (float)(b.y & 0xffu), (float)((b.y >> 8) & 0xffu), (float)((b.y >> 16) & 0xffu), (float)(b.y >> 24)};
#pragma unroll
                    for (int k = 0; k < 8; ++k) g[k] = fmaxf(g[k], nmin) * (last ? (1.0f / 255.0f) : __builtin_amdgcn_rcpf(fmaxf(d[k], GMIN)));
                    f32x4 v0 = acc[ai][bj][m][0], v1 = acc[ai][bj][m][1];
                    v0[0] *= g[0]; v0[1] *= g[1]; v0[2] *= g[2]; v0[3] *= g[3]; v1[0] *= g[4]; v1[1] *= g[5]; v1[2] *= g[6]; v1[3] *= g[7];
                    acc[ai][bj][m][0] = v0; acc[ai][bj][m][1] = v1; }
        if (last) {
#pragma unroll
            for (int ai = 0; ai < 2; ++ai)
#pragma unroll
                for (int m = 0; m < 4; ++m) { const size_t row = (size_t)pmr * 256 + ai * 128 + wr * 64 + m * 16 + fr;
#pragma unroll
                    for (int bj = 0; bj < 2; ++bj) { const int col = pnr * 256 + bj * 128 + wc * 32 + 8 * fq; const f32x4 v0 = acc[ai][bj][m][0], v1 = acc[ai][bj][m][1];
                        u32x4 w; w.x = pk2(v0[0], v0[1]); w.y = pk2(v0[2], v0[3]); w.z = pk2(v1[0], v1[1]); w.w = pk2(v1[2], v1[3]); *(GAS u32x4*)(MG + row * 1024 + col) = w; } }
        }
    }
};
namespace pg8 { template <> struct epi_chain<::EpiMerge> { static constexpr bool v = true; }; }
struct EpiOut {
    static constexpr bool PERM = true;
    volatile LAS unsigned* MISC;
    __device__ __forceinline__ void operator()(const f32x4 (&acc)[2][2][4][2], const Unit& u, int wr, int wc, int fr, int fq) const {
        auto Y = WSP(bf16, WS_Y);
#pragma unroll
        for (int ai = 0; ai < 2; ++ai)
#pragma unroll
            for (int m = 0; m < 4; ++m) { gbp rowp = Y + ((size_t)u.pm * 256 + ai * 128 + wr * 64 + m * 16 + fr) * 1024 + u.pn * 256 + wc * 32 + 8 * fq;
#pragma unroll
                for (int bj = 0; bj < 2; ++bj) { const f32x4 v0 = acc[ai][bj][m][0], v1 = acc[ai][bj][m][1];
                    u32x4 w; w.x = pk2(v0[0], v0[1]); w.y = pk2(v0[2], v0[3]); w.z = pk2(v1[0], v1[1]); w.w = pk2(v1[2], v1[3]); *(GAS u32x4*)(rowp + bj * 128) = w; } }
    }
};
template <int NP> struct MoeOrder {
    const LAS int* tb; const LAS int* cn; const GAS int* list; int G, bid, vcu, U, chunk, per;
    __device__ __forceinline__ void init(const LAS int* tb_, const LAS int* cn_, const GAS int* list_, int G_, int bid_) {
        tb = tb_; cn = cn_; list = list_; G = G_; bid = bid_; U = tb_[NE] * NP;
        if (G_ % 8 == 0) { per = G_ / 8; vcu = (bid_ % 8) * per + bid_ / 8; chunk = (U + 7) / 8; } else { per = G_; vcu = bid_; chunk = U; }
    }
    __device__ __forceinline__ bool next(int i, Unit& u) const {
        const int x = vcu / per, j = i * per + (vcu % per); if (j >= chunk) return false;
        const int id = x * chunk + j; if (id >= U) return false;
        const int T = id / NP, pnl = id - T * NP; int e = 0;
#pragma unroll
        for (int q = 1; q < NE; ++q) e += (T >= tb[q]) ? 1 : 0;
        e = __builtin_amdgcn_readfirstlane(e);
        u.pm = T; u.pn = e * NP + pnl; return true;
    }
    __device__ __forceinline__ unsigned a_row(const Unit& u, int r) const {
        const int e = u.pn / NP; int idx = (u.pm - tb[e]) * 256 + r; const int c = cn[e]; idx = idx < c ? idx : c - 1;
        return (unsigned)list[(size_t)e * MTOT + idx];
    }
};
template <bool F8> struct EpiSwiglu {
    static constexpr bool PERM = true;
    volatile LAS unsigned* MISC; int l;
    __device__ __forceinline__ void operator()(const f32x4 (&acc)[2][2][4][2], const Unit& u, int wr, int wc, int fr, int fq) const {
        auto ACT = WSP(bf16, WS_ACT); auto b1 = INP(17) + (size_t)l * NE * 2048;
        const int e = u.pn >> 3, pnl = u.pn & 7; const int col = pnl * 128 + wc * 32 + 8 * fq;
        gcfp bg = b1 + (size_t)e * 2048 + col; gcfp bu = bg + 1024;
        const f32x4 bg0 = *(const GAS f32x4*)bg, bg1 = *(const GAS f32x4*)(bg + 4), bu0 = *(const GAS f32x4*)bu, bu1 = *(const GAS f32x4*)(bu + 4);
#pragma unroll
        for (int ai = 0; ai < 2; ++ai)
#pragma unroll
            for (int m = 0; m < 4; ++m) { const size_t row = (size_t)u.pm * 256 + ai * 128 + wr * 64 + m * 16 + fr;
                float a[8];
#pragma unroll
                for (int n = 0; n < 2; ++n)
#pragma unroll
                    for (int j = 0; j < 4; ++j) { constexpr float SC = F8 ? W8_INV : 1.0f; float gt = acc[ai][0][m][n][j] * SC + (n ? bg1[j] : bg0[j]), up = acc[ai][1][m][n][j] * SC + (n ? bu1[j] : bu0[j]);
                        gt = fminf(gt, 7.0f); up = fminf(fmaxf(up, -7.0f), 7.0f);
                        a[n * 4 + j] = (up + 1.0f) * (gt * sigmoidf_(1.702f * gt)); }
                if constexpr (F8) { u32x2 w; w.x = pk4f8(a[0], a[1], a[2], a[3]); w.y = pk4f8(a[4], a[5], a[6], a[7]); *(GAS u32x2*)((GAS unsigned char*)ACT + row * 1024 + col) = w; }
                else { u32x4 w; w.x = pk2(a[0], a[1]); w.y = pk2(a[2], a[3]); w.z = pk2(a[4], a[5]); w.w = pk2(a[6], a[7]);
                *(GAS u32x4*)(ACT + row * 1024 + col) = w; } }
    }
};
#if defined(EPIDUP_MOE1)
namespace pg8 { template <> struct epi_dup<::EpiSwiglu<true>> { static constexpr int v = 1; }; }
#endif
template <bool F8> struct EpiMoe2 {
    static constexpr bool PERM = true;
    volatile LAS unsigned* MISC; int l;
    __device__ __forceinline__ void operator()(const f32x4 (&acc)[2][2][4][2], const Unit& u, int wr, int wc, int fr, int fq) const {
        auto YS2 = WSP(bf16, WS_YS2); auto b2 = INP(19) + (size_t)l * NE * D;
        const int e = u.pn >> 2, pnl = u.pn & 3;
#pragma unroll
        for (int bj = 0; bj < 2; ++bj) { const int col = pnl * 256 + bj * 128 + wc * 32 + 8 * fq;
            const f32x4 c0 = *(const GAS f32x4*)(b2 + (size_t)e * 1024 + col), c1 = *(const GAS f32x4*)(b2 + (size_t)e * 1024 + col + 4);
#pragma unroll
            for (int ai = 0; ai < 2; ++ai)
#pragma unroll
                for (int m = 0; m < 4; ++m) { const size_t row = (size_t)u.pm * 256 + ai * 128 + wr * 64 + m * 16 + fr;
                    constexpr float SC = F8 ? W8_INV : 1.0f; const f32x4 v0 = acc[ai][bj][m][0] * SC + c0, v1 = acc[ai][bj][m][1] * SC + c1;
                    u32x4 w; w.x = pk2(v0[0], v0[1]); w.y = pk2(v0[2], v0[3]); w.z = pk2(v1[0], v1[1]); w.w = pk2(v1[2], v1[3]);
                    *(GAS u32x4*)(YS2 + row * 1024 + col) = w; } }
    }
};

#if defined(EPIDUP_MOE2)
namespace pg8 { template <> struct epi_dup<::EpiMoe2<true>> { static constexpr int v = 1; }; }
#endif

struct Args { const float* in[20]; float* out; unsigned char* ws; int ph_lo, ph_hi; };

#ifndef MOE_F8_FROM
#define MOE_F8_FROM 0
#endif
__device__ __forceinline__ int sgpr_launder(int x) { asm volatile("" : "+s"(x)); return x; }
struct CvtItem { gcfp W; gbp WT; int N, k0, n0, Kd, rowd, f8; };
__device__ __forceinline__ void cvt_load(const CvtItem& I, int lane, float (&v)[32]) {
    const GAS char* base = (const GAS char*)(I.W + (size_t)I.k0 * I.N + I.n0);
    unsigned off = (unsigned)((lane >> 5) * I.N + (lane & 31)) * 4u; const unsigned step = (unsigned)I.N * 8u;
#pragma unroll
    for (int i = 0; i < 32; ++i) { v[i] = __builtin_nontemporal_load((const GAS float*)(base + off)); off += step; }
}
__device__ __forceinline__ void cvt_store(const CvtItem& I, int lane, const float (&v)[32], LAS float* scr) {
#pragma unroll
    for (int i = 0; i < 32; ++i) { const int kk = 2 * i + (lane >> 5); scr[kk * 33 + (lane & 31)] = v[i]; }
    LDS_WAIT(); asm volatile("" ::: "memory");
    const int c = lane & 7;
#pragma unroll
    for (int j = 0; j < 4; ++j) { const int n = (lane >> 3) + 8 * j; const LAS float* s = scr + (8 * c) * 33 + n;
        if (I.f8 & 1) { u32x2 o; o.x = pk4f8(s[0 * 33] * W8_SCALE, s[1 * 33] * W8_SCALE, s[2 * 33] * W8_SCALE, s[3 * 33] * W8_SCALE); o.y = pk4f8(s[4 * 33] * W8_SCALE, s[5 * 33] * W8_SCALE, s[6 * 33] * W8_SCALE, s[7 * 33] * W8_SCALE);
            __builtin_nontemporal_store(o, (GAS u32x2*)((GAS char*)I.WT + (size_t)I.rowd * I.Kd + I.k0 + (unsigned)(n * I.Kd + 8 * c))); }
        else { u32x4 o; o.x = pk2(s[0 * 33], s[1 * 33]); o.y = pk2(s[2 * 33], s[3 * 33]); o.z = pk2(s[4 * 33], s[5 * 33]); o.w = pk2(s[6 * 33], s[7 * 33]);
        const int nd = (I.f8 & 2) ? 16 * ((n >> 2) & 1) + 4 * (n >> 3) + (n & 3) : n;
        __builtin_nontemporal_store(o, (GAS u32x4*)((GAS char*)(I.WT + (size_t)I.rowd * I.Kd + I.k0) + (unsigned)(nd * I.Kd + 8 * c) * 2u)); } }
    LDS_WAIT(); asm volatile("" ::: "memory");
}

__device__ __forceinline__ void ld_row(gcfp p, int lane, f32x4 (&v)[4]) {
#pragma unroll
    for (int j = 0; j < 4; ++j) v[j] = *(const GAS f32x4*)(p + 4 * lane + 256 * j);
}
__device__ __forceinline__ void ld_row_bf(gcbp p, int lane, f32x4 (&v)[4]) {
#pragma unroll
    for (int j = 0; j < 4; ++j) { const u32x2 w = *(const GAS u32x2*)(p + 4 * lane + 256 * j); v[j] = (f32x4){bflo(w.x), bfhi(w.x), bflo(w.y), bfhi(w.y)}; }
}
__device__ __forceinline__ float sumsq_row(const f32x4 (&v)[4]) {
    float s = 0.f;
#pragma unroll
    for (int j = 0; j < 4; ++j) s += (v[j][0] * v[j][0] + v[j][1] * v[j][1]) + (v[j][2] * v[j][2] + v[j][3] * v[j][3]);
    return wave_sum(s);
}
template <bool F8 = false> __device__ __forceinline__ void norm_mod_row(const f32x4 (&x)[4], gcfp g, gcfp sc, gcfp sh, int lane, f32x4 (&h)[4], gbp dst) {
    const float rn = 1.0f / sqrtf(sumsq_row(x) * (1.0f / D) + EPS);
#pragma unroll
    for (int j = 0; j < 4; ++j) { const int c = 4 * lane + 256 * j; const f32x4 gv = *(const GAS f32x4*)(g + c), sv = *(const GAS f32x4*)(sc + c), hv = *(const GAS f32x4*)(sh + c);
        h[j] = (x[j] * rn) * gv * (1.0f + sv) + hv;
        if constexpr (F8) { *(GAS unsigned*)((GAS unsigned char*)dst + c) = pk4f8(h[j][0], h[j][1], h[j][2], h[j][3]); }
        else { u32x2 w; w.x = pk2(h[j][0], h[j][1]); w.y = pk2(h[j][2], h[j][3]); *(GAS u32x2*)(dst + c) = w; } }
}

constexpr int CVT_I_IN = 16 * 192, CVT_I_WB = 3 * 8 * 32, CVT_I_WO = 16 * 32, CVT_I_W1 = NE * 16 * 64, CVT_I_W2 = NE * 16 * 32, CVT_I_L = CVT_I_IN + CVT_I_WB + CVT_I_WO + CVT_I_W1 + CVT_I_W2;
constexpr int CVT_P0_END = CVT_I_IN + CVT_I_WB + CVT_I_WO, CVT_END = DEPTH * CVT_I_L, CVT_REST = CVT_END - CVT_P0_END;
constexpr int CVT_T1_END = CVT_P0_END + (CVT_REST * 21) / 100, CVT_T3_END = CVT_T1_END + (CVT_REST * 48) / 100;
static_assert(CVT_T3_END >= CVT_I_L, "layer 0's expert weights are converted before its expert GEMMs");
__device__ __forceinline__ void cvt_range(volatile LAS unsigned* MISC, LAS unsigned char* ldsl, int first, int last, int gw, int NGW, int wave, int lane) {
    auto w_in = INP(7); auto w_branch = INP(12); auto w_out = INP(13); auto w1 = INP(16); auto w2 = INP(18);
    auto WIN = WSP(bf16, WS_WIN); auto WB = WSP(bf16, WS_WB); auto WO = WSP(bf16, WS_WO); auto W1 = WSP(bf16, WS_W1); auto W2 = WSP(bf16, WS_W2);
    LAS float* scr = (LAS float*)(ldsl + wave * 16384);
    constexpr int I_IN = CVT_I_IN, I_WB = CVT_I_WB, I_WO = CVT_I_WO, I_W1 = CVT_I_W1, I_W2 = CVT_I_W2, I_L = CVT_I_L;
#define CVT_DECODE(it_, I_) do { const int l_ = (it_) / I_L; int r_ = (it_) - l_ * I_L; \
            if (r_ < I_IN) { const int kb = r_ / 192, nbd = r_ % 192; I_ = CvtItem{w_in + (size_t)l_ * D * NIN, WIN + (size_t)l_ * NIN * D, NIN, 64 * kb, in_src_col(nbd), D, 32 * nbd, (nbd >= 72) ? 2 : 0}; break; } r_ -= I_IN; \
            if (r_ < I_WB) { const int i = r_ / 256, rr = r_ % 256, kb = rr / 32, nb = rr % 32; I_ = CvtItem{w_branch + (size_t)(l_ * 3 + i) * 512 * D, WB + (size_t)(l_ * 3 + i) * D * 512, D, 64 * kb, 32 * nb, 512, 32 * nb, 0}; break; } r_ -= I_WB; \
            if (r_ < I_WO) { const int kb = r_ / 32, nb = r_ % 32; I_ = CvtItem{w_out + (size_t)l_ * D * D, WO + (size_t)l_ * D * D, D, 64 * kb, 32 * nb, D, 32 * nb, 0}; break; } r_ -= I_WO; \
            if (r_ < I_W1) { const int e = r_ / 1024, rr = r_ % 1024, kb = rr / 64, nbd = rr % 64; const int pn = nbd >> 3, blk = nbd & 7, bj = blk >> 2, q = blk & 3; \
                const bool f8_ = (l_ >= MOE_F8_FROM);     \
                I_ = CvtItem{w1 + (size_t)(l_ * NE + e) * D * 2048, f8_ ? (gbp)((GAS char*)(W1 + (size_t)l_ * NE * 2048 * D) + (size_t)e * 2048 * D) : W1 + (size_t)(l_ * NE + e) * 2048 * D, 2048, 64 * kb, bj * 1024 + 128 * pn + 32 * q, D, 32 * nbd, f8_ ? 1 : 0}; break; } r_ -= I_W1; \
            { const int e = r_ / 512, rr = r_ % 512, kb = rr / 32, nb = rr % 32; const bool f8_ = (l_ >= MOE_F8_FROM); \
              I_ = CvtItem{w2 + (size_t)(l_ * NE + e) * D * D, f8_ ? (gbp)((GAS char*)(W2 + (size_t)l_ * NE * D * D) + (size_t)e * D * D) : W2 + (size_t)(l_ * NE + e) * D * D, D, 64 * kb, 32 * nb, D, 32 * nb, f8_ ? 1 : 0}; } } while (0)
        {
            int it = first + gw; CvtItem Iq[4]; float v[4][32];
#define CVT_PRE(k, itx) do { if ((itx) < last) { CVT_DECODE((itx), Iq[k]); cvt_load(Iq[k], lane, v[k]); } } while (0)
#define CVT_STG(k) { CVT_PRE(((k) + 3) & 3, it + 3 * NGW); cvt_store(Iq[k], lane, v[k], scr); it += NGW; if (it >= last) break; }
            CVT_PRE(0, it); CVT_PRE(1, it + NGW); CVT_PRE(2, it + 2 * NGW);
            if (it < last) for (;;) { CVT_STG(0) CVT_STG(1) CVT_STG(2) CVT_STG(3) }
#undef CVT_PRE
#undef CVT_STG
        }
#undef CVT_DECODE
}

#ifndef DISMASK
#define DISMASK 0
#endif
#define EN(k) (((DISMASK >> (k)) & 1) == 0)
#ifndef TOKPROBE
#define TOKPROBE 0
#endif
#ifndef DUPMASK
#ifndef INPROJ_STAGGER
#define INPROJ_STAGGER 2
#endif
#ifndef A128DUP
#define A128DUP 0
#endif
#define DUPMASK 0
#endif
#define REPS(k) ((((DUPMASK) >> (k)) & 1) ? 2 : 1)
__device__ __forceinline__ void ld_prod(gcfp a, gcfp b, int lane, f32x4 (&o)[4]) {
#pragma unroll
    for (int j = 0; j < 4; ++j) o[j] = *(const GAS f32x4*)(a + 4 * lane + 256 * j) * *(const GAS f32x4*)(b + 4 * lane + 256 * j);
}
__device__ __forceinline__ void ld_scale(gcfp g, gcfp sc, int lane, f32x4 (&A)[4]) {
#pragma unroll
    for (int j = 0; j < 4; ++j) A[j] = *(const GAS f32x4*)(g + 4 * lane + 256 * j) * (1.0f + *(const GAS f32x4*)(sc + 4 * lane + 256 * j));
}
template <bool F8 = false> __device__ __forceinline__ void norm_affine_row(const f32x4 (&x)[4], const f32x4 (&A)[4], int lane, f32x4 (&h)[4], gbp dst) {
    const float rn = __builtin_amdgcn_rsqf(sumsq_row(x) * (1.0f / D) + EPS);
#pragma unroll
    for (int j = 0; j < 4; ++j) { const int c = 4 * lane + 256 * j; h[j] = (x[j] * rn) * A[j] + h[j];
        if constexpr (F8) { *(GAS unsigned*)((GAS unsigned char*)dst + c) = pk4f8(h[j][0], h[j][1], h[j][2], h[j][3]); }
        else { u32x2 w; w.x = pk2(h[j][0], h[j][1]); w.y = pk2(h[j][2], h[j][3]); *(GAS u32x2*)(dst + c) = w; } }
}
__global__ void __launch_bounds__(NWAVES * 64, 2) mk_fwd(Args args) {
    extern __shared__ __attribute__((aligned(16))) unsigned char lds[];
    LAS unsigned char* ldsl = (LAS unsigned char*)lds;
    volatile LAS unsigned* MISC = (volatile LAS unsigned*)(ldsl + MISC_OFF);
    const int tid = threadIdx.x; const int wave0 = __builtin_amdgcn_readfirstlane(tid >> 6);
#define TIDNOW() (wave0 * 64 + lane_now())
    const int G = gridDim.x, bid = blockIdx.x;
    const int vcu = (G % 8 == 0) ? (bid % 8) * (G / 8) + bid / 8 : bid;
    const int G0 = G, bid0 = bid, vcu0 = vcu, wave00 = wave0;
#define IDS_NOW const int G = sgpr_launder(G0), bid = sgpr_launder(bid0), vcu = sgpr_launder(vcu0), wave0 = sgpr_launder(wave00); (void)G; (void)bid; (void)vcu; (void)wave0
    unsigned* ctl = (unsigned*)(GAS unsigned*)(args.ws + WS_CTL);
    for (int u = tid; u < (LDS_BYTES - MISC_OFF) / 4; u += NWAVES * 64) MISC[u] = 0u;
    __syncthreads();
    if (tid == 0) {
#pragma unroll
        for (int i = 0; i < 22; ++i) { const unsigned long long pv = i < 20 ? (unsigned long long)args.in[i] : (i == 20 ? (unsigned long long)args.out : (unsigned long long)args.ws);
            MISC[MW_PT + 2 * i] = (unsigned)pv; MISC[MW_PT + 2 * i + 1] = (unsigned)(pv >> 32); }
    }
    __syncthreads();
    XcdBarrier bar = xcd_barrier_post(ctl + CW_BAR, MISC + MW_BAR);
    const int lo = args.ph_lo, hi = args.ph_hi;
#define IN(k) (sgpr_launder(lo) <= (k) && (k) < sgpr_launder(hi))
#define SEAM(k) do { if (IN(k) && IN((k) + 1)) xcd_barrier(bar, TIDNOW()); } while (0)

    const int NGW = G * NWAVES;
#define PHASE_IDS const int lane = lane_now(), tid = wave0 * 64 + lane, wave = wave0, gw = vcu * NWAVES + wave; (void)gw; (void)lane

    for (int rep_ = 0; rep_ < REPS(0); ++rep_) { if (rep_) xcd_barrier(bar, TIDNOW());
    if (IN(0) && EN(0)) {
        IDS_NOW;
        PHASE_IDS;
        auto c_in = INP(1); auto cctx_in = INP(3); auto ada_w = INP(4); auto ada_b = INP(5);
        auto diff_lambda = INP(8);
        auto MOD = WSP(float, WS_MOD); auto ROPEC = WSP(float, WS_ROPEC); auto ROPES = WSP(float, WS_ROPES); auto LAMV = WSP(float, WS_LAM);
        if (bid < 2 * 96) {
            const int l = bid / 96, nb = bid % 96;
            LAS float* sl = (LAS float*)(ldsl + wave * 2560);
            LAS float* part = (LAS float*)(ldsl + 32768);
            { float cvv[10];
#pragma unroll
              for (int t = 0; t < 10; ++t) { const int idx = lane + 64 * t; const int r = idx >> 7, kk = idx & 127, k = wave * 128 + kk; cvv[t] = r < 4 ? c_in[r * D + k] : cctx_in[k]; }
#pragma unroll
              for (int t = 0; t < 10; ++t) sl[lane + 64 * t] = cvv[t] / (1.0f + __expf(-cvv[t])); }
            LDS_WAIT(); asm volatile("" ::: "memory");
            float a[5];
#pragma unroll
            for (int r = 0; r < 5; ++r) a[r] = 0.f;
            gcfp wp = ada_w + ((size_t)l * D + wave * 128) * NIN + nb * 64 + lane;
#pragma unroll 32
            for (int kk = 0; kk < 128; ++kk) { const float wv = wp[(size_t)kk * NIN];
#pragma unroll
                for (int r = 0; r < 5; ++r) a[r] += wv * sl[r * 128 + kk]; }
#pragma unroll
            for (int r = 0; r < 5; ++r) part[(wave * 5 + r) * 64 + lane] = a[r];
            __syncthreads();
            for (int idx = tid; idx < 320; idx += NWAVES * 64) { const int r = idx >> 6, cc = idx & 63; float s = ada_b[l * NIN + nb * 64 + cc];
#pragma unroll
                for (int w = 0; w < 8; ++w) s += part[(w * 5 + r) * 64 + cc];
                MOD[((size_t)l * 5 + r) * NIN + nb * 64 + cc] = s; }
            __syncthreads();
        }
        if (bid == G - 1) {
            for (int idx = tid; idx < 1024; idx += NWAVES * 64) { const int pos = idx >> 4, p = idx & 15; const float inv = powf(10000.0f, -(float)p / 16.0f); const float ang = (float)pos * inv;
                ROPEC[idx] = cosf(ang); ROPES[idx] = sinf(ang); }
            if (wave < 2) { gcfp lv = diff_lambda + wave * 256;
                const float s1 = wave_sum(lv[lane] * lv[64 + lane]), s2 = wave_sum(lv[128 + lane] * lv[192 + lane]);
                const float lam_init = 0.8f - 0.6f * expf(-0.3f * (float)wave);
                if (lane == 0) LAMV[wave] = expf(s1) - expf(s2) + lam_init; }
        }
        cvt_range(MISC, ldsl, 0, CVT_P0_END, gw, NGW, wave, lane);
    }
    }
    SEAM(0);
    if (IN(1) && EN(1)) {
        IDS_NOW;
        PHASE_IDS;
        auto x_in = INP(0); auto ctx_in = INP(2); auto norm_g = INP(6);
        auto MOD = WSP(float, WS_MOD); auto X = WSP(float, WS_X); auto H = WSP(bf16, WS_H);
        {
            auto PV = WSP(float, WS_PV);
            for (int idx = bid * (NWAVES * 64) + tid; idx < DEPTH * 5 * D; idx += G * NWAVES * 64) { const int l_ = idx / (5 * D), mr_ = (idx / D) % 5, d_ = idx % D;
                gcfp md_ = MOD + ((size_t)l_ * 5 + mr_) * NIN; gcfp ng_ = norm_g + (size_t)l_ * 4 * D; gfp pv_ = PV + ((size_t)l_ * 5 + mr_) * 4 * D;
                pv_[d_] = md_[2 * D + d_] * ng_[D + d_]; pv_[D + d_] = ng_[2 * D + d_] * (1.0f + md_[4 * D + d_]); pv_[2 * D + d_] = md_[5 * D + d_] * ng_[3 * D + d_]; pv_[3 * D + d_] = ng_[d_] * (1.0f + md_[D + d_]); }
        }
        {
            const int RPB = (MTOT + G - 1) / G, r0 = bid * RPB;
            int i = wave; bool have = (i < RPB && r0 + i < MTOT); f32x4 xn[4], A2[4]; int mrc = -1;
#define P1SRC(r_) ((r_) < MLAT ? x_in + (size_t)(r_) * D : ctx_in + (size_t)((r_) - MLAT) * D)
            if (have) ld_row(P1SRC(r0 + i), lane, xn);
            while (have) {
                const int r = r0 + i; f32x4 xv[4], hv[4];
#pragma unroll
                for (int j = 0; j < 4; ++j) xv[j] = xn[j];
                const int inx = i + NWAVES; const bool hn = (inx < RPB && r0 + inx < MTOT);
                if (hn) ld_row(P1SRC(r0 + inx), lane, xn);
                const int mr = r < MLAT ? (r >> 12) : 4;
                gcfp md = MOD + (size_t)mr * NIN; ld_row(md, lane, hv);
                if (mr != mrc) { ld_scale(norm_g, md + 1024, lane, A2); mrc = mr; }
                norm_affine_row(xv, A2, lane, hv, H + (size_t)r * D);
                i = inx; have = hn;
            }
#undef P1SRC
        }
    }
    SEAM(1);

    for (int l = 0; l < DEPTH; ++l) {
        const int pb = 2 + 8 * l; const bool lastl = (l == DEPTH - 1);
        const int ML = lastl ? MLAT : MTOT;
        unsigned* cntg = ctl + CW_CNT + l * 32 * 64;
        for (int rep_ = 0; rep_ < (l == 0 ? REPS(2) : 1); ++rep_) { if (rep_) xcd_barrier(bar, TIDNOW());
        if (IN(pb + 0) && EN(2)) {
            IDS_NOW;
            auto H = WSP(bf16, WS_H); auto WIN = WSP(bf16, WS_WIN);
            pg8::Gemm g{(const bf16*)H, (const bf16*)(WIN + (size_t)l * NIN * D), MTOT, NIN, D}; pg8::StaticOrder S; S.init(MTOT, NIN, G, bid);
            EpiInproj E{MISC, l};
            { const int c0s = (MTOT / 256) * (NIN / 256) - ((MTOT / 256) * (NIN / 256) / G) * G;
              if (c0s > 0 && bid >= c0s) { const int nsl = INPROJ_STAGGER * (1 + (bid - c0s) % 3); for (int i_ = 0; i_ < nsl; ++i_) __builtin_amdgcn_s_sleep(64); } }
            pg8::gemm_phase<EpiInproj, pg8::StaticOrder, false>(ldsl, g, S, E, wave0);
            { const int nfull = (MTOT / 256) * (NIN / 256) / G, c0 = (MTOT / 256) * (NIN / 256) - nfull * G;
              if (l == 0 && c0 > 0 && bid >= c0) { const int tc = TIDNOW(); const int wv = wave0;
                  cvt_range(MISC, ldsl, CVT_P0_END, CVT_T1_END, (bid - c0) * NWAVES + wv, (G - c0) * NWAVES, wv, tc & 63); } }
        }
        }
        SEAM(pb + 0);
        for (int rep_ = 0; rep_ < (l == 0 ? REPS(3) : 1); ++rep_) { if (rep_) xcd_barrier(bar, TIDNOW());
        if (IN(pb + 1) && EN(3)) {
            IDS_NOW;
            auto diff_subln = INP(9); auto sink = INP(11); auto LAMV = WSP(float, WS_LAM);
            auto QA = WSP(bf16, WS_QA); auto QB = WSP(bf16, WS_QB); auto QC = WSP(bf16, WS_QC);
            auto KA = WSP(bf16, WS_KA); auto VA = WSP(bf16, WS_VA); auto KB = WSP(bf16, WS_KB); auto VB = WSP(bf16, WS_VB); auto KC = WSP(bf16, WS_KC); auto VC = WSP(bf16, WS_VC);
            auto YS = WSP(bf16, WS_YS);
            const int NU = lastl ? 1536 : 1632;
            const float lam = LAMV[l]; const float post = 1.0f - (0.8f - 0.6f * expf(-0.3f * (float)l));
            {
                for (int rp_ = 0; rp_ < ((A128DUP && l == 0) ? 2 : 1); ++rp_)
                for (int pr = vcu; pr < 256; pr += G) {
                    const int b = pr >> 6, hh = (pr >> 4) & 3, q0 = b * SEQ + (pr & 15) * 256;
                    const size_t kv0 = (size_t)b * KVR * 512 + hh * 128;
                    for (int mp = 0; mp < 2; ++mp) {
                        __syncthreads();
                        att128::attn_unit<8>((const att64::bf16*)(const bf16*)(QA + (size_t)q0 * 512 + hh * 128 + mp * 64), 512, (const att64::bf16*)(const bf16*)(KA + kv0 + mp * 64), (const att64::bf16*)(const bf16*)(VA + kv0), 512, 68, mp,
                                             lam, diff_subln + l * 128, post, (att64::bf16*)(bf16*)(YS + (size_t)q0 * 512 + hh * 128), 512, (char*)lds, wave0);
                    }
                }
            }
            for (int i = 0;; ++i) {
                const int L = 512 + i * G + vcu; if (L >= NU) break;
                int type, b, hh, qb, qrow; bool isctx;
                if (L < 1536) { type = L / 512; const int idx = L % 512; b = idx >> 7; hh = (idx >> 5) & 3; qb = idx & 31; qrow = b * SEQ + qb * 128; isctx = false; }
                else { const int e = L - 1536; type = e / 32; const int idx = e % 32; b = idx >> 3; hh = (idx >> 1) & 3; qb = idx & 1; qrow = MLAT + b * CTXL + qb * 128; isctx = true; }
                if (type != 0) {
                    __syncthreads();
                    const int idx = isctx ? (L - 1536) % 32 : L % 512;
                    if (type == 1) {
                        const int b1 = isctx ? idx >> 3 : idx >> 7, head = isctx ? idx & 7 : (idx >> 4) & 7, q0 = isctx ? MLAT + b1 * CTXL : b1 * SEQ + (idx & 15) * 256;
                        const size_t kv0 = ((size_t)b1 * KVR + (isctx ? SEQ : 0)) * 128 + (head >> 2) * 64; const int nt = isctx ? 4 : 68;
                        att64::attn_unit<8, false, false>((const att64::bf16*)(const bf16*)(QB + (size_t)q0 * 512 + head * 64), 512, (const att64::bf16*)(const bf16*)(KB + kv0), (const att64::bf16*)(const bf16*)(VB + kv0), 128, nt, nt, 0, 0, 0, 0, 0.f, 0.f,
                                                         (att64::bf16*)(bf16*)(YS + (size_t)MTOT * 512 + (size_t)q0 * 512 + head * 64), 512, (char*)lds, wave0);
                    } else {
                        const int b1 = isctx ? idx >> 3 : idx >> 7, hp = isctx ? (idx >> 1) & 3 : (idx >> 5) & 3, qbl = isctx ? idx & 1 : idx & 31;
                        const int head = 2 * hp, q0 = isctx ? MLAT + b1 * CTXL + qbl * 128 : b1 * SEQ + qbl * 128;
                        const size_t kv0 = ((size_t)b1 * KVR + SEQ) * 128 + (head >> 2) * 64; const float sl2a = sink[l * 8 + head] * 1.4426950408889634f, sl2b = sink[l * 8 + head + 1] * 1.4426950408889634f;
                        const att64::bf16* qp_ = (const att64::bf16*)(const bf16*)(QC + (size_t)q0 * 512 + head * 64); att64::bf16* op_ = (att64::bf16*)(bf16*)(YS + (size_t)2 * MTOT * 512 + (size_t)q0 * 512 + head * 64);
                        if (isctx) att64::attn_unit<8, false, true>(qp_, 512, (const att64::bf16*)(const bf16*)(KC + kv0), (const att64::bf16*)(const bf16*)(VC + kv0), 128, 4, 4, 0, 0, 0, 1, sl2a, sl2b, op_, 512, (char*)lds, wave0);
                        else { const int qpos = qbl * 128; const int klo = qpos - 128 < 0 ? 0 : qpos - 128, khi = qpos + 256 > SEQ ? SEQ : qpos + 256; const int n2 = (khi - klo) / 64;
                            att64::attn_unit<8, true, true>(qp_, 512, (const att64::bf16*)(const bf16*)(KC + kv0), (const att64::bf16*)(const bf16*)(VC + kv0), 128, 4 + n2, 4, klo - SEQ, klo, qpos, 1, sl2a, sl2b, op_, 512, (char*)lds, wave0); }
                    }
                    continue;
                }
                att::UnitArgs A;
                A.s1 = isctx ? SEQ : 0; A.n1 = isctx ? 4 : 68; A.s2 = 0; A.n2 = 0; A.qpos0 = -1; A.use_sink = 0; A.sink0 = 0.f; A.sink1 = 0.f; A.lam = lam; A.post = post; A.subg = diff_subln + l * 128;
                {
                    A.Q = QA + (size_t)qrow * 512 + hh * 128; A.qg1 = 64; A.K = KA + (size_t)b * KVR * 512 + hh * 128; A.V = VA + (size_t)b * KVR * 512 + hh * 128; A.ldk = 512;
                    A.O = YS + (size_t)qrow * 512 + hh * 128; A.og1 = 0;
                    att::attn_unit<true, false>(A, (char*)lds, wave0);
                }
            }
        }
        }
        SEAM(pb + 1);
        for (int rep_ = 0; rep_ < (l == 0 ? REPS(4) : 1); ++rep_) { if (rep_) xcd_barrier(bar, TIDNOW());
        if (IN(pb + 2) && EN(4)) {
            IDS_NOW;
            auto YS = WSP(bf16, WS_YS); auto WB = WSP(bf16, WS_WB);
            pg8::Gemm g{(const bf16*)YS, (const bf16*)(WB + (size_t)l * 3 * D * 512), 3 * MTOT, 3 * D, 512}; MergeOrder S{(ML / 256) * 4, G, vcu};
            EpiMerge E{MISC};
            pg8::gemm_phase<EpiMerge, MergeOrder, false>(ldsl, g, S, E, wave0);
            { const int c0 = (ML / 256) * 4 - G;
              if (l == 0 && c0 > 0 && c0 < G && vcu >= c0) { const int tc = TIDNOW(); const int wv = wave0;
                  cvt_range(MISC, ldsl, CVT_T1_END, CVT_T3_END, (vcu - c0) * NWAVES + wv, (G - c0) * NWAVES, wv, tc & 63); } }
        }
        }
        SEAM(pb + 2);
        for (int rep_ = 0; rep_ < (l == 0 ? REPS(5) : 1); ++rep_) { if (rep_) xcd_barrier(bar, TIDNOW());
        if (IN(pb + 3) && EN(5)) {
            IDS_NOW;
            auto MG = WSP(bf16, WS_MG); auto WO = WSP(bf16, WS_WO);
            pg8::Gemm g{(const bf16*)MG, (const bf16*)(WO + (size_t)l * D * D), ML, D, D}; pg8::StaticOrder S; S.init(ML, D, G, bid);
            EpiOut E{MISC};
            pg8::gemm_phase<EpiOut, pg8::StaticOrder, false>(ldsl, g, S, E, wave0);
            { const int c0 = (ML / 256) * 4 - G;
              if (l == 0 && c0 > 0 && c0 < G && bid >= c0) { const int tc = TIDNOW(); const int wv = wave0;
                  cvt_range(MISC, ldsl, CVT_T3_END, CVT_END, (bid - c0) * NWAVES + wv, (G - c0) * NWAVES, wv, tc & 63); } }
        }
        }
        SEAM(pb + 3);
        if (IN(pb + 4) && EN(6)) {
            IDS_NOW;
            PHASE_IDS;
            auto norm_g = INP(6); auto router_w = INP(14); auto router_b = INP(15);
            gcfp ng = norm_g + (size_t)l * 4 * D; auto modl = WSP(float, WS_MOD) + (size_t)l * 5 * NIN;
            auto Y = WSP(bf16, WS_Y); auto X = WSP(float, WS_X); auto H2 = WSP(bf16, WS_H2); auto x_in0 = INP(0); auto ctx_in0 = INP(2);
            auto SE = WSP(int, WS_SE); auto SR = WSP(int, WS_SR); auto SW = WSP(float, WS_SW); auto LIST = WSP(int, WS_LIST);
            LAS f32x4* rwL = (LAS f32x4*)ldsl;
            gcfp rw = router_w + (size_t)l * D * NE;
            {
                f32x4 tw[16];
#pragma unroll
                for (int k = 0; k < 16; ++k) { const int idx = tid + k * (NWAVES * 64); const int d = idx >> 3, q = idx & 7; tw[k] = *(const GAS f32x4*)(rw + (size_t)d * NE + q * 4); }
#pragma unroll
                for (int k = 0; k < 16; ++k) { const int idx = tid + k * (NWAVES * 64); const int d = idx >> 3, q = idx & 7; const int rowp = (d & 3) * 256 + (d >> 2);
                    rwL[rowp * 8 + (q ^ ((rowp >> 1) & 7))] = tw[k]; }
            }
            volatile LAS unsigned* hist = MISC + MW_HIST; volatile LAS unsigned* gbase = MISC + MW_BASE; volatile LAS unsigned* slotw = MISC + MW_SLOT + wave * (9 * 4 * 3);
            if (tid < NE) hist[tid] = 0u;
            __syncthreads();
            const int RPB = (ML + G - 1) / G; const int r0 = bid * RPB;
            int nti = 0;
#if TOKPROBE & 1
            for (int rep1 = (l == 0) ? 0 : 1; rep1 < 2; ++rep1) { const bool dry1 = rep1 == 0; gfp Xo = dry1 ? (gfp)WSP(float, WS_TMP) : (gfp)X; gbp H2o = dry1 ? (gbp)WSP(bf16, WS_ACT) : (gbp)H2; nti = 0;
#else
            { gfp Xo = (gfp)X; gbp H2o = (gbp)H2; constexpr bool dry1 = false;
#endif
            {
            int i = wave; bool have = (i < RPB && r0 + i < ML);
            u32x2 yn[4]; auto PVl = WSP(float, WS_PV) + (size_t)l * 5 * 4 * D;
#define YLD(r_) do { _Pragma("unroll") for (int j = 0; j < 4; ++j) yn[j] = *(const GAS u32x2*)(Y + (size_t)(r_) * D + 4 * lane + 256 * j); } while (0)
#define XSRC(r_) (l == 0 ? ((r_) < MLAT ? x_in0 + (size_t)(r_) * D : ctx_in0 + (size_t)((r_) - MLAT) * D) : (gcfp)(X + (size_t)(r_) * D))
            if (have) { YLD(r0 + i); }
            while (have) {
                const int r = r0 + i; const int mr = r < MLAT ? (r >> 12) : 4;
                gcfp md = modl + (size_t)mr * NIN; gcfp pv = PVl + (size_t)mr * 4 * D; f32x4 yv[4], xv[4], hv[4], A1[4], A2[4];
                ld_row(XSRC(r), lane, xv); ld_row(pv, lane, A1); ld_row(pv + D, lane, A2); ld_row(md + 3 * D, lane, hv);

#pragma unroll
                for (int j = 0; j < 4; ++j) yv[j] = (f32x4){bflo(yn[j].x), bfhi(yn[j].x), bflo(yn[j].y), bfhi(yn[j].y)};
                const int inx = i + NWAVES; const bool hn = (inx < RPB && r0 + inx < ML);
                if (hn) { YLD(r0 + inx); }
                const float rny = __builtin_amdgcn_rsqf(sumsq_row(yv) * (1.0f / D) + EPS);
#pragma unroll
                for (int j = 0; j < 4; ++j) { const int c = 4 * lane + 256 * j; xv[j] = xv[j] + A1[j] * (yv[j] * rny); *(GAS f32x4*)(Xo + (size_t)r * D + c) = xv[j]; }
                if (l >= MOE_F8_FROM) norm_affine_row<true>(xv, A2, lane, hv, (gbp)((GAS unsigned char*)H2o + (size_t)r * D));
                else norm_affine_row<false>(xv, A2, lane, hv, H2o + (size_t)r * D);
                float a[32];
#pragma unroll
                for (int q = 0; q < 32; ++q) a[q] = 0.f;
                const int sw = (lane >> 1) & 7;
                {
                    f32x4 wA[8], wB[8];
#define RW_LD(W, blk) do { const int rowp_ = ((blk) & 3) * 256 + 64 * ((blk) >> 2) + lane; _Pragma("unroll") for (int q = 0; q < 8; ++q) W[q] = rwL[rowp_ * 8 + (q ^ sw)]; } while (0)
#define RW_FMA(W, blk) do { const float hval_ = hv[(blk) >> 2][(blk) & 3]; _Pragma("unroll") for (int q = 0; q < 8; ++q) { a[4 * q + 0] += hval_ * W[q][0]; a[4 * q + 1] += hval_ * W[q][1]; a[4 * q + 2] += hval_ * W[q][2]; a[4 * q + 3] += hval_ * W[q][3]; } } while (0)
                    RW_LD(wA, 0);
#pragma unroll
                    for (int blk = 0; blk < 16; blk += 2) { RW_LD(wB, blk + 1); RW_FMA(wA, blk); __builtin_amdgcn_sched_barrier(0); if (blk + 2 < 16) RW_LD(wA, blk + 2); RW_FMA(wB, blk + 1); __builtin_amdgcn_sched_barrier(0); }
#undef RW_LD
#undef RW_FMA
                }
#define RS(N, MASK) do { const bool up = (lane & (MASK)) != 0; _Pragma("unroll") for (int q = 0; q < (N) / 2; ++q) { const float keep = up ? a[(N) / 2 + q] : a[q]; const float send = up ? a[q] : a[(N) / 2 + q]; a[q] = keep + __shfl_xor(send, (MASK)); } } while (0)
                RS(32, 32); RS(16, 16); RS(8, 8); RS(4, 4); RS(2, 2);
#undef RS
                const int myE = (lane >> 1) & 31;
                float val = a[0] + dppf<0xB1>(a[0]) + router_b[l * NE + myE];
                float tv[4]; int te[4];
#define BETTER(ov, oe, bv, be) ((ov) > (bv) || ((ov) == (bv) && (oe) < (be)))
#define TSTEP(CTRL) do { const float ov = dppf<CTRL>(bv); const int oe = dppi<CTRL>(be); if (BETTER(ov, oe, bv, be)) { bv = ov; be = oe; } } while (0)
#pragma unroll
                for (int k = 0; k < 4; ++k) { float bv = val; int be = myE;
                    TSTEP(0x4E); TSTEP(0x141); TSTEP(0x140);
                    float v0 = rdl(bv, 0), v1 = rdl(bv, 16), v2 = rdl(bv, 32), v3 = rdl(bv, 48);
                    int e0 = __builtin_amdgcn_readlane(be, 0), e1 = __builtin_amdgcn_readlane(be, 16), e2 = __builtin_amdgcn_readlane(be, 32), e3 = __builtin_amdgcn_readlane(be, 48);
                    if (BETTER(v1, e1, v0, e0)) { v0 = v1; e0 = e1; } if (BETTER(v3, e3, v2, e2)) { v2 = v3; e2 = e3; } if (BETTER(v2, e2, v0, e0)) { v0 = v2; e0 = e2; }
                    tv[k] = v0; te[k] = e0; if (myE == e0) val = -INFINITY; }
#undef TSTEP
#undef BETTER
                const float e1 = __expf(tv[1] - tv[0]), e2 = __expf(tv[2] - tv[0]), e3 = __expf(tv[3] - tv[0]); const float inv = 1.0f / (1.0f + e1 + e2 + e3);
                if (lane < 4) { const int ek = lane == 0 ? te[0] : lane == 1 ? te[1] : lane == 2 ? te[2] : te[3]; const float wk = (lane == 0 ? 1.0f : lane == 1 ? e1 : lane == 2 ? e2 : e3) * inv;
                    const unsigned lr = __hip_atomic_fetch_add((LAS unsigned*)((dry1 ? gbase : hist) + ek), 1u, __ATOMIC_RELAXED, __HIP_MEMORY_SCOPE_WORKGROUP);
                    slotw[(nti * 4 + lane) * 3 + 0] = (unsigned)ek; slotw[(nti * 4 + lane) * 3 + 1] = lr; slotw[(nti * 4 + lane) * 3 + 2] = __builtin_bit_cast(unsigned, wk); }
                i = inx; have = hn; ++nti;
            }
            }
            }
            __syncthreads();
            if (tid < NE) { const unsigned hcount = hist[tid]; gbase[tid] = hcount ? __hip_atomic_fetch_add(cntg + tid * 64, hcount, __ATOMIC_RELAXED, __HIP_MEMORY_SCOPE_AGENT) : 0u; }
            __syncthreads();
            nti = 0;
            for (int i = wave; i < RPB && r0 + i < ML; i += NWAVES, ++nti) {
                const int r = r0 + i;
                if (lane < 4) { const unsigned ek = slotw[(nti * 4 + lane) * 3 + 0], lr = slotw[(nti * 4 + lane) * 3 + 1], wkb = slotw[(nti * 4 + lane) * 3 + 2];
                    const unsigned rank = gbase[ek] + lr;
                    LIST[(size_t)ek * MTOT + rank] = r; SE[r * 4 + lane] = (int)ek; SR[r * 4 + lane] = (int)rank; SW[r * 4 + lane] = __builtin_bit_cast(float, wkb); }
            }
            __syncthreads();
        }
        SEAM(pb + 4);
        LAS int* tb = (LAS int*)(ldsl + MISC_OFF) + MW_TB; LAS int* cn = (LAS int*)(ldsl + MISC_OFF) + MW_CNT;
        if (IN(pb + 5) || IN(pb + 6) || IN(pb + 7)) {
            IDS_NOW;
            __syncthreads();
            const int tid = TIDNOW();
            if (tid < NE) cn[tid] = (int)__hip_atomic_load(cntg + tid * 64, __ATOMIC_RELAXED, __HIP_MEMORY_SCOPE_AGENT);
            __syncthreads();
            if (tid == 0) { int accu = 0; for (int e = 0; e < NE; ++e) { tb[e] = accu; accu += (cn[e] + 255) >> 8; } tb[NE] = accu; }
            __syncthreads();
        }
        for (int rep_ = 0; rep_ < (l == 0 ? REPS(7) : 1); ++rep_) { if (rep_) xcd_barrier(bar, TIDNOW());
        if (IN(pb + 5) && EN(7)) {
            IDS_NOW;
            auto H2 = WSP(bf16, WS_H2); auto W1 = WSP(bf16, WS_W1); auto LIST = WSP(int, WS_LIST);
            MoeOrder<8> S; S.init(tb, cn, LIST, G, bid);
            if (l >= MOE_F8_FROM) { pg8::Gemm g{(const bf16*)H2, (const bf16*)(W1 + (size_t)l * NE * 2048 * D), MTOT, NE * 2048, D / 2}; EpiSwiglu<true> E{MISC, l};
                pg8::gemm_phase<EpiSwiglu<true>, MoeOrder<8>, true, true>(ldsl, g, S, E, wave0); }
            else { pg8::Gemm g{(const bf16*)H2, (const bf16*)(W1 + (size_t)l * NE * 2048 * D), MTOT, NE * 2048, D}; EpiSwiglu<false> E{MISC, l};
                pg8::gemm_phase<EpiSwiglu<false>, MoeOrder<8>, true, false>(ldsl, g, S, E, wave0); }
        }
        }
        SEAM(pb + 5);
        for (int rep_ = 0; rep_ < (l == 0 ? REPS(8) : 1); ++rep_) { if (rep_) xcd_barrier(bar, TIDNOW());
        if (IN(pb + 6) && EN(8)) {
            IDS_NOW;
            auto ACT = WSP(bf16, WS_ACT); auto W2 = WSP(bf16, WS_W2); auto LIST = WSP(int, WS_LIST);
            MoeOrder<4> S; S.init(tb, cn, LIST, G, bid);
            if (l >= MOE_F8_FROM) { pg8::Gemm g{(const bf16*)ACT, (const bf16*)(W2 + (size_t)l * NE * D * D), MAXTILES * 256, NE * D, D / 2}; EpiMoe2<true> E{MISC, l};
                pg8::gemm_phase<EpiMoe2<true>, MoeOrder<4>, false, true>(ldsl, g, S, E, wave0); }
            else { pg8::Gemm g{(const bf16*)ACT, (const bf16*)(W2 + (size_t)l * NE * D * D), MAXTILES * 256, NE * D, D}; EpiMoe2<false> E{MISC, l};
                pg8::gemm_phase<EpiMoe2<false>, MoeOrder<4>, false, false>(ldsl, g, S, E, wave0); }
        }
        }
        SEAM(pb + 6);
        if (IN(pb + 7) && EN(9)) {
            IDS_NOW;
            PHASE_IDS;
            auto norm_g = INP(6); gcfp ng = norm_g + (size_t)l * 4 * D; auto MOD = WSP(float, WS_MOD); gcfp modl = MOD + (size_t)l * 5 * NIN;
            auto X = WSP(float, WS_X); auto H = WSP(bf16, WS_H); auto YS2 = WSP(bf16, WS_YS2); gfp outp = (gfp)ldp(MISC, 20);
            auto SE = WSP(int, WS_SE); auto SR = WSP(int, WS_SR); auto SW = WSP(float, WS_SW);
            for (int rep2 = ((TOKPROBE & 2) && l == 0) ? 0 : 1; rep2 < 2; ++rep2) { const bool dry2 = rep2 == 0; gfp Xo = dry2 ? (gfp)WSP(float, WS_TMP) : (gfp)X; gbp Ho = dry2 ? (gbp)WSP(bf16, WS_MG) : (gbp)H;
            for (int rb = gw; rb < ML; rb += 16 * NGW) {
                const int myr = rb + (lane >> 2) * NGW; const bool vld = myr < ML;
                const int se = vld ? SE[myr * 4 + (lane & 3)] : 0, sr = vld ? SR[myr * 4 + (lane & 3)] : 0; const float swt = vld ? SW[myr * 4 + (lane & 3)] : 0.f;
                const int yrow = tb[se] * 256 + sr;
                u32x2 yn[4][4]; f32x4 xn[4];
#define T2_LOAD(ri_) do { const int r_ = rb + (ri_) * NGW; _Pragma("unroll") for (int k = 0; k < 4; ++k) { const int yr_ = __builtin_amdgcn_readlane(yrow, (ri_) * 4 + k); gcbp yp = YS2 + (size_t)yr_ * D; \
                    _Pragma("unroll") for (int j = 0; j < 4; ++j) yn[k][j] = *(const GAS u32x2*)(yp + 4 * lane + 256 * j); } ld_row(X + (size_t)r_ * D, lane, xn); } while (0)
                int ri = 0;
                if (rb < ML) T2_LOAD(0);
                while (ri < 16 && rb + ri * NGW < ML) {
                    const int r = rb + ri * NGW; const int mr = r < MLAT ? (r >> 12) : 4; gcfp md = modl + (size_t)mr * NIN;
                    f32x4 yv[4], xv[4];
#pragma unroll
                    for (int j = 0; j < 4; ++j) { yv[j] = (f32x4){0.f, 0.f, 0.f, 0.f}; xv[j] = xn[j]; }
#pragma unroll
                    for (int k = 0; k < 4; ++k) { const float wk = rdl(swt, ri * 4 + k);
#pragma unroll
                        for (int j = 0; j < 4; ++j) { const u32x2 w = yn[k][j]; yv[j][0] += wk * bflo(w.x); yv[j][1] += wk * bfhi(w.x); yv[j][2] += wk * bflo(w.y); yv[j][3] += wk * bfhi(w.y); } }
                    if (ri + 1 < 16 && rb + (ri + 1) * NGW < ML) T2_LOAD(ri + 1);
                    const float rny = 1.0f / sqrtf(sumsq_row(yv) * (1.0f / D) + EPS);
#pragma unroll
                    for (int j = 0; j < 4; ++j) { const int c = 4 * lane + 256 * j; const f32x4 g3 = *(const GAS f32x4*)(ng + 3 * D + c), gf = *(const GAS f32x4*)(md + 5 * D + c);
                        xv[j] = xv[j] + gf * ((yv[j] * rny) * g3);
                        if (lastl) *(GAS f32x4*)(outp + (size_t)r * D + c) = xv[j]; else *(GAS f32x4*)(Xo + (size_t)r * D + c) = xv[j]; }
                    if (!lastl) { f32x4 hv[4]; gcfp mdn = MOD + ((size_t)(l + 1) * 5 + mr) * NIN;
                        norm_mod_row(xv, norm_g + (size_t)(l + 1) * 4 * D, mdn + 1024, mdn, lane, hv, Ho + (size_t)r * D); }
                    ++ri;
                }
#undef T2_LOAD
            }
            if (dry2) { asm volatile("s_waitcnt vmcnt(0)" ::: "memory"); __syncthreads(); } }
        }
        if (!lastl) SEAM(pb + 7);
    }
#undef IN
#undef SEAM
}

constexpr int N_PHASES = 2 + 8 * DEPTH;
#ifndef MK_CUTS
#define MK_CUTS 0
#endif
extern "C" void kernel_launch(void* const* d_in, const int* in_sizes, int n_in, void* d_out, int out_size, void* d_ws, size_t ws_size, hipStream_t stream) {
    static int grid = 0;
    if (grid == 0) {
        if (n_in != 20 || out_size != MLAT * D || ws_size < WS_END) { fprintf(stderr, "kernel_launch: unexpected shapes (n_in %d out %d ws %zu need %zu)\n", n_in, out_size, ws_size, (size_t)WS_END); grid = -1; return; }
        int dev = 0, cus = 0, per_cu = 0;
        if (hipGetDevice(&dev) != hipSuccess || hipDeviceGetAttribute(&cus, hipDeviceAttributeMultiprocessorCount, dev) != hipSuccess) { grid = -1; return; }
        if (hipFuncSetAttribute((const void*)mk_fwd, hipFuncAttributeMaxDynamicSharedMemorySize, LDS_BYTES) != hipSuccess) { fprintf(stderr, "kernel_launch: hipFuncSetAttribute failed\n"); grid = -1; return; }
        if (hipOccupancyMaxActiveBlocksPerMultiprocessor(&per_cu, (const void*)mk_fwd, NWAVES * 64, LDS_BYTES) != hipSuccess || per_cu < 1) { fprintf(stderr, "kernel_launch: occupancy query reports %d\n", per_cu); }
        (void)hipGetLastError();
        grid = cus;
    }
    if (grid < 0) return;
    if (hipMemsetAsync((char*)d_ws + WS_CTL, 0, CTL_BYTES, stream) != hipSuccess) return;
    Args a{};
    for (int i = 0; i < 20; ++i) a.in[i] = (const float*)d_in[i];
    a.out = (float*)d_out; a.ws = (unsigned char*)d_ws;
#if MK_CUTS
    for (int p = 0; p < N_PHASES; ++p) { a.ph_lo = p; a.ph_hi = p + 1; hipLaunchKernelGGL(mk_fwd, dim3(grid), dim3(NWAVES * 64), LDS_BYTES, stream, a); }
#else
    a.ph_lo = 0; a.ph_hi = N_PHASES;
    hipLaunchKernelGGL(mk_fwd, dim3(grid), dim3(NWAVES * 64), LDS_BYTES, stream, a);
#endif
    const hipError_t le = hipPeekAtLastError();
    if (le != hipSuccess) fprintf(stderr, "kernel_launch: launch failed: %s\n", hipGetErrorName(le));
}
```

```cpp
#include <hip/hip_runtime.h>
#include <cstdio>
#include <cstdint>

#define LAS __attribute__((address_space(3)))
#define GAS __attribute__((address_space(1)))

__device__ __forceinline__ int lane_now() { int l = (int)__builtin_amdgcn_mbcnt_hi(~0u, __builtin_amdgcn_mbcnt_lo(~0u, 0u)); asm volatile("" : "+v"(l)); return l; }

namespace pg8 {
#define PG8_LAS __attribute__((address_space(3)))
typedef unsigned short bf16_t;
typedef short bf16x8 __attribute__((ext_vector_type(8)));
typedef float f32x4 __attribute__((ext_vector_type(4)));
typedef float f32x2 __attribute__((ext_vector_type(2)));
typedef unsigned u32x4 __attribute__((ext_vector_type(4)));
typedef unsigned u32x2 __attribute__((ext_vector_type(2)));
constexpr int BM = 256, BK = 64, HALF = 128, HTB = HALF * BK * 2  , STAGE_BYTES = 8 * HTB, NXCD = 8, WGM = 8;

__host__ __device__ __forceinline__ int lds_byte(int r, int c) { const int st = (r >> 4) * 2 + (c >> 5), rr = r & 15, cc = c & 31, ob = rr * 64 + cc * 2; return st * 1024 + (ob ^ (((ob >> 9) & 1) << 5)); }
__host__ __device__ __forceinline__ void stage_rc(int b, int& R, int& C) { const int st = b / 1024, sb = b % 1024, swz = sb ^ (((sb >> 9) & 1) << 5); R = (st >> 1) * 16 + swz / 64; C = (st & 1) * 32 + (swz % 64) / 2; }
__host__ __device__ __forceinline__ int perm32(int rho) { const int n = rho >> 4, i = rho & 15; return 8 * (i >> 2) + 4 * n + (i & 3); }

struct Unit { int pm, pn; };
struct Gemm { const bf16_t* A; const bf16_t* Bt; int M, N, K; };

struct StaticOrder {
    int nM, nN, nwg, G, c;
    __host__ __device__ void init(int M, int N, int G_, int c_) { nM = M / BM; nN = N / BM; nwg = nM * nN; G = G_; c = c_; }
    __host__ __device__ bool next(int i, Unit& u) const {
        const long L = (long)i * G + c; if (L >= nwg) return false;
        int wgid = (int)L; { const int q = nwg / NXCD, r = nwg % NXCD, xcd = wgid % NXCD, off = wgid / NXCD; wgid = (xcd < r ? xcd * (q + 1) : r * (q + 1) + (xcd - r) * q) + off; }
        const int nig = WGM * nN, gid = wgid / nig, fm = gid * WGM, gsz = (nM - fm) < WGM ? (nM - fm) : WGM;
        u.pm = fm + ((wgid % nig) % gsz); u.pn = (wgid % nig) / gsz; return true;
    }
    __device__ __forceinline__ unsigned a_row(const Unit&, int) const { return 0u; }
};

__device__ __forceinline__ unsigned cvt_pk_bf16(float lo, float hi) { unsigned r; asm volatile("v_cvt_pk_bf16_f32 %0, %1, %2" : "=v"(r) : "v"(lo), "v"(hi)); return r; }

typedef int v8i32 __attribute__((ext_vector_type(8)));
typedef int v4i32 __attribute__((ext_vector_type(4)));
__device__ __forceinline__ v8i32 cat8(bf16x8 lo, bf16x8 hi) { const v4i32 a = __builtin_bit_cast(v4i32, lo), b = __builtin_bit_cast(v4i32, hi); return (v8i32){a[0], a[1], a[2], a[3], b[0], b[1], b[2], b[3]}; }
__device__ __forceinline__ void mfma_f8(f32x4& acc, v8i32 a, v8i32 b, int sc) {
    asm volatile("v_mfma_scale_f32_16x16x128_f8f6f4 %0, %1, %2, %0, %3, %3 op_sel_hi:[0,0,0]" : "+v"(acc) : "v"(a), "v"(b), "v"(sc)); }
template <class E> struct epi_chain { static constexpr bool v = false; };
template <class E> struct epi_dup { static constexpr int v = 0; };
template <class Epi, class Sched, bool GATHER, bool FP8 = false>
__device__ __forceinline__ void gemm_phase(PG8_LAS unsigned char* lds, const Gemm g, const Sched& S, const Epi& E, const int wave0) {
    const int lane = lane_now(), tid = wave0 * 64 + lane, wid = wave0, wr = wid >> 2, wc = wid & 3, fr = lane & 15, fq = lane >> 4;
    const int K = g.K, nt = K / BK;
    unsigned voffA[2], voffB[2]; int RA[2], CA[2];
#pragma unroll
    for (int i = 0; i < 2; ++i) { int R, C; stage_rc(tid * 16 + i * 8192, R, C); const int Rb = Epi::PERM ? ((R & ~31) + perm32(R & 31)) : R;
        RA[i] = R; CA[i] = C; voffA[i] = (unsigned)(R * K + C) * 2u; voffB[i] = (unsigned)(Rb * K + C) * 2u; }
    const size_t kstep = (size_t)(BK * 2);
    const size_t hstep = (size_t)HALF * K * 2;
    const size_t tstep = 2 * hstep;
    const unsigned ldsw = (unsigned)wid * 1024u;
    const int aoff = lds_byte(wr * 64 + fr, fq * 8), boff = lds_byte(wc * 32 + fr, fq * 8);
#define PG8_SA(b, h) (((b) * 2 + (h)) * HTB)
#define PG8_SB(b, h) ((4 + (b) * 2 + (h)) * HTB)
#define PG8_STAGE2(bufoff, gbase, o0, o1) do { \
        __builtin_amdgcn_global_load_lds((const unsigned*)((const char*)(gbase) + (o0)), (PG8_LAS unsigned*)(lds + (bufoff) + ldsw), 16, 0, 0); \
        __builtin_amdgcn_global_load_lds((const unsigned*)((const char*)(gbase) + (o1)), (PG8_LAS unsigned*)(lds + (bufoff) + ldsw + 8192), 16, 0, 0); } while (0)
#define PG8_STB(bufoff, gbase) PG8_STAGE2(bufoff, gbase, voffB[0], voffB[1])
#define PG8_STA(bufoff, ptr, h, OC) do { if constexpr (GATHER) PG8_STAGE2(bufoff, ptr, OC[h][0], OC[h][1]); else PG8_STAGE2(bufoff, (ptr) + ((h) ? hstep : (size_t)0), voffA[0], voffA[1]); } while (0)
#define PG8_LDA(dst, b, h) do { _Pragma("unroll") for (int m = 0; m < 4; ++m) _Pragma("unroll") for (int k = 0; k < 2; ++k) dst[m][k] = *(const PG8_LAS bf16x8*)(lds + PG8_SA(b, h) + aoff + m * 2048 + k * 1024); } while (0)
#define PG8_LDB(dst, b, h) do { _Pragma("unroll") for (int n = 0; n < 2; ++n) _Pragma("unroll") for (int k = 0; k < 2; ++k) dst[n][k] = *(const PG8_LAS bf16x8*)(lds + PG8_SB(b, h) + boff + n * 2048 + k * 1024); } while (0)
#define PG8_MMA(ai, bj, At, Bt) do { __builtin_amdgcn_s_setprio(1); \
        if constexpr (FP8) { _Pragma("unroll") for (int m = 0; m < 4; ++m) _Pragma("unroll") for (int n = 0; n < 2; ++n) \
            mfma_f8(acc[ai][bj][m][n], cat8(Bt[n][0], Bt[n][1]), cat8(At[m][0], At[m][1]), sc8); } \
        else { _Pragma("unroll") for (int m = 0; m < 4; ++m) _Pragma("unroll") for (int n = 0; n < 2; ++n) _Pragma("unroll") for (int k = 0; k < 2; ++k) \
            acc[ai][bj][m][n] = __builtin_amdgcn_mfma_f32_16x16x32_bf16(Bt[n][k], At[m][k], acc[ai][bj][m][n], 0, 0, 0); } \
        __builtin_amdgcn_s_setprio(0); } while (0)
#define PG8_WAIT_V(n) asm volatile("s_waitcnt vmcnt(" #n ")" ::: "memory")
#define PG8_WAIT_L(n) asm volatile("s_waitcnt lgkmcnt(" #n ")" ::: "memory")
#define PG8_BAR __builtin_amdgcn_s_barrier()
#define PG8_SCHED __builtin_amdgcn_sched_barrier(0)
    Unit cur, nxt; int ui = 0;
    if (!S.next(0, cur)) return;
    f32x4 acc[2][2][4][2];
#pragma unroll
    for (int a = 0; a < 2; ++a)
#pragma unroll
        for (int b = 0; b < 2; ++b)
#pragma unroll
            for (int m = 0; m < 4; ++m)
#pragma unroll
                for (int n = 0; n < 2; ++n) acc[a][b][m][n] = (f32x4){0.f, 0.f, 0.f, 0.f};
    bf16x8 At[4][2], B0[2][2], B1[2][2];
    int sc8 = 0x7f7f7f7f; asm volatile("" : "+v"(sc8));
    unsigned vC[2][2] = {{0u, 0u}, {0u, 0u}}, vN[2][2] = {{0u, 0u}, {0u, 0u}};
    if constexpr (GATHER) {
#pragma unroll
        for (int h = 0; h < 2; ++h)
#pragma unroll
            for (int i = 0; i < 2; ++i) vC[h][i] = (S.a_row(cur, h * HALF + RA[i]) * (unsigned)K + (unsigned)CA[i]) * 2u;
    }
    const char* Ab = (const char*)g.A;
    const char* cA = GATHER ? Ab : Ab + (size_t)cur.pm * tstep; const char* cB = (const char*)g.Bt + (size_t)cur.pn * tstep;
    PG8_STB(PG8_SB(0, 0), cB); PG8_STB(PG8_SB(0, 1), cB + hstep); PG8_STA(PG8_SA(0, 0), cA, 0, vC); PG8_STA(PG8_SA(0, 1), cA, 1, vC);
    if (wr == 1) PG8_BAR;
    PG8_WAIT_V(2); PG8_BAR;
    PG8_STB(PG8_SB(1, 0), cB + kstep); PG8_STA(PG8_SA(1, 0), cA + kstep, 0, vC); PG8_STB(PG8_SB(1, 1), cB + hstep + kstep);
    PG8_WAIT_V(6); PG8_BAR;
    for (;;) {
        const bool has_next = S.next(ui + 1, nxt);
        const char* nA = GATHER ? Ab : (has_next ? Ab + (size_t)nxt.pm * tstep : cA); const char* nB = has_next ? (const char*)g.Bt + (size_t)nxt.pn * tstep : cB;
        if constexpr (GATHER) {
            if (has_next) {
#pragma unroll
                for (int h = 0; h < 2; ++h)
#pragma unroll
                    for (int i = 0; i < 2; ++i) vN[h][i] = (S.a_row(nxt, h * HALF + RA[i]) * (unsigned)K + (unsigned)CA[i]) * 2u;
            } else {
#pragma unroll
                for (int h = 0; h < 2; ++h)
#pragma unroll
                    for (int i = 0; i < 2; ++i) vN[h][i] = vC[h][i];
            }
        }
        for (int t = 0; t < nt; t += 2) {
            const bool last = (t == nt - 2);
            const char* a1 = cA + (size_t)(t + 1) * kstep;
            const char* a2 = last ? nA : cA + (size_t)(t + 2) * kstep; const char* b2 = last ? nB : cB + (size_t)(t + 2) * kstep;
            const char* a3 = a2 + kstep; const char* b3 = b2 + kstep;
            unsigned v2[2][2];
#pragma unroll
            for (int h = 0; h < 2; ++h)
#pragma unroll
                for (int i = 0; i < 2; ++i) v2[h][i] = last ? vN[h][i] : vC[h][i];
            PG8_LDB(B0, 0, 0); PG8_LDB(B1, 0, 1); PG8_SCHED; PG8_LDA(At, 0, 0); PG8_STA(PG8_SA(1, 1), a1, 1, vC);
            PG8_WAIT_V(8); PG8_WAIT_L(0); PG8_BAR; PG8_MMA(0, 0, At, B0); PG8_MMA(0, 1, At, B1); PG8_BAR; PG8_SCHED;
            PG8_LDA(At, 0, 1); PG8_STB(PG8_SB(0, 0), b2); PG8_STB(PG8_SB(0, 1), b2 + hstep); PG8_STA(PG8_SA(0, 0), a2, 0, v2);
            PG8_WAIT_V(8); PG8_WAIT_L(0); PG8_BAR; PG8_MMA(1, 0, At, B0); PG8_MMA(1, 1, At, B1); PG8_BAR; PG8_SCHED;
            PG8_LDB(B0, 1, 0); PG8_LDB(B1, 1, 1); PG8_SCHED; PG8_LDA(At, 1, 0); PG8_STA(PG8_SA(0, 1), a2, 1, v2);
            PG8_WAIT_V(8); PG8_WAIT_L(0); PG8_BAR; PG8_MMA(0, 0, At, B0); PG8_MMA(0, 1, At, B1); PG8_BAR; PG8_SCHED;
            PG8_LDA(At, 1, 1); PG8_STB(PG8_SB(1, 0), b3); PG8_STB(PG8_SB(1, 1), b3 + hstep); PG8_STA(PG8_SA(1, 0), a3, 0, v2);
            PG8_WAIT_V(8); PG8_WAIT_L(0); PG8_BAR; PG8_MMA(1, 0, At, B0); PG8_MMA(1, 1, At, B1); PG8_BAR; PG8_SCHED;
        }
        if (wr == 0) PG8_BAR;
        if constexpr (FP8) {
            asm volatile("s_nop 15\n\ts_nop 15" ::: "memory");
#pragma unroll
            for (int a = 0; a < 2; ++a)
#pragma unroll
                for (int b = 0; b < 2; ++b)
#pragma unroll
                    for (int m = 0; m < 4; ++m)
#pragma unroll
                        for (int n = 0; n < 2; ++n) asm volatile("" : "+v"(acc[a][b][m][n]));
        }
        E(acc, cur, wr, wc, fr, fq);
        if constexpr (epi_dup<Epi>::v) { asm volatile("" ::: "memory"); E(acc, cur, wr, wc, fr, fq); }
        if (!has_next) break;
        bool keep_acc = false; if constexpr (epi_chain<Epi>::v) keep_acc = E.keep(cur);
        if (!keep_acc) {
#pragma unroll
        for (int a = 0; a < 2; ++a)
#pragma unroll
            for (int b = 0; b < 2; ++b)
#pragma unroll
                for (int m = 0; m < 4; ++m)
#pragma unroll
                    for (int n = 0; n < 2; ++n) acc[a][b][m][n] = (f32x4){0.f, 0.f, 0.f, 0.f};
        }
        cur = nxt; cA = nA; cB = nB; ++ui;
        if constexpr (GATHER) {
#pragma unroll
            for (int h = 0; h < 2; ++h)
#pragma unroll
                for (int i = 0; i < 2; ++i) vC[h][i] = vN[h][i];
        }
        if (wr == 1) PG8_BAR;
    }
    PG8_WAIT_V(0);
    PG8_BAR;
#undef PG8_SA
#undef PG8_SB
#undef PG8_STAGE2
#undef PG8_STB
#undef PG8_STA
#undef PG8_LDA
#undef PG8_LDB
#undef PG8_MMA
#undef PG8_WAIT_V
#undef PG8_WAIT_L
#undef PG8_BAR
#undef PG8_SCHED
}
}

namespace att {
typedef unsigned short bf16_t;
using bf16x8 = __attribute__((ext_vector_type(8))) short;
using s16x4  = __attribute__((ext_vector_type(4))) short;
using f32x16 = __attribute__((ext_vector_type(16))) float;
using u32x4  = __attribute__((ext_vector_type(4))) unsigned;
constexpr int NW = 8, QBLK = 32, KVBLK = 64;
constexpr float SCALE = 0.125f;
#ifndef ATT_SGB
#define ATT_SGB 1
#endif
#ifndef ATT_PROBE
#define ATT_PROBE 0
#endif
constexpr float THR = 8.f;
constexpr int SHM_V = KVBLK * 128 * 2, SHM_K = KVBLK * 128 * 2;
constexpr int SHM_ATTN = 2 * SHM_V + 2 * SHM_K + NW * 64 * 4;
#define KSWZ(row, colB) ((row) * 256 + ((colB) ^ (((row) & 7) << 4)))
#define SBAR() __builtin_amdgcn_sched_barrier(0)
#define SGB(mask, n) __builtin_amdgcn_sched_group_barrier((mask), (n), 0)
#define S1_PIPE() do { if (ATT_SGB) { SGB(0x100, 4); _Pragma("unroll") for (int i_ = 0; i_ < 8; ++i_) { SGB(0x008, 1); SGB(0x002, 13); if ((i_ & 1) && i_ < 5) SGB(0x100, 2); } } } while (0)
__device__ __forceinline__ int crow(int r, int hi) { return (r & 3) + 8 * (r >> 2) + 4 * hi; }
typedef float f32x2_a __attribute__((ext_vector_type(2))); typedef __bf16 bf16x2_a __attribute__((ext_vector_type(2)));
__device__ __forceinline__ unsigned cvtpk(float lo, float hi) { const f32x2_a v = {lo, hi}; const bf16x2_a b = __builtin_convertvector(v, bf16x2_a); return __builtin_bit_cast(unsigned, b); }
__device__ __forceinline__ unsigned short f2bf(float f) { return (unsigned short)(cvtpk(f, 0.f) & 0xffffu); }

__device__ __forceinline__ void partialSM(f32x16& p0, f32x16& p1, float& m_reg, float& mn, float& alpha, bool domask, int dq) {
  constexpr float C = SCALE * 1.4426950408889634f;
  if (domask) {
#pragma unroll
    for (int r = 0; r < 16; ++r) { const int d0 = dq + (r & 3) + 8 * (r >> 2), d1 = d0 + 32;
      if (d0 > 128 || d0 < -128) p0[r] = -1e30f; if (d1 > 128 || d1 < -128) p1[r] = -1e30f; }
  }
  float pmax = p0[0];
#pragma unroll
  for (int r = 1; r < 16; ++r) pmax = fmaxf(pmax, p0[r]);
#pragma unroll
  for (int r = 0; r < 16; ++r) pmax = fmaxf(pmax, p1[r]);
  { auto rr = __builtin_amdgcn_permlane32_swap(__float_as_uint(pmax), __float_as_uint(pmax), false, false);
    pmax = fmaxf(__uint_as_float(rr[0]), __uint_as_float(rr[1])); }
  if (__builtin_expect(__all(pmax - m_reg <= THR / SCALE), 1)) { mn = m_reg; alpha = 1.f; }
  else { mn = fmaxf(m_reg, pmax); alpha = __builtin_amdgcn_exp2f((m_reg - mn) * C); m_reg = mn; }
  const float mnC = -mn * C;
#pragma unroll
  for (int r = 0; r < 16; ++r) p0[r] = fmaf(p0[r], C, mnC);
#pragma unroll
  for (int r = 0; r < 16; ++r) p1[r] = fmaf(p1[r], C, mnC);
#pragma unroll
  for (int r = 0; r < 16; ++r) { if (ATT_PROBE == 3) { float x2 = p0[r]; asm volatile("" : "+v"(x2)); p0[r] = 0.5f * (__builtin_amdgcn_exp2f(p0[r]) + __builtin_amdgcn_exp2f(x2)); } else p0[r] = __builtin_amdgcn_exp2f(p0[r]); }
}
__device__ __forceinline__ void finishSM(f32x16& p0, f32x16& p1, float alpha, float& l_reg, bf16x8& pa0, bf16x8& pa1, bf16x8& pa2, bf16x8& pa3, float pscale = 1.0f) {
#pragma unroll
  for (int r = 0; r < 16; ++r) { if (ATT_PROBE == 3) { float x2 = p1[r]; asm volatile("" : "+v"(x2)); p1[r] = 0.5f * (__builtin_amdgcn_exp2f(p1[r]) + __builtin_amdgcn_exp2f(x2)); } else p1[r] = __builtin_amdgcn_exp2f(p1[r]); }
  float ps = 0;
#pragma unroll
  for (int r = 0; r < 16; ++r) ps += p0[r];
#pragma unroll
  for (int r = 0; r < 16; ++r) ps += p1[r];
  { auto rr = __builtin_amdgcn_permlane32_swap(__float_as_uint(ps), __float_as_uint(ps), false, false);
    ps = __uint_as_float(rr[0]) + __uint_as_float(rr[1]); }
  l_reg = l_reg * alpha + ps;
  if (pscale != 1.0f) {
#pragma unroll
    for (int r = 0; r < 16; ++r) { p0[r] *= pscale; p1[r] *= pscale; } }
#define PK4(P, BASE, OUT) do { unsigned a0 = cvtpk(P[BASE + 0], P[BASE + 1]), a1 = cvtpk(P[BASE + 2], P[BASE + 3]);   \
    unsigned b0 = cvtpk(P[BASE + 4], P[BASE + 5]), b1 = cvtpk(P[BASE + 6], P[BASE + 7]);                              \
    auto r0 = __builtin_amdgcn_permlane32_swap(a0, b0, false, false); auto r1 = __builtin_amdgcn_permlane32_swap(a1, b1, false, false); \
    u32x4 w = {r0[0], r1[0], r0[1], r1[1]}; OUT = *reinterpret_cast<bf16x8*>(&w); } while (0)
  PK4(p0, 0, pa0); PK4(p0, 8, pa1); PK4(p1, 0, pa2); PK4(p1, 8, pa3);
#undef PK4
}
__device__ __forceinline__ void qkt(f32x16& p0, f32x16& p1, const char* Ks, const bf16x8* qr, int r32, int hi, int kcolB) {
  p0 = f32x16{}; p1 = f32x16{};
#pragma unroll
  for (int d0 = 0; d0 < 4; ++d0) { const int cb = kcolB + (d0 * 16 + hi * 8) * 2;
    bf16x8 b0 = *reinterpret_cast<const bf16x8*>(Ks + KSWZ(r32, cb));
    bf16x8 b1 = *reinterpret_cast<const bf16x8*>(Ks + KSWZ(32 + r32, cb));
    p0 = __builtin_amdgcn_mfma_f32_32x32x16_bf16(b0, qr[d0], p0, 0, 0, 0);
    p1 = __builtin_amdgcn_mfma_f32_32x32x16_bf16(b1, qr[d0], p1, 0, 0, 0); }
}
__device__ __forceinline__ int v_st(int k, int c) { const int kk = (k & ~0xC) | ((k & 4) << 1) | ((k & 8) >> 1); return ((kk >> 3) * 4 + (c >> 5)) * 512 + ((kk & 7) * 32 + (c & 31)) * 2; }
__device__ __forceinline__ int v_rd_base(int lane) { return ((lane & 3) << 3) | (((lane >> 2) & 3) << 6) | (((lane >> 4) & 1) << 5) | (((lane >> 5) & 1) << 8); }
constexpr int v_rd_off(int d0, int ks, int half) { return d0 * 512 + ks * 4096 + half * 2048; }
template <int OFF> __device__ __forceinline__ s16x4 tr_read(int vb) {
  s16x4 r; asm volatile("ds_read_b64_tr_b16 %0, %1 offset:%2" : "=&v"(r) : "v"(vb), "i"(OFF) : "memory"); return r;
}
template <int D0> __device__ __forceinline__ void pv_one(f32x16& od, int vb, bf16x8 pa0, bf16x8 pa1, bf16x8 pa2, bf16x8 pa3) {
  const s16x4 l0 = tr_read<v_rd_off(D0, 0, 0)>(vb), h0 = tr_read<v_rd_off(D0, 0, 1)>(vb), l1 = tr_read<v_rd_off(D0, 1, 0)>(vb), h1 = tr_read<v_rd_off(D0, 1, 1)>(vb);
  const s16x4 l2 = tr_read<v_rd_off(D0, 2, 0)>(vb), h2 = tr_read<v_rd_off(D0, 2, 1)>(vb), l3 = tr_read<v_rd_off(D0, 3, 0)>(vb), h3 = tr_read<v_rd_off(D0, 3, 1)>(vb);
  asm volatile("s_waitcnt lgkmcnt(0)" ::: "memory"); SBAR();
#define PK(L, H) (bf16x8){L[0], L[1], L[2], L[3], H[0], H[1], H[2], H[3]}
  od = __builtin_amdgcn_mfma_f32_32x32x16_bf16(pa0, PK(l0, h0), od, 0, 0, 0);
  od = __builtin_amdgcn_mfma_f32_32x32x16_bf16(pa1, PK(l1, h1), od, 0, 0, 0);
  od = __builtin_amdgcn_mfma_f32_32x32x16_bf16(pa2, PK(l2, h2), od, 0, 0, 0);
  od = __builtin_amdgcn_mfma_f32_32x32x16_bf16(pa3, PK(l3, h3), od, 0, 0, 0);
#undef PK
}
template <bool DIFF> __device__ __forceinline__ void pv_all(f32x16* o, int vb, bf16x8 pa0, bf16x8 pa1, bf16x8 pa2, bf16x8 pa3) {
  pv_one<0>(o[0], vb, pa0, pa1, pa2, pa3); pv_one<1>(o[1], vb, pa0, pa1, pa2, pa3);
  if constexpr (DIFF) { pv_one<2>(o[2], vb, pa0, pa1, pa2, pa3); pv_one<3>(o[3], vb, pa0, pa1, pa2, pa3); }
}

struct UnitArgs {
  const GAS bf16_t* Q;
  int qg1;
  const GAS bf16_t* K;
  const GAS bf16_t* V;
  int ldk;
  int s1, n1, s2, n2;
  int qpos0;
  float sink0, sink1;
  int use_sink;
  GAS bf16_t* O;
  int og1;
  float lam, post;
  const GAS float* subg;
};

template <bool DIFF, bool MASK>
__device__ __forceinline__ void attn_unit(const UnitArgs& A, char* lds, const int wave0) {
  constexpr int NO = DIFF ? 4 : 2;
  const int lane = lane_now(), tid = wave0 * 64 + lane, wid = wave0, r32 = lane & 31, hi = lane >> 5;
  const int mg = wid >> 2, wq = wid & 3;
  char* V_lds = lds; char* K_lds = lds + 2 * SHM_V;
  float* ws = (float*)(lds + 2 * SHM_V + 2 * SHM_K) + wid * 64; float* li_l = ws; float* al_l = ws + 32;
  float m_reg = -1e30f, l_reg = 0.f;
  if (!DIFF && A.use_sink) { m_reg = (mg ? A.sink1 : A.sink0) * (1.0f / SCALE); l_reg = 1.f; }
  f32x16 o[NO];
#pragma unroll
  for (int d = 0; d < NO; ++d) o[d] = f32x16{};
  bf16x8 qr[4];
  const GAS bf16_t* Qw = A.Q + (mg ? A.qg1 : 0) + (long)(wq * QBLK + r32) * 512 + hi * 8;
#pragma unroll
  for (int d0 = 0; d0 < 4; ++d0) qr[d0] = *(const GAS bf16x8*)(Qw + d0 * 16);
  const int sr = tid >> 4, sc = (tid & 15) * 8, vst0 = v_st(sr, sc), vst1 = v_st(32 + sr, sc);
  const int vb0 = (int)(uintptr_t)V_lds + v_rd_base(lane) + ((!DIFF && mg) ? 1024 : 0);
  const int kcolB = mg * 128;
  const int ldk = A.ldk;
  const GAS bf16_t* Kh = A.K; const GAS bf16_t* Vh = A.V;
  const int NT = A.n1 + A.n2;
  const int qposl = A.qpos0 + wq * QBLK + r32;
  constexpr bool maskunit = MASK;
#define KST(j) ((j) < A.n1 ? A.s1 + (j) * KVBLK : A.s2 + ((j) - A.n1) * KVBLK)
  struct { bf16x8 vs0, vs1, ks0, ks1; } sr_[2];
#define SLOAD(i, k0) do { const long k0_ = (k0); sr_[i].vs0 = *(const GAS bf16x8*)(&Vh[(k0_ + sr) * ldk + sc]); sr_[i].vs1 = *(const GAS bf16x8*)(&Vh[(k0_ + 32 + sr) * ldk + sc]); \
    sr_[i].ks0 = *(const GAS bf16x8*)(&Kh[(k0_ + sr) * ldk + sc]); sr_[i].ks1 = *(const GAS bf16x8*)(&Kh[(k0_ + 32 + sr) * ldk + sc]); } while (0)
#define SWRITE(b, i) do { *(bf16x8*)(V_lds + (b) * SHM_V + vst0) = sr_[i].vs0;          \
    *(bf16x8*)(V_lds + (b) * SHM_V + vst1) = sr_[i].vs1; const int kc = sc * 2;               \
    *(bf16x8*)(K_lds + (b) * SHM_K + KSWZ(sr, kc)) = sr_[i].ks0;                       \
    *(bf16x8*)(K_lds + (b) * SHM_K + KSWZ(32 + sr, kc)) = sr_[i].ks1; } while (0)
#define SWAIT() asm volatile("s_waitcnt vmcnt(4)" ::: "memory")
#define RESC(a) do { if (__any((a) < 1.f)) { if (hi == 0) al_l[r32] = (a); asm volatile("s_waitcnt lgkmcnt(0)" ::: "memory"); \
    _Pragma("unroll") for (int d = 0; d < NO; ++d) _Pragma("unroll") for (int r = 0; r < 16; ++r) o[d][r] *= al_l[crow(r, hi)]; } } while (0)
#define MASKARGS(j) (maskunit && (j) >= A.n1), (KST(j) - qposl + 4 * hi)
  f32x16 pA0, pA1, pB0, pB1; float mnA, mnB, alA, alB; bf16x8 pa0, pa1, pa2, pa3;
  constexpr int SE = 0, SO = 1;
  __syncthreads();
  SLOAD(SE, KST(0)); asm volatile("s_waitcnt vmcnt(0)" ::: "memory"); SWRITE(0, SE); __syncthreads();
  qkt(pA0, pA1, K_lds, qr, r32, hi, kcolB); partialSM(pA0, pA1, m_reg, mnA, alA, MASKARGS(0));
  SLOAD(SO, KST(1)); if (2 < NT) SLOAD(SE, KST(2));
  SWAIT(); SWRITE(1, SO); __syncthreads();
  for (int j = 1; j + 1 < NT; j += 2) {
    SBAR(); qkt(pB0, pB1, K_lds + SHM_K, qr, r32, hi, kcolB);
    if (ATT_PROBE == 1) { asm volatile("" : "+v"(pB0), "+v"(pB1)); qkt(pB0, pB1, K_lds + SHM_K, qr, r32, hi, kcolB); }
    finishSM(pA0, pA1, alA, l_reg, pa0, pa1, pa2, pa3, ATT_PROBE == 2 ? 0.5f : 1.0f); S1_PIPE(); SBAR();
    SLOAD(SO, KST(j + 2)); SBAR();
    if (ATT_PROBE == 2) pv_all<DIFF>(o, vb0, pa0, pa1, pa2, pa3);
    pv_all<DIFF>(o, vb0, pa0, pa1, pa2, pa3); partialSM(pB0, pB1, m_reg, mnB, alB, MASKARGS(j));
    __syncthreads(); SWAIT(); SWRITE(0, SE); if (ATT_PROBE == 4) { asm volatile("" ::: "memory"); SWRITE(0, SE); }
    RESC(alB); __syncthreads();
    SBAR(); qkt(pA0, pA1, K_lds, qr, r32, hi, kcolB);
    if (ATT_PROBE == 1) { asm volatile("" : "+v"(pA0), "+v"(pA1)); qkt(pA0, pA1, K_lds, qr, r32, hi, kcolB); }
    finishSM(pB0, pB1, alB, l_reg, pa0, pa1, pa2, pa3, ATT_PROBE == 2 ? 0.5f : 1.0f); S1_PIPE(); SBAR();
    if (j + 3 < NT) SLOAD(SE, KST(j + 3)); SBAR();
    if (ATT_PROBE == 2) pv_all<DIFF>(o, vb0 + SHM_V, pa0, pa1, pa2, pa3);
    pv_all<DIFF>(o, vb0 + SHM_V, pa0, pa1, pa2, pa3); partialSM(pA0, pA1, m_reg, mnA, alA, MASKARGS(j + 1));
    __syncthreads(); SWAIT(); SWRITE(1, SO); if (ATT_PROBE == 4) { asm volatile("" ::: "memory"); SWRITE(1, SO); }
    RESC(alA); __syncthreads();
  }
  SBAR(); qkt(pB0, pB1, K_lds + SHM_K, qr, r32, hi, kcolB);
  finishSM(pA0, pA1, alA, l_reg, pa0, pa1, pa2, pa3); SBAR();
  pv_all<DIFF>(o, vb0, pa0, pa1, pa2, pa3); partialSM(pB0, pB1, m_reg, mnB, alB, MASKARGS(NT - 1));
  __syncthreads(); RESC(alB);
  finishSM(pB0, pB1, alB, l_reg, pa0, pa1, pa2, pa3); SBAR();
  pv_all<DIFF>(o, vb0 + SHM_V, pa0, pa1, pa2, pa3);
  if (hi == 0) li_l[r32] = l_reg; asm volatile("s_waitcnt lgkmcnt(0)" ::: "memory");
  float rli[16];
#pragma unroll
  for (int r = 0; r < 16; ++r) rli[r] = __builtin_amdgcn_rcpf(li_l[crow(r, hi)]);
  if constexpr (!DIFF) {
    GAS bf16_t* Ow = A.O + (mg ? A.og1 : 0) + (long)(wq * QBLK) * 512;
#pragma unroll
    for (int r = 0; r < 16; ++r) { const int orow = crow(r, hi);
#pragma unroll
      for (int d0 = 0; d0 < 2; ++d0) Ow[(long)orow * 512 + d0 * 32 + r32] = f2bf(o[d0][r] * rli[r]); }
  } else {
    float* ex = (float*)lds;
    __syncthreads();
    if (mg == 1) {
#pragma unroll
      for (int d0 = 0; d0 < 4; ++d0)
#pragma unroll
        for (int r = 0; r < 16; ++r) ex[(wq * 64 + d0 * 16 + r) * 64 + lane] = o[d0][r] * rli[r];
    }
    __syncthreads();
    if (mg == 0) {
      GAS bf16_t* Ow = A.O + (long)(wq * QBLK) * 512;
      float gsub[4];
#pragma unroll
      for (int d0 = 0; d0 < 4; ++d0) gsub[d0] = A.subg[d0 * 32 + r32] * A.post;
#pragma unroll
      for (int r = 0; r < 16; ++r) {
        float v[4]; float ss = 0.f;
#pragma unroll
        for (int d0 = 0; d0 < 4; ++d0) { v[d0] = o[d0][r] * rli[r] - A.lam * ex[(wq * 64 + d0 * 16 + r) * 64 + lane]; ss += v[d0] * v[d0]; }
        ss += __shfl_xor(ss, 1); ss += __shfl_xor(ss, 2); ss += __shfl_xor(ss, 4); ss += __shfl_xor(ss, 8); ss += __shfl_xor(ss, 16);
        const float rn = __builtin_amdgcn_rsqf(ss * (1.0f / 128.0f) + 1e-6f);
        const int orow = crow(r, hi);
#pragma unroll
        for (int d0 = 0; d0 < 4; ++d0) Ow[(long)orow * 512 + d0 * 32 + r32] = f2bf(v[d0] * rn * gsub[d0]);
      }
    }
  }
#undef KST
#undef SLOAD
#undef SWRITE
#undef SWAIT
#undef RESC
#undef MASKARGS
}
#undef KSWZ
}
#include <hip/hip_bf16.h>
namespace att64 {
using bf16=__hip_bfloat16;
using bf16x8=__attribute__((ext_vector_type(8)))short;
using s16x4=__attribute__((ext_vector_type(4)))short;
using f32x16=__attribute__((ext_vector_type(16)))float;
using u32x4=__attribute__((ext_vector_type(4)))unsigned;
constexpr int D=64;
constexpr int NW=8,QBLK=32,QB=QBLK*NW,KVBLK=64;
__device__ __forceinline__ int crow(int r,int hi){return (r&3)+8*(r>>2)+4*hi;}
#define SBAR() __builtin_amdgcn_sched_barrier(0)
__device__ __forceinline__ void bmask(f32x16&p0,f32x16&p1,int dq){
  const float NEG=-INFINITY;
  #pragma unroll
  for(int r=0;r<16;++r){const int d0=dq+(r&3)+8*(r>>2),d1=d0+32; if(d0>128||d0<-128)p0[r]=NEG; if(d1>128||d1<-128)p1[r]=NEG;}
}
constexpr int NSLOT=3, SLOTB=8192;
constexpr int LDS_K=0, LDS_V=NSLOT*SLOTB, LDS_WS=2*NSLOT*SLOTB, LDS_OST=LDS_WS+NW*64*4, LDS_BYTES=LDS_OST+NW*4096;
constexpr float C2=0.125f*1.4426950408889634f;
__device__ __forceinline__ void glds16(const void*gsrc,unsigned lds_dst){unsigned keep;
  asm volatile("s_mov_b32 %0, m0\n\ts_mov_b32 m0, %2\n\ts_nop 0\n\tglobal_load_lds_dwordx4 %1, off\n\ts_mov_b32 m0, %0":"=&s"(keep):"v"(gsrc),"s"(lds_dst):"memory");}
__device__ __forceinline__ float max3f(float a,float b,float c){float r;asm("v_max3_f32 %0, %1, %2, %3":"=v"(r):"v"(a),"v"(b),"v"(c));return r;}
__device__ __forceinline__ float max2f(float a,float b){float r;asm("v_max_f32_e32 %0, %1, %2":"=v"(r):"v"(a),"v"(b));return r;}
__device__ __forceinline__ float fadd_s(float a,float b){float r;asm("v_add_f32_e32 %0, %1, %2":"=v"(r):"v"(a),"v"(b));return r;}
__device__ __forceinline__ float fsub_s(float a,float b){float r;asm("v_sub_f32_e32 %0, %1, %2":"=v"(r):"v"(a),"v"(b));return r;}
typedef float f32x2_t __attribute__((ext_vector_type(2))); typedef __bf16 bf16x2_t __attribute__((ext_vector_type(2)));
__device__ __forceinline__ unsigned cvtpk_s(float lo,float hi){f32x2_t v={lo,hi};bf16x2_t b=__builtin_convertvector(v,bf16x2_t);return __builtin_bit_cast(unsigned,b);}
#define WAIT_BAR(N) asm volatile("s_waitcnt vmcnt(" #N ") lgkmcnt(0)\n\ts_barrier":::"memory")

__device__ __forceinline__ void qkt(f32x16&p0,f32x16&p1,const char*Kslot,const bf16x8*qr,const f32x16&negm,int r32,int hi){
  const char*kb=Kslot+hi*1024+r32*16;
  #pragma unroll
  for(int d0=0;d0<4;++d0){
    const bf16x8 b0=*reinterpret_cast<const bf16x8*>(kb+d0*2048);
    const bf16x8 b1=*reinterpret_cast<const bf16x8*>(kb+d0*2048+512);
    if(d0==0){p0=__builtin_amdgcn_mfma_f32_32x32x16_bf16(b0,qr[0],negm,0,0,0);p1=__builtin_amdgcn_mfma_f32_32x32x16_bf16(b1,qr[0],negm,0,0,0);}
    else{p0=__builtin_amdgcn_mfma_f32_32x32x16_bf16(b0,qr[d0],p0,0,0,0);p1=__builtin_amdgcn_mfma_f32_32x32x16_bf16(b1,qr[d0],p1,0,0,0);}}
}
typedef __attribute__((address_space(3))) const char* lds_cptr;
typedef short v4i16_t __attribute__((ext_vector_type(4)));
__device__ __forceinline__ void kload8(bf16x8*kf,lds_cptr kp){
  kf[0]=*(const __attribute__((address_space(3))) bf16x8*)(kp);      kf[1]=*(const __attribute__((address_space(3))) bf16x8*)(kp+512);
  kf[2]=*(const __attribute__((address_space(3))) bf16x8*)(kp+2048); kf[3]=*(const __attribute__((address_space(3))) bf16x8*)(kp+2560);
  kf[4]=*(const __attribute__((address_space(3))) bf16x8*)(kp+4096); kf[5]=*(const __attribute__((address_space(3))) bf16x8*)(kp+4608);
  kf[6]=*(const __attribute__((address_space(3))) bf16x8*)(kp+6144); kf[7]=*(const __attribute__((address_space(3))) bf16x8*)(kp+6656);
}
__device__ __forceinline__ void kload2(bf16x8*kf,lds_cptr kp,int j){ kf[2*j]=*(const __attribute__((address_space(3))) bf16x8*)(kp+j*2048); kf[2*j+1]=*(const __attribute__((address_space(3))) bf16x8*)(kp+j*2048+512); }
__device__ __forceinline__ s16x4 vtr(lds_cptr p){ return __builtin_bit_cast(s16x4,__builtin_amdgcn_ds_read_tr16_b64_v4i16((__attribute__((address_space(3))) v4i16_t*)p)); }
__device__ __forceinline__ float rowmax(const f32x16&p0,const f32x16&p1){
  float a=max3f(p0[0],p0[1],p1[0]),b=max3f(p0[2],p0[3],p1[1]);a=max3f(a,p1[2],p1[3]);
  #pragma unroll
  for(int r=4;r<16;r+=4){a=max3f(a,p0[r],p0[r+1]);b=max3f(b,p0[r+2],p0[r+3]);a=max3f(a,p1[r],p1[r+1]);b=max3f(b,p1[r+2],p1[r+3]);}
  const float m=max2f(a,b);
  auto rr=__builtin_amdgcn_permlane32_swap(__float_as_uint(m),__float_as_uint(m),false,false);
  return max2f(__uint_as_float(rr[0]),__uint_as_float(rr[1]));
}
__device__ __forceinline__ void pv(f32x16*o,int vb,bf16x8 pa0,bf16x8 pa1,bf16x8 pa2,bf16x8 pa3){
  #pragma unroll
  for(int d0=0;d0<2;++d0){s16x4 lo[4],hi[4];
    #pragma unroll
    for(int ks=0;ks<4;++ks){
      asm volatile("ds_read_b64_tr_b16 %0,%1 offset:%c2":"=&v"(lo[ks]):"v"(vb),"i"(d0*4096+ks*1024):"memory");
      asm volatile("ds_read_b64_tr_b16 %0,%1 offset:%c2":"=&v"(hi[ks]):"v"(vb),"i"(d0*4096+ks*1024+512):"memory");}
    asm volatile("s_waitcnt lgkmcnt(0)":::"memory");SBAR();
    #define PK(k) (bf16x8){lo[k][0],lo[k][1],lo[k][2],lo[k][3],hi[k][0],hi[k][1],hi[k][2],hi[k][3]}
    o[d0]=__builtin_amdgcn_mfma_f32_32x32x16_bf16(pa0,PK(0),o[d0],0,0,0);
    o[d0]=__builtin_amdgcn_mfma_f32_32x32x16_bf16(pa1,PK(1),o[d0],0,0,0);
    o[d0]=__builtin_amdgcn_mfma_f32_32x32x16_bf16(pa2,PK(2),o[d0],0,0,0);
    o[d0]=__builtin_amdgcn_mfma_f32_32x32x16_bf16(pa3,PK(3),o[d0],0,0,0);
    #undef PK
  }
}

#ifndef ATTN_STORE16
#define ATTN_STORE16(p,v) (*(u32x4*)(p)=(v))
#endif
template<int THRL,bool MASK,bool PAIR> __device__ __forceinline__ void attn_unit(const bf16*Qu,int qp,const bf16*__restrict__ Kh,const bf16*__restrict__ Vh,int kvp,int NT,int n1,int s2,int kpos2,int qpos0,int use_sink,float sink_l2,float sink_l2b,bf16*Ou,int op,char*shm,const int wave0){
  const int lane=lane_now(),tid=wave0*64+lane,r32=lane&31,hi=lane>>5; const int wid=wave0;
  const int wrow=PAIR?(wid&3):wid, whead=PAIR?(wid>>2):0;
  const bf16*Qw=Qu+(long)(wrow*QBLK)*qp+whead*D;
  const unsigned lds0=(unsigned)(uintptr_t)shm;
  float*wsf=(float*)(shm+LDS_WS)+wid*64;
  const bf16*ksrc=Kh+(long)lane*kvp+wid*8;
  const bf16*vsrc=Vh+(long)(16*(wid&3)+(lane>>2))*kvp+(wid>>2)*32+(lane&3)*8;
  const unsigned kdst=lds0+LDS_K+wid*1024, vdst=lds0+LDS_V+wid*1024;
  #define KROW(t) ((t)<n1?(t)*KVBLK:s2+((t)-n1)*KVBLK)
  #define DMA_K(t,slot) glds16(ksrc+(long)KROW(t)*kvp,(unsigned)__builtin_amdgcn_readfirstlane(kdst+(slot)))
  #define DMA_V(t,slot) glds16(vsrc+(long)KROW(t)*kvp,(unsigned)__builtin_amdgcn_readfirstlane(vdst+(slot)))
  const int vb0=(int)(lds0+LDS_V)+((lane>>4)&1)*32+(lane&3)*8+(4*hi+((lane&15)>>2))*64;
  const char*Kbase=shm+LDS_K; bf16x8 kf[8];
  const lds_cptr shm3=(lds_cptr)shm; const lds_cptr kp0=shm3+LDS_K+hi*1024+r32*16; const lds_cptr vp0=shm3+LDS_V+((lane>>4)&1)*32+(lane&3)*8+(4*hi+((lane&15)>>2))*64;
  DMA_K(0,0);DMA_V(0,0);DMA_K(1,SLOTB);
  bf16x8 qr[4];
  #pragma unroll
  for(int d0=0;d0<4;++d0)qr[d0]=*reinterpret_cast<const bf16x8*>(&Qw[(long)r32*qp+d0*16+hi*8]);
  float mhat=0.f,l_reg=0.f;f32x16 o[2];o[0]=f32x16{};o[1]=f32x16{};f32x16 negm=f32x16{};asm volatile("":"+v"(negm));
  const int dqb=kpos2-(qpos0+wrow*QBLK+r32)+4*hi;
  #define CMASK(P0,P1,t) do{ if(MASK&&(t)>=n1) bmask(P0,P1,dqb+((t)-n1)*KVBLK); }while(0)
  bool resc=false;
  #define START(P0,P1) do{ const float rm=rowmax(P0,P1); resc=false; \
    { const float dl=rm; mhat=fadd_s(mhat,dl); \
      _Pragma("unroll") for(int r=0;r<16;++r){P0[r]=fsub_s(P0[r],dl);P1[r]=fsub_s(P1[r],dl);} \
      _Pragma("unroll") for(int r=0;r<16;++r)negm[r]=-mhat; asm volatile("":"+v"(negm)); } \
    _Pragma("unroll") for(int r=0;r<16;++r)P0[r]=__builtin_amdgcn_exp2f(P0[r]); }while(0)
  #define RESC() do{ if(resc){ asm volatile("s_waitcnt lgkmcnt(0)":::"memory"); \
      _Pragma("unroll") for(int d_=0;d_<2;++d_) _Pragma("unroll") for(int r=0;r<16;++r)o[d_][r]*=wsf[crow(r,hi)]; } }while(0)
  f32x16 pA0,pA1,pB0,pB1;
  int sl_prev=0,sl_cur=0,sl_next=SLOTB;
  #define ROT() do{sl_prev=sl_cur;sl_cur=sl_next;sl_next=(sl_next==(NSLOT-1)*SLOTB)?0:sl_next+SLOTB;}while(0)
  DMA_K(2,2*SLOTB);
  WAIT_BAR(3);
  qkt(pA0,pA1,Kbase,qr,f32x16{},r32,hi);asm volatile("s_nop 15\n\ts_nop 7":"+v"(pA0),"+v"(pA1));CMASK(pA0,pA1,0);
  START(pA0,pA1);
  _Pragma("unroll") for(int r=0;r<16;++r)pA1[r]=__builtin_amdgcn_exp2f(pA1[r]);
  WAIT_BAR(0);
  DMA_K(3,0);DMA_V(1,SLOTB);
  ROT();
  kload8(kf,kp0+sl_cur);
  WAIT_BAR(2);
  s16x4 vlo[8],vhi[8]; u32x4 pw0,pw1,pw2,pw3;
  #define PKW(P,B) cvtpk_s(P[B],P[B+1])
  #define PAF(k) __builtin_bit_cast(bf16x8,pw##k)
  #define VFR(i) (bf16x8){vlo[i][0],vlo[i][1],vlo[i][2],vlo[i][3],vhi[i][0],vhi[i][1],vhi[i][2],vhi[i][3]}
  #define PIN(x) asm volatile("":"+v"(x))
  #define MX3(a,b,c) __builtin_fmaxf(__builtin_fmaxf((a),(b)),(c))
  #define GAPA(MF,A0,A1,A2,A3,W0,W1,PW) do{ MF; sacc+=A0; sacc+=A1; sacc+=A2; sacc+=A3; PIN(sacc); W0; W1; PIN(PW); SBAR(); }while(0)
  #define EX(v) __builtin_amdgcn_exp2f(v)
  #define GAPB(MF,X,B) do{ MF; X[B]=EX(X[B]); X[B+1]=EX(X[B+1]); X[B+2]=EX(X[B+2]); X[B+3]=EX(X[B+3]); PIN(X); SBAR(); }while(0)
  #define VRD(i) do{ vlo[i]=vtr(vp_+(((i)>>2)*4096+((i)&3)*1024)); vhi[i]=vtr(vp_+(((i)>>2)*4096+((i)&3)*1024+512)); }while(0)
  #define KRD(G,j) do{ if(G){ kload2(kf,kp0+sl_next,j); SBAR(); } }while(0)
  #define STEP(C0,C1,P0,P1,t,GK,GV,GL) do{ SBAR(); \
    const lds_cptr vp_=vp0+sl_prev; \
    VRD(0); SBAR(); float sacc=(P0[0]+P0[1]); \
    GAPA(C0=__builtin_amdgcn_mfma_f32_32x32x16_bf16(kf[0],qr[0],negm,0,0,0), P0[2],P0[3],P0[4],P0[5],     pw0[0]=PKW(P0,0), pw0[1]=PKW(P0,2), pw0); \
    VRD(4); SBAR(); GAPA(C1=__builtin_amdgcn_mfma_f32_32x32x16_bf16(kf[1],qr[0],negm,0,0,0), P0[6],P0[7],P0[8],P0[9],     pw0[2]=PKW(P0,4), pw0[3]=PKW(P0,6), pw0); \
    VRD(1); SBAR(); GAPA(C0=__builtin_amdgcn_mfma_f32_32x32x16_bf16(kf[2],qr[1],C0,0,0,0),   P0[10],P0[11],P0[12],P0[13], pw1[0]=PKW(P0,8), pw1[1]=PKW(P0,10), pw1); \
    VRD(5); SBAR(); GAPA(C1=__builtin_amdgcn_mfma_f32_32x32x16_bf16(kf[3],qr[1],C1,0,0,0),   P0[14],P0[15],P1[0],P1[1],   pw1[2]=PKW(P0,12),pw1[3]=PKW(P0,14), pw1); \
    VRD(2); SBAR(); GAPA(C0=__builtin_amdgcn_mfma_f32_32x32x16_bf16(kf[4],qr[2],C0,0,0,0),   P1[2],P1[3],P1[4],P1[5],     pw2[0]=PKW(P1,0), pw2[1]=PKW(P1,2), pw2); \
    VRD(6); SBAR(); GAPA(C1=__builtin_amdgcn_mfma_f32_32x32x16_bf16(kf[5],qr[2],C1,0,0,0),   P1[6],P1[7],P1[8],P1[9],     pw2[2]=PKW(P1,4), pw2[3]=PKW(P1,6), pw2); \
    VRD(3); SBAR(); GAPA(C0=__builtin_amdgcn_mfma_f32_32x32x16_bf16(kf[6],qr[3],C0,0,0,0),   P1[10],P1[11],P1[12],P1[13], pw3[0]=PKW(P1,8), pw3[1]=PKW(P1,10), pw3); \
    VRD(7); SBAR(); GAPA(C1=__builtin_amdgcn_mfma_f32_32x32x16_bf16(kf[7],qr[3],C1,0,0,0),   P1[14],P1[15],0.f,0.f,       pw3[2]=PKW(P1,12),pw3[3]=PKW(P1,14), pw3); \
    l_reg+=sacc; \
    if(GK){DMA_K((t)+3,sl_cur);} if(GV){DMA_V((t)+1,sl_next);} \
    CMASK(C0,C1,t); \
    { float a=MX3(C0[0],C0[1],C1[0]),b=MX3(C0[2],C0[3],C1[1]); a=MX3(a,C1[2],C1[3]); \
      _Pragma("unroll") for(int r=4;r<16;r+=4){a=MX3(a,C0[r],C0[r+1]);b=MX3(b,C0[r+2],C0[r+3]);a=MX3(a,C1[r],C1[r+1]);b=MX3(b,C1[r+2],C1[r+3]);} \
      float rm=__builtin_fmaxf(a,b); { auto rr=__builtin_amdgcn_permlane32_swap(__float_as_uint(rm),__float_as_uint(rm),false,false); rm=__builtin_fmaxf(__uint_as_float(rr[0]),__uint_as_float(rr[1])); } \
      resc=false;                                              \
      if(__builtin_expect(__any(rm>(float)THRL),0)){ const float dl=__builtin_fmaxf(rm,0.f); mhat+=dl; \
        _Pragma("unroll") for(int r=0;r<16;++r){C0[r]-=dl;C1[r]-=dl;} \
        _Pragma("unroll") for(int r=0;r<16;++r)negm[r]=-mhat; asm volatile("":"+v"(negm)); \
        const float f=__builtin_amdgcn_exp2f(-dl); l_reg*=f; if(hi==0)wsf[r32]=f; resc=true; } } \
    SBAR(); \
    GAPB(o[0]=__builtin_amdgcn_mfma_f32_32x32x16_bf16(PAF(0),VFR(0),o[0],0,0,0), C0,0); \
    GAPB(o[1]=__builtin_amdgcn_mfma_f32_32x32x16_bf16(PAF(0),VFR(4),o[1],0,0,0), C0,4); \
    KRD(GL,0); GAPB(o[0]=__builtin_amdgcn_mfma_f32_32x32x16_bf16(PAF(1),VFR(1),o[0],0,0,0), C0,8); \
    KRD(GL,1); GAPB(o[1]=__builtin_amdgcn_mfma_f32_32x32x16_bf16(PAF(1),VFR(5),o[1],0,0,0), C0,12); \
    KRD(GL,2); GAPB(o[0]=__builtin_amdgcn_mfma_f32_32x32x16_bf16(PAF(2),VFR(2),o[0],0,0,0), C1,0); \
    KRD(GL,3); GAPB(o[1]=__builtin_amdgcn_mfma_f32_32x32x16_bf16(PAF(2),VFR(6),o[1],0,0,0), C1,4); \
    GAPB(o[0]=__builtin_amdgcn_mfma_f32_32x32x16_bf16(PAF(3),VFR(3),o[0],0,0,0), C1,8); \
    GAPB(o[1]=__builtin_amdgcn_mfma_f32_32x32x16_bf16(PAF(3),VFR(7),o[1],0,0,0), C1,12); \
    }while(0)
  int t=1;
  for(;t+5<NT;t+=2){
    STEP(pB0,pB1,pA0,pA1,t,true,true,true);     WAIT_BAR(2); RESC(); ROT();
    STEP(pA0,pA1,pB0,pB1,t+1,true,true,true);   WAIT_BAR(2); RESC(); ROT();
  }
  #define ENDW(tt) do{ if((tt)+3<NT){WAIT_BAR(2);} else if((tt)+2<NT){WAIT_BAR(1);} else {WAIT_BAR(0);} }while(0)
  for(;t+1<NT;t+=2){
    STEP(pB0,pB1,pA0,pA1,t,(t+3<NT),(t+1<NT),(t+1<NT));       ENDW(t);   RESC(); ROT();
    STEP(pA0,pA1,pB0,pB1,t+1,(t+4<NT),(t+2<NT),(t+2<NT));     ENDW(t+1); RESC(); ROT();
  }
  STEP(pB0,pB1,pA0,pA1,NT-1,false,false,false); RESC();
  { float sacc=pB0[0]+pB0[1]; _Pragma("unroll") for(int r=2;r<16;++r)sacc+=pB0[r]; _Pragma("unroll") for(int r=0;r<16;++r)sacc+=pB1[r]; l_reg+=sacc;
    pw0=(u32x4){PKW(pB0,0),PKW(pB0,2),PKW(pB0,4),PKW(pB0,6)};pw1=(u32x4){PKW(pB0,8),PKW(pB0,10),PKW(pB0,12),PKW(pB0,14)};pw2=(u32x4){PKW(pB1,0),PKW(pB1,2),PKW(pB1,4),PKW(pB1,6)};pw3=(u32x4){PKW(pB1,8),PKW(pB1,10),PKW(pB1,12),PKW(pB1,14)};
    SBAR(); pv(o,vb0+sl_cur,PAF(0),PAF(1),PAF(2),PAF(3)); }
  #undef PKW
  #undef PAF
  #undef VFR
  #undef PIN
  #undef MX3
  #undef GAPA
  #undef GAPB
  #undef EX
  #undef VRD
  #undef KRD
  #undef STEP
  #undef ENDW
  {auto rr=__builtin_amdgcn_permlane32_swap(__float_as_uint(l_reg),__float_as_uint(l_reg),false,false);l_reg=__uint_as_float(rr[0])+__uint_as_float(rr[1]);}
  if(use_sink) l_reg+=__builtin_amdgcn_exp2f(fminf((whead?sink_l2b:sink_l2)-mhat,120.f));
  if(hi==0)wsf[32+r32]=l_reg;asm volatile("s_waitcnt lgkmcnt(0)":::"memory");
  float rli[16];
  #pragma unroll
  for(int r=0;r<16;++r)rli[r]=__builtin_amdgcn_rcpf(wsf[32+crow(r,hi)]);
  bf16*Ow=Ou+(long)(wrow*QBLK)*op+whead*D;
  { bf16*stg=(bf16*)(shm+LDS_OST)+wid*2048;
    #pragma unroll
    for(int r=0;r<16;++r){const int orow=crow(r,hi);
      #pragma unroll
      for(int d0=0;d0<2;++d0)stg[orow*64+d0*32+r32]=__float2bfloat16(o[d0][r]*rli[r]);}
    asm volatile("s_waitcnt lgkmcnt(0)":::"memory");
    #pragma unroll
    for(int i=0;i<4;++i){const int row=i*8+(lane>>3),ch=lane&7; const u32x4 v=*(const u32x4*)(stg+row*64+ch*8); ATTN_STORE16(Ow+(long)row*op+ch*8,v);} }
  asm volatile("s_waitcnt lgkmcnt(0)\n\ts_barrier":::"memory");
  #undef KROW
  #undef DMA_K
  #undef DMA_V
  #undef CMASK
  #undef START
  #undef RESC
  #undef ROT
}
#undef SBAR
#undef WAIT_BAR
}
namespace att128 {
using att64::bf16; using att64::bf16x8; using att64::s16x4; using att64::f32x16; using att64::u32x4; using att64::lds_cptr;
using att64::crow; using att64::glds16; using att64::cvtpk_s; using att64::kload8; using att64::kload2; using att64::vtr; using att64::rowmax; using att64::qkt; using att64::fadd_s; using att64::fsub_s;
typedef float f32x4v __attribute__((ext_vector_type(4)));
constexpr int D=64,NW=8,QBLK=32,KVBLK=64;
constexpr int NSLOT=3, SLOTB=8192;
constexpr int LDS_K=0, LDS_V=NSLOT*SLOTB, LDS_WS=LDS_V+2*NSLOT*SLOTB, LDS_O1=LDS_WS+NW*64*4, LDS_BYTES=LDS_O1+NW*8192;
#define SBAR() __builtin_amdgcn_sched_barrier(0)
#define WAIT_BAR(N) asm volatile("s_waitcnt vmcnt(" #N ") lgkmcnt(0)\n\ts_barrier":::"memory")
__device__ __forceinline__ void pv4(f32x16*o,int vb,bf16x8 pa0,bf16x8 pa1,bf16x8 pa2,bf16x8 pa3){
  #pragma unroll
  for(int d0=0;d0<4;++d0){s16x4 lo[4],hi[4];
    #pragma unroll
    for(int ks=0;ks<4;++ks){
      asm volatile("ds_read_b64_tr_b16 %0,%1 offset:%c2":"=&v"(lo[ks]):"v"(vb),"i"(d0*4096+ks*1024):"memory");
      asm volatile("ds_read_b64_tr_b16 %0,%1 offset:%c2":"=&v"(hi[ks]):"v"(vb),"i"(d0*4096+ks*1024+512):"memory");}
    asm volatile("s_waitcnt lgkmcnt(0)":::"memory");SBAR();
    #define PK(k) (bf16x8){lo[k][0],lo[k][1],lo[k][2],lo[k][3],hi[k][0],hi[k][1],hi[k][2],hi[k][3]}
    o[d0]=__builtin_amdgcn_mfma_f32_32x32x16_bf16(pa0,PK(0),o[d0],0,0,0);
    o[d0]=__builtin_amdgcn_mfma_f32_32x32x16_bf16(pa1,PK(1),o[d0],0,0,0);
    o[d0]=__builtin_amdgcn_mfma_f32_32x32x16_bf16(pa2,PK(2),o[d0],0,0,0);
    o[d0]=__builtin_amdgcn_mfma_f32_32x32x16_bf16(pa3,PK(3),o[d0],0,0,0);
    #undef PK
  }
}
template<int THRL> __device__ __forceinline__ void attn_unit(const bf16*Qu,int qp,const bf16*__restrict__ Kh,const bf16*__restrict__ Vh,int kvp,int NT,int second,float lam,const GAS float*subg,float post,bf16*Ou,int op,char*shm,const int wave0){
  const int lane=lane_now(),r32=lane&31,hi=lane>>5; const int wid=wave0;
  const bf16*Qw=Qu+(long)(wid*QBLK)*qp;
  const unsigned lds0=(unsigned)(uintptr_t)shm;
  float*wsf=(float*)(shm+LDS_WS)+wid*64;
  const bf16*ksrc=Kh+(long)lane*kvp+wid*8;
  const bf16*vsrc=Vh+(long)(16*(wid&3)+(lane>>2))*kvp+(wid>>2)*32+(lane&3)*8;
  const unsigned kdst=lds0+LDS_K+wid*1024, vdst=lds0+LDS_V+wid*1024;
  #define DMA_K(t,slot) glds16(ksrc+(long)((t)*KVBLK)*kvp,(unsigned)__builtin_amdgcn_readfirstlane(kdst+(slot)))
  #define DMA_V(t,slot) do{ glds16(vsrc+(long)((t)*KVBLK)*kvp,(unsigned)__builtin_amdgcn_readfirstlane(vdst+2*(slot))); glds16(vsrc+(long)((t)*KVBLK)*kvp+64,(unsigned)__builtin_amdgcn_readfirstlane(vdst+2*(slot)+8192)); }while(0)
  const int vb0=(int)(lds0+LDS_V)+((lane>>4)&1)*32+(lane&3)*8+(4*hi+((lane&15)>>2))*64;
  const char*Kbase=shm+LDS_K; bf16x8 kf[8];
  const lds_cptr shm3=(lds_cptr)shm; const lds_cptr kp0=shm3+LDS_K+hi*1024+r32*16; const lds_cptr vp0=shm3+LDS_V+((lane>>4)&1)*32+(lane&3)*8+(4*hi+((lane&15)>>2))*64;
  DMA_K(0,0);DMA_V(0,0);DMA_K(1,SLOTB);
  bf16x8 qr[4];
  #pragma unroll
  for(int d0=0;d0<4;++d0)qr[d0]=*reinterpret_cast<const bf16x8*>(&Qw[(long)r32*qp+d0*16+hi*8]);
  float mhat=0.f,l_reg=0.f;f32x16 o[4];o[0]=f32x16{};o[1]=f32x16{};o[2]=f32x16{};o[3]=f32x16{};
  bool resc=false;
  #define START(P0,P1) do{ const float rm=rowmax(P0,P1); resc=false; \
    { const float dl=rm; mhat=fadd_s(mhat,dl); \
      _Pragma("unroll") for(int r=0;r<16;++r){P0[r]=fsub_s(P0[r],dl);P1[r]=fsub_s(P1[r],dl);} \
      } \
    _Pragma("unroll") for(int r=0;r<16;++r)P0[r]=__builtin_amdgcn_exp2f(P0[r]); }while(0)
  #define RESC() do{ if(resc){ asm volatile("s_waitcnt lgkmcnt(0)":::"memory"); \
      _Pragma("unroll") for(int r=0;r<16;++r){ const float f_=wsf[crow(r,hi)]; o[0][r]*=f_;o[1][r]*=f_;o[2][r]*=f_;o[3][r]*=f_; } } }while(0)
  f32x16 pA0,pA1,pB0,pB1;
  int sl_prev=0,sl_cur=0,sl_next=SLOTB;
  #define ROT() do{sl_prev=sl_cur;sl_cur=sl_next;sl_next=(sl_next==(NSLOT-1)*SLOTB)?0:sl_next+SLOTB;}while(0)
  DMA_K(2,2*SLOTB);
  WAIT_BAR(4);
  qkt(pA0,pA1,Kbase,qr,f32x16{},r32,hi);asm volatile("s_nop 15\n\ts_nop 7":"+v"(pA0),"+v"(pA1));
  START(pA0,pA1);
  _Pragma("unroll") for(int r=0;r<16;++r)pA1[r]=__builtin_amdgcn_exp2f(pA1[r]);
  WAIT_BAR(0);
  DMA_K(3,0);DMA_V(1,SLOTB);
  ROT();
  kload8(kf,kp0+sl_cur);
  WAIT_BAR(3);
  s16x4 vlo[16],vhi[16]; u32x4 pw0,pw1,pw2,pw3;
  #define PKW(P,B) cvtpk_s(P[B],P[B+1])
  #define PAF(k) __builtin_bit_cast(bf16x8,pw##k)
  #define VFR(i) (bf16x8){vlo[i][0],vlo[i][1],vlo[i][2],vlo[i][3],vhi[i][0],vhi[i][1],vhi[i][2],vhi[i][3]}
  #define PIN(x) asm volatile("":"+v"(x))
  #define MX3(a,b,c) __builtin_fmaxf(__builtin_fmaxf((a),(b)),(c))
  #define GAPA(MF,A0,A1,A2,A3,W0,W1,PW) do{ MF; sacc+=A0; sacc+=A1; sacc+=A2; sacc+=A3; PIN(sacc); W0; W1; PIN(PW); SBAR(); }while(0)
  #define EX(v) __builtin_amdgcn_exp2f(v)
  #define GAPB(MF,X,B) do{ MF; X[B]=EX(X[B]); X[B+1]=EX(X[B+1]); PIN(X); SBAR(); }while(0)
  #define VRD(n) do{ vlo[n]=vtr(vp_+(((n)&3)*4096+((n)>>2)*1024)); vhi[n]=vtr(vp_+(((n)&3)*4096+((n)>>2)*1024+512)); }while(0)
  #define KRD(G,j) do{ if(G){ kload2(kf,kp0+sl_next,j); SBAR(); } }while(0)
  #define PVM(n,k) o[(n)&3]=__builtin_amdgcn_mfma_f32_32x32x16_bf16(PAF(k),VFR(n),o[(n)&3],0,0,0)
  #define STEP(C0,C1,P0,P1,t,GK,GV,GL) do{ SBAR(); \
    const lds_cptr vp_=vp0+2*sl_prev; \
    VRD(0); SBAR(); float sacc=(P0[0]+P0[1]); \
    GAPA(C0=__builtin_amdgcn_mfma_f32_32x32x16_bf16(kf[0],qr[0],f32x16{},0,0,0), P0[2],P0[3],P0[4],P0[5],     pw0[0]=PKW(P0,0), pw0[1]=PKW(P0,2), pw0); \
    VRD(1); SBAR(); GAPA(C1=__builtin_amdgcn_mfma_f32_32x32x16_bf16(kf[1],qr[0],f32x16{},0,0,0), P0[6],P0[7],P0[8],P0[9],     pw0[2]=PKW(P0,4), pw0[3]=PKW(P0,6), pw0); \
    VRD(2); SBAR(); GAPA(C0=__builtin_amdgcn_mfma_f32_32x32x16_bf16(kf[2],qr[1],C0,0,0,0),   P0[10],P0[11],P0[12],P0[13], pw1[0]=PKW(P0,8), pw1[1]=PKW(P0,10), pw1); \
    VRD(3); SBAR(); GAPA(C1=__builtin_amdgcn_mfma_f32_32x32x16_bf16(kf[3],qr[1],C1,0,0,0),   P0[14],P0[15],P1[0],P1[1],   pw1[2]=PKW(P0,12),pw1[3]=PKW(P0,14), pw1); \
    VRD(4); SBAR(); GAPA(C0=__builtin_amdgcn_mfma_f32_32x32x16_bf16(kf[4],qr[2],C0,0,0,0),   P1[2],P1[3],P1[4],P1[5],     pw2[0]=PKW(P1,0), pw2[1]=PKW(P1,2), pw2); \
    VRD(5); SBAR(); GAPA(C1=__builtin_amdgcn_mfma_f32_32x32x16_bf16(kf[5],qr[2],C1,0,0,0),   P1[6],P1[7],P1[8],P1[9],     pw2[2]=PKW(P1,4), pw2[3]=PKW(P1,6), pw2); \
    VRD(6); SBAR(); GAPA(C0=__builtin_amdgcn_mfma_f32_32x32x16_bf16(kf[6],qr[3],C0,0,0,0),   P1[10],P1[11],P1[12],P1[13], pw3[0]=PKW(P1,8), pw3[1]=PKW(P1,10), pw3); \
    VRD(7); SBAR(); GAPA(C1=__builtin_amdgcn_mfma_f32_32x32x16_bf16(kf[7],qr[3],C1,0,0,0),   P1[14],P1[15],0.f,0.f,       pw3[2]=PKW(P1,12),pw3[3]=PKW(P1,14), pw3); \
    l_reg+=sacc; \
    if(GK){DMA_K((t)+3,sl_cur);} if(GV){DMA_V((t)+1,sl_next);} \
    { float a=MX3(C0[0],C0[1],C1[0]),b=MX3(C0[2],C0[3],C1[1]); a=MX3(a,C1[2],C1[3]); \
      _Pragma("unroll") for(int r=4;r<16;r+=4){a=MX3(a,C0[r],C0[r+1]);b=MX3(b,C0[r+2],C0[r+3]);a=MX3(a,C1[r],C1[r+1]);b=MX3(b,C1[r+2],C1[r+3]);} \
      float rm=__builtin_fmaxf(a,b); { auto rr=__builtin_amdgcn_permlane32_swap(__float_as_uint(rm),__float_as_uint(rm),false,false); rm=__builtin_fmaxf(__uint_as_float(rr[0]),__uint_as_float(rr[1])); } \
      rm-=mhat; \
      resc=false; \
      if(__builtin_expect(__any(rm>(float)THRL),0)){ const float dl=__builtin_fmaxf(rm,0.f); mhat+=dl; \
        const float f=__builtin_amdgcn_exp2f(-dl); l_reg*=f; if(hi==0)wsf[r32]=f; resc=true; } \
      _Pragma("unroll") for(int r=0;r<16;++r){C0[r]-=mhat;C1[r]-=mhat;} } \
    SBAR(); \
    VRD(8);  SBAR(); GAPB(PVM(0,0),C0,0); \
    VRD(9);  SBAR(); GAPB(PVM(1,0),C0,2); \
    VRD(10); SBAR(); GAPB(PVM(2,0),C0,4); \
    VRD(11); SBAR(); GAPB(PVM(3,0),C0,6); \
    VRD(12); SBAR(); GAPB(PVM(4,1),C0,8); \
    VRD(13); SBAR(); GAPB(PVM(5,1),C0,10); \
    VRD(14); SBAR(); GAPB(PVM(6,1),C0,12); \
    VRD(15); SBAR(); GAPB(PVM(7,1),C0,14); \
    KRD(GL,0); GAPB(PVM(8,2),C1,0); \
    KRD(GL,1); GAPB(PVM(9,2),C1,2); \
    KRD(GL,2); GAPB(PVM(10,2),C1,4); \
    KRD(GL,3); GAPB(PVM(11,2),C1,6); \
    GAPB(PVM(12,3),C1,8); \
    GAPB(PVM(13,3),C1,10); \
    GAPB(PVM(14,3),C1,12); \
    GAPB(PVM(15,3),C1,14); \
    }while(0)
  int t=1;
  for(;t+5<NT;t+=2){
    STEP(pB0,pB1,pA0,pA1,t,true,true,true);     WAIT_BAR(3); RESC(); ROT();
    STEP(pA0,pA1,pB0,pB1,t+1,true,true,true);   WAIT_BAR(3); RESC(); ROT();
  }
  #define ENDW(tt) do{ if((tt)+3<NT){WAIT_BAR(3);} else if((tt)+2<NT){WAIT_BAR(2);} else {WAIT_BAR(0);} }while(0)
  for(;t+1<NT;t+=2){
    STEP(pB0,pB1,pA0,pA1,t,(t+3<NT),(t+1<NT),(t+1<NT));       ENDW(t);   RESC(); ROT();
    STEP(pA0,pA1,pB0,pB1,t+1,(t+4<NT),(t+2<NT),(t+2<NT));     ENDW(t+1); RESC(); ROT();
  }
  STEP(pB0,pB1,pA0,pA1,NT-1,false,false,false); RESC();
  { float sacc=pB0[0]+pB0[1]; _Pragma("unroll") for(int r=2;r<16;++r)sacc+=pB0[r]; _Pragma("unroll") for(int r=0;r<16;++r)sacc+=pB1[r]; l_reg+=sacc;
    pw0=(u32x4){PKW(pB0,0),PKW(pB0,2),PKW(pB0,4),PKW(pB0,6)};pw1=(u32x4){PKW(pB0,8),PKW(pB0,10),PKW(pB0,12),PKW(pB0,14)};pw2=(u32x4){PKW(pB1,0),PKW(pB1,2),PKW(pB1,4),PKW(pB1,6)};pw3=(u32x4){PKW(pB1,8),PKW(pB1,10),PKW(pB1,12),PKW(pB1,14)};
    SBAR(); pv4(o,vb0+2*sl_cur,PAF(0),PAF(1),PAF(2),PAF(3)); }
  #undef PKW
  #undef PAF
  #undef VFR
  #undef MX3
  #undef GAPA
  #undef GAPB
  #undef EX
  #undef VRD
  #undef KRD
  #undef PVM
  #undef STEP
  #undef ENDW
  {auto rr=__builtin_amdgcn_permlane32_swap(__float_as_uint(l_reg),__float_as_uint(l_reg),false,false);l_reg=__uint_as_float(rr[0])+__uint_as_float(rr[1]);}
  if(hi==0)wsf[32+r32]=l_reg;asm volatile("s_waitcnt lgkmcnt(0)":::"memory");
  typedef unsigned u32x2v __attribute__((ext_vector_type(2)));
  u32x2v*sp=(u32x2v*)(shm+LDS_O1+wid*8192)+lane;
  if(!second){
    #pragma unroll
    for(int r=0;r<16;++r){ const float rl=__builtin_amdgcn_rcpf(wsf[32+crow(r,hi)]); const u32x2v v={cvtpk_s(o[0][r]*rl,o[1][r]*rl),cvtpk_s(o[2][r]*rl,o[3][r]*rl)}; sp[r*64]=v; }
  } else {
    float g4[4];
    #pragma unroll
    for(int d0=0;d0<4;++d0)g4[d0]=subg[d0*32+r32]*post;
    #pragma unroll
    for(int r=0;r<16;++r){ const float rl=__builtin_amdgcn_rcpf(wsf[32+crow(r,hi)])*lam; const u32x2v av=sp[r*64];
      const float a0=__uint_as_float(av[0]<<16),a1=__uint_as_float(av[0]&0xffff0000u),a2=__uint_as_float(av[1]<<16),a3=__uint_as_float(av[1]&0xffff0000u);
      float v0=a0-o[0][r]*rl,v1=a1-o[1][r]*rl,v2=a2-o[2][r]*rl,v3=a3-o[3][r]*rl; float ss=(v0*v0+v1*v1)+(v2*v2+v3*v3);
      ss+=__shfl_xor(ss,1);ss+=__shfl_xor(ss,2);ss+=__shfl_xor(ss,4);ss+=__shfl_xor(ss,8);ss+=__shfl_xor(ss,16);
      const float rn=__builtin_amdgcn_rsqf(ss*(1.0f/128.0f)+1e-6f);
      o[0][r]=v0*rn*g4[0];o[1][r]=v1*rn*g4[1];o[2][r]=v2*rn*g4[2];o[3][r]=v3*rn*g4[3]; }
    bf16*Ow=Ou+(long)(wid*QBLK)*op;
    bf16*stg=(bf16*)(shm+LDS_O1+wid*8192);
    asm volatile("s_waitcnt lgkmcnt(0)":::"memory");
    #pragma unroll
    for(int r=0;r<16;++r){const int orow=crow(r,hi);
      #pragma unroll
      for(int d0=0;d0<4;++d0)stg[orow*128+d0*32+r32]=__float2bfloat16(o[d0][r]);}
    asm volatile("s_waitcnt lgkmcnt(0)":::"memory");
    #pragma unroll
    for(int i=0;i<8;++i){const int row=i*4+(lane>>4),ch=lane&15; const u32x4 v=*(const u32x4*)(stg+row*128+ch*8); ATTN_STORE16(Ow+(long)row*op+ch*8,v);}
  }
  asm volatile("s_waitcnt lgkmcnt(0)\n\ts_barrier":::"memory");
  #undef PIN
  #undef DMA_K
  #undef DMA_V
  #undef START
  #undef RESC
  #undef ROT
}
#undef SBAR
#undef WAIT_BAR
}

typedef unsigned short bf16;
typedef float f32x4 __attribute__((ext_vector_type(4)));
typedef unsigned u32x4 __attribute__((ext_vector_type(4)));
typedef unsigned u32x2 __attribute__((ext_vector_type(2)));
constexpr int D = 1024, NBATCH = 4, SEQ = 4096, CTXL = 256, DEPTH = 2;
constexpr int MLAT = NBATCH * SEQ, MCTX = NBATCH * CTXL, MTOT = MLAT + MCTX;
constexpr int KVR = SEQ + CTXL;
constexpr int NIN = 6144, NE = 32, TOPK = 4, NWAVES = 8;
constexpr int MAXTILES = 304;
constexpr float EPS = 1e-6f;

constexpr size_t al256(size_t x) { return (x + 255) / 256 * 256; }
constexpr size_t WS_CTL = 0, CTL_BYTES = 1u << 20;
constexpr size_t WS_MOD = WS_CTL + CTL_BYTES;
constexpr size_t WS_ROPEC = WS_MOD + al256((size_t)DEPTH * 5 * NIN * 4);
constexpr size_t WS_ROPES = WS_ROPEC + 4096;
constexpr size_t WS_LAM = WS_ROPES + 4096;
constexpr size_t WS_PV = WS_LAM + 256;
constexpr size_t WS_WIN = WS_PV + (size_t)DEPTH * 5 * 4 * D * 4;
constexpr size_t WS_WB = WS_WIN + (size_t)DEPTH * NIN * D * 2;
constexpr size_t WS_WO = WS_WB + (size_t)DEPTH * 3 * D * 512 * 2;
constexpr size_t WS_W1 = WS_WO + (size_t)DEPTH * D * D * 2;
constexpr size_t WS_W2 = WS_W1 + (size_t)DEPTH * NE * 2048 * D * 2;
constexpr size_t WS_X = WS_W2 + (size_t)DEPTH * NE * D * D * 2;
constexpr size_t WS_H = WS_X + (size_t)MTOT * D * 4;
constexpr size_t WS_QA = WS_H + (size_t)MTOT * D * 2;
constexpr size_t WS_QB = WS_QA + (size_t)MTOT * 512 * 2;
constexpr size_t WS_QC = WS_QB + (size_t)MTOT * 512 * 2;
constexpr size_t WS_KA = WS_QC + (size_t)MTOT * 512 * 2;
constexpr size_t WS_VA = WS_KA + (size_t)NBATCH * KVR * 512 * 2;
constexpr size_t WS_KB = WS_VA + (size_t)NBATCH * KVR * 512 * 2;
constexpr size_t WS_VB = WS_KB + (size_t)NBATCH * KVR * 128 * 2;
constexpr size_t WS_KC = WS_VB + (size_t)NBATCH * KVR * 128 * 2;
constexpr size_t WS_VC = WS_KC + (size_t)NBATCH * KVR * 128 * 2;
constexpr size_t WS_GT = WS_VC + (size_t)NBATCH * KVR * 128 * 2;
constexpr size_t WS_YS = WS_GT + (size_t)MTOT * 3072 * 2;
constexpr size_t WS_TMP = WS_YS + (size_t)3 * MTOT * 512 * 2;
constexpr size_t WS_MG = WS_TMP + (size_t)MTOT * D * 4;
constexpr size_t WS_Y = WS_MG + (size_t)MTOT * D * 2;
constexpr size_t WS_H2 = WS_Y + (size_t)MTOT * D * 4;
constexpr size_t WS_SE = WS_H2 + (size_t)MTOT * D * 2;
constexpr size_t WS_SR = WS_SE + (size_t)MTOT * 4 * 4;
constexpr size_t WS_SW = WS_SR + (size_t)MTOT * 4 * 4;
constexpr size_t WS_LIST = WS_SW + (size_t)MTOT * 4 * 4;
constexpr size_t WS_ACT = WS_LIST + (size_t)NE * MTOT * 4;
constexpr size_t WS_YS2 = WS_ACT + (size_t)MAXTILES * 256 * D * 2;
constexpr size_t WS_EX = WS_YS2 + (size_t)MAXTILES * 256 * D * 2;
constexpr size_t WS_END = WS_EX + (size_t)DEPTH * 256 * 131072;
static_assert(WS_WIN % 256 == 0 && WS_X % 256 == 0 && WS_SE % 256 == 0 && WS_ACT % 256 == 0, "alignment");

constexpr int CW_BAR = 4096;
constexpr int CW_Q = 16384;
constexpr int CW_CNT = 8192;

constexpr int RING_BYTES = 141312, MISC_OFF = RING_BYTES, LDS_BYTES = MISC_OFF + 8192;
constexpr int MW_Q = 12; constexpr int MW_BAR = 0, MW_TB = 16, MW_CNT = 64, MW_HIST = 128, MW_BASE = 160, MW_PT = 192, MW_SLOT = 256;

#define LDS_WAIT() asm volatile("s_waitcnt lgkmcnt(0)" ::: "memory")
#define VM_WAIT() asm volatile("s_waitcnt vmcnt(0)" ::: "memory")
__device__ __forceinline__ unsigned f2bf(float f) { unsigned u = __builtin_bit_cast(unsigned, f); return (u + 0x7fffu + ((u >> 16) & 1u)) >> 16; }
typedef float f32x2_t __attribute__((ext_vector_type(2))); typedef __bf16 bf16x2_t __attribute__((ext_vector_type(2)));
__device__ __forceinline__ unsigned pk2(float lo, float hi) { const f32x2_t v = {lo, hi}; const bf16x2_t b = __builtin_convertvector(v, bf16x2_t); return __builtin_bit_cast(unsigned, b); }
__device__ __forceinline__ unsigned pk4f8(float a, float b, float c, float d) {
    int r = __builtin_amdgcn_cvt_pk_fp8_f32(a, b, 0, false); r = __builtin_amdgcn_cvt_pk_fp8_f32(c, d, r, true); return (unsigned)r; }
constexpr float W8_SCALE = 64.0f, W8_INV = 1.0f / 64.0f;
__device__ __forceinline__ float bflo(unsigned w) { return __builtin_bit_cast(float, w << 16); }
__device__ __forceinline__ float bfhi(unsigned w) { return __builtin_bit_cast(float, w & 0xffff0000u); }
template <int CTRL> __device__ __forceinline__ float dppf(float v) { return __builtin_bit_cast(float, __builtin_amdgcn_update_dpp(0, __builtin_bit_cast(int, v), CTRL, 0xf, 0xf, true)); }
template <int CTRL> __device__ __forceinline__ int dppi(int v) { return __builtin_amdgcn_update_dpp(0, v, CTRL, 0xf, 0xf, true); }
__device__ __forceinline__ float rdl(float v, int l) { return __builtin_bit_cast(float, __builtin_amdgcn_readlane(__builtin_bit_cast(int, v), l)); }
__device__ __forceinline__ float wave_sum(float v) {
    v += dppf<0xB1>(v); v += dppf<0x4E>(v); v += dppf<0x141>(v); v += dppf<0x140>(v);
    return (rdl(v, 0) + rdl(v, 16)) + (rdl(v, 32) + rdl(v, 48));
}
__device__ __forceinline__ float sigmoid255_(float x) { return __builtin_amdgcn_rcpf(__builtin_fmaf(__builtin_amdgcn_exp2f(-1.4426950408889634f * x), 1.0f / 255.0f, 1.0f / 255.0f)); }
__device__ __forceinline__ float sigmoidf_(float x) { return __builtin_amdgcn_rcpf(1.0f + __builtin_amdgcn_exp2f(-1.4426950408889634f * x)); }

__device__ __forceinline__ unsigned char* ldp(volatile LAS unsigned* MISC, int i) {
    const unsigned lo = (unsigned)__builtin_amdgcn_readfirstlane((int)MISC[MW_PT + 2 * i]), hi = (unsigned)__builtin_amdgcn_readfirstlane((int)MISC[MW_PT + 2 * i + 1]);
    return (unsigned char*)(((unsigned long long)hi << 32) | lo);
}
typedef const GAS float* gcfp; typedef GAS float* gfp; typedef const GAS unsigned short* gcbp; typedef GAS unsigned short* gbp;
#define INP(i) ((const GAS float*)ldp(MISC, (i)))
#define WSP(T, off) ((GAS T*)(ldp(MISC, 21) + (off)))
#define XB_TMO      128
#define XB_XCNT(j)  (256  + 64 * (j))
#define XB_XSUB(j)  (1280 + 64 * (j))
#define XB_XGEN(j)  (2304 + 64 * (j))
#define XB_TOP      3328
#define XB_TOPGEN   3392
#define XCD_BAR_WORDS 3456
#define XB_SPIN_CAP (1u << 18)

__device__ __forceinline__ unsigned xb_ld(unsigned* p)              { return __hip_atomic_load(p, __ATOMIC_RELAXED, __HIP_MEMORY_SCOPE_AGENT); }
__device__ __forceinline__ unsigned xb_add(unsigned* p, unsigned v) { return __hip_atomic_fetch_add(p, v, __ATOMIC_RELAXED, __HIP_MEMORY_SCOPE_AGENT); }
__device__ __forceinline__ unsigned xb_xcc_id() { return (unsigned)__builtin_amdgcn_s_getreg((3 << 11) | 20) & 0xFu; }
#define XB_SPIN(cond, bar) do { unsigned _sp = 0; while (cond) { __builtin_amdgcn_s_sleep(1); \
    if ((++_sp & 255u) == 0u) { if (xb_ld(&(bar)[XB_TMO])) break; if (_sp > XB_SPIN_CAP) { atomicAdd(&(bar)[XB_TMO], 1u); break; } } } } while (0)

struct XcdBarrier {
    unsigned* bar; unsigned x;
    volatile LAS unsigned* st;
};

__device__ __forceinline__ XcdBarrier xcd_barrier_post(unsigned* bar, volatile LAS unsigned* st) {
    XcdBarrier b; b.bar = bar; b.x = xb_xcc_id(); b.st = st;
    if (threadIdx.x == 0) (void)xb_add(&bar[XB_XCNT(b.x)], 1u);
    return b;
}
__device__ __forceinline__ void xcd_barrier_complete(unsigned* bar, unsigned x, unsigned& nloc, unsigned& nx) {
    const unsigned G = gridDim.x * gridDim.y * gridDim.z;
    unsigned sum, cnt, mine, sp = 0u;
    for (;;) {
        sum = 0u; cnt = 0u; mine = 0u;
#pragma unroll
        for (unsigned j = 0; j < 16; ++j) { const unsigned c = xb_ld(&bar[XB_XCNT(j)]); sum += c; cnt += (c > 0u) ? 1u : 0u; mine = (j == x) ? c : mine; }
        if (sum == G) break;
        __builtin_amdgcn_s_sleep(1);
        if ((++sp & 255u) == 0u) { if (xb_ld(&bar[XB_TMO])) break; if (sp > XB_SPIN_CAP) { atomicAdd(&bar[XB_TMO], 1u); break; } }
    }
    nloc = mine > 0u ? mine : 1u; nx = cnt > 0u ? cnt : 1u;
}

__device__ __forceinline__ void xcd_barrier(const XcdBarrier& b, const int tid_now) {
    asm volatile("s_waitcnt vmcnt(0)" ::: "memory");
    __syncthreads();
    if (tid_now == 0) {
        unsigned long long bp_ = (unsigned long long)b.bar; asm volatile("" : "+s"(bp_)); unsigned* bar = (unsigned*)bp_;
        unsigned bx_ = b.x; asm volatile("" : "+s"(bx_));
        __builtin_amdgcn_s_waitcnt(0);
        unsigned nloc = b.st[0], nx = b.st[1];
        if (nloc == 0u) { xcd_barrier_complete(bar, bx_, nloc, nx); b.st[0] = nloc; b.st[1] = nx; }
        const unsigned old = xb_add(&bar[XB_XSUB(bx_)], 1u);
        const unsigned gen = old / nloc;
        if (old + 1u == (gen + 1u) * nloc) {
            __builtin_amdgcn_fence(__ATOMIC_RELEASE, "agent");
            asm volatile("s_waitcnt vmcnt(0)" ::: "memory");
            const unsigned og = xb_add(&bar[XB_TOP], 1u);
            const unsigned tg = og / nx;
            if (og + 1u == (tg + 1u) * nx) xb_add(&bar[XB_TOPGEN], 1u);
            else XB_SPIN(xb_ld(&bar[XB_TOPGEN]) == tg, bar);
            __builtin_amdgcn_fence(__ATOMIC_ACQUIRE, "agent");
            xb_add(&bar[XB_XGEN(bx_)], 1u);
            asm volatile("s_waitcnt vmcnt(0)" ::: "memory");
        } else {
            XB_SPIN(xb_ld(&bar[XB_XGEN(bx_)]) == gen, bar);
            __builtin_amdgcn_fence(__ATOMIC_ACQUIRE, "agent");
            asm volatile("s_waitcnt vmcnt(0)" ::: "memory");
        }
    }
    __syncthreads();
}

using pg8::Unit;
__host__ __device__ __forceinline__ int in_src_col(int nbd) {
    const int pn = nbd >> 3, blk = nbd & 7, bj = blk >> 2, wc = blk & 3;
    if (pn <= 8) { const int hs = pn * 4 + wc; int base;
        if (hs < 8) base = hs * 64; else if (hs < 16) base = 512 + (hs - 8) * 64; else if (hs < 24) base = 1536 + (hs - 16) * 64;
        else if (hs < 32) base = 2304 + (hs - 24) * 64; else if (hs < 34) base = 2048 + (hs - 32) * 64; else base = 2816 + (hs - 34) * 64;
        return base + 32 * bj; }
    if (pn <= 10) return 1024 + (pn - 9) * 256 + blk * 32;
    if (pn == 11) return blk < 4 ? 2176 + blk * 32 : 2944 + (blk - 4) * 32;
    return 3072 + (pn - 12) * 256 + blk * 32;
}
struct EpiInproj {
    static constexpr bool PERM = false;
    volatile LAS unsigned* MISC; int l;
    __device__ __forceinline__ void operator()(const f32x4 (&acc)[2][2][4][2], const Unit& u, int wr, int wc, int fr, int fq) const {
        auto QA = WSP(bf16, WS_QA); auto QB = WSP(bf16, WS_QB); auto QC = WSP(bf16, WS_QC); auto KA = WSP(bf16, WS_KA); auto VA = WSP(bf16, WS_VA);
        auto KB = WSP(bf16, WS_KB); auto VB = WSP(bf16, WS_VB); auto KC = WSP(bf16, WS_KC); auto VC = WSP(bf16, WS_VC); auto GT = WSP(bf16, WS_GT);
        auto ropec = WSP(float, WS_ROPEC); auto ropes = WSP(float, WS_ROPES); auto qkg = INP(10) + l * 128;
        const int pn = u.pn; const bool ctx = u.pm >= (MLAT / 256);
#pragma unroll
        for (int ai = 0; ai < 2; ++ai)
#pragma unroll
            for (int m = 0; m < 4; ++m) {
                const int r = u.pm * 256 + ai * 128 + wr * 64 + m * 16 + fr;
                int kvrow, t = 0;
                if (!ctx) { t = r & (SEQ - 1); kvrow = (r >> 12) * KVR + t; } else { const int rr = r - MLAT; kvrow = (rr >> 8) * KVR + SEQ + (rr & 255); }
                if (pn <= 8) {
                    float v[2][2][4];
#pragma unroll
                    for (int bj = 0; bj < 2; ++bj)
#pragma unroll
                        for (int n = 0; n < 2; ++n)
#pragma unroll
                            for (int j = 0; j < 4; ++j) v[bj][n][j] = acc[ai][bj][m][n][j];
                    const int hs = pn * 4 + wc;
                    const bool isbq = (pn == 4 || pn == 5), isbk = (pn == 8 && wc < 2);
                    if (isbq || isbk) {
                        float ss = 0.f;
#pragma unroll
                        for (int bj = 0; bj < 2; ++bj)
#pragma unroll
                            for (int n = 0; n < 2; ++n)
#pragma unroll
                                for (int j = 0; j < 4; ++j) ss += v[bj][n][j] * v[bj][n][j];
                        ss += __shfl_xor(ss, 16); ss += __shfl_xor(ss, 32);
                        const float rn = __builtin_amdgcn_rsqf(ss * (1.0f / 64.0f) + EPS);
                        gcfp g = qkg + (isbk ? 64 : 0);
#pragma unroll
                        for (int bj = 0; bj < 2; ++bj)
#pragma unroll
                            for (int n = 0; n < 2; ++n) { const f32x4 gv = *(const GAS f32x4*)(g + 32 * bj + 16 * n + 4 * fq);
#pragma unroll
                                for (int j = 0; j < 4; ++j) v[bj][n][j] = v[bj][n][j] * rn * gv[j]; }
                    }
                    if (!ctx) {
#pragma unroll
                        for (int bj = 0; bj < 2; ++bj) { const int pos = bj ? (t & 63) : (t >> 6);
                            const f32x4 cs = *(const GAS f32x4*)(ropec + pos * 16 + 4 * fq), sn = *(const GAS f32x4*)(ropes + pos * 16 + 4 * fq);
#pragma unroll
                            for (int j = 0; j < 4; ++j) { const float x0 = v[bj][0][j], x1 = v[bj][1][j];
                                v[bj][0][j] = x0 * cs[j] - x1 * sn[j]; v[bj][1][j] = x1 * cs[j] + x0 * sn[j]; } }
                    }
                    if (isbq || pn == 6 || pn == 7 || (pn < 2 && !ctx)) {
#pragma unroll
                        for (int bj = 0; bj < 2; ++bj)
#pragma unroll
                            for (int n = 0; n < 2; ++n)
#pragma unroll
                                for (int j = 0; j < 4; ++j) v[bj][n][j] *= att64::C2; }
                    gbp dst;
                    if (pn < 2) dst = QA + (size_t)r * 512 + hs * 64;
                    else if (pn < 4) dst = KA + (size_t)kvrow * 512 + (hs - 8) * 64;
                    else if (pn < 6) dst = QB + (size_t)r * 512 + (hs - 16) * 64;
                    else if (pn < 8) dst = QC + (size_t)r * 512 + (hs - 24) * 64;
                    else if (wc < 2) dst = KB + (size_t)kvrow * 128 + wc * 64;
                    else dst = KC + (size_t)kvrow * 128 + (wc - 2) * 64;
#pragma unroll
                    for (int bj = 0; bj < 2; ++bj) { u32x4 w; w.x = pk2(v[bj][0][0], v[bj][0][1]); w.y = pk2(v[bj][0][2], v[bj][0][3]); w.z = pk2(v[bj][1][0], v[bj][1][1]); w.w = pk2(v[bj][1][2], v[bj][1][3]);
                        *(GAS u32x4*)(dst + 32 * bj + 8 * fq) = w; }
                } else if (pn <= 11) {
#pragma unroll
                    for (int bj = 0; bj < 2; ++bj) { const int c = 128 * bj + 32 * wc + 8 * fq; const f32x4 x = acc[ai][bj][m][0], y = acc[ai][bj][m][1];
                            gbp dst = (pn < 11) ? VA + (size_t)kvrow * 512 + (pn - 9) * 256 + c : ((bj == 0) ? VB : VC) + (size_t)kvrow * 128 + (c & 127);
                            u32x4 w; w.x = pk2(x[0], x[1]); w.y = pk2(x[2], x[3]); w.z = pk2(y[0], y[1]); w.w = pk2(y[2], y[3]); *(GAS u32x4*)dst = w; }
                } else {
#pragma unroll
                    for (int bj = 0; bj < 2; ++bj) { const int c = 128 * bj + 32 * wc + 8 * fq; const f32x4 x = acc[ai][bj][m][0], y = acc[ai][bj][m][1];
                            u32x2 w = {0u, 0u};
#pragma unroll
                            for (int j = 0; j < 4; ++j) { w.x = __builtin_amdgcn_cvt_pk_u8_f32(sigmoid255_(x[j]), (unsigned)j, w.x); w.y = __builtin_amdgcn_cvt_pk_u8_f32(sigmoid255_(y[j]), (unsigned)j, w.y); }
                            *(GAS u32x2*)((GAS unsigned char*)GT + (size_t)r * 3072 + (pn - 12) * 256 + c) = w; }
                }
            }
    }
};

#if defined(EPIDUP_INPROJ)
namespace pg8 { template <> struct epi_dup<::EpiInproj> { static constexpr int v = 1; }; }
#endif
struct MergeOrder {
    int ntiles, G, vcu;
    __device__ __forceinline__ bool next(int i, Unit& u) const { const int rnd = i / 3, sub = i - rnd * 3; const int tl = rnd * G + vcu; if (tl >= ntiles) return false;
        u.pm = sub * (MTOT / 256) + (tl >> 2); u.pn = sub * 4 + (tl & 3); return true; }
    __device__ __forceinline__ unsigned a_row(const Unit&, int) const { return 0u; }
};
struct EpiMerge {
    static constexpr bool PERM = true;
    volatile LAS unsigned* MISC;
    __device__ __forceinline__ bool keep(const Unit& u) const { return (u.pn >> 2) < 2; }
    __device__ __forceinline__ void operator()(f32x4 (&acc)[2][2][4][2], const Unit& u, int wr, int wc, int fr, int fq) const {
        const auto GT = WSP(bf16, WS_GT); auto MG = WSP(bf16, WS_MG);
        const int sub = u.pn >> 2, pnr = u.pn & 3, pmr = u.pm - sub * (MTOT / 256);
        constexpr float GMIN = 1e-24f;
        const int subn = sub < 2 ? sub + 1 : sub;
        const GAS unsigned char* gbase = (const GAS unsigned char*)GT + ((size_t)pmr * 256 + wr * 64 + fr) * 3072 + pnr * 256 + wc * 32 + 8 * fq;
        u32x2 gw[2][4][2], gn[2][4][2];
#pragma unroll
        for (int ai = 0; ai < 2; ++ai)
#pragma unroll
            for (int m = 0; m < 4; ++m)
#pragma unroll
                for (int bj = 0; bj < 2; ++bj) { const GAS unsigned char* p = gbase + (size_t)(ai * 128 + m * 16) * 3072 + bj * 128;
                    gw[ai][m][bj] = *(const GAS u32x2*)(p + sub * 1024); gn[ai][m][bj] = *(const GAS u32x2*)(p + subn * 1024); }
        const float nmin = sub > 0 ? GMIN : 0.0f;
        const bool last = sub == 2;
#pragma unroll
        for (int ai = 0; ai < 2; ++ai)
#pragma unroll
            for (int m = 0; m < 4; ++m)
#pragma unroll
                for (int bj = 0; bj < 2; ++bj) {
                    const u32x2 a = gw[ai][m][bj], b = gn[ai][m][bj];
                    float g[8] = {(float)(a.x & 0xffu), (float)((a.x >> 8) & 0xffu), (float)((a.x >> 16) & 0xffu), (float)(a.x >> 24), (float)(a.y & 0xffu), (float)((a.y >> 8) & 0xffu), (float)((a.y >> 16) & 0xffu), (float)(a.y >> 24)};
                    const float d[8] = {(float)(b.x & 0xffu), (float)((b.x >> 8) & 0xffu), (float)((b.x >> 16) & 0xffu), (float)(b.x >> 24), (float)(b.y & 0xffu), (float)((b.y >> 8) & 0xffu), (float)((b.y >> 16) & 0xffu), (float)(b.y >> 24)};
#pragma unroll
                    for (int k = 0; k < 8; ++k) g[k] = fmaxf(g[k], nmin) * (last ? (1.0f / 255.0f) : __builtin_amdgcn_rcpf(fmaxf(d[k], GMIN)));
                    f32x4 v0 = acc[ai][bj][m][0], v1 = acc[ai][bj][m][1];
                    v0[0] *= g[0]; v0[1] *= g[1]; v0[2] *= g[2]; v0[3] *= g[3]; v1[0] *= g[4]; v1[1] *= g[5]; v1[2] *= g[6]; v1[3] *= g[7];
                    acc[ai][bj][m][0] = v0; acc[ai][bj][m][1] = v1; }
        if (last) {
#pragma unroll
            for (int ai = 0; ai < 2; ++ai)
#pragma unroll
                for (int m = 0; m < 4; ++m) { const size_t row = (size_t)pmr * 256 + ai * 128 + wr * 64 + m * 16 + fr;
#pragma unroll
                    for (int bj = 0; bj < 2; ++bj) { const int col = pnr * 256 + bj * 128 + wc * 32 + 8 * fq; const f32x4 v0 = acc[ai][bj][m][0], v1 = acc[ai][bj][m][1];
                        u32x4 w; w.x = pk2(v0[0], v0[1]); w.y = pk2(v0[2], v0[3]); w.z = pk2(v1[0], v1[1]); w.w = pk2(v1[2], v1[3]); *(GAS u32x4*)(MG + row * 1024 + col) = w; } }
        }
    }
};
namespace pg8 { template <> struct epi_chain<::EpiMerge> { static constexpr bool v = true; }; }
struct EpiOut {
    static constexpr bool PERM = true;
    volatile LAS unsigned* MISC;
    __device__ __forceinline__ void operator()(const f32x4 (&acc)[2][2][4][2], const Unit& u, int wr, int wc, int fr, int fq) const {
        auto Y = WSP(bf16, WS_Y);
#pragma unroll
        for (int ai = 0; ai < 2; ++ai)
#pragma unroll
            for (int m = 0; m < 4; ++m) { gbp rowp = Y + ((size_t)u.pm * 256 + ai * 128 + wr * 64 + m * 16 + fr) * 1024 + u.pn * 256 + wc * 32 + 8 * fq;
#pragma unroll
                for (int bj = 0; bj < 2; ++bj) { const f32x4 v0 = acc[ai][bj][m][0], v1 = acc[ai][bj][m][1];
                    u32x4 w; w.x = pk2(v0[0], v0[1]); w.y = pk2(v0[2], v0[3]); w.z = pk2(v1[0], v1[1]); w.w = pk2(v1[2], v1[3]); *(GAS u32x4*)(rowp + bj * 128) = w; } }
    }
};
template <int NP> struct MoeOrder {
    const LAS int* tb; const LAS int* cn; const GAS int* list; int G, bid, vcu, U, chunk, per;
    __device__ __forceinline__ void init(const LAS int* tb_, const LAS int* cn_, const GAS int* list_, int G_, int bid_) {
        tb = tb_; cn = cn_; list = list_; G = G_; bid = bid_; U = tb_[NE] * NP;
        if (G_ % 8 == 0) { per = G_ / 8; vcu = (bid_ % 8) * per + bid_ / 8; chunk = (U + 7) / 8; } else { per = G_; vcu = bid_; chunk = U; }
    }
    __device__ __forceinline__ bool next(int i, Unit& u) const {
        const int x = vcu / per, j = i * per + (vcu % per); if (j >= chunk) return false;
        const int id = x * chunk + j; if (id >= U) return false;
        const int T = id / NP, pnl = id - T * NP; int e = 0;
#pragma unroll
        for (int q = 1; q < NE; ++q) e += (T >= tb[q]) ? 1 : 0;
        e = __builtin_amdgcn_readfirstlane(e);
        u.pm = T; u.pn = e * NP + pnl; return true;
    }
    __device__ __forceinline__ unsigned a_row(const Unit& u, int r) const {
        const int e = u.pn / NP; int idx = (u.pm - tb[e]) * 256 + r; const int c = cn[e]; idx = idx < c ? idx : c - 1;
        return (unsigned)list[(size_t)e * MTOT + idx];
    }
};
template <bool F8> struct EpiSwiglu {
    static constexpr bool PERM = true;
    volatile LAS unsigned* MISC; int l;
    __device__ __forceinline__ void operator()(const f32x4 (&acc)[2][2][4][2], const Unit& u, int wr, int wc, int fr, int fq) const {
        auto ACT = WSP(bf16, WS_ACT); auto b1 = INP(17) + (size_t)l * NE * 2048;
        const int e = u.pn >> 3, pnl = u.pn & 7; const int col = pnl * 128 + wc * 32 + 8 * fq;
        gcfp bg = b1 + (size_t)e * 2048 + col; gcfp bu = bg + 1024;
        const f32x4 bg0 = *(const GAS f32x4*)bg, bg1 = *(const GAS f32x4*)(bg + 4), bu0 = *(const GAS f32x4*)bu, bu1 = *(const GAS f32x4*)(bu + 4);
#pragma unroll
        for (int ai = 0; ai < 2; ++ai)
#pragma unroll
            for (int m = 0; m < 4; ++m) { const size_t row = (size_t)u.pm * 256 + ai * 128 + wr * 64 + m * 16 + fr;
                float a[8];
#pragma unroll
                for (int n = 0; n < 2; ++n)
#pragma unroll
                    for (int j = 0; j < 4; ++j) { constexpr float SC = F8 ? W8_INV : 1.0f; float gt = acc[ai][0][m][n][j] * SC + (n ? bg1[j] : bg0[j]), up = acc[ai][1][m][n][j] * SC + (n ? bu1[j] : bu0[j]);
                        gt = fminf(gt, 7.0f); up = fminf(fmaxf(up, -7.0f), 7.0f);
                        a[n * 4 + j] = (up + 1.0f) * (gt * sigmoidf_(1.702f * gt)); }
                if constexpr (F8) { u32x2 w; w.x = pk4f8(a[0], a[1], a[2], a[3]); w.y = pk4f8(a[4], a[5], a[6], a[7]); *(GAS u32x2*)((GAS unsigned char*)ACT + row * 1024 + col) = w; }
                else { u32x4 w; w.x = pk2(a[0], a[1]); w.y = pk2(a[2], a[3]); w.z = pk2(a[4], a[5]); w.w = pk2(a[6], a[7]);
                *(GAS u32x4*)(ACT + row * 1024 + col) = w; } }
    }
};
#if defined(EPIDUP_MOE1)
namespace pg8 { template <> struct epi_dup<::EpiSwiglu<true>> { static constexpr int v = 1; }; }
#endif
template <bool F8> struct EpiMoe2 {
    static constexpr bool PERM = true;
    volatile LAS unsigned* MISC; int l;
    __device__ __forceinline__ void operator()(const f32x4 (&acc)[2][2][4][2], const Unit& u, int wr, int wc, int fr, int fq) const {
        auto YS2 = WSP(bf16, WS_YS2); auto b2 = INP(19) + (size_t)l * NE * D;
        const int e = u.pn >> 2, pnl = u.pn & 3;
#pragma unroll
        for (int bj = 0; bj < 2; ++bj) { const int col = pnl * 256 + bj * 128 + wc * 32 + 8 * fq;
            const f32x4 c0 = *(const GAS f32x4*)(b2 + (size_t)e * 1024 + col), c1 = *(const GAS f32x4*)(b2 + (size_t)e * 1024 + col + 4);
#pragma unroll
            for (int ai = 0; ai < 2; ++ai)
#pragma unroll
                for (int m = 0; m < 4; ++m) { const size_t row = (size_t)u.pm * 256 + ai * 128 + wr * 64 + m * 16 + fr;
                    constexpr float SC = F8 ? W8_INV : 1.0f; const f32x4 v0 = acc[ai][bj][m][0] * SC + c0, v1 = acc[ai][bj][m][1] * SC + c1;
                    u32x4 w; w.x = pk2(v0[0], v0[1]); w.y = pk2(v0[2], v0[3]); w.z = pk2(v1[0], v1[1]); w.w = pk2(v1[2], v1[3]);
                    *(GAS u32x4*)(YS2 + row * 1024 + col) = w; } }
    }
};

#if defined(EPIDUP_MOE2)
namespace pg8 { template <> struct epi_dup<::EpiMoe2<true>> { static constexpr int v = 1; }; }
#endif

struct Args { const float* in[20]; float* out; unsigned char* ws; int ph_lo, ph_hi; };

#ifndef MOE_F8_FROM
#define MOE_F8_FROM 0
#endif
__device__ __forceinline__ int sgpr_launder(int x) { asm volatile("" : "+s"(x)); return x; }
#ifndef CVT_SH2
#define CVT_SH2 43
#define CVT_SH4 12
#endif
struct CvtItem { gcfp W; gbp WT; int N, k0, n0, Kd, rowd, f8; };
__device__ __forceinline__ void cvt_load(const CvtItem& I, int lane, float (&v)[32]) {
    const GAS char* base = (const GAS char*)(I.W + (size_t)I.k0 * I.N + I.n0);
    unsigned off = (unsigned)((lane >> 5) * I.N + (lane & 31)) * 4u; const unsigned step = (unsigned)I.N * 8u;
#pragma unroll
    for (int i = 0; i < 32; ++i) { v[i] = __builtin_nontemporal_load((const GAS float*)(base + off)); off += step; }
}
__device__ __forceinline__ void cvt_store(const CvtItem& I, int lane, const float (&v)[32], LAS float* scr) {
#pragma unroll
    for (int i = 0; i < 32; ++i) { const int kk = 2 * i + (lane >> 5); scr[kk * 33 + (lane & 31)] = v[i]; }
    LDS_WAIT(); asm volatile("" ::: "memory");
    const int c = lane & 7;
#pragma unroll
    for (int j = 0; j < 4; ++j) { const int n = (lane >> 3) + 8 * j; const LAS float* s = scr + (8 * c) * 33 + n;
        if (I.f8 & 1) { u32x2 o; o.x = pk4f8(s[0 * 33] * W8_SCALE, s[1 * 33] * W8_SCALE, s[2 * 33] * W8_SCALE, s[3 * 33] * W8_SCALE); o.y = pk4f8(s[4 * 33] * W8_SCALE, s[5 * 33] * W8_SCALE, s[6 * 33] * W8_SCALE, s[7 * 33] * W8_SCALE);
            __builtin_nontemporal_store(o, (GAS u32x2*)((GAS char*)I.WT + (size_t)I.rowd * I.Kd + I.k0 + (unsigned)(n * I.Kd + 8 * c))); }
        else { u32x4 o; o.x = pk2(s[0 * 33], s[1 * 33]); o.y = pk2(s[2 * 33], s[3 * 33]); o.z = pk2(s[4 * 33], s[5 * 33]); o.w = pk2(s[6 * 33], s[7 * 33]);
        const int nd = (I.f8 & 2) ? 16 * ((n >> 2) & 1) + 4 * (n >> 3) + (n & 3) : n;
        __builtin_nontemporal_store(o, (GAS u32x4*)((GAS char*)(I.WT + (size_t)I.rowd * I.Kd + I.k0) + (unsigned)(nd * I.Kd + 8 * c) * 2u)); } }
    LDS_WAIT(); asm volatile("" ::: "memory");
}

__device__ __forceinline__ void ld_row(gcfp p, int lane, f32x4 (&v)[4]) {
#pragma unroll
    for (int j = 0; j < 4; ++j) v[j] = *(const GAS f32x4*)(p + 4 * lane + 256 * j);
}
__device__ __forceinline__ void ld_row_bf(gcbp p, int lane, f32x4 (&v)[4]) {
#pragma unroll
    for (int j = 0; j < 4; ++j) { const u32x2 w = *(const GAS u32x2*)(p + 4 * lane + 256 * j); v[j] = (f32x4){bflo(w.x), bfhi(w.x), bflo(w.y), bfhi(w.y)}; }
}
__device__ __forceinline__ float sumsq_row(const f32x4 (&v)[4]) {
    float s = 0.f;
#pragma unroll
    for (int j = 0; j < 4; ++j) s += (v[j][0] * v[j][0] + v[j][1] * v[j][1]) + (v[j][2] * v[j][2] + v[j][3] * v[j][3]);
    return wave_sum(s);
}
template <bool F8 = false> __device__ __forceinline__ void norm_mod_row(const f32x4 (&x)[4], gcfp g, gcfp sc, gcfp sh, int lane, f32x4 (&h)[4], gbp dst) {
    const float rn = 1.0f / sqrtf(sumsq_row(x) * (1.0f / D) + EPS);
#pragma unroll
    for (int j = 0; j < 4; ++j) { const int c = 4 * lane + 256 * j; const f32x4 gv = *(const GAS f32x4*)(g + c), sv = *(const GAS f32x4*)(sc + c), hv = *(const GAS f32x4*)(sh + c);
        h[j] = (x[j] * rn) * gv * (1.0f + sv) + hv;
        if constexpr (F8) { *(GAS unsigned*)((GAS unsigned char*)dst + c) = pk4f8(h[j][0], h[j][1], h[j][2], h[j][3]); }
        else { u32x2 w; w.x = pk2(h[j][0], h[j][1]); w.y = pk2(h[j][2], h[j][3]); *(GAS u32x2*)(dst + c) = w; } }
}

constexpr int CVT_I_IN = 16 * 192, CVT_I_WB = 3 * 8 * 32, CVT_I_WO = 16 * 32, CVT_I_W1 = NE * 16 * 64, CVT_I_W2 = NE * 16 * 32, CVT_I_L = CVT_I_IN + CVT_I_WB + CVT_I_WO + CVT_I_W1 + CVT_I_W2;
constexpr int CVT_P0_END = CVT_I_IN + CVT_I_WB + CVT_I_WO, CVT_END = DEPTH * CVT_I_L, CVT_REST = CVT_END - CVT_P0_END;
constexpr int CVT_T1_END = CVT_P0_END + (CVT_REST * 21) / 100, CVT_T3_END = CVT_T1_END + (CVT_REST * CVT_SH2) / 100, CVT_T4_END = CVT_END - (CVT_REST * CVT_SH4) / 100;
static_assert(CVT_T3_END >= CVT_I_L, "layer 0's expert weights are converted before its expert GEMMs");
static_assert(CVT_T4_END >= CVT_I_L + CVT_I_IN + CVT_I_WB + CVT_I_WO && CVT_T4_END >= CVT_T3_END, "only layer 1's expert weights may wait for layer 1's in-projection");
__device__ __forceinline__ void cvt_range(volatile LAS unsigned* MISC, LAS unsigned char* ldsl, int first, int last, int gw, int NGW, int wave, int lane) {
    auto w_in = INP(7); auto w_branch = INP(12); auto w_out = INP(13); auto w1 = INP(16); auto w2 = INP(18);
    auto WIN = WSP(bf16, WS_WIN); auto WB = WSP(bf16, WS_WB); auto WO = WSP(bf16, WS_WO); auto W1 = WSP(bf16, WS_W1); auto W2 = WSP(bf16, WS_W2);
    LAS float* scr = (LAS float*)(ldsl + wave * 16384);
    constexpr int I_IN = CVT_I_IN, I_WB = CVT_I_WB, I_WO = CVT_I_WO, I_W1 = CVT_I_W1, I_W2 = CVT_I_W2, I_L = CVT_I_L;
#define CVT_DECODE(it_, I_) do { const int l_ = (it_) / I_L; int r_ = (it_) - l_ * I_L; \
            if (r_ < I_IN) { const int kb = r_ / 192, nbd = r_ % 192; I_ = CvtItem{w_in + (size_t)l_ * D * NIN, WIN + (size_t)l_ * NIN * D, NIN, 64 * kb, in_src_col(nbd), D, 32 * nbd, (nbd >= 72) ? 2 : 0}; break; } r_ -= I_IN; \
            if (r_ < I_WB) { const int i = r_ / 256, rr = r_ % 256, kb = rr / 32, nb = rr % 32; I_ = CvtItem{w_branch + (size_t)(l_ * 3 + i) * 512 * D, WB + (size_t)(l_ * 3 + i) * D * 512, D, 64 * kb, 32 * nb, 512, 32 * nb, 0}; break; } r_ -= I_WB; \
            if (r_ < I_WO) { const int kb = r_ / 32, nb = r_ % 32; I_ = CvtItem{w_out + (size_t)l_ * D * D, WO + (size_t)l_ * D * D, D, 64 * kb, 32 * nb, D, 32 * nb, 0}; break; } r_ -= I_WO; \
            if (r_ < I_W1) { const int e = r_ / 1024, rr = r_ % 1024, kb = rr / 64, nbd = rr % 64; const int pn = nbd >> 3, blk = nbd & 7, bj = blk >> 2, q = blk & 3; \
                const bool f8_ = (l_ >= MOE_F8_FROM);     \
                I_ = CvtItem{w1 + (size_t)(l_ * NE + e) * D * 2048, f8_ ? (gbp)((GAS char*)(W1 + (size_t)l_ * NE * 2048 * D) + (size_t)e * 2048 * D) : W1 + (size_t)(l_ * NE + e) * 2048 * D, 2048, 64 * kb, bj * 1024 + 128 * pn + 32 * q, D, 32 * nbd, f8_ ? 1 : 0}; break; } r_ -= I_W1; \
            { const int e = r_ / 512, rr = r_ % 512, kb = rr / 32, nb = rr % 32; const bool f8_ = (l_ >= MOE_F8_FROM); \
              I_ = CvtItem{w2 + (size_t)(l_ * NE + e) * D * D, f8_ ? (gbp)((GAS char*)(W2 + (size_t)l_ * NE * D * D) + (size_t)e * D * D) : W2 + (size_t)(l_ * NE + e) * D * D, D, 64 * kb, 32 * nb, D, 32 * nb, f8_ ? 1 : 0}; } } while (0)
        {
            int it = first + gw; CvtItem Iq[4]; float v[4][32];
#define CVT_PRE(k, itx) do { if ((itx) < last) { CVT_DECODE((itx), Iq[k]); cvt_load(Iq[k], lane, v[k]); } } while (0)
#define CVT_STG(k) { CVT_PRE(((k) + 3) & 3, it + 3 * NGW); cvt_store(Iq[k], lane, v[k], scr); it += NGW; if (it >= last) break; }
            CVT_PRE(0, it); CVT_PRE(1, it + NGW); CVT_PRE(2, it + 2 * NGW);
            if (it < last) for (;;) { CVT_STG(0) CVT_STG(1) CVT_STG(2) CVT_STG(3) }
#undef CVT_PRE
#undef CVT_STG
        }
#undef CVT_DECODE
}

#ifndef DISMASK
#define DISMASK 0
#endif
#define EN(k) (((DISMASK >> (k)) & 1) == 0)
#ifndef TOKPROBE
#define TOKPROBE 0
#endif
#ifndef DUPMASK
#ifndef INPROJ_STAGGER
#define INPROJ_STAGGER 2
#endif
#ifndef A128DUP
#define A128DUP 0
#endif
#define DUPMASK 0
#endif
#define REPS(k) ((((DUPMASK) >> (k)) & 1) ? 2 : 1)
__device__ __forceinline__ void ld_prod(gcfp a, gcfp b, int lane, f32x4 (&o)[4]) {
#pragma unroll
    for (int j = 0; j < 4; ++j) o[j] = *(const GAS f32x4*)(a + 4 * lane + 256 * j) * *(const GAS f32x4*)(b + 4 * lane + 256 * j);
}
__device__ __forceinline__ void ld_scale(gcfp g, gcfp sc, int lane, f32x4 (&A)[4]) {
#pragma unroll
    for (int j = 0; j < 4; ++j) A[j] = *(const GAS f32x4*)(g + 4 * lane + 256 * j) * (1.0f + *(const GAS f32x4*)(sc + 4 * lane + 256 * j));
}
template <bool F8 = false> __device__ __forceinline__ void norm_affine_row(const f32x4 (&x)[4], const f32x4 (&A)[4], int lane, f32x4 (&h)[4], gbp dst) {
    const float rn = __builtin_amdgcn_rsqf(sumsq_row(x) * (1.0f / D) + EPS);
#pragma unroll
    for (int j = 0; j < 4; ++j) { const int c = 4 * lane + 256 * j; h[j] = (x[j] * rn) * A[j] + h[j];
        if constexpr (F8) { *(GAS unsigned*)((GAS unsigned char*)dst + c) = pk4f8(h[j][0], h[j][1], h[j][2], h[j][3]); }
        else { u32x2 w; w.x = pk2(h[j][0], h[j][1]); w.y = pk2(h[j][2], h[j][3]); *(GAS u32x2*)(dst + c) = w; } }
}
__global__ void __launch_bounds__(NWAVES * 64, 2) mk_fwd(Args args) {
    extern __shared__ __attribute__((aligned(16))) unsigned char lds[];
    LAS unsigned char* ldsl = (LAS unsigned char*)lds;
    volatile LAS unsigned* MISC = (volatile LAS unsigned*)(ldsl + MISC_OFF);
    const int tid = threadIdx.x; const int wave0 = __builtin_amdgcn_readfirstlane(tid >> 6);
#define TIDNOW() (wave0 * 64 + lane_now())
    const int G = gridDim.x, bid = blockIdx.x;
    const int vcu = (G % 8 == 0) ? (bid % 8) * (G / 8) + bid / 8 : bid;
    const int G0 = G, bid0 = bid, vcu0 = vcu, wave00 = wave0;
#define IDS_NOW const int G = sgpr_launder(G0), bid = sgpr_launder(bid0), vcu = sgpr_launder(vcu0), wave0 = sgpr_launder(wave00); (void)G; (void)bid; (void)vcu; (void)wave0
    unsigned* ctl = (unsigned*)(GAS unsigned*)(args.ws + WS_CTL);
    for (int u = tid; u < (LDS_BYTES - MISC_OFF) / 4; u += NWAVES * 64) MISC[u] = 0u;
    __syncthreads();
    if (tid == 0) {
#pragma unroll
        for (int i = 0; i < 22; ++i) { const unsigned long long pv = i < 20 ? (unsigned long long)args.in[i] : (i == 20 ? (unsigned long long)args.out : (unsigned long long)args.ws);
            MISC[MW_PT + 2 * i] = (unsigned)pv; MISC[MW_PT + 2 * i + 1] = (unsigned)(pv >> 32); }
    }
    __syncthreads();
    XcdBarrier bar = xcd_barrier_post(ctl + CW_BAR, MISC + MW_BAR);
    const int lo = args.ph_lo, hi = args.ph_hi;
#define IN(k) (sgpr_launder(lo) <= (k) && (k) < sgpr_launder(hi))
#define SEAM(k) do { if (IN(k) && IN((k) + 1)) xcd_barrier(bar, TIDNOW()); } while (0)

    const int NGW = G * NWAVES;
#define PHASE_IDS const int lane = lane_now(), tid = wave0 * 64 + lane, wave = wave0, gw = vcu * NWAVES + wave; (void)gw; (void)lane

    for (int rep_ = 0; rep_ < REPS(0); ++rep_) { if (rep_) xcd_barrier(bar, TIDNOW());
    if (IN(0) && EN(0)) {
        IDS_NOW;
        PHASE_IDS;
        auto c_in = INP(1); auto cctx_in = INP(3); auto ada_w = INP(4); auto ada_b = INP(5);
        auto diff_lambda = INP(8);
        auto MOD = WSP(float, WS_MOD); auto ROPEC = WSP(float, WS_ROPEC); auto ROPES = WSP(float, WS_ROPES); auto LAMV = WSP(float, WS_LAM);
        if (bid < 2 * 96) {
            const int l = bid / 96, nb = bid % 96;
            LAS float* sl = (LAS float*)(ldsl + wave * 2560);
            LAS float* part = (LAS float*)(ldsl + 32768);
            { float cvv[10];
#pragma unroll
              for (int t = 0; t < 10; ++t) { const int idx = lane + 64 * t; const int r = idx >> 7, kk = idx & 127, k = wave * 128 + kk; cvv[t] = r < 4 ? c_in[r * D + k] : cctx_in[k]; }
#pragma unroll
              for (int t = 0; t < 10; ++t) sl[lane + 64 * t] = cvv[t] / (1.0f + __expf(-cvv[t])); }
            LDS_WAIT(); asm volatile("" ::: "memory");
            float a[5];
#pragma unroll
            for (int r = 0; r < 5; ++r) a[r] = 0.f;
            gcfp wp = ada_w + ((size_t)l * D + wave * 128) * NIN + nb * 64 + lane;
#pragma unroll 32
            for (int kk = 0; kk < 128; ++kk) { const float wv = wp[(size_t)kk * NIN];
#pragma unroll
                for (int r = 0; r < 5; ++r) a[r] += wv * sl[r * 128 + kk]; }
#pragma unroll
            for (int r = 0; r < 5; ++r) part[(wave * 5 + r) * 64 + lane] = a[r];
            __syncthreads();
            for (int idx = tid; idx < 320; idx += NWAVES * 64) { const int r = idx >> 6, cc = idx & 63; float s = ada_b[l * NIN + nb * 64 + cc];
#pragma unroll
                for (int w = 0; w < 8; ++w) s += part[(w * 5 + r) * 64 + cc];
                MOD[((size_t)l * 5 + r) * NIN + nb * 64 + cc] = s; }
            __syncthreads();
        }
        if (bid == G - 1) {
            for (int idx = tid; idx < 1024; idx += NWAVES * 64) { const int pos = idx >> 4, p = idx & 15; const float inv = powf(10000.0f, -(float)p / 16.0f); const float ang = (float)pos * inv;
                ROPEC[idx] = cosf(ang); ROPES[idx] = sinf(ang); }
            if (wave < 2) { gcfp lv = diff_lambda + wave * 256;
                const float s1 = wave_sum(lv[lane] * lv[64 + lane]), s2 = wave_sum(lv[128 + lane] * lv[192 + lane]);
                const float lam_init = 0.8f - 0.6f * expf(-0.3f * (float)wave);
                if (lane == 0) LAMV[wave] = expf(s1) - expf(s2) + lam_init; }
        }
        cvt_range(MISC, ldsl, 0, CVT_P0_END, gw, NGW, wave, lane);
    }
    }
    SEAM(0);
    if (IN(1) && EN(1)) {
        IDS_NOW;
        PHASE_IDS;
        auto x_in = INP(0); auto ctx_in = INP(2); auto norm_g = INP(6);
        auto MOD = WSP(float, WS_MOD); auto X = WSP(float, WS_X); auto H = WSP(bf16, WS_H);
        {
            auto PV = WSP(float, WS_PV);
            for (int idx = bid * (NWAVES * 64) + tid; idx < DEPTH * 5 * D; idx += G * NWAVES * 64) { const int l_ = idx / (5 * D), mr_ = (idx / D) % 5, d_ = idx % D;
                gcfp md_ = MOD + ((size_t)l_ * 5 + mr_) * NIN; gcfp ng_ = norm_g + (size_t)l_ * 4 * D; gfp pv_ = PV + ((size_t)l_ * 5 + mr_) * 4 * D;
                pv_[d_] = md_[2 * D + d_] * ng_[D + d_]; pv_[D + d_] = ng_[2 * D + d_] * (1.0f + md_[4 * D + d_]); pv_[2 * D + d_] = md_[5 * D + d_] * ng_[3 * D + d_]; pv_[3 * D + d_] = ng_[d_] * (1.0f + md_[D + d_]); }
        }
        {
            const int RPB = (MTOT + G - 1) / G, r0 = bid * RPB;
            int i = wave; bool have = (i < RPB && r0 + i < MTOT); f32x4 xn[4], A2[4]; int mrc = -1;
#define P1SRC(r_) ((r_) < MLAT ? x_in + (size_t)(r_) * D : ctx_in + (size_t)((r_) - MLAT) * D)
            if (have) ld_row(P1SRC(r0 + i), lane, xn);
            while (have) {
                const int r = r0 + i; f32x4 xv[4], hv[4];
#pragma unroll
                for (int j = 0; j < 4; ++j) xv[j] = xn[j];
                const int inx = i + NWAVES; const bool hn = (inx < RPB && r0 + inx < MTOT);
                if (hn) ld_row(P1SRC(r0 + inx), lane, xn);
                const int mr = r < MLAT ? (r >> 12) : 4;
                gcfp md = MOD + (size_t)mr * NIN; ld_row(md, lane, hv);
                if (mr != mrc) { ld_scale(norm_g, md + 1024, lane, A2); mrc = mr; }
                norm_affine_row(xv, A2, lane, hv, H + (size_t)r * D);
                i = inx; have = hn;
            }
#undef P1SRC
        }
    }
    SEAM(1);

    for (int l = 0; l < DEPTH; ++l) {
        const int pb = 2 + 8 * l; const bool lastl = (l == DEPTH - 1);
        const int ML = lastl ? MLAT : MTOT;
        unsigned* cntg = ctl + CW_CNT + l * 32 * 64;
        for (int rep_ = 0; rep_ < (l == 0 ? REPS(2) : 1); ++rep_) { if (rep_) xcd_barrier(bar, TIDNOW());
        if (IN(pb + 0) && EN(2)) {
            IDS_NOW;
            auto H = WSP(bf16, WS_H); auto WIN = WSP(bf16, WS_WIN);
            pg8::Gemm g{(const bf16*)H, (const bf16*)(WIN + (size_t)l * NIN * D), MTOT, NIN, D}; pg8::StaticOrder S; S.init(MTOT, NIN, G, bid);
            EpiInproj E{MISC, l};
            { const int c0s = (MTOT / 256) * (NIN / 256) - ((MTOT / 256) * (NIN / 256) / G) * G;
              if (c0s > 0 && bid >= c0s) { const int nsl = INPROJ_STAGGER * (1 + (bid - c0s) % 3); for (int i_ = 0; i_ < nsl; ++i_) __builtin_amdgcn_s_sleep(64); } }
            pg8::gemm_phase<EpiInproj, pg8::StaticOrder, false>(ldsl, g, S, E, wave0);
            { const int nfull = (MTOT / 256) * (NIN / 256) / G, c0 = (MTOT / 256) * (NIN / 256) - nfull * G;
              if (c0 > 0 && bid >= c0) { const int tc = TIDNOW(); const int wv = wave0;
                  cvt_range(MISC, ldsl, l == 0 ? CVT_P0_END : CVT_T4_END, l == 0 ? CVT_T1_END : CVT_END, (bid - c0) * NWAVES + wv, (G - c0) * NWAVES, wv, tc & 63); } }
        }
        }
        SEAM(pb + 0);
        for (int rep_ = 0; rep_ < (l == 0 ? REPS(3) : 1); ++rep_) { if (rep_) xcd_barrier(bar, TIDNOW());
        if (IN(pb + 1) && EN(3)) {
            IDS_NOW;
            auto diff_subln = INP(9); auto sink = INP(11); auto LAMV = WSP(float, WS_LAM);
            auto QA = WSP(bf16, WS_QA); auto QB = WSP(bf16, WS_QB); auto QC = WSP(bf16, WS_QC);
            auto KA = WSP(bf16, WS_KA); auto VA = WSP(bf16, WS_VA); auto KB = WSP(bf16, WS_KB); auto VB = WSP(bf16, WS_VB); auto KC = WSP(bf16, WS_KC); auto VC = WSP(bf16, WS_VC);
            auto YS = WSP(bf16, WS_YS);
            const int NU = lastl ? 1536 : 1632;
            const float lam = LAMV[l]; const float post = 1.0f - (0.8f - 0.6f * expf(-0.3f * (float)l));
            {
                for (int rp_ = 0; rp_ < ((A128DUP && l == 0) ? 2 : 1); ++rp_)
                for (int pr = vcu; pr < 256; pr += G) {
                    const int b = pr >> 6, hh = (pr >> 4) & 3, q0 = b * SEQ + (pr & 15) * 256;
                    const size_t kv0 = (size_t)b * KVR * 512 + hh * 128;
                    for (int mp = 0; mp < 2; ++mp) {
                        __syncthreads();
                        att128::attn_unit<8>((const att64::bf16*)(const bf16*)(QA + (size_t)q0 * 512 + hh * 128 + mp * 64), 512, (const att64::bf16*)(const bf16*)(KA + kv0 + mp * 64), (const att64::bf16*)(const bf16*)(VA + kv0), 512, 68, mp,
                                             lam, diff_subln + l * 128, post, (att64::bf16*)(bf16*)(YS + (size_t)q0 * 512 + hh * 128), 512, (char*)lds, wave0);
                    }
                }
            }
            for (int i = 0;; ++i) {
                const int L = 512 + i * G + vcu; if (L >= NU) break;
                int type, b, hh, qb, qrow; bool isctx;
                if (L < 1536) { type = L / 512; const int idx = L % 512; b = idx >> 7; hh = (idx >> 5) & 3; qb = idx & 31; qrow = b * SEQ + qb * 128; isctx = false; }
                else { const int e = L - 1536; type = e / 32; const int idx = e % 32; b = idx >> 3; hh = (idx >> 1) & 3; qb = idx & 1; qrow = MLAT + b * CTXL + qb * 128; isctx = true; }
                if (type != 0) {
                    __syncthreads();
                    const int idx = isctx ? (L - 1536) % 32 : L % 512;
                    if (type == 1) {
                        const int b1 = isctx ? idx >> 3 : idx >> 7, head = isctx ? idx & 7 : (idx >> 4) & 7, q0 = isctx ? MLAT + b1 * CTXL : b1 * SEQ + (idx & 15) * 256;
                        const size_t kv0 = ((size_t)b1 * KVR + (isctx ? SEQ : 0)) * 128 + (head >> 2) * 64; const int nt = isctx ? 4 : 68;
                        att64::attn_unit<8, false, false>((const att64::bf16*)(const bf16*)(QB + (size_t)q0 * 512 + head * 64), 512, (const att64::bf16*)(const bf16*)(KB + kv0), (const att64::bf16*)(const bf16*)(VB + kv0), 128, nt, nt, 0, 0, 0, 0, 0.f, 0.f,
                                                         (att64::bf16*)(bf16*)(YS + (size_t)MTOT * 512 + (size_t)q0 * 512 + head * 64), 512, (char*)lds, wave0);
                    } else {
                        const int b1 = isctx ? idx >> 3 : idx >> 7, hp = isctx ? (idx >> 1) & 3 : (idx >> 5) & 3, qbl = isctx ? idx & 1 : idx & 31;
                        const int head = 2 * hp, q0 = isctx ? MLAT + b1 * CTXL + qbl * 128 : b1 * SEQ + qbl * 128;
                        const size_t kv0 = ((size_t)b1 * KVR + SEQ) * 128 + (head >> 2) * 64; const float sl2a = sink[l * 8 + head] * 1.4426950408889634f, sl2b = sink[l * 8 + head + 1] * 1.4426950408889634f;
                        const att64::bf16* qp_ = (const att64::bf16*)(const bf16*)(QC + (size_t)q0 * 512 + head * 64); att64::bf16* op_ = (att64::bf16*)(bf16*)(YS + (size_t)2 * MTOT * 512 + (size_t)q0 * 512 + head * 64);
                        if (isctx) att64::attn_unit<8, false, true>(qp_, 512, (const att64::bf16*)(const bf16*)(KC + kv0), (const att64::bf16*)(const bf16*)(VC + kv0), 128, 4, 4, 0, 0, 0, 1, sl2a, sl2b, op_, 512, (char*)lds, wave0);
                        else { const int qpos = qbl * 128; const int klo = qpos - 128 < 0 ? 0 : qpos - 128, khi = qpos + 256 > SEQ ? SEQ : qpos + 256; const int n2 = (khi - klo) / 64;
                            att64::attn_unit<8, true, true>(qp_, 512, (const att64::bf16*)(const bf16*)(KC + kv0), (const att64::bf16*)(const bf16*)(VC + kv0), 128, 4 + n2, 4, klo - SEQ, klo, qpos, 1, sl2a, sl2b, op_, 512, (char*)lds, wave0); }
                    }
                    continue;
                }
                att::UnitArgs A;
                A.s1 = isctx ? SEQ : 0; A.n1 = isctx ? 4 : 68; A.s2 = 0; A.n2 = 0; A.qpos0 = -1; A.use_sink = 0; A.sink0 = 0.f; A.sink1 = 0.f; A.lam = lam; A.post = post; A.subg = diff_subln + l * 128;
                {
                    A.Q = QA + (size_t)qrow * 512 + hh * 128; A.qg1 = 64; A.K = KA + (size_t)b * KVR * 512 + hh * 128; A.V = VA + (size_t)b * KVR * 512 + hh * 128; A.ldk = 512;
                    A.O = YS + (size_t)qrow * 512 + hh * 128; A.og1 = 0;
                    att::attn_unit<true, false>(A, (char*)lds, wave0);
                }
            }
        }
        }
        SEAM(pb + 1);
        for (int rep_ = 0; rep_ < (l == 0 ? REPS(4) : 1); ++rep_) { if (rep_) xcd_barrier(bar, TIDNOW());
        if (IN(pb + 2) && EN(4)) {
            IDS_NOW;
            auto YS = WSP(bf16, WS_YS); auto WB = WSP(bf16, WS_WB);
            pg8::Gemm g{(const bf16*)YS, (const bf16*)(WB + (size_t)l * 3 * D * 512), 3 * MTOT, 3 * D, 512}; MergeOrder S{(ML / 256) * 4, G, vcu};
            EpiMerge E{MISC};
            pg8::gemm_phase<EpiMerge, MergeOrder, false>(ldsl, g, S, E, wave0);
            { const int c0 = (ML / 256) * 4 - G;
              if (l == 0 && c0 > 0 && c0 < G && vcu >= c0) { const int tc = TIDNOW(); const int wv = wave0;
                  cvt_range(MISC, ldsl, CVT_T1_END, CVT_T3_END, (vcu - c0) * NWAVES + wv, (G - c0) * NWAVES, wv, tc & 63); } }
        }
        }
        SEAM(pb + 2);
        for (int rep_ = 0; rep_ < (l == 0 ? REPS(5) : 1); ++rep_) { if (rep_) xcd_barrier(bar, TIDNOW());
        if (IN(pb + 3) && EN(5)) {
            IDS_NOW;
            auto MG = WSP(bf16, WS_MG); auto WO = WSP(bf16, WS_WO);
            pg8::Gemm g{(const bf16*)MG, (const bf16*)(WO + (size_t)l * D * D), ML, D, D}; pg8::StaticOrder S; S.init(ML, D, G, bid);
            EpiOut E{MISC};
            pg8::gemm_phase<EpiOut, pg8::StaticOrder, false>(ldsl, g, S, E, wave0);
            { const int c0 = (ML / 256) * 4 - G;
              if (l == 0 && c0 > 0 && c0 < G && bid >= c0) { const int tc = TIDNOW(); const int wv = wave0;
                  cvt_range(MISC, ldsl, CVT_T3_END, CVT_T4_END, (bid - c0) * NWAVES + wv, (G - c0) * NWAVES, wv, tc & 63); } }
        }
        }
        SEAM(pb + 3);
        if (IN(pb + 4) && EN(6)) {
            IDS_NOW;
            PHASE_IDS;
            auto norm_g = INP(6); auto router_w = INP(14); auto router_b = INP(15);
            gcfp ng = norm_g + (size_t)l * 4 * D; auto modl = WSP(float, WS_MOD) + (size_t)l * 5 * NIN;
            auto Y = WSP(bf16, WS_Y); auto X = WSP(float, WS_X); auto H2 = WSP(bf16, WS_H2); auto x_in0 = INP(0); auto ctx_in0 = INP(2);
            auto SE = WSP(int, WS_SE); auto SR = WSP(int, WS_SR); auto SW = WSP(float, WS_SW); auto LIST = WSP(int, WS_LIST);
            LAS f32x4* rwL = (LAS f32x4*)ldsl;
            gcfp rw = router_w + (size_t)l * D * NE;
            {
                f32x4 tw[16];
#pragma unroll
                for (int k = 0; k < 16; ++k) { const int idx = tid + k * (NWAVES * 64); const int d = idx >> 3, q = idx & 7; tw[k] = *(const GAS f32x4*)(rw + (size_t)d * NE + q * 4); }
#pragma unroll
                for (int k = 0; k < 16; ++k) { const int idx = tid + k * (NWAVES * 64); const int d = idx >> 3, q = idx & 7; const int rowp = (d & 3) * 256 + (d >> 2);
                    rwL[rowp * 8 + (q ^ ((rowp >> 1) & 7))] = tw[k]; }
            }
            volatile LAS unsigned* hist = MISC + MW_HIST; volatile LAS unsigned* gbase = MISC + MW_BASE; volatile LAS unsigned* slotw = MISC + MW_SLOT + wave * (9 * 4 * 3);
            if (tid < NE) hist[tid] = 0u;
            __syncthreads();
            const int RPB = (ML + G - 1) / G; const int r0 = bid * RPB;
            int nti = 0;
#if TOKPROBE & 1
            for (int rep1 = (l == 0) ? 0 : 1; rep1 < 2; ++rep1) { const bool dry1 = rep1 == 0; gfp Xo = dry1 ? (gfp)WSP(float, WS_TMP) : (gfp)X; gbp H2o = dry1 ? (gbp)WSP(bf16, WS_ACT) : (gbp)H2; nti = 0;
#else
            { gfp Xo = (gfp)X; gbp H2o = (gbp)H2; constexpr bool dry1 = false;
#endif
            {
            int i = wave; bool have = (i < RPB && r0 + i < ML);
            u32x2 yn[4]; auto PVl = WSP(float, WS_PV) + (size_t)l * 5 * 4 * D;
#define YLD(r_) do { _Pragma("unroll") for (int j = 0; j < 4; ++j) yn[j] = *(const GAS u32x2*)(Y + (size_t)(r_) * D + 4 * lane + 256 * j); } while (0)
#define XSRC(r_) (l == 0 ? ((r_) < MLAT ? x_in0 + (size_t)(r_) * D : ctx_in0 + (size_t)((r_) - MLAT) * D) : (gcfp)(X + (size_t)(r_) * D))
            if (have) { YLD(r0 + i); }
            while (have) {
                const int r = r0 + i; const int mr = r < MLAT ? (r >> 12) : 4;
                gcfp md = modl + (size_t)mr * NIN; gcfp pv = PVl + (size_t)mr * 4 * D; f32x4 yv[4], xv[4], hv[4], A1[4], A2[4];
                ld_row(XSRC(r), lane, xv); ld_row(pv, lane, A1); ld_row(pv + D, lane, A2); ld_row(md + 3 * D, lane, hv);

#pragma unroll
                for (int j = 0; j < 4; ++j) yv[j] = (f32x4){bflo(yn[j].x), bfhi(yn[j].x), bflo(yn[j].y), bfhi(yn[j].y)};
                const int inx = i + NWAVES; const bool hn = (inx < RPB && r0 + inx < ML);
                if (hn) { YLD(r0 + inx); }
                const float rny = __builtin_amdgcn_rsqf(sumsq_row(yv) * (1.0f / D) + EPS);
#pragma unroll
                for (int j = 0; j < 4; ++j) { const int c = 4 * lane + 256 * j; xv[j] = xv[j] + A1[j] * (yv[j] * rny); *(GAS f32x4*)(Xo + (size_t)r * D + c) = xv[j]; }
                if (l >= MOE_F8_FROM) norm_affine_row<true>(xv, A2, lane, hv, (gbp)((GAS unsigned char*)H2o + (size_t)r * D));
                else norm_affine_row<false>(xv, A2, lane, hv, H2o + (size_t)r * D);
                float a[32];
#pragma unroll
                for (int q = 0; q < 32; ++q) a[q] = 0.f;
                const int sw = (lane >> 1) & 7;
                {
                    f32x4 wA[8], wB[8];
#define RW_LD(W, blk) do { const int rowp_ = ((blk) & 3) * 256 + 64 * ((blk) >> 2) + lane; _Pragma("unroll") for (int q = 0; q < 8; ++q) W[q] = rwL[rowp_ * 8 + (q ^ sw)]; } while (0)
#define RW_FMA(W, blk) do { const float hval_ = hv[(blk) >> 2][(blk) & 3]; _Pragma("unroll") for (int q = 0; q < 8; ++q) { a[4 * q + 0] += hval_ * W[q][0]; a[4 * q + 1] += hval_ * W[q][1]; a[4 * q + 2] += hval_ * W[q][2]; a[4 * q + 3] += hval_ * W[q][3]; } } while (0)
                    RW_LD(wA, 0);
#pragma unroll
                    for (int blk = 0; blk < 16; blk += 2) { RW_LD(wB, blk + 1); RW_FMA(wA, blk); __builtin_amdgcn_sched_barrier(0); if (blk + 2 < 16) RW_LD(wA, blk + 2); RW_FMA(wB, blk + 1); __builtin_amdgcn_sched_barrier(0); }
#undef RW_LD
#undef RW_FMA
                }
#define RS(N, MASK) do { const bool up = (lane & (MASK)) != 0; _Pragma("unroll") for (int q = 0; q < (N) / 2; ++q) { const float keep = up ? a[(N) / 2 + q] : a[q]; const float send = up ? a[q] : a[(N) / 2 + q]; a[q] = keep + __shfl_xor(send, (MASK)); } } while (0)
                RS(32, 32); RS(16, 16); RS(8, 8); RS(4, 4); RS(2, 2);
#undef RS
                const int myE = (lane >> 1) & 31;
                float val = a[0] + dppf<0xB1>(a[0]) + router_b[l * NE + myE];
                float tv[4]; int te[4];
#define BETTER(ov, oe, bv, be) ((ov) > (bv) || ((ov) == (bv) && (oe) < (be)))
#define TSTEP(CTRL) do { const float ov = dppf<CTRL>(bv); const int oe = dppi<CTRL>(be); if (BETTER(ov, oe, bv, be)) { bv = ov; be = oe; } } while (0)
#pragma unroll
                for (int k = 0; k < 4; ++k) { float bv = val; int be = myE;
                    TSTEP(0x4E); TSTEP(0x141); TSTEP(0x140);
                    float v0 = rdl(bv, 0), v1 = rdl(bv, 16), v2 = rdl(bv, 32), v3 = rdl(bv, 48);
                    int e0 = __builtin_amdgcn_readlane(be, 0), e1 = __builtin_amdgcn_readlane(be, 16), e2 = __builtin_amdgcn_readlane(be, 32), e3 = __builtin_amdgcn_readlane(be, 48);
                    if (BETTER(v1, e1, v0, e0)) { v0 = v1; e0 = e1; } if (BETTER(v3, e3, v2, e2)) { v2 = v3; e2 = e3; } if (BETTER(v2, e2, v0, e0)) { v0 = v2; e0 = e2; }
                    tv[k] = v0; te[k] = e0; if (myE == e0) val = -INFINITY; }
#undef TSTEP
#undef BETTER
                const float e1 = __expf(tv[1] - tv[0]), e2 = __expf(tv[2] - tv[0]), e3 = __expf(tv[3] - tv[0]); const float inv = 1.0f / (1.0f + e1 + e2 + e3);
                if (lane < 4) { const int ek = lane == 0 ? te[0] : lane == 1 ? te[1] : lane == 2 ? te[2] : te[3]; const float wk = (lane == 0 ? 1.0f : lane == 1 ? e1 : lane == 2 ? e2 : e3) * inv;
                    const unsigned lr = __hip_atomic_fetch_add((LAS unsigned*)((dry1 ? gbase : hist) + ek), 1u, __ATOMIC_RELAXED, __HIP_MEMORY_SCOPE_WORKGROUP);
                    slotw[(nti * 4 + lane) * 3 + 0] = (unsigned)ek; slotw[(nti * 4 + lane) * 3 + 1] = lr; slotw[(nti * 4 + lane) * 3 + 2] = __builtin_bit_cast(unsigned, wk); }
                i = inx; have = hn; ++nti;
            }
            }
            }
            __syncthreads();
            if (tid < NE) { const unsigned hcount = hist[tid]; gbase[tid] = hcount ? __hip_atomic_fetch_add(cntg + tid * 64, hcount, __ATOMIC_RELAXED, __HIP_MEMORY_SCOPE_AGENT) : 0u; }
            __syncthreads();
            nti = 0;
            for (int i = wave; i < RPB && r0 + i < ML; i += NWAVES, ++nti) {
                const int r = r0 + i;
                if (lane < 4) { const unsigned ek = slotw[(nti * 4 + lane) * 3 + 0], lr = slotw[(nti * 4 + lane) * 3 + 1], wkb = slotw[(nti * 4 + lane) * 3 + 2];
                    const unsigned rank = gbase[ek] + lr;
                    LIST[(size_t)ek * MTOT + rank] = r; SE[r * 4 + lane] = (int)ek; SR[r * 4 + lane] = (int)rank; SW[r * 4 + lane] = __builtin_bit_cast(float, wkb); }
            }
            __syncthreads();
        }
        SEAM(pb + 4);
        LAS int* tb = (LAS int*)(ldsl + MISC_OFF) + MW_TB; LAS int* cn = (LAS int*)(ldsl + MISC_OFF) + MW_CNT;
        if (IN(pb + 5) || IN(pb + 6) || IN(pb + 7)) {
            IDS_NOW;
            __syncthreads();
            const int tid = TIDNOW();
            if (tid < NE) cn[tid] = (int)__hip_atomic_load(cntg + tid * 64, __ATOMIC_RELAXED, __HIP_MEMORY_SCOPE_AGENT);
            __syncthreads();
            if (tid == 0) { int accu = 0; for (int e = 0; e < NE; ++e) { tb[e] = accu; accu += (cn[e] + 255) >> 8; } tb[NE] = accu; }
            __syncthreads();
        }
        for (int rep_ = 0; rep_ < (l == 0 ? REPS(7) : 1); ++rep_) { if (rep_) xcd_barrier(bar, TIDNOW());
        if (IN(pb + 5) && EN(7)) {
            IDS_NOW;
            auto H2 = WSP(bf16, WS_H2); auto W1 = WSP(bf16, WS_W1); auto LIST = WSP(int, WS_LIST);
            MoeOrder<8> S; S.init(tb, cn, LIST, G, bid);
            if (l >= MOE_F8_FROM) { pg8::Gemm g{(const bf16*)H2, (const bf16*)(W1 + (size_t)l * NE * 2048 * D), MTOT, NE * 2048, D / 2}; EpiSwiglu<true> E{MISC, l};
                pg8::gemm_phase<EpiSwiglu<true>, MoeOrder<8>, true, true>(ldsl, g, S, E, wave0); }
            else { pg8::Gemm g{(const bf16*)H2, (const bf16*)(W1 + (size_t)l * NE * 2048 * D), MTOT, NE * 2048, D}; EpiSwiglu<false> E{MISC, l};
                pg8::gemm_phase<EpiSwiglu<false>, MoeOrder<8>, true, false>(ldsl, g, S, E, wave0); }
        }
        }
        SEAM(pb + 5);
        for (int rep_ = 0; rep_ < (l == 0 ? REPS(8) : 1); ++rep_) { if (rep_) xcd_barrier(bar, TIDNOW());
        if (IN(pb + 6) && EN(8)) {
            IDS_NOW;
            auto ACT = WSP(bf16, WS_ACT); auto W2 = WSP(bf16, WS_W2); auto LIST = WSP(int, WS_LIST);
            MoeOrder<4> S; S.init(tb, cn, LIST, G, bid);
            if (l >= MOE_F8_FROM) { pg8::Gemm g{(const bf16*)ACT, (const bf16*)(W2 + (size_t)l * NE * D * D), MAXTILES * 256, NE * D, D / 2}; EpiMoe2<true> E{MISC, l};
                pg8::gemm_phase<EpiMoe2<true>, MoeOrder<4>, false, true>(ldsl, g, S, E, wave0); }
            else { pg8::Gemm g{(const bf16*)ACT, (const bf16*)(W2 + (size_t)l * NE * D * D), MAXTILES * 256, NE * D, D}; EpiMoe2<false> E{MISC, l};
                pg8::gemm_phase<EpiMoe2<false>, MoeOrder<4>, false, false>(ldsl, g, S, E, wave0); }
        }
        }
        SEAM(pb + 6);
        if (IN(pb + 7) && EN(9)) {
            IDS_NOW;
            PHASE_IDS;
            auto norm_g = INP(6); gcfp ng = norm_g + (size_t)l * 4 * D; auto MOD = WSP(float, WS_MOD); gcfp modl = MOD + (size_t)l * 5 * NIN;
            auto X = WSP(float, WS_X); auto H = WSP(bf16, WS_H); auto YS2 = WSP(bf16, WS_YS2); gfp outp = (gfp)ldp(MISC, 20);
            auto SE = WSP(int, WS_SE); auto SR = WSP(int, WS_SR); auto SW = WSP(float, WS_SW);
            for (int rep2 = ((TOKPROBE & 2) && l == 0) ? 0 : 1; rep2 < 2; ++rep2) { const bool dry2 = rep2 == 0; gfp Xo = dry2 ? (gfp)WSP(float, WS_TMP) : (gfp)X; gbp Ho = dry2 ? (gbp)WSP(bf16, WS_MG) : (gbp)H;
            for (int rb = gw; rb < ML; rb += 16 * NGW) {
                const int myr = rb + (lane >> 2) * NGW; const bool vld = myr < ML;
                const int se = vld ? SE[myr * 4 + (lane & 3)] : 0, sr = vld ? SR[myr * 4 + (lane & 3)] : 0; const float swt = vld ? SW[myr * 4 + (lane & 3)] : 0.f;
                const int yrow = tb[se] * 256 + sr;
                u32x2 yn[4][4]; f32x4 xn[4];
#define T2_LOAD(ri_) do { const int r_ = rb + (ri_) * NGW; _Pragma("unroll") for (int k = 0; k < 4; ++k) { const int yr_ = __builtin_amdgcn_readlane(yrow, (ri_) * 4 + k); gcbp yp = YS2 + (size_t)yr_ * D; \
                    _Pragma("unroll") for (int j = 0; j < 4; ++j) yn[k][j] = *(const GAS u32x2*)(yp + 4 * lane + 256 * j); } ld_row(X + (size_t)r_ * D, lane, xn); } while (0)
                int ri = 0;
                if (rb < ML) T2_LOAD(0);
                while (ri < 16 && rb + ri * NGW < ML) {
                    const int r = rb + ri * NGW; const int mr = r < MLAT ? (r >> 12) : 4; gcfp md = modl + (size_t)mr * NIN;
                    f32x4 yv[4], xv[4];
#pragma unroll
                    for (int j = 0; j < 4; ++j) { yv[j] = (f32x4){0.f, 0.f, 0.f, 0.f}; xv[j] = xn[j]; }
#pragma unroll
                    for (int k = 0; k < 4; ++k) { const float wk = rdl(swt, ri * 4 + k);
#pragma unroll
                        for (int j = 0; j < 4; ++j) { const u32x2 w = yn[k][j]; yv[j][0] += wk * bflo(w.x); yv[j][1] += wk * bfhi(w.x); yv[j][2] += wk * bflo(w.y); yv[j][3] += wk * bfhi(w.y); } }
                    if (ri + 1 < 16 && rb + (ri + 1) * NGW < ML) T2_LOAD(ri + 1);
                    const float rny = 1.0f / sqrtf(sumsq_row(yv) * (1.0f / D) + EPS);
#pragma unroll
                    for (int j = 0; j < 4; ++j) { const int c = 4 * lane + 256 * j; const f32x4 g3 = *(const GAS f32x4*)(ng + 3 * D + c), gf = *(const GAS f32x4*)(md + 5 * D + c);
                        xv[j] = xv[j] + gf * ((yv[j] * rny) * g3);
                        if (lastl) *(GAS f32x4*)(outp + (size_t)r * D + c) = xv[j]; else *(GAS f32x4*)(Xo + (size_t)r * D + c) = xv[j]; }
                    if (!lastl) { f32x4 hv[4]; gcfp mdn = MOD + ((size_t)(l + 1) * 5 + mr) * NIN;
                        norm_mod_row(xv, norm_g + (size_t)(l + 1) * 4 * D, mdn + 1024, mdn, lane, hv, Ho + (size_t)r * D); }
                    ++ri;
                }
#undef T2_LOAD
            }
            if (dry2) { asm volatile("s_waitcnt vmcnt(0)" ::: "memory"); __syncthreads(); } }
        }
        if (!lastl) SEAM(pb + 7);
    }
#undef IN
#undef SEAM
}

constexpr int N_PHASES = 2 + 8 * DEPTH;
#ifndef MK_CUTS
#define MK_CUTS 0
#endif
extern "C" void kernel_launch(void* const* d_in, const int* in_sizes, int n_in, void* d_out, int out_size, void* d_ws, size_t ws_size, hipStream_t stream) {
    static int grid = 0;
    if (grid == 0) {
        if (n_in != 20 || out_size != MLAT * D || ws_size < WS_END) { fprintf(stderr, "kernel_launch: unexpected shapes (n_in %d out %d ws %zu need %zu)\n", n_in, out_size, ws_size, (size_t)WS_END); grid = -1; return; }
        int dev = 0, cus = 0, per_cu = 0;
        if (hipGetDevice(&dev) != hipSuccess || hipDeviceGetAttribute(&cus, hipDeviceAttributeMultiprocessorCount, dev) != hipSuccess) { grid = -1; return; }
        if (hipFuncSetAttribute((const void*)mk_fwd, hipFuncAttributeMaxDynamicSharedMemorySize, LDS_BYTES) != hipSuccess) { fprintf(stderr, "kernel_launch: hipFuncSetAttribute failed\n"); grid = -1; return; }
        if (hipOccupancyMaxActiveBlocksPerMultiprocessor(&per_cu, (const void*)mk_fwd, NWAVES * 64, LDS_BYTES) != hipSuccess || per_cu < 1) { fprintf(stderr, "kernel_launch: occupancy query reports %d\n", per_cu); }
        (void)hipGetLastError();
        grid = cus;
    }
    if (grid < 0) return;
    if (hipMemsetAsync((char*)d_ws + WS_CTL, 0, CTL_BYTES, stream) != hipSuccess) return;
    Args a{};
    for (int i = 0; i < 20; ++i) a.in[i] = (const float*)d_in[i];
    a.out = (float*)d_out; a.ws = (unsigned char*)d_ws;
#if MK_CUTS
    for (int p = 0; p < N_PHASES; ++p) { a.ph_lo = p; a.ph_hi = p + 1; hipLaunchKernelGGL(mk_fwd, dim3(grid), dim3(NWAVES * 64), LDS_BYTES, stream, a); }
#else
    a.ph_lo = 0; a.ph_hi = N_PHASES;
    hipLaunchKernelGGL(mk_fwd, dim3(grid), dim3(NWAVES * 64), LDS_BYTES, stream, a);
#endif
    const hipError_t le = hipPeekAtLastError();
    if (le != hipSuccess) fprintf(stderr, "kernel_launch: launch failed: %s\n", hipGetErrorName(le));
}
```

```cpp
#include <hip/hip_runtime.h>
#include <cstdio>
#include <cstdint>

#define LAS __attribute__((address_space(3)))
#define GAS __attribute__((address_space(1)))

__device__ __forceinline__ int lane_now() { int l = (int)__builtin_amdgcn_mbcnt_hi(~0u, __builtin_amdgcn_mbcnt_lo(~0u, 0u)); asm volatile("" : "+v"(l)); return l; }

namespace pg8 {
#define PG8_LAS __attribute__((address_space(3)))
typedef unsigned short bf16_t;
typedef short bf16x8 __attribute__((ext_vector_type(8)));
typedef float f32x4 __attribute__((ext_vector_type(4)));
typedef float f32x2 __attribute__((ext_vector_type(2)));
typedef unsigned u32x4 __attribute__((ext_vector_type(4)));
typedef unsigned u32x2 __attribute__((ext_vector_type(2)));
constexpr int BM = 256, BK = 64, HALF = 128, HTB = HALF * BK * 2  , STAGE_BYTES = 8 * HTB, NXCD = 8, WGM = 8;

__host__ __device__ __forceinline__ int lds_byte(int r, int c) { const int st = (r >> 4) * 2 + (c >> 5), rr = r & 15, cc = c & 31, ob = rr * 64 + cc * 2; return st * 1024 + (ob ^ (((ob >> 9) & 1) << 5)); }
__host__ __device__ __forceinline__ void stage_rc(int b, int& R, int& C) { const int st = b / 1024, sb = b % 1024, swz = sb ^ (((sb >> 9) & 1) << 5); R = (st >> 1) * 16 + swz / 64; C = (st & 1) * 32 + (swz % 64) / 2; }
__host__ __device__ __forceinline__ int perm32(int rho) { const int n = rho >> 4, i = rho & 15; return 8 * (i >> 2) + 4 * n + (i & 3); }

struct Unit { int pm, pn; };
struct Gemm { const bf16_t* A; const bf16_t* Bt; int M, N, K; };

struct StaticOrder {
    int nM, nN, nwg, G, c;
    __host__ __device__ void init(int M, int N, int G_, int c_) { nM = M / BM; nN = N / BM; nwg = nM * nN; G = G_; c = c_; }
    __host__ __device__ bool next(int i, Unit& u) const {
        const long L = (long)i * G + c; if (L >= nwg) return false;
        int wgid = (int)L; { const int q = nwg / NXCD, r = nwg % NXCD, xcd = wgid % NXCD, off = wgid / NXCD; wgid = (xcd < r ? xcd * (q + 1) : r * (q + 1) + (xcd - r) * q) + off; }
        const int nig = WGM * nN, gid = wgid / nig, fm = gid * WGM, gsz = (nM - fm) < WGM ? (nM - fm) : WGM;
        u.pm = fm + ((wgid % nig) % gsz); u.pn = (wgid % nig) / gsz; return true;
    }
    __device__ __forceinline__ unsigned a_row(const Unit&, int) const { return 0u; }
};

__device__ __forceinline__ unsigned cvt_pk_bf16(float lo, float hi) { unsigned r; asm volatile("v_cvt_pk_bf16_f32 %0, %1, %2" : "=v"(r) : "v"(lo), "v"(hi)); return r; }

typedef int v8i32 __attribute__((ext_vector_type(8)));
typedef int v4i32 __attribute__((ext_vector_type(4)));
__device__ __forceinline__ v8i32 cat8(bf16x8 lo, bf16x8 hi) { const v4i32 a = __builtin_bit_cast(v4i32, lo), b = __builtin_bit_cast(v4i32, hi); return (v8i32){a[0], a[1], a[2], a[3], b[0], b[1], b[2], b[3]}; }
__device__ __forceinline__ void mfma_f8(f32x4& acc, v8i32 a, v8i32 b, int sc) {
    asm volatile("v_mfma_scale_f32_16x16x128_f8f6f4 %0, %1, %2, %0, %3, %3 op_sel_hi:[0,0,0]" : "+v"(acc) : "v"(a), "v"(b), "v"(sc)); }
template <class E> struct epi_chain { static constexpr bool v = false; };
template <class E> struct epi_dup { static constexpr int v = 0; };
template <class Epi, class Sched, bool GATHER, bool FP8 = false>
__device__ __forceinline__ void gemm_phase(PG8_LAS unsigned char* lds, const Gemm g, const Sched& S, const Epi& E, const int wave0) {
    const int lane = lane_now(), tid = wave0 * 64 + lane, wid = wave0, wr = wid >> 2, wc = wid & 3, fr = lane & 15, fq = lane >> 4;
    const int K = g.K, nt = K / BK;
    unsigned voffA[2], voffB[2]; int RA[2], CA[2];
#pragma unroll
    for (int i = 0; i < 2; ++i) { int R, C; stage_rc(tid * 16 + i * 8192, R, C); const int Rb = Epi::PERM ? ((R & ~31) + perm32(R & 31)) : R;
        RA[i] = R; CA[i] = C; voffA[i] = (unsigned)(R * K + C) * 2u; voffB[i] = (unsigned)(Rb * K + C) * 2u; }
    const size_t kstep = (size_t)(BK * 2);
    const size_t hstep = (size_t)HALF * K * 2;
    const size_t tstep = 2 * hstep;
    const unsigned ldsw = (unsigned)wid * 1024u;
    const int aoff = lds_byte(wr * 64 + fr, fq * 8), boff = lds_byte(wc * 32 + fr, fq * 8);
#define PG8_SA(b, h) (((b) * 2 + (h)) * HTB)
#define PG8_SB(b, h) ((4 + (b) * 2 + (h)) * HTB)
#define PG8_STAGE2(bufoff, gbase, o0, o1) do { \
        __builtin_amdgcn_global_load_lds((const unsigned*)((const char*)(gbase) + (o0)), (PG8_LAS unsigned*)(lds + (bufoff) + ldsw), 16, 0, 0); \
        __builtin_amdgcn_global_load_lds((const unsigned*)((const char*)(gbase) + (o1)), (PG8_LAS unsigned*)(lds + (bufoff) + ldsw + 8192), 16, 0, 0); } while (0)
#define PG8_STB(bufoff, gbase) PG8_STAGE2(bufoff, gbase, voffB[0], voffB[1])
#define PG8_STA(bufoff, ptr, h, OC) do { if constexpr (GATHER) PG8_STAGE2(bufoff, ptr, OC[h][0], OC[h][1]); else PG8_STAGE2(bufoff, (ptr) + ((h) ? hstep : (size_t)0), voffA[0], voffA[1]); } while (0)
#define PG8_LDA(dst, b, h) do { _Pragma("unroll") for (int m = 0; m < 4; ++m) _Pragma("unroll") for (int k = 0; k < 2; ++k) dst[m][k] = *(const PG8_LAS bf16x8*)(lds + PG8_SA(b, h) + aoff + m * 2048 + k * 1024); } while (0)
#define PG8_LDB(dst, b, h) do { _Pragma("unroll") for (int n = 0; n < 2; ++n) _Pragma("unroll") for (int k = 0; k < 2; ++k) dst[n][k] = *(const PG8_LAS bf16x8*)(lds + PG8_SB(b, h) + boff + n * 2048 + k * 1024); } while (0)
#define PG8_MMA(ai, bj, At, Bt) do { __builtin_amdgcn_s_setprio(1); \
        if constexpr (FP8) { _Pragma("unroll") for (int m = 0; m < 4; ++m) _Pragma("unroll") for (int n = 0; n < 2; ++n) \
            mfma_f8(acc[ai][bj][m][n], cat8(Bt[n][0], Bt[n][1]), cat8(At[m][0], At[m][1]), sc8); } \
        else { _Pragma("unroll") for (int m = 0; m < 4; ++m) _Pragma("unroll") for (int n = 0; n < 2; ++n) _Pragma("unroll") for (int k = 0; k < 2; ++k) \
            acc[ai][bj][m][n] = __builtin_amdgcn_mfma_f32_16x16x32_bf16(Bt[n][k], At[m][k], acc[ai][bj][m][n], 0, 0, 0); } \
        __builtin_amdgcn_s_setprio(0); } while (0)
#define PG8_WAIT_V(n) asm volatile("s_waitcnt vmcnt(" #n ")" ::: "memory")
#define PG8_WAIT_L(n) asm volatile("s_waitcnt lgkmcnt(" #n ")" ::: "memory")
#define PG8_BAR __builtin_amdgcn_s_barrier()
#define PG8_SCHED __builtin_amdgcn_sched_barrier(0)
    Unit cur, nxt; int ui = 0;
    if (!S.next(0, cur)) return;
    f32x4 acc[2][2][4][2];
#pragma unroll
    for (int a = 0; a < 2; ++a)
#pragma unroll
        for (int b = 0; b < 2; ++b)
#pragma unroll
            for (int m = 0; m < 4; ++m)
#pragma unroll
                for (int n = 0; n < 2; ++n) acc[a][b][m][n] = (f32x4){0.f, 0.f, 0.f, 0.f};
    bf16x8 At[4][2], B0[2][2], B1[2][2];
    int sc8 = 0x7f7f7f7f; asm volatile("" : "+v"(sc8));
    unsigned vC[2][2] = {{0u, 0u}, {0u, 0u}}, vN[2][2] = {{0u, 0u}, {0u, 0u}};
    if constexpr (GATHER) {
#pragma unroll
        for (int h = 0; h < 2; ++h)
#pragma unroll
            for (int i = 0; i < 2; ++i) vC[h][i] = (S.a_row(cur, h * HALF + RA[i]) * (unsigned)K + (unsigned)CA[i]) * 2u;
    }
    const char* Ab = (const char*)g.A;
    const char* cA = GATHER ? Ab : Ab + (size_t)cur.pm * tstep; const char* cB = (const char*)g.Bt + (size_t)cur.pn * tstep;
    PG8_STB(PG8_SB(0, 0), cB); PG8_STB(PG8_SB(0, 1), cB + hstep); PG8_STA(PG8_SA(0, 0), cA, 0, vC); PG8_STA(PG8_SA(0, 1), cA, 1, vC);
    if (wr == 1) PG8_BAR;
    PG8_WAIT_V(2); PG8_BAR;
    PG8_STB(PG8_SB(1, 0), cB + kstep); PG8_STA(PG8_SA(1, 0), cA + kstep, 0, vC); PG8_STB(PG8_SB(1, 1), cB + hstep + kstep);
    PG8_WAIT_V(6); PG8_BAR;
    for (;;) {
        const bool has_next = S.next(ui + 1, nxt);
        const char* nA = GATHER ? Ab : (has_next ? Ab + (size_t)nxt.pm * tstep : cA); const char* nB = has_next ? (const char*)g.Bt + (size_t)nxt.pn * tstep : cB;
        if constexpr (GATHER) {
            if (has_next) {
#pragma unroll
                for (int h = 0; h < 2; ++h)
#pragma unroll
                    for (int i = 0; i < 2; ++i) vN[h][i] = (S.a_row(nxt, h * HALF + RA[i]) * (unsigned)K + (unsigned)CA[i]) * 2u;
            } else {
#pragma unroll
                for (int h = 0; h < 2; ++h)
#pragma unroll
                    for (int i = 0; i < 2; ++i) vN[h][i] = vC[h][i];
            }
        }
        for (int t = 0; t < nt; t += 2) {
            const bool last = (t == nt - 2);
            const char* a1 = cA + (size_t)(t + 1) * kstep;
            const char* a2 = last ? nA : cA + (size_t)(t + 2) * kstep; const char* b2 = last ? nB : cB + (size_t)(t + 2) * kstep;
            const char* a3 = a2 + kstep; const char* b3 = b2 + kstep;
            unsigned v2[2][2];
#pragma unroll
            for (int h = 0; h < 2; ++h)
#pragma unroll
                for (int i = 0; i < 2; ++i) v2[h][i] = last ? vN[h][i] : vC[h][i];
            PG8_LDB(B0, 0, 0); PG8_LDB(B1, 0, 1); PG8_SCHED; PG8_LDA(At, 0, 0); PG8_STA(PG8_SA(1, 1), a1, 1, vC);
            PG8_WAIT_V(8); PG8_WAIT_L(0); PG8_BAR; PG8_MMA(0, 0, At, B0); PG8_MMA(0, 1, At, B1); PG8_BAR; PG8_SCHED;
            PG8_LDA(At, 0, 1); PG8_STB(PG8_SB(0, 0), b2); PG8_STB(PG8_SB(0, 1), b2 + hstep); PG8_STA(PG8_SA(0, 0), a2, 0, v2);
            PG8_WAIT_V(8); PG8_WAIT_L(0); PG8_BAR; PG8_MMA(1, 0, At, B0); PG8_MMA(1, 1, At, B1); PG8_BAR; PG8_SCHED;
            PG8_LDB(B0, 1, 0); PG8_LDB(B1, 1, 1); PG8_SCHED; PG8_LDA(At, 1, 0); PG8_STA(PG8_SA(0, 1), a2, 1, v2);
            PG8_WAIT_V(8); PG8_WAIT_L(0); PG8_BAR; PG8_MMA(0, 0, At, B0); PG8_MMA(0, 1, At, B1); PG8_BAR; PG8_SCHED;
            PG8_LDA(At, 1, 1); PG8_STB(PG8_SB(1, 0), b3); PG8_STB(PG8_SB(1, 1), b3 + hstep); PG8_STA(PG8_SA(1, 0), a3, 0, v2);
            PG8_WAIT_V(8); PG8_WAIT_L(0); PG8_BAR; PG8_MMA(1, 0, At, B0); PG8_MMA(1, 1, At, B1); PG8_BAR; PG8_SCHED;
        }
        if (wr == 0) PG8_BAR;
        if constexpr (FP8) {
            asm volatile("s_nop 15\n\ts_nop 15" ::: "memory");
#pragma unroll
            for (int a = 0; a < 2; ++a)
#pragma unroll
                for (int b = 0; b < 2; ++b)
#pragma unroll
                    for (int m = 0; m < 4; ++m)
#pragma unroll
                        for (int n = 0; n < 2; ++n) asm volatile("" : "+v"(acc[a][b][m][n]));
        }
        E(acc, cur, wr, wc, fr, fq);
        if constexpr (epi_dup<Epi>::v) { asm volatile("" ::: "memory"); E(acc, cur, wr, wc, fr, fq); }
        if (!has_next) break;
        bool keep_acc = false; if constexpr (epi_chain<Epi>::v) keep_acc = E.keep(cur);
        if (!keep_acc) {
#pragma unroll
        for (int a = 0; a < 2; ++a)
#pragma unroll
            for (int b = 0; b < 2; ++b)
#pragma unroll
                for (int m = 0; m < 4; ++m)
#pragma unroll
                    for (int n = 0; n < 2; ++n) acc[a][b][m][n] = (f32x4){0.f, 0.f, 0.f, 0.f};
        }
        cur = nxt; cA = nA; cB = nB; ++ui;
        if constexpr (GATHER) {
#pragma unroll
            for (int h = 0; h < 2; ++h)
#pragma unroll
                for (int i = 0; i < 2; ++i) vC[h][i] = vN[h][i];
        }
        if (wr == 1) PG8_BAR;
    }
    PG8_WAIT_V(0);
    PG8_BAR;
#undef PG8_SA
#undef PG8_SB
#undef PG8_STAGE2
#undef PG8_STB
#undef PG8_STA
#undef PG8_LDA
#undef PG8_LDB
#undef PG8_MMA
#undef PG8_WAIT_V
#undef PG8_WAIT_L
#undef PG8_BAR
#undef PG8_SCHED
}
}

namespace att {
typedef unsigned short bf16_t;
using bf16x8 = __attribute__((ext_vector_type(8))) short;
using s16x4  = __attribute__((ext_vector_type(4))) short;
using f32x16 = __attribute__((ext_vector_type(16))) float;
using u32x4  = __attribute__((ext_vector_type(4))) unsigned;
constexpr int NW = 8, QBLK = 32, KVBLK = 64;
constexpr float SCALE = 0.125f;
#ifndef ATT_SGB
#define ATT_SGB 1
#endif
#ifndef ATT_PROBE
#define ATT_PROBE 0
#endif
constexpr float THR = 8.f;
constexpr int SHM_V = KVBLK * 128 * 2, SHM_K = KVBLK * 128 * 2;
constexpr int SHM_ATTN = 2 * SHM_V + 2 * SHM_K + NW * 64 * 4;
#define KSWZ(row, colB) ((row) * 256 + ((colB) ^ (((row) & 7) << 4)))
#define SBAR() __builtin_amdgcn_sched_barrier(0)
#define SGB(mask, n) __builtin_amdgcn_sched_group_barrier((mask), (n), 0)
#define S1_PIPE() do { if (ATT_SGB) { SGB(0x100, 4); _Pragma("unroll") for (int i_ = 0; i_ < 8; ++i_) { SGB(0x008, 1); SGB(0x002, 13); if ((i_ & 1) && i_ < 5) SGB(0x100, 2); } } } while (0)
__device__ __forceinline__ int crow(int r, int hi) { return (r & 3) + 8 * (r >> 2) + 4 * hi; }
typedef float f32x2_a __attribute__((ext_vector_type(2))); typedef __bf16 bf16x2_a __attribute__((ext_vector_type(2)));
__device__ __forceinline__ unsigned cvtpk(float lo, float hi) { const f32x2_a v = {lo, hi}; const bf16x2_a b = __builtin_convertvector(v, bf16x2_a); return __builtin_bit_cast(unsigned, b); }
__device__ __forceinline__ unsigned short f2bf(float f) { return (unsigned short)(cvtpk(f, 0.f) & 0xffffu); }

__device__ __forceinline__ void partialSM(f32x16& p0, f32x16& p1, float& m_reg, float& mn, float& alpha, bool domask, int dq) {
  constexpr float C = SCALE * 1.4426950408889634f;
  if (domask) {
#pragma unroll
    for (int r = 0; r < 16; ++r) { const int d0 = dq + (r & 3) + 8 * (r >> 2), d1 = d0 + 32;
      if (d0 > 128 || d0 < -128) p0[r] = -1e30f; if (d1 > 128 || d1 < -128) p1[r] = -1e30f; }
  }
  float pmax = p0[0];
#pragma unroll
  for (int r = 1; r < 16; ++r) pmax = fmaxf(pmax, p0[r]);
#pragma unroll
  for (int r = 0; r < 16; ++r) pmax = fmaxf(pmax, p1[r]);
  { auto rr = __builtin_amdgcn_permlane32_swap(__float_as_uint(pmax), __float_as_uint(pmax), false, false);
    pmax = fmaxf(__uint_as_float(rr[0]), __uint_as_float(rr[1])); }
  if (__builtin_expect(__all(pmax - m_reg <= THR / SCALE), 1)) { mn = m_reg; alpha = 1.f; }
  else { mn = fmaxf(m_reg, pmax); alpha = __builtin_amdgcn_exp2f((m_reg - mn) * C); m_reg = mn; }
  const float mnC = -mn * C;
#pragma unroll
  for (int r = 0; r < 16; ++r) p0[r] = fmaf(p0[r], C, mnC);
#pragma unroll
  for (int r = 0; r < 16; ++r) p1[r] = fmaf(p1[r], C, mnC);
#pragma unroll
  for (int r = 0; r < 16; ++r) { if (ATT_PROBE == 3) { float x2 = p0[r]; asm volatile("" : "+v"(x2)); p0[r] = 0.5f * (__builtin_amdgcn_exp2f(p0[r]) + __builtin_amdgcn_exp2f(x2)); } else p0[r] = __builtin_amdgcn_exp2f(p0[r]); }
}
__device__ __forceinline__ void finishSM(f32x16& p0, f32x16& p1, float alpha, float& l_reg, bf16x8& pa0, bf16x8& pa1, bf16x8& pa2, bf16x8& pa3, float pscale = 1.0f) {
#pragma unroll
  for (int r = 0; r < 16; ++r) { if (ATT_PROBE == 3) { float x2 = p1[r]; asm volatile("" : "+v"(x2)); p1[r] = 0.5f * (__builtin_amdgcn_exp2f(p1[r]) + __builtin_amdgcn_exp2f(x2)); } else p1[r] = __builtin_amdgcn_exp2f(p1[r]); }
  float ps = 0;
#pragma unroll
  for (int r = 0; r < 16; ++r) ps += p0[r];
#pragma unroll
  for (int r = 0; r < 16; ++r) ps += p1[r];
  { auto rr = __builtin_amdgcn_permlane32_swap(__float_as_uint(ps), __float_as_uint(ps), false, false);
    ps = __uint_as_float(rr[0]) + __uint_as_float(rr[1]); }
  l_reg = l_reg * alpha + ps;
  if (pscale != 1.0f) {
#pragma unroll
    for (int r = 0; r < 16; ++r) { p0[r] *= pscale; p1[r] *= pscale; } }
#define PK4(P, BASE, OUT) do { unsigned a0 = cvtpk(P[BASE + 0], P[BASE + 1]), a1 = cvtpk(P[BASE + 2], P[BASE + 3]);   \
    unsigned b0 = cvtpk(P[BASE + 4], P[BASE + 5]), b1 = cvtpk(P[BASE + 6], P[BASE + 7]);                              \
    auto r0 = __builtin_amdgcn_permlane32_swap(a0, b0, false, false); auto r1 = __builtin_amdgcn_permlane32_swap(a1, b1, false, false); \
    u32x4 w = {r0[0], r1[0], r0[1], r1[1]}; OUT = *reinterpret_cast<bf16x8*>(&w); } while (0)
  PK4(p0, 0, pa0); PK4(p0, 8, pa1); PK4(p1, 0, pa2); PK4(p1, 8, pa3);
#undef PK4
}
__device__ __forceinline__ void qkt(f32x16& p0, f32x16& p1, const char* Ks, const bf16x8* qr, int r32, int hi, int kcolB) {
  p0 = f32x16{}; p1 = f32x16{};
#pragma unroll
  for (int d0 = 0; d0 < 4; ++d0) { const int cb = kcolB + (d0 * 16 + hi * 8) * 2;
    bf16x8 b0 = *reinterpret_cast<const bf16x8*>(Ks + KSWZ(r32, cb));
    bf16x8 b1 = *reinterpret_cast<const bf16x8*>(Ks + KSWZ(32 + r32, cb));
    p0 = __builtin_amdgcn_mfma_f32_32x32x16_bf16(b0, qr[d0], p0, 0, 0, 0);
    p1 = __builtin_amdgcn_mfma_f32_32x32x16_bf16(b1, qr[d0], p1, 0, 0, 0); }
}
__device__ __forceinline__ int v_st(int k, int c) { const int kk = (k & ~0xC) | ((k & 4) << 1) | ((k & 8) >> 1); return ((kk >> 3) * 4 + (c >> 5)) * 512 + ((kk & 7) * 32 + (c & 31)) * 2; }
__device__ __forceinline__ int v_rd_base(int lane) { return ((lane & 3) << 3) | (((lane >> 2) & 3) << 6) | (((lane >> 4) & 1) << 5) | (((lane >> 5) & 1) << 8); }
constexpr int v_rd_off(int d0, int ks, int half) { return d0 * 512 + ks * 4096 + half * 2048; }
template <int OFF> __device__ __forceinline__ s16x4 tr_read(int vb) {
  s16x4 r; asm volatile("ds_read_b64_tr_b16 %0, %1 offset:%2" : "=&v"(r) : "v"(vb), "i"(OFF) : "memory"); return r;
}
template <int D0> __device__ __forceinline__ void pv_one(f32x16& od, int vb, bf16x8 pa0, bf16x8 pa1, bf16x8 pa2, bf16x8 pa3) {
  const s16x4 l0 = tr_read<v_rd_off(D0, 0, 0)>(vb), h0 = tr_read<v_rd_off(D0, 0, 1)>(vb), l1 = tr_read<v_rd_off(D0, 1, 0)>(vb), h1 = tr_read<v_rd_off(D0, 1, 1)>(vb);
  const s16x4 l2 = tr_read<v_rd_off(D0, 2, 0)>(vb), h2 = tr_read<v_rd_off(D0, 2, 1)>(vb), l3 = tr_read<v_rd_off(D0, 3, 0)>(vb), h3 = tr_read<v_rd_off(D0, 3, 1)>(vb);
  asm volatile("s_waitcnt lgkmcnt(0)" ::: "memory"); SBAR();
#define PK(L, H) (bf16x8){L[0], L[1], L[2], L[3], H[0], H[1], H[2], H[3]}
  od = __builtin_amdgcn_mfma_f32_32x32x16_bf16(pa0, PK(l0, h0), od, 0, 0, 0);
  od = __builtin_amdgcn_mfma_f32_32x32x16_bf16(pa1, PK(l1, h1), od, 0, 0, 0);
  od = __builtin_amdgcn_mfma_f32_32x32x16_bf16(pa2, PK(l2, h2), od, 0, 0, 0);
  od = __builtin_amdgcn_mfma_f32_32x32x16_bf16(pa3, PK(l3, h3), od, 0, 0, 0);
#undef PK
}
template <bool DIFF> __device__ __forceinline__ void pv_all(f32x16* o, int vb, bf16x8 pa0, bf16x8 pa1, bf16x8 pa2, bf16x8 pa3) {
  pv_one<0>(o[0], vb, pa0, pa1, pa2, pa3); pv_one<1>(o[1], vb, pa0, pa1, pa2, pa3);
  if constexpr (DIFF) { pv_one<2>(o[2], vb, pa0, pa1, pa2, pa3); pv_one<3>(o[3], vb, pa0, pa1, pa2, pa3); }
}

struct UnitArgs {
  const GAS bf16_t* Q;
  int qg1;
  const GAS bf16_t* K;
  const GAS bf16_t* V;
  int ldk;
  int s1, n1, s2, n2;
  int qpos0;
  float sink0, sink1;
  int use_sink;
  GAS bf16_t* O;
  int og1;
  float lam, post;
  const GAS float* subg;
};

template <bool DIFF, bool MASK>
__device__ __forceinline__ void attn_unit(const UnitArgs& A, char* lds, const int wave0) {
  constexpr int NO = DIFF ? 4 : 2;
  const int lane = lane_now(), tid = wave0 * 64 + lane, wid = wave0, r32 = lane & 31, hi = lane >> 5;
  const int mg = wid >> 2, wq = wid & 3;
  char* V_lds = lds; char* K_lds = lds + 2 * SHM_V;
  float* ws = (float*)(lds + 2 * SHM_V + 2 * SHM_K) + wid * 64; float* li_l = ws; float* al_l = ws + 32;
  float m_reg = -1e30f, l_reg = 0.f;
  if (!DIFF && A.use_sink) { m_reg = (mg ? A.sink1 : A.sink0) * (1.0f / SCALE); l_reg = 1.f; }
  f32x16 o[NO];
#pragma unroll
  for (int d = 0; d < NO; ++d) o[d] = f32x16{};
  bf16x8 qr[4];
  const GAS bf16_t* Qw = A.Q + (mg ? A.qg1 : 0) + (long)(wq * QBLK + r32) * 512 + hi * 8;
#pragma unroll
  for (int d0 = 0; d0 < 4; ++d0) qr[d0] = *(const GAS bf16x8*)(Qw + d0 * 16);
  const int sr = tid >> 4, sc = (tid & 15) * 8, vst0 = v_st(sr, sc), vst1 = v_st(32 + sr, sc);
  const int vb0 = (int)(uintptr_t)V_lds + v_rd_base(lane) + ((!DIFF && mg) ? 1024 : 0);
  const int kcolB = mg * 128;
  const int ldk = A.ldk;
  const GAS bf16_t* Kh = A.K; const GAS bf16_t* Vh = A.V;
  const int NT = A.n1 + A.n2;
  const int qposl = A.qpos0 + wq * QBLK + r32;
  constexpr bool maskunit = MASK;
#define KST(j) ((j) < A.n1 ? A.s1 + (j) * KVBLK : A.s2 + ((j) - A.n1) * KVBLK)
  struct { bf16x8 vs0, vs1, ks0, ks1; } sr_[2];
#define SLOAD(i, k0) do { const long k0_ = (k0); sr_[i].vs0 = *(const GAS bf16x8*)(&Vh[(k0_ + sr) * ldk + sc]); sr_[i].vs1 = *(const GAS bf16x8*)(&Vh[(k0_ + 32 + sr) * ldk + sc]); \
    sr_[i].ks0 = *(const GAS bf16x8*)(&Kh[(k0_ + sr) * ldk + sc]); sr_[i].ks1 = *(const GAS bf16x8*)(&Kh[(k0_ + 32 + sr) * ldk + sc]); } while (0)
#define SWRITE(b, i) do { *(bf16x8*)(V_lds + (b) * SHM_V + vst0) = sr_[i].vs0;          \
    *(bf16x8*)(V_lds + (b) * SHM_V + vst1) = sr_[i].vs1; const int kc = sc * 2;               \
    *(bf16x8*)(K_lds + (b) * SHM_K + KSWZ(sr, kc)) = sr_[i].ks0;                       \
    *(bf16x8*)(K_lds + (b) * SHM_K + KSWZ(32 + sr, kc)) = sr_[i].ks1; } while (0)
#define SWAIT() asm volatile("s_waitcnt vmcnt(4)" ::: "memory")
#define RESC(a) do { if (__any((a) < 1.f)) { if (hi == 0) al_l[r32] = (a); asm volatile("s_waitcnt lgkmcnt(0)" ::: "memory"); \
    _Pragma("unroll") for (int d = 0; d < NO; ++d) _Pragma("unroll") for (int r = 0; r < 16; ++r) o[d][r] *= al_l[crow(r, hi)]; } } while (0)
#define MASKARGS(j) (maskunit && (j) >= A.n1), (KST(j) - qposl + 4 * hi)
  f32x16 pA0, pA1, pB0, pB1; float mnA, mnB, alA, alB; bf16x8 pa0, pa1, pa2, pa3;
  constexpr int SE = 0, SO = 1;
  __syncthreads();
  SLOAD(SE, KST(0)); asm volatile("s_waitcnt vmcnt(0)" ::: "memory"); SWRITE(0, SE); __syncthreads();
  qkt(pA0, pA1, K_lds, qr, r32, hi, kcolB); partialSM(pA0, pA1, m_reg, mnA, alA, MASKARGS(0));
  SLOAD(SO, KST(1)); if (2 < NT) SLOAD(SE, KST(2));
  SWAIT(); SWRITE(1, SO); __syncthreads();
  for (int j = 1; j + 1 < NT; j += 2) {
    SBAR(); qkt(pB0, pB1, K_lds + SHM_K, qr, r32, hi, kcolB);
    if (ATT_PROBE == 1) { asm volatile("" : "+v"(pB0), "+v"(pB1)); qkt(pB0, pB1, K_lds + SHM_K, qr, r32, hi, kcolB); }
    finishSM(pA0, pA1, alA, l_reg, pa0, pa1, pa2, pa3, ATT_PROBE == 2 ? 0.5f : 1.0f); S1_PIPE(); SBAR();
    SLOAD(SO, KST(j + 2)); SBAR();
    if (ATT_PROBE == 2) pv_all<DIFF>(o, vb0, pa0, pa1, pa2, pa3);
    pv_all<DIFF>(o, vb0, pa0, pa1, pa2, pa3); partialSM(pB0, pB1, m_reg, mnB, alB, MASKARGS(j));
    __syncthreads(); SWAIT(); SWRITE(0, SE); if (ATT_PROBE == 4) { asm volatile("" ::: "memory"); SWRITE(0, SE); }
    RESC(alB); __syncthreads();
    SBAR(); qkt(pA0, pA1, K_lds, qr, r32, hi, kcolB);
    if (ATT_PROBE == 1) { asm volatile("" : "+v"(pA0), "+v"(pA1)); qkt(pA0, pA1, K_lds, qr, r32, hi, kcolB); }
    finishSM(pB0, pB1, alB, l_reg, pa0, pa1, pa2, pa3, ATT_PROBE == 2 ? 0.5f : 1.0f); S1_PIPE(); SBAR();
    if (j + 3 < NT) SLOAD(SE, KST(j + 3)); SBAR();
    if (ATT_PROBE == 2) pv_all<DIFF>(o, vb0 + SHM_V, pa0, pa1, pa2, pa3);
    pv_all<DIFF>(o, vb0 + SHM_V, pa0, pa1, pa2, pa3); partialSM(pA0, pA1, m_reg, mnA, alA, MASKARGS(j + 1));
    __syncthreads(); SWAIT(); SWRITE(1, SO); if (ATT_PROBE == 4) { asm volatile("" ::: "memory"); SWRITE(1, SO); }
    RESC(alA); __syncthreads();
  }
  SBAR(); qkt(pB0, pB1, K_lds + SHM_K, qr, r32, hi, kcolB);
  finishSM(pA0, pA1, alA, l_reg, pa0, pa1, pa2, pa3); SBAR();
  pv_all<DIFF>(o, vb0, pa0, pa1, pa2, pa3); partialSM(pB0, pB1, m_reg, mnB, alB, MASKARGS(NT - 1));
  __syncthreads(); RESC(alB);
  finishSM(pB0, pB1, alB, l_reg, pa0, pa1, pa2, pa3); SBAR();
  pv_all<DIFF>(o, vb0 + SHM_V, pa0, pa1, pa2, pa3);
  if (hi == 0) li_l[r32] = l_reg; asm volatile("s_waitcnt lgkmcnt(0)" ::: "memory");
  float rli[16];
#pragma unroll
  for (int r = 0; r < 16; ++r) rli[r] = __builtin_amdgcn_rcpf(li_l[crow(r, hi)]);
  if constexpr (!DIFF) {
    GAS bf16_t* Ow = A.O + (mg ? A.og1 : 0) + (long)(wq * QBLK) * 512;
#pragma unroll
    for (int r = 0; r < 16; ++r) { const int orow = crow(r, hi);
#pragma unroll
      for (int d0 = 0; d0 < 2; ++d0) Ow[(long)orow * 512 + d0 * 32 + r32] = f2bf(o[d0][r] * rli[r]); }
  } else {
    float* ex = (float*)lds;
    __syncthreads();
    if (mg == 1) {
#pragma unroll
      for (int d0 = 0; d0 < 4; ++d0)
#pragma unroll
        for (int r = 0; r < 16; ++r) ex[(wq * 64 + d0 * 16 + r) * 64 + lane] = o[d0][r] * rli[r];
    }
    __syncthreads();
    if (mg == 0) {
      GAS bf16_t* Ow = A.O + (long)(wq * QBLK) * 512;
      float gsub[4];
#pragma unroll
      for (int d0 = 0; d0 < 4; ++d0) gsub[d0] = A.subg[d0 * 32 + r32] * A.post;
#pragma unroll
      for (int r = 0; r < 16; ++r) {
        float v[4]; float ss = 0.f;
#pragma unroll
        for (int d0 = 0; d0 < 4; ++d0) { v[d0] = o[d0][r] * rli[r] - A.lam * ex[(wq * 64 + d0 * 16 + r) * 64 + lane]; ss += v[d0] * v[d0]; }
        ss += __shfl_xor(ss, 1); ss += __shfl_xor(ss, 2); ss += __shfl_xor(ss, 4); ss += __shfl_xor(ss, 8); ss += __shfl_xor(ss, 16);
        const float rn = __builtin_amdgcn_rsqf(ss * (1.0f / 128.0f) + 1e-6f);
        const int orow = crow(r, hi);
#pragma unroll
        for (int d0 = 0; d0 < 4; ++d0) Ow[(long)orow * 512 + d0 * 32 + r32] = f2bf(v[d0] * rn * gsub[d0]);
      }
    }
  }
#undef KST
#undef SLOAD
#undef SWRITE
#undef SWAIT
#undef RESC
#undef MASKARGS
}
#undef KSWZ
}
#include <hip/hip_bf16.h>
namespace att64 {
using bf16=__hip_bfloat16;
using bf16x8=__attribute__((ext_vector_type(8)))short;
using s16x4=__attribute__((ext_vector_type(4)))short;
using f32x16=__attribute__((ext_vector_type(16)))float;
using u32x4=__attribute__((ext_vector_type(4)))unsigned;
constexpr int D=64;
constexpr int NW=8,QBLK=32,QB=QBLK*NW,KVBLK=64;
__device__ __forceinline__ int crow(int r,int hi){return (r&3)+8*(r>>2)+4*hi;}
#define SBAR() __builtin_amdgcn_sched_barrier(0)
__device__ __forceinline__ void bmask(f32x16&p0,f32x16&p1,int dq){
  const float NEG=-INFINITY;
  #pragma unroll
  for(int r=0;r<16;++r){const int d0=dq+(r&3)+8*(r>>2),d1=d0+32; if(d0>128||d0<-128)p0[r]=NEG; if(d1>128||d1<-128)p1[r]=NEG;}
}
constexpr int NSLOT=3, SLOTB=8192;
constexpr int LDS_K=0, LDS_V=NSLOT*SLOTB, LDS_WS=2*NSLOT*SLOTB, LDS_OST=LDS_WS+NW*64*4, LDS_BYTES=LDS_OST+NW*4096;
constexpr float C2=0.125f*1.4426950408889634f;
__device__ __forceinline__ void glds16(const void*gsrc,unsigned lds_dst){unsigned keep;
  asm volatile("s_mov_b32 %0, m0\n\ts_mov_b32 m0, %2\n\ts_nop 0\n\tglobal_load_lds_dwordx4 %1, off\n\ts_mov_b32 m0, %0":"=&s"(keep):"v"(gsrc),"s"(lds_dst):"memory");}
__device__ __forceinline__ float max3f(float a,float b,float c){float r;asm("v_max3_f32 %0, %1, %2, %3":"=v"(r):"v"(a),"v"(b),"v"(c));return r;}
__device__ __forceinline__ float max2f(float a,float b){float r;asm("v_max_f32_e32 %0, %1, %2":"=v"(r):"v"(a),"v"(b));return r;}
__device__ __forceinline__ float fadd_s(float a,float b){float r;asm("v_add_f32_e32 %0, %1, %2":"=v"(r):"v"(a),"v"(b));return r;}
__device__ __forceinline__ float fsub_s(float a,float b){float r;asm("v_sub_f32_e32 %0, %1, %2":"=v"(r):"v"(a),"v"(b));return r;}
typedef float f32x2_t __attribute__((ext_vector_type(2))); typedef __bf16 bf16x2_t __attribute__((ext_vector_type(2)));
__device__ __forceinline__ unsigned cvtpk_s(float lo,float hi){f32x2_t v={lo,hi};bf16x2_t b=__builtin_convertvector(v,bf16x2_t);return __builtin_bit_cast(unsigned,b);}
#define WAIT_BAR(N) asm volatile("s_waitcnt vmcnt(" #N ") lgkmcnt(0)\n\ts_barrier":::"memory")

__device__ __forceinline__ void qkt(f32x16&p0,f32x16&p1,const char*Kslot,const bf16x8*qr,const f32x16&negm,int r32,int hi){
  const char*kb=Kslot+hi*1024+r32*16;
  #pragma unroll
  for(int d0=0;d0<4;++d0){
    const bf16x8 b0=*reinterpret_cast<const bf16x8*>(kb+d0*2048);
    const bf16x8 b1=*reinterpret_cast<const bf16x8*>(kb+d0*2048+512);
    if(d0==0){p0=__builtin_amdgcn_mfma_f32_32x32x16_bf16(b0,qr[0],negm,0,0,0);p1=__builtin_amdgcn_mfma_f32_32x32x16_bf16(b1,qr[0],negm,0,0,0);}
    else{p0=__builtin_amdgcn_mfma_f32_32x32x16_bf16(b0,qr[d0],p0,0,0,0);p1=__builtin_amdgcn_mfma_f32_32x32x16_bf16(b1,qr[d0],p1,0,0,0);}}
}
typedef __attribute__((address_space(3))) const char* lds_cptr;
typedef short v4i16_t __attribute__((ext_vector_type(4)));
__device__ __forceinline__ void kload8(bf16x8*kf,lds_cptr kp){
  kf[0]=*(const __attribute__((address_space(3))) bf16x8*)(kp);      kf[1]=*(const __attribute__((address_space(3))) bf16x8*)(kp+512);
  kf[2]=*(const __attribute__((address_space(3))) bf16x8*)(kp+2048); kf[3]=*(const __attribute__((address_space(3))) bf16x8*)(kp+2560);
  kf[4]=*(const __attribute__((address_space(3))) bf16x8*)(kp+4096); kf[5]=*(const __attribute__((address_space(3))) bf16x8*)(kp+4608);
  kf[6]=*(const __attribute__((address_space(3))) bf16x8*)(kp+6144); kf[7]=*(const __attribute__((address_space(3))) bf16x8*)(kp+6656);
}
__device__ __forceinline__ void kload2(bf16x8*kf,lds_cptr kp,int j){ kf[2*j]=*(const __attribute__((address_space(3))) bf16x8*)(kp+j*2048); kf[2*j+1]=*(const __attribute__((address_space(3))) bf16x8*)(kp+j*2048+512); }
__device__ __forceinline__ s16x4 vtr(lds_cptr p){ return __builtin_bit_cast(s16x4,__builtin_amdgcn_ds_read_tr16_b64_v4i16((__attribute__((address_space(3))) v4i16_t*)p)); }
__device__ __forceinline__ float rowmax(const f32x16&p0,const f32x16&p1){
  float a=max3f(p0[0],p0[1],p1[0]),b=max3f(p0[2],p0[3],p1[1]);a=max3f(a,p1[2],p1[3]);
  #pragma unroll
  for(int r=4;r<16;r+=4){a=max3f(a,p0[r],p0[r+1]);b=max3f(b,p0[r+2],p0[r+3]);a=max3f(a,p1[r],p1[r+1]);b=max3f(b,p1[r+2],p1[r+3]);}
  const float m=max2f(a,b);
  auto rr=__builtin_amdgcn_permlane32_swap(__float_as_uint(m),__float_as_uint(m),false,false);
  return max2f(__uint_as_float(rr[0]),__uint_as_float(rr[1]));
}
__device__ __forceinline__ void pv(f32x16*o,int vb,bf16x8 pa0,bf16x8 pa1,bf16x8 pa2,bf16x8 pa3){
  #pragma unroll
  for(int d0=0;d0<2;++d0){s16x4 lo[4],hi[4];
    #pragma unroll
    for(int ks=0;ks<4;++ks){
      asm volatile("ds_read_b64_tr_b16 %0,%1 offset:%c2":"=&v"(lo[ks]):"v"(vb),"i"(d0*4096+ks*1024):"memory");
      asm volatile("ds_read_b64_tr_b16 %0,%1 offset:%c2":"=&v"(hi[ks]):"v"(vb),"i"(d0*4096+ks*1024+512):"memory");}
    asm volatile("s_waitcnt lgkmcnt(0)":::"memory");SBAR();
    #define PK(k) (bf16x8){lo[k][0],lo[k][1],lo[k][2],lo[k][3],hi[k][0],hi[k][1],hi[k][2],hi[k][3]}
    o[d0]=__builtin_amdgcn_mfma_f32_32x32x16_bf16(pa0,PK(0),o[d0],0,0,0);
    o[d0]=__builtin_amdgcn_mfma_f32_32x32x16_bf16(pa1,PK(1),o[d0],0,0,0);
    o[d0]=__builtin_amdgcn_mfma_f32_32x32x16_bf16(pa2,PK(2),o[d0],0,0,0);
    o[d0]=__builtin_amdgcn_mfma_f32_32x32x16_bf16(pa3,PK(3),o[d0],0,0,0);
    #undef PK
  }
}

#ifndef ATTN_STORE16
#define ATTN_STORE16(p,v) (*(u32x4*)(p)=(v))
#endif
template<int THRL,bool MASK,bool PAIR> __device__ __forceinline__ void attn_unit(const bf16*Qu,int qp,const bf16*__restrict__ Kh,const bf16*__restrict__ Vh,int kvp,int NT,int n1,int s2,int kpos2,int qpos0,int use_sink,float sink_l2,float sink_l2b,bf16*Ou,int op,char*shm,const int wave0){
  const int lane=lane_now(),tid=wave0*64+lane,r32=lane&31,hi=lane>>5; const int wid=wave0;
  const int wrow=PAIR?(wid&3):wid, whead=PAIR?(wid>>2):0;
  const bf16*Qw=Qu+(long)(wrow*QBLK)*qp+whead*D;
  const unsigned lds0=(unsigned)(uintptr_t)shm;
  float*wsf=(float*)(shm+LDS_WS)+wid*64;
  const bf16*ksrc=Kh+(long)lane*kvp+wid*8;
  const bf16*vsrc=Vh+(long)(16*(wid&3)+(lane>>2))*kvp+(wid>>2)*32+(lane&3)*8;
  const unsigned kdst=lds0+LDS_K+wid*1024, vdst=lds0+LDS_V+wid*1024;
  #define KROW(t) ((t)<n1?(t)*KVBLK:s2+((t)-n1)*KVBLK)
  #define DMA_K(t,slot) glds16(ksrc+(long)KROW(t)*kvp,(unsigned)__builtin_amdgcn_readfirstlane(kdst+(slot)))
  #define DMA_V(t,slot) glds16(vsrc+(long)KROW(t)*kvp,(unsigned)__builtin_amdgcn_readfirstlane(vdst+(slot)))
  const int vb0=(int)(lds0+LDS_V)+((lane>>4)&1)*32+(lane&3)*8+(4*hi+((lane&15)>>2))*64;
  const char*Kbase=shm+LDS_K; bf16x8 kf[8];
  const lds_cptr shm3=(lds_cptr)shm; const lds_cptr kp0=shm3+LDS_K+hi*1024+r32*16; const lds_cptr vp0=shm3+LDS_V+((lane>>4)&1)*32+(lane&3)*8+(4*hi+((lane&15)>>2))*64;
  DMA_K(0,0);DMA_V(0,0);DMA_K(1,SLOTB);
  bf16x8 qr[4];
  #pragma unroll
  for(int d0=0;d0<4;++d0)qr[d0]=*reinterpret_cast<const bf16x8*>(&Qw[(long)r32*qp+d0*16+hi*8]);
  float mhat=0.f,l_reg=0.f;f32x16 o[2];o[0]=f32x16{};o[1]=f32x16{};f32x16 negm=f32x16{};asm volatile("":"+v"(negm));
  const int dqb=kpos2-(qpos0+wrow*QBLK+r32)+4*hi;
  #define CMASK(P0,P1,t) do{ if(MASK&&(t)>=n1) bmask(P0,P1,dqb+((t)-n1)*KVBLK); }while(0)
  bool resc=false;
  #define START(P0,P1) do{ const float rm=rowmax(P0,P1); resc=false; \
    { const float dl=rm; mhat=fadd_s(mhat,dl); \
      _Pragma("unroll") for(int r=0;r<16;++r){P0[r]=fsub_s(P0[r],dl);P1[r]=fsub_s(P1[r],dl);} \
      _Pragma("unroll") for(int r=0;r<16;++r)negm[r]=-mhat; asm volatile("":"+v"(negm)); } \
    _Pragma("unroll") for(int r=0;r<16;++r)P0[r]=__builtin_amdgcn_exp2f(P0[r]); }while(0)
  #define RESC() do{ if(resc){ asm volatile("s_waitcnt lgkmcnt(0)":::"memory"); \
      _Pragma("unroll") for(int d_=0;d_<2;++d_) _Pragma("unroll") for(int r=0;r<16;++r)o[d_][r]*=wsf[crow(r,hi)]; } }while(0)
  f32x16 pA0,pA1,pB0,pB1;
  int sl_prev=0,sl_cur=0,sl_next=SLOTB;
  #define ROT() do{sl_prev=sl_cur;sl_cur=sl_next;sl_next=(sl_next==(NSLOT-1)*SLOTB)?0:sl_next+SLOTB;}while(0)
  DMA_K(2,2*SLOTB);
  WAIT_BAR(3);
  qkt(pA0,pA1,Kbase,qr,f32x16{},r32,hi);asm volatile("s_nop 15\n\ts_nop 7":"+v"(pA0),"+v"(pA1));CMASK(pA0,pA1,0);
  START(pA0,pA1);
  _Pragma("unroll") for(int r=0;r<16;++r)pA1[r]=__builtin_amdgcn_exp2f(pA1[r]);
  WAIT_BAR(0);
  DMA_K(3,0);DMA_V(1,SLOTB);
  ROT();
  kload8(kf,kp0+sl_cur);
  WAIT_BAR(2);
  s16x4 vlo[8],vhi[8]; u32x4 pw0,pw1,pw2,pw3;
  #define PKW(P,B) cvtpk_s(P[B],P[B+1])
  #define PAF(k) __builtin_bit_cast(bf16x8,pw##k)
  #define VFR(i) (bf16x8){vlo[i][0],vlo[i][1],vlo[i][2],vlo[i][3],vhi[i][0],vhi[i][1],vhi[i][2],vhi[i][3]}
  #define PIN(x) asm volatile("":"+v"(x))
  #define MX3(a,b,c) __builtin_fmaxf(__builtin_fmaxf((a),(b)),(c))
  #define GAPA(MF,A0,A1,A2,A3,W0,W1,PW) do{ MF; sacc+=A0; sacc+=A1; sacc+=A2; sacc+=A3; PIN(sacc); W0; W1; PIN(PW); SBAR(); }while(0)
  #define EX(v) __builtin_amdgcn_exp2f(v)
  #define GAPB(MF,X,B) do{ MF; X[B]=EX(X[B]); X[B+1]=EX(X[B+1]); X[B+2]=EX(X[B+2]); X[B+3]=EX(X[B+3]); PIN(X); SBAR(); }while(0)
  #define VRD(i) do{ vlo[i]=vtr(vp_+(((i)>>2)*4096+((i)&3)*1024)); vhi[i]=vtr(vp_+(((i)>>2)*4096+((i)&3)*1024+512)); }while(0)
  #define KRD(G,j) do{ if(G){ kload2(kf,kp0+sl_next,j); SBAR(); } }while(0)
  #define STEP(C0,C1,P0,P1,t,GK,GV,GL) do{ SBAR(); \
    const lds_cptr vp_=vp0+sl_prev; \
    VRD(0); SBAR(); float sacc=(P0[0]+P0[1]); \
    GAPA(C0=__builtin_amdgcn_mfma_f32_32x32x16_bf16(kf[0],qr[0],negm,0,0,0), P0[2],P0[3],P0[4],P0[5],     pw0[0]=PKW(P0,0), pw0[1]=PKW(P0,2), pw0); \
    VRD(4); SBAR(); GAPA(C1=__builtin_amdgcn_mfma_f32_32x32x16_bf16(kf[1],qr[0],negm,0,0,0), P0[6],P0[7],P0[8],P0[9],     pw0[2]=PKW(P0,4), pw0[3]=PKW(P0,6), pw0); \
    VRD(1); SBAR(); GAPA(C0=__builtin_amdgcn_mfma_f32_32x32x16_bf16(kf[2],qr[1],C0,0,0,0),   P0[10],P0[11],P0[12],P0[13], pw1[0]=PKW(P0,8), pw1[1]=PKW(P0,10), pw1); \
    VRD(5); SBAR(); GAPA(C1=__builtin_amdgcn_mfma_f32_32x32x16_bf16(kf[3],qr[1],C1,0,0,0),   P0[14],P0[15],P1[0],P1[1],   pw1[2]=PKW(P0,12),pw1[3]=PKW(P0,14), pw1); \
    VRD(2); SBAR(); GAPA(C0=__builtin_amdgcn_mfma_f32_32x32x16_bf16(kf[4],qr[2],C0,0,0,0),   P1[2],P1[3],P1[4],P1[5],     pw2[0]=PKW(P1,0), pw2[1]=PKW(P1,2), pw2); \
    VRD(6); SBAR(); GAPA(C1=__builtin_amdgcn_mfma_f32_32x32x16_bf16(kf[5],qr[2],C1,0,0,0),   P1[6],P1[7],P1[8],P1[9],     pw2[2]=PKW(P1,4), pw2[3]=PKW(P1,6), pw2); \
    VRD(3); SBAR(); GAPA(C0=__builtin_amdgcn_mfma_f32_32x32x16_bf16(kf[6],qr[3],C0,0,0,0),   P1[10],P1[11],P1[12],P1[13], pw3[0]=PKW(P1,8), pw3[1]=PKW(P1,10), pw3); \
    VRD(7); SBAR(); GAPA(C1=__builtin_amdgcn_mfma_f32_32x32x16_bf16(kf[7],qr[3],C1,0,0,0),   P1[14],P1[15],0.f,0.f,       pw3[2]=PKW(P1,12),pw3[3]=PKW(P1,14), pw3); \
    l_reg+=sacc; \
    if(GK){DMA_K((t)+3,sl_cur);} if(GV){DMA_V((t)+1,sl_next);} \
    CMASK(C0,C1,t); \
    { float a=MX3(C0[0],C0[1],C1[0]),b=MX3(C0[2],C0[3],C1[1]); a=MX3(a,C1[2],C1[3]); \
      _Pragma("unroll") for(int r=4;r<16;r+=4){a=MX3(a,C0[r],C0[r+1]);b=MX3(b,C0[r+2],C0[r+3]);a=MX3(a,C1[r],C1[r+1]);b=MX3(b,C1[r+2],C1[r+3]);} \
      float rm=__builtin_fmaxf(a,b); { auto rr=__builtin_amdgcn_permlane32_swap(__float_as_uint(rm),__float_as_uint(rm),false,false); rm=__builtin_fmaxf(__uint_as_float(rr[0]),__uint_as_float(rr[1])); } \
      resc=false;                                              \
      if(__builtin_expect(__any(rm>(float)THRL),0)){ const float dl=__builtin_fmaxf(rm,0.f); mhat+=dl; \
        _Pragma("unroll") for(int r=0;r<16;++r){C0[r]-=dl;C1[r]-=dl;} \
        _Pragma("unroll") for(int r=0;r<16;++r)negm[r]=-mhat; asm volatile("":"+v"(negm)); \
        const float f=__builtin_amdgcn_exp2f(-dl); l_reg*=f; if(hi==0)wsf[r32]=f; resc=true; } } \
    SBAR(); \
    GAPB(o[0]=__builtin_amdgcn_mfma_f32_32x32x16_bf16(PAF(0),VFR(0),o[0],0,0,0), C0,0); \
    GAPB(o[1]=__builtin_amdgcn_mfma_f32_32x32x16_bf16(PAF(0),VFR(4),o[1],0,0,0), C0,4); \
    KRD(GL,0); GAPB(o[0]=__builtin_amdgcn_mfma_f32_32x32x16_bf16(PAF(1),VFR(1),o[0],0,0,0), C0,8); \
    KRD(GL,1); GAPB(o[1]=__builtin_amdgcn_mfma_f32_32x32x16_bf16(PAF(1),VFR(5),o[1],0,0,0), C0,12); \
    KRD(GL,2); GAPB(o[0]=__builtin_amdgcn_mfma_f32_32x32x16_bf16(PAF(2),VFR(2),o[0],0,0,0), C1,0); \
    KRD(GL,3); GAPB(o[1]=__builtin_amdgcn_mfma_f32_32x32x16_bf16(PAF(2),VFR(6),o[1],0,0,0), C1,4); \
    GAPB(o[0]=__builtin_amdgcn_mfma_f32_32x32x16_bf16(PAF(3),VFR(3),o[0],0,0,0), C1,8); \
    GAPB(o[1]=__builtin_amdgcn_mfma_f32_32x32x16_bf16(PAF(3),VFR(7),o[1],0,0,0), C1,12); \
    }while(0)
  int t=1;
  for(;t+5<NT;t+=2){
    STEP(pB0,pB1,pA0,pA1,t,true,true,true);     WAIT_BAR(2); RESC(); ROT();
    STEP(pA0,pA1,pB0,pB1,t+1,true,true,true);   WAIT_BAR(2); RESC(); ROT();
  }
  #define ENDW(tt) do{ if((tt)+3<NT){WAIT_BAR(2);} else if((tt)+2<NT){WAIT_BAR(1);} else {WAIT_BAR(0);} }while(0)
  for(;t+1<NT;t+=2){
    STEP(pB0,pB1,pA0,pA1,t,(t+3<NT),(t+1<NT),(t+1<NT));       ENDW(t);   RESC(); ROT();
    STEP(pA0,pA1,pB0,pB1,t+1,(t+4<NT),(t+2<NT),(t+2<NT));     ENDW(t+1); RESC(); ROT();
  }
  STEP(pB0,pB1,pA0,pA1,NT-1,false,false,false); RESC();
  { float sacc=pB0[0]+pB0[1]; _Pragma("unroll") for(int r=2;r<16;++r)sacc+=pB0[r]; _Pragma("unroll") for(int r=0;r<16;++r)sacc+=pB1[r]; l_reg+=sacc;
    pw0=(u32x4){PKW(pB0,0),PKW(pB0,2),PKW(pB0,4),PKW(pB0,6)};pw1=(u32x4){PKW(pB0,8),PKW(pB0,10),PKW(pB0,12),PKW(pB0,14)};pw2=(u32x4){PKW(pB1,0),PKW(pB1,2),PKW(pB1,4),PKW(pB1,6)};pw3=(u32x4){PKW(pB1,8),PKW(pB1,10),PKW(pB1,12),PKW(pB1,14)};
    SBAR(); pv(o,vb0+sl_cur,PAF(0),PAF(1),PAF(2),PAF(3)); }
  #undef PKW
  #undef PAF
  #undef VFR
  #undef PIN
  #undef MX3
  #undef GAPA
  #undef GAPB
  #undef EX
  #undef VRD
  #undef KRD
  #undef STEP
  #undef ENDW
  {auto rr=__builtin_amdgcn_permlane32_swap(__float_as_uint(l_reg),__float_as_uint(l_reg),false,false);l_reg=__uint_as_float(rr[0])+__uint_as_float(rr[1]);}
  if(use_sink) l_reg+=__builtin_amdgcn_exp2f(fminf((whead?sink_l2b:sink_l2)-mhat,120.f));
  if(hi==0)wsf[32+r32]=l_reg;asm volatile("s_waitcnt lgkmcnt(0)":::"memory");
  float rli[16];
  #pragma unroll
  for(int r=0;r<16;++r)rli[r]=__builtin_amdgcn_rcpf(wsf[32+crow(r,hi)]);
  bf16*Ow=Ou+(long)(wrow*QBLK)*op+whead*D;
  { bf16*stg=(bf16*)(shm+LDS_OST)+wid*2048;
    #pragma unroll
    for(int r=0;r<16;++r){const int orow=crow(r,hi);
      #pragma unroll
      for(int d0=0;d0<2;++d0)stg[orow*64+d0*32+r32]=__float2bfloat16(o[d0][r]*rli[r]);}
    asm volatile("s_waitcnt lgkmcnt(0)":::"memory");
    #pragma unroll
    for(int i=0;i<4;++i){const int row=i*8+(lane>>3),ch=lane&7; const u32x4 v=*(const u32x4*)(stg+row*64+ch*8); ATTN_STORE16(Ow+(long)row*op+ch*8,v);} }
  asm volatile("s_waitcnt lgkmcnt(0)\n\ts_barrier":::"memory");
  #undef KROW
  #undef DMA_K
  #undef DMA_V
  #undef CMASK
  #undef START
  #undef RESC
  #undef ROT
}
#undef SBAR
#undef WAIT_BAR
}
namespace att128 {
using att64::bf16; using att64::bf16x8; using att64::s16x4; using att64::f32x16; using att64::u32x4; using att64::lds_cptr;
using att64::crow; using att64::glds16; using att64::cvtpk_s; using att64::kload8; using att64::kload2; using att64::vtr; using att64::rowmax; using att64::qkt; using att64::fadd_s; using att64::fsub_s;
typedef float f32x4v __attribute__((ext_vector_type(4)));
constexpr int D=64,NW=8,QBLK=32,KVBLK=64;
constexpr int NSLOT=3, SLOTB=8192;
constexpr int LDS_K=0, LDS_V=NSLOT*SLOTB, LDS_WS=LDS_V+2*NSLOT*SLOTB, LDS_O1=LDS_WS+NW*64*4, LDS_BYTES=LDS_O1+NW*8192;
#define SBAR() __builtin_amdgcn_sched_barrier(0)
#define WAIT_BAR(N) asm volatile("s_waitcnt vmcnt(" #N ") lgkmcnt(0)\n\ts_barrier":::"memory")
__device__ __forceinline__ void pv4(f32x16*o,int vb,bf16x8 pa0,bf16x8 pa1,bf16x8 pa2,bf16x8 pa3){
  #pragma unroll
  for(int d0=0;d0<4;++d0){s16x4 lo[4],hi[4];
    #pragma unroll
    for(int ks=0;ks<4;++ks){
      asm volatile("ds_read_b64_tr_b16 %0,%1 offset:%c2":"=&v"(lo[ks]):"v"(vb),"i"(d0*4096+ks*1024):"memory");
      asm volatile("ds_read_b64_tr_b16 %0,%1 offset:%c2":"=&v"(hi[ks]):"v"(vb),"i"(d0*4096+ks*1024+512):"memory");}
    asm volatile("s_waitcnt lgkmcnt(0)":::"memory");SBAR();
    #define PK(k) (bf16x8){lo[k][0],lo[k][1],lo[k][2],lo[k][3],hi[k][0],hi[k][1],hi[k][2],hi[k][3]}
    o[d0]=__builtin_amdgcn_mfma_f32_32x32x16_bf16(pa0,PK(0),o[d0],0,0,0);
    o[d0]=__builtin_amdgcn_mfma_f32_32x32x16_bf16(pa1,PK(1),o[d0],0,0,0);
    o[d0]=__builtin_amdgcn_mfma_f32_32x32x16_bf16(pa2,PK(2),o[d0],0,0,0);
    o[d0]=__builtin_amdgcn_mfma_f32_32x32x16_bf16(pa3,PK(3),o[d0],0,0,0);
    #undef PK
  }
}
template<int THRL> __device__ __forceinline__ void attn_unit(const bf16*Qu,int qp,const bf16*__restrict__ Kh,const bf16*__restrict__ Vh,int kvp,int NT,int second,float lam,const GAS float*subg,float post,bf16*Ou,int op,char*shm,const int wave0){
  const int lane=lane_now(),r32=lane&31,hi=lane>>5; const int wid=wave0;
  const bf16*Qw=Qu+(long)(wid*QBLK)*qp;
  const unsigned lds0=(unsigned)(uintptr_t)shm;
  float*wsf=(float*)(shm+LDS_WS)+wid*64;
  const bf16*ksrc=Kh+(long)lane*kvp+wid*8;
  const bf16*vsrc=Vh+(long)(16*(wid&3)+(lane>>2))*kvp+(wid>>2)*32+(lane&3)*8;
  const unsigned kdst=lds0+LDS_K+wid*1024, vdst=lds0+LDS_V+wid*1024;
  #define DMA_K(t,slot) glds16(ksrc+(long)((t)*KVBLK)*kvp,(unsigned)__builtin_amdgcn_readfirstlane(kdst+(slot)))
  #define DMA_V(t,slot) do{ glds16(vsrc+(long)((t)*KVBLK)*kvp,(unsigned)__builtin_amdgcn_readfirstlane(vdst+2*(slot))); glds16(vsrc+(long)((t)*KVBLK)*kvp+64,(unsigned)__builtin_amdgcn_readfirstlane(vdst+2*(slot)+8192)); }while(0)
  const int vb0=(int)(lds0+LDS_V)+((lane>>4)&1)*32+(lane&3)*8+(4*hi+((lane&15)>>2))*64;
  const char*Kbase=shm+LDS_K; bf16x8 kf[8];
  const lds_cptr shm3=(lds_cptr)shm; const lds_cptr kp0=shm3+LDS_K+hi*1024+r32*16; const lds_cptr vp0=shm3+LDS_V+((lane>>4)&1)*32+(lane&3)*8+(4*hi+((lane&15)>>2))*64;
  DMA_K(0,0);DMA_V(0,0);DMA_K(1,SLOTB);
  bf16x8 qr[4];
  #pragma unroll
  for(int d0=0;d0<4;++d0)qr[d0]=*reinterpret_cast<const bf16x8*>(&Qw[(long)r32*qp+d0*16+hi*8]);
  float mhat=0.f,l_reg=0.f;f32x16 o[4];o[0]=f32x16{};o[1]=f32x16{};o[2]=f32x16{};o[3]=f32x16{};
  bool resc=false;
  #define START(P0,P1) do{ const float rm=rowmax(P0,P1); resc=false; \
    { const float dl=rm; mhat=fadd_s(mhat,dl); \
      _Pragma("unroll") for(int r=0;r<16;++r){P0[r]=fsub_s(P0[r],dl);P1[r]=fsub_s(P1[r],dl);} \
      } \
    _Pragma("unroll") for(int r=0;r<16;++r)P0[r]=__builtin_amdgcn_exp2f(P0[r]); }while(0)
  #define RESC() do{ if(resc){ asm volatile("s_waitcnt lgkmcnt(0)":::"memory"); \
      _Pragma("unroll") for(int r=0;r<16;++r){ const float f_=wsf[crow(r,hi)]; o[0][r]*=f_;o[1][r]*=f_;o[2][r]*=f_;o[3][r]*=f_; } } }while(0)
  f32x16 pA0,pA1,pB0,pB1;
  int sl_prev=0,sl_cur=0,sl_next=SLOTB;
  #define ROT() do{sl_prev=sl_cur;sl_cur=sl_next;sl_next=(sl_next==(NSLOT-1)*SLOTB)?0:sl_next+SLOTB;}while(0)
  DMA_K(2,2*SLOTB);
  WAIT_BAR(4);
  qkt(pA0,pA1,Kbase,qr,f32x16{},r32,hi);asm volatile("s_nop 15\n\ts_nop 7":"+v"(pA0),"+v"(pA1));
  START(pA0,pA1);
  _Pragma("unroll") for(int r=0;r<16;++r)pA1[r]=__builtin_amdgcn_exp2f(pA1[r]);
  WAIT_BAR(0);
  DMA_K(3,0);DMA_V(1,SLOTB);
  ROT();
  kload8(kf,kp0+sl_cur);
  WAIT_BAR(3);
  s16x4 vlo[16],vhi[16]; u32x4 pw0,pw1,pw2,pw3;
  #define PKW(P,B) cvtpk_s(P[B],P[B+1])
  #define PAF(k) __builtin_bit_cast(bf16x8,pw##k)
  #define VFR(i) (bf16x8){vlo[i][0],vlo[i][1],vlo[i][2],vlo[i][3],vhi[i][0],vhi[i][1],vhi[i][2],vhi[i][3]}
  #define PIN(x) asm volatile("":"+v"(x))
  #define MX3(a,b,c) __builtin_fmaxf(__builtin_fmaxf((a),(b)),(c))
  #define GAPA(MF,A0,A1,A2,A3,W0,W1,PW) do{ MF; sacc+=A0; sacc+=A1; sacc+=A2; sacc+=A3; PIN(sacc); W0; W1; PIN(PW); SBAR(); }while(0)
  #define EX(v) __builtin_amdgcn_exp2f(v)
  #define GAPB(MF,X,B) do{ MF; X[B]=EX(X[B]); X[B+1]=EX(X[B+1]); PIN(X); SBAR(); }while(0)
  #define VRD(n) do{ vlo[n]=vtr(vp_+(((n)&3)*4096+((n)>>2)*1024)); vhi[n]=vtr(vp_+(((n)&3)*4096+((n)>>2)*1024+512)); }while(0)
  #define KRD(G,j) do{ if(G){ kload2(kf,kp0+sl_next,j); SBAR(); } }while(0)
  #define PVM(n,k) o[(n)&3]=__builtin_amdgcn_mfma_f32_32x32x16_bf16(PAF(k),VFR(n),o[(n)&3],0,0,0)
  #define STEP(C0,C1,P0,P1,t,GK,GV,GL) do{ SBAR(); \
    const lds_cptr vp_=vp0+2*sl_prev; \
    VRD(0); SBAR(); float sacc=(P0[0]+P0[1]); \
    GAPA(C0=__builtin_amdgcn_mfma_f32_32x32x16_bf16(kf[0],qr[0],f32x16{},0,0,0), P0[2],P0[3],P0[4],P0[5],     pw0[0]=PKW(P0,0), pw0[1]=PKW(P0,2), pw0); \
    VRD(1); SBAR(); GAPA(C1=__builtin_amdgcn_mfma_f32_32x32x16_bf16(kf[1],qr[0],f32x16{},0,0,0), P0[6],P0[7],P0[8],P0[9],     pw0[2]=PKW(P0,4), pw0[3]=PKW(P0,6), pw0); \
    VRD(2); SBAR(); GAPA(C0=__builtin_amdgcn_mfma_f32_32x32x16_bf16(kf[2],qr[1],C0,0,0,0),   P0[10],P0[11],P0[12],P0[13], pw1[0]=PKW(P0,8), pw1[1]=PKW(P0,10), pw1); \
    VRD(3); SBAR(); GAPA(C1=__builtin_amdgcn_mfma_f32_32x32x16_bf16(kf[3],qr[1],C1,0,0,0),   P0[14],P0[15],P1[0],P1[1],   pw1[2]=PKW(P0,12),pw1[3]=PKW(P0,14), pw1); \
    VRD(4); SBAR(); GAPA(C0=__builtin_amdgcn_mfma_f32_32x32x16_bf16(kf[4],qr[2],C0,0,0,0),   P1[2],P1[3],P1[4],P1[5],     pw2[0]=PKW(P1,0), pw2[1]=PKW(P1,2), pw2); \
    VRD(5); SBAR(); GAPA(C1=__builtin_amdgcn_mfma_f32_32x32x16_bf16(kf[5],qr[2],C1,0,0,0),   P1[6],P1[7],P1[8],P1[9],     pw2[2]=PKW(P1,4), pw2[3]=PKW(P1,6), pw2); \
    VRD(6); SBAR(); GAPA(C0=__builtin_amdgcn_mfma_f32_32x32x16_bf16(kf[6],qr[3],C0,0,0,0),   P1[10],P1[11],P1[12],P1[13], pw3[0]=PKW(P1,8), pw3[1]=PKW(P1,10), pw3); \
    VRD(7); SBAR(); GAPA(C1=__builtin_amdgcn_mfma_f32_32x32x16_bf16(kf[7],qr[3],C1,0,0,0),   P1[14],P1[15],0.f,0.f,       pw3[2]=PKW(P1,12),pw3[3]=PKW(P1,14), pw3); \
    l_reg+=sacc; \
    if(GK){DMA_K((t)+3,sl_cur);} if(GV){DMA_V((t)+1,sl_next);} \
    { float a=MX3(C0[0],C0[1],C1[0]),b=MX3(C0[2],C0[3],C1[1]); a=MX3(a,C1[2],C1[3]); \
      _Pragma("unroll") for(int r=4;r<16;r+=4){a=MX3(a,C0[r],C0[r+1]);b=MX3(b,C0[r+2],C0[r+3]);a=MX3(a,C1[r],C1[r+1]);b=MX3(b,C1[r+2],C1[r+3]);} \
      float rm=__builtin_fmaxf(a,b); { auto rr=__builtin_amdgcn_permlane32_swap(__float_as_uint(rm),__float_as_uint(rm),false,false); rm=__builtin_fmaxf(__uint_as_float(rr[0]),__uint_as_float(rr[1])); } \
      rm-=mhat; \
      resc=false; \
      if(__builtin_expect(__any(rm>(float)THRL),0)){ const float dl=__builtin_fmaxf(rm,0.f); mhat+=dl; \
        const float f=__builtin_amdgcn_exp2f(-dl); l_reg*=f; if(hi==0)wsf[r32]=f; resc=true; } \
      _Pragma("unroll") for(int r=0;r<16;++r){C0[r]-=mhat;C1[r]-=mhat;} } \
    SBAR(); \
    VRD(8);  SBAR(); GAPB(PVM(0,0),C0,0); \
    VRD(9);  SBAR(); GAPB(PVM(1,0),C0,2); \
    VRD(10); SBAR(); GAPB(PVM(2,0),C0,4); \
    VRD(11); SBAR(); GAPB(PVM(3,0),C0,6); \
    VRD(12); SBAR(); GAPB(PVM(4,1),C0,8); \
    VRD(13); SBAR(); GAPB(PVM(5,1),C0,10); \
    VRD(14); SBAR(); GAPB(PVM(6,1),C0,12); \
    VRD(15); SBAR(); GAPB(PVM(7,1),C0,14); \
    KRD(GL,0); GAPB(PVM(8,2),C1,0); \
    KRD(GL,1); GAPB(PVM(9,2),C1,2); \
    KRD(GL,2); GAPB(PVM(10,2),C1,4); \
    KRD(GL,3); GAPB(PVM(11,2),C1,6); \
    GAPB(PVM(12,3),C1,8); \
    GAPB(PVM(13,3),C1,10); \
    GAPB(PVM(14,3),C1,12); \
    GAPB(PVM(15,3),C1,14); \
    }while(0)
  int t=1;
  for(;t+5<NT;t+=2){
    STEP(pB0,pB1,pA0,pA1,t,true,true,true);     WAIT_BAR(3); RESC(); ROT();
    STEP(pA0,pA1,pB0,pB1,t+1,true,true,true);   WAIT_BAR(3); RESC(); ROT();
  }
  #define ENDW(tt) do{ if((tt)+3<NT){WAIT_BAR(3);} else if((tt)+2<NT){WAIT_BAR(2);} else {WAIT_BAR(0);} }while(0)
  for(;t+1<NT;t+=2){
    STEP(pB0,pB1,pA0,pA1,t,(t+3<NT),(t+1<NT),(t+1<NT));       ENDW(t);   RESC(); ROT();
    STEP(pA0,pA1,pB0,pB1,t+1,(t+4<NT),(t+2<NT),(t+2<NT));     ENDW(t+1); RESC(); ROT();
  }
  STEP(pB0,pB1,pA0,pA1,NT-1,false,false,false); RESC();
  { float sacc=pB0[0]+pB0[1]; _Pragma("unroll") for(int r=2;r<16;++r)sacc+=pB0[r]; _Pragma("unroll") for(int r=0;r<16;++r)sacc+=pB1[r]; l_reg+=sacc;
    pw0=(u32x4){PKW(pB0,0),PKW(pB0,2),PKW(pB0,4),PKW(pB0,6)};pw1=(u32x4){PKW(pB0,8),PKW(pB0,10),PKW(pB0,12),PKW(pB0,14)};pw2=(u32x4){PKW(pB1,0),PKW(pB1,2),PKW(pB1,4),PKW(pB1,6)};pw3=(u32x4){PKW(pB1,8),PKW(pB1,10),PKW(pB1,12),PKW(pB1,14)};
    SBAR(); pv4(o,vb0+2*sl_cur,PAF(0),PAF(1),PAF(2),PAF(3)); }
  #undef PKW
  #undef PAF
  #undef VFR
  #undef MX3
  #undef GAPA
  #undef GAPB
  #undef EX
  #undef VRD
  #undef KRD
  #undef PVM
  #undef STEP
  #undef ENDW
  {auto rr=__builtin_amdgcn_permlane32_swap(__float_as_uint(l_reg),__float_as_uint(l_reg),false,false);l_reg=__uint_as_float(rr[0])+__uint_as_float(rr[1]);}
  if(hi==0)wsf[32+r32]=l_reg;asm volatile("s_waitcnt lgkmcnt(0)":::"memory");
  typedef unsigned u32x2v __attribute__((ext_vector_type(2)));
  u32x2v*sp=(u32x2v*)(shm+LDS_O1+wid*8192)+lane;
  if(!second){
    #pragma unroll
    for(int r=0;r<16;++r){ const float rl=__builtin_amdgcn_rcpf(wsf[32+crow(r,hi)]); const u32x2v v={cvtpk_s(o[0][r]*rl,o[1][r]*rl),cvtpk_s(o[2][r]*rl,o[3][r]*rl)}; sp[r*64]=v; }
  } else {
    float g4[4];
    #pragma unroll
    for(int d0=0;d0<4;++d0)g4[d0]=subg[d0*32+r32]*post;
    #pragma unroll
    for(int r=0;r<16;++r){ const float rl=__builtin_amdgcn_rcpf(wsf[32+crow(r,hi)])*lam; const u32x2v av=sp[r*64];
      const float a0=__uint_as_float(av[0]<<16),a1=__uint_as_float(av[0]&0xffff0000u),a2=__uint_as_float(av[1]<<16),a3=__uint_as_float(av[1]&0xffff0000u);
      float v0=a0-o[0][r]*rl,v1=a1-o[1][r]*rl,v2=a2-o[2][r]*rl,v3=a3-o[3][r]*rl; float ss=(v0*v0+v1*v1)+(v2*v2+v3*v3);
      ss+=__shfl_xor(ss,1);ss+=__shfl_xor(ss,2);ss+=__shfl_xor(ss,4);ss+=__shfl_xor(ss,8);ss+=__shfl_xor(ss,16);
      const float rn=__builtin_amdgcn_rsqf(ss*(1.0f/128.0f)+1e-6f);
      o[0][r]=v0*rn*g4[0];o[1][r]=v1*rn*g4[1];o[2][r]=v2*rn*g4[2];o[3][r]=v3*rn*g4[3]; }
    bf16*Ow=Ou+(long)(wid*QBLK)*op;
    bf16*stg=(bf16*)(shm+LDS_O1+wid*8192);
    asm volatile("s_waitcnt lgkmcnt(0)":::"memory");
    #pragma unroll
    for(int r=0;r<16;++r){const int orow=crow(r,hi);
      #pragma unroll
      for(int d0=0;d0<4;++d0)stg[orow*128+d0*32+r32]=__float2bfloat16(o[d0][r]);}
    asm volatile("s_waitcnt lgkmcnt(0)":::"memory");
    #pragma unroll
    for(int i=0;i<8;++i){const int row=i*4+(lane>>4),ch=lane&15; const u32x4 v=*(const u32x4*)(stg+row*128+ch*8); ATTN_STORE16(Ow+(long)row*op+ch*8,v);}
  }
  asm volatile("s_waitcnt lgkmcnt(0)\n\ts_barrier":::"memory");
  #undef PIN
  #undef DMA_K
  #undef DMA_V
  #undef START
  #undef RESC
  #undef ROT
}
#undef SBAR
#undef WAIT_BAR
}

typedef unsigned short bf16;
typedef float f32x4 __attribute__((ext_vector_type(4)));
typedef unsigned u32x4 __attribute__((ext_vector_type(4)));
typedef unsigned u32x2 __attribute__((ext_vector_type(2)));
constexpr int D = 1024, NBATCH = 4, SEQ = 4096, CTXL = 256, DEPTH = 2;
constexpr int MLAT = NBATCH * SEQ, MCTX = NBATCH * CTXL, MTOT = MLAT + MCTX;
constexpr int KVR = SEQ + CTXL;
constexpr int NIN = 6144, NE = 32, TOPK = 4, NWAVES = 8;
constexpr int MAXTILES = 304;
constexpr float EPS = 1e-6f;

constexpr size_t al256(size_t x) { return (x + 255) / 256 * 256; }
constexpr size_t WS_CTL = 0, CTL_BYTES = 1u << 20;
constexpr size_t WS_MOD = WS_CTL + CTL_BYTES;
constexpr size_t WS_ROPEC = WS_MOD + al256((size_t)DEPTH * 5 * NIN * 4);
constexpr size_t WS_ROPES = WS_ROPEC + 4096;
constexpr size_t WS_LAM = WS_ROPES + 4096;
constexpr size_t WS_PV = WS_LAM + 256;
constexpr size_t WS_WIN = WS_PV + (size_t)DEPTH * 5 * 4 * D * 4;
constexpr size_t WS_WB = WS_WIN + (size_t)DEPTH * NIN * D * 2;
constexpr size_t WS_WO = WS_WB + (size_t)DEPTH * 3 * D * 512 * 2;
constexpr size_t WS_W1 = WS_WO + (size_t)DEPTH * D * D * 2;
constexpr size_t WS_W2 = WS_W1 + (size_t)DEPTH * NE * 2048 * D * 2;
constexpr size_t WS_X = WS_W2 + (size_t)DEPTH * NE * D * D * 2;
constexpr size_t WS_H = WS_X + (size_t)MTOT * D * 4;
constexpr size_t WS_QA = WS_H + (size_t)MTOT * D * 2;
constexpr size_t WS_QB = WS_QA + (size_t)MTOT * 512 * 2;
constexpr size_t WS_QC = WS_QB + (size_t)MTOT * 512 * 2;
constexpr size_t WS_KA = WS_QC + (size_t)MTOT * 512 * 2;
constexpr size_t WS_VA = WS_KA + (size_t)NBATCH * KVR * 512 * 2;
constexpr size_t WS_KB = WS_VA + (size_t)NBATCH * KVR * 512 * 2;
constexpr size_t WS_VB = WS_KB + (size_t)NBATCH * KVR * 128 * 2;
constexpr size_t WS_KC = WS_VB + (size_t)NBATCH * KVR * 128 * 2;
constexpr size_t WS_VC = WS_KC + (size_t)NBATCH * KVR * 128 * 2;
constexpr size_t WS_GT = WS_VC + (size_t)NBATCH * KVR * 128 * 2;
constexpr size_t WS_YS = WS_GT + (size_t)MTOT * 3072 * 2;
constexpr size_t WS_TMP = WS_YS + (size_t)3 * MTOT * 512 * 2;
constexpr size_t WS_MG = WS_TMP + (size_t)MTOT * D * 4;
constexpr size_t WS_Y = WS_MG + (size_t)MTOT * D * 2;
constexpr size_t WS_H2 = WS_Y + (size_t)MTOT * D * 4;
constexpr size_t WS_SE = WS_H2 + (size_t)MTOT * D * 2;
constexpr size_t WS_SR = WS_SE + (size_t)MTOT * 4 * 4;
constexpr size_t WS_SW = WS_SR + (size_t)MTOT * 4 * 4;
constexpr size_t WS_LIST = WS_SW + (size_t)MTOT * 4 * 4;
constexpr size_t WS_ACT = WS_LIST + (size_t)NE * MTOT * 4;
constexpr size_t WS_YS2 = WS_ACT + (size_t)MAXTILES * 256 * D * 2;
constexpr size_t WS_EX = WS_YS2 + (size_t)MAXTILES * 256 * D * 2;
constexpr size_t WS_END = WS_EX + (size_t)DEPTH * 256 * 131072;
static_assert(WS_WIN % 256 == 0 && WS_X % 256 == 0 && WS_SE % 256 == 0 && WS_ACT % 256 == 0, "alignment");

constexpr int CW_BAR = 4096;
constexpr int CW_Q = 16384;
constexpr int CW_CNT = 8192;

constexpr int RING_BYTES = 141312, MISC_OFF = RING_BYTES, LDS_BYTES = MISC_OFF + 8192;
constexpr int MW_Q = 12; constexpr int MW_BAR = 0, MW_TB = 16, MW_CNT = 64, MW_HIST = 128, MW_BASE = 160, MW_PT = 192, MW_SLOT = 256;

#define LDS_WAIT() asm volatile("s_waitcnt lgkmcnt(0)" ::: "memory")
#define VM_WAIT() asm volatile("s_waitcnt vmcnt(0)" ::: "memory")
__device__ __forceinline__ unsigned f2bf(float f) { unsigned u = __builtin_bit_cast(unsigned, f); return (u + 0x7fffu + ((u >> 16) & 1u)) >> 16; }
typedef float f32x2_t __attribute__((ext_vector_type(2))); typedef __bf16 bf16x2_t __attribute__((ext_vector_type(2)));
__device__ __forceinline__ unsigned pk2(float lo, float hi) { const f32x2_t v = {lo, hi}; const bf16x2_t b = __builtin_convertvector(v, bf16x2_t); return __builtin_bit_cast(unsigned, b); }
__device__ __forceinline__ unsigned pk4f8(float a, float b, float c, float d) {
    int r = __builtin_amdgcn_cvt_pk_fp8_f32(a, b, 0, false); r = __builtin_amdgcn_cvt_pk_fp8_f32(c, d, r, true); return (unsigned)r; }
constexpr float W8_SCALE = 64.0f, W8_INV = 1.0f / 64.0f;
__device__ __forceinline__ float bflo(unsigned w) { return __builtin_bit_cast(float, w << 16); }
__device__ __forceinline__ float bfhi(unsigned w) { return __builtin_bit_cast(float, w & 0xffff0000u); }
template <int CTRL> __device__ __forceinline__ float dppf(float v) { return __builtin_bit_cast(float, __builtin_amdgcn_update_dpp(0, __builtin_bit_cast(int, v), CTRL, 0xf, 0xf, true)); }
template <int CTRL> __device__ __forceinline__ int dppi(int v) { return __builtin_amdgcn_update_dpp(0, v, CTRL, 0xf, 0xf, true); }
__device__ __forceinline__ float rdl(float v, int l) { return __builtin_bit_cast(float, __builtin_amdgcn_readlane(__builtin_bit_cast(int, v), l)); }
__device__ __forceinline__ float wave_sum(float v) {
    v += dppf<0xB1>(v); v += dppf<0x4E>(v); v += dppf<0x141>(v); v += dppf<0x140>(v);
    return (rdl(v, 0) + rdl(v, 16)) + (rdl(v, 32) + rdl(v, 48));
}
__device__ __forceinline__ float sigmoid255_(float x) { return __builtin_amdgcn_rcpf(__builtin_fmaf(__builtin_amdgcn_exp2f(-1.4426950408889634f * x), 1.0f / 255.0f, 1.0f / 255.0f)); }
__device__ __forceinline__ float sigmoidf_(float x) { return __builtin_amdgcn_rcpf(1.0f + __builtin_amdgcn_exp2f(-1.4426950408889634f * x)); }

__device__ __forceinline__ unsigned char* ldp(volatile LAS unsigned* MISC, int i) {
    const unsigned lo = (unsigned)__builtin_amdgcn_readfirstlane((int)MISC[MW_PT + 2 * i]), hi = (unsigned)__builtin_amdgcn_readfirstlane((int)MISC[MW_PT + 2 * i + 1]);
    return (unsigned char*)(((unsigned long long)hi << 32) | lo);
}
typedef const GAS float* gcfp; typedef GAS float* gfp; typedef const GAS unsigned short* gcbp; typedef GAS unsigned short* gbp;
#define INP(i) ((const GAS float*)ldp(MISC, (i)))
#define WSP(T, off) ((GAS T*)(ldp(MISC, 21) + (off)))
#define XB_TMO      128
#define XB_XCNT(j)  (256  + 64 * (j))
#define XB_XSUB(j)  (1280 + 64 * (j))
#define XB_XGEN(j)  (2304 + 64 * (j))
#define XB_TOP      3328
#define XB_TOPGEN   3392
#define XCD_BAR_WORDS 3456
#define XB_SPIN_CAP (1u << 18)

__device__ __forceinline__ unsigned xb_ld(unsigned* p)              { return __hip_atomic_load(p, __ATOMIC_RELAXED, __HIP_MEMORY_SCOPE_AGENT); }
__device__ __forceinline__ unsigned xb_add(unsigned* p, unsigned v) { return __hip_atomic_fetch_add(p, v, __ATOMIC_RELAXED, __HIP_MEMORY_SCOPE_AGENT); }
__device__ __forceinline__ unsigned xb_xcc_id() { return (unsigned)__builtin_amdgcn_s_getreg((3 << 11) | 20) & 0xFu; }
#define XB_SPIN(cond, bar) do { unsigned _sp = 0; while (cond) { __builtin_amdgcn_s_sleep(1); \
    if ((++_sp & 255u) == 0u) { if (xb_ld(&(bar)[XB_TMO])) break; if (_sp > XB_SPIN_CAP) { atomicAdd(&(bar)[XB_TMO], 1u); break; } } } } while (0)

struct XcdBarrier {
    unsigned* bar; unsigned x;
    volatile LAS unsigned* st;
};

__device__ __forceinline__ XcdBarrier xcd_barrier_post(unsigned* bar, volatile LAS unsigned* st) {
    XcdBarrier b; b.bar = bar; b.x = xb_xcc_id(); b.st = st;
    if (threadIdx.x == 0) (void)xb_add(&bar[XB_XCNT(b.x)], 1u);
    return b;
}
__device__ __forceinline__ void xcd_barrier_complete(unsigned* bar, unsigned x, unsigned& nloc, unsigned& nx) {
    const unsigned G = gridDim.x * gridDim.y * gridDim.z;
    unsigned sum, cnt, mine, sp = 0u;
    for (;;) {
        sum = 0u; cnt = 0u; mine = 0u;
#pragma unroll
        for (unsigned j = 0; j < 16; ++j) { const unsigned c = xb_ld(&bar[XB_XCNT(j)]); sum += c; cnt += (c > 0u) ? 1u : 0u; mine = (j == x) ? c : mine; }
        if (sum == G) break;
        __builtin_amdgcn_s_sleep(1);
        if ((++sp & 255u) == 0u) { if (xb_ld(&bar[XB_TMO])) break; if (sp > XB_SPIN_CAP) { atomicAdd(&bar[XB_TMO], 1u); break; } }
    }
    nloc = mine > 0u ? mine : 1u; nx = cnt > 0u ? cnt : 1u;
}

__device__ __forceinline__ void xcd_barrier(const XcdBarrier& b, const int tid_now) {
    asm volatile("s_waitcnt vmcnt(0)" ::: "memory");
    __syncthreads();
    if (tid_now == 0) {
        unsigned long long bp_ = (unsigned long long)b.bar; asm volatile("" : "+s"(bp_)); unsigned* bar = (unsigned*)bp_;
        unsigned bx_ = b.x; asm volatile("" : "+s"(bx_));
        __builtin_amdgcn_s_waitcnt(0);
        unsigned nloc = b.st[0], nx = b.st[1];
        if (nloc == 0u) { xcd_barrier_complete(bar, bx_, nloc, nx); b.st[0] = nloc; b.st[1] = nx; }
        const unsigned old = xb_add(&bar[XB_XSUB(bx_)], 1u);
        const unsigned gen = old / nloc;
        if (old + 1u == (gen + 1u) * nloc) {
            __builtin_amdgcn_fence(__ATOMIC_RELEASE, "agent");
            asm volatile("s_waitcnt vmcnt(0)" ::: "memory");
            const unsigned og = xb_add(&bar[XB_TOP], 1u);
            const unsigned tg = og / nx;
            if (og + 1u == (tg + 1u) * nx) xb_add(&bar[XB_TOPGEN], 1u);
            else XB_SPIN(xb_ld(&bar[XB_TOPGEN]) == tg, bar);
            __builtin_amdgcn_fence(__ATOMIC_ACQUIRE, "agent");
            xb_add(&bar[XB_XGEN(bx_)], 1u);
            asm volatile("s_waitcnt vmcnt(0)" ::: "memory");
        } else {
            XB_SPIN(xb_ld(&bar[XB_XGEN(bx_)]) == gen, bar);
            __builtin_amdgcn_fence(__ATOMIC_ACQUIRE, "agent");
            asm volatile("s_waitcnt vmcnt(0)" ::: "memory");
        }
    }
    __syncthreads();
}

using pg8::Unit;
__host__ __device__ __forceinline__ int in_src_col(int nbd) {
    const int pn = nbd >> 3, blk = nbd & 7, bj = blk >> 2, wc = blk & 3;
    if (pn <= 8) { const int hs = pn * 4 + wc; int base;
        if (hs < 8) base = hs * 64; else if (hs < 16) base = 512 + (hs - 8) * 64; else if (hs < 24) base = 1536 + (hs - 16) * 64;
        else if (hs < 32) base = 2304 + (hs - 24) * 64; else if (hs < 34) base = 2048 + (hs - 32) * 64; else base = 2816 + (hs - 34) * 64;
        return base + 32 * bj; }
    if (pn <= 10) return 1024 + (pn - 9) * 256 + blk * 32;
    if (pn == 11) return blk < 4 ? 2176 + blk * 32 : 2944 + (blk - 4) * 32;
    return 3072 + (pn - 12) * 256 + blk * 32;
}
struct EpiInproj {
    static constexpr bool PERM = false;
    volatile LAS unsigned* MISC; int l;
    __device__ __forceinline__ void operator()(const f32x4 (&acc)[2][2][4][2], const Unit& u, int wr, int wc, int fr, int fq) const {
        auto QA = WSP(bf16, WS_QA); auto QB = WSP(bf16, WS_QB); auto QC = WSP(bf16, WS_QC); auto KA = WSP(bf16, WS_KA); auto VA = WSP(bf16, WS_VA);
        auto KB = WSP(bf16, WS_KB); auto VB = WSP(bf16, WS_VB); auto KC = WSP(bf16, WS_KC); auto VC = WSP(bf16, WS_VC); auto GT = WSP(bf16, WS_GT);
        auto ropec = WSP(float, WS_ROPEC); auto ropes = WSP(float, WS_ROPES); auto qkg = INP(10) + l * 128;
        const int pn = u.pn; const bool ctx = u.pm >= (MLAT / 256);
#pragma unroll
        for (int ai = 0; ai < 2; ++ai)
#pragma unroll
            for (int m = 0; m < 4; ++m) {
                const int r = u.pm * 256 + ai * 128 + wr * 64 + m * 16 + fr;
                int kvrow, t = 0;
                if (!ctx) { t = r & (SEQ - 1); kvrow = (r >> 12) * KVR + t; } else { const int rr = r - MLAT; kvrow = (rr >> 8) * KVR + SEQ + (rr & 255); }
                if (pn <= 8) {
                    float v[2][2][4];
#pragma unroll
                    for (int bj = 0; bj < 2; ++bj)
#pragma unroll
                        for (int n = 0; n < 2; ++n)
#pragma unroll
                            for (int j = 0; j < 4; ++j) v[bj][n][j] = acc[ai][bj][m][n][j];
                    const int hs = pn * 4 + wc;
                    const bool isbq = (pn == 4 || pn == 5), isbk = (pn == 8 && wc < 2);
                    if (isbq || isbk) {
                        float ss = 0.f;
#pragma unroll
                        for (int bj = 0; bj < 2; ++bj)
#pragma unroll
                            for (int n = 0; n < 2; ++n)
#pragma unroll
                                for (int j = 0; j < 4; ++j) ss += v[bj][n][j] * v[bj][n][j];
                        ss += __shfl_xor(ss, 16); ss += __shfl_xor(ss, 32);
                        const float rn = __builtin_amdgcn_rsqf(ss * (1.0f / 64.0f) + EPS);
                        gcfp g = qkg + (isbk ? 64 : 0);
#pragma unroll
                        for (int bj = 0; bj < 2; ++bj)
#pragma unroll
                            for (int n = 0; n < 2; ++n) { const f32x4 gv = *(const GAS f32x4*)(g + 32 * bj + 16 * n + 4 * fq);
#pragma unroll
                                for (int j = 0; j < 4; ++j) v[bj][n][j] = v[bj][n][j] * rn * gv[j]; }
                    }
                    if (!ctx) {
#pragma unroll
                        for (int bj = 0; bj < 2; ++bj) { const int pos = bj ? (t & 63) : (t >> 6);
                            const f32x4 cs = *(const GAS f32x4*)(ropec + pos * 16 + 4 * fq), sn = *(const GAS f32x4*)(ropes + pos * 16 + 4 * fq);
#pragma unroll
                            for (int j = 0; j < 4; ++j) { const float x0 = v[bj][0][j], x1 = v[bj][1][j];
                                v[bj][0][j] = x0 * cs[j] - x1 * sn[j]; v[bj][1][j] = x1 * cs[j] + x0 * sn[j]; } }
                    }
                    if (isbq || pn == 6 || pn == 7 || (pn < 2 && !ctx)) {
#pragma unroll
                        for (int bj = 0; bj < 2; ++bj)
#pragma unroll
                            for (int n = 0; n < 2; ++n)
#pragma unroll
                                for (int j = 0; j < 4; ++j) v[bj][n][j] *= att64::C2; }
                    gbp dst;
                    if (pn < 2) dst = QA + (size_t)r * 512 + hs * 64;
                    else if (pn < 4) dst = KA + (size_t)kvrow * 512 + (hs - 8) * 64;
                    else if (pn < 6) dst = QB + (size_t)r * 512 + (hs - 16) * 64;
                    else if (pn < 8) dst = QC + (size_t)r * 512 + (hs - 24) * 64;
                    else if (wc < 2) dst = KB + (size_t)kvrow * 128 + wc * 64;
                    else dst = KC + (size_t)kvrow * 128 + (wc - 2) * 64;
#pragma unroll
                    for (int bj = 0; bj < 2; ++bj) { u32x4 w; w.x = pk2(v[bj][0][0], v[bj][0][1]); w.y = pk2(v[bj][0][2], v[bj][0][3]); w.z = pk2(v[bj][1][0], v[bj][1][1]); w.w = pk2(v[bj][1][2], v[bj][1][3]);
                        *(GAS u32x4*)(dst + 32 * bj + 8 * fq) = w; }
                } else if (pn <= 11) {
#pragma unroll
                    for (int bj = 0; bj < 2; ++bj) { const int c = 128 * bj + 32 * wc + 8 * fq; const f32x4 x = acc[ai][bj][m][0], y = acc[ai][bj][m][1];
                            gbp dst = (pn < 11) ? VA + (size_t)kvrow * 512 + (pn - 9) * 256 + c : ((bj == 0) ? VB : VC) + (size_t)kvrow * 128 + (c & 127);
                            u32x4 w; w.x = pk2(x[0], x[1]); w.y = pk2(x[2], x[3]); w.z = pk2(y[0], y[1]); w.w = pk2(y[2], y[3]); *(GAS u32x4*)dst = w; }
                } else {
#pragma unroll
                    for (int bj = 0; bj < 2; ++bj) { const int c = 128 * bj + 32 * wc + 8 * fq; const f32x4 x = acc[ai][bj][m][0], y = acc[ai][bj][m][1];
                            u32x2 w = {0u, 0u};
#pragma unroll
                            for (int j = 0; j < 4; ++j) { w.x = __builtin_amdgcn_cvt_pk_u8_f32(sigmoid255_(x[j]), (unsigned)j, w.x); w.y = __builtin_amdgcn_cvt_pk_u8_f32(sigmoid255_(y[j]), (unsigned)j, w.y); }
                            *(GAS u32x2*)((GAS unsigned char*)GT + (size_t)r * 3072 + (pn - 12) * 256 + c) = w; }
                }
            }
    }
};

#if defined(EPIDUP_INPROJ)
namespace pg8 { template <> struct epi_dup<::EpiInproj> { static constexpr int v = 1; }; }
#endif
struct MergeOrder {
    int ntiles, G, vcu;
    __device__ __forceinline__ bool next(int i, Unit& u) const { const int rnd = i / 3, sub = i - rnd * 3; const int tl = rnd * G + vcu; if (tl >= ntiles) return false;
        u.pm = sub * (MTOT / 256) + (tl >> 2); u.pn = sub * 4 + (tl & 3); return true; }
    __device__ __forceinline__ unsigned a_row(const Unit&, int) const { return 0u; }
};
struct EpiMerge {
    static constexpr bool PERM = true;
    volatile LAS unsigned* MISC;
    __device__ __forceinline__ bool keep(const Unit& u) const { return (u.pn >> 2) < 2; }
    __device__ __forceinline__ void operator()(f32x4 (&acc)[2][2][4][2], const Unit& u, int wr, int wc, int fr, int fq) const {
        const auto GT = WSP(bf16, WS_GT); auto MG = WSP(bf16, WS_MG);
        const int sub = u.pn >> 2, pnr = u.pn & 3, pmr = u.pm - sub * (MTOT / 256);
        constexpr float GMIN = 1e-24f;
        const int subn = sub < 2 ? sub + 1 : sub;
        const GAS unsigned char* gbase = (const GAS unsigned char*)GT + ((size_t)pmr * 256 + wr * 64 + fr) * 3072 + pnr * 256 + wc * 32 + 8 * fq;
        u32x2 gw[2][4][2], gn[2][4][2];
#pragma unroll
        for (int ai = 0; ai < 2; ++ai)
#pragma unroll
            for (int m = 0; m < 4; ++m)
#pragma unroll
                for (int bj = 0; bj < 2; ++bj) { const GAS unsigned char* p = gbase + (size_t)(ai * 128 + m * 16) * 3072 + bj * 128;
                    gw[ai][m][bj] = *(const GAS u32x2*)(p + sub * 1024); gn[ai][m][bj] = *(const GAS u32x2*)(p + subn * 1024); }
        const float nmin = sub > 0 ? GMIN : 0.0f;
        const bool last = sub == 2;
#pragma unroll
        for (int ai = 0; ai < 2; ++ai)
#pragma unroll
            for (int m = 0; m < 4; ++m)
#pragma unroll
                for (int bj = 0; bj < 2; ++bj) {
                    const u32x2 a = gw[ai][m][bj], b = gn[ai][m][bj];
                    float g[8] = {(float)(a.x & 0xffu), (float)((a.x >> 8) & 0xffu), (float)((a.x >> 16) & 0xffu), (float)(a.x >> 24), (float)(a.y & 0xffu), (float)((a.y >> 8) & 0xffu), (float)((a.y >> 16) & 0xffu), (float)(a.y >> 24)};
                    const float d[8] = {(float)(b.x & 0xffu), (float)((b.x >> 8) & 0xffu), (float)((b.x >> 16) & 0xffu), (float)(b.x >> 24), (float)(b.y & 0xffu), (float)((b.y >> 8) & 0xffu), (float)((b.y >> 16) & 0xffu), (float)(b.y >> 24)};
#pragma unroll
                    for (int k = 0; k < 8; ++k) g[k] = fmaxf(g[k], nmin) * (last ? (1.0f / 255.0f) : __builtin_amdgcn_rcpf(fmaxf(d[k], GMIN)));
                    f32x4 v0 = acc[ai][bj][m][0], v1 = acc[ai][bj][m][1];
                    v0[0] *= g[0]; v0[1] *= g[1]; v0[2] *= g[2]; v0[3] *= g[3]; v1[0] *= g[4]; v1[1] *= g[5]; v1[2] *= g[6]; v1[3] *= g[7];
                    acc[ai][bj][m][0] = v0; acc[ai][bj][m][1] = v1; }
        if (last) {
#pragma unroll
            for (int ai = 0; ai < 2; ++ai)
#pragma unroll
                for (int m = 0; m < 4; ++m) { const size_t row = (size_t)pmr * 256 + ai * 128 + wr * 64 + m * 16 + fr;
#pragma unroll
                    for (int bj = 0; bj < 2; ++bj) { const int col = pnr * 256 + bj * 128 + wc * 32 + 8 * fq; const f32x4 v0 = acc[ai][bj][m][0], v1 = acc[ai][bj][m][1];
                        u32x4 w; w.x = pk2(v0[0], v0[1]); w.y = pk2(v0[2], v0[3]); w.z = pk2(v1[0], v1[1]); w.w = pk2(v1[2], v1[3]); *(GAS u32x4*)(MG + row * 1024 + col) = w; } }
        }
    }
};
namespace pg8 { template <> struct epi_chain<::EpiMerge> { static constexpr bool v = true; }; }
struct EpiOut {
    static constexpr bool PERM = true;
    volatile LAS unsigned* MISC;
    __device__ __forceinline__ void operator()(const f32x4 (&acc)[2][2][4][2], const Unit& u, int wr, int wc, int fr, int fq) const {
        auto Y = WSP(bf16, WS_Y);
#pragma unroll
        for (int ai = 0; ai < 2; ++ai)
#pragma unroll
            for (int m = 0; m < 4; ++m) { gbp rowp = Y + ((size_t)u.pm * 256 + ai * 128 + wr * 64 + m * 16 + fr) * 1024 + u.pn * 256 + wc * 32 + 8 * fq;
#pragma unroll
                for (int bj = 0; bj < 2; ++bj) { const f32x4 v0 = acc[ai][bj][m][0], v1 = acc[ai][bj][m][1];
                    u32x4 w; w.x = pk2(v0[0], v0[1]); w.y = pk2(v0[2], v0[3]); w.z = pk2(v1[0], v1[1]); w.w = pk2(v1[2], v1[3]); *(GAS u32x4*)(rowp + bj * 128) = w; } }
    }
};
template <int NP> struct MoeOrder {
    const LAS int* tb; const LAS int* cn; const GAS int* list; int G, bid, vcu, U, chunk, per;
    __device__ __forceinline__ void init(const LAS int* tb_, const LAS int* cn_, const GAS int* list_, int G_, int bid_) {
        tb = tb_; cn = cn_; list = list_; G = G_; bid = bid_; U = tb_[NE] * NP;
        if (G_ % 8 == 0) { per = G_ / 8; vcu = (bid_ % 8) * per + bid_ / 8; chunk = (U + 7) / 8; } else { per = G_; vcu = bid_; chunk = U; }
    }
    __device__ __forceinline__ bool next(int i, Unit& u) const {
        const int x = vcu / per, j = i * per + (vcu % per); if (j >= chunk) return false;
        const int id = x * chunk + j; if (id >= U) return false;
        const int T = id / NP, pnl = id - T * NP; int e = 0;
#pragma unroll
        for (int q = 1; q < NE; ++q) e += (T >= tb[q]) ? 1 : 0;
        e = __builtin_amdgcn_readfirstlane(e);
        u.pm = T; u.pn = e * NP + pnl; return true;
    }
    __device__ __forceinline__ unsigned a_row(const Unit& u, int r) const {
        const int e = u.pn / NP; int idx = (u.pm - tb[e]) * 256 + r; const int c = cn[e]; idx = idx < c ? idx : c - 1;
        return (unsigned)list[(size_t)e * MTOT + idx];
    }
};
template <bool F8> struct EpiSwiglu {
    static constexpr bool PERM = true;
    volatile LAS unsigned* MISC; int l;
    __device__ __forceinline__ void operator()(const f32x4 (&acc)[2][2][4][2], const Unit& u, int wr, int wc, int fr, int fq) const {
        auto ACT = WSP(bf16, WS_ACT); auto b1 = INP(17) + (size_t)l * NE * 2048;
        const int e = u.pn >> 3, pnl = u.pn & 7; const int col = pnl * 128 + wc * 32 + 8 * fq;
        gcfp bg = b1 + (size_t)e * 2048 + col; gcfp bu = bg + 1024;
        const f32x4 bg0 = *(const GAS f32x4*)bg, bg1 = *(const GAS f32x4*)(bg + 4), bu0 = *(const GAS f32x4*)bu, bu1 = *(const GAS f32x4*)(bu + 4);
#pragma unroll
        for (int ai = 0; ai < 2; ++ai)
#pragma unroll
            for (int m = 0; m < 4; ++m) { const size_t row = (size_t)u.pm * 256 + ai * 128 + wr * 64 + m * 16 + fr;
                float a[8];
#pragma unroll
                for (int n = 0; n < 2; ++n)
#pragma unroll
                    for (int j = 0; j < 4; ++j) { constexpr float SC = F8 ? W8_INV : 1.0f; float gt = acc[ai][0][m][n][j] * SC + (n ? bg1[j] : bg0[j]), up = acc[ai][1][m][n][j] * SC + (n ? bu1[j] : bu0[j]);
                        gt = fminf(gt, 7.0f); up = fminf(fmaxf(up, -7.0f), 7.0f);
                        a[n * 4 + j] = (up + 1.0f) * (gt * sigmoidf_(1.702f * gt)); }
                if constexpr (F8) { u32x2 w; w.x = pk4f8(a[0], a[1], a[2], a[3]); w.y = pk4f8(a[4], a[5], a[6], a[7]); *(GAS u32x2*)((GAS unsigned char*)ACT + row * 1024 + col) = w; }
                else { u32x4 w; w.x = pk2(a[0], a[1]); w.y = pk2(a[2], a[3]); w.z = pk2(a[4], a[5]); w.w = pk2(a[6], a[7]);
                *(GAS u32x4*)(ACT + row * 1024 + col) = w; } }
    }
};
#if defined(EPIDUP_MOE1)
namespace pg8 { template <> struct epi_dup<::EpiSwiglu<true>> { static constexpr int v = 1; }; }
#endif
template <bool F8> struct EpiMoe2 {
    static constexpr bool PERM = true;
    volatile LAS unsigned* MISC; int l;
    __device__ __forceinline__ void operator()(const f32x4 (&acc)[2][2][4][2], const Unit& u, int wr, int wc, int fr, int fq) const {
        auto YS2 = WSP(bf16, WS_YS2); auto b2 = INP(19) + (size_t)l * NE * D;
        const int e = u.pn >> 2, pnl = u.pn & 3;
#pragma unroll
        for (int bj = 0; bj < 2; ++bj) { const int col = pnl * 256 + bj * 128 + wc * 32 + 8 * fq;
            const f32x4 c0 = *(const GAS f32x4*)(b2 + (size_t)e * 1024 + col), c1 = *(const GAS f32x4*)(b2 + (size_t)e * 1024 + col + 4);
#pragma unroll
            for (int ai = 0; ai < 2; ++ai)
#pragma unroll
                for (int m = 0; m < 4; ++m) { const size_t row = (size_t)u.pm * 256 + ai * 128 + wr * 64 + m * 16 + fr;
                    constexpr float SC = F8 ? W8_INV : 1.0f; const f32x4 v0 = acc[ai][bj][m][0] * SC + c0, v1 = acc[ai][bj][m][1] * SC + c1;
                    u32x4 w; w.x = pk2(v0[0], v0[1]); w.y = pk2(v0[2], v0[3]); w.z = pk2(v1[0], v1[1]); w.w = pk2(v1[2], v1[3]);
                    *(GAS u32x4*)(YS2 + row * 1024 + col) = w; } }
    }
};

#if defined(EPIDUP_MOE2)
namespace pg8 { template <> struct epi_dup<::EpiMoe2<true>> { static constexpr int v = 1; }; }
#endif

struct Args { const float* in[20]; float* out; unsigned char* ws; int ph_lo, ph_hi; };

#ifndef MOE_F8_FROM
#define MOE_F8_FROM 0
#endif
__device__ __forceinline__ int sgpr_launder(int x) { asm volatile("" : "+s"(x)); return x; }
#ifndef CVT_SH2
#define CVT_SH2 43
#define CVT_SH4 12
#endif
#ifndef CVT_SH5
#define CVT_SH5 4
#endif
struct CvtItem { gcfp W; gbp WT; int N, k0, n0, Kd, rowd, f8; };
__device__ __forceinline__ void cvt_load(const CvtItem& I, int lane, float (&v)[32]) {
    const GAS char* base = (const GAS char*)(I.W + (size_t)I.k0 * I.N + I.n0);
    unsigned off = (unsigned)((lane >> 5) * I.N + (lane & 31)) * 4u; const unsigned step = (unsigned)I.N * 8u;
#pragma unroll
    for (int i = 0; i < 32; ++i) { v[i] = __builtin_nontemporal_load((const GAS float*)(base + off)); off += step; }
}
__device__ __forceinline__ void cvt_store(const CvtItem& I, int lane, const float (&v)[32], LAS float* scr) {
#pragma unroll
    for (int i = 0; i < 32; ++i) { const int kk = 2 * i + (lane >> 5); scr[kk * 33 + (lane & 31)] = v[i]; }
    LDS_WAIT(); asm volatile("" ::: "memory");
    const int c = lane & 7;
#pragma unroll
    for (int j = 0; j < 4; ++j) { const int n = (lane >> 3) + 8 * j; const LAS float* s = scr + (8 * c) * 33 + n;
        if (I.f8 & 1) { u32x2 o; o.x = pk4f8(s[0 * 33] * W8_SCALE, s[1 * 33] * W8_SCALE, s[2 * 33] * W8_SCALE, s[3 * 33] * W8_SCALE); o.y = pk4f8(s[4 * 33] * W8_SCALE, s[5 * 33] * W8_SCALE, s[6 * 33] * W8_SCALE, s[7 * 33] * W8_SCALE);
            __builtin_nontemporal_store(o, (GAS u32x2*)((GAS char*)I.WT + (size_t)I.rowd * I.Kd + I.k0 + (unsigned)(n * I.Kd + 8 * c))); }
        else { u32x4 o; o.x = pk2(s[0 * 33], s[1 * 33]); o.y = pk2(s[2 * 33], s[3 * 33]); o.z = pk2(s[4 * 33], s[5 * 33]); o.w = pk2(s[6 * 33], s[7 * 33]);
        const int nd = (I.f8 & 2) ? 16 * ((n >> 2) & 1) + 4 * (n >> 3) + (n & 3) : n;
        __builtin_nontemporal_store(o, (GAS u32x4*)((GAS char*)(I.WT + (size_t)I.rowd * I.Kd + I.k0) + (unsigned)(nd * I.Kd + 8 * c) * 2u)); } }
    LDS_WAIT(); asm volatile("" ::: "memory");
}

__device__ __forceinline__ void ld_row(gcfp p, int lane, f32x4 (&v)[4]) {
#pragma unroll
    for (int j = 0; j < 4; ++j) v[j] = *(const GAS f32x4*)(p + 4 * lane + 256 * j);
}
__device__ __forceinline__ void ld_row_bf(gcbp p, int lane, f32x4 (&v)[4]) {
#pragma unroll
    for (int j = 0; j < 4; ++j) { const u32x2 w = *(const GAS u32x2*)(p + 4 * lane + 256 * j); v[j] = (f32x4){bflo(w.x), bfhi(w.x), bflo(w.y), bfhi(w.y)}; }
}
__device__ __forceinline__ float sumsq_row(const f32x4 (&v)[4]) {
    float s = 0.f;
#pragma unroll
    for (int j = 0; j < 4; ++j) s += (v[j][0] * v[j][0] + v[j][1] * v[j][1]) + (v[j][2] * v[j][2] + v[j][3] * v[j][3]);
    return wave_sum(s);
}
template <bool F8 = false> __device__ __forceinline__ void norm_mod_row(const f32x4 (&x)[4], gcfp g, gcfp sc, gcfp sh, int lane, f32x4 (&h)[4], gbp dst) {
    const float rn = 1.0f / sqrtf(sumsq_row(x) * (1.0f / D) + EPS);
#pragma unroll
    for (int j = 0; j < 4; ++j) { const int c = 4 * lane + 256 * j; const f32x4 gv = *(const GAS f32x4*)(g + c), sv = *(const GAS f32x4*)(sc + c), hv = *(const GAS f32x4*)(sh + c);
        h[j] = (x[j] * rn) * gv * (1.0f + sv) + hv;
        if constexpr (F8) { *(GAS unsigned*)((GAS unsigned char*)dst + c) = pk4f8(h[j][0], h[j][1], h[j][2], h[j][3]); }
        else { u32x2 w; w.x = pk2(h[j][0], h[j][1]); w.y = pk2(h[j][2], h[j][3]); *(GAS u32x2*)(dst + c) = w; } }
}

constexpr int CVT_I_IN = 16 * 192, CVT_I_WB = 3 * 8 * 32, CVT_I_WO = 16 * 32, CVT_I_W1 = NE * 16 * 64, CVT_I_W2 = NE * 16 * 32, CVT_I_L = CVT_I_IN + CVT_I_WB + CVT_I_WO + CVT_I_W1 + CVT_I_W2;
constexpr int CVT_P0_END = CVT_I_IN + CVT_I_WB + CVT_I_WO, CVT_END = DEPTH * CVT_I_L, CVT_REST = CVT_END - CVT_P0_END;
constexpr int CVT_T1_END = CVT_P0_END + (CVT_REST * 21) / 100, CVT_T3_END = CVT_T1_END + (CVT_REST * CVT_SH2) / 100, CVT_T4_END = CVT_END - (CVT_REST * CVT_SH4) / 100, CVT_T5_END = CVT_T4_END - (CVT_REST * CVT_SH5) / 100;
static_assert(CVT_T3_END >= CVT_I_L, "layer 0's expert weights are converted before its expert GEMMs");
static_assert(CVT_T5_END >= CVT_I_L + CVT_I_IN + CVT_I_WB + CVT_I_WO && CVT_T5_END >= CVT_T3_END, "only layer 1's expert weights may wait for layer 1's in-projection");
__device__ __forceinline__ void cvt_range(volatile LAS unsigned* MISC, LAS unsigned char* ldsl, int first, int last, int gw, int NGW, int wave, int lane) {
    auto w_in = INP(7); auto w_branch = INP(12); auto w_out = INP(13); auto w1 = INP(16); auto w2 = INP(18);
    auto WIN = WSP(bf16, WS_WIN); auto WB = WSP(bf16, WS_WB); auto WO = WSP(bf16, WS_WO); auto W1 = WSP(bf16, WS_W1); auto W2 = WSP(bf16, WS_W2);
    LAS float* scr = (LAS float*)(ldsl + wave * 16384);
    constexpr int I_IN = CVT_I_IN, I_WB = CVT_I_WB, I_WO = CVT_I_WO, I_W1 = CVT_I_W1, I_W2 = CVT_I_W2, I_L = CVT_I_L;
#define CVT_DECODE(it_, I_) do { const int l_ = (it_) / I_L; int r_ = (it_) - l_ * I_L; \
            if (r_ < I_IN) { const int kb = r_ / 192, nbd = r_ % 192; I_ = CvtItem{w_in + (size_t)l_ * D * NIN, WIN + (size_t)l_ * NIN * D, NIN, 64 * kb, in_src_col(nbd), D, 32 * nbd, (nbd >= 72) ? 2 : 0}; break; } r_ -= I_IN; \
            if (r_ < I_WB) { const int i = r_ / 256, rr = r_ % 256, kb = rr / 32, nb = rr % 32; I_ = CvtItem{w_branch + (size_t)(l_ * 3 + i) * 512 * D, WB + (size_t)(l_ * 3 + i) * D * 512, D, 64 * kb, 32 * nb, 512, 32 * nb, 0}; break; } r_ -= I_WB; \
            if (r_ < I_WO) { const int kb = r_ / 32, nb = r_ % 32; I_ = CvtItem{w_out + (size_t)l_ * D * D, WO + (size_t)l_ * D * D, D, 64 * kb, 32 * nb, D, 32 * nb, 0}; break; } r_ -= I_WO; \
            if (r_ < I_W1) { const int e = r_ / 1024, rr = r_ % 1024, kb = rr / 64, nbd = rr % 64; const int pn = nbd >> 3, blk = nbd & 7, bj = blk >> 2, q = blk & 3; \
                const bool f8_ = (l_ >= MOE_F8_FROM);     \
                I_ = CvtItem{w1 + (size_t)(l_ * NE + e) * D * 2048, f8_ ? (gbp)((GAS char*)(W1 + (size_t)l_ * NE * 2048 * D) + (size_t)e * 2048 * D) : W1 + (size_t)(l_ * NE + e) * 2048 * D, 2048, 64 * kb, bj * 1024 + 128 * pn + 32 * q, D, 32 * nbd, f8_ ? 1 : 0}; break; } r_ -= I_W1; \
            { const int e = r_ / 512, rr = r_ % 512, kb = rr / 32, nb = rr % 32; const bool f8_ = (l_ >= MOE_F8_FROM); \
              I_ = CvtItem{w2 + (size_t)(l_ * NE + e) * D * D, f8_ ? (gbp)((GAS char*)(W2 + (size_t)l_ * NE * D * D) + (size_t)e * D * D) : W2 + (size_t)(l_ * NE + e) * D * D, D, 64 * kb, 32 * nb, D, 32 * nb, f8_ ? 1 : 0}; } } while (0)
        {
            int it = first + gw; CvtItem Iq[4]; float v[4][32];
#define CVT_PRE(k, itx) do { if ((itx) < last) { CVT_DECODE((itx), Iq[k]); cvt_load(Iq[k], lane, v[k]); } } while (0)
#define CVT_STG(k) { CVT_PRE(((k) + 3) & 3, it + 3 * NGW); cvt_store(Iq[k], lane, v[k], scr); it += NGW; if (it >= last) break; }
            CVT_PRE(0, it); CVT_PRE(1, it + NGW); CVT_PRE(2, it + 2 * NGW);
            if (it < last) for (;;) { CVT_STG(0) CVT_STG(1) CVT_STG(2) CVT_STG(3) }
#undef CVT_PRE
#undef CVT_STG
        }
#undef CVT_DECODE
}

#ifndef DISMASK
#define DISMASK 0
#endif
#define EN(k) (((DISMASK >> (k)) & 1) == 0)
#ifndef TOKPROBE
#define TOKPROBE 0
#endif
#ifndef DUPMASK
#ifndef INPROJ_STAGGER
#define INPROJ_STAGGER 2
#endif
#ifndef A128DUP
#define A128DUP 0
#endif
#define DUPMASK 0
#endif
#define REPS(k) ((((DUPMASK) >> (k)) & 1) ? 2 : 1)
__device__ __forceinline__ void ld_prod(gcfp a, gcfp b, int lane, f32x4 (&o)[4]) {
#pragma unroll
    for (int j = 0; j < 4; ++j) o[j] = *(const GAS f32x4*)(a + 4 * lane + 256 * j) * *(const GAS f32x4*)(b + 4 * lane + 256 * j);
}
__device__ __forceinline__ void ld_scale(gcfp g, gcfp sc, int lane, f32x4 (&A)[4]) {
#pragma unroll
    for (int j = 0; j < 4; ++j) A[j] = *(const GAS f32x4*)(g + 4 * lane + 256 * j) * (1.0f + *(const GAS f32x4*)(sc + 4 * lane + 256 * j));
}
template <bool F8 = false> __device__ __forceinline__ void norm_affine_row(const f32x4 (&x)[4], const f32x4 (&A)[4], int lane, f32x4 (&h)[4], gbp dst) {
    const float rn = __builtin_amdgcn_rsqf(sumsq_row(x) * (1.0f / D) + EPS);
#pragma unroll
    for (int j = 0; j < 4; ++j) { const int c = 4 * lane + 256 * j; h[j] = (x[j] * rn) * A[j] + h[j];
        if constexpr (F8) { *(GAS unsigned*)((GAS unsigned char*)dst + c) = pk4f8(h[j][0], h[j][1], h[j][2], h[j][3]); }
        else { u32x2 w; w.x = pk2(h[j][0], h[j][1]); w.y = pk2(h[j][2], h[j][3]); *(GAS u32x2*)(dst + c) = w; } }
}
__global__ void __launch_bounds__(NWAVES * 64, 2) mk_fwd(Args args) {
    extern __shared__ __attribute__((aligned(16))) unsigned char lds[];
    LAS unsigned char* ldsl = (LAS unsigned char*)lds;
    volatile LAS unsigned* MISC = (volatile LAS unsigned*)(ldsl + MISC_OFF);
    const int tid = threadIdx.x; const int wave0 = __builtin_amdgcn_readfirstlane(tid >> 6);
#define TIDNOW() (wave0 * 64 + lane_now())
    const int G = gridDim.x, bid = blockIdx.x;
    const int vcu = (G % 8 == 0) ? (bid % 8) * (G / 8) + bid / 8 : bid;
    const int G0 = G, bid0 = bid, vcu0 = vcu, wave00 = wave0;
#define IDS_NOW const int G = sgpr_launder(G0), bid = sgpr_launder(bid0), vcu = sgpr_launder(vcu0), wave0 = sgpr_launder(wave00); (void)G; (void)bid; (void)vcu; (void)wave0
    unsigned* ctl = (unsigned*)(GAS unsigned*)(args.ws + WS_CTL);
    for (int u = tid; u < (LDS_BYTES - MISC_OFF) / 4; u += NWAVES * 64) MISC[u] = 0u;
    __syncthreads();
    if (tid == 0) {
#pragma unroll
        for (int i = 0; i < 22; ++i) { const unsigned long long pv = i < 20 ? (unsigned long long)args.in[i] : (i == 20 ? (unsigned long long)args.out : (unsigned long long)args.ws);
            MISC[MW_PT + 2 * i] = (unsigned)pv; MISC[MW_PT + 2 * i + 1] = (unsigned)(pv >> 32); }
    }
    __syncthreads();
    XcdBarrier bar = xcd_barrier_post(ctl + CW_BAR, MISC + MW_BAR);
    const int lo = args.ph_lo, hi = args.ph_hi;
#define IN(k) (sgpr_launder(lo) <= (k) && (k) < sgpr_launder(hi))
#define SEAM(k) do { if (IN(k) && IN((k) + 1)) xcd_barrier(bar, TIDNOW()); } while (0)

    const int NGW = G * NWAVES;
#define PHASE_IDS const int lane = lane_now(), tid = wave0 * 64 + lane, wave = wave0, gw = vcu * NWAVES + wave; (void)gw; (void)lane

    for (int rep_ = 0; rep_ < REPS(0); ++rep_) { if (rep_) xcd_barrier(bar, TIDNOW());
    if (IN(0) && EN(0)) {
        IDS_NOW;
        PHASE_IDS;
        auto c_in = INP(1); auto cctx_in = INP(3); auto ada_w = INP(4); auto ada_b = INP(5);
        auto diff_lambda = INP(8);
        auto MOD = WSP(float, WS_MOD); auto ROPEC = WSP(float, WS_ROPEC); auto ROPES = WSP(float, WS_ROPES); auto LAMV = WSP(float, WS_LAM);
        if (bid < 2 * 96) {
            const int l = bid / 96, nb = bid % 96;
            LAS float* sl = (LAS float*)(ldsl + wave * 2560);
            LAS float* part = (LAS float*)(ldsl + 32768);
            { float cvv[10];
#pragma unroll
              for (int t = 0; t < 10; ++t) { const int idx = lane + 64 * t; const int r = idx >> 7, kk = idx & 127, k = wave * 128 + kk; cvv[t] = r < 4 ? c_in[r * D + k] : cctx_in[k]; }
#pragma unroll
              for (int t = 0; t < 10; ++t) sl[lane + 64 * t] = cvv[t] / (1.0f + __expf(-cvv[t])); }
            LDS_WAIT(); asm volatile("" ::: "memory");
            float a[5];
#pragma unroll
            for (int r = 0; r < 5; ++r) a[r] = 0.f;
            gcfp wp = ada_w + ((size_t)l * D + wave * 128) * NIN + nb * 64 + lane;
#pragma unroll 32
            for (int kk = 0; kk < 128; ++kk) { const float wv = wp[(size_t)kk * NIN];
#pragma unroll
                for (int r = 0; r < 5; ++r) a[r] += wv * sl[r * 128 + kk]; }
#pragma unroll
            for (int r = 0; r < 5; ++r) part[(wave * 5 + r) * 64 + lane] = a[r];
            __syncthreads();
            for (int idx = tid; idx < 320; idx += NWAVES * 64) { const int r = idx >> 6, cc = idx & 63; float s = ada_b[l * NIN + nb * 64 + cc];
#pragma unroll
                for (int w = 0; w < 8; ++w) s += part[(w * 5 + r) * 64 + cc];
                MOD[((size_t)l * 5 + r) * NIN + nb * 64 + cc] = s; }
            __syncthreads();
        }
        if (bid == G - 1) {
            for (int idx = tid; idx < 1024; idx += NWAVES * 64) { const int pos = idx >> 4, p = idx & 15; const float inv = powf(10000.0f, -(float)p / 16.0f); const float ang = (float)pos * inv;
                ROPEC[idx] = cosf(ang); ROPES[idx] = sinf(ang); }
            if (wave < 2) { gcfp lv = diff_lambda + wave * 256;
                const float s1 = wave_sum(lv[lane] * lv[64 + lane]), s2 = wave_sum(lv[128 + lane] * lv[192 + lane]);
                const float lam_init = 0.8f - 0.6f * expf(-0.3f * (float)wave);
                if (lane == 0) LAMV[wave] = expf(s1) - expf(s2) + lam_init; }
        }
        cvt_range(MISC, ldsl, 0, CVT_P0_END, gw, NGW, wave, lane);
    }
    }
    SEAM(0);
    if (IN(1) && EN(1)) {
        IDS_NOW;
        PHASE_IDS;
        auto x_in = INP(0); auto ctx_in = INP(2); auto norm_g = INP(6);
        auto MOD = WSP(float, WS_MOD); auto X = WSP(float, WS_X); auto H = WSP(bf16, WS_H);
        {
            auto PV = WSP(float, WS_PV);
            for (int idx = bid * (NWAVES * 64) + tid; idx < DEPTH * 5 * D; idx += G * NWAVES * 64) { const int l_ = idx / (5 * D), mr_ = (idx / D) % 5, d_ = idx % D;
                gcfp md_ = MOD + ((size_t)l_ * 5 + mr_) * NIN; gcfp ng_ = norm_g + (size_t)l_ * 4 * D; gfp pv_ = PV + ((size_t)l_ * 5 + mr_) * 4 * D;
                pv_[d_] = md_[2 * D + d_] * ng_[D + d_]; pv_[D + d_] = ng_[2 * D + d_] * (1.0f + md_[4 * D + d_]); pv_[2 * D + d_] = md_[5 * D + d_] * ng_[3 * D + d_]; pv_[3 * D + d_] = ng_[d_] * (1.0f + md_[D + d_]); }
        }
        {
            const int RPB = (MTOT + G - 1) / G, r0 = bid * RPB;
            int i = wave; bool have = (i < RPB && r0 + i < MTOT); f32x4 xn[4], A2[4]; int mrc = -1;
#define P1SRC(r_) ((r_) < MLAT ? x_in + (size_t)(r_) * D : ctx_in + (size_t)((r_) - MLAT) * D)
            if (have) ld_row(P1SRC(r0 + i), lane, xn);
            while (have) {
                const int r = r0 + i; f32x4 xv[4], hv[4];
#pragma unroll
                for (int j = 0; j < 4; ++j) xv[j] = xn[j];
                const int inx = i + NWAVES; const bool hn = (inx < RPB && r0 + inx < MTOT);
                if (hn) ld_row(P1SRC(r0 + inx), lane, xn);
                const int mr = r < MLAT ? (r >> 12) : 4;
                gcfp md = MOD + (size_t)mr * NIN; ld_row(md, lane, hv);
                if (mr != mrc) { ld_scale(norm_g, md + 1024, lane, A2); mrc = mr; }
                norm_affine_row(xv, A2, lane, hv, H + (size_t)r * D);
                i = inx; have = hn;
            }
#undef P1SRC
        }
    }
    SEAM(1);

    for (int l = 0; l < DEPTH; ++l) {
        const int pb = 2 + 8 * l; const bool lastl = (l == DEPTH - 1);
        const int ML = lastl ? MLAT : MTOT;
        unsigned* cntg = ctl + CW_CNT + l * 32 * 64;
        for (int rep_ = 0; rep_ < (l == 0 ? REPS(2) : 1); ++rep_) { if (rep_) xcd_barrier(bar, TIDNOW());
        if (IN(pb + 0) && EN(2)) {
            IDS_NOW;
            auto H = WSP(bf16, WS_H); auto WIN = WSP(bf16, WS_WIN);
            pg8::Gemm g{(const bf16*)H, (const bf16*)(WIN + (size_t)l * NIN * D), MTOT, NIN, D}; pg8::StaticOrder S; S.init(MTOT, NIN, G, bid);
            EpiInproj E{MISC, l};
            { const int c0s = (MTOT / 256) * (NIN / 256) - ((MTOT / 256) * (NIN / 256) / G) * G;
              if (c0s > 0 && bid >= c0s) { const int nsl = INPROJ_STAGGER * (1 + (bid - c0s) % 3); for (int i_ = 0; i_ < nsl; ++i_) __builtin_amdgcn_s_sleep(64); } }
            pg8::gemm_phase<EpiInproj, pg8::StaticOrder, false>(ldsl, g, S, E, wave0);
            { const int nfull = (MTOT / 256) * (NIN / 256) / G, c0 = (MTOT / 256) * (NIN / 256) - nfull * G;
              if (c0 > 0 && bid >= c0) { const int tc = TIDNOW(); const int wv = wave0;
                  cvt_range(MISC, ldsl, l == 0 ? CVT_P0_END : CVT_T4_END, l == 0 ? CVT_T1_END : CVT_END, (bid - c0) * NWAVES + wv, (G - c0) * NWAVES, wv, tc & 63); } }
        }
        }
        SEAM(pb + 0);
        for (int rep_ = 0; rep_ < (l == 0 ? REPS(3) : 1); ++rep_) { if (rep_) xcd_barrier(bar, TIDNOW());
        if (IN(pb + 1) && EN(3)) {
            IDS_NOW;
            auto diff_subln = INP(9); auto sink = INP(11); auto LAMV = WSP(float, WS_LAM);
            auto QA = WSP(bf16, WS_QA); auto QB = WSP(bf16, WS_QB); auto QC = WSP(bf16, WS_QC);
            auto KA = WSP(bf16, WS_KA); auto VA = WSP(bf16, WS_VA); auto KB = WSP(bf16, WS_KB); auto VB = WSP(bf16, WS_VB); auto KC = WSP(bf16, WS_KC); auto VC = WSP(bf16, WS_VC);
            auto YS = WSP(bf16, WS_YS);
            const int NU = lastl ? 1536 : 1632;
            const float lam = LAMV[l]; const float post = 1.0f - (0.8f - 0.6f * expf(-0.3f * (float)l));
            {
                for (int rp_ = 0; rp_ < ((A128DUP && l == 0) ? 2 : 1); ++rp_)
                for (int pr = vcu; pr < 256; pr += G) {
                    const int b = pr >> 6, hh = (pr >> 4) & 3, q0 = b * SEQ + (pr & 15) * 256;
                    const size_t kv0 = (size_t)b * KVR * 512 + hh * 128;
                    for (int mp = 0; mp < 2; ++mp) {
                        __syncthreads();
                        att128::attn_unit<8>((const att64::bf16*)(const bf16*)(QA + (size_t)q0 * 512 + hh * 128 + mp * 64), 512, (const att64::bf16*)(const bf16*)(KA + kv0 + mp * 64), (const att64::bf16*)(const bf16*)(VA + kv0), 512, 68, mp,
                                             lam, diff_subln + l * 128, post, (att64::bf16*)(bf16*)(YS + (size_t)q0 * 512 + hh * 128), 512, (char*)lds, wave0);
                    }
                }
            }
            for (int i = 0;; ++i) {
                const int L = 512 + i * G + vcu; if (L >= NU) break;
                int type, b, hh, qb, qrow; bool isctx;
                if (L < 1536) { type = L / 512; const int idx = L % 512; b = idx >> 7; hh = (idx >> 5) & 3; qb = idx & 31; qrow = b * SEQ + qb * 128; isctx = false; }
                else { const int e = L - 1536; type = e / 32; const int idx = e % 32; b = idx >> 3; hh = (idx >> 1) & 3; qb = idx & 1; qrow = MLAT + b * CTXL + qb * 128; isctx = true; }
                if (type != 0) {
                    __syncthreads();
                    const int idx = isctx ? (L - 1536) % 32 : L % 512;
                    if (type == 1) {
                        const int b1 = isctx ? idx >> 3 : idx >> 7, head = isctx ? idx & 7 : (idx >> 4) & 7, q0 = isctx ? MLAT + b1 * CTXL : b1 * SEQ + (idx & 15) * 256;
                        const size_t kv0 = ((size_t)b1 * KVR + (isctx ? SEQ : 0)) * 128 + (head >> 2) * 64; const int nt = isctx ? 4 : 68;
                        att64::attn_unit<8, false, false>((const att64::bf16*)(const bf16*)(QB + (size_t)q0 * 512 + head * 64), 512, (const att64::bf16*)(const bf16*)(KB + kv0), (const att64::bf16*)(const bf16*)(VB + kv0), 128, nt, nt, 0, 0, 0, 0, 0.f, 0.f,
                                                         (att64::bf16*)(bf16*)(YS + (size_t)MTOT * 512 + (size_t)q0 * 512 + head * 64), 512, (char*)lds, wave0);
                    } else {
                        const int b1 = isctx ? idx >> 3 : idx >> 7, hp = isctx ? (idx >> 1) & 3 : (idx >> 5) & 3, qbl = isctx ? idx & 1 : idx & 31;
                        const int head = 2 * hp, q0 = isctx ? MLAT + b1 * CTXL + qbl * 128 : b1 * SEQ + qbl * 128;
                        const size_t kv0 = ((size_t)b1 * KVR + SEQ) * 128 + (head >> 2) * 64; const float sl2a = sink[l * 8 + head] * 1.4426950408889634f, sl2b = sink[l * 8 + head + 1] * 1.4426950408889634f;
                        const att64::bf16* qp_ = (const att64::bf16*)(const bf16*)(QC + (size_t)q0 * 512 + head * 64); att64::bf16* op_ = (att64::bf16*)(bf16*)(YS + (size_t)2 * MTOT * 512 + (size_t)q0 * 512 + head * 64);
                        if (isctx) att64::attn_unit<8, false, true>(qp_, 512, (const att64::bf16*)(const bf16*)(KC + kv0), (const att64::bf16*)(const bf16*)(VC + kv0), 128, 4, 4, 0, 0, 0, 1, sl2a, sl2b, op_, 512, (char*)lds, wave0);
                        else { const int qpos = qbl * 128; const int klo = qpos - 128 < 0 ? 0 : qpos - 128, khi = qpos + 256 > SEQ ? SEQ : qpos + 256; const int n2 = (khi - klo) / 64;
                            att64::attn_unit<8, true, true>(qp_, 512, (const att64::bf16*)(const bf16*)(KC + kv0), (const att64::bf16*)(const bf16*)(VC + kv0), 128, 4 + n2, 4, klo - SEQ, klo, qpos, 1, sl2a, sl2b, op_, 512, (char*)lds, wave0); }
                    }
                    continue;
                }
                att::UnitArgs A;
                A.s1 = isctx ? SEQ : 0; A.n1 = isctx ? 4 : 68; A.s2 = 0; A.n2 = 0; A.qpos0 = -1; A.use_sink = 0; A.sink0 = 0.f; A.sink1 = 0.f; A.lam = lam; A.post = post; A.subg = diff_subln + l * 128;
                {
                    A.Q = QA + (size_t)qrow * 512 + hh * 128; A.qg1 = 64; A.K = KA + (size_t)b * KVR * 512 + hh * 128; A.V = VA + (size_t)b * KVR * 512 + hh * 128; A.ldk = 512;
                    A.O = YS + (size_t)qrow * 512 + hh * 128; A.og1 = 0;
                    att::attn_unit<true, false>(A, (char*)lds, wave0);
                }
            }
        }
        }
        SEAM(pb + 1);
        for (int rep_ = 0; rep_ < (l == 0 ? REPS(4) : 1); ++rep_) { if (rep_) xcd_barrier(bar, TIDNOW());
        if (IN(pb + 2) && EN(4)) {
            IDS_NOW;
            auto YS = WSP(bf16, WS_YS); auto WB = WSP(bf16, WS_WB);
            pg8::Gemm g{(const bf16*)YS, (const bf16*)(WB + (size_t)l * 3 * D * 512), 3 * MTOT, 3 * D, 512}; MergeOrder S{(ML / 256) * 4, G, vcu};
            EpiMerge E{MISC};
            pg8::gemm_phase<EpiMerge, MergeOrder, false>(ldsl, g, S, E, wave0);
            { const int c0 = (ML / 256) * 4 - G;
              if (l == 0 && c0 > 0 && c0 < G && vcu >= c0) { const int tc = TIDNOW(); const int wv = wave0;
                  cvt_range(MISC, ldsl, CVT_T1_END, CVT_T3_END, (vcu - c0) * NWAVES + wv, (G - c0) * NWAVES, wv, tc & 63); } }
        }
        }
        SEAM(pb + 2);
        for (int rep_ = 0; rep_ < (l == 0 ? REPS(5) : 1); ++rep_) { if (rep_) xcd_barrier(bar, TIDNOW());
        if (IN(pb + 3) && EN(5)) {
            IDS_NOW;
            auto MG = WSP(bf16, WS_MG); auto WO = WSP(bf16, WS_WO);
            pg8::Gemm g{(const bf16*)MG, (const bf16*)(WO + (size_t)l * D * D), ML, D, D}; pg8::StaticOrder S; S.init(ML, D, G, bid);
            EpiOut E{MISC};
            pg8::gemm_phase<EpiOut, pg8::StaticOrder, false>(ldsl, g, S, E, wave0);
            { const int c0 = (ML / 256) * 4 - G;
              if (l == 0 && c0 > 0 && c0 < G && bid >= c0) { const int tc = TIDNOW(); const int wv = wave0;
                  cvt_range(MISC, ldsl, CVT_T3_END, CVT_T5_END, (bid - c0) * NWAVES + wv, (G - c0) * NWAVES, wv, tc & 63); } }
        }
        }
        SEAM(pb + 3);
        if (IN(pb + 4) && EN(6)) {
            IDS_NOW;
            PHASE_IDS;
            auto norm_g = INP(6); auto router_w = INP(14); auto router_b = INP(15);
            gcfp ng = norm_g + (size_t)l * 4 * D; auto modl = WSP(float, WS_MOD) + (size_t)l * 5 * NIN;
            auto Y = WSP(bf16, WS_Y); auto X = WSP(float, WS_X); auto H2 = WSP(bf16, WS_H2); auto x_in0 = INP(0); auto ctx_in0 = INP(2);
            auto SE = WSP(int, WS_SE); auto SR = WSP(int, WS_SR); auto SW = WSP(float, WS_SW); auto LIST = WSP(int, WS_LIST);
            LAS f32x4* rwL = (LAS f32x4*)ldsl;
            gcfp rw = router_w + (size_t)l * D * NE;
            {
                f32x4 tw[16];
#pragma unroll
                for (int k = 0; k < 16; ++k) { const int idx = tid + k * (NWAVES * 64); const int d = idx >> 3, q = idx & 7; tw[k] = *(const GAS f32x4*)(rw + (size_t)d * NE + q * 4); }
#pragma unroll
                for (int k = 0; k < 16; ++k) { const int idx = tid + k * (NWAVES * 64); const int d = idx >> 3, q = idx & 7; const int rowp = (d & 3) * 256 + (d >> 2);
                    rwL[rowp * 8 + (q ^ ((rowp >> 1) & 7))] = tw[k]; }
            }
            volatile LAS unsigned* hist = MISC + MW_HIST; volatile LAS unsigned* gbase = MISC + MW_BASE; volatile LAS unsigned* slotw = MISC + MW_SLOT + wave * (9 * 4 * 3);
            if (tid < NE) hist[tid] = 0u;
            __syncthreads();
            const int RPB = (ML + G - 1) / G; const int r0 = bid * RPB;
            int nti = 0;
#if TOKPROBE & 1
            for (int rep1 = (l == 0) ? 0 : 1; rep1 < 2; ++rep1) { const bool dry1 = rep1 == 0; gfp Xo = dry1 ? (gfp)WSP(float, WS_TMP) : (gfp)X; gbp H2o = dry1 ? (gbp)WSP(bf16, WS_ACT) : (gbp)H2; nti = 0;
#else
            { gfp Xo = (gfp)X; gbp H2o = (gbp)H2; constexpr bool dry1 = false;
#endif
            {
            int i = wave; bool have = (i < RPB && r0 + i < ML);
            u32x2 yn[4]; auto PVl = WSP(float, WS_PV) + (size_t)l * 5 * 4 * D;
#define YLD(r_) do { _Pragma("unroll") for (int j = 0; j < 4; ++j) yn[j] = *(const GAS u32x2*)(Y + (size_t)(r_) * D + 4 * lane + 256 * j); } while (0)
#define XSRC(r_) (l == 0 ? ((r_) < MLAT ? x_in0 + (size_t)(r_) * D : ctx_in0 + (size_t)((r_) - MLAT) * D) : (gcfp)(X + (size_t)(r_) * D))
            if (have) { YLD(r0 + i); }
            while (have) {
                const int r = r0 + i; const int mr = r < MLAT ? (r >> 12) : 4;
                gcfp md = modl + (size_t)mr * NIN; gcfp pv = PVl + (size_t)mr * 4 * D; f32x4 yv[4], xv[4], hv[4], A1[4], A2[4];
                ld_row(XSRC(r), lane, xv); ld_row(pv, lane, A1); ld_row(pv + D, lane, A2); ld_row(md + 3 * D, lane, hv);

#pragma unroll
                for (int j = 0; j < 4; ++j) yv[j] = (f32x4){bflo(yn[j].x), bfhi(yn[j].x), bflo(yn[j].y), bfhi(yn[j].y)};
                const int inx = i + NWAVES; const bool hn = (inx < RPB && r0 + inx < ML);
                if (hn) { YLD(r0 + inx); }
                const float rny = __builtin_amdgcn_rsqf(sumsq_row(yv) * (1.0f / D) + EPS);
#pragma unroll
                for (int j = 0; j < 4; ++j) { const int c = 4 * lane + 256 * j; xv[j] = xv[j] + A1[j] * (yv[j] * rny); *(GAS f32x4*)(Xo + (size_t)r * D + c) = xv[j]; }
                if (l >= MOE_F8_FROM) norm_affine_row<true>(xv, A2, lane, hv, (gbp)((GAS unsigned char*)H2o + (size_t)r * D));
                else norm_affine_row<false>(xv, A2, lane, hv, H2o + (size_t)r * D);
                float a[32];
#pragma unroll
                for (int q = 0; q < 32; ++q) a[q] = 0.f;
                const int sw = (lane >> 1) & 7;
                {
                    f32x4 wA[8], wB[8];
#define RW_LD(W, blk) do { const int rowp_ = ((blk) & 3) * 256 + 64 * ((blk) >> 2) + lane; _Pragma("unroll") for (int q = 0; q < 8; ++q) W[q] = rwL[rowp_ * 8 + (q ^ sw)]; } while (0)
#define RW_FMA(W, blk) do { const float hval_ = hv[(blk) >> 2][(blk) & 3]; _Pragma("unroll") for (int q = 0; q < 8; ++q) { a[4 * q + 0] += hval_ * W[q][0]; a[4 * q + 1] += hval_ * W[q][1]; a[4 * q + 2] += hval_ * W[q][2]; a[4 * q + 3] += hval_ * W[q][3]; } } while (0)
                    RW_LD(wA, 0);
#pragma unroll
                    for (int blk = 0; blk < 16; blk += 2) { RW_LD(wB, blk + 1); RW_FMA(wA, blk); __builtin_amdgcn_sched_barrier(0); if (blk + 2 < 16) RW_LD(wA, blk + 2); RW_FMA(wB, blk + 1); __builtin_amdgcn_sched_barrier(0); }
#undef RW_LD
#undef RW_FMA
                }
#define RS(N, MASK) do { const bool up = (lane & (MASK)) != 0; _Pragma("unroll") for (int q = 0; q < (N) / 2; ++q) { const float keep = up ? a[(N) / 2 + q] : a[q]; const float send = up ? a[q] : a[(N) / 2 + q]; a[q] = keep + __shfl_xor(send, (MASK)); } } while (0)
                RS(32, 32); RS(16, 16); RS(8, 8); RS(4, 4); RS(2, 2);
#undef RS
                const int myE = (lane >> 1) & 31;
                float val = a[0] + dppf<0xB1>(a[0]) + router_b[l * NE + myE];
                float tv[4]; int te[4];
#define BETTER(ov, oe, bv, be) ((ov) > (bv) || ((ov) == (bv) && (oe) < (be)))
#define TSTEP(CTRL) do { const float ov = dppf<CTRL>(bv); const int oe = dppi<CTRL>(be); if (BETTER(ov, oe, bv, be)) { bv = ov; be = oe; } } while (0)
#pragma unroll
                for (int k = 0; k < 4; ++k) { float bv = val; int be = myE;
                    TSTEP(0x4E); TSTEP(0x141); TSTEP(0x140);
                    float v0 = rdl(bv, 0), v1 = rdl(bv, 16), v2 = rdl(bv, 32), v3 = rdl(bv, 48);
                    int e0 = __builtin_amdgcn_readlane(be, 0), e1 = __builtin_amdgcn_readlane(be, 16), e2 = __builtin_amdgcn_readlane(be, 32), e3 = __builtin_amdgcn_readlane(be, 48);
                    if (BETTER(v1, e1, v0, e0)) { v0 = v1; e0 = e1; } if (BETTER(v3, e3, v2, e2)) { v2 = v3; e2 = e3; } if (BETTER(v2, e2, v0, e0)) { v0 = v2; e0 = e2; }
                    tv[k] = v0; te[k] = e0; if (myE == e0) val = -INFINITY; }
#undef TSTEP
#undef BETTER
                const float e1 = __expf(tv[1] - tv[0]), e2 = __expf(tv[2] - tv[0]), e3 = __expf(tv[3] - tv[0]); const float inv = 1.0f / (1.0f + e1 + e2 + e3);
                if (lane < 4) { const int ek = lane == 0 ? te[0] : lane == 1 ? te[1] : lane == 2 ? te[2] : te[3]; const float wk = (lane == 0 ? 1.0f : lane == 1 ? e1 : lane == 2 ? e2 : e3) * inv;
                    const unsigned lr = __hip_atomic_fetch_add((LAS unsigned*)((dry1 ? gbase : hist) + ek), 1u, __ATOMIC_RELAXED, __HIP_MEMORY_SCOPE_WORKGROUP);
                    slotw[(nti * 4 + lane) * 3 + 0] = (unsigned)ek; slotw[(nti * 4 + lane) * 3 + 1] = lr; slotw[(nti * 4 + lane) * 3 + 2] = __builtin_bit_cast(unsigned, wk); }
                i = inx; have = hn; ++nti;
            }
            }
            }
            __syncthreads();
            if (tid < NE) { const unsigned hcount = hist[tid]; gbase[tid] = hcount ? __hip_atomic_fetch_add(cntg + tid * 64, hcount, __ATOMIC_RELAXED, __HIP_MEMORY_SCOPE_AGENT) : 0u; }
            __syncthreads();
            nti = 0;
            for (int i = wave; i < RPB && r0 + i < ML; i += NWAVES, ++nti) {
                const int r = r0 + i;
                if (lane < 4) { const unsigned ek = slotw[(nti * 4 + lane) * 3 + 0], lr = slotw[(nti * 4 + lane) * 3 + 1], wkb = slotw[(nti * 4 + lane) * 3 + 2];
                    const unsigned rank = gbase[ek] + lr;
                    LIST[(size_t)ek * MTOT + rank] = r; SE[r * 4 + lane] = (int)ek; SR[r * 4 + lane] = (int)rank; SW[r * 4 + lane] = __builtin_bit_cast(float, wkb); }
            }
            __syncthreads();
        }
        SEAM(pb + 4);
        LAS int* tb = (LAS int*)(ldsl + MISC_OFF) + MW_TB; LAS int* cn = (LAS int*)(ldsl + MISC_OFF) + MW_CNT;
        if (IN(pb + 5) || IN(pb + 6) || IN(pb + 7)) {
            IDS_NOW;
            __syncthreads();
            const int tid = TIDNOW();
            if (tid < NE) cn[tid] = (int)__hip_atomic_load(cntg + tid * 64, __ATOMIC_RELAXED, __HIP_MEMORY_SCOPE_AGENT);
            __syncthreads();
            if (tid == 0) { int accu = 0; for (int e = 0; e < NE; ++e) { tb[e] = accu; accu += (cn[e] + 255) >> 8; } tb[NE] = accu; }
            __syncthreads();
        }
        for (int rep_ = 0; rep_ < (l == 0 ? REPS(7) : 1); ++rep_) { if (rep_) xcd_barrier(bar, TIDNOW());
        if (IN(pb + 5) && EN(7)) {
            IDS_NOW;
            auto H2 = WSP(bf16, WS_H2); auto W1 = WSP(bf16, WS_W1); auto LIST = WSP(int, WS_LIST);
            MoeOrder<8> S; S.init(tb, cn, LIST, G, bid);
            if (l >= MOE_F8_FROM) { pg8::Gemm g{(const bf16*)H2, (const bf16*)(W1 + (size_t)l * NE * 2048 * D), MTOT, NE * 2048, D / 2}; EpiSwiglu<true> E{MISC, l};
                pg8::gemm_phase<EpiSwiglu<true>, MoeOrder<8>, true, true>(ldsl, g, S, E, wave0); }
            else { pg8::Gemm g{(const bf16*)H2, (const bf16*)(W1 + (size_t)l * NE * 2048 * D), MTOT, NE * 2048, D}; EpiSwiglu<false> E{MISC, l};
                pg8::gemm_phase<EpiSwiglu<false>, MoeOrder<8>, true, false>(ldsl, g, S, E, wave0); }
            if (l == 0 && CVT_SH5 > 0) {
                const int nfull = S.chunk / S.per, rem = S.chunk - nfull * S.per, lc = S.vcu % S.per, xg = S.vcu / S.per, nidle = S.per - rem, ngrp = S.vcu == S.bid && S.per == G ? 1 : 8;
                const int tc = TIDNOW(); const int wv = wave0;
                if (rem == 0) cvt_range(MISC, ldsl, CVT_T5_END, CVT_T4_END, S.vcu * NWAVES + wv, G * NWAVES, wv, tc & 63);
                else if (lc >= rem) cvt_range(MISC, ldsl, CVT_T5_END, CVT_T4_END, (xg * nidle + (lc - rem)) * NWAVES + wv, ngrp * nidle * NWAVES, wv, tc & 63);
            }
        }
        }
        SEAM(pb + 5);
        for (int rep_ = 0; rep_ < (l == 0 ? REPS(8) : 1); ++rep_) { if (rep_) xcd_barrier(bar, TIDNOW());
        if (IN(pb + 6) && EN(8)) {
            IDS_NOW;
            auto ACT = WSP(bf16, WS_ACT); auto W2 = WSP(bf16, WS_W2); auto LIST = WSP(int, WS_LIST);
            MoeOrder<4> S; S.init(tb, cn, LIST, G, bid);
            if (l >= MOE_F8_FROM) { pg8::Gemm g{(const bf16*)ACT, (const bf16*)(W2 + (size_t)l * NE * D * D), MAXTILES * 256, NE * D, D / 2}; EpiMoe2<true> E{MISC, l};
                pg8::gemm_phase<EpiMoe2<true>, MoeOrder<4>, false, true>(ldsl, g, S, E, wave0); }
            else { pg8::Gemm g{(const bf16*)ACT, (const bf16*)(W2 + (size_t)l * NE * D * D), MAXTILES * 256, NE * D, D}; EpiMoe2<false> E{MISC, l};
                pg8::gemm_phase<EpiMoe2<false>, MoeOrder<4>, false, false>(ldsl, g, S, E, wave0); }
        }
        }
        SEAM(pb + 6);
        if (IN(pb + 7) && EN(9)) {
            IDS_NOW;
            PHASE_IDS;
            auto norm_g = INP(6); gcfp ng = norm_g + (size_t)l * 4 * D; auto MOD = WSP(float, WS_MOD); gcfp modl = MOD + (size_t)l * 5 * NIN;
            auto X = WSP(float, WS_X); auto H = WSP(bf16, WS_H); auto YS2 = WSP(bf16, WS_YS2); gfp outp = (gfp)ldp(MISC, 20);
            auto SE = WSP(int, WS_SE); auto SR = WSP(int, WS_SR); auto SW = WSP(float, WS_SW);
            for (int rep2 = ((TOKPROBE & 2) && l == 0) ? 0 : 1; rep2 < 2; ++rep2) { const bool dry2 = rep2 == 0; gfp Xo = dry2 ? (gfp)WSP(float, WS_TMP) : (gfp)X; gbp Ho = dry2 ? (gbp)WSP(bf16, WS_MG) : (gbp)H;
            for (int rb = gw; rb < ML; rb += 16 * NGW) {
                const int myr = rb + (lane >> 2) * NGW; const bool vld = myr < ML;
                const int se = vld ? SE[myr * 4 + (lane & 3)] : 0, sr = vld ? SR[myr * 4 + (lane & 3)] : 0; const float swt = vld ? SW[myr * 4 + (lane & 3)] : 0.f;
                const int yrow = tb[se] * 256 + sr;
                u32x2 yn[4][4]; f32x4 xn[4];
#define T2_LOAD(ri_) do { const int r_ = rb + (ri_) * NGW; _Pragma("unroll") for (int k = 0; k < 4; ++k) { const int yr_ = __builtin_amdgcn_readlane(yrow, (ri_) * 4 + k); gcbp yp = YS2 + (size_t)yr_ * D; \
                    _Pragma("unroll") for (int j = 0; j < 4; ++j) yn[k][j] = *(const GAS u32x2*)(yp + 4 * lane + 256 * j); } ld_row(X + (size_t)r_ * D, lane, xn); } while (0)
                int ri = 0;
                if (rb < ML) T2_LOAD(0);
                while (ri < 16 && rb + ri * NGW < ML) {
                    const int r = rb + ri * NGW; const int mr = r < MLAT ? (r >> 12) : 4; gcfp md = modl + (size_t)mr * NIN;
                    f32x4 yv[4], xv[4];
#pragma unroll
                    for (int j = 0; j < 4; ++j) { yv[j] = (f32x4){0.f, 0.f, 0.f, 0.f}; xv[j] = xn[j]; }
#pragma unroll
                    for (int k = 0; k < 4; ++k) { const float wk = rdl(swt, ri * 4 + k);
#pragma unroll
                        for (int j = 0; j < 4; ++j) { const u32x2 w = yn[k][j]; yv[j][0] += wk * bflo(w.x); yv[j][1] += wk * bfhi(w.x); yv[j][2] += wk * bflo(w.y); yv[j][3] += wk * bfhi(w.y); } }
                    if (ri + 1 < 16 && rb + (ri + 1) * NGW < ML) T2_LOAD(ri + 1);
                    const float rny = 1.0f / sqrtf(sumsq_row(yv) * (1.0f / D) + EPS);
#pragma unroll
                    for (int j = 0; j < 4; ++j) { const int c = 4 * lane + 256 * j; const f32x4 g3 = *(const GAS f32x4*)(ng + 3 * D + c), gf = *(const GAS f32x4*)(md + 5 * D + c);
                        xv[j] = xv[j] + gf * ((yv[j] * rny) * g3);
                        if (lastl) *(GAS f32x4*)(outp + (size_t)r * D + c) = xv[j]; else *(GAS f32x4*)(Xo + (size_t)r * D + c) = xv[j]; }
                    if (!lastl) { f32x4 hv[4]; gcfp mdn = MOD + ((size_t)(l + 1) * 5 + mr) * NIN;
                        norm_mod_row(xv, norm_g + (size_t)(l + 1) * 4 * D, mdn + 1024, mdn, lane, hv, Ho + (size_t)r * D); }
                    ++ri;
                }
#undef T2_LOAD
            }
            if (dry2) { asm volatile("s_waitcnt vmcnt(0)" ::: "memory"); __syncthreads(); } }
        }
        if (!lastl) SEAM(pb + 7);
    }
#undef IN
#undef SEAM
}

constexpr int N_PHASES = 2 + 8 * DEPTH;
#ifndef MK_CUTS
#define MK_CUTS 0
#endif
extern "C" void kernel_launch(void* const* d_in, const int* in_sizes, int n_in, void* d_out, int out_size, void* d_ws, size_t ws_size, hipStream_t stream) {
    static int grid = 0;
    if (grid == 0) {
        if (n_in != 20 || out_size != MLAT * D || ws_size < WS_END) { fprintf(stderr, "kernel_launch: unexpected shapes (n_in %d out %d ws %zu need %zu)\n", n_in, out_size, ws_size, (size_t)WS_END); grid = -1; return; }
        int dev = 0, cus = 0, per_cu = 0;
        if (hipGetDevice(&dev) != hipSuccess || hipDeviceGetAttribute(&cus, hipDeviceAttributeMultiprocessorCount, dev) != hipSuccess) { grid = -1; return; }
        if (hipFuncSetAttribute((const void*)mk_fwd, hipFuncAttributeMaxDynamicSharedMemorySize, LDS_BYTES) != hipSuccess) { fprintf(stderr, "kernel_launch: hipFuncSetAttribute failed\n"); grid = -1; return; }
        if (hipOccupancyMaxActiveBlocksPerMultiprocessor(&per_cu, (const void*)mk_fwd, NWAVES * 64, LDS_BYTES) != hipSuccess || per_cu < 1) { fprintf(stderr, "kernel_launch: occupancy query reports %d\n", per_cu); }
        (void)hipGetLastError();
        grid = cus;
    }
    if (grid < 0) return;
    if (hipMemsetAsync((char*)d_ws + WS_CTL, 0, CTL_BYTES, stream) != hipSuccess) return;
    Args a{};
    for (int i = 0; i < 20; ++i) a.in[i] = (const float*)d_in[i];
    a.out = (float*)d_out; a.ws = (unsigned char*)d_ws;
#if MK_CUTS
    for (int p = 0; p < N_PHASES; ++p) { a.ph_lo = p; a.ph_hi = p + 1; hipLaunchKernelGGL(mk_fwd, dim3(grid), dim3(NWAVES * 64), LDS_BYTES, stream, a); }
#else
    a.ph_lo = 0; a.ph_hi = N_PHASES;
    hipLaunchKernelGGL(mk_fwd, dim3(grid), dim3(NWAVES * 64), LDS_BYTES, stream, a);
#endif
    const hipError_t le = hipPeekAtLastError();
    if (le != hipSuccess) fprintf(stderr, "kernel_launch: launch failed: %s\n", hipGetErrorName(le));
}
```

```cpp
#define CVT_SH1 26
#define CVT_SH2 38
#define CVT_SH4 12
#include <hip/hip_runtime.h>
#include <cstdio>
#include <cstdint>

#define LAS __attribute__((address_space(3)))
#define GAS __attribute__((address_space(1)))

__device__ __forceinline__ int lane_now() { int l = (int)__builtin_amdgcn_mbcnt_hi(~0u, __builtin_amdgcn_mbcnt_lo(~0u, 0u)); asm volatile("" : "+v"(l)); return l; }

namespace pg8 {
#define PG8_LAS __attribute__((address_space(3)))
typedef unsigned short bf16_t;
typedef short bf16x8 __attribute__((ext_vector_type(8)));
typedef float f32x4 __attribute__((ext_vector_type(4)));
typedef float f32x2 __attribute__((ext_vector_type(2)));
typedef unsigned u32x4 __attribute__((ext_vector_type(4)));
typedef unsigned u32x2 __attribute__((ext_vector_type(2)));
constexpr int BM = 256, BK = 64, HALF = 128, HTB = HALF * BK * 2  , STAGE_BYTES = 8 * HTB, NXCD = 8, WGM = 8;

__host__ __device__ __forceinline__ int lds_byte(int r, int c) { const int st = (r >> 4) * 2 + (c >> 5), rr = r & 15, cc = c & 31, ob = rr * 64 + cc * 2; return st * 1024 + (ob ^ (((ob >> 9) & 1) << 5)); }
__host__ __device__ __forceinline__ void stage_rc(int b, int& R, int& C) { const int st = b / 1024, sb = b % 1024, swz = sb ^ (((sb >> 9) & 1) << 5); R = (st >> 1) * 16 + swz / 64; C = (st & 1) * 32 + (swz % 64) / 2; }
__host__ __device__ __forceinline__ int perm32(int rho) { const int n = rho >> 4, i = rho & 15; return 8 * (i >> 2) + 4 * n + (i & 3); }

struct Unit { int pm, pn; };
struct Gemm { const bf16_t* A; const bf16_t* Bt; int M, N, K; };

struct StaticOrder {
    int nM, nN, nwg, G, c;
    __host__ __device__ void init(int M, int N, int G_, int c_) { nM = M / BM; nN = N / BM; nwg = nM * nN; G = G_; c = c_; }
    __host__ __device__ bool next(int i, Unit& u) const {
        const long L = (long)i * G + c; if (L >= nwg) return false;
        int wgid = (int)L; { const int q = nwg / NXCD, r = nwg % NXCD, xcd = wgid % NXCD, off = wgid / NXCD; wgid = (xcd < r ? xcd * (q + 1) : r * (q + 1) + (xcd - r) * q) + off; }
        const int nig = WGM * nN, gid = wgid / nig, fm = gid * WGM, gsz = (nM - fm) < WGM ? (nM - fm) : WGM;
        u.pm = fm + ((wgid % nig) % gsz); u.pn = (wgid % nig) / gsz; return true;
    }
    __device__ __forceinline__ unsigned a_row(const Unit&, int) const { return 0u; }
};

__device__ __forceinline__ unsigned cvt_pk_bf16(float lo, float hi) { unsigned r; asm volatile("v_cvt_pk_bf16_f32 %0, %1, %2" : "=v"(r) : "v"(lo), "v"(hi)); return r; }

typedef int v8i32 __attribute__((ext_vector_type(8)));
typedef int v4i32 __attribute__((ext_vector_type(4)));
__device__ __forceinline__ v8i32 cat8(bf16x8 lo, bf16x8 hi) { const v4i32 a = __builtin_bit_cast(v4i32, lo), b = __builtin_bit_cast(v4i32, hi); return (v8i32){a[0], a[1], a[2], a[3], b[0], b[1], b[2], b[3]}; }
__device__ __forceinline__ void mfma_f8(f32x4& acc, v8i32 a, v8i32 b, int sc) {
    asm volatile("v_mfma_scale_f32_16x16x128_f8f6f4 %0, %1, %2, %0, %3, %3 op_sel_hi:[0,0,0]" : "+v"(acc) : "v"(a), "v"(b), "v"(sc)); }
template <class E> struct epi_chain { static constexpr bool v = false; };
template <class E> struct epi_dup { static constexpr int v = 0; };
template <class Epi, class Sched, bool GATHER, bool FP8 = false>
__device__ __forceinline__ void gemm_phase(PG8_LAS unsigned char* lds, const Gemm g, const Sched& S, const Epi& E, const int wave0) {
    const int lane = lane_now(), tid = wave0 * 64 + lane, wid = wave0, wr = wid >> 2, wc = wid & 3, fr = lane & 15, fq = lane >> 4;
    const int K = g.K, nt = K / BK;
    unsigned voffA[2], voffB[2]; int RA[2], CA[2];
#pragma unroll
    for (int i = 0; i < 2; ++i) { int R, C; stage_rc(tid * 16 + i * 8192, R, C); const int Rb = Epi::PERM ? ((R & ~31) + perm32(R & 31)) : R;
        RA[i] = R; CA[i] = C; voffA[i] = (unsigned)(R * K + C) * 2u; voffB[i] = (unsigned)(Rb * K + C) * 2u; }
    const size_t kstep = (size_t)(BK * 2);
    const size_t hstep = (size_t)HALF * K * 2;
    const size_t tstep = 2 * hstep;
    const unsigned ldsw = (unsigned)wid * 1024u;
    const int aoff = lds_byte(wr * 64 + fr, fq * 8), boff = lds_byte(wc * 32 + fr, fq * 8);
#define PG8_SA(b, h) (((b) * 2 + (h)) * HTB)
#define PG8_SB(b, h) ((4 + (b) * 2 + (h)) * HTB)
#define PG8_STAGE2(bufoff, gbase, o0, o1) do { \
        __builtin_amdgcn_global_load_lds((const unsigned*)((const char*)(gbase) + (o0)), (PG8_LAS unsigned*)(lds + (bufoff) + ldsw), 16, 0, 0); \
        __builtin_amdgcn_global_load_lds((const unsigned*)((const char*)(gbase) + (o1)), (PG8_LAS unsigned*)(lds + (bufoff) + ldsw + 8192), 16, 0, 0); } while (0)
#define PG8_STB(bufoff, gbase) PG8_STAGE2(bufoff, gbase, voffB[0], voffB[1])
#define PG8_STA(bufoff, ptr, h, OC) do { if constexpr (GATHER) PG8_STAGE2(bufoff, ptr, OC[h][0], OC[h][1]); else PG8_STAGE2(bufoff, (ptr) + ((h) ? hstep : (size_t)0), voffA[0], voffA[1]); } while (0)
#define PG8_LDA(dst, b, h) do { _Pragma("unroll") for (int m = 0; m < 4; ++m) _Pragma("unroll") for (int k = 0; k < 2; ++k) dst[m][k] = *(const PG8_LAS bf16x8*)(lds + PG8_SA(b, h) + aoff + m * 2048 + k * 1024); } while (0)
#define PG8_LDB(dst, b, h) do { _Pragma("unroll") for (int n = 0; n < 2; ++n) _Pragma("unroll") for (int k = 0; k < 2; ++k) dst[n][k] = *(const PG8_LAS bf16x8*)(lds + PG8_SB(b, h) + boff + n * 2048 + k * 1024); } while (0)
#define PG8_MMA(ai, bj, At, Bt) do { __builtin_amdgcn_s_setprio(1); \
        if constexpr (FP8) { _Pragma("unroll") for (int m = 0; m < 4; ++m) _Pragma("unroll") for (int n = 0; n < 2; ++n) \
            mfma_f8(acc[ai][bj][m][n], cat8(Bt[n][0], Bt[n][1]), cat8(At[m][0], At[m][1]), sc8); } \
        else { _Pragma("unroll") for (int m = 0; m < 4; ++m) _Pragma("unroll") for (int n = 0; n < 2; ++n) _Pragma("unroll") for (int k = 0; k < 2; ++k) \
            acc[ai][bj][m][n] = __builtin_amdgcn_mfma_f32_16x16x32_bf16(Bt[n][k], At[m][k], acc[ai][bj][m][n], 0, 0, 0); } \
        __builtin_amdgcn_s_setprio(0); } while (0)
#define PG8_WAIT_V(n) asm volatile("s_waitcnt vmcnt(" #n ")" ::: "memory")
#define PG8_WAIT_L(n) asm volatile("s_waitcnt lgkmcnt(" #n ")" ::: "memory")
#define PG8_BAR __builtin_amdgcn_s_barrier()
#define PG8_SCHED __builtin_amdgcn_sched_barrier(0)
    Unit cur, nxt; int ui = 0;
    if (!S.next(0, cur)) return;
    f32x4 acc[2][2][4][2];
#pragma unroll
    for (int a = 0; a < 2; ++a)
#pragma unroll
        for (int b = 0; b < 2; ++b)
#pragma unroll
            for (int m = 0; m < 4; ++m)
#pragma unroll
                for (int n = 0; n < 2; ++n) acc[a][b][m][n] = (f32x4){0.f, 0.f, 0.f, 0.f};
    bf16x8 At[4][2], B0[2][2], B1[2][2];
    int sc8 = 0x7f7f7f7f; asm volatile("" : "+v"(sc8));
    unsigned vC[2][2] = {{0u, 0u}, {0u, 0u}}, vN[2][2] = {{0u, 0u}, {0u, 0u}};
    if constexpr (GATHER) {
#pragma unroll
        for (int h = 0; h < 2; ++h)
#pragma unroll
            for (int i = 0; i < 2; ++i) vC[h][i] = (S.a_row(cur, h * HALF + RA[i]) * (unsigned)K + (unsigned)CA[i]) * 2u;
    }
    const char* Ab = (const char*)g.A;
    const char* cA = GATHER ? Ab : Ab + (size_t)cur.pm * tstep; const char* cB = (const char*)g.Bt + (size_t)cur.pn * tstep;
    PG8_STB(PG8_SB(0, 0), cB); PG8_STB(PG8_SB(0, 1), cB + hstep); PG8_STA(PG8_SA(0, 0), cA, 0, vC); PG8_STA(PG8_SA(0, 1), cA, 1, vC);
    if (wr == 1) PG8_BAR;
    PG8_WAIT_V(2); PG8_BAR;
    PG8_STB(PG8_SB(1, 0), cB + kstep); PG8_STA(PG8_SA(1, 0), cA + kstep, 0, vC); PG8_STB(PG8_SB(1, 1), cB + hstep + kstep);
    PG8_WAIT_V(6); PG8_BAR;
    for (;;) {
        const bool has_next = S.next(ui + 1, nxt);
        const char* nA = GATHER ? Ab : (has_next ? Ab + (size_t)nxt.pm * tstep : cA); const char* nB = has_next ? (const char*)g.Bt + (size_t)nxt.pn * tstep : cB;
        if constexpr (GATHER) {
            if (has_next) {
#pragma unroll
                for (int h = 0; h < 2; ++h)
#pragma unroll
                    for (int i = 0; i < 2; ++i) vN[h][i] = (S.a_row(nxt, h * HALF + RA[i]) * (unsigned)K + (unsigned)CA[i]) * 2u;
            } else {
#pragma unroll
                for (int h = 0; h < 2; ++h)
#pragma unroll
                    for (int i = 0; i < 2; ++i) vN[h][i] = vC[h][i];
            }
        }
        for (int t = 0; t < nt; t += 2) {
            const bool last = (t == nt - 2);
            const char* a1 = cA + (size_t)(t + 1) * kstep;
            const char* a2 = last ? nA : cA + (size_t)(t + 2) * kstep; const char* b2 = last ? nB : cB + (size_t)(t + 2) * kstep;
            const char* a3 = a2 + kstep; const char* b3 = b2 + kstep;
            unsigned v2[2][2];
#pragma unroll
            for (int h = 0; h < 2; ++h)
#pragma unroll
                for (int i = 0; i < 2; ++i) v2[h][i] = last ? vN[h][i] : vC[h][i];
            PG8_LDB(B0, 0, 0); PG8_LDB(B1, 0, 1); PG8_SCHED; PG8_LDA(At, 0, 0); PG8_STA(PG8_SA(1, 1), a1, 1, vC);
            PG8_WAIT_V(8); PG8_WAIT_L(0); PG8_BAR; PG8_MMA(0, 0, At, B0); PG8_MMA(0, 1, At, B1); PG8_BAR; PG8_SCHED;
            PG8_LDA(At, 0, 1); PG8_STB(PG8_SB(0, 0), b2); PG8_STB(PG8_SB(0, 1), b2 + hstep); PG8_STA(PG8_SA(0, 0), a2, 0, v2);
            PG8_WAIT_V(8); PG8_WAIT_L(0); PG8_BAR; PG8_MMA(1, 0, At, B0); PG8_MMA(1, 1, At, B1); PG8_BAR; PG8_SCHED;
            PG8_LDB(B0, 1, 0); PG8_LDB(B1, 1, 1); PG8_SCHED; PG8_LDA(At, 1, 0); PG8_STA(PG8_SA(0, 1), a2, 1, v2);
            PG8_WAIT_V(8); PG8_WAIT_L(0); PG8_BAR; PG8_MMA(0, 0, At, B0); PG8_MMA(0, 1, At, B1); PG8_BAR; PG8_SCHED;
            PG8_LDA(At, 1, 1); PG8_STB(PG8_SB(1, 0), b3); PG8_STB(PG8_SB(1, 1), b3 + hstep); PG8_STA(PG8_SA(1, 0), a3, 0, v2);
            PG8_WAIT_V(8); PG8_WAIT_L(0); PG8_BAR; PG8_MMA(1, 0, At, B0); PG8_MMA(1, 1, At, B1); PG8_BAR; PG8_SCHED;
        }
        if (wr == 0) PG8_BAR;
        if constexpr (FP8) {
            asm volatile("s_nop 15\n\ts_nop 15" ::: "memory");
#pragma unroll
            for (int a = 0; a < 2; ++a)
#pragma unroll
                for (int b = 0; b < 2; ++b)
#pragma unroll
                    for (int m = 0; m < 4; ++m)
#pragma unroll
                        for (int n = 0; n < 2; ++n) asm volatile("" : "+v"(acc[a][b][m][n]));
        }
        E(acc, cur, wr, wc, fr, fq);
        if constexpr (epi_dup<Epi>::v) { asm volatile("" ::: "memory"); E(acc, cur, wr, wc, fr, fq); }
        if (!has_next) break;
        bool keep_acc = false; if constexpr (epi_chain<Epi>::v) keep_acc = E.keep(cur);
        if (!keep_acc) {
#pragma unroll
        for (int a = 0; a < 2; ++a)
#pragma unroll
            for (int b = 0; b < 2; ++b)
#pragma unroll
                for (int m = 0; m < 4; ++m)
#pragma unroll
                    for (int n = 0; n < 2; ++n) acc[a][b][m][n] = (f32x4){0.f, 0.f, 0.f, 0.f};
        }
        cur = nxt; cA = nA; cB = nB; ++ui;
        if constexpr (GATHER) {
#pragma unroll
            for (int h = 0; h < 2; ++h)
#pragma unroll
                for (int i = 0; i < 2; ++i) vC[h][i] = vN[h][i];
        }
        if (wr == 1) PG8_BAR;
    }
    PG8_WAIT_V(0);
    PG8_BAR;
#undef PG8_SA
#undef PG8_SB
#undef PG8_STAGE2
#undef PG8_STB
#undef PG8_STA
#undef PG8_LDA
#undef PG8_LDB
#undef PG8_MMA
#undef PG8_WAIT_V
#undef PG8_WAIT_L
#undef PG8_BAR
#undef PG8_SCHED
}
}

namespace att {
typedef unsigned short bf16_t;
using bf16x8 = __attribute__((ext_vector_type(8))) short;
using s16x4  = __attribute__((ext_vector_type(4))) short;
using f32x16 = __attribute__((ext_vector_type(16))) float;
using u32x4  = __attribute__((ext_vector_type(4))) unsigned;
constexpr int NW = 8, QBLK = 32, KVBLK = 64;
constexpr float SCALE = 0.125f;
#ifndef ATT_SGB
#define ATT_SGB 1
#endif
#ifndef ATT_PROBE
#define ATT_PROBE 0
#endif
constexpr float THR = 8.f;
constexpr int SHM_V = KVBLK * 128 * 2, SHM_K = KVBLK * 128 * 2;
constexpr int SHM_ATTN = 2 * SHM_V + 2 * SHM_K + NW * 64 * 4;
#define KSWZ(row, colB) ((row) * 256 + ((colB) ^ (((row) & 7) << 4)))
#define SBAR() __builtin_amdgcn_sched_barrier(0)
#define SGB(mask, n) __builtin_amdgcn_sched_group_barrier((mask), (n), 0)
#define S1_PIPE() do { if (ATT_SGB) { SGB(0x100, 4); _Pragma("unroll") for (int i_ = 0; i_ < 8; ++i_) { SGB(0x008, 1); SGB(0x002, 13); if ((i_ & 1) && i_ < 5) SGB(0x100, 2); } } } while (0)
__device__ __forceinline__ int crow(int r, int hi) { return (r & 3) + 8 * (r >> 2) + 4 * hi; }
typedef float f32x2_a __attribute__((ext_vector_type(2))); typedef __bf16 bf16x2_a __attribute__((ext_vector_type(2)));
__device__ __forceinline__ unsigned cvtpk(float lo, float hi) { const f32x2_a v = {lo, hi}; const bf16x2_a b = __builtin_convertvector(v, bf16x2_a); return __builtin_bit_cast(unsigned, b); }
__device__ __forceinline__ unsigned short f2bf(float f) { return (unsigned short)(cvtpk(f, 0.f) & 0xffffu); }

__device__ __forceinline__ void partialSM(f32x16& p0, f32x16& p1, float& m_reg, float& mn, float& alpha, bool domask, int dq) {
  constexpr float C = SCALE * 1.4426950408889634f;
  if (domask) {
#pragma unroll
    for (int r = 0; r < 16; ++r) { const int d0 = dq + (r & 3) + 8 * (r >> 2), d1 = d0 + 32;
      if (d0 > 128 || d0 < -128) p0[r] = -1e30f; if (d1 > 128 || d1 < -128) p1[r] = -1e30f; }
  }
  float pmax = p0[0];
#pragma unroll
  for (int r = 1; r < 16; ++r) pmax = fmaxf(pmax, p0[r]);
#pragma unroll
  for (int r = 0; r < 16; ++r) pmax = fmaxf(pmax, p1[r]);
  { auto rr = __builtin_amdgcn_permlane32_swap(__float_as_uint(pmax), __float_as_uint(pmax), false, false);
    pmax = fmaxf(__uint_as_float(rr[0]), __uint_as_float(rr[1])); }
  if (__builtin_expect(__all(pmax - m_reg <= THR / SCALE), 1)) { mn = m_reg; alpha = 1.f; }
  else { mn = fmaxf(m_reg, pmax); alpha = __builtin_amdgcn_exp2f((m_reg - mn) * C); m_reg = mn; }
  const float mnC = -mn * C;
#pragma unroll
  for (int r = 0; r < 16; ++r) p0[r] = fmaf(p0[r], C, mnC);
#pragma unroll
  for (int r = 0; r < 16; ++r) p1[r] = fmaf(p1[r], C, mnC);
#pragma unroll
  for (int r = 0; r < 16; ++r) { if (ATT_PROBE == 3) { float x2 = p0[r]; asm volatile("" : "+v"(x2)); p0[r] = 0.5f * (__builtin_amdgcn_exp2f(p0[r]) + __builtin_amdgcn_exp2f(x2)); } else p0[r] = __builtin_amdgcn_exp2f(p0[r]); }
}
__device__ __forceinline__ void finishSM(f32x16& p0, f32x16& p1, float alpha, float& l_reg, bf16x8& pa0, bf16x8& pa1, bf16x8& pa2, bf16x8& pa3, float pscale = 1.0f) {
#pragma unroll
  for (int r = 0; r < 16; ++r) { if (ATT_PROBE == 3) { float x2 = p1[r]; asm volatile("" : "+v"(x2)); p1[r] = 0.5f * (__builtin_amdgcn_exp2f(p1[r]) + __builtin_amdgcn_exp2f(x2)); } else p1[r] = __builtin_amdgcn_exp2f(p1[r]); }
  float ps = 0;
#pragma unroll
  for (int r = 0; r < 16; ++r) ps += p0[r];
#pragma unroll
  for (int r = 0; r < 16; ++r) ps += p1[r];
  { auto rr = __builtin_amdgcn_permlane32_swap(__float_as_uint(ps), __float_as_uint(ps), false, false);
    ps = __uint_as_float(rr[0]) + __uint_as_float(rr[1]); }
  l_reg = l_reg * alpha + ps;
  if (pscale != 1.0f) {
#pragma unroll
    for (int r = 0; r < 16; ++r) { p0[r] *= pscale; p1[r] *= pscale; } }
#define PK4(P, BASE, OUT) do { unsigned a0 = cvtpk(P[BASE + 0], P[BASE + 1]), a1 = cvtpk(P[BASE + 2], P[BASE + 3]);   \
    unsigned b0 = cvtpk(P[BASE + 4], P[BASE + 5]), b1 = cvtpk(P[BASE + 6], P[BASE + 7]);                              \
    auto r0 = __builtin_amdgcn_permlane32_swap(a0, b0, false, false); auto r1 = __builtin_amdgcn_permlane32_swap(a1, b1, false, false); \
    u32x4 w = {r0[0], r1[0], r0[1], r1[1]}; OUT = *reinterpret_cast<bf16x8*>(&w); } while (0)
  PK4(p0, 0, pa0); PK4(p0, 8, pa1); PK4(p1, 0, pa2); PK4(p1, 8, pa3);
#undef PK4
}
__device__ __forceinline__ void qkt(f32x16& p0, f32x16& p1, const char* Ks, const bf16x8* qr, int r32, int hi, int kcolB) {
  p0 = f32x16{}; p1 = f32x16{};
#pragma unroll
  for (int d0 = 0; d0 < 4; ++d0) { const int cb = kcolB + (d0 * 16 + hi * 8) * 2;
    bf16x8 b0 = *reinterpret_cast<const bf16x8*>(Ks + KSWZ(r32, cb));
    bf16x8 b1 = *reinterpret_cast<const bf16x8*>(Ks + KSWZ(32 + r32, cb));
    p0 = __builtin_amdgcn_mfma_f32_32x32x16_bf16(b0, qr[d0], p0, 0, 0, 0);
    p1 = __builtin_amdgcn_mfma_f32_32x32x16_bf16(b1, qr[d0], p1, 0, 0, 0); }
}
__device__ __forceinline__ int v_st(int k, int c) { const int kk = (k & ~0xC) | ((k & 4) << 1) | ((k & 8) >> 1); return ((kk >> 3) * 4 + (c >> 5)) * 512 + ((kk & 7) * 32 + (c & 31)) * 2; }
__device__ __forceinline__ int v_rd_base(int lane) { return ((lane & 3) << 3) | (((lane >> 2) & 3) << 6) | (((lane >> 4) & 1) << 5) | (((lane >> 5) & 1) << 8); }
constexpr int v_rd_off(int d0, int ks, int half) { return d0 * 512 + ks * 4096 + half * 2048; }
template <int OFF> __device__ __forceinline__ s16x4 tr_read(int vb) {
  s16x4 r; asm volatile("ds_read_b64_tr_b16 %0, %1 offset:%2" : "=&v"(r) : "v"(vb), "i"(OFF) : "memory"); return r;
}
template <int D0> __device__ __forceinline__ void pv_one(f32x16& od, int vb, bf16x8 pa0, bf16x8 pa1, bf16x8 pa2, bf16x8 pa3) {
  const s16x4 l0 = tr_read<v_rd_off(D0, 0, 0)>(vb), h0 = tr_read<v_rd_off(D0, 0, 1)>(vb), l1 = tr_read<v_rd_off(D0, 1, 0)>(vb), h1 = tr_read<v_rd_off(D0, 1, 1)>(vb);
  const s16x4 l2 = tr_read<v_rd_off(D0, 2, 0)>(vb), h2 = tr_read<v_rd_off(D0, 2, 1)>(vb), l3 = tr_read<v_rd_off(D0, 3, 0)>(vb), h3 = tr_read<v_rd_off(D0, 3, 1)>(vb);
  asm volatile("s_waitcnt lgkmcnt(0)" ::: "memory"); SBAR();
#define PK(L, H) (bf16x8){L[0], L[1], L[2], L[3], H[0], H[1], H[2], H[3]}
  od = __builtin_amdgcn_mfma_f32_32x32x16_bf16(pa0, PK(l0, h0), od, 0, 0, 0);
  od = __builtin_amdgcn_mfma_f32_32x32x16_bf16(pa1, PK(l1, h1), od, 0, 0, 0);
  od = __builtin_amdgcn_mfma_f32_32x32x16_bf16(pa2, PK(l2, h2), od, 0, 0, 0);
  od = __builtin_amdgcn_mfma_f32_32x32x16_bf16(pa3, PK(l3, h3), od, 0, 0, 0);
#undef PK
}
template <bool DIFF> __device__ __forceinline__ void pv_all(f32x16* o, int vb, bf16x8 pa0, bf16x8 pa1, bf16x8 pa2, bf16x8 pa3) {
  pv_one<0>(o[0], vb, pa0, pa1, pa2, pa3); pv_one<1>(o[1], vb, pa0, pa1, pa2, pa3);
  if constexpr (DIFF) { pv_one<2>(o[2], vb, pa0, pa1, pa2, pa3); pv_one<3>(o[3], vb, pa0, pa1, pa2, pa3); }
}

struct UnitArgs {
  const GAS bf16_t* Q;
  int qg1;
  const GAS bf16_t* K;
  const GAS bf16_t* V;
  int ldk;
  int s1, n1, s2, n2;
  int qpos0;
  float sink0, sink1;
  int use_sink;
  GAS bf16_t* O;
  int og1;
  float lam, post;
  const GAS float* subg;
};

template <bool DIFF, bool MASK>
__device__ __forceinline__ void attn_unit(const UnitArgs& A, char* lds, const int wave0) {
  constexpr int NO = DIFF ? 4 : 2;
  const int lane = lane_now(), tid = wave0 * 64 + lane, wid = wave0, r32 = lane & 31, hi = lane >> 5;
  const int mg = wid >> 2, wq = wid & 3;
  char* V_lds = lds; char* K_lds = lds + 2 * SHM_V;
  float* ws = (float*)(lds + 2 * SHM_V + 2 * SHM_K) + wid * 64; float* li_l = ws; float* al_l = ws + 32;
  float m_reg = -1e30f, l_reg = 0.f;
  if (!DIFF && A.use_sink) { m_reg = (mg ? A.sink1 : A.sink0) * (1.0f / SCALE); l_reg = 1.f; }
  f32x16 o[NO];
#pragma unroll
  for (int d = 0; d < NO; ++d) o[d] = f32x16{};
  bf16x8 qr[4];
  const GAS bf16_t* Qw = A.Q + (mg ? A.qg1 : 0) + (long)(wq * QBLK + r32) * 512 + hi * 8;
#pragma unroll
  for (int d0 = 0; d0 < 4; ++d0) qr[d0] = *(const GAS bf16x8*)(Qw + d0 * 16);
  const int sr = tid >> 4, sc = (tid & 15) * 8, vst0 = v_st(sr, sc), vst1 = v_st(32 + sr, sc);
  const int vb0 = (int)(uintptr_t)V_lds + v_rd_base(lane) + ((!DIFF && mg) ? 1024 : 0);
  const int kcolB = mg * 128;
  const int ldk = A.ldk;
  const GAS bf16_t* Kh = A.K; const GAS bf16_t* Vh = A.V;
  const int NT = A.n1 + A.n2;
  const int qposl = A.qpos0 + wq * QBLK + r32;
  constexpr bool maskunit = MASK;
#define KST(j) ((j) < A.n1 ? A.s1 + (j) * KVBLK : A.s2 + ((j) - A.n1) * KVBLK)
  struct { bf16x8 vs0, vs1, ks0, ks1; } sr_[2];
#define SLOAD(i, k0) do { const long k0_ = (k0); sr_[i].vs0 = *(const GAS bf16x8*)(&Vh[(k0_ + sr) * ldk + sc]); sr_[i].vs1 = *(const GAS bf16x8*)(&Vh[(k0_ + 32 + sr) * ldk + sc]); \
    sr_[i].ks0 = *(const GAS bf16x8*)(&Kh[(k0_ + sr) * ldk + sc]); sr_[i].ks1 = *(const GAS bf16x8*)(&Kh[(k0_ + 32 + sr) * ldk + sc]); } while (0)
#define SWRITE(b, i) do { *(bf16x8*)(V_lds + (b) * SHM_V + vst0) = sr_[i].vs0;          \
    *(bf16x8*)(V_lds + (b) * SHM_V + vst1) = sr_[i].vs1; const int kc = sc * 2;               \
    *(bf16x8*)(K_lds + (b) * SHM_K + KSWZ(sr, kc)) = sr_[i].ks0;                       \
    *(bf16x8*)(K_lds + (b) * SHM_K + KSWZ(32 + sr, kc)) = sr_[i].ks1; } while (0)
#define SWAIT() asm volatile("s_waitcnt vmcnt(4)" ::: "memory")
#define RESC(a) do { if (__any((a) < 1.f)) { if (hi == 0) al_l[r32] = (a); asm volatile("s_waitcnt lgkmcnt(0)" ::: "memory"); \
    _Pragma("unroll") for (int d = 0; d < NO; ++d) _Pragma("unroll") for (int r = 0; r < 16; ++r) o[d][r] *= al_l[crow(r, hi)]; } } while (0)
#define MASKARGS(j) (maskunit && (j) >= A.n1), (KST(j) - qposl + 4 * hi)
  f32x16 pA0, pA1, pB0, pB1; float mnA, mnB, alA, alB; bf16x8 pa0, pa1, pa2, pa3;
  constexpr int SE = 0, SO = 1;
  __syncthreads();
  SLOAD(SE, KST(0)); asm volatile("s_waitcnt vmcnt(0)" ::: "memory"); SWRITE(0, SE); __syncthreads();
  qkt(pA0, pA1, K_lds, qr, r32, hi, kcolB); partialSM(pA0, pA1, m_reg, mnA, alA, MASKARGS(0));
  SLOAD(SO, KST(1)); if (2 < NT) SLOAD(SE, KST(2));
  SWAIT(); SWRITE(1, SO); __syncthreads();
  for (int j = 1; j + 1 < NT; j += 2) {
    SBAR(); qkt(pB0, pB1, K_lds + SHM_K, qr, r32, hi, kcolB);
    if (ATT_PROBE == 1) { asm volatile("" : "+v"(pB0), "+v"(pB1)); qkt(pB0, pB1, K_lds + SHM_K, qr, r32, hi, kcolB); }
    finishSM(pA0, pA1, alA, l_reg, pa0, pa1, pa2, pa3, ATT_PROBE == 2 ? 0.5f : 1.0f); S1_PIPE(); SBAR();
    SLOAD(SO, KST(j + 2)); SBAR();
    if (ATT_PROBE == 2) pv_all<DIFF>(o, vb0, pa0, pa1, pa2, pa3);
    pv_all<DIFF>(o, vb0, pa0, pa1, pa2, pa3); partialSM(pB0, pB1, m_reg, mnB, alB, MASKARGS(j));
    __syncthreads(); SWAIT(); SWRITE(0, SE); if (ATT_PROBE == 4) { asm volatile("" ::: "memory"); SWRITE(0, SE); }
    RESC(alB); __syncthreads();
    SBAR(); qkt(pA0, pA1, K_lds, qr, r32, hi, kcolB);
    if (ATT_PROBE == 1) { asm volatile("" : "+v"(pA0), "+v"(pA1)); qkt(pA0, pA1, K_lds, qr, r32, hi, kcolB); }
    finishSM(pB0, pB1, alB, l_reg, pa0, pa1, pa2, pa3, ATT_PROBE == 2 ? 0.5f : 1.0f); S1_PIPE(); SBAR();
    if (j + 3 < NT) SLOAD(SE, KST(j + 3)); SBAR();
    if (ATT_PROBE == 2) pv_all<DIFF>(o, vb0 + SHM_V, pa0, pa1, pa2, pa3);
    pv_all<DIFF>(o, vb0 + SHM_V, pa0, pa1, pa2, pa3); partialSM(pA0, pA1, m_reg, mnA, alA, MASKARGS(j + 1));
    __syncthreads(); SWAIT(); SWRITE(1, SO); if (ATT_PROBE == 4) { asm volatile("" ::: "memory"); SWRITE(1, SO); }
    RESC(alA); __syncthreads();
  }
  SBAR(); qkt(pB0, pB1, K_lds + SHM_K, qr, r32, hi, kcolB);
  finishSM(pA0, pA1, alA, l_reg, pa0, pa1, pa2, pa3); SBAR();
  pv_all<DIFF>(o, vb0, pa0, pa1, pa2, pa3); partialSM(pB0, pB1, m_reg, mnB, alB, MASKARGS(NT - 1));
  __syncthreads(); RESC(alB);
  finishSM(pB0, pB1, alB, l_reg, pa0, pa1, pa2, pa3); SBAR();
  pv_all<DIFF>(o, vb0 + SHM_V, pa0, pa1, pa2, pa3);
  if (hi == 0) li_l[r32] = l_reg; asm volatile("s_waitcnt lgkmcnt(0)" ::: "memory");
  float rli[16];
#pragma unroll
  for (int r = 0; r < 16; ++r) rli[r] = __builtin_amdgcn_rcpf(li_l[crow(r, hi)]);
  if constexpr (!DIFF) {
    GAS bf16_t* Ow = A.O + (mg ? A.og1 : 0) + (long)(wq * QBLK) * 512;
#pragma unroll
    for (int r = 0; r < 16; ++r) { const int orow = crow(r, hi);
#pragma unroll
      for (int d0 = 0; d0 < 2; ++d0) Ow[(long)orow * 512 + d0 * 32 + r32] = f2bf(o[d0][r] * rli[r]); }
  } else {
    float* ex = (float*)lds;
    __syncthreads();
    if (mg == 1) {
#pragma unroll
      for (int d0 = 0; d0 < 4; ++d0)
#pragma unroll
        for (int r = 0; r < 16; ++r) ex[(wq * 64 + d0 * 16 + r) * 64 + lane] = o[d0][r] * rli[r];
    }
    __syncthreads();
    if (mg == 0) {
      GAS bf16_t* Ow = A.O + (long)(wq * QBLK) * 512;
      float gsub[4];
#pragma unroll
      for (int d0 = 0; d0 < 4; ++d0) gsub[d0] = A.subg[d0 * 32 + r32] * A.post;
#pragma unroll
      for (int r = 0; r < 16; ++r) {
        float v[4]; float ss = 0.f;
#pragma unroll
        for (int d0 = 0; d0 < 4; ++d0) { v[d0] = o[d0][r] * rli[r] - A.lam * ex[(wq * 64 + d0 * 16 + r) * 64 + lane]; ss += v[d0] * v[d0]; }
        ss += __shfl_xor(ss, 1); ss += __shfl_xor(ss, 2); ss += __shfl_xor(ss, 4); ss += __shfl_xor(ss, 8); ss += __shfl_xor(ss, 16);
        const float rn = __builtin_amdgcn_rsqf(ss * (1.0f / 128.0f) + 1e-6f);
        const int orow = crow(r, hi);
#pragma unroll
        for (int d0 = 0; d0 < 4; ++d0) Ow[(long)orow * 512 + d0 * 32 + r32] = f2bf(v[d0] * rn * gsub[d0]);
      }
    }
  }
#undef KST
#undef SLOAD
#undef SWRITE
#undef SWAIT
#undef RESC
#undef MASKARGS
}
#undef KSWZ
}
#include <hip/hip_bf16.h>
namespace att64 {
using bf16=__hip_bfloat16;
using bf16x8=__attribute__((ext_vector_type(8)))short;
using s16x4=__attribute__((ext_vector_type(4)))short;
using f32x16=__attribute__((ext_vector_type(16)))float;
using u32x4=__attribute__((ext_vector_type(4)))unsigned;
constexpr int D=64;
constexpr int NW=8,QBLK=32,QB=QBLK*NW,KVBLK=64;
__device__ __forceinline__ int crow(int r,int hi){return (r&3)+8*(r>>2)+4*hi;}
#define SBAR() __builtin_amdgcn_sched_barrier(0)
__device__ __forceinline__ void bmask(f32x16&p0,f32x16&p1,int dq){
  const float NEG=-INFINITY;
  #pragma unroll
  for(int r=0;r<16;++r){const int d0=dq+(r&3)+8*(r>>2),d1=d0+32; if(d0>128||d0<-128)p0[r]=NEG; if(d1>128||d1<-128)p1[r]=NEG;}
}
constexpr int NSLOT=3, SLOTB=8192;
constexpr int LDS_K=0, LDS_V=NSLOT*SLOTB, LDS_WS=2*NSLOT*SLOTB, LDS_OST=LDS_WS+NW*64*4, LDS_BYTES=LDS_OST+NW*4096;
constexpr float C2=0.125f*1.4426950408889634f;
__device__ __forceinline__ void glds16(const void*gsrc,unsigned lds_dst){unsigned keep;
  asm volatile("s_mov_b32 %0, m0\n\ts_mov_b32 m0, %2\n\ts_nop 0\n\tglobal_load_lds_dwordx4 %1, off\n\ts_mov_b32 m0, %0":"=&s"(keep):"v"(gsrc),"s"(lds_dst):"memory");}
__device__ __forceinline__ float max3f(float a,float b,float c){float r;asm("v_max3_f32 %0, %1, %2, %3":"=v"(r):"v"(a),"v"(b),"v"(c));return r;}
__device__ __forceinline__ float max2f(float a,float b){float r;asm("v_max_f32_e32 %0, %1, %2":"=v"(r):"v"(a),"v"(b));return r;}
__device__ __forceinline__ float fadd_s(float a,float b){float r;asm("v_add_f32_e32 %0, %1, %2":"=v"(r):"v"(a),"v"(b));return r;}
__device__ __forceinline__ float fsub_s(float a,float b){float r;asm("v_sub_f32_e32 %0, %1, %2":"=v"(r):"v"(a),"v"(b));return r;}
typedef float f32x2_t __attribute__((ext_vector_type(2))); typedef __bf16 bf16x2_t __attribute__((ext_vector_type(2)));
__device__ __forceinline__ unsigned cvtpk_s(float lo,float hi){f32x2_t v={lo,hi};bf16x2_t b=__builtin_convertvector(v,bf16x2_t);return __builtin_bit_cast(unsigned,b);}
#define WAIT_BAR(N) asm volatile("s_waitcnt vmcnt(" #N ") lgkmcnt(0)\n\ts_barrier":::"memory")

__device__ __forceinline__ void qkt(f32x16&p0,f32x16&p1,const char*Kslot,const bf16x8*qr,const f32x16&negm,int r32,int hi){
  const char*kb=Kslot+hi*1024+r32*16;
  #pragma unroll
  for(int d0=0;d0<4;++d0){
    const bf16x8 b0=*reinterpret_cast<const bf16x8*>(kb+d0*2048);
    const bf16x8 b1=*reinterpret_cast<const bf16x8*>(kb+d0*2048+512);
    if(d0==0){p0=__builtin_amdgcn_mfma_f32_32x32x16_bf16(b0,qr[0],negm,0,0,0);p1=__builtin_amdgcn_mfma_f32_32x32x16_bf16(b1,qr[0],negm,0,0,0);}
    else{p0=__builtin_amdgcn_mfma_f32_32x32x16_bf16(b0,qr[d0],p0,0,0,0);p1=__builtin_amdgcn_mfma_f32_32x32x16_bf16(b1,qr[d0],p1,0,0,0);}}
}
typedef __attribute__((address_space(3))) const char* lds_cptr;
typedef short v4i16_t __attribute__((ext_vector_type(4)));
__device__ __forceinline__ void kload8(bf16x8*kf,lds_cptr kp){
  kf[0]=*(const __attribute__((address_space(3))) bf16x8*)(kp);      kf[1]=*(const __attribute__((address_space(3))) bf16x8*)(kp+512);
  kf[2]=*(const __attribute__((address_space(3))) bf16x8*)(kp+2048); kf[3]=*(const __attribute__((address_space(3))) bf16x8*)(kp+2560);
  kf[4]=*(const __attribute__((address_space(3))) bf16x8*)(kp+4096); kf[5]=*(const __attribute__((address_space(3))) bf16x8*)(kp+4608);
  kf[6]=*(const __attribute__((address_space(3))) bf16x8*)(kp+6144); kf[7]=*(const __attribute__((address_space(3))) bf16x8*)(kp+6656);
}
__device__ __forceinline__ void kload2(bf16x8*kf,lds_cptr kp,int j){ kf[2*j]=*(const __attribute__((address_space(3))) bf16x8*)(kp+j*2048); kf[2*j+1]=*(const __attribute__((address_space(3))) bf16x8*)(kp+j*2048+512); }
__device__ __forceinline__ s16x4 vtr(lds_cptr p){ return __builtin_bit_cast(s16x4,__builtin_amdgcn_ds_read_tr16_b64_v4i16((__attribute__((address_space(3))) v4i16_t*)p)); }
__device__ __forceinline__ float rowmax(const f32x16&p0,const f32x16&p1){
  float a=max3f(p0[0],p0[1],p1[0]),b=max3f(p0[2],p0[3],p1[1]);a=max3f(a,p1[2],p1[3]);
  #pragma unroll
  for(int r=4;r<16;r+=4){a=max3f(a,p0[r],p0[r+1]);b=max3f(b,p0[r+2],p0[r+3]);a=max3f(a,p1[r],p1[r+1]);b=max3f(b,p1[r+2],p1[r+3]);}
  const float m=max2f(a,b);
  auto rr=__builtin_amdgcn_permlane32_swap(__float_as_uint(m),__float_as_uint(m),false,false);
  return max2f(__uint_as_float(rr[0]),__uint_as_float(rr[1]));
}
__device__ __forceinline__ void pv(f32x16*o,int vb,bf16x8 pa0,bf16x8 pa1,bf16x8 pa2,bf16x8 pa3){
  #pragma unroll
  for(int d0=0;d0<2;++d0){s16x4 lo[4],hi[4];
    #pragma unroll
    for(int ks=0;ks<4;++ks){
      asm volatile("ds_read_b64_tr_b16 %0,%1 offset:%c2":"=&v"(lo[ks]):"v"(vb),"i"(d0*4096+ks*1024):"memory");
      asm volatile("ds_read_b64_tr_b16 %0,%1 offset:%c2":"=&v"(hi[ks]):"v"(vb),"i"(d0*4096+ks*1024+512):"memory");}
    asm volatile("s_waitcnt lgkmcnt(0)":::"memory");SBAR();
    #define PK(k) (bf16x8){lo[k][0],lo[k][1],lo[k][2],lo[k][3],hi[k][0],hi[k][1],hi[k][2],hi[k][3]}
    o[d0]=__builtin_amdgcn_mfma_f32_32x32x16_bf16(pa0,PK(0),o[d0],0,0,0);
    o[d0]=__builtin_amdgcn_mfma_f32_32x32x16_bf16(pa1,PK(1),o[d0],0,0,0);
    o[d0]=__builtin_amdgcn_mfma_f32_32x32x16_bf16(pa2,PK(2),o[d0],0,0,0);
    o[d0]=__builtin_amdgcn_mfma_f32_32x32x16_bf16(pa3,PK(3),o[d0],0,0,0);
    #undef PK
  }
}

#ifndef ATTN_STORE16
#define ATTN_STORE16(p,v) (*(u32x4*)(p)=(v))
#endif
template<int THRL,bool MASK,bool PAIR> __device__ __forceinline__ void attn_unit(const bf16*Qu,int qp,const bf16*__restrict__ Kh,const bf16*__restrict__ Vh,int kvp,int NT,int n1,int s2,int kpos2,int qpos0,int use_sink,float sink_l2,float sink_l2b,bf16*Ou,int op,char*shm,const int wave0){
  const int lane=lane_now(),tid=wave0*64+lane,r32=lane&31,hi=lane>>5; const int wid=wave0;
  const int wrow=PAIR?(wid&3):wid, whead=PAIR?(wid>>2):0;
  const bf16*Qw=Qu+(long)(wrow*QBLK)*qp+whead*D;
  const unsigned lds0=(unsigned)(uintptr_t)shm;
  float*wsf=(float*)(shm+LDS_WS)+wid*64;
  const bf16*ksrc=Kh+(long)lane*kvp+wid*8;
  const bf16*vsrc=Vh+(long)(16*(wid&3)+(lane>>2))*kvp+(wid>>2)*32+(lane&3)*8;
  const unsigned kdst=lds0+LDS_K+wid*1024, vdst=lds0+LDS_V+wid*1024;
  #define KROW(t) ((t)<n1?(t)*KVBLK:s2+((t)-n1)*KVBLK)
  #define DMA_K(t,slot) glds16(ksrc+(long)KROW(t)*kvp,(unsigned)__builtin_amdgcn_readfirstlane(kdst+(slot)))
  #define DMA_V(t,slot) glds16(vsrc+(long)KROW(t)*kvp,(unsigned)__builtin_amdgcn_readfirstlane(vdst+(slot)))
  const int vb0=(int)(lds0+LDS_V)+((lane>>4)&1)*32+(lane&3)*8+(4*hi+((lane&15)>>2))*64;
  const char*Kbase=shm+LDS_K; bf16x8 kf[8];
  const lds_cptr shm3=(lds_cptr)shm; const lds_cptr kp0=shm3+LDS_K+hi*1024+r32*16; const lds_cptr vp0=shm3+LDS_V+((lane>>4)&1)*32+(lane&3)*8+(4*hi+((lane&15)>>2))*64;
  DMA_K(0,0);DMA_V(0,0);DMA_K(1,SLOTB);
  bf16x8 qr[4];
  #pragma unroll
  for(int d0=0;d0<4;++d0)qr[d0]=*reinterpret_cast<const bf16x8*>(&Qw[(long)r32*qp+d0*16+hi*8]);
  float mhat=0.f,l_reg=0.f;f32x16 o[2];o[0]=f32x16{};o[1]=f32x16{};f32x16 negm=f32x16{};asm volatile("":"+v"(negm));
  const int dqb=kpos2-(qpos0+wrow*QBLK+r32)+4*hi;
  #define CMASK(P0,P1,t) do{ if(MASK&&(t)>=n1) bmask(P0,P1,dqb+((t)-n1)*KVBLK); }while(0)
  bool resc=false;
  #define START(P0,P1) do{ const float rm=rowmax(P0,P1); resc=false; \
    { const float dl=rm; mhat=fadd_s(mhat,dl); \
      _Pragma("unroll") for(int r=0;r<16;++r){P0[r]=fsub_s(P0[r],dl);P1[r]=fsub_s(P1[r],dl);} \
      _Pragma("unroll") for(int r=0;r<16;++r)negm[r]=-mhat; asm volatile("":"+v"(negm)); } \
    _Pragma("unroll") for(int r=0;r<16;++r)P0[r]=__builtin_amdgcn_exp2f(P0[r]); }while(0)
  #define RESC() do{ if(resc){ asm volatile("s_waitcnt lgkmcnt(0)":::"memory"); \
      _Pragma("unroll") for(int d_=0;d_<2;++d_) _Pragma("unroll") for(int r=0;r<16;++r)o[d_][r]*=wsf[crow(r,hi)]; } }while(0)
  f32x16 pA0,pA1,pB0,pB1;
  int sl_prev=0,sl_cur=0,sl_next=SLOTB;
  #define ROT() do{sl_prev=sl_cur;sl_cur=sl_next;sl_next=(sl_next==(NSLOT-1)*SLOTB)?0:sl_next+SLOTB;}while(0)
  DMA_K(2,2*SLOTB);
  WAIT_BAR(3);
  qkt(pA0,pA1,Kbase,qr,f32x16{},r32,hi);asm volatile("s_nop 15\n\ts_nop 7":"+v"(pA0),"+v"(pA1));CMASK(pA0,pA1,0);
  START(pA0,pA1);
  _Pragma("unroll") for(int r=0;r<16;++r)pA1[r]=__builtin_amdgcn_exp2f(pA1[r]);
  WAIT_BAR(0);
  DMA_K(3,0);DMA_V(1,SLOTB);
  ROT();
  kload8(kf,kp0+sl_cur);
  WAIT_BAR(2);
  s16x4 vlo[8],vhi[8]; u32x4 pw0,pw1,pw2,pw3;
  #define PKW(P,B) cvtpk_s(P[B],P[B+1])
  #define PAF(k) __builtin_bit_cast(bf16x8,pw##k)
  #define VFR(i) (bf16x8){vlo[i][0],vlo[i][1],vlo[i][2],vlo[i][3],vhi[i][0],vhi[i][1],vhi[i][2],vhi[i][3]}
  #define PIN(x) asm volatile("":"+v"(x))
  #define MX3(a,b,c) __builtin_fmaxf(__builtin_fmaxf((a),(b)),(c))
  #define GAPA(MF,A0,A1,A2,A3,W0,W1,PW) do{ MF; sacc+=A0; sacc+=A1; sacc+=A2; sacc+=A3; PIN(sacc); W0; W1; PIN(PW); SBAR(); }while(0)
  #define EX(v) __builtin_amdgcn_exp2f(v)
  #define GAPB(MF,X,B) do{ MF; X[B]=EX(X[B]); X[B+1]=EX(X[B+1]); X[B+2]=EX(X[B+2]); X[B+3]=EX(X[B+3]); PIN(X); SBAR(); }while(0)
  #define VRD(i) do{ vlo[i]=vtr(vp_+(((i)>>2)*4096+((i)&3)*1024)); vhi[i]=vtr(vp_+(((i)>>2)*4096+((i)&3)*1024+512)); }while(0)
  #define KRD(G,j) do{ if(G){ kload2(kf,kp0+sl_next,j); SBAR(); } }while(0)
  #define STEP(C0,C1,P0,P1,t,GK,GV,GL) do{ SBAR(); \
    const lds_cptr vp_=vp0+sl_prev; \
    VRD(0); SBAR(); float sacc=(P0[0]+P0[1]); \
    GAPA(C0=__builtin_amdgcn_mfma_f32_32x32x16_bf16(kf[0],qr[0],negm,0,0,0), P0[2],P0[3],P0[4],P0[5],     pw0[0]=PKW(P0,0), pw0[1]=PKW(P0,2), pw0); \
    VRD(4); SBAR(); GAPA(C1=__builtin_amdgcn_mfma_f32_32x32x16_bf16(kf[1],qr[0],negm,0,0,0), P0[6],P0[7],P0[8],P0[9],     pw0[2]=PKW(P0,4), pw0[3]=PKW(P0,6), pw0); \
    VRD(1); SBAR(); GAPA(C0=__builtin_amdgcn_mfma_f32_32x32x16_bf16(kf[2],qr[1],C0,0,0,0),   P0[10],P0[11],P0[12],P0[13], pw1[0]=PKW(P0,8), pw1[1]=PKW(P0,10), pw1); \
    VRD(5); SBAR(); GAPA(C1=__builtin_amdgcn_mfma_f32_32x32x16_bf16(kf[3],qr[1],C1,0,0,0),   P0[14],P0[15],P1[0],P1[1],   pw1[2]=PKW(P0,12),pw1[3]=PKW(P0,14), pw1); \
    VRD(2); SBAR(); GAPA(C0=__builtin_amdgcn_mfma_f32_32x32x16_bf16(kf[4],qr[2],C0,0,0,0),   P1[2],P1[3],P1[4],P1[5],     pw2[0]=PKW(P1,0), pw2[1]=PKW(P1,2), pw2); \
    VRD(6); SBAR(); GAPA(C1=__builtin_amdgcn_mfma_f32_32x32x16_bf16(kf[5],qr[2],C1,0,0,0),   P1[6],P1[7],P1[8],P1[9],     pw2[2]=PKW(P1,4), pw2[3]=PKW(P1,6), pw2); \
    VRD(3); SBAR(); GAPA(C0=__builtin_amdgcn_mfma_f32_32x32x16_bf16(kf[6],qr[3],C0,0,0,0),   P1[10],P1[11],P1[12],P1[13], pw3[0]=PKW(P1,8), pw3[1]=PKW(P1,10), pw3); \
    VRD(7); SBAR(); GAPA(C1=__builtin_amdgcn_mfma_f32_32x32x16_bf16(kf[7],qr[3],C1,0,0,0),   P1[14],P1[15],0.f,0.f,       pw3[2]=PKW(P1,12),pw3[3]=PKW(P1,14), pw3); \
    l_reg+=sacc; \
    if(GK){DMA_K((t)+3,sl_cur);} if(GV){DMA_V((t)+1,sl_next);} \
    CMASK(C0,C1,t); \
    { float a=MX3(C0[0],C0[1],C1[0]),b=MX3(C0[2],C0[3],C1[1]); a=MX3(a,C1[2],C1[3]); \
      _Pragma("unroll") for(int r=4;r<16;r+=4){a=MX3(a,C0[r],C0[r+1]);b=MX3(b,C0[r+2],C0[r+3]);a=MX3(a,C1[r],C1[r+1]);b=MX3(b,C1[r+2],C1[r+3]);} \
      float rm=__builtin_fmaxf(a,b); { auto rr=__builtin_amdgcn_permlane32_swap(__float_as_uint(rm),__float_as_uint(rm),false,false); rm=__builtin_fmaxf(__uint_as_float(rr[0]),__uint_as_float(rr[1])); } \
      resc=false;                                              \
      if(__builtin_expect(__any(rm>(float)THRL),0)){ const float dl=__builtin_fmaxf(rm,0.f); mhat+=dl; \
        _Pragma("unroll") for(int r=0;r<16;++r){C0[r]-=dl;C1[r]-=dl;} \
        _Pragma("unroll") for(int r=0;r<16;++r)negm[r]=-mhat; asm volatile("":"+v"(negm)); \
        const float f=__builtin_amdgcn_exp2f(-dl); l_reg*=f; if(hi==0)wsf[r32]=f; resc=true; } } \
    SBAR(); \
    GAPB(o[0]=__builtin_amdgcn_mfma_f32_32x32x16_bf16(PAF(0),VFR(0),o[0],0,0,0), C0,0); \
    GAPB(o[1]=__builtin_amdgcn_mfma_f32_32x32x16_bf16(PAF(0),VFR(4),o[1],0,0,0), C0,4); \
    KRD(GL,0); GAPB(o[0]=__builtin_amdgcn_mfma_f32_32x32x16_bf16(PAF(1),VFR(1),o[0],0,0,0), C0,8); \
    KRD(GL,1); GAPB(o[1]=__builtin_amdgcn_mfma_f32_32x32x16_bf16(PAF(1),VFR(5),o[1],0,0,0), C0,12); \
    KRD(GL,2); GAPB(o[0]=__builtin_amdgcn_mfma_f32_32x32x16_bf16(PAF(2),VFR(2),o[0],0,0,0), C1,0); \
    KRD(GL,3); GAPB(o[1]=__builtin_amdgcn_mfma_f32_32x32x16_bf16(PAF(2),VFR(6),o[1],0,0,0), C1,4); \
    GAPB(o[0]=__builtin_amdgcn_mfma_f32_32x32x16_bf16(PAF(3),VFR(3),o[0],0,0,0), C1,8); \
    GAPB(o[1]=__builtin_amdgcn_mfma_f32_32x32x16_bf16(PAF(3),VFR(7),o[1],0,0,0), C1,12); \
    }while(0)
  int t=1;
  for(;t+5<NT;t+=2){
    STEP(pB0,pB1,pA0,pA1,t,true,true,true);     WAIT_BAR(2); RESC(); ROT();
    STEP(pA0,pA1,pB0,pB1,t+1,true,true,true);   WAIT_BAR(2); RESC(); ROT();
  }
  #define ENDW(tt) do{ if((tt)+3<NT){WAIT_BAR(2);} else if((tt)+2<NT){WAIT_BAR(1);} else {WAIT_BAR(0);} }while(0)
  for(;t+1<NT;t+=2){
    STEP(pB0,pB1,pA0,pA1,t,(t+3<NT),(t+1<NT),(t+1<NT));       ENDW(t);   RESC(); ROT();
    STEP(pA0,pA1,pB0,pB1,t+1,(t+4<NT),(t+2<NT),(t+2<NT));     ENDW(t+1); RESC(); ROT();
  }
  STEP(pB0,pB1,pA0,pA1,NT-1,false,false,false); RESC();
  { float sacc=pB0[0]+pB0[1]; _Pragma("unroll") for(int r=2;r<16;++r)sacc+=pB0[r]; _Pragma("unroll") for(int r=0;r<16;++r)sacc+=pB1[r]; l_reg+=sacc;
    pw0=(u32x4){PKW(pB0,0),PKW(pB0,2),PKW(pB0,4),PKW(pB0,6)};pw1=(u32x4){PKW(pB0,8),PKW(pB0,10),PKW(pB0,12),PKW(pB0,14)};pw2=(u32x4){PKW(pB1,0),PKW(pB1,2),PKW(pB1,4),PKW(pB1,6)};pw3=(u32x4){PKW(pB1,8),PKW(pB1,10),PKW(pB1,12),PKW(pB1,14)};
    SBAR(); pv(o,vb0+sl_cur,PAF(0),PAF(1),PAF(2),PAF(3)); }
  #undef PKW
  #undef PAF
  #undef VFR
  #undef PIN
  #undef MX3
  #undef GAPA
  #undef GAPB
  #undef EX
  #undef VRD
  #undef KRD
  #undef STEP
  #undef ENDW
  {auto rr=__builtin_amdgcn_permlane32_swap(__float_as_uint(l_reg),__float_as_uint(l_reg),false,false);l_reg=__uint_as_float(rr[0])+__uint_as_float(rr[1]);}
  if(use_sink) l_reg+=__builtin_amdgcn_exp2f(fminf((whead?sink_l2b:sink_l2)-mhat,120.f));
  if(hi==0)wsf[32+r32]=l_reg;asm volatile("s_waitcnt lgkmcnt(0)":::"memory");
  float rli[16];
  #pragma unroll
  for(int r=0;r<16;++r)rli[r]=__builtin_amdgcn_rcpf(wsf[32+crow(r,hi)]);
  bf16*Ow=Ou+(long)(wrow*QBLK)*op+whead*D;
  { bf16*stg=(bf16*)(shm+LDS_OST)+wid*2048;
    #pragma unroll
    for(int r=0;r<16;++r){const int orow=crow(r,hi);
      #pragma unroll
      for(int d0=0;d0<2;++d0)stg[orow*64+d0*32+r32]=__float2bfloat16(o[d0][r]*rli[r]);}
    asm volatile("s_waitcnt lgkmcnt(0)":::"memory");
    #pragma unroll
    for(int i=0;i<4;++i){const int row=i*8+(lane>>3),ch=lane&7; const u32x4 v=*(const u32x4*)(stg+row*64+ch*8); ATTN_STORE16(Ow+(long)row*op+ch*8,v);} }
  asm volatile("s_waitcnt lgkmcnt(0)\n\ts_barrier":::"memory");
  #undef KROW
  #undef DMA_K
  #undef DMA_V
  #undef CMASK
  #undef START
  #undef RESC
  #undef ROT
}
#undef SBAR
#undef WAIT_BAR
}
namespace att128 {
using att64::bf16; using att64::bf16x8; using att64::s16x4; using att64::f32x16; using att64::u32x4; using att64::lds_cptr;
using att64::crow; using att64::glds16; using att64::cvtpk_s; using att64::kload8; using att64::kload2; using att64::vtr; using att64::rowmax; using att64::qkt; using att64::fadd_s; using att64::fsub_s;
typedef float f32x4v __attribute__((ext_vector_type(4)));
constexpr int D=64,NW=8,QBLK=32,KVBLK=64;
constexpr int NSLOT=3, SLOTB=8192;
constexpr int LDS_K=0, LDS_V=NSLOT*SLOTB, LDS_WS=LDS_V+2*NSLOT*SLOTB, LDS_O1=LDS_WS+NW*64*4, LDS_BYTES=LDS_O1+NW*8192;
#define SBAR() __builtin_amdgcn_sched_barrier(0)
#define WAIT_BAR(N) asm volatile("s_waitcnt vmcnt(" #N ") lgkmcnt(0)\n\ts_barrier":::"memory")
__device__ __forceinline__ void pv4(f32x16*o,int vb,bf16x8 pa0,bf16x8 pa1,bf16x8 pa2,bf16x8 pa3){
  #pragma unroll
  for(int d0=0;d0<4;++d0){s16x4 lo[4],hi[4];
    #pragma unroll
    for(int ks=0;ks<4;++ks){
      asm volatile("ds_read_b64_tr_b16 %0,%1 offset:%c2":"=&v"(lo[ks]):"v"(vb),"i"(d0*4096+ks*1024):"memory");
      asm volatile("ds_read_b64_tr_b16 %0,%1 offset:%c2":"=&v"(hi[ks]):"v"(vb),"i"(d0*4096+ks*1024+512):"memory");}
    asm volatile("s_waitcnt lgkmcnt(0)":::"memory");SBAR();
    #define PK(k) (bf16x8){lo[k][0],lo[k][1],lo[k][2],lo[k][3],hi[k][0],hi[k][1],hi[k][2],hi[k][3]}
    o[d0]=__builtin_amdgcn_mfma_f32_32x32x16_bf16(pa0,PK(0),o[d0],0,0,0);
    o[d0]=__builtin_amdgcn_mfma_f32_32x32x16_bf16(pa1,PK(1),o[d0],0,0,0);
    o[d0]=__builtin_amdgcn_mfma_f32_32x32x16_bf16(pa2,PK(2),o[d0],0,0,0);
    o[d0]=__builtin_amdgcn_mfma_f32_32x32x16_bf16(pa3,PK(3),o[d0],0,0,0);
    #undef PK
  }
}
template<int THRL> __device__ __forceinline__ void attn_unit(const bf16*Qu,int qp,const bf16*__restrict__ Kh,const bf16*__restrict__ Vh,int kvp,int NT,int second,float lam,const GAS float*subg,float post,bf16*Ou,int op,char*shm,const int wave0){
  const int lane=lane_now(),r32=lane&31,hi=lane>>5; const int wid=wave0;
  const bf16*Qw=Qu+(long)(wid*QBLK)*qp;
  const unsigned lds0=(unsigned)(uintptr_t)shm;
  float*wsf=(float*)(shm+LDS_WS)+wid*64;
  const bf16*ksrc=Kh+(long)lane*kvp+wid*8;
  const bf16*vsrc=Vh+(long)(16*(wid&3)+(lane>>2))*kvp+(wid>>2)*32+(lane&3)*8;
  const unsigned kdst=lds0+LDS_K+wid*1024, vdst=lds0+LDS_V+wid*1024;
  #define DMA_K(t,slot) glds16(ksrc+(long)((t)*KVBLK)*kvp,(unsigned)__builtin_amdgcn_readfirstlane(kdst+(slot)))
  #define DMA_V(t,slot) do{ glds16(vsrc+(long)((t)*KVBLK)*kvp,(unsigned)__builtin_amdgcn_readfirstlane(vdst+2*(slot))); glds16(vsrc+(long)((t)*KVBLK)*kvp+64,(unsigned)__builtin_amdgcn_readfirstlane(vdst+2*(slot)+8192)); }while(0)
  const int vb0=(int)(lds0+LDS_V)+((lane>>4)&1)*32+(lane&3)*8+(4*hi+((lane&15)>>2))*64;
  const char*Kbase=shm+LDS_K; bf16x8 kf[8];
  const lds_cptr shm3=(lds_cptr)shm; const lds_cptr kp0=shm3+LDS_K+hi*1024+r32*16; const lds_cptr vp0=shm3+LDS_V+((lane>>4)&1)*32+(lane&3)*8+(4*hi+((lane&15)>>2))*64;
  DMA_K(0,0);DMA_V(0,0);DMA_K(1,SLOTB);
  bf16x8 qr[4];
  #pragma unroll
  for(int d0=0;d0<4;++d0)qr[d0]=*reinterpret_cast<const bf16x8*>(&Qw[(long)r32*qp+d0*16+hi*8]);
  float mhat=0.f,l_reg=0.f;f32x16 o[4];o[0]=f32x16{};o[1]=f32x16{};o[2]=f32x16{};o[3]=f32x16{};
  bool resc=false;
  #define START(P0,P1) do{ const float rm=rowmax(P0,P1); resc=false; \
    { const float dl=rm; mhat=fadd_s(mhat,dl); \
      _Pragma("unroll") for(int r=0;r<16;++r){P0[r]=fsub_s(P0[r],dl);P1[r]=fsub_s(P1[r],dl);} \
      } \
    _Pragma("unroll") for(int r=0;r<16;++r)P0[r]=__builtin_amdgcn_exp2f(P0[r]); }while(0)
  #define RESC() do{ if(resc){ asm volatile("s_waitcnt lgkmcnt(0)":::"memory"); \
      _Pragma("unroll") for(int r=0;r<16;++r){ const float f_=wsf[crow(r,hi)]; o[0][r]*=f_;o[1][r]*=f_;o[2][r]*=f_;o[3][r]*=f_; } } }while(0)
  f32x16 pA0,pA1,pB0,pB1;
  int sl_prev=0,sl_cur=0,sl_next=SLOTB;
  #define ROT() do{sl_prev=sl_cur;sl_cur=sl_next;sl_next=(sl_next==(NSLOT-1)*SLOTB)?0:sl_next+SLOTB;}while(0)
  DMA_K(2,2*SLOTB);
  WAIT_BAR(4);
  qkt(pA0,pA1,Kbase,qr,f32x16{},r32,hi);asm volatile("s_nop 15\n\ts_nop 7":"+v"(pA0),"+v"(pA1));
  START(pA0,pA1);
  _Pragma("unroll") for(int r=0;r<16;++r)pA1[r]=__builtin_amdgcn_exp2f(pA1[r]);
  WAIT_BAR(0);
  DMA_K(3,0);DMA_V(1,SLOTB);
  ROT();
  kload8(kf,kp0+sl_cur);
  WAIT_BAR(3);
  s16x4 vlo[16],vhi[16]; u32x4 pw0,pw1,pw2,pw3;
  #define PKW(P,B) cvtpk_s(P[B],P[B+1])
  #define PAF(k) __builtin_bit_cast(bf16x8,pw##k)
  #define VFR(i) (bf16x8){vlo[i][0],vlo[i][1],vlo[i][2],vlo[i][3],vhi[i][0],vhi[i][1],vhi[i][2],vhi[i][3]}
  #define PIN(x) asm volatile("":"+v"(x))
  #define MX3(a,b,c) __builtin_fmaxf(__builtin_fmaxf((a),(b)),(c))
  #define GAPA(MF,A0,A1,A2,A3,W0,W1,PW) do{ MF; sacc+=A0; sacc+=A1; sacc+=A2; sacc+=A3; PIN(sacc); W0; W1; PIN(PW); SBAR(); }while(0)
  #define EX(v) __builtin_amdgcn_exp2f(v)
  #define GAPB(MF,X,B) do{ MF; X[B]=EX(X[B]); X[B+1]=EX(X[B+1]); PIN(X); SBAR(); }while(0)
  #define VRD(n) do{ vlo[n]=vtr(vp_+(((n)&3)*4096+((n)>>2)*1024)); vhi[n]=vtr(vp_+(((n)&3)*4096+((n)>>2)*1024+512)); }while(0)
  #define KRD(G,j) do{ if(G){ kload2(kf,kp0+sl_next,j); SBAR(); } }while(0)
  #define PVM(n,k) o[(n)&3]=__builtin_amdgcn_mfma_f32_32x32x16_bf16(PAF(k),VFR(n),o[(n)&3],0,0,0)
  #define STEP(C0,C1,P0,P1,t,GK,GV,GL) do{ SBAR(); \
    const lds_cptr vp_=vp0+2*sl_prev; \
    VRD(0); SBAR(); float sacc=(P0[0]+P0[1]); \
    GAPA(C0=__builtin_amdgcn_mfma_f32_32x32x16_bf16(kf[0],qr[0],f32x16{},0,0,0), P0[2],P0[3],P0[4],P0[5],     pw0[0]=PKW(P0,0), pw0[1]=PKW(P0,2), pw0); \
    VRD(1); SBAR(); GAPA(C1=__builtin_amdgcn_mfma_f32_32x32x16_bf16(kf[1],qr[0],f32x16{},0,0,0), P0[6],P0[7],P0[8],P0[9],     pw0[2]=PKW(P0,4), pw0[3]=PKW(P0,6), pw0); \
    VRD(2); SBAR(); GAPA(C0=__builtin_amdgcn_mfma_f32_32x32x16_bf16(kf[2],qr[1],C0,0,0,0),   P0[10],P0[11],P0[12],P0[13], pw1[0]=PKW(P0,8), pw1[1]=PKW(P0,10), pw1); \
    VRD(3); SBAR(); GAPA(C1=__builtin_amdgcn_mfma_f32_32x32x16_bf16(kf[3],qr[1],C1,0,0,0),   P0[14],P0[15],P1[0],P1[1],   pw1[2]=PKW(P0,12),pw1[3]=PKW(P0,14), pw1); \
    VRD(4); SBAR(); GAPA(C0=__builtin_amdgcn_mfma_f32_32x32x16_bf16(kf[4],qr[2],C0,0,0,0),   P1[2],P1[3],P1[4],P1[5],     pw2[0]=PKW(P1,0), pw2[1]=PKW(P1,2), pw2); \
    VRD(5); SBAR(); GAPA(C1=__builtin_amdgcn_mfma_f32_32x32x16_bf16(kf[5],qr[2],C1,0,0,0),   P1[6],P1[7],P1[8],P1[9],     pw2[2]=PKW(P1,4), pw2[3]=PKW(P1,6), pw2); \
    VRD(6); SBAR(); GAPA(C0=__builtin_amdgcn_mfma_f32_32x32x16_bf16(kf[6],qr[3],C0,0,0,0),   P1[10],P1[11],P1[12],P1[13], pw3[0]=PKW(P1,8), pw3[1]=PKW(P1,10), pw3); \
    VRD(7); SBAR(); GAPA(C1=__builtin_amdgcn_mfma_f32_32x32x16_bf16(kf[7],qr[3],C1,0,0,0),   P1[14],P1[15],0.f,0.f,       pw3[2]=PKW(P1,12),pw3[3]=PKW(P1,14), pw3); \
    l_reg+=sacc; \
    if(GK){DMA_K((t)+3,sl_cur);} if(GV){DMA_V((t)+1,sl_next);} \
    { float a=MX3(C0[0],C0[1],C1[0]),b=MX3(C0[2],C0[3],C1[1]); a=MX3(a,C1[2],C1[3]); \
      _Pragma("unroll") for(int r=4;r<16;r+=4){a=MX3(a,C0[r],C0[r+1]);b=MX3(b,C0[r+2],C0[r+3]);a=MX3(a,C1[r],C1[r+1]);b=MX3(b,C1[r+2],C1[r+3]);} \
      float rm=__builtin_fmaxf(a,b); { auto rr=__builtin_amdgcn_permlane32_swap(__float_as_uint(rm),__float_as_uint(rm),false,false); rm=__builtin_fmaxf(__uint_as_float(rr[0]),__uint_as_float(rr[1])); } \
      rm-=mhat; \
      resc=false; \
      if(__builtin_expect(__any(rm>(float)THRL),0)){ const float dl=__builtin_fmaxf(rm,0.f); mhat+=dl; \
        const float f=__builtin_amdgcn_exp2f(-dl); l_reg*=f; if(hi==0)wsf[r32]=f; resc=true; } \
      _Pragma("unroll") for(int r=0;r<16;++r){C0[r]-=mhat;C1[r]-=mhat;} } \
    SBAR(); \
    VRD(8);  SBAR(); GAPB(PVM(0,0),C0,0); \
    VRD(9);  SBAR(); GAPB(PVM(1,0),C0,2); \
    VRD(10); SBAR(); GAPB(PVM(2,0),C0,4); \
    VRD(11); SBAR(); GAPB(PVM(3,0),C0,6); \
    VRD(12); SBAR(); GAPB(PVM(4,1),C0,8); \
    VRD(13); SBAR(); GAPB(PVM(5,1),C0,10); \
    VRD(14); SBAR(); GAPB(PVM(6,1),C0,12); \
    VRD(15); SBAR(); GAPB(PVM(7,1),C0,14); \
    KRD(GL,0); GAPB(PVM(8,2),C1,0); \
    KRD(GL,1); GAPB(PVM(9,2),C1,2); \
    KRD(GL,2); GAPB(PVM(10,2),C1,4); \
    KRD(GL,3); GAPB(PVM(11,2),C1,6); \
    GAPB(PVM(12,3),C1,8); \
    GAPB(PVM(13,3),C1,10); \
    GAPB(PVM(14,3),C1,12); \
    GAPB(PVM(15,3),C1,14); \
    }while(0)
  int t=1;
  for(;t+5<NT;t+=2){
    STEP(pB0,pB1,pA0,pA1,t,true,true,true);     WAIT_BAR(3); RESC(); ROT();
    STEP(pA0,pA1,pB0,pB1,t+1,true,true,true);   WAIT_BAR(3); RESC(); ROT();
  }
  #define ENDW(tt) do{ if((tt)+3<NT){WAIT_BAR(3);} else if((tt)+2<NT){WAIT_BAR(2);} else {WAIT_BAR(0);} }while(0)
  for(;t+1<NT;t+=2){
    STEP(pB0,pB1,pA0,pA1,t,(t+3<NT),(t+1<NT),(t+1<NT));       ENDW(t);   RESC(); ROT();
    STEP(pA0,pA1,pB0,pB1,t+1,(t+4<NT),(t+2<NT),(t+2<NT));     ENDW(t+1); RESC(); ROT();
  }
  STEP(pB0,pB1,pA0,pA1,NT-1,false,false,false); RESC();
  { float sacc=pB0[0]+pB0[1]; _Pragma("unroll") for(int r=2;r<16;++r)sacc+=pB0[r]; _Pragma("unroll") for(int r=0;r<16;++r)sacc+=pB1[r]; l_reg+=sacc;
    pw0=(u32x4){PKW(pB0,0),PKW(pB0,2),PKW(pB0,4),PKW(pB0,6)};pw1=(u32x4){PKW(pB0,8),PKW(pB0,10),PKW(pB0,12),PKW(pB0,14)};pw2=(u32x4){PKW(pB1,0),PKW(pB1,2),PKW(pB1,4),PKW(pB1,6)};pw3=(u32x4){PKW(pB1,8),PKW(pB1,10),PKW(pB1,12),PKW(pB1,14)};
    SBAR(); pv4(o,vb0+2*sl_cur,PAF(0),PAF(1),PAF(2),PAF(3)); }
  #undef PKW
  #undef PAF
  #undef VFR
  #undef MX3
  #undef GAPA
  #undef GAPB
  #undef EX
  #undef VRD
  #undef KRD
  #undef PVM
  #undef STEP
  #undef ENDW
  {auto rr=__builtin_amdgcn_permlane32_swap(__float_as_uint(l_reg),__float_as_uint(l_reg),false,false);l_reg=__uint_as_float(rr[0])+__uint_as_float(rr[1]);}
  if(hi==0)wsf[32+r32]=l_reg;asm volatile("s_waitcnt lgkmcnt(0)":::"memory");
  typedef unsigned u32x2v __attribute__((ext_vector_type(2)));
  u32x2v*sp=(u32x2v*)(shm+LDS_O1+wid*8192)+lane;
  if(!second){
    #pragma unroll
    for(int r=0;r<16;++r){ const float rl=__builtin_amdgcn_rcpf(wsf[32+crow(r,hi)]); const u32x2v v={cvtpk_s(o[0][r]*rl,o[1][r]*rl),cvtpk_s(o[2][r]*rl,o[3][r]*rl)}; sp[r*64]=v; }
  } else {
    float g4[4];
    #pragma unroll
    for(int d0=0;d0<4;++d0)g4[d0]=subg[d0*32+r32]*post;
    #pragma unroll
    for(int r=0;r<16;++r){ const float rl=__builtin_amdgcn_rcpf(wsf[32+crow(r,hi)])*lam; const u32x2v av=sp[r*64];
      const float a0=__uint_as_float(av[0]<<16),a1=__uint_as_float(av[0]&0xffff0000u),a2=__uint_as_float(av[1]<<16),a3=__uint_as_float(av[1]&0xffff0000u);
      float v0=a0-o[0][r]*rl,v1=a1-o[1][r]*rl,v2=a2-o[2][r]*rl,v3=a3-o[3][r]*rl; float ss=(v0*v0+v1*v1)+(v2*v2+v3*v3);
      ss+=__shfl_xor(ss,1);ss+=__shfl_xor(ss,2);ss+=__shfl_xor(ss,4);ss+=__shfl_xor(ss,8);ss+=__shfl_xor(ss,16);
      const float rn=__builtin_amdgcn_rsqf(ss*(1.0f/128.0f)+1e-6f);
      o[0][r]=v0*rn*g4[0];o[1][r]=v1*rn*g4[1];o[2][r]=v2*rn*g4[2];o[3][r]=v3*rn*g4[3]; }
    bf16*Ow=Ou+(long)(wid*QBLK)*op;
    bf16*stg=(bf16*)(shm+LDS_O1+wid*8192);
    asm volatile("s_waitcnt lgkmcnt(0)":::"memory");
    #pragma unroll
    for(int r=0;r<16;++r){const int orow=crow(r,hi);
      #pragma unroll
      for(int d0=0;d0<4;++d0)stg[orow*128+d0*32+r32]=__float2bfloat16(o[d0][r]);}
    asm volatile("s_waitcnt lgkmcnt(0)":::"memory");
    #pragma unroll
    for(int i=0;i<8;++i){const int row=i*4+(lane>>4),ch=lane&15; const u32x4 v=*(const u32x4*)(stg+row*128+ch*8); ATTN_STORE16(Ow+(long)row*op+ch*8,v);}
  }
  asm volatile("s_waitcnt lgkmcnt(0)\n\ts_barrier":::"memory");
  #undef PIN
  #undef DMA_K
  #undef DMA_V
  #undef START
  #undef RESC
  #undef ROT
}
#undef SBAR
#undef WAIT_BAR
}

typedef unsigned short bf16;
typedef float f32x4 __attribute__((ext_vector_type(4)));
typedef unsigned u32x4 __attribute__((ext_vector_type(4)));
typedef unsigned u32x2 __attribute__((ext_vector_type(2)));
constexpr int D = 1024, NBATCH = 4, SEQ = 4096, CTXL = 256, DEPTH = 2;
constexpr int MLAT = NBATCH * SEQ, MCTX = NBATCH * CTXL, MTOT = MLAT + MCTX;
constexpr int KVR = SEQ + CTXL;
constexpr int NIN = 6144, NE = 32, TOPK = 4, NWAVES = 8;
constexpr int MAXTILES = 304;
constexpr float EPS = 1e-6f;

constexpr size_t al256(size_t x) { return (x + 255) / 256 * 256; }
constexpr size_t WS_CTL = 0, CTL_BYTES = 1u << 20;
constexpr size_t WS_MOD = WS_CTL + CTL_BYTES;
constexpr size_t WS_ROPEC = WS_MOD + al256((size_t)DEPTH * 5 * NIN * 4);
constexpr size_t WS_ROPES = WS_ROPEC + 4096;
constexpr size_t WS_LAM = WS_ROPES + 4096;
constexpr size_t WS_PV = WS_LAM + 256;
constexpr size_t WS_WIN = WS_PV + (size_t)DEPTH * 5 * 4 * D * 4;
constexpr size_t WS_WB = WS_WIN + (size_t)DEPTH * NIN * D * 2;
constexpr size_t WS_WO = WS_WB + (size_t)DEPTH * 3 * D * 512 * 2;
constexpr size_t WS_W1 = WS_WO + (size_t)DEPTH * D * D * 2;
constexpr size_t WS_W2 = WS_W1 + (size_t)DEPTH * NE * 2048 * D * 2;
constexpr size_t WS_X = WS_W2 + (size_t)DEPTH * NE * D * D * 2;
constexpr size_t WS_H = WS_X + (size_t)MTOT * D * 4;
constexpr size_t WS_QA = WS_H + (size_t)MTOT * D * 2;
constexpr size_t WS_QB = WS_QA + (size_t)MTOT * 512 * 2;
constexpr size_t WS_QC = WS_QB + (size_t)MTOT * 512 * 2;
constexpr size_t WS_KA = WS_QC + (size_t)MTOT * 512 * 2;
constexpr size_t WS_VA = WS_KA + (size_t)NBATCH * KVR * 512 * 2;
constexpr size_t WS_KB = WS_VA + (size_t)NBATCH * KVR * 512 * 2;
constexpr size_t WS_VB = WS_KB + (size_t)NBATCH * KVR * 128 * 2;
constexpr size_t WS_KC = WS_VB + (size_t)NBATCH * KVR * 128 * 2;
constexpr size_t WS_VC = WS_KC + (size_t)NBATCH * KVR * 128 * 2;
constexpr size_t WS_GT = WS_VC + (size_t)NBATCH * KVR * 128 * 2;
constexpr size_t WS_YS = WS_GT + (size_t)MTOT * 3072 * 2;
constexpr size_t WS_TMP = WS_YS + (size_t)3 * MTOT * 512 * 2;
constexpr size_t WS_MG = WS_TMP + (size_t)MTOT * D * 4;
constexpr size_t WS_Y = WS_MG + (size_t)MTOT * D * 2;
constexpr size_t WS_H2 = WS_Y + (size_t)MTOT * D * 4;
constexpr size_t WS_SE = WS_H2 + (size_t)MTOT * D * 2;
constexpr size_t WS_SR = WS_SE + (size_t)MTOT * 4 * 4;
constexpr size_t WS_SW = WS_SR + (size_t)MTOT * 4 * 4;
constexpr size_t WS_LIST = WS_SW + (size_t)MTOT * 4 * 4;
constexpr size_t WS_ACT = WS_LIST + (size_t)NE * MTOT * 4;
constexpr size_t WS_YS2 = WS_ACT + (size_t)MAXTILES * 256 * D * 2;
constexpr size_t WS_EX = WS_YS2 + (size_t)MAXTILES * 256 * D * 2;
constexpr size_t WS_END = WS_EX + (size_t)DEPTH * 256 * 131072;
static_assert(WS_WIN % 256 == 0 && WS_X % 256 == 0 && WS_SE % 256 == 0 && WS_ACT % 256 == 0, "alignment");

constexpr int CW_BAR = 4096;
constexpr int CW_Q = 16384;
constexpr int CW_CNT = 8192;

constexpr int RING_BYTES = 141312, MISC_OFF = RING_BYTES, LDS_BYTES = MISC_OFF + 8192;
constexpr int MW_Q = 12; constexpr int MW_BAR = 0, MW_TB = 16, MW_CNT = 64, MW_HIST = 128, MW_BASE = 160, MW_PT = 192, MW_SLOT = 256;

#define LDS_WAIT() asm volatile("s_waitcnt lgkmcnt(0)" ::: "memory")
#define VM_WAIT() asm volatile("s_waitcnt vmcnt(0)" ::: "memory")
__device__ __forceinline__ unsigned f2bf(float f) { unsigned u = __builtin_bit_cast(unsigned, f); return (u + 0x7fffu + ((u >> 16) & 1u)) >> 16; }
typedef float f32x2_t __attribute__((ext_vector_type(2))); typedef __bf16 bf16x2_t __attribute__((ext_vector_type(2)));
__device__ __forceinline__ unsigned pk2(float lo, float hi) { const f32x2_t v = {lo, hi}; const bf16x2_t b = __builtin_convertvector(v, bf16x2_t); return __builtin_bit_cast(unsigned, b); }
__device__ __forceinline__ unsigned pk4f8(float a, float b, float c, float d) {
    int r = __builtin_amdgcn_cvt_pk_fp8_f32(a, b, 0, false); r = __builtin_amdgcn_cvt_pk_fp8_f32(c, d, r, true); return (unsigned)r; }
constexpr float W8_SCALE = 64.0f, W8_INV = 1.0f / 64.0f;
__device__ __forceinline__ float bflo(unsigned w) { return __builtin_bit_cast(float, w << 16); }
__device__ __forceinline__ float bfhi(unsigned w) { return __builtin_bit_cast(float, w & 0xffff0000u); }
template <int CTRL> __device__ __forceinline__ float dppf(float v) { return __builtin_bit_cast(float, __builtin_amdgcn_update_dpp(0, __builtin_bit_cast(int, v), CTRL, 0xf, 0xf, true)); }
template <int CTRL> __device__ __forceinline__ int dppi(int v) { return __builtin_amdgcn_update_dpp(0, v, CTRL, 0xf, 0xf, true); }
__device__ __forceinline__ float rdl(float v, int l) { return __builtin_bit_cast(float, __builtin_amdgcn_readlane(__builtin_bit_cast(int, v), l)); }
__device__ __forceinline__ float wave_sum(float v) {
    v += dppf<0xB1>(v); v += dppf<0x4E>(v); v += dppf<0x141>(v); v += dppf<0x140>(v);
    return (rdl(v, 0) + rdl(v, 16)) + (rdl(v, 32) + rdl(v, 48));
}
__device__ __forceinline__ float sigmoid255_(float x) { return __builtin_amdgcn_rcpf(__builtin_fmaf(__builtin_amdgcn_exp2f(-1.4426950408889634f * x), 1.0f / 255.0f, 1.0f / 255.0f)); }
__device__ __forceinline__ float sigmoidf_(float x) { return __builtin_amdgcn_rcpf(1.0f + __builtin_amdgcn_exp2f(-1.4426950408889634f * x)); }

__device__ __forceinline__ unsigned char* ldp(volatile LAS unsigned* MISC, int i) {
    const unsigned lo = (unsigned)__builtin_amdgcn_readfirstlane((int)MISC[MW_PT + 2 * i]), hi = (unsigned)__builtin_amdgcn_readfirstlane((int)MISC[MW_PT + 2 * i + 1]);
    return (unsigned char*)(((unsigned long long)hi << 32) | lo);
}
typedef const GAS float* gcfp; typedef GAS float* gfp; typedef const GAS unsigned short* gcbp; typedef GAS unsigned short* gbp;
#define INP(i) ((const GAS float*)ldp(MISC, (i)))
#define WSP(T, off) ((GAS T*)(ldp(MISC, 21) + (off)))
#define XB_TMO      128
#define XB_XCNT(j)  (256  + 64 * (j))
#define XB_XSUB(j)  (1280 + 64 * (j))
#define XB_XGEN(j)  (2304 + 64 * (j))
#define XB_TOP      3328
#define XB_TOPGEN   3392
#define XCD_BAR_WORDS 3456
#define XB_SPIN_CAP (1u << 18)

__device__ __forceinline__ unsigned xb_ld(unsigned* p)              { return __hip_atomic_load(p, __ATOMIC_RELAXED, __HIP_MEMORY_SCOPE_AGENT); }
__device__ __forceinline__ unsigned xb_add(unsigned* p, unsigned v) { return __hip_atomic_fetch_add(p, v, __ATOMIC_RELAXED, __HIP_MEMORY_SCOPE_AGENT); }
__device__ __forceinline__ unsigned xb_xcc_id() { return (unsigned)__builtin_amdgcn_s_getreg((3 << 11) | 20) & 0xFu; }
#define XB_SPIN(cond, bar) do { unsigned _sp = 0; while (cond) { __builtin_amdgcn_s_sleep(1); \
    if ((++_sp & 255u) == 0u) { if (xb_ld(&(bar)[XB_TMO])) break; if (_sp > XB_SPIN_CAP) { atomicAdd(&(bar)[XB_TMO], 1u); break; } } } } while (0)

struct XcdBarrier {
    unsigned* bar; unsigned x;
    volatile LAS unsigned* st;
};

__device__ __forceinline__ XcdBarrier xcd_barrier_post(unsigned* bar, volatile LAS unsigned* st) {
    XcdBarrier b; b.bar = bar; b.x = xb_xcc_id(); b.st = st;
    if (threadIdx.x == 0) (void)xb_add(&bar[XB_XCNT(b.x)], 1u);
    return b;
}
__device__ __forceinline__ void xcd_barrier_complete(unsigned* bar, unsigned x, unsigned& nloc, unsigned& nx) {
    const unsigned G = gridDim.x * gridDim.y * gridDim.z;
    unsigned sum, cnt, mine, sp = 0u;
    for (;;) {
        sum = 0u; cnt = 0u; mine = 0u;
#pragma unroll
        for (unsigned j = 0; j < 16; ++j) { const unsigned c = xb_ld(&bar[XB_XCNT(j)]); sum += c; cnt += (c > 0u) ? 1u : 0u; mine = (j == x) ? c : mine; }
        if (sum == G) break;
        __builtin_amdgcn_s_sleep(1);
        if ((++sp & 255u) == 0u) { if (xb_ld(&bar[XB_TMO])) break; if (sp > XB_SPIN_CAP) { atomicAdd(&bar[XB_TMO], 1u); break; } }
    }
    nloc = mine > 0u ? mine : 1u; nx = cnt > 0u ? cnt : 1u;
}

__device__ __forceinline__ void xcd_barrier(const XcdBarrier& b, const int tid_now) {
    asm volatile("s_waitcnt vmcnt(0)" ::: "memory");
    __syncthreads();
    if (tid_now == 0) {
        unsigned long long bp_ = (unsigned long long)b.bar; asm volatile("" : "+s"(bp_)); unsigned* bar = (unsigned*)bp_;
        unsigned bx_ = b.x; asm volatile("" : "+s"(bx_));
        __builtin_amdgcn_s_waitcnt(0);
        unsigned nloc = b.st[0], nx = b.st[1];
        if (nloc == 0u) { xcd_barrier_complete(bar, bx_, nloc, nx); b.st[0] = nloc; b.st[1] = nx; }
        const unsigned old = xb_add(&bar[XB_XSUB(bx_)], 1u);
        const unsigned gen = old / nloc;
        if (old + 1u == (gen + 1u) * nloc) {
            __builtin_amdgcn_fence(__ATOMIC_RELEASE, "agent");
            asm volatile("s_waitcnt vmcnt(0)" ::: "memory");
            const unsigned og = xb_add(&bar[XB_TOP], 1u);
            const unsigned tg = og / nx;
            if (og + 1u == (tg + 1u) * nx) xb_add(&bar[XB_TOPGEN], 1u);
            else XB_SPIN(xb_ld(&bar[XB_TOPGEN]) == tg, bar);
            __builtin_amdgcn_fence(__ATOMIC_ACQUIRE, "agent");
            xb_add(&bar[XB_XGEN(bx_)], 1u);
            asm volatile("s_waitcnt vmcnt(0)" ::: "memory");
        } else {
            XB_SPIN(xb_ld(&bar[XB_XGEN(bx_)]) == gen, bar);
            __builtin_amdgcn_fence(__ATOMIC_ACQUIRE, "agent");
            asm volatile("s_waitcnt vmcnt(0)" ::: "memory");
        }
    }
    __syncthreads();
}

using pg8::Unit;
__host__ __device__ __forceinline__ int in_src_col(int nbd) {
    const int pn = nbd >> 3, blk = nbd & 7, bj = blk >> 2, wc = blk & 3;
    if (pn <= 8) { const int hs = pn * 4 + wc; int base;
        if (hs < 8) base = hs * 64; else if (hs < 16) base = 512 + (hs - 8) * 64; else if (hs < 24) base = 1536 + (hs - 16) * 64;
        else if (hs < 32) base = 2304 + (hs - 24) * 64; else if (hs < 34) base = 2048 + (hs - 32) * 64; else base = 2816 + (hs - 34) * 64;
        return base + 32 * bj; }
    if (pn <= 10) return 1024 + (pn - 9) * 256 + blk * 32;
    if (pn == 11) return blk < 4 ? 2176 + blk * 32 : 2944 + (blk - 4) * 32;
    return 3072 + (pn - 12) * 256 + blk * 32;
}
struct EpiInproj {
    static constexpr bool PERM = false;
    volatile LAS unsigned* MISC; int l;
    __device__ __forceinline__ void operator()(const f32x4 (&acc)[2][2][4][2], const Unit& u, int wr, int wc, int fr, int fq) const {
        auto QA = WSP(bf16, WS_QA); auto QB = WSP(bf16, WS_QB); auto QC = WSP(bf16, WS_QC); auto KA = WSP(bf16, WS_KA); auto VA = WSP(bf16, WS_VA);
        auto KB = WSP(bf16, WS_KB); auto VB = WSP(bf16, WS_VB); auto KC = WSP(bf16, WS_KC); auto VC = WSP(bf16, WS_VC); auto GT = WSP(bf16, WS_GT);
        auto ropec = WSP(float, WS_ROPEC); auto ropes = WSP(float, WS_ROPES); auto qkg = INP(10) + l * 128;
        const int pn = u.pn; const bool ctx = u.pm >= (MLAT / 256);
#pragma unroll
        for (int ai = 0; ai < 2; ++ai)
#pragma unroll
            for (int m = 0; m < 4; ++m) {
                const int r = u.pm * 256 + ai * 128 + wr * 64 + m * 16 + fr;
                int kvrow, t = 0;
                if (!ctx) { t = r & (SEQ - 1); kvrow = (r >> 12) * KVR + t; } else { const int rr = r - MLAT; kvrow = (rr >> 8) * KVR + SEQ + (rr & 255); }
                if (pn <= 8) {
                    float v[2][2][4];
#pragma unroll
                    for (int bj = 0; bj < 2; ++bj)
#pragma unroll
                        for (int n = 0; n < 2; ++n)
#pragma unroll
                            for (int j = 0; j < 4; ++j) v[bj][n][j] = acc[ai][bj][m][n][j];
                    const int hs = pn * 4 + wc;
                    const bool isbq = (pn == 4 || pn == 5), isbk = (pn == 8 && wc < 2);
                    if (isbq || isbk) {
                        float ss = 0.f;
#pragma unroll
                        for (int bj = 0; bj < 2; ++bj)
#pragma unroll
                            for (int n = 0; n < 2; ++n)
#pragma unroll
                                for (int j = 0; j < 4; ++j) ss += v[bj][n][j] * v[bj][n][j];
                        ss += __shfl_xor(ss, 16); ss += __shfl_xor(ss, 32);
                        const float rn = __builtin_amdgcn_rsqf(ss * (1.0f / 64.0f) + EPS);
                        gcfp g = qkg + (isbk ? 64 : 0);
#pragma unroll
                        for (int bj = 0; bj < 2; ++bj)
#pragma unroll
                            for (int n = 0; n < 2; ++n) { const f32x4 gv = *(const GAS f32x4*)(g + 32 * bj + 16 * n + 4 * fq);
#pragma unroll
                                for (int j = 0; j < 4; ++j) v[bj][n][j] = v[bj][n][j] * rn * gv[j]; }
                    }
                    if (!ctx) {
#pragma unroll
                        for (int bj = 0; bj < 2; ++bj) { const int pos = bj ? (t & 63) : (t >> 6);
                            const f32x4 cs = *(const GAS f32x4*)(ropec + pos * 16 + 4 * fq), sn = *(const GAS f32x4*)(ropes + pos * 16 + 4 * fq);
#pragma unroll
                            for (int j = 0; j < 4; ++j) { const float x0 = v[bj][0][j], x1 = v[bj][1][j];
                                v[bj][0][j] = x0 * cs[j] - x1 * sn[j]; v[bj][1][j] = x1 * cs[j] + x0 * sn[j]; } }
                    }
                    if (isbq || pn == 6 || pn == 7 || (pn < 2 && !ctx)) {
#pragma unroll
                        for (int bj = 0; bj < 2; ++bj)
#pragma unroll
                            for (int n = 0; n < 2; ++n)
#pragma unroll
                                for (int j = 0; j < 4; ++j) v[bj][n][j] *= att64::C2; }
                    gbp dst;
                    if (pn < 2) dst = QA + (size_t)r * 512 + hs * 64;
                    else if (pn < 4) dst = KA + (size_t)kvrow * 512 + (hs - 8) * 64;
                    else if (pn < 6) dst = QB + (size_t)r * 512 + (hs - 16) * 64;
                    else if (pn < 8) dst = QC + (size_t)r * 512 + (hs - 24) * 64;
                    else if (wc < 2) dst = KB + (size_t)kvrow * 128 + wc * 64;
                    else dst = KC + (size_t)kvrow * 128 + (wc - 2) * 64;
#pragma unroll
                    for (int bj = 0; bj < 2; ++bj) { u32x4 w; w.x = pk2(v[bj][0][0], v[bj][0][1]); w.y = pk2(v[bj][0][2], v[bj][0][3]); w.z = pk2(v[bj][1][0], v[bj][1][1]); w.w = pk2(v[bj][1][2], v[bj][1][3]);
                        *(GAS u32x4*)(dst + 32 * bj + 8 * fq) = w; }
                } else if (pn <= 11) {
#pragma unroll
                    for (int bj = 0; bj < 2; ++bj) { const int c = 128 * bj + 32 * wc + 8 * fq; const f32x4 x = acc[ai][bj][m][0], y = acc[ai][bj][m][1];
                            gbp dst = (pn < 11) ? VA + (size_t)kvrow * 512 + (pn - 9) * 256 + c : ((bj == 0) ? VB : VC) + (size_t)kvrow * 128 + (c & 127);
                            u32x4 w; w.x = pk2(x[0], x[1]); w.y = pk2(x[2], x[3]); w.z = pk2(y[0], y[1]); w.w = pk2(y[2], y[3]); *(GAS u32x4*)dst = w; }
                } else {
#pragma unroll
                    for (int bj = 0; bj < 2; ++bj) { const int c = 128 * bj + 32 * wc + 8 * fq; const f32x4 x = acc[ai][bj][m][0], y = acc[ai][bj][m][1];
                            u32x2 w = {0u, 0u};
#pragma unroll
                            for (int j = 0; j < 4; ++j) { w.x = __builtin_amdgcn_cvt_pk_u8_f32(sigmoid255_(x[j]), (unsigned)j, w.x); w.y = __builtin_amdgcn_cvt_pk_u8_f32(sigmoid255_(y[j]), (unsigned)j, w.y); }
                            *(GAS u32x2*)((GAS unsigned char*)GT + (size_t)r * 3072 + (pn - 12) * 256 + c) = w; }
                }
            }
    }
};

#if defined(EPIDUP_INPROJ)
namespace pg8 { template <> struct epi_dup<::EpiInproj> { static constexpr int v = 1; }; }
#endif
struct MergeOrder {
    int ntiles, G, vcu;
    __device__ __forceinline__ bool next(int i, Unit& u) const { const int rnd = i / 3, sub = i - rnd * 3; const int tl = rnd * G + vcu; if (tl >= ntiles) return false;
        u.pm = sub * (MTOT / 256) + (tl >> 2); u.pn = sub * 4 + (tl & 3); return true; }
    __device__ __forceinline__ unsigned a_row(const Unit&, int) const { return 0u; }
};
struct EpiMerge {
    static constexpr bool PERM = true;
    volatile LAS unsigned* MISC;
    __device__ __forceinline__ bool keep(const Unit& u) const { return (u.pn >> 2) < 2; }
    __device__ __forceinline__ void operator()(f32x4 (&acc)[2][2][4][2], const Unit& u, int wr, int wc, int fr, int fq) const {
        const auto GT = WSP(bf16, WS_GT); auto MG = WSP(bf16, WS_MG);
        const int sub = u.pn >> 2, pnr = u.pn & 3, pmr = u.pm - sub * (MTOT / 256);
        constexpr float GMIN = 1e-24f;
        const int subn = sub < 2 ? sub + 1 : sub;
        const GAS unsigned char* gbase = (const GAS unsigned char*)GT + ((size_t)pmr * 256 + wr * 64 + fr) * 3072 + pnr * 256 + wc * 32 + 8 * fq;
        u32x2 gw[2][4][2], gn[2][4][2];
#pragma unroll
        for (int ai = 0; ai < 2; ++ai)
#pragma unroll
            for (int m = 0; m < 4; ++m)
#pragma unroll
                for (int bj = 0; bj < 2; ++bj) { const GAS unsigned char* p = gbase + (size_t)(ai * 128 + m * 16) * 3072 + bj * 128;
                    gw[ai][m][bj] = *(const GAS u32x2*)(p + sub * 1024); gn[ai][m][bj] = *(const GAS u32x2*)(p + subn * 1024); }
        const float nmin = sub > 0 ? GMIN : 0.0f;
        const bool last = sub == 2;
#pragma unroll
        for (int ai = 0; ai < 2; ++ai)
#pragma unroll
            for (int m = 0; m < 4; ++m)
#pragma unroll
                for (int bj = 0; bj < 2; ++bj) {
                    const u32x2 a = gw[ai][m][bj], b = gn[ai][m][bj];
                    float g[8] = {(float)(a.x & 0xffu), (float)((a.x >> 8) & 0xffu), (float)((a.x >> 16) & 0xffu), (float)(a.x >> 24), (float)(a.y & 0xffu), (float)((a.y >> 8) & 0xffu), (float)((a.y >> 16) & 0xffu), (float)(a.y >> 24)};
                    const float d[8] = {(float)(b.x & 0xffu), (float)((b.x >> 8) & 0xffu), (float)((b.x >> 16) & 0xffu), (float)(b.x >> 24), (float)(b.y & 0xffu), (float)((b.y >> 8) & 0xffu), (float)((b.y >> 16) & 0xffu), (float)(b.y >> 24)};
#pragma unroll
                    for (int k = 0; k < 8; ++k) g[k] = fmaxf(g[k], nmin) * (last ? (1.0f / 255.0f) : __builtin_amdgcn_rcpf(fmaxf(d[k], GMIN)));
                    f32x4 v0 = acc[ai][bj][m][0], v1 = acc[ai][bj][m][1];
                    v0[0] *= g[0]; v0[1] *= g[1]; v0[2] *= g[2]; v0[3] *= g[3]; v1[0] *= g[4]; v1[1] *= g[5]; v1[2] *= g[6]; v1[3] *= g[7];
                    acc[ai][bj][m][0] = v0; acc[ai][bj][m][1] = v1; }
        if (last) {
#pragma unroll
            for (int ai = 0; ai < 2; ++ai)
#pragma unroll
                for (int m = 0; m < 4; ++m) { const size_t row = (size_t)pmr * 256 + ai * 128 + wr * 64 + m * 16 + fr;
#pragma unroll
                    for (int bj = 0; bj < 2; ++bj) { const int col = pnr * 256 + bj * 128 + wc * 32 + 8 * fq; const f32x4 v0 = acc[ai][bj][m][0], v1 = acc[ai][bj][m][1];
                        u32x4 w; w.x = pk2(v0[0], v0[1]); w.y = pk2(v0[2], v0[3]); w.z = pk2(v1[0], v1[1]); w.w = pk2(v1[2], v1[3]); *(GAS u32x4*)(MG + row * 1024 + col) = w; } }
        }
    }
};
namespace pg8 { template <> struct epi_chain<::EpiMerge> { static constexpr bool v = true; }; }
struct EpiOut {
    static constexpr bool PERM = true;
    volatile LAS unsigned* MISC;
    __device__ __forceinline__ void operator()(const f32x4 (&acc)[2][2][4][2], const Unit& u, int wr, int wc, int fr, int fq) const {
        auto Y = WSP(bf16, WS_Y);
#pragma unroll
        for (int ai = 0; ai < 2; ++ai)
#pragma unroll
            for (int m = 0; m < 4; ++m) { gbp rowp = Y + ((size_t)u.pm * 256 + ai * 128 + wr * 64 + m * 16 + fr) * 1024 + u.pn * 256 + wc * 32 + 8 * fq;
#pragma unroll
                for (int bj = 0; bj < 2; ++bj) { const f32x4 v0 = acc[ai][bj][m][0], v1 = acc[ai][bj][m][1];
                    u32x4 w; w.x = pk2(v0[0], v0[1]); w.y = pk2(v0[2], v0[3]); w.z = pk2(v1[0], v1[1]); w.w = pk2(v1[2], v1[3]); *(GAS u32x4*)(rowp + bj * 128) = w; } }
    }
};
template <int NP> struct MoeOrder {
    const LAS int* tb; const LAS int* cn; const GAS int* list; int G, bid, vcu, U, chunk, per;
    __device__ __forceinline__ void init(const LAS int* tb_, const LAS int* cn_, const GAS int* list_, int G_, int bid_) {
        tb = tb_; cn = cn_; list = list_; G = G_; bid = bid_; U = tb_[NE] * NP;
        if (G_ % 8 == 0) { per = G_ / 8; vcu = (bid_ % 8) * per + bid_ / 8; chunk = (U + 7) / 8; } else { per = G_; vcu = bid_; chunk = U; }
    }
    __device__ __forceinline__ bool next(int i, Unit& u) const {
        const int x = vcu / per, j = i * per + (vcu % per); if (j >= chunk) return false;
        const int id = x * chunk + j; if (id >= U) return false;
        const int T = id / NP, pnl = id - T * NP; int e = 0;
#pragma unroll
        for (int q = 1; q < NE; ++q) e += (T >= tb[q]) ? 1 : 0;
        e = __builtin_amdgcn_readfirstlane(e);
        u.pm = T; u.pn = e * NP + pnl; return true;
    }
    __device__ __forceinline__ unsigned a_row(const Unit& u, int r) const {
        const int e = u.pn / NP; int idx = (u.pm - tb[e]) * 256 + r; const int c = cn[e]; idx = idx < c ? idx : c - 1;
        return (unsigned)list[(size_t)e * MTOT + idx];
    }
};
template <bool F8> struct EpiSwiglu {
    static constexpr bool PERM = true;
    volatile LAS unsigned* MISC; int l;
    __device__ __forceinline__ void operator()(const f32x4 (&acc)[2][2][4][2], const Unit& u, int wr, int wc, int fr, int fq) const {
        auto ACT = WSP(bf16, WS_ACT); auto b1 = INP(17) + (size_t)l * NE * 2048;
        const int e = u.pn >> 3, pnl = u.pn & 7; const int col = pnl * 128 + wc * 32 + 8 * fq;
        gcfp bg = b1 + (size_t)e * 2048 + col; gcfp bu = bg + 1024;
        const f32x4 bg0 = *(const GAS f32x4*)bg, bg1 = *(const GAS f32x4*)(bg + 4), bu0 = *(const GAS f32x4*)bu, bu1 = *(const GAS f32x4*)(bu + 4);
#pragma unroll
        for (int ai = 0; ai < 2; ++ai)
#pragma unroll
            for (int m = 0; m < 4; ++m) { const size_t row = (size_t)u.pm * 256 + ai * 128 + wr * 64 + m * 16 + fr;
                float a[8];
#pragma unroll
                for (int n = 0; n < 2; ++n)
#pragma unroll
                    for (int j = 0; j < 4; ++j) { constexpr float SC = F8 ? W8_INV : 1.0f; float gt = acc[ai][0][m][n][j] * SC + (n ? bg1[j] : bg0[j]), up = acc[ai][1][m][n][j] * SC + (n ? bu1[j] : bu0[j]);
                        gt = fminf(gt, 7.0f); up = fminf(fmaxf(up, -7.0f), 7.0f);
                        a[n * 4 + j] = (up + 1.0f) * (gt * sigmoidf_(1.702f * gt)); }
                if constexpr (F8) { u32x2 w; w.x = pk4f8(a[0], a[1], a[2], a[3]); w.y = pk4f8(a[4], a[5], a[6], a[7]); *(GAS u32x2*)((GAS unsigned char*)ACT + row * 1024 + col) = w; }
                else { u32x4 w; w.x = pk2(a[0], a[1]); w.y = pk2(a[2], a[3]); w.z = pk2(a[4], a[5]); w.w = pk2(a[6], a[7]);
                *(GAS u32x4*)(ACT + row * 1024 + col) = w; } }
    }
};
#if defined(EPIDUP_MOE1)
namespace pg8 { template <> struct epi_dup<::EpiSwiglu<true>> { static constexpr int v = 1; }; }
#endif
template <bool F8> struct EpiMoe2 {
    static constexpr bool PERM = true;
    volatile LAS unsigned* MISC; int l;
    __device__ __forceinline__ void operator()(const f32x4 (&acc)[2][2][4][2], const Unit& u, int wr, int wc, int fr, int fq) const {
        auto YS2 = WSP(bf16, WS_YS2); auto b2 = INP(19) + (size_t)l * NE * D;
        const int e = u.pn >> 2, pnl = u.pn & 3;
#pragma unroll
        for (int bj = 0; bj < 2; ++bj) { const int col = pnl * 256 + bj * 128 + wc * 32 + 8 * fq;
            const f32x4 c0 = *(const GAS f32x4*)(b2 + (size_t)e * 1024 + col), c1 = *(const GAS f32x4*)(b2 + (size_t)e * 1024 + col + 4);
#pragma unroll
            for (int ai = 0; ai < 2; ++ai)
#pragma unroll
                for (int m = 0; m < 4; ++m) { const size_t row = (size_t)u.pm * 256 + ai * 128 + wr * 64 + m * 16 + fr;
                    constexpr float SC = F8 ? W8_INV : 1.0f; const f32x4 v0 = acc[ai][bj][m][0] * SC + c0, v1 = acc[ai][bj][m][1] * SC + c1;
                    u32x4 w; w.x = pk2(v0[0], v0[1]); w.y = pk2(v0[2], v0[3]); w.z = pk2(v1[0], v1[1]); w.w = pk2(v1[2], v1[3]);
                    *(GAS u32x4*)(YS2 + row * 1024 + col) = w; } }
    }
};

#if defined(EPIDUP_MOE2)
namespace pg8 { template <> struct epi_dup<::EpiMoe2<true>> { static constexpr int v = 1; }; }
#endif

struct Args { const float* in[20]; float* out; unsigned char* ws; int ph_lo, ph_hi; };

#ifndef MOE_F8_FROM
#define MOE_F8_FROM 0
#endif
__device__ __forceinline__ int sgpr_launder(int x) { asm volatile("" : "+s"(x)); return x; }
#ifndef CVT_SH2
#define CVT_SH2 43
#define CVT_SH4 12
#endif
#ifndef CVT_SH1
#define CVT_SH1 21
#endif
#ifndef CVT_SH6
#define CVT_SH6 4
#endif
#ifndef CVT_SH5
#define CVT_SH5 4
#endif
struct CvtItem { gcfp W; gbp WT; int N, k0, n0, Kd, rowd, f8; };
__device__ __forceinline__ void cvt_load(const CvtItem& I, int lane, float (&v)[32]) {
    const GAS char* base = (const GAS char*)(I.W + (size_t)I.k0 * I.N + I.n0);
    unsigned off = (unsigned)((lane >> 5) * I.N + (lane & 31)) * 4u; const unsigned step = (unsigned)I.N * 8u;
#pragma unroll
    for (int i = 0; i < 32; ++i) { v[i] = __builtin_nontemporal_load((const GAS float*)(base + off)); off += step; }
}
__device__ __forceinline__ void cvt_store(const CvtItem& I, int lane, const float (&v)[32], LAS float* scr) {
#pragma unroll
    for (int i = 0; i < 32; ++i) { const int kk = 2 * i + (lane >> 5); scr[kk * 33 + (lane & 31)] = v[i]; }
    LDS_WAIT(); asm volatile("" ::: "memory");
    const int c = lane & 7;
#pragma unroll
    for (int j = 0; j < 4; ++j) { const int n = (lane >> 3) + 8 * j; const LAS float* s = scr + (8 * c) * 33 + n;
        if (I.f8 & 1) { u32x2 o; o.x = pk4f8(s[0 * 33] * W8_SCALE, s[1 * 33] * W8_SCALE, s[2 * 33] * W8_SCALE, s[3 * 33] * W8_SCALE); o.y = pk4f8(s[4 * 33] * W8_SCALE, s[5 * 33] * W8_SCALE, s[6 * 33] * W8_SCALE, s[7 * 33] * W8_SCALE);
            __builtin_nontemporal_store(o, (GAS u32x2*)((GAS char*)I.WT + (size_t)I.rowd * I.Kd + I.k0 + (unsigned)(n * I.Kd + 8 * c))); }
        else { u32x4 o; o.x = pk2(s[0 * 33], s[1 * 33]); o.y = pk2(s[2 * 33], s[3 * 33]); o.z = pk2(s[4 * 33], s[5 * 33]); o.w = pk2(s[6 * 33], s[7 * 33]);
        const int nd = (I.f8 & 2) ? 16 * ((n >> 2) & 1) + 4 * (n >> 3) + (n & 3) : n;
        __builtin_nontemporal_store(o, (GAS u32x4*)((GAS char*)(I.WT + (size_t)I.rowd * I.Kd + I.k0) + (unsigned)(nd * I.Kd + 8 * c) * 2u)); } }
    LDS_WAIT(); asm volatile("" ::: "memory");
}

__device__ __forceinline__ void ld_row(gcfp p, int lane, f32x4 (&v)[4]) {
#pragma unroll
    for (int j = 0; j < 4; ++j) v[j] = *(const GAS f32x4*)(p + 4 * lane + 256 * j);
}
__device__ __forceinline__ void ld_row_bf(gcbp p, int lane, f32x4 (&v)[4]) {
#pragma unroll
    for (int j = 0; j < 4; ++j) { const u32x2 w = *(const GAS u32x2*)(p + 4 * lane + 256 * j); v[j] = (f32x4){bflo(w.x), bfhi(w.x), bflo(w.y), bfhi(w.y)}; }
}
__device__ __forceinline__ float sumsq_row(const f32x4 (&v)[4]) {
    float s = 0.f;
#pragma unroll
    for (int j = 0; j < 4; ++j) s += (v[j][0] * v[j][0] + v[j][1] * v[j][1]) + (v[j][2] * v[j][2] + v[j][3] * v[j][3]);
    return wave_sum(s);
}
template <bool F8 = false> __device__ __forceinline__ void norm_mod_row(const f32x4 (&x)[4], gcfp g, gcfp sc, gcfp sh, int lane, f32x4 (&h)[4], gbp dst) {
    const float rn = 1.0f / sqrtf(sumsq_row(x) * (1.0f / D) + EPS);
#pragma unroll
    for (int j = 0; j < 4; ++j) { const int c = 4 * lane + 256 * j; const f32x4 gv = *(const GAS f32x4*)(g + c), sv = *(const GAS f32x4*)(sc + c), hv = *(const GAS f32x4*)(sh + c);
        h[j] = (x[j] * rn) * gv * (1.0f + sv) + hv;
        if constexpr (F8) { *(GAS unsigned*)((GAS unsigned char*)dst + c) = pk4f8(h[j][0], h[j][1], h[j][2], h[j][3]); }
        else { u32x2 w; w.x = pk2(h[j][0], h[j][1]); w.y = pk2(h[j][2], h[j][3]); *(GAS u32x2*)(dst + c) = w; } }
}

constexpr int CVT_I_IN = 16 * 192, CVT_I_WB = 3 * 8 * 32, CVT_I_WO = 16 * 32, CVT_I_W1 = NE * 16 * 64, CVT_I_W2 = NE * 16 * 32, CVT_I_L = CVT_I_IN + CVT_I_WB + CVT_I_WO + CVT_I_W1 + CVT_I_W2;
constexpr int CVT_P0_END = CVT_I_IN + CVT_I_WB + CVT_I_WO, CVT_END = DEPTH * CVT_I_L, CVT_REST = CVT_END - CVT_P0_END;
constexpr int CVT_T1_END = CVT_P0_END + (CVT_REST * CVT_SH1) / 100, CVT_T3_END = CVT_T1_END + (CVT_REST * CVT_SH2) / 100, CVT_T6_END = CVT_END - (CVT_REST * CVT_SH6) / 100, CVT_T4_END = CVT_T6_END - (CVT_REST * CVT_SH4) / 100, CVT_T5_END = CVT_T4_END - (CVT_REST * CVT_SH5) / 100;
static_assert(CVT_T3_END >= CVT_I_L, "layer 0's expert weights are converted before its expert GEMMs");
static_assert(CVT_T6_END >= CVT_END - CVT_I_W2, "only layer 1's w2 may wait for layer 1's first expert GEMM");
static_assert(CVT_T5_END >= CVT_I_L + CVT_I_IN + CVT_I_WB + CVT_I_WO && CVT_T5_END >= CVT_T3_END, "only layer 1's expert weights may wait for layer 1's in-projection");
__device__ __forceinline__ void cvt_range(volatile LAS unsigned* MISC, LAS unsigned char* ldsl, int first, int last, int gw, int NGW, int wave, int lane) {
    auto w_in = INP(7); auto w_branch = INP(12); auto w_out = INP(13); auto w1 = INP(16); auto w2 = INP(18);
    auto WIN = WSP(bf16, WS_WIN); auto WB = WSP(bf16, WS_WB); auto WO = WSP(bf16, WS_WO); auto W1 = WSP(bf16, WS_W1); auto W2 = WSP(bf16, WS_W2);
    LAS float* scr = (LAS float*)(ldsl + wave * 16384);
    constexpr int I_IN = CVT_I_IN, I_WB = CVT_I_WB, I_WO = CVT_I_WO, I_W1 = CVT_I_W1, I_W2 = CVT_I_W2, I_L = CVT_I_L;
#define CVT_DECODE(it_, I_) do { const int l_ = (it_) / I_L; int r_ = (it_) - l_ * I_L; \
            if (r_ < I_IN) { const int kb = r_ / 192, nbd = r_ % 192; I_ = CvtItem{w_in + (size_t)l_ * D * NIN, WIN + (size_t)l_ * NIN * D, NIN, 64 * kb, in_src_col(nbd), D, 32 * nbd, (nbd >= 72) ? 2 : 0}; break; } r_ -= I_IN; \
            if (r_ < I_WB) { const int i = r_ / 256, rr = r_ % 256, kb = rr / 32, nb = rr % 32; I_ = CvtItem{w_branch + (size_t)(l_ * 3 + i) * 512 * D, WB + (size_t)(l_ * 3 + i) * D * 512, D, 64 * kb, 32 * nb, 512, 32 * nb, 0}; break; } r_ -= I_WB; \
            if (r_ < I_WO) { const int kb = r_ / 32, nb = r_ % 32; I_ = CvtItem{w_out + (size_t)l_ * D * D, WO + (size_t)l_ * D * D, D, 64 * kb, 32 * nb, D, 32 * nb, 0}; break; } r_ -= I_WO; \
            if (r_ < I_W1) { const int e = r_ / 1024, rr = r_ % 1024, kb = rr / 64, nbd = rr % 64; const int pn = nbd >> 3, blk = nbd & 7, bj = blk >> 2, q = blk & 3; \
                const bool f8_ = (l_ >= MOE_F8_FROM);     \
                I_ = CvtItem{w1 + (size_t)(l_ * NE + e) * D * 2048, f8_ ? (gbp)((GAS char*)(W1 + (size_t)l_ * NE * 2048 * D) + (size_t)e * 2048 * D) : W1 + (size_t)(l_ * NE + e) * 2048 * D, 2048, 64 * kb, bj * 1024 + 128 * pn + 32 * q, D, 32 * nbd, f8_ ? 1 : 0}; break; } r_ -= I_W1; \
            { const int e = r_ / 512, rr = r_ % 512, kb = rr / 32, nb = rr % 32; const bool f8_ = (l_ >= MOE_F8_FROM); \
              I_ = CvtItem{w2 + (size_t)(l_ * NE + e) * D * D, f8_ ? (gbp)((GAS char*)(W2 + (size_t)l_ * NE * D * D) + (size_t)e * D * D) : W2 + (size_t)(l_ * NE + e) * D * D, D, 64 * kb, 32 * nb, D, 32 * nb, f8_ ? 1 : 0}; } } while (0)
        {
            int it = first + gw; CvtItem Iq[4]; float v[4][32];
#define CVT_PRE(k, itx) do { if ((itx) < last) { CVT_DECODE((itx), Iq[k]); cvt_load(Iq[k], lane, v[k]); } } while (0)
#define CVT_STG(k) { CVT_PRE(((k) + 3) & 3, it + 3 * NGW); cvt_store(Iq[k], lane, v[k], scr); it += NGW; if (it >= last) break; }
            CVT_PRE(0, it); CVT_PRE(1, it + NGW); CVT_PRE(2, it + 2 * NGW);
            if (it < last) for (;;) { CVT_STG(0) CVT_STG(1) CVT_STG(2) CVT_STG(3) }
#undef CVT_PRE
#undef CVT_STG
        }
#undef CVT_DECODE
}

#ifndef DISMASK
#define DISMASK 0
#endif
#define EN(k) (((DISMASK >> (k)) & 1) == 0)
#ifndef TOKPROBE
#define TOKPROBE 0
#endif
#ifndef DUPMASK
#ifndef INPROJ_STAGGER
#define INPROJ_STAGGER 2
#endif
#ifndef A128DUP
#define A128DUP 0
#endif
#define DUPMASK 0
#endif
#define REPS(k) ((((DUPMASK) >> (k)) & 1) ? 2 : 1)
__device__ __forceinline__ void ld_prod(gcfp a, gcfp b, int lane, f32x4 (&o)[4]) {
#pragma unroll
    for (int j = 0; j < 4; ++j) o[j] = *(const GAS f32x4*)(a + 4 * lane + 256 * j) * *(const GAS f32x4*)(b + 4 * lane + 256 * j);
}
__device__ __forceinline__ void ld_scale(gcfp g, gcfp sc, int lane, f32x4 (&A)[4]) {
#pragma unroll
    for (int j = 0; j < 4; ++j) A[j] = *(const GAS f32x4*)(g + 4 * lane + 256 * j) * (1.0f + *(const GAS f32x4*)(sc + 4 * lane + 256 * j));
}
template <bool F8 = false> __device__ __forceinline__ void norm_affine_row(const f32x4 (&x)[4], const f32x4 (&A)[4], int lane, f32x4 (&h)[4], gbp dst) {
    const float rn = __builtin_amdgcn_rsqf(sumsq_row(x) * (1.0f / D) + EPS);
#pragma unroll
    for (int j = 0; j < 4; ++j) { const int c = 4 * lane + 256 * j; h[j] = (x[j] * rn) * A[j] + h[j];
        if constexpr (F8) { *(GAS unsigned*)((GAS unsigned char*)dst + c) = pk4f8(h[j][0], h[j][1], h[j][2], h[j][3]); }
        else { u32x2 w; w.x = pk2(h[j][0], h[j][1]); w.y = pk2(h[j][2], h[j][3]); *(GAS u32x2*)(dst + c) = w; } }
}
__global__ void __launch_bounds__(NWAVES * 64, 2) mk_fwd(Args args) {
    extern __shared__ __attribute__((aligned(16))) unsigned char lds[];
    LAS unsigned char* ldsl = (LAS unsigned char*)lds;
    volatile LAS unsigned* MISC = (volatile LAS unsigned*)(ldsl + MISC_OFF);
    const int tid = threadIdx.x; const int wave0 = __builtin_amdgcn_readfirstlane(tid >> 6);
#define TIDNOW() (wave0 * 64 + lane_now())
    const int G = gridDim.x, bid = blockIdx.x;
    const int vcu = (G % 8 == 0) ? (bid % 8) * (G / 8) + bid / 8 : bid;
    const int G0 = G, bid0 = bid, vcu0 = vcu, wave00 = wave0;
#define IDS_NOW const int G = sgpr_launder(G0), bid = sgpr_launder(bid0), vcu = sgpr_launder(vcu0), wave0 = sgpr_launder(wave00); (void)G; (void)bid; (void)vcu; (void)wave0
    unsigned* ctl = (unsigned*)(GAS unsigned*)(args.ws + WS_CTL);
    for (int u = tid; u < (LDS_BYTES - MISC_OFF) / 4; u += NWAVES * 64) MISC[u] = 0u;
    __syncthreads();
    if (tid == 0) {
#pragma unroll
        for (int i = 0; i < 22; ++i) { const unsigned long long pv = i < 20 ? (unsigned long long)args.in[i] : (i == 20 ? (unsigned long long)args.out : (unsigned long long)args.ws);
            MISC[MW_PT + 2 * i] = (unsigned)pv; MISC[MW_PT + 2 * i + 1] = (unsigned)(pv >> 32); }
    }
    __syncthreads();
    XcdBarrier bar = xcd_barrier_post(ctl + CW_BAR, MISC + MW_BAR);
    const int lo = args.ph_lo, hi = args.ph_hi;
#define IN(k) (sgpr_launder(lo) <= (k) && (k) < sgpr_launder(hi))
#define SEAM(k) do { if (IN(k) && IN((k) + 1)) xcd_barrier(bar, TIDNOW()); } while (0)

    const int NGW = G * NWAVES;
#define PHASE_IDS const int lane = lane_now(), tid = wave0 * 64 + lane, wave = wave0, gw = vcu * NWAVES + wave; (void)gw; (void)lane

    for (int rep_ = 0; rep_ < REPS(0); ++rep_) { if (rep_) xcd_barrier(bar, TIDNOW());
    if (IN(0) && EN(0)) {
        IDS_NOW;
        PHASE_IDS;
        auto c_in = INP(1); auto cctx_in = INP(3); auto ada_w = INP(4); auto ada_b = INP(5);
        auto diff_lambda = INP(8);
        auto MOD = WSP(float, WS_MOD); auto ROPEC = WSP(float, WS_ROPEC); auto ROPES = WSP(float, WS_ROPES); auto LAMV = WSP(float, WS_LAM);
        if (bid < 2 * 96) {
            const int l = bid / 96, nb = bid % 96;
            LAS float* sl = (LAS float*)(ldsl + wave * 2560);
            LAS float* part = (LAS float*)(ldsl + 32768);
            { float cvv[10];
#pragma unroll
              for (int t = 0; t < 10; ++t) { const int idx = lane + 64 * t; const int r = idx >> 7, kk = idx & 127, k = wave * 128 + kk; cvv[t] = r < 4 ? c_in[r * D + k] : cctx_in[k]; }
#pragma unroll
              for (int t = 0; t < 10; ++t) sl[lane + 64 * t] = cvv[t] / (1.0f + __expf(-cvv[t])); }
            LDS_WAIT(); asm volatile("" ::: "memory");
            float a[5];
#pragma unroll
            for (int r = 0; r < 5; ++r) a[r] = 0.f;
            gcfp wp = ada_w + ((size_t)l * D + wave * 128) * NIN + nb * 64 + lane;
#pragma unroll 32
            for (int kk = 0; kk < 128; ++kk) { const float wv = wp[(size_t)kk * NIN];
#pragma unroll
                for (int r = 0; r < 5; ++r) a[r] += wv * sl[r * 128 + kk]; }
#pragma unroll
            for (int r = 0; r < 5; ++r) part[(wave * 5 + r) * 64 + lane] = a[r];
            __syncthreads();
            for (int idx = tid; idx < 320; idx += NWAVES * 64) { const int r = idx >> 6, cc = idx & 63; float s = ada_b[l * NIN + nb * 64 + cc];
#pragma unroll
                for (int w = 0; w < 8; ++w) s += part[(w * 5 + r) * 64 + cc];
                MOD[((size_t)l * 5 + r) * NIN + nb * 64 + cc] = s; }
            __syncthreads();
        }
        if (bid == G - 1) {
            for (int idx = tid; idx < 1024; idx += NWAVES * 64) { const int pos = idx >> 4, p = idx & 15; const float inv = powf(10000.0f, -(float)p / 16.0f); const float ang = (float)pos * inv;
                ROPEC[idx] = cosf(ang); ROPES[idx] = sinf(ang); }
            if (wave < 2) { gcfp lv = diff_lambda + wave * 256;
                const float s1 = wave_sum(lv[lane] * lv[64 + lane]), s2 = wave_sum(lv[128 + lane] * lv[192 + lane]);
                const float lam_init = 0.8f - 0.6f * expf(-0.3f * (float)wave);
                if (lane == 0) LAMV[wave] = expf(s1) - expf(s2) + lam_init; }
        }
        cvt_range(MISC, ldsl, 0, CVT_P0_END, gw, NGW, wave, lane);
    }
    }
    SEAM(0);
    if (IN(1) && EN(1)) {
        IDS_NOW;
        PHASE_IDS;
        auto x_in = INP(0); auto ctx_in = INP(2); auto norm_g = INP(6);
        auto MOD = WSP(float, WS_MOD); auto X = WSP(float, WS_X); auto H = WSP(bf16, WS_H);
        {
            auto PV = WSP(float, WS_PV);
            for (int idx = bid * (NWAVES * 64) + tid; idx < DEPTH * 5 * D; idx += G * NWAVES * 64) { const int l_ = idx / (5 * D), mr_ = (idx / D) % 5, d_ = idx % D;
                gcfp md_ = MOD + ((size_t)l_ * 5 + mr_) * NIN; gcfp ng_ = norm_g + (size_t)l_ * 4 * D; gfp pv_ = PV + ((size_t)l_ * 5 + mr_) * 4 * D;
                pv_[d_] = md_[2 * D + d_] * ng_[D + d_]; pv_[D + d_] = ng_[2 * D + d_] * (1.0f + md_[4 * D + d_]); pv_[2 * D + d_] = md_[5 * D + d_] * ng_[3 * D + d_]; pv_[3 * D + d_] = ng_[d_] * (1.0f + md_[D + d_]); }
        }
        {
            const int RPB = (MTOT + G - 1) / G, r0 = bid * RPB;
            int i = wave; bool have = (i < RPB && r0 + i < MTOT); f32x4 xn[4], A2[4]; int mrc = -1;
#define P1SRC(r_) ((r_) < MLAT ? x_in + (size_t)(r_) * D : ctx_in + (size_t)((r_) - MLAT) * D)
            if (have) ld_row(P1SRC(r0 + i), lane, xn);
            while (have) {
                const int r = r0 + i; f32x4 xv[4], hv[4];
#pragma unroll
                for (int j = 0; j < 4; ++j) xv[j] = xn[j];
                const int inx = i + NWAVES; const bool hn = (inx < RPB && r0 + inx < MTOT);
                if (hn) ld_row(P1SRC(r0 + inx), lane, xn);
                const int mr = r < MLAT ? (r >> 12) : 4;
                gcfp md = MOD + (size_t)mr * NIN; ld_row(md, lane, hv);
                if (mr != mrc) { ld_scale(norm_g, md + 1024, lane, A2); mrc = mr; }
                norm_affine_row(xv, A2, lane, hv, H + (size_t)r * D);
                i = inx; have = hn;
            }
#undef P1SRC
        }
    }
    SEAM(1);

    for (int l = 0; l < DEPTH; ++l) {
        const int pb = 2 + 8 * l; const bool lastl = (l == DEPTH - 1);
        const int ML = lastl ? MLAT : MTOT;
        unsigned* cntg = ctl + CW_CNT + l * 32 * 64;
        for (int rep_ = 0; rep_ < (l == 0 ? REPS(2) : 1); ++rep_) { if (rep_) xcd_barrier(bar, TIDNOW());
        if (IN(pb + 0) && EN(2)) {
            IDS_NOW;
            auto H = WSP(bf16, WS_H); auto WIN = WSP(bf16, WS_WIN);
            pg8::Gemm g{(const bf16*)H, (const bf16*)(WIN + (size_t)l * NIN * D), MTOT, NIN, D}; pg8::StaticOrder S; S.init(MTOT, NIN, G, bid);
            EpiInproj E{MISC, l};
            { const int c0s = (MTOT / 256) * (NIN / 256) - ((MTOT / 256) * (NIN / 256) / G) * G;
              if (c0s > 0 && bid >= c0s) { const int nsl = INPROJ_STAGGER * (1 + (bid - c0s) % 3); for (int i_ = 0; i_ < nsl; ++i_) __builtin_amdgcn_s_sleep(64); } }
            pg8::gemm_phase<EpiInproj, pg8::StaticOrder, false>(ldsl, g, S, E, wave0);
            { const int nfull = (MTOT / 256) * (NIN / 256) / G, c0 = (MTOT / 256) * (NIN / 256) - nfull * G;
              if (c0 > 0 && bid >= c0) { const int tc = TIDNOW(); const int wv = wave0;
                  cvt_range(MISC, ldsl, l == 0 ? CVT_P0_END : CVT_T4_END, l == 0 ? CVT_T1_END : CVT_T6_END, (bid - c0) * NWAVES + wv, (G - c0) * NWAVES, wv, tc & 63); } }
        }
        }
        SEAM(pb + 0);
        for (int rep_ = 0; rep_ < (l == 0 ? REPS(3) : 1); ++rep_) { if (rep_) xcd_barrier(bar, TIDNOW());
        if (IN(pb + 1) && EN(3)) {
            IDS_NOW;
            auto diff_subln = INP(9); auto sink = INP(11); auto LAMV = WSP(float, WS_LAM);
            auto QA = WSP(bf16, WS_QA); auto QB = WSP(bf16, WS_QB); auto QC = WSP(bf16, WS_QC);
            auto KA = WSP(bf16, WS_KA); auto VA = WSP(bf16, WS_VA); auto KB = WSP(bf16, WS_KB); auto VB = WSP(bf16, WS_VB); auto KC = WSP(bf16, WS_KC); auto VC = WSP(bf16, WS_VC);
            auto YS = WSP(bf16, WS_YS);
            const int NU = lastl ? 1536 : 1632;
            const float lam = LAMV[l]; const float post = 1.0f - (0.8f - 0.6f * expf(-0.3f * (float)l));
            {
                for (int rp_ = 0; rp_ < ((A128DUP && l == 0) ? 2 : 1); ++rp_)
                for (int pr = vcu; pr < 256; pr += G) {
                    const int b = pr >> 6, hh = (pr >> 4) & 3, q0 = b * SEQ + (pr & 15) * 256;
                    const size_t kv0 = (size_t)b * KVR * 512 + hh * 128;
                    for (int mp = 0; mp < 2; ++mp) {
                        __syncthreads();
                        att128::attn_unit<8>((const att64::bf16*)(const bf16*)(QA + (size_t)q0 * 512 + hh * 128 + mp * 64), 512, (const att64::bf16*)(const bf16*)(KA + kv0 + mp * 64), (const att64::bf16*)(const bf16*)(VA + kv0), 512, 68, mp,
                                             lam, diff_subln + l * 128, post, (att64::bf16*)(bf16*)(YS + (size_t)q0 * 512 + hh * 128), 512, (char*)lds, wave0);
                    }
                }
            }
            for (int i = 0;; ++i) {
                const int L = 512 + i * G + vcu; if (L >= NU) break;
                int type, b, hh, qb, qrow; bool isctx;
                if (L < 1536) { type = L / 512; const int idx = L % 512; b = idx >> 7; hh = (idx >> 5) & 3; qb = idx & 31; qrow = b * SEQ + qb * 128; isctx = false; }
                else { const int e = L - 1536; type = e / 32; const int idx = e % 32; b = idx >> 3; hh = (idx >> 1) & 3; qb = idx & 1; qrow = MLAT + b * CTXL + qb * 128; isctx = true; }
                if (type != 0) {
                    __syncthreads();
                    const int idx = isctx ? (L - 1536) % 32 : L % 512;
                    if (type == 1) {
                        const int b1 = isctx ? idx >> 3 : idx >> 7, head = isctx ? idx & 7 : (idx >> 4) & 7, q0 = isctx ? MLAT + b1 * CTXL : b1 * SEQ + (idx & 15) * 256;
                        const size_t kv0 = ((size_t)b1 * KVR + (isctx ? SEQ : 0)) * 128 + (head >> 2) * 64; const int nt = isctx ? 4 : 68;
                        att64::attn_unit<8, false, false>((const att64::bf16*)(const bf16*)(QB + (size_t)q0 * 512 + head * 64), 512, (const att64::bf16*)(const bf16*)(KB + kv0), (const att64::bf16*)(const bf16*)(VB + kv0), 128, nt, nt, 0, 0, 0, 0, 0.f, 0.f,
                                                         (att64::bf16*)(bf16*)(YS + (size_t)MTOT * 512 + (size_t)q0 * 512 + head * 64), 512, (char*)lds, wave0);
                    } else {
                        const int b1 = isctx ? idx >> 3 : idx >> 7, hp = isctx ? (idx >> 1) & 3 : (idx >> 5) & 3, qbl = isctx ? idx & 1 : idx & 31;
                        const int head = 2 * hp, q0 = isctx ? MLAT + b1 * CTXL + qbl * 128 : b1 * SEQ + qbl * 128;
                        const size_t kv0 = ((size_t)b1 * KVR + SEQ) * 128 + (head >> 2) * 64; const float sl2a = sink[l * 8 + head] * 1.4426950408889634f, sl2b = sink[l * 8 + head + 1] * 1.4426950408889634f;
                        const att64::bf16* qp_ = (const att64::bf16*)(const bf16*)(QC + (size_t)q0 * 512 + head * 64); att64::bf16* op_ = (att64::bf16*)(bf16*)(YS + (size_t)2 * MTOT * 512 + (size_t)q0 * 512 + head * 64);
                        if (isctx) att64::attn_unit<8, false, true>(qp_, 512, (const att64::bf16*)(const bf16*)(KC + kv0), (const att64::bf16*)(const bf16*)(VC + kv0), 128, 4, 4, 0, 0, 0, 1, sl2a, sl2b, op_, 512, (char*)lds, wave0);
                        else { const int qpos = qbl * 128; const int klo = qpos - 128 < 0 ? 0 : qpos - 128, khi = qpos + 256 > SEQ ? SEQ : qpos + 256; const int n2 = (khi - klo) / 64;
                            att64::attn_unit<8, true, true>(qp_, 512, (const att64::bf16*)(const bf16*)(KC + kv0), (const att64::bf16*)(const bf16*)(VC + kv0), 128, 4 + n2, 4, klo - SEQ, klo, qpos, 1, sl2a, sl2b, op_, 512, (char*)lds, wave0); }
                    }
                    continue;
                }
                att::UnitArgs A;
                A.s1 = isctx ? SEQ : 0; A.n1 = isctx ? 4 : 68; A.s2 = 0; A.n2 = 0; A.qpos0 = -1; A.use_sink = 0; A.sink0 = 0.f; A.sink1 = 0.f; A.lam = lam; A.post = post; A.subg = diff_subln + l * 128;
                {
                    A.Q = QA + (size_t)qrow * 512 + hh * 128; A.qg1 = 64; A.K = KA + (size_t)b * KVR * 512 + hh * 128; A.V = VA + (size_t)b * KVR * 512 + hh * 128; A.ldk = 512;
                    A.O = YS + (size_t)qrow * 512 + hh * 128; A.og1 = 0;
                    att::attn_unit<true, false>(A, (char*)lds, wave0);
                }
            }
        }
        }
        SEAM(pb + 1);
        for (int rep_ = 0; rep_ < (l == 0 ? REPS(4) : 1); ++rep_) { if (rep_) xcd_barrier(bar, TIDNOW());
        if (IN(pb + 2) && EN(4)) {
            IDS_NOW;
            auto YS = WSP(bf16, WS_YS); auto WB = WSP(bf16, WS_WB);
            pg8::Gemm g{(const bf16*)YS, (const bf16*)(WB + (size_t)l * 3 * D * 512), 3 * MTOT, 3 * D, 512}; MergeOrder S{(ML / 256) * 4, G, vcu};
            EpiMerge E{MISC};
            pg8::gemm_phase<EpiMerge, MergeOrder, false>(ldsl, g, S, E, wave0);
            { const int c0 = (ML / 256) * 4 - G;
              if (l == 0 && c0 > 0 && c0 < G && vcu >= c0) { const int tc = TIDNOW(); const int wv = wave0;
                  cvt_range(MISC, ldsl, CVT_T1_END, CVT_T3_END, (vcu - c0) * NWAVES + wv, (G - c0) * NWAVES, wv, tc & 63); } }
        }
        }
        SEAM(pb + 2);
        for (int rep_ = 0; rep_ < (l == 0 ? REPS(5) : 1); ++rep_) { if (rep_) xcd_barrier(bar, TIDNOW());
        if (IN(pb + 3) && EN(5)) {
            IDS_NOW;
            auto MG = WSP(bf16, WS_MG); auto WO = WSP(bf16, WS_WO);
            pg8::Gemm g{(const bf16*)MG, (const bf16*)(WO + (size_t)l * D * D), ML, D, D}; pg8::StaticOrder S; S.init(ML, D, G, bid);
            EpiOut E{MISC};
            pg8::gemm_phase<EpiOut, pg8::StaticOrder, false>(ldsl, g, S, E, wave0);
            { const int c0 = (ML / 256) * 4 - G;
              if (l == 0 && c0 > 0 && c0 < G && bid >= c0) { const int tc = TIDNOW(); const int wv = wave0;
                  cvt_range(MISC, ldsl, CVT_T3_END, CVT_T5_END, (bid - c0) * NWAVES + wv, (G - c0) * NWAVES, wv, tc & 63); } }
        }
        }
        SEAM(pb + 3);
        if (IN(pb + 4) && EN(6)) {
            IDS_NOW;
            PHASE_IDS;
            auto norm_g = INP(6); auto router_w = INP(14); auto router_b = INP(15);
            gcfp ng = norm_g + (size_t)l * 4 * D; auto modl = WSP(float, WS_MOD) + (size_t)l * 5 * NIN;
            auto Y = WSP(bf16, WS_Y); auto X = WSP(float, WS_X); auto H2 = WSP(bf16, WS_H2); auto x_in0 = INP(0); auto ctx_in0 = INP(2);
            auto SE = WSP(int, WS_SE); auto SR = WSP(int, WS_SR); auto SW = WSP(float, WS_SW); auto LIST = WSP(int, WS_LIST);
            LAS f32x4* rwL = (LAS f32x4*)ldsl;
            gcfp rw = router_w + (size_t)l * D * NE;
            {
                f32x4 tw[16];
#pragma unroll
                for (int k = 0; k < 16; ++k) { const int idx = tid + k * (NWAVES * 64); const int d = idx >> 3, q = idx & 7; tw[k] = *(const GAS f32x4*)(rw + (size_t)d * NE + q * 4); }
#pragma unroll
                for (int k = 0; k < 16; ++k) { const int idx = tid + k * (NWAVES * 64); const int d = idx >> 3, q = idx & 7; const int rowp = (d & 3) * 256 + (d >> 2);
                    rwL[rowp * 8 + (q ^ ((rowp >> 1) & 7))] = tw[k]; }
            }
            volatile LAS unsigned* hist = MISC + MW_HIST; volatile LAS unsigned* gbase = MISC + MW_BASE; volatile LAS unsigned* slotw = MISC + MW_SLOT + wave * (9 * 4 * 3);
            if (tid < NE) hist[tid] = 0u;
            __syncthreads();
            const int RPB = (ML + G - 1) / G; const int r0 = bid * RPB;
            int nti = 0;
#if TOKPROBE & 1
            for (int rep1 = (l == 0) ? 0 : 1; rep1 < 2; ++rep1) { const bool dry1 = rep1 == 0; gfp Xo = dry1 ? (gfp)WSP(float, WS_TMP) : (gfp)X; gbp H2o = dry1 ? (gbp)WSP(bf16, WS_ACT) : (gbp)H2; nti = 0;
#else
            { gfp Xo = (gfp)X; gbp H2o = (gbp)H2; constexpr bool dry1 = false;
#endif
            {
            int i = wave; bool have = (i < RPB && r0 + i < ML);
            u32x2 yn[4]; auto PVl = WSP(float, WS_PV) + (size_t)l * 5 * 4 * D;
#define YLD(r_) do { _Pragma("unroll") for (int j = 0; j < 4; ++j) yn[j] = *(const GAS u32x2*)(Y + (size_t)(r_) * D + 4 * lane + 256 * j); } while (0)
#define XSRC(r_) (l == 0 ? ((r_) < MLAT ? x_in0 + (size_t)(r_) * D : ctx_in0 + (size_t)((r_) - MLAT) * D) : (gcfp)(X + (size_t)(r_) * D))
            if (have) { YLD(r0 + i); }
            while (have) {
                const int r = r0 + i; const int mr = r < MLAT ? (r >> 12) : 4;
                gcfp md = modl + (size_t)mr * NIN; gcfp pv = PVl + (size_t)mr * 4 * D; f32x4 yv[4], xv[4], hv[4], A1[4], A2[4];
                ld_row(XSRC(r), lane, xv); ld_row(pv, lane, A1); ld_row(pv + D, lane, A2); ld_row(md + 3 * D, lane, hv);

#pragma unroll
                for (int j = 0; j < 4; ++j) yv[j] = (f32x4){bflo(yn[j].x), bfhi(yn[j].x), bflo(yn[j].y), bfhi(yn[j].y)};
                const int inx = i + NWAVES; const bool hn = (inx < RPB && r0 + inx < ML);
                if (hn) { YLD(r0 + inx); }
                const float rny = __builtin_amdgcn_rsqf(sumsq_row(yv) * (1.0f / D) + EPS);
#pragma unroll
                for (int j = 0; j < 4; ++j) { const int c = 4 * lane + 256 * j; xv[j] = xv[j] + A1[j] * (yv[j] * rny); *(GAS f32x4*)(Xo + (size_t)r * D + c) = xv[j]; }
                if (l >= MOE_F8_FROM) norm_affine_row<true>(xv, A2, lane, hv, (gbp)((GAS unsigned char*)H2o + (size_t)r * D));
                else norm_affine_row<false>(xv, A2, lane, hv, H2o + (size_t)r * D);
                float a[32];
#pragma unroll
                for (int q = 0; q < 32; ++q) a[q] = 0.f;
                const int sw = (lane >> 1) & 7;
                {
                    f32x4 wA[8], wB[8];
#define RW_LD(W, blk) do { const int rowp_ = ((blk) & 3) * 256 + 64 * ((blk) >> 2) + lane; _Pragma("unroll") for (int q = 0; q < 8; ++q) W[q] = rwL[rowp_ * 8 + (q ^ sw)]; } while (0)
#define RW_FMA(W, blk) do { const float hval_ = hv[(blk) >> 2][(blk) & 3]; _Pragma("unroll") for (int q = 0; q < 8; ++q) { a[4 * q + 0] += hval_ * W[q][0]; a[4 * q + 1] += hval_ * W[q][1]; a[4 * q + 2] += hval_ * W[q][2]; a[4 * q + 3] += hval_ * W[q][3]; } } while (0)
                    RW_LD(wA, 0);
#pragma unroll
                    for (int blk = 0; blk < 16; blk += 2) { RW_LD(wB, blk + 1); RW_FMA(wA, blk); __builtin_amdgcn_sched_barrier(0); if (blk + 2 < 16) RW_LD(wA, blk + 2); RW_FMA(wB, blk + 1); __builtin_amdgcn_sched_barrier(0); }
#undef RW_LD
#undef RW_FMA
                }
#define RS(N, MASK) do { const bool up = (lane & (MASK)) != 0; _Pragma("unroll") for (int q = 0; q < (N) / 2; ++q) { const float keep = up ? a[(N) / 2 + q] : a[q]; const float send = up ? a[q] : a[(N) / 2 + q]; a[q] = keep + __shfl_xor(send, (MASK)); } } while (0)
                RS(32, 32); RS(16, 16); RS(8, 8); RS(4, 4); RS(2, 2);
#undef RS
                const int myE = (lane >> 1) & 31;
                float val = a[0] + dppf<0xB1>(a[0]) + router_b[l * NE + myE];
                float tv[4]; int te[4];
#define BETTER(ov, oe, bv, be) ((ov) > (bv) || ((ov) == (bv) && (oe) < (be)))
#define TSTEP(CTRL) do { const float ov = dppf<CTRL>(bv); const int oe = dppi<CTRL>(be); if (BETTER(ov, oe, bv, be)) { bv = ov; be = oe; } } while (0)
#pragma unroll
                for (int k = 0; k < 4; ++k) { float bv = val; int be = myE;
                    TSTEP(0x4E); TSTEP(0x141); TSTEP(0x140);
                    float v0 = rdl(bv, 0), v1 = rdl(bv, 16), v2 = rdl(bv, 32), v3 = rdl(bv, 48);
                    int e0 = __builtin_amdgcn_readlane(be, 0), e1 = __builtin_amdgcn_readlane(be, 16), e2 = __builtin_amdgcn_readlane(be, 32), e3 = __builtin_amdgcn_readlane(be, 48);
                    if (BETTER(v1, e1, v0, e0)) { v0 = v1; e0 = e1; } if (BETTER(v3, e3, v2, e2)) { v2 = v3; e2 = e3; } if (BETTER(v2, e2, v0, e0)) { v0 = v2; e0 = e2; }
                    tv[k] = v0; te[k] = e0; if (myE == e0) val = -INFINITY; }
#undef TSTEP
#undef BETTER
                const float e1 = __expf(tv[1] - tv[0]), e2 = __expf(tv[2] - tv[0]), e3 = __expf(tv[3] - tv[0]); const float inv = 1.0f / (1.0f + e1 + e2 + e3);
                if (lane < 4) { const int ek = lane == 0 ? te[0] : lane == 1 ? te[1] : lane == 2 ? te[2] : te[3]; const float wk = (lane == 0 ? 1.0f : lane == 1 ? e1 : lane == 2 ? e2 : e3) * inv;
                    const unsigned lr = __hip_atomic_fetch_add((LAS unsigned*)((dry1 ? gbase : hist) + ek), 1u, __ATOMIC_RELAXED, __HIP_MEMORY_SCOPE_WORKGROUP);
                    slotw[(nti * 4 + lane) * 3 + 0] = (unsigned)ek; slotw[(nti * 4 + lane) * 3 + 1] = lr; slotw[(nti * 4 + lane) * 3 + 2] = __builtin_bit_cast(unsigned, wk); }
                i = inx; have = hn; ++nti;
            }
            }
            }
            __syncthreads();
            if (tid < NE) { const unsigned hcount = hist[tid]; gbase[tid] = hcount ? __hip_atomic_fetch_add(cntg + tid * 64, hcount, __ATOMIC_RELAXED, __HIP_MEMORY_SCOPE_AGENT) : 0u; }
            __syncthreads();
            nti = 0;
            for (int i = wave; i < RPB && r0 + i < ML; i += NWAVES, ++nti) {
                const int r = r0 + i;
                if (lane < 4) { const unsigned ek = slotw[(nti * 4 + lane) * 3 + 0], lr = slotw[(nti * 4 + lane) * 3 + 1], wkb = slotw[(nti * 4 + lane) * 3 + 2];
                    const unsigned rank = gbase[ek] + lr;
                    LIST[(size_t)ek * MTOT + rank] = r; SE[r * 4 + lane] = (int)ek; SR[r * 4 + lane] = (int)rank; SW[r * 4 + lane] = __builtin_bit_cast(float, wkb); }
            }
            __syncthreads();
        }
        SEAM(pb + 4);
        LAS int* tb = (LAS int*)(ldsl + MISC_OFF) + MW_TB; LAS int* cn = (LAS int*)(ldsl + MISC_OFF) + MW_CNT;
        if (IN(pb + 5) || IN(pb + 6) || IN(pb + 7)) {
            IDS_NOW;
            __syncthreads();
            const int tid = TIDNOW();
            if (tid < NE) cn[tid] = (int)__hip_atomic_load(cntg + tid * 64, __ATOMIC_RELAXED, __HIP_MEMORY_SCOPE_AGENT);
            __syncthreads();
            if (tid == 0) { int accu = 0; for (int e = 0; e < NE; ++e) { tb[e] = accu; accu += (cn[e] + 255) >> 8; } tb[NE] = accu; }
            __syncthreads();
        }
        for (int rep_ = 0; rep_ < (l == 0 ? REPS(7) : 1); ++rep_) { if (rep_) xcd_barrier(bar, TIDNOW());
        if (IN(pb + 5) && EN(7)) {
            IDS_NOW;
            auto H2 = WSP(bf16, WS_H2); auto W1 = WSP(bf16, WS_W1); auto LIST = WSP(int, WS_LIST);
            MoeOrder<8> S; S.init(tb, cn, LIST, G, bid);
            if (l >= MOE_F8_FROM) { pg8::Gemm g{(const bf16*)H2, (const bf16*)(W1 + (size_t)l * NE * 2048 * D), MTOT, NE * 2048, D / 2}; EpiSwiglu<true> E{MISC, l};
                pg8::gemm_phase<EpiSwiglu<true>, MoeOrder<8>, true, true>(ldsl, g, S, E, wave0); }
            else { pg8::Gemm g{(const bf16*)H2, (const bf16*)(W1 + (size_t)l * NE * 2048 * D), MTOT, NE * 2048, D}; EpiSwiglu<false> E{MISC, l};
                pg8::gemm_phase<EpiSwiglu<false>, MoeOrder<8>, true, false>(ldsl, g, S, E, wave0); }
            if (l == 0 ? CVT_SH5 > 0 : CVT_SH6 > 0) { const int cf = l == 0 ? CVT_T5_END : CVT_T6_END, cl = l == 0 ? CVT_T4_END : CVT_END;
                const int nfull = S.chunk / S.per, rem = S.chunk - nfull * S.per, lc = S.vcu % S.per, xg = S.vcu / S.per, nidle = S.per - rem, ngrp = S.vcu == S.bid && S.per == G ? 1 : 8;
                const int tc = TIDNOW(); const int wv = wave0;
                if (rem == 0) cvt_range(MISC, ldsl, cf, cl, S.vcu * NWAVES + wv, G * NWAVES, wv, tc & 63);
                else if (lc >= rem) cvt_range(MISC, ldsl, cf, cl, (xg * nidle + (lc - rem)) * NWAVES + wv, ngrp * nidle * NWAVES, wv, tc & 63);
            }
        }
        }
        SEAM(pb + 5);
        for (int rep_ = 0; rep_ < (l == 0 ? REPS(8) : 1); ++rep_) { if (rep_) xcd_barrier(bar, TIDNOW());
        if (IN(pb + 6) && EN(8)) {
            IDS_NOW;
            auto ACT = WSP(bf16, WS_ACT); auto W2 = WSP(bf16, WS_W2); auto LIST = WSP(int, WS_LIST);
            MoeOrder<4> S; S.init(tb, cn, LIST, G, bid);
            if (l >= MOE_F8_FROM) { pg8::Gemm g{(const bf16*)ACT, (const bf16*)(W2 + (size_t)l * NE * D * D), MAXTILES * 256, NE * D, D / 2}; EpiMoe2<true> E{MISC, l};
                pg8::gemm_phase<EpiMoe2<true>, MoeOrder<4>, false, true>(ldsl, g, S, E, wave0); }
            else { pg8::Gemm g{(const bf16*)ACT, (const bf16*)(W2 + (size_t)l * NE * D * D), MAXTILES * 256, NE * D, D}; EpiMoe2<false> E{MISC, l};
                pg8::gemm_phase<EpiMoe2<false>, MoeOrder<4>, false, false>(ldsl, g, S, E, wave0); }
        }
        }
        SEAM(pb + 6);
        if (IN(pb + 7) && EN(9)) {
            IDS_NOW;
            PHASE_IDS;
            auto norm_g = INP(6); gcfp ng = norm_g + (size_t)l * 4 * D; auto MOD = WSP(float, WS_MOD); gcfp modl = MOD + (size_t)l * 5 * NIN;
            auto X = WSP(float, WS_X); auto H = WSP(bf16, WS_H); auto YS2 = WSP(bf16, WS_YS2); gfp outp = (gfp)ldp(MISC, 20);
            auto SE = WSP(int, WS_SE); auto SR = WSP(int, WS_SR); auto SW = WSP(float, WS_SW);
            for (int rep2 = ((TOKPROBE & 2) && l == 0) ? 0 : 1; rep2 < 2; ++rep2) { const bool dry2 = rep2 == 0; gfp Xo = dry2 ? (gfp)WSP(float, WS_TMP) : (gfp)X; gbp Ho = dry2 ? (gbp)WSP(bf16, WS_MG) : (gbp)H;
            for (int rb = gw; rb < ML; rb += 16 * NGW) {
                const int myr = rb + (lane >> 2) * NGW; const bool vld = myr < ML;
                const int se = vld ? SE[myr * 4 + (lane & 3)] : 0, sr = vld ? SR[myr * 4 + (lane & 3)] : 0; const float swt = vld ? SW[myr * 4 + (lane & 3)] : 0.f;
                const int yrow = tb[se] * 256 + sr;
                u32x2 yn[4][4]; f32x4 xn[4];
#define T2_LOAD(ri_) do { const int r_ = rb + (ri_) * NGW; _Pragma("unroll") for (int k = 0; k < 4; ++k) { const int yr_ = __builtin_amdgcn_readlane(yrow, (ri_) * 4 + k); gcbp yp = YS2 + (size_t)yr_ * D; \
                    _Pragma("unroll") for (int j = 0; j < 4; ++j) yn[k][j] = *(const GAS u32x2*)(yp + 4 * lane + 256 * j); } ld_row(X + (size_t)r_ * D, lane, xn); } while (0)
                int ri = 0;
                if (rb < ML) T2_LOAD(0);
                while (ri < 16 && rb + ri * NGW < ML) {
                    const int r = rb + ri * NGW; const int mr = r < MLAT ? (r >> 12) : 4; gcfp md = modl + (size_t)mr * NIN;
                    f32x4 yv[4], xv[4];
#pragma unroll
                    for (int j = 0; j < 4; ++j) { yv[j] = (f32x4){0.f, 0.f, 0.f, 0.f}; xv[j] = xn[j]; }
#pragma unroll
                    for (int k = 0; k < 4; ++k) { const float wk = rdl(swt, ri * 4 + k);
#pragma unroll
                        for (int j = 0; j < 4; ++j) { const u32x2 w = yn[k][j]; yv[j][0] += wk * bflo(w.x); yv[j][1] += wk * bfhi(w.x); yv[j][2] += wk * bflo(w.y); yv[j][3] += wk * bfhi(w.y); } }
                    if (ri + 1 < 16 && rb + (ri + 1) * NGW < ML) T2_LOAD(ri + 1);
                    const float rny = 1.0f / sqrtf(sumsq_row(yv) * (1.0f / D) + EPS);
#pragma unroll
                    for (int j = 0; j < 4; ++j) { const int c = 4 * lane + 256 * j; const f32x4 g3 = *(const GAS f32x4*)(ng + 3 * D + c), gf = *(const GAS f32x4*)(md + 5 * D + c);
                        xv[j] = xv[j] + gf * ((yv[j] * rny) * g3);
                        if (lastl) *(GAS f32x4*)(outp + (size_t)r * D + c) = xv[j]; else *(GAS f32x4*)(Xo + (size_t)r * D + c) = xv[j]; }
                    if (!lastl) { f32x4 hv[4]; gcfp mdn = MOD + ((size_t)(l + 1) * 5 + mr) * NIN;
                        norm_mod_row(xv, norm_g + (size_t)(l + 1) * 4 * D, mdn + 1024, mdn, lane, hv, Ho + (size_t)r * D); }
                    ++ri;
                }
#undef T2_LOAD
            }
            if (dry2) { asm volatile("s_waitcnt vmcnt(0)" ::: "memory"); __syncthreads(); } }
        }
        if (!lastl) SEAM(pb + 7);
    }
#undef IN
#undef SEAM
}

constexpr int N_PHASES = 2 + 8 * DEPTH;
#ifndef MK_CUTS
#define MK_CUTS 0
#endif
extern "C" void kernel_launch(void* const* d_in, const int* in_sizes, int n_in, void* d_out, int out_size, void* d_ws, size_t ws_size, hipStream_t stream) {
    static int grid = 0;
    if (grid == 0) {
        if (n_in != 20 || out_size != MLAT * D || ws_size < WS_END) { fprintf(stderr, "kernel_launch: unexpected shapes (n_in %d out %d ws %zu need %zu)\n", n_in, out_size, ws_size, (size_t)WS_END); grid = -1; return; }
        int dev = 0, cus = 0, per_cu = 0;
        if (hipGetDevice(&dev) != hipSuccess || hipDeviceGetAttribute(&cus, hipDeviceAttributeMultiprocessorCount, dev) != hipSuccess) { grid = -1; return; }
        if (hipFuncSetAttribute((const void*)mk_fwd, hipFuncAttributeMaxDynamicSharedMemorySize, LDS_BYTES) != hipSuccess) { fprintf(stderr, "kernel_launch: hipFuncSetAttribute failed\n"); grid = -1; return; }
        if (hipOccupancyMaxActiveBlocksPerMultiprocessor(&per_cu, (const void*)mk_fwd, NWAVES * 64, LDS_BYTES) != hipSuccess || per_cu < 1) { fprintf(stderr, "kernel_launch: occupancy query reports %d\n", per_cu); }
        (void)hipGetLastError();
        grid = cus;
    }
    if (grid < 0) return;
    if (hipMemsetAsync((char*)d_ws + WS_CTL, 0, CTL_BYTES, stream) != hipSuccess) return;
    Args a{};
    for (int i = 0; i < 20; ++i) a.in[i] = (const float*)d_in[i];
    a.out = (float*)d_out; a.ws = (unsigned char*)d_ws;
#if MK_CUTS
    for (int p = 0; p < N_PHASES; ++p) { a.ph_lo = p; a.ph_hi = p + 1; hipLaunchKernelGGL(mk_fwd, dim3(grid), dim3(NWAVES * 64), LDS_BYTES, stream, a); }
#else
    a.ph_lo = 0; a.ph_hi = N_PHASES;
    hipLaunchKernelGGL(mk_fwd, dim3(grid), dim3(NWAVES * 64), LDS_BYTES, stream, a);
#endif
    const hipError_t le = hipPeekAtLastError();
    if (le != hipSuccess) fprintf(stderr, "kernel_launch: launch failed: %s\n", hipGetErrorName(le));
}
```

```cpp
#include <hip/hip_runtime.h>
#include <cstdio>
#include <cstdint>

#define LAS __attribute__((address_space(3)))
#define GAS __attribute__((address_space(1)))

__device__ __forceinline__ int lane_now() { int l = (int)__builtin_amdgcn_mbcnt_hi(~0u, __builtin_amdgcn_mbcnt_lo(~0u, 0u)); asm volatile("" : "+v"(l)); return l; }

namespace pg8 {
#define PG8_LAS __attribute__((address_space(3)))
typedef unsigned short bf16_t;
typedef short bf16x8 __attribute__((ext_vector_type(8)));
typedef float f32x4 __attribute__((ext_vector_type(4)));
typedef float f32x2 __attribute__((ext_vector_type(2)));
typedef unsigned u32x4 __attribute__((ext_vector_type(4)));
typedef unsigned u32x2 __attribute__((ext_vector_type(2)));
constexpr int BM = 256, BK = 64, HALF = 128, HTB = HALF * BK * 2  , STAGE_BYTES = 8 * HTB, NXCD = 8, WGM = 8;

__host__ __device__ __forceinline__ int lds_byte(int r, int c) { const int st = (r >> 4) * 2 + (c >> 5), rr = r & 15, cc = c & 31, ob = rr * 64 + cc * 2; return st * 1024 + (ob ^ (((ob >> 9) & 1) << 5)); }
__host__ __device__ __forceinline__ void stage_rc(int b, int& R, int& C) { const int st = b / 1024, sb = b % 1024, swz = sb ^ (((sb >> 9) & 1) << 5); R = (st >> 1) * 16 + swz / 64; C = (st & 1) * 32 + (swz % 64) / 2; }
__host__ __device__ __forceinline__ int perm32(int rho) { const int n = rho >> 4, i = rho & 15; return 8 * (i >> 2) + 4 * n + (i & 3); }

struct Unit { int pm, pn; };
struct Gemm { const bf16_t* A; const bf16_t* Bt; int M, N, K; };

struct StaticOrder {
    int nM, nN, nwg, G, c;
    __host__ __device__ void init(int M, int N, int G_, int c_) { nM = M / BM; nN = N / BM; nwg = nM * nN; G = G_; c = c_; }
    __host__ __device__ bool next(int i, Unit& u) const {
        const long L = (long)i * G + c; if (L >= nwg) return false;
        int wgid = (int)L; { const int q = nwg / NXCD, r = nwg % NXCD, xcd = wgid % NXCD, off = wgid / NXCD; wgid = (xcd < r ? xcd * (q + 1) : r * (q + 1) + (xcd - r) * q) + off; }
        const int nig = WGM * nN, gid = wgid / nig, fm = gid * WGM, gsz = (nM - fm) < WGM ? (nM - fm) : WGM;
        u.pm = fm + ((wgid % nig) % gsz); u.pn = (wgid % nig) / gsz; return true;
    }
    __device__ __forceinline__ unsigned a_row(const Unit&, int) const { return 0u; }
};

__device__ __forceinline__ unsigned cvt_pk_bf16(float lo, float hi) { unsigned r; asm volatile("v_cvt_pk_bf16_f32 %0, %1, %2" : "=v"(r) : "v"(lo), "v"(hi)); return r; }

typedef int v8i32 __attribute__((ext_vector_type(8)));
typedef int v4i32 __attribute__((ext_vector_type(4)));
__device__ __forceinline__ v8i32 cat8(bf16x8 lo, bf16x8 hi) { const v4i32 a = __builtin_bit_cast(v4i32, lo), b = __builtin_bit_cast(v4i32, hi); return (v8i32){a[0], a[1], a[2], a[3], b[0], b[1], b[2], b[3]}; }
__device__ __forceinline__ void mfma_f8(f32x4& acc, v8i32 a, v8i32 b, int sc) {
    asm volatile("v_mfma_scale_f32_16x16x128_f8f6f4 %0, %1, %2, %0, %3, %3 op_sel_hi:[0,0,0]" : "+v"(acc) : "v"(a), "v"(b), "v"(sc)); }
template <class E> struct epi_chain { static constexpr bool v = false; };
template <class E> struct epi_dup { static constexpr int v = 0; };
template <class Epi, class Sched, bool GATHER, bool FP8 = false>
__device__ __forceinline__ void gemm_phase(PG8_LAS unsigned char* lds, const Gemm g, const Sched& S, const Epi& E, const int wave0) {
    const int lane = lane_now(), tid = wave0 * 64 + lane, wid = wave0, wr = wid >> 2, wc = wid & 3, fr = lane & 15, fq = lane >> 4;
    const int K = g.K, nt = K / BK;
    unsigned voffA[2], voffB[2]; int RA[2], CA[2];
#pragma unroll
    for (int i = 0; i < 2; ++i) { int R, C; stage_rc(tid * 16 + i * 8192, R, C); const int Rb = Epi::PERM ? ((R & ~31) + perm32(R & 31)) : R;
        RA[i] = R; CA[i] = C; voffA[i] = (unsigned)(R * K + C) * 2u; voffB[i] = (unsigned)(Rb * K + C) * 2u; }
    const size_t kstep = (size_t)(BK * 2);
    const size_t hstep = (size_t)HALF * K * 2;
    const size_t tstep = 2 * hstep;
    const unsigned ldsw = (unsigned)wid * 1024u;
    const int aoff = lds_byte(wr * 64 + fr, fq * 8), boff = lds_byte(wc * 32 + fr, fq * 8);
#define PG8_SA(b, h) (((b) * 2 + (h)) * HTB)
#define PG8_SB(b, h) ((4 + (b) * 2 + (h)) * HTB)
#define PG8_STAGE2(bufoff, gbase, o0, o1) do { \
        __builtin_amdgcn_global_load_lds((const unsigned*)((const char*)(gbase) + (o0)), (PG8_LAS unsigned*)(lds + (bufoff) + ldsw), 16, 0, 0); \
        __builtin_amdgcn_global_load_lds((const unsigned*)((const char*)(gbase) + (o1)), (PG8_LAS unsigned*)(lds + (bufoff) + ldsw + 8192), 16, 0, 0); } while (0)
#define PG8_STB(bufoff, gbase) PG8_STAGE2(bufoff, gbase, voffB[0], voffB[1])
#define PG8_STA(bufoff, ptr, h, OC) do { if constexpr (GATHER) PG8_STAGE2(bufoff, ptr, OC[h][0], OC[h][1]); else PG8_STAGE2(bufoff, (ptr) + ((h) ? hstep : (size_t)0), voffA[0], voffA[1]); } while (0)
#define PG8_LDA(dst, b, h) do { _Pragma("unroll") for (int m = 0; m < 4; ++m) _Pragma("unroll") for (int k = 0; k < 2; ++k) dst[m][k] = *(const PG8_LAS bf16x8*)(lds + PG8_SA(b, h) + aoff + m * 2048 + k * 1024); } while (0)
#define PG8_LDB(dst, b, h) do { _Pragma("unroll") for (int n = 0; n < 2; ++n) _Pragma("unroll") for (int k = 0; k < 2; ++k) dst[n][k] = *(const PG8_LAS bf16x8*)(lds + PG8_SB(b, h) + boff + n * 2048 + k * 1024); } while (0)
#define PG8_MMA(ai, bj, At, Bt) do { __builtin_amdgcn_s_setprio(1); \
        if constexpr (FP8) { _Pragma("unroll") for (int m = 0; m < 4; ++m) _Pragma("unroll") for (int n = 0; n < 2; ++n) \
            mfma_f8(acc[ai][bj][m][n], cat8(Bt[n][0], Bt[n][1]), cat8(At[m][0], At[m][1]), sc8); } \
        else { _Pragma("unroll") for (int m = 0; m < 4; ++m) _Pragma("unroll") for (int n = 0; n < 2; ++n) _Pragma("unroll") for (int k = 0; k < 2; ++k) \
            acc[ai][bj][m][n] = __builtin_amdgcn_mfma_f32_16x16x32_bf16(Bt[n][k], At[m][k], acc[ai][bj][m][n], 0, 0, 0); } \
        __builtin_amdgcn_s_setprio(0); } while (0)
#define PG8_WAIT_V(n) asm volatile("s_waitcnt vmcnt(" #n ")" ::: "memory")
#define PG8_WAIT_L(n) asm volatile("s_waitcnt lgkmcnt(" #n ")" ::: "memory")
#define PG8_BAR __builtin_amdgcn_s_barrier()
#define PG8_SCHED __builtin_amdgcn_sched_barrier(0)
    Unit cur, nxt; int ui = 0;
    if (!S.next(0, cur)) return;
    f32x4 acc[2][2][4][2];
#pragma unroll
    for (int a = 0; a < 2; ++a)
#pragma unroll
        for (int b = 0; b < 2; ++b)
#pragma unroll
            for (int m = 0; m < 4; ++m)
#pragma unroll
                for (int n = 0; n < 2; ++n) acc[a][b][m][n] = (f32x4){0.f, 0.f, 0.f, 0.f};
    bf16x8 At[4][2], B0[2][2], B1[2][2];
    int sc8 = 0x7f7f7f7f; asm volatile("" : "+v"(sc8));
    unsigned vC[2][2] = {{0u, 0u}, {0u, 0u}}, vN[2][2] = {{0u, 0u}, {0u, 0u}};
    if constexpr (GATHER) {
#pragma unroll
        for (int h = 0; h < 2; ++h)
#pragma unroll
            for (int i = 0; i < 2; ++i) vC[h][i] = (S.a_row(cur, h * HALF + RA[i]) * (unsigned)K + (unsigned)CA[i]) * 2u;
    }
    const char* Ab = (const char*)g.A;
    const char* cA = GATHER ? Ab : Ab + (size_t)cur.pm * tstep; const char* cB = (const char*)g.Bt + (size_t)cur.pn * tstep;
    PG8_STB(PG8_SB(0, 0), cB); PG8_STB(PG8_SB(0, 1), cB + hstep); PG8_STA(PG8_SA(0, 0), cA, 0, vC); PG8_STA(PG8_SA(0, 1), cA, 1, vC);
    if (wr == 1) PG8_BAR;
    PG8_WAIT_V(2); PG8_BAR;
    PG8_STB(PG8_SB(1, 0), cB + kstep); PG8_STA(PG8_SA(1, 0), cA + kstep, 0, vC); PG8_STB(PG8_SB(1, 1), cB + hstep + kstep);
    PG8_WAIT_V(6); PG8_BAR;
    for (;;) {
        const bool has_next = S.next(ui + 1, nxt);
        const char* nA = GATHER ? Ab : (has_next ? Ab + (size_t)nxt.pm * tstep : cA); const char* nB = has_next ? (const char*)g.Bt + (size_t)nxt.pn * tstep : cB;
        if constexpr (GATHER) {
            if (has_next) {
#pragma unroll
                for (int h = 0; h < 2; ++h)
#pragma unroll
                    for (int i = 0; i < 2; ++i) vN[h][i] = (S.a_row(nxt, h * HALF + RA[i]) * (unsigned)K + (unsigned)CA[i]) * 2u;
            } else {
#pragma unroll
                for (int h = 0; h < 2; ++h)
#pragma unroll
                    for (int i = 0; i < 2; ++i) vN[h][i] = vC[h][i];
            }
        }
        for (int t = 0; t < nt; t += 2) {
            const bool last = (t == nt - 2);
            const char* a1 = cA + (size_t)(t + 1) * kstep;
            const char* a2 = last ? nA : cA + (size_t)(t + 2) * kstep; const char* b2 = last ? nB : cB + (size_t)(t + 2) * kstep;
            const char* a3 = a2 + kstep; const char* b3 = b2 + kstep;
            unsigned v2[2][2];
#pragma unroll
            for (int h = 0; h < 2; ++h)
#pragma unroll
                for (int i = 0; i < 2; ++i) v2[h][i] = last ? vN[h][i] : vC[h][i];
            PG8_LDB(B0, 0, 0); PG8_LDB(B1, 0, 1); PG8_SCHED; PG8_LDA(At, 0, 0); PG8_STA(PG8_SA(1, 1), a1, 1, vC);
            PG8_WAIT_V(8); PG8_WAIT_L(0); PG8_BAR; PG8_MMA(0, 0, At, B0); PG8_MMA(0, 1, At, B1); PG8_BAR; PG8_SCHED;
            PG8_LDA(At, 0, 1); PG8_STB(PG8_SB(0, 0), b2); PG8_STB(PG8_SB(0, 1), b2 + hstep); PG8_STA(PG8_SA(0, 0), a2, 0, v2);
            PG8_WAIT_V(8); PG8_WAIT_L(0); PG8_BAR; PG8_MMA(1, 0, At, B0); PG8_MMA(1, 1, At, B1); PG8_BAR; PG8_SCHED;
            PG8_LDB(B0, 1, 0); PG8_LDB(B1, 1, 1); PG8_SCHED; PG8_LDA(At, 1, 0); PG8_STA(PG8_SA(0, 1), a2, 1, v2);
            PG8_WAIT_V(8); PG8_WAIT_L(0); PG8_BAR; PG8_MMA(0, 0, At, B0); PG8_MMA(0, 1, At, B1); PG8_BAR; PG8_SCHED;
            PG8_LDA(At, 1, 1); PG8_STB(PG8_SB(1, 0), b3); PG8_STB(PG8_SB(1, 1), b3 + hstep); PG8_STA(PG8_SA(1, 0), a3, 0, v2);
            PG8_WAIT_V(8); PG8_WAIT_L(0); PG8_BAR; PG8_MMA(1, 0, At, B0); PG8_MMA(1, 1, At, B1); PG8_BAR; PG8_SCHED;
        }
        if (wr == 0) PG8_BAR;
        if constexpr (FP8) {
            asm volatile("s_nop 15\n\ts_nop 15" ::: "memory");
#pragma unroll
            for (int a = 0; a < 2; ++a)
#pragma unroll
                for (int b = 0; b < 2; ++b)
#pragma unroll
                    for (int m = 0; m < 4; ++m)
#pragma unroll
                        for (int n = 0; n < 2; ++n) asm volatile("" : "+v"(acc[a][b][m][n]));
        }
        E(acc, cur, wr, wc, fr, fq);
        if constexpr (epi_dup<Epi>::v) { asm volatile("" ::: "memory"); E(acc, cur, wr, wc, fr, fq); }
        if (!has_next) break;
        bool keep_acc = false; if constexpr (epi_chain<Epi>::v) keep_acc = E.keep(cur);
        if (!keep_acc) {
#pragma unroll
        for (int a = 0; a < 2; ++a)
#pragma unroll
            for (int b = 0; b < 2; ++b)
#pragma unroll
                for (int m = 0; m < 4; ++m)
#pragma unroll
                    for (int n = 0; n < 2; ++n) acc[a][b][m][n] = (f32x4){0.f, 0.f, 0.f, 0.f};
        }
        cur = nxt; cA = nA; cB = nB; ++ui;
        if constexpr (GATHER) {
#pragma unroll
            for (int h = 0; h < 2; ++h)
#pragma unroll
                for (int i = 0; i < 2; ++i) vC[h][i] = vN[h][i];
        }
        if (wr == 1) PG8_BAR;
    }
    PG8_WAIT_V(0);
    PG8_BAR;
#undef PG8_SA
#undef PG8_SB
#undef PG8_STAGE2
#undef PG8_STB
#undef PG8_STA
#undef PG8_LDA
#undef PG8_LDB
#undef PG8_MMA
#undef PG8_WAIT_V
#undef PG8_WAIT_L
#undef PG8_BAR
#undef PG8_SCHED
}
}

namespace att {
typedef unsigned short bf16_t;
using bf16x8 = __attribute__((ext_vector_type(8))) short;
using s16x4  = __attribute__((ext_vector_type(4))) short;
using f32x16 = __attribute__((ext_vector_type(16))) float;
using u32x4  = __attribute__((ext_vector_type(4))) unsigned;
constexpr int NW = 8, QBLK = 32, KVBLK = 64;
constexpr float SCALE = 0.125f;
#ifndef ATT_SGB
#define ATT_SGB 1
#endif
#ifndef ATT_PROBE
#define ATT_PROBE 0
#endif
constexpr float THR = 8.f;
constexpr int SHM_V = KVBLK * 128 * 2, SHM_K = KVBLK * 128 * 2;
constexpr int SHM_ATTN = 2 * SHM_V + 2 * SHM_K + NW * 64 * 4;
#define KSWZ(row, colB) ((row) * 256 + ((colB) ^ (((row) & 7) << 4)))
#define SBAR() __builtin_amdgcn_sched_barrier(0)
#define SGB(mask, n) __builtin_amdgcn_sched_group_barrier((mask), (n), 0)
#define S1_PIPE() do { if (ATT_SGB) { SGB(0x100, 4); _Pragma("unroll") for (int i_ = 0; i_ < 8; ++i_) { SGB(0x008, 1); SGB(0x002, 13); if ((i_ & 1) && i_ < 5) SGB(0x100, 2); } } } while (0)
__device__ __forceinline__ int crow(int r, int hi) { return (r & 3) + 8 * (r >> 2) + 4 * hi; }
typedef float f32x2_a __attribute__((ext_vector_type(2))); typedef __bf16 bf16x2_a __attribute__((ext_vector_type(2)));
__device__ __forceinline__ unsigned cvtpk(float lo, float hi) { const f32x2_a v = {lo, hi}; const bf16x2_a b = __builtin_convertvector(v, bf16x2_a); return __builtin_bit_cast(unsigned, b); }
__device__ __forceinline__ unsigned short f2bf(float f) { return (unsigned short)(cvtpk(f, 0.f) & 0xffffu); }

__device__ __forceinline__ void partialSM(f32x16& p0, f32x16& p1, float& m_reg, float& mn, float& alpha, bool domask, int dq) {
  constexpr float C = SCALE * 1.4426950408889634f;
  if (domask) {
#pragma unroll
    for (int r = 0; r < 16; ++r) { const int d0 = dq + (r & 3) + 8 * (r >> 2), d1 = d0 + 32;
      if (d0 > 128 || d0 < -128) p0[r] = -1e30f; if (d1 > 128 || d1 < -128) p1[r] = -1e30f; }
  }
  float pmax = p0[0];
#pragma unroll
  for (int r = 1; r < 16; ++r) pmax = fmaxf(pmax, p0[r]);
#pragma unroll
  for (int r = 0; r < 16; ++r) pmax = fmaxf(pmax, p1[r]);
  { auto rr = __builtin_amdgcn_permlane32_swap(__float_as_uint(pmax), __float_as_uint(pmax), false, false);
    pmax = fmaxf(__uint_as_float(rr[0]), __uint_as_float(rr[1])); }
  if (__builtin_expect(__all(pmax - m_reg <= THR / SCALE), 1)) { mn = m_reg; alpha = 1.f; }
  else { mn = fmaxf(m_reg, pmax); alpha = __builtin_amdgcn_exp2f((m_reg - mn) * C); m_reg = mn; }
  const float mnC = -mn * C;
#pragma unroll
  for (int r = 0; r < 16; ++r) p0[r] = fmaf(p0[r], C, mnC);
#pragma unroll
  for (int r = 0; r < 16; ++r) p1[r] = fmaf(p1[r], C, mnC);
#pragma unroll
  for (int r = 0; r < 16; ++r) { if (ATT_PROBE == 3) { float x2 = p0[r]; asm volatile("" : "+v"(x2)); p0[r] = 0.5f * (__builtin_amdgcn_exp2f(p0[r]) + __builtin_amdgcn_exp2f(x2)); } else p0[r] = __builtin_amdgcn_exp2f(p0[r]); }
}
__device__ __forceinline__ void finishSM(f32x16& p0, f32x16& p1, float alpha, float& l_reg, bf16x8& pa0, bf16x8& pa1, bf16x8& pa2, bf16x8& pa3, float pscale = 1.0f) {
#pragma unroll
  for (int r = 0; r < 16; ++r) { if (ATT_PROBE == 3) { float x2 = p1[r]; asm volatile("" : "+v"(x2)); p1[r] = 0.5f * (__builtin_amdgcn_exp2f(p1[r]) + __builtin_amdgcn_exp2f(x2)); } else p1[r] = __builtin_amdgcn_exp2f(p1[r]); }
  float ps = 0;
#pragma unroll
  for (int r = 0; r < 16; ++r) ps += p0[r];
#pragma unroll
  for (int r = 0; r < 16; ++r) ps += p1[r];
  { auto rr = __builtin_amdgcn_permlane32_swap(__float_as_uint(ps), __float_as_uint(ps), false, false);
    ps = __uint_as_float(rr[0]) + __uint_as_float(rr[1]); }
  l_reg = l_reg * alpha + ps;
  if (pscale != 1.0f) {
#pragma unroll
    for (int r = 0; r < 16; ++r) { p0[r] *= pscale; p1[r] *= pscale; } }
#define PK4(P, BASE, OUT) do { unsigned a0 = cvtpk(P[BASE + 0], P[BASE + 1]), a1 = cvtpk(P[BASE + 2], P[BASE + 3]);   \
    unsigned b0 = cvtpk(P[BASE + 4], P[BASE + 5]), b1 = cvtpk(P[BASE + 6], P[BASE + 7]);                              \
    auto r0 = __builtin_amdgcn_permlane32_swap(a0, b0, false, false); auto r1 = __builtin_amdgcn_permlane32_swap(a1, b1, false, false); \
    u32x4 w = {r0[0], r1[0], r0[1], r1[1]}; OUT = *reinterpret_cast<bf16x8*>(&w); } while (0)
  PK4(p0, 0, pa0); PK4(p0, 8, pa1); PK4(p1, 0, pa2); PK4(p1, 8, pa3);
#undef PK4
}
__device__ __forceinline__ void qkt(f32x16& p0, f32x16& p1, const char* Ks, const bf16x8* qr, int r32, int hi, int kcolB) {
  p0 = f32x16{}; p1 = f32x16{};
#pragma unroll
  for (int d0 = 0; d0 < 4; ++d0) { const int cb = kcolB + (d0 * 16 + hi * 8) * 2;
    bf16x8 b0 = *reinterpret_cast<const bf16x8*>(Ks + KSWZ(r32, cb));
    bf16x8 b1 = *reinterpret_cast<const bf16x8*>(Ks + KSWZ(32 + r32, cb));
    p0 = __builtin_amdgcn_mfma_f32_32x32x16_bf16(b0, qr[d0], p0, 0, 0, 0);
    p1 = __builtin_amdgcn_mfma_f32_32x32x16_bf16(b1, qr[d0], p1, 0, 0, 0); }
}
__device__ __forceinline__ int v_st(int k, int c) { const int kk = (k & ~0xC) | ((k & 4) << 1) | ((k & 8) >> 1); return ((kk >> 3) * 4 + (c >> 5)) * 512 + ((kk & 7) * 32 + (c & 31)) * 2; }
__device__ __forceinline__ int v_rd_base(int lane) { return ((lane & 3) << 3) | (((lane >> 2) & 3) << 6) | (((lane >> 4) & 1) << 5) | (((lane >> 5) & 1) << 8); }
constexpr int v_rd_off(int d0, int ks, int half) { return d0 * 512 + ks * 4096 + half * 2048; }
template <int OFF> __device__ __forceinline__ s16x4 tr_read(int vb) {
  s16x4 r; asm volatile("ds_read_b64_tr_b16 %0, %1 offset:%2" : "=&v"(r) : "v"(vb), "i"(OFF) : "memory"); return r;
}
template <int D0> __device__ __forceinline__ void pv_one(f32x16& od, int vb, bf16x8 pa0, bf16x8 pa1, bf16x8 pa2, bf16x8 pa3) {
  const s16x4 l0 = tr_read<v_rd_off(D0, 0, 0)>(vb), h0 = tr_read<v_rd_off(D0, 0, 1)>(vb), l1 = tr_read<v_rd_off(D0, 1, 0)>(vb), h1 = tr_read<v_rd_off(D0, 1, 1)>(vb);
  const s16x4 l2 = tr_read<v_rd_off(D0, 2, 0)>(vb), h2 = tr_read<v_rd_off(D0, 2, 1)>(vb), l3 = tr_read<v_rd_off(D0, 3, 0)>(vb), h3 = tr_read<v_rd_off(D0, 3, 1)>(vb);
  asm volatile("s_waitcnt lgkmcnt(0)" ::: "memory"); SBAR();
#define PK(L, H) (bf16x8){L[0], L[1], L[2], L[3], H[0], H[1], H[2], H[3]}
  od = __builtin_amdgcn_mfma_f32_32x32x16_bf16(pa0, PK(l0, h0), od, 0, 0, 0);
  od = __builtin_amdgcn_mfma_f32_32x32x16_bf16(pa1, PK(l1, h1), od, 0, 0, 0);
  od = __builtin_amdgcn_mfma_f32_32x32x16_bf16(pa2, PK(l2, h2), od, 0, 0, 0);
  od = __builtin_amdgcn_mfma_f32_32x32x16_bf16(pa3, PK(l3, h3), od, 0, 0, 0);
#undef PK
}
template <bool DIFF> __device__ __forceinline__ void pv_all(f32x16* o, int vb, bf16x8 pa0, bf16x8 pa1, bf16x8 pa2, bf16x8 pa3) {
  pv_one<0>(o[0], vb, pa0, pa1, pa2, pa3); pv_one<1>(o[1], vb, pa0, pa1, pa2, pa3);
  if constexpr (DIFF) { pv_one<2>(o[2], vb, pa0, pa1, pa2, pa3); pv_one<3>(o[3], vb, pa0, pa1, pa2, pa3); }
}

struct UnitArgs {
  const GAS bf16_t* Q;
  int qg1;
  const GAS bf16_t* K;
  const GAS bf16_t* V;
  int ldk;
  int s1, n1, s2, n2;
  int qpos0;
  float sink0, sink1;
  int use_sink;
  GAS bf16_t* O;
  int og1;
  float lam, post;
  const GAS float* subg;
};

template <bool DIFF, bool MASK>
__device__ __forceinline__ void attn_unit(const UnitArgs& A, char* lds, const int wave0) {
  constexpr int NO = DIFF ? 4 : 2;
  const int lane = lane_now(), tid = wave0 * 64 + lane, wid = wave0, r32 = lane & 31, hi = lane >> 5;
  const int mg = wid >> 2, wq = wid & 3;
  char* V_lds = lds; char* K_lds = lds + 2 * SHM_V;
  float* ws = (float*)(lds + 2 * SHM_V + 2 * SHM_K) + wid * 64; float* li_l = ws; float* al_l = ws + 32;
  float m_reg = -1e30f, l_reg = 0.f;
  if (!DIFF && A.use_sink) { m_reg = (mg ? A.sink1 : A.sink0) * (1.0f / SCALE); l_reg = 1.f; }
  f32x16 o[NO];
#pragma unroll
  for (int d = 0; d < NO; ++d) o[d] = f32x16{};
  bf16x8 qr[4];
  const GAS bf16_t* Qw = A.Q + (mg ? A.qg1 : 0) + (long)(wq * QBLK + r32) * 512 + hi * 8;
#pragma unroll
  for (int d0 = 0; d0 < 4; ++d0) qr[d0] = *(const GAS bf16x8*)(Qw + d0 * 16);
  const int sr = tid >> 4, sc = (tid & 15) * 8, vst0 = v_st(sr, sc), vst1 = v_st(32 + sr, sc);
  const int vb0 = (int)(uintptr_t)V_lds + v_rd_base(lane) + ((!DIFF && mg) ? 1024 : 0);
  const int kcolB = mg * 128;
  const int ldk = A.ldk;
  const GAS bf16_t* Kh = A.K; const GAS bf16_t* Vh = A.V;
  const int NT = A.n1 + A.n2;
  const int qposl = A.qpos0 + wq * QBLK + r32;
  constexpr bool maskunit = MASK;
#define KST(j) ((j) < A.n1 ? A.s1 + (j) * KVBLK : A.s2 + ((j) - A.n1) * KVBLK)
  struct { bf16x8 vs0, vs1, ks0, ks1; } sr_[2];
#define SLOAD(i, k0) do { const long k0_ = (k0); sr_[i].vs0 = *(const GAS bf16x8*)(&Vh[(k0_ + sr) * ldk + sc]); sr_[i].vs1 = *(const GAS bf16x8*)(&Vh[(k0_ + 32 + sr) * ldk + sc]); \
    sr_[i].ks0 = *(const GAS bf16x8*)(&Kh[(k0_ + sr) * ldk + sc]); sr_[i].ks1 = *(const GAS bf16x8*)(&Kh[(k0_ + 32 + sr) * ldk + sc]); } while (0)
#define SWRITE(b, i) do { *(bf16x8*)(V_lds + (b) * SHM_V + vst0) = sr_[i].vs0;          \
    *(bf16x8*)(V_lds + (b) * SHM_V + vst1) = sr_[i].vs1; const int kc = sc * 2;               \
    *(bf16x8*)(K_lds + (b) * SHM_K + KSWZ(sr, kc)) = sr_[i].ks0;                       \
    *(bf16x8*)(K_lds + (b) * SHM_K + KSWZ(32 + sr, kc)) = sr_[i].ks1; } while (0)
#define SWAIT() asm volatile("s_waitcnt vmcnt(4)" ::: "memory")
#define RESC(a) do { if (__any((a) < 1.f)) { if (hi == 0) al_l[r32] = (a); asm volatile("s_waitcnt lgkmcnt(0)" ::: "memory"); \
    _Pragma("unroll") for (int d = 0; d < NO; ++d) _Pragma("unroll") for (int r = 0; r < 16; ++r) o[d][r] *= al_l[crow(r, hi)]; } } while (0)
#define MASKARGS(j) (maskunit && (j) >= A.n1), (KST(j) - qposl + 4 * hi)
  f32x16 pA0, pA1, pB0, pB1; float mnA, mnB, alA, alB; bf16x8 pa0, pa1, pa2, pa3;
  constexpr int SE = 0, SO = 1;
  __syncthreads();
  SLOAD(SE, KST(0)); asm volatile("s_waitcnt vmcnt(0)" ::: "memory"); SWRITE(0, SE); __syncthreads();
  qkt(pA0, pA1, K_lds, qr, r32, hi, kcolB); partialSM(pA0, pA1, m_reg, mnA, alA, MASKARGS(0));
  SLOAD(SO, KST(1)); if (2 < NT) SLOAD(SE, KST(2));
  SWAIT(); SWRITE(1, SO); __syncthreads();
  for (int j = 1; j + 1 < NT; j += 2) {
    SBAR(); qkt(pB0, pB1, K_lds + SHM_K, qr, r32, hi, kcolB);
    if (ATT_PROBE == 1) { asm volatile("" : "+v"(pB0), "+v"(pB1)); qkt(pB0, pB1, K_lds + SHM_K, qr, r32, hi, kcolB); }
    finishSM(pA0, pA1, alA, l_reg, pa0, pa1, pa2, pa3, ATT_PROBE == 2 ? 0.5f : 1.0f); S1_PIPE(); SBAR();
    SLOAD(SO, KST(j + 2)); SBAR();
    if (ATT_PROBE == 2) pv_all<DIFF>(o, vb0, pa0, pa1, pa2, pa3);
    pv_all<DIFF>(o, vb0, pa0, pa1, pa2, pa3); partialSM(pB0, pB1, m_reg, mnB, alB, MASKARGS(j));
    __syncthreads(); SWAIT(); SWRITE(0, SE); if (ATT_PROBE == 4) { asm volatile("" ::: "memory"); SWRITE(0, SE); }
    RESC(alB); __syncthreads();
    SBAR(); qkt(pA0, pA1, K_lds, qr, r32, hi, kcolB);
    if (ATT_PROBE == 1) { asm volatile("" : "+v"(pA0), "+v"(pA1)); qkt(pA0, pA1, K_lds, qr, r32, hi, kcolB); }
    finishSM(pB0, pB1, alB, l_reg, pa0, pa1, pa2, pa3, ATT_PROBE == 2 ? 0.5f : 1.0f); S1_PIPE(); SBAR();
    if (j + 3 < NT) SLOAD(SE, KST(j + 3)); SBAR();
    if (ATT_PROBE == 2) pv_all<DIFF>(o, vb0 + SHM_V, pa0, pa1, pa2, pa3);
    pv_all<DIFF>(o, vb0 + SHM_V, pa0, pa1, pa2, pa3); partialSM(pA0, pA1, m_reg, mnA, alA, MASKARGS(j + 1));
    __syncthreads(); SWAIT(); SWRITE(1, SO); if (ATT_PROBE == 4) { asm volatile("" ::: "memory"); SWRITE(1, SO); }
    RESC(alA); __syncthreads();
  }
  SBAR(); qkt(pB0, pB1, K_lds + SHM_K, qr, r32, hi, kcolB);
  finishSM(pA0, pA1, alA, l_reg, pa0, pa1, pa2, pa3); SBAR();
  pv_all<DIFF>(o, vb0, pa0, pa1, pa2, pa3); partialSM(pB0, pB1, m_reg, mnB, alB, MASKARGS(NT - 1));
  __syncthreads(); RESC(alB);
  finishSM(pB0, pB1, alB, l_reg, pa0, pa1, pa2, pa3); SBAR();
  pv_all<DIFF>(o, vb0 + SHM_V, pa0, pa1, pa2, pa3);
  if (hi == 0) li_l[r32] = l_reg; asm volatile("s_waitcnt lgkmcnt(0)" ::: "memory");
  float rli[16];
#pragma unroll
  for (int r = 0; r < 16; ++r) rli[r] = __builtin_amdgcn_rcpf(li_l[crow(r, hi)]);
  if constexpr (!DIFF) {
    GAS bf16_t* Ow = A.O + (mg ? A.og1 : 0) + (long)(wq * QBLK) * 512;
#pragma unroll
    for (int r = 0; r < 16; ++r) { const int orow = crow(r, hi);
#pragma unroll
      for (int d0 = 0; d0 < 2; ++d0) Ow[(long)orow * 512 + d0 * 32 + r32] = f2bf(o[d0][r] * rli[r]); }
  } else {
    float* ex = (float*)lds;
    __syncthreads();
    if (mg == 1) {
#pragma unroll
      for (int d0 = 0; d0 < 4; ++d0)
#pragma unroll
        for (int r = 0; r < 16; ++r) ex[(wq * 64 + d0 * 16 + r) * 64 + lane] = o[d0][r] * rli[r];
    }
    __syncthreads();
    if (mg == 0) {
      GAS bf16_t* Ow = A.O + (long)(wq * QBLK) * 512;
      float gsub[4];
#pragma unroll
      for (int d0 = 0; d0 < 4; ++d0) gsub[d0] = A.subg[d0 * 32 + r32] * A.post;
#pragma unroll
      for (int r = 0; r < 16; ++r) {
        float v[4]; float ss = 0.f;
#pragma unroll
        for (int d0 = 0; d0 < 4; ++d0) { v[d0] = o[d0][r] * rli[r] - A.lam * ex[(wq * 64 + d0 * 16 + r) * 64 + lane]; ss += v[d0] * v[d0]; }
        ss += __shfl_xor(ss, 1); ss += __shfl_xor(ss, 2); ss += __shfl_xor(ss, 4); ss += __shfl_xor(ss, 8); ss += __shfl_xor(ss, 16);
        const float rn = __builtin_amdgcn_rsqf(ss * (1.0f / 128.0f) + 1e-6f);
        const int orow = crow(r, hi);
#pragma unroll
        for (int d0 = 0; d0 < 4; ++d0) Ow[(long)orow * 512 + d0 * 32 + r32] = f2bf(v[d0] * rn * gsub[d0]);
      }
    }
  }
#undef KST
#undef SLOAD
#undef SWRITE
#undef SWAIT
#undef RESC
#undef MASKARGS
}
#undef KSWZ
}
#include <hip/hip_bf16.h>
namespace att64 {
using bf16=__hip_bfloat16;
using bf16x8=__attribute__((ext_vector_type(8)))short;
using s16x4=__attribute__((ext_vector_type(4)))short;
using f32x16=__attribute__((ext_vector_type(16)))float;
using u32x4=__attribute__((ext_vector_type(4)))unsigned;
constexpr int D=64;
constexpr int NW=8,QBLK=32,QB=QBLK*NW,KVBLK=64;
__device__ __forceinline__ int crow(int r,int hi){return (r&3)+8*(r>>2)+4*hi;}
#define SBAR() __builtin_amdgcn_sched_barrier(0)
__device__ __forceinline__ void bmask(f32x16&p0,f32x16&p1,int dq){
  const float NEG=-INFINITY;
  #pragma unroll
  for(int r=0;r<16;++r){const int d0=dq+(r&3)+8*(r>>2),d1=d0+32; if(d0>128||d0<-128)p0[r]=NEG; if(d1>128||d1<-128)p1[r]=NEG;}
}
constexpr int NSLOT=3, SLOTB=8192;
constexpr int LDS_K=0, LDS_V=NSLOT*SLOTB, LDS_WS=2*NSLOT*SLOTB, LDS_OST=LDS_WS+NW*64*4, LDS_BYTES=LDS_OST+NW*4096;
constexpr float C2=0.125f*1.4426950408889634f;
__device__ __forceinline__ void glds16(const void*gsrc,unsigned lds_dst){unsigned keep;
  asm volatile("s_mov_b32 %0, m0\n\ts_mov_b32 m0, %2\n\ts_nop 0\n\tglobal_load_lds_dwordx4 %1, off\n\ts_mov_b32 m0, %0":"=&s"(keep):"v"(gsrc),"s"(lds_dst):"memory");}
__device__ __forceinline__ float max3f(float a,float b,float c){float r;asm("v_max3_f32 %0, %1, %2, %3":"=v"(r):"v"(a),"v"(b),"v"(c));return r;}
__device__ __forceinline__ float max2f(float a,float b){float r;asm("v_max_f32_e32 %0, %1, %2":"=v"(r):"v"(a),"v"(b));return r;}
__device__ __forceinline__ float fadd_s(float a,float b){float r;asm("v_add_f32_e32 %0, %1, %2":"=v"(r):"v"(a),"v"(b));return r;}
__device__ __forceinline__ float fsub_s(float a,float b){float r;asm("v_sub_f32_e32 %0, %1, %2":"=v"(r):"v"(a),"v"(b));return r;}
typedef float f32x2_t __attribute__((ext_vector_type(2))); typedef __bf16 bf16x2_t __attribute__((ext_vector_type(2)));
__device__ __forceinline__ unsigned cvtpk_s(float lo,float hi){f32x2_t v={lo,hi};bf16x2_t b=__builtin_convertvector(v,bf16x2_t);return __builtin_bit_cast(unsigned,b);}
#define WAIT_BAR(N) asm volatile("s_waitcnt vmcnt(" #N ") lgkmcnt(0)\n\ts_barrier":::"memory")

__device__ __forceinline__ void qkt(f32x16&p0,f32x16&p1,const char*Kslot,const bf16x8*qr,const f32x16&negm,int r32,int hi){
  const char*kb=Kslot+hi*1024+r32*16;
  #pragma unroll
  for(int d0=0;d0<4;++d0){
    const bf16x8 b0=*reinterpret_cast<const bf16x8*>(kb+d0*2048);
    const bf16x8 b1=*reinterpret_cast<const bf16x8*>(kb+d0*2048+512);
    if(d0==0){p0=__builtin_amdgcn_mfma_f32_32x32x16_bf16(b0,qr[0],negm,0,0,0);p1=__builtin_amdgcn_mfma_f32_32x32x16_bf16(b1,qr[0],negm,0,0,0);}
    else{p0=__builtin_amdgcn_mfma_f32_32x32x16_bf16(b0,qr[d0],p0,0,0,0);p1=__builtin_amdgcn_mfma_f32_32x32x16_bf16(b1,qr[d0],p1,0,0,0);}}
}
typedef __attribute__((address_space(3))) const char* lds_cptr;
typedef short v4i16_t __attribute__((ext_vector_type(4)));
__device__ __forceinline__ void kload8(bf16x8*kf,lds_cptr kp){
  kf[0]=*(const __attribute__((address_space(3))) bf16x8*)(kp);      kf[1]=*(const __attribute__((address_space(3))) bf16x8*)(kp+512);
  kf[2]=*(const __attribute__((address_space(3))) bf16x8*)(kp+2048); kf[3]=*(const __attribute__((address_space(3))) bf16x8*)(kp+2560);
  kf[4]=*(const __attribute__((address_space(3))) bf16x8*)(kp+4096); kf[5]=*(const __attribute__((address_space(3))) bf16x8*)(kp+4608);
  kf[6]=*(const __attribute__((address_space(3))) bf16x8*)(kp+6144); kf[7]=*(const __attribute__((address_space(3))) bf16x8*)(kp+6656);
}
__device__ __forceinline__ void kload2(bf16x8*kf,lds_cptr kp,int j){ kf[2*j]=*(const __attribute__((address_space(3))) bf16x8*)(kp+j*2048); kf[2*j+1]=*(const __attribute__((address_space(3))) bf16x8*)(kp+j*2048+512); }
__device__ __forceinline__ s16x4 vtr(lds_cptr p){ return __builtin_bit_cast(s16x4,__builtin_amdgcn_ds_read_tr16_b64_v4i16((__attribute__((address_space(3))) v4i16_t*)p)); }
__device__ __forceinline__ float rowmax(const f32x16&p0,const f32x16&p1){
  float a=max3f(p0[0],p0[1],p1[0]),b=max3f(p0[2],p0[3],p1[1]);a=max3f(a,p1[2],p1[3]);
  #pragma unroll
  for(int r=4;r<16;r+=4){a=max3f(a,p0[r],p0[r+1]);b=max3f(b,p0[r+2],p0[r+3]);a=max3f(a,p1[r],p1[r+1]);b=max3f(b,p1[r+2],p1[r+3]);}
  const float m=max2f(a,b);
  auto rr=__builtin_amdgcn_permlane32_swap(__float_as_uint(m),__float_as_uint(m),false,false);
  return max2f(__uint_as_float(rr[0]),__uint_as_float(rr[1]));
}
__device__ __forceinline__ void pv(f32x16*o,int vb,bf16x8 pa0,bf16x8 pa1,bf16x8 pa2,bf16x8 pa3){
  #pragma unroll
  for(int d0=0;d0<2;++d0){s16x4 lo[4],hi[4];
    #pragma unroll
    for(int ks=0;ks<4;++ks){
      asm volatile("ds_read_b64_tr_b16 %0,%1 offset:%c2":"=&v"(lo[ks]):"v"(vb),"i"(d0*4096+ks*1024):"memory");
      asm volatile("ds_read_b64_tr_b16 %0,%1 offset:%c2":"=&v"(hi[ks]):"v"(vb),"i"(d0*4096+ks*1024+512):"memory");}
    asm volatile("s_waitcnt lgkmcnt(0)":::"memory");SBAR();
    #define PK(k) (bf16x8){lo[k][0],lo[k][1],lo[k][2],lo[k][3],hi[k][0],hi[k][1],hi[k][2],hi[k][3]}
    o[d0]=__builtin_amdgcn_mfma_f32_32x32x16_bf16(pa0,PK(0),o[d0],0,0,0);
    o[d0]=__builtin_amdgcn_mfma_f32_32x32x16_bf16(pa1,PK(1),o[d0],0,0,0);
    o[d0]=__builtin_amdgcn_mfma_f32_32x32x16_bf16(pa2,PK(2),o[d0],0,0,0);
    o[d0]=__builtin_amdgcn_mfma_f32_32x32x16_bf16(pa3,PK(3),o[d0],0,0,0);
    #undef PK
  }
}

#ifndef ATTN_STORE16
#define ATTN_STORE16(p,v) (*(u32x4*)(p)=(v))
#endif
template<int THRL,bool MASK,bool PAIR> __device__ __forceinline__ void attn_unit(const bf16*Qu,int qp,const bf16*__restrict__ Kh,const bf16*__restrict__ Vh,int kvp,int NT,int n1,int s2,int kpos2,int qpos0,int use_sink,float sink_l2,float sink_l2b,bf16*Ou,int op,char*shm,const int wave0){
  const int lane=lane_now(),tid=wave0*64+lane,r32=lane&31,hi=lane>>5; const int wid=wave0;
  const int wrow=PAIR?(wid&3):wid, whead=PAIR?(wid>>2):0;
  const bf16*Qw=Qu+(long)(wrow*QBLK)*qp+whead*D;
  const unsigned lds0=(unsigned)(uintptr_t)shm;
  float*wsf=(float*)(shm+LDS_WS)+wid*64;
  const bf16*ksrc=Kh+(long)lane*kvp+wid*8;
  const bf16*vsrc=Vh+(long)(16*(wid&3)+(lane>>2))*kvp+(wid>>2)*32+(lane&3)*8;
  const unsigned kdst=lds0+LDS_K+wid*1024, vdst=lds0+LDS_V+wid*1024;
  #define KROW(t) ((t)<n1?(t)*KVBLK:s2+((t)-n1)*KVBLK)
  #define DMA_K(t,slot) glds16(ksrc+(long)KROW(t)*kvp,(unsigned)__builtin_amdgcn_readfirstlane(kdst+(slot)))
  #define DMA_V(t,slot) glds16(vsrc+(long)KROW(t)*kvp,(unsigned)__builtin_amdgcn_readfirstlane(vdst+(slot)))
  const int vb0=(int)(lds0+LDS_V)+((lane>>4)&1)*32+(lane&3)*8+(4*hi+((lane&15)>>2))*64;
  const char*Kbase=shm+LDS_K; bf16x8 kf[8];
  const lds_cptr shm3=(lds_cptr)shm; const lds_cptr kp0=shm3+LDS_K+hi*1024+r32*16; const lds_cptr vp0=shm3+LDS_V+((lane>>4)&1)*32+(lane&3)*8+(4*hi+((lane&15)>>2))*64;
  DMA_K(0,0);DMA_V(0,0);DMA_K(1,SLOTB);
  bf16x8 qr[4];
  #pragma unroll
  for(int d0=0;d0<4;++d0)qr[d0]=*reinterpret_cast<const bf16x8*>(&Qw[(long)r32*qp+d0*16+hi*8]);
  float mhat=0.f,l_reg=0.f;f32x16 o[2];o[0]=f32x16{};o[1]=f32x16{};f32x16 negm=f32x16{};asm volatile("":"+v"(negm));
  const int dqb=kpos2-(qpos0+wrow*QBLK+r32)+4*hi;
  #define CMASK(P0,P1,t) do{ if(MASK&&(t)>=n1) bmask(P0,P1,dqb+((t)-n1)*KVBLK); }while(0)
  bool resc=false;
  #define START(P0,P1) do{ const float rm=rowmax(P0,P1); resc=false; \
    { const float dl=rm; mhat=fadd_s(mhat,dl); \
      _Pragma("unroll") for(int r=0;r<16;++r){P0[r]=fsub_s(P0[r],dl);P1[r]=fsub_s(P1[r],dl);} \
      _Pragma("unroll") for(int r=0;r<16;++r)negm[r]=-mhat; asm volatile("":"+v"(negm)); } \
    _Pragma("unroll") for(int r=0;r<16;++r)P0[r]=__builtin_amdgcn_exp2f(P0[r]); }while(0)
  #define RESC() do{ if(resc){ asm volatile("s_waitcnt lgkmcnt(0)":::"memory"); \
      _Pragma("unroll") for(int d_=0;d_<2;++d_) _Pragma("unroll") for(int r=0;r<16;++r)o[d_][r]*=wsf[crow(r,hi)]; } }while(0)
  f32x16 pA0,pA1,pB0,pB1;
  int sl_prev=0,sl_cur=0,sl_next=SLOTB;
  #define ROT() do{sl_prev=sl_cur;sl_cur=sl_next;sl_next=(sl_next==(NSLOT-1)*SLOTB)?0:sl_next+SLOTB;}while(0)
  DMA_K(2,2*SLOTB);
  WAIT_BAR(3);
  qkt(pA0,pA1,Kbase,qr,f32x16{},r32,hi);asm volatile("s_nop 15\n\ts_nop 7":"+v"(pA0),"+v"(pA1));CMASK(pA0,pA1,0);
  START(pA0,pA1);
  _Pragma("unroll") for(int r=0;r<16;++r)pA1[r]=__builtin_amdgcn_exp2f(pA1[r]);
  WAIT_BAR(0);
  DMA_K(3,0);DMA_V(1,SLOTB);
  ROT();
  kload8(kf,kp0+sl_cur);
  WAIT_BAR(2);
  s16x4 vlo[8],vhi[8]; u32x4 pw0,pw1,pw2,pw3;
  #define PKW(P,B) cvtpk_s(P[B],P[B+1])
  #define PAF(k) __builtin_bit_cast(bf16x8,pw##k)
  #define VFR(i) (bf16x8){vlo[i][0],vlo[i][1],vlo[i][2],vlo[i][3],vhi[i][0],vhi[i][1],vhi[i][2],vhi[i][3]}
  #define PIN(x) asm volatile("":"+v"(x))
  #define MX3(a,b,c) __builtin_fmaxf(__builtin_fmaxf((a),(b)),(c))
  #define GAPA(MF,A0,A1,A2,A3,W0,W1,PW) do{ MF; sacc+=A0; sacc+=A1; sacc+=A2; sacc+=A3; PIN(sacc); W0; W1; PIN(PW); SBAR(); }while(0)
  #define EX(v) __builtin_amdgcn_exp2f(v)
  #define GAPB(MF,X,B) do{ MF; X[B]=EX(X[B]); X[B+1]=EX(X[B+1]); X[B+2]=EX(X[B+2]); X[B+3]=EX(X[B+3]); PIN(X); SBAR(); }while(0)
  #define VRD(i) do{ vlo[i]=vtr(vp_+(((i)>>2)*4096+((i)&3)*1024)); vhi[i]=vtr(vp_+(((i)>>2)*4096+((i)&3)*1024+512)); }while(0)
  #define KRD(G,j) do{ if(G){ kload2(kf,kp0+sl_next,j); SBAR(); } }while(0)
  #define STEP(C0,C1,P0,P1,t,GK,GV,GL) do{ SBAR(); \
    const lds_cptr vp_=vp0+sl_prev; \
    VRD(0); SBAR(); float sacc=(P0[0]+P0[1]); \
    GAPA(C0=__builtin_amdgcn_mfma_f32_32x32x16_bf16(kf[0],qr[0],negm,0,0,0), P0[2],P0[3],P0[4],P0[5],     pw0[0]=PKW(P0,0), pw0[1]=PKW(P0,2), pw0); \
    VRD(4); SBAR(); GAPA(C1=__builtin_amdgcn_mfma_f32_32x32x16_bf16(kf[1],qr[0],negm,0,0,0), P0[6],P0[7],P0[8],P0[9],     pw0[2]=PKW(P0,4), pw0[3]=PKW(P0,6), pw0); \
    VRD(1); SBAR(); GAPA(C0=__builtin_amdgcn_mfma_f32_32x32x16_bf16(kf[2],qr[1],C0,0,0,0),   P0[10],P0[11],P0[12],P0[13], pw1[0]=PKW(P0,8), pw1[1]=PKW(P0,10), pw1); \
    VRD(5); SBAR(); GAPA(C1=__builtin_amdgcn_mfma_f32_32x32x16_bf16(kf[3],qr[1],C1,0,0,0),   P0[14],P0[15],P1[0],P1[1],   pw1[2]=PKW(P0,12),pw1[3]=PKW(P0,14), pw1); \
    VRD(2); SBAR(); GAPA(C0=__builtin_amdgcn_mfma_f32_32x32x16_bf16(kf[4],qr[2],C0,0,0,0),   P1[2],P1[3],P1[4],P1[5],     pw2[0]=PKW(P1,0), pw2[1]=PKW(P1,2), pw2); \
    VRD(6); SBAR(); GAPA(C1=__builtin_amdgcn_mfma_f32_32x32x16_bf16(kf[5],qr[2],C1,0,0,0),   P1[6],P1[7],P1[8],P1[9],     pw2[2]=PKW(P1,4), pw2[3]=PKW(P1,6), pw2); \
    VRD(3); SBAR(); GAPA(C0=__builtin_amdgcn_mfma_f32_32x32x16_bf16(kf[6],qr[3],C0,0,0,0),   P1[10],P1[11],P1[12],P1[13], pw3[0]=PKW(P1,8), pw3[1]=PKW(P1,10), pw3); \
    VRD(7); SBAR(); GAPA(C1=__builtin_amdgcn_mfma_f32_32x32x16_bf16(kf[7],qr[3],C1,0,0,0),   P1[14],P1[15],0.f,0.f,       pw3[2]=PKW(P1,12),pw3[3]=PKW(P1,14), pw3); \
    l_reg+=sacc; \
    if(GK){DMA_K((t)+3,sl_cur);} if(GV){DMA_V((t)+1,sl_next);} \
    CMASK(C0,C1,t); \
    { float a=MX3(C0[0],C0[1],C1[0]),b=MX3(C0[2],C0[3],C1[1]); a=MX3(a,C1[2],C1[3]); \
      _Pragma("unroll") for(int r=4;r<16;r+=4){a=MX3(a,C0[r],C0[r+1]);b=MX3(b,C0[r+2],C0[r+3]);a=MX3(a,C1[r],C1[r+1]);b=MX3(b,C1[r+2],C1[r+3]);} \
      float rm=__builtin_fmaxf(a,b); { auto rr=__builtin_amdgcn_permlane32_swap(__float_as_uint(rm),__float_as_uint(rm),false,false); rm=__builtin_fmaxf(__uint_as_float(rr[0]),__uint_as_float(rr[1])); } \
      resc=false;                                              \
      if(__builtin_expect(__any(rm>(float)THRL),0)){ const float dl=__builtin_fmaxf(rm,0.f); mhat+=dl; \
        _Pragma("unroll") for(int r=0;r<16;++r){C0[r]-=dl;C1[r]-=dl;} \
        _Pragma("unroll") for(int r=0;r<16;++r)negm[r]=-mhat; asm volatile("":"+v"(negm)); \
        const float f=__builtin_amdgcn_exp2f(-dl); l_reg*=f; if(hi==0)wsf[r32]=f; resc=true; } } \
    SBAR(); \
    GAPB(o[0]=__builtin_amdgcn_mfma_f32_32x32x16_bf16(PAF(0),VFR(0),o[0],0,0,0), C0,0); \
    GAPB(o[1]=__builtin_amdgcn_mfma_f32_32x32x16_bf16(PAF(0),VFR(4),o[1],0,0,0), C0,4); \
    KRD(GL,0); GAPB(o[0]=__builtin_amdgcn_mfma_f32_32x32x16_bf16(PAF(1),VFR(1),o[0],0,0,0), C0,8); \
    KRD(GL,1); GAPB(o[1]=__builtin_amdgcn_mfma_f32_32x32x16_bf16(PAF(1),VFR(5),o[1],0,0,0), C0,12); \
    KRD(GL,2); GAPB(o[0]=__builtin_amdgcn_mfma_f32_32x32x16_bf16(PAF(2),VFR(2),o[0],0,0,0), C1,0); \
    KRD(GL,3); GAPB(o[1]=__builtin_amdgcn_mfma_f32_32x32x16_bf16(PAF(2),VFR(6),o[1],0,0,0), C1,4); \
    GAPB(o[0]=__builtin_amdgcn_mfma_f32_32x32x16_bf16(PAF(3),VFR(3),o[0],0,0,0), C1,8); \
    GAPB(o[1]=__builtin_amdgcn_mfma_f32_32x32x16_bf16(PAF(3),VFR(7),o[1],0,0,0), C1,12); \
    }while(0)
  int t=1;
  for(;t+5<NT;t+=2){
    STEP(pB0,pB1,pA0,pA1,t,true,true,true);     WAIT_BAR(2); RESC(); ROT();
    STEP(pA0,pA1,pB0,pB1,t+1,true,true,true);   WAIT_BAR(2); RESC(); ROT();
  }
  #define ENDW(tt) do{ if((tt)+3<NT){WAIT_BAR(2);} else if((tt)+2<NT){WAIT_BAR(1);} else {WAIT_BAR(0);} }while(0)
  for(;t+1<NT;t+=2){
    STEP(pB0,pB1,pA0,pA1,t,(t+3<NT),(t+1<NT),(t+1<NT));       ENDW(t);   RESC(); ROT();
    STEP(pA0,pA1,pB0,pB1,t+1,(t+4<NT),(t+2<NT),(t+2<NT));     ENDW(t+1); RESC(); ROT();
  }
  STEP(pB0,pB1,pA0,pA1,NT-1,false,false,false); RESC();
  { float sacc=pB0[0]+pB0[1]; _Pragma("unroll") for(int r=2;r<16;++r)sacc+=pB0[r]; _Pragma("unroll") for(int r=0;r<16;++r)sacc+=pB1[r]; l_reg+=sacc;
    pw0=(u32x4){PKW(pB0,0),PKW(pB0,2),PKW(pB0,4),PKW(pB0,6)};pw1=(u32x4){PKW(pB0,8),PKW(pB0,10),PKW(pB0,12),PKW(pB0,14)};pw2=(u32x4){PKW(pB1,0),PKW(pB1,2),PKW(pB1,4),PKW(pB1,6)};pw3=(u32x4){PKW(pB1,8),PKW(pB1,10),PKW(pB1,12),PKW(pB1,14)};
    SBAR(); pv(o,vb0+sl_cur,PAF(0),PAF(1),PAF(2),PAF(3)); }
  #undef PKW
  #undef PAF
  #undef VFR
  #undef PIN
  #undef MX3
  #undef GAPA
  #undef GAPB
  #undef EX
  #undef VRD
  #undef KRD
  #undef STEP
  #undef ENDW
  {auto rr=__builtin_amdgcn_permlane32_swap(__float_as_uint(l_reg),__float_as_uint(l_reg),false,false);l_reg=__uint_as_float(rr[0])+__uint_as_float(rr[1]);}
  if(use_sink) l_reg+=__builtin_amdgcn_exp2f(fminf((whead?sink_l2b:sink_l2)-mhat,120.f));
  if(hi==0)wsf[32+r32]=l_reg;asm volatile("s_waitcnt lgkmcnt(0)":::"memory");
  float rli[16];
  #pragma unroll
  for(int r=0;r<16;++r)rli[r]=__builtin_amdgcn_rcpf(wsf[32+crow(r,hi)]);
  bf16*Ow=Ou+(long)(wrow*QBLK)*op+whead*D;
  { bf16*stg=(bf16*)(shm+LDS_OST)+wid*2048;
    #pragma unroll
    for(int r=0;r<16;++r){const int orow=crow(r,hi);
      #pragma unroll
      for(int d0=0;d0<2;++d0)stg[orow*64+d0*32+r32]=__float2bfloat16(o[d0][r]*rli[r]);}
    asm volatile("s_waitcnt lgkmcnt(0)":::"memory");
    #pragma unroll
    for(int i=0;i<4;++i){const int row=i*8+(lane>>3),ch=lane&7; const u32x4 v=*(const u32x4*)(stg+row*64+ch*8); ATTN_STORE16(Ow+(long)row*op+ch*8,v);} }
  asm volatile("s_waitcnt lgkmcnt(0)\n\ts_barrier":::"memory");
  #undef KROW
  #undef DMA_K
  #undef DMA_V
  #undef CMASK
  #undef START
  #undef RESC
  #undef ROT
}
#undef SBAR
#undef WAIT_BAR
}
namespace att128 {
using att64::bf16; using att64::bf16x8; using att64::s16x4; using att64::f32x16; using att64::u32x4; using att64::lds_cptr;
using att64::crow; using att64::glds16; using att64::cvtpk_s; using att64::kload8; using att64::kload2; using att64::vtr; using att64::rowmax; using att64::qkt; using att64::fadd_s; using att64::fsub_s;
typedef float f32x4v __attribute__((ext_vector_type(4)));
constexpr int D=64,NW=8,QBLK=32,KVBLK=64;
constexpr int NSLOT=3, SLOTB=8192;
constexpr int LDS_K=0, LDS_V=NSLOT*SLOTB, LDS_WS=LDS_V+2*NSLOT*SLOTB, LDS_O1=LDS_WS+NW*64*4, LDS_BYTES=LDS_O1+NW*8192;
#define SBAR() __builtin_amdgcn_sched_barrier(0)
#define WAIT_BAR(N) asm volatile("s_waitcnt vmcnt(" #N ") lgkmcnt(0)\n\ts_barrier":::"memory")
__device__ __forceinline__ void pv4(f32x16*o,int vb,bf16x8 pa0,bf16x8 pa1,bf16x8 pa2,bf16x8 pa3){
  #pragma unroll
  for(int d0=0;d0<4;++d0){s16x4 lo[4],hi[4];
    #pragma unroll
    for(int ks=0;ks<4;++ks){
      asm volatile("ds_read_b64_tr_b16 %0,%1 offset:%c2":"=&v"(lo[ks]):"v"(vb),"i"(d0*4096+ks*1024):"memory");
      asm volatile("ds_read_b64_tr_b16 %0,%1 offset:%c2":"=&v"(hi[ks]):"v"(vb),"i"(d0*4096+ks*1024+512):"memory");}
    asm volatile("s_waitcnt lgkmcnt(0)":::"memory");SBAR();
    #define PK(k) (bf16x8){lo[k][0],lo[k][1],lo[k][2],lo[k][3],hi[k][0],hi[k][1],hi[k][2],hi[k][3]}
    o[d0]=__builtin_amdgcn_mfma_f32_32x32x16_bf16(pa0,PK(0),o[d0],0,0,0);
    o[d0]=__builtin_amdgcn_mfma_f32_32x32x16_bf16(pa1,PK(1),o[d0],0,0,0);
    o[d0]=__builtin_amdgcn_mfma_f32_32x32x16_bf16(pa2,PK(2),o[d0],0,0,0);
    o[d0]=__builtin_amdgcn_mfma_f32_32x32x16_bf16(pa3,PK(3),o[d0],0,0,0);
    #undef PK
  }
}
template<int THRL> __device__ __forceinline__ void attn_unit(const bf16*Qu,int qp,const bf16*__restrict__ Kh,const bf16*__restrict__ Vh,int kvp,int NT,int second,float lam,const GAS float*subg,float post,bf16*Ou,int op,char*shm,const int wave0){
  const int lane=lane_now(),r32=lane&31,hi=lane>>5; const int wid=wave0;
  const bf16*Qw=Qu+(long)(wid*QBLK)*qp;
  const unsigned lds0=(unsigned)(uintptr_t)shm;
  float*wsf=(float*)(shm+LDS_WS)+wid*64;
  const bf16*ksrc=Kh+(long)lane*kvp+wid*8;
  const bf16*vsrc=Vh+(long)(16*(wid&3)+(lane>>2))*kvp+(wid>>2)*32+(lane&3)*8;
  const unsigned kdst=lds0+LDS_K+wid*1024, vdst=lds0+LDS_V+wid*1024;
  #define DMA_K(t,slot) glds16(ksrc+(long)((t)*KVBLK)*kvp,(unsigned)__builtin_amdgcn_readfirstlane(kdst+(slot)))
  #define DMA_V(t,slot) do{ glds16(vsrc+(long)((t)*KVBLK)*kvp,(unsigned)__builtin_amdgcn_readfirstlane(vdst+2*(slot))); glds16(vsrc+(long)((t)*KVBLK)*kvp+64,(unsigned)__builtin_amdgcn_readfirstlane(vdst+2*(slot)+8192)); }while(0)
  const int vb0=(int)(lds0+LDS_V)+((lane>>4)&1)*32+(lane&3)*8+(4*hi+((lane&15)>>2))*64;
  const char*Kbase=shm+LDS_K; bf16x8 kf[8];
  const lds_cptr shm3=(lds_cptr)shm; const lds_cptr kp0=shm3+LDS_K+hi*1024+r32*16; const lds_cptr vp0=shm3+LDS_V+((lane>>4)&1)*32+(lane&3)*8+(4*hi+((lane&15)>>2))*64;
  DMA_K(0,0);DMA_V(0,0);DMA_K(1,SLOTB);
  bf16x8 qr[4];
  #pragma unroll
  for(int d0=0;d0<4;++d0)qr[d0]=*reinterpret_cast<const bf16x8*>(&Qw[(long)r32*qp+d0*16+hi*8]);
  float mhat=0.f,l_reg=0.f;f32x16 o[4];o[0]=f32x16{};o[1]=f32x16{};o[2]=f32x16{};o[3]=f32x16{};
  bool resc=false;
  #define START(P0,P1) do{ const float rm=rowmax(P0,P1); resc=false; \
    { const float dl=rm; mhat=fadd_s(mhat,dl); \
      _Pragma("unroll") for(int r=0;r<16;++r){P0[r]=fsub_s(P0[r],dl);P1[r]=fsub_s(P1[r],dl);} \
      } \
    _Pragma("unroll") for(int r=0;r<16;++r)P0[r]=__builtin_amdgcn_exp2f(P0[r]); }while(0)
  #define RESC() do{ if(resc){ asm volatile("s_waitcnt lgkmcnt(0)":::"memory"); \
      _Pragma("unroll") for(int r=0;r<16;++r){ const float f_=wsf[crow(r,hi)]; o[0][r]*=f_;o[1][r]*=f_;o[2][r]*=f_;o[3][r]*=f_; } } }while(0)
  f32x16 pA0,pA1,pB0,pB1;
  int sl_prev=0,sl_cur=0,sl_next=SLOTB;
  #define ROT() do{sl_prev=sl_cur;sl_cur=sl_next;sl_next=(sl_next==(NSLOT-1)*SLOTB)?0:sl_next+SLOTB;}while(0)
  DMA_K(2,2*SLOTB);
  WAIT_BAR(4);
  qkt(pA0,pA1,Kbase,qr,f32x16{},r32,hi);asm volatile("s_nop 15\n\ts_nop 7":"+v"(pA0),"+v"(pA1));
  START(pA0,pA1);
  _Pragma("unroll") for(int r=0;r<16;++r)pA1[r]=__builtin_amdgcn_exp2f(pA1[r]);
  WAIT_BAR(0);
  DMA_K(3,0);DMA_V(1,SLOTB);
  ROT();
  kload8(kf,kp0+sl_cur);
  WAIT_BAR(3);
  s16x4 vlo[16],vhi[16]; u32x4 pw0,pw1,pw2,pw3;
  #define PKW(P,B) cvtpk_s(P[B],P[B+1])
  #define PAF(k) __builtin_bit_cast(bf16x8,pw##k)
  #define VFR(i) (bf16x8){vlo[i][0],vlo[i][1],vlo[i][2],vlo[i][3],vhi[i][0],vhi[i][1],vhi[i][2],vhi[i][3]}
  #define PIN(x) asm volatile("":"+v"(x))
  #define MX3(a,b,c) __builtin_fmaxf(__builtin_fmaxf((a),(b)),(c))
  #define GAPA(MF,A0,A1,A2,A3,W0,W1,PW) do{ MF; sacc+=A0; sacc+=A1; sacc+=A2; sacc+=A3; PIN(sacc); W0; W1; PIN(PW); SBAR(); }while(0)
  #define EX(v) __builtin_amdgcn_exp2f(v)
  #define GAPB(MF,X,B) do{ MF; X[B]=EX(X[B]); X[B+1]=EX(X[B+1]); PIN(X); SBAR(); }while(0)
  #define VRD(n) do{ vlo[n]=vtr(vp_+(((n)&3)*4096+((n)>>2)*1024)); vhi[n]=vtr(vp_+(((n)&3)*4096+((n)>>2)*1024+512)); }while(0)
  #define KRD(G,j) do{ if(G){ kload2(kf,kp0+sl_next,j); SBAR(); } }while(0)
  #define PVM(n,k) o[(n)&3]=__builtin_amdgcn_mfma_f32_32x32x16_bf16(PAF(k),VFR(n),o[(n)&3],0,0,0)
  #define STEP(C0,C1,P0,P1,t,GK,GV,GL) do{ SBAR(); \
    const lds_cptr vp_=vp0+2*sl_prev; \
    VRD(0); SBAR(); float sacc=(P0[0]+P0[1]); \
    GAPA(C0=__builtin_amdgcn_mfma_f32_32x32x16_bf16(kf[0],qr[0],f32x16{},0,0,0), P0[2],P0[3],P0[4],P0[5],     pw0[0]=PKW(P0,0), pw0[1]=PKW(P0,2), pw0); \
    VRD(1); SBAR(); GAPA(C1=__builtin_amdgcn_mfma_f32_32x32x16_bf16(kf[1],qr[0],f32x16{},0,0,0), P0[6],P0[7],P0[8],P0[9],     pw0[2]=PKW(P0,4), pw0[3]=PKW(P0,6), pw0); \
    VRD(2); SBAR(); GAPA(C0=__builtin_amdgcn_mfma_f32_32x32x16_bf16(kf[2],qr[1],C0,0,0,0),   P0[10],P0[11],P0[12],P0[13], pw1[0]=PKW(P0,8), pw1[1]=PKW(P0,10), pw1); \
    VRD(3); SBAR(); GAPA(C1=__builtin_amdgcn_mfma_f32_32x32x16_bf16(kf[3],qr[1],C1,0,0,0),   P0[14],P0[15],P1[0],P1[1],   pw1[2]=PKW(P0,12),pw1[3]=PKW(P0,14), pw1); \
    VRD(4); SBAR(); GAPA(C0=__builtin_amdgcn_mfma_f32_32x32x16_bf16(kf[4],qr[2],C0,0,0,0),   P1[2],P1[3],P1[4],P1[5],     pw2[0]=PKW(P1,0), pw2[1]=PKW(P1,2), pw2); \
    VRD(5); SBAR(); GAPA(C1=__builtin_amdgcn_mfma_f32_32x32x16_bf16(kf[5],qr[2],C1,0,0,0),   P1[6],P1[7],P1[8],P1[9],     pw2[2]=PKW(P1,4), pw2[3]=PKW(P1,6), pw2); \
    VRD(6); SBAR(); GAPA(C0=__builtin_amdgcn_mfma_f32_32x32x16_bf16(kf[6],qr[3],C0,0,0,0),   P1[10],P1[11],P1[12],P1[13], pw3[0]=PKW(P1,8), pw3[1]=PKW(P1,10), pw3); \
    VRD(7); SBAR(); GAPA(C1=__builtin_amdgcn_mfma_f32_32x32x16_bf16(kf[7],qr[3],C1,0,0,0),   P1[14],P1[15],0.f,0.f,       pw3[2]=PKW(P1,12),pw3[3]=PKW(P1,14), pw3); \
    l_reg+=sacc; \
    if(GK){DMA_K((t)+3,sl_cur);} if(GV){DMA_V((t)+1,sl_next);} \
    { float a=MX3(C0[0],C0[1],C1[0]),b=MX3(C0[2],C0[3],C1[1]); a=MX3(a,C1[2],C1[3]); \
      _Pragma("unroll") for(int r=4;r<16;r+=4){a=MX3(a,C0[r],C0[r+1]);b=MX3(b,C0[r+2],C0[r+3]);a=MX3(a,C1[r],C1[r+1]);b=MX3(b,C1[r+2],C1[r+3]);} \
      float rm=__builtin_fmaxf(a,b); { auto rr=__builtin_amdgcn_permlane32_swap(__float_as_uint(rm),__float_as_uint(rm),false,false); rm=__builtin_fmaxf(__uint_as_float(rr[0]),__uint_as_float(rr[1])); } \
      rm-=mhat; \
      resc=false; \
      if(__builtin_expect(__any(rm>(float)THRL),0)){ const float dl=__builtin_fmaxf(rm,0.f); mhat+=dl; \
        const float f=__builtin_amdgcn_exp2f(-dl); l_reg*=f; if(hi==0)wsf[r32]=f; resc=true; } \
      _Pragma("unroll") for(int r=0;r<16;++r){C0[r]-=mhat;C1[r]-=mhat;} } \
    SBAR(); \
    VRD(8);  SBAR(); GAPB(PVM(0,0),C0,0); \
    VRD(9);  SBAR(); GAPB(PVM(1,0),C0,2); \
    VRD(10); SBAR(); GAPB(PVM(2,0),C0,4); \
    VRD(11); SBAR(); GAPB(PVM(3,0),C0,6); \
    VRD(12); SBAR(); GAPB(PVM(4,1),C0,8); \
    VRD(13); SBAR(); GAPB(PVM(5,1),C0,10); \
    VRD(14); SBAR(); GAPB(PVM(6,1),C0,12); \
    VRD(15); SBAR(); GAPB(PVM(7,1),C0,14); \
    KRD(GL,0); GAPB(PVM(8,2),C1,0); \
    KRD(GL,1); GAPB(PVM(9,2),C1,2); \
    KRD(GL,2); GAPB(PVM(10,2),C1,4); \
    KRD(GL,3); GAPB(PVM(11,2),C1,6); \
    GAPB(PVM(12,3),C1,8); \
    GAPB(PVM(13,3),C1,10); \
    GAPB(PVM(14,3),C1,12); \
    GAPB(PVM(15,3),C1,14); \
    }while(0)
  int t=1;
  for(;t+5<NT;t+=2){
    STEP(pB0,pB1,pA0,pA1,t,true,true,true);     WAIT_BAR(3); RESC(); ROT();
    STEP(pA0,pA1,pB0,pB1,t+1,true,true,true);   WAIT_BAR(3); RESC(); ROT();
  }
  #define ENDW(tt) do{ if((tt)+3<NT){WAIT_BAR(3);} else if((tt)+2<NT){WAIT_BAR(2);} else {WAIT_BAR(0);} }while(0)
  for(;t+1<NT;t+=2){
    STEP(pB0,pB1,pA0,pA1,t,(t+3<NT),(t+1<NT),(t+1<NT));       ENDW(t);   RESC(); ROT();
    STEP(pA0,pA1,pB0,pB1,t+1,(t+4<NT),(t+2<NT),(t+2<NT));     ENDW(t+1); RESC(); ROT();
  }
  STEP(pB0,pB1,pA0,pA1,NT-1,false,false,false); RESC();
  { float sacc=pB0[0]+pB0[1]; _Pragma("unroll") for(int r=2;r<16;++r)sacc+=pB0[r]; _Pragma("unroll") for(int r=0;r<16;++r)sacc+=pB1[r]; l_reg+=sacc;
    pw0=(u32x4){PKW(pB0,0),PKW(pB0,2),PKW(pB0,4),PKW(pB0,6)};pw1=(u32x4){PKW(pB0,8),PKW(pB0,10),PKW(pB0,12),PKW(pB0,14)};pw2=(u32x4){PKW(pB1,0),PKW(pB1,2),PKW(pB1,4),PKW(pB1,6)};pw3=(u32x4){PKW(pB1,8),PKW(pB1,10),PKW(pB1,12),PKW(pB1,14)};
    SBAR(); pv4(o,vb0+2*sl_cur,PAF(0),PAF(1),PAF(2),PAF(3)); }
  #undef PKW
  #undef PAF
  #undef VFR
  #undef MX3
  #undef GAPA
  #undef GAPB
  #undef EX
  #undef VRD
  #undef KRD
  #undef PVM
  #undef STEP
  #undef ENDW
  {auto rr=__builtin_amdgcn_permlane32_swap(__float_as_uint(l_reg),__float_as_uint(l_reg),false,false);l_reg=__uint_as_float(rr[0])+__uint_as_float(rr[1]);}
  if(hi==0)wsf[32+r32]=l_reg;asm volatile("s_waitcnt lgkmcnt(0)":::"memory");
  typedef unsigned u32x2v __attribute__((ext_vector_type(2)));
  u32x2v*sp=(u32x2v*)(shm+LDS_O1+wid*8192)+lane;
  if(!second){
    #pragma unroll
    for(int r=0;r<16;++r){ const float rl=__builtin_amdgcn_rcpf(wsf[32+crow(r,hi)]); const u32x2v v={cvtpk_s(o[0][r]*rl,o[1][r]*rl),cvtpk_s(o[2][r]*rl,o[3][r]*rl)}; sp[r*64]=v; }
  } else {
    float g4[4];
    #pragma unroll
    for(int d0=0;d0<4;++d0)g4[d0]=subg[d0*32+r32]*post;
    #pragma unroll
    for(int r=0;r<16;++r){ const float rl=__builtin_amdgcn_rcpf(wsf[32+crow(r,hi)])*lam; const u32x2v av=sp[r*64];
      const float a0=__uint_as_float(av[0]<<16),a1=__uint_as_float(av[0]&0xffff0000u),a2=__uint_as_float(av[1]<<16),a3=__uint_as_float(av[1]&0xffff0000u);
      float v0=a0-o[0][r]*rl,v1=a1-o[1][r]*rl,v2=a2-o[2][r]*rl,v3=a3-o[3][r]*rl; float ss=(v0*v0+v1*v1)+(v2*v2+v3*v3);
      ss+=__shfl_xor(ss,1);ss+=__shfl_xor(ss,2);ss+=__shfl_xor(ss,4);ss+=__shfl_xor(ss,8);ss+=__shfl_xor(ss,16);
      const float rn=__builtin_amdgcn_rsqf(ss*(1.0f/128.0f)+1e-6f);
      o[0][r]=v0*rn*g4[0];o[1][r]=v1*rn*g4[1];o[2][r]=v2*rn*g4[2];o[3][r]=v3*rn*g4[3]; }
    bf16*Ow=Ou+(long)(wid*QBLK)*op;
    bf16*stg=(bf16*)(shm+LDS_O1+wid*8192);
    asm volatile("s_waitcnt lgkmcnt(0)":::"memory");
    #pragma unroll
    for(int r=0;r<16;++r){const int orow=crow(r,hi);
      #pragma unroll
      for(int d0=0;d0<4;++d0)stg[orow*128+d0*32+r32]=__float2bfloat16(o[d0][r]);}
    asm volatile("s_waitcnt lgkmcnt(0)":::"memory");
    #pragma unroll
    for(int i=0;i<8;++i){const int row=i*4+(lane>>4),ch=lane&15; const u32x4 v=*(const u32x4*)(stg+row*128+ch*8); ATTN_STORE16(Ow+(long)row*op+ch*8,v);}
  }
  asm volatile("s_waitcnt lgkmcnt(0)\n\ts_barrier":::"memory");
  #undef PIN
  #undef DMA_K
  #undef DMA_V
  #undef START
  #undef RESC
  #undef ROT
}
#undef SBAR
#undef WAIT_BAR
}

typedef unsigned short bf16;
typedef float f32x4 __attribute__((ext_vector_type(4)));
typedef unsigned u32x4 __attribute__((ext_vector_type(4)));
typedef unsigned u32x2 __attribute__((ext_vector_type(2)));
constexpr int D = 1024, NBATCH = 4, SEQ = 4096, CTXL = 256, DEPTH = 2;
constexpr int MLAT = NBATCH * SEQ, MCTX = NBATCH * CTXL, MTOT = MLAT + MCTX;
constexpr int KVR = SEQ + CTXL;
constexpr int NIN = 6144, NE = 32, TOPK = 4, NWAVES = 8;
constexpr int MAXTILES = 304;
constexpr float EPS = 1e-6f;

constexpr size_t al256(size_t x) { return (x + 255) / 256 * 256; }
constexpr size_t WS_CTL = 0, CTL_BYTES = 1u << 20;
constexpr size_t WS_MOD = WS_CTL + CTL_BYTES;
constexpr size_t WS_ROPEC = WS_MOD + al256((size_t)DEPTH * 5 * NIN * 4);
constexpr size_t WS_ROPES = WS_ROPEC + 4096;
constexpr size_t WS_LAM = WS_ROPES + 4096;
constexpr size_t WS_PV = WS_LAM + 256;
constexpr size_t WS_WIN = WS_PV + (size_t)DEPTH * 5 * 4 * D * 4;
constexpr size_t WS_WB = WS_WIN + (size_t)DEPTH * NIN * D * 2;
constexpr size_t WS_WO = WS_WB + (size_t)DEPTH * 3 * D * 512 * 2;
constexpr size_t WS_W1 = WS_WO + (size_t)DEPTH * D * D * 2;
constexpr size_t WS_W2 = WS_W1 + (size_t)DEPTH * NE * 2048 * D * 2;
constexpr size_t WS_X = WS_W2 + (size_t)DEPTH * NE * D * D * 2;
constexpr size_t WS_H = WS_X + (size_t)MTOT * D * 4;
constexpr size_t WS_QA = WS_H + (size_t)MTOT * D * 2;
constexpr size_t WS_QB = WS_QA + (size_t)MTOT * 512 * 2;
constexpr size_t WS_QC = WS_QB + (size_t)MTOT * 512 * 2;
constexpr size_t WS_KA = WS_QC + (size_t)MTOT * 512 * 2;
constexpr size_t WS_VA = WS_KA + (size_t)NBATCH * KVR * 512 * 2;
constexpr size_t WS_KB = WS_VA + (size_t)NBATCH * KVR * 512 * 2;
constexpr size_t WS_VB = WS_KB + (size_t)NBATCH * KVR * 128 * 2;
constexpr size_t WS_KC = WS_VB + (size_t)NBATCH * KVR * 128 * 2;
constexpr size_t WS_VC = WS_KC + (size_t)NBATCH * KVR * 128 * 2;
constexpr size_t WS_GT = WS_VC + (size_t)NBATCH * KVR * 128 * 2;
constexpr size_t WS_YS = WS_GT + (size_t)MTOT * 3072 * 2;
constexpr size_t WS_TMP = WS_YS + (size_t)3 * MTOT * 512 * 2;
constexpr size_t WS_MG = WS_TMP + (size_t)MTOT * D * 4;
constexpr size_t WS_Y = WS_MG + (size_t)MTOT * D * 2;
constexpr size_t WS_H2 = WS_Y + (size_t)MTOT * D * 4;
constexpr size_t WS_SE = WS_H2 + (size_t)MTOT * D * 2;
constexpr size_t WS_SR = WS_SE + (size_t)MTOT * 4 * 4;
constexpr size_t WS_SW = WS_SR + (size_t)MTOT * 4 * 4;
constexpr size_t WS_LIST = WS_SW + (size_t)MTOT * 4 * 4;
constexpr size_t WS_ACT = WS_LIST + (size_t)NE * MTOT * 4;
constexpr size_t WS_YS2 = WS_ACT + (size_t)MAXTILES * 256 * D * 2;
constexpr size_t WS_EX = WS_YS2 + (size_t)MAXTILES * 256 * D * 2;
constexpr size_t WS_END = WS_EX + (size_t)DEPTH * 256 * 131072;
static_assert(WS_WIN % 256 == 0 && WS_X % 256 == 0 && WS_SE % 256 == 0 && WS_ACT % 256 == 0, "alignment");

constexpr int CW_BAR = 4096;
constexpr int CW_Q = 16384;
constexpr int CW_CNT = 8192;

constexpr int RING_BYTES = 141312, MISC_OFF = RING_BYTES, TAB_OFF = MISC_OFF + 8192, LDS_BYTES = TAB_OFF + 8192 + 512;
constexpr int MW_Q = 12; constexpr int MW_BAR = 0, MW_TB = 16, MW_CNT = 64, MW_HIST = 128, MW_BASE = 160, MW_PT = 192, MW_SLOT = 256;

#define LDS_WAIT() asm volatile("s_waitcnt lgkmcnt(0)" ::: "memory")
#define VM_WAIT() asm volatile("s_waitcnt vmcnt(0)" ::: "memory")
__device__ __forceinline__ unsigned f2bf(float f) { unsigned u = __builtin_bit_cast(unsigned, f); return (u + 0x7fffu + ((u >> 16) & 1u)) >> 16; }
typedef float f32x2_t __attribute__((ext_vector_type(2))); typedef __bf16 bf16x2_t __attribute__((ext_vector_type(2)));
__device__ __forceinline__ unsigned pk2(float lo, float hi) { const f32x2_t v = {lo, hi}; const bf16x2_t b = __builtin_convertvector(v, bf16x2_t); return __builtin_bit_cast(unsigned, b); }
__device__ __forceinline__ unsigned pk4f8(float a, float b, float c, float d) {
    int r = __builtin_amdgcn_cvt_pk_fp8_f32(a, b, 0, false); r = __builtin_amdgcn_cvt_pk_fp8_f32(c, d, r, true); return (unsigned)r; }
constexpr float W8_SCALE = 64.0f, W8_INV = 1.0f / 64.0f;
__device__ __forceinline__ float bflo(unsigned w) { return __builtin_bit_cast(float, w << 16); }
__device__ __forceinline__ float bfhi(unsigned w) { return __builtin_bit_cast(float, w & 0xffff0000u); }
template <int CTRL> __device__ __forceinline__ float dppf(float v) { return __builtin_bit_cast(float, __builtin_amdgcn_update_dpp(0, __builtin_bit_cast(int, v), CTRL, 0xf, 0xf, true)); }
template <int CTRL> __device__ __forceinline__ int dppi(int v) { return __builtin_amdgcn_update_dpp(0, v, CTRL, 0xf, 0xf, true); }
__device__ __forceinline__ float rdl(float v, int l) { return __builtin_bit_cast(float, __builtin_amdgcn_readlane(__builtin_bit_cast(int, v), l)); }
__device__ __forceinline__ float wave_sum(float v) {
    v += dppf<0xB1>(v); v += dppf<0x4E>(v); v += dppf<0x141>(v); v += dppf<0x140>(v);
    return (rdl(v, 0) + rdl(v, 16)) + (rdl(v, 32) + rdl(v, 48));
}
__device__ __forceinline__ float sigmoid255_(float x) { return __builtin_amdgcn_rcpf(__builtin_fmaf(__builtin_amdgcn_exp2f(-1.4426950408889634f * x), 1.0f / 255.0f, 1.0f / 255.0f)); }
__device__ __forceinline__ float sigmoidf_(float x) { return __builtin_amdgcn_rcpf(1.0f + __builtin_amdgcn_exp2f(-1.4426950408889634f * x)); }

__device__ __forceinline__ unsigned char* ldp(volatile LAS unsigned* MISC, int i) {
    const unsigned lo = (unsigned)__builtin_amdgcn_readfirstlane((int)MISC[MW_PT + 2 * i]), hi = (unsigned)__builtin_amdgcn_readfirstlane((int)MISC[MW_PT + 2 * i + 1]);
    return (unsigned char*)(((unsigned long long)hi << 32) | lo);
}
typedef const GAS float* gcfp; typedef GAS float* gfp; typedef const GAS unsigned short* gcbp; typedef GAS unsigned short* gbp;
#define INP(i) ((const GAS float*)ldp(MISC, (i)))
#define WSP(T, off) ((GAS T*)(ldp(MISC, 21) + (off)))
#define XB_TMO      128
#define XB_XCNT(j)  (256  + 64 * (j))
#define XB_XSUB(j)  (1280 + 64 * (j))
#define XB_XGEN(j)  (2304 + 64 * (j))
#define XB_TOP      3328
#define XB_TOPGEN   3392
#define XCD_BAR_WORDS 3456
#define XB_SPIN_CAP (1u << 18)

__device__ __forceinline__ unsigned xb_ld(unsigned* p)              { return __hip_atomic_load(p, __ATOMIC_RELAXED, __HIP_MEMORY_SCOPE_AGENT); }
__device__ __forceinline__ unsigned xb_add(unsigned* p, unsigned v) { return __hip_atomic_fetch_add(p, v, __ATOMIC_RELAXED, __HIP_MEMORY_SCOPE_AGENT); }
__device__ __forceinline__ unsigned xb_xcc_id() { return (unsigned)__builtin_amdgcn_s_getreg((3 << 11) | 20) & 0xFu; }
#define XB_SPIN(cond, bar) do { unsigned _sp = 0; while (cond) { __builtin_amdgcn_s_sleep(1); \
    if ((++_sp & 255u) == 0u) { if (xb_ld(&(bar)[XB_TMO])) break; if (_sp > XB_SPIN_CAP) { atomicAdd(&(bar)[XB_TMO], 1u); break; } } } } while (0)

struct XcdBarrier {
    unsigned* bar; unsigned x;
    volatile LAS unsigned* st;
};

__device__ __forceinline__ XcdBarrier xcd_barrier_post(unsigned* bar, volatile LAS unsigned* st) {
    XcdBarrier b; b.bar = bar; b.x = xb_xcc_id(); b.st = st;
    if (threadIdx.x == 0) (void)xb_add(&bar[XB_XCNT(b.x)], 1u);
    return b;
}
__device__ __forceinline__ void xcd_barrier_complete(unsigned* bar, unsigned x, unsigned& nloc, unsigned& nx) {
    const unsigned G = gridDim.x * gridDim.y * gridDim.z;
    unsigned sum, cnt, mine, sp = 0u;
    for (;;) {
        sum = 0u; cnt = 0u; mine = 0u;
#pragma unroll
        for (unsigned j = 0; j < 16; ++j) { const unsigned c = xb_ld(&bar[XB_XCNT(j)]); sum += c; cnt += (c > 0u) ? 1u : 0u; mine = (j == x) ? c : mine; }
        if (sum == G) break;
        __builtin_amdgcn_s_sleep(1);
        if ((++sp & 255u) == 0u) { if (xb_ld(&bar[XB_TMO])) break; if (sp > XB_SPIN_CAP) { atomicAdd(&bar[XB_TMO], 1u); break; } }
    }
    nloc = mine > 0u ? mine : 1u; nx = cnt > 0u ? cnt : 1u;
}

__device__ __forceinline__ void xcd_barrier(const XcdBarrier& b, const int tid_now) {
    asm volatile("s_waitcnt vmcnt(0)" ::: "memory");
    __syncthreads();
    if (tid_now == 0) {
        unsigned long long bp_ = (unsigned long long)b.bar; asm volatile("" : "+s"(bp_)); unsigned* bar = (unsigned*)bp_;
        unsigned bx_ = b.x; asm volatile("" : "+s"(bx_));
        __builtin_amdgcn_s_waitcnt(0);
        unsigned nloc = b.st[0], nx = b.st[1];
        if (nloc == 0u) { xcd_barrier_complete(bar, bx_, nloc, nx); b.st[0] = nloc; b.st[1] = nx; }
        const unsigned old = xb_add(&bar[XB_XSUB(bx_)], 1u);
        const unsigned gen = old / nloc;
        if (old + 1u == (gen + 1u) * nloc) {
            __builtin_amdgcn_fence(__ATOMIC_RELEASE, "agent");
            asm volatile("s_waitcnt vmcnt(0)" ::: "memory");
            const unsigned og = xb_add(&bar[XB_TOP], 1u);
            const unsigned tg = og / nx;
            if (og + 1u == (tg + 1u) * nx) xb_add(&bar[XB_TOPGEN], 1u);
            else XB_SPIN(xb_ld(&bar[XB_TOPGEN]) == tg, bar);
            __builtin_amdgcn_fence(__ATOMIC_ACQUIRE, "agent");
            xb_add(&bar[XB_XGEN(bx_)], 1u);
            asm volatile("s_waitcnt vmcnt(0)" ::: "memory");
        } else {
            XB_SPIN(xb_ld(&bar[XB_XGEN(bx_)]) == gen, bar);
            __builtin_amdgcn_fence(__ATOMIC_ACQUIRE, "agent");
            asm volatile("s_waitcnt vmcnt(0)" ::: "memory");
        }
    }
    __syncthreads();
}

using pg8::Unit;
__host__ __device__ __forceinline__ int in_src_col(int nbd) {
    const int pn = nbd >> 3, blk = nbd & 7, bj = blk >> 2, wc = blk & 3;
    if (pn <= 8) { const int hs = pn * 4 + wc; int base;
        if (hs < 8) base = hs * 64; else if (hs < 16) base = 512 + (hs - 8) * 64; else if (hs < 24) base = 1536 + (hs - 16) * 64;
        else if (hs < 32) base = 2304 + (hs - 24) * 64; else if (hs < 34) base = 2048 + (hs - 32) * 64; else base = 2816 + (hs - 34) * 64;
        return base + 32 * bj; }
    if (pn <= 10) return 1024 + (pn - 9) * 256 + blk * 32;
    if (pn == 11) return blk < 4 ? 2176 + blk * 32 : 2944 + (blk - 4) * 32;
    return 3072 + (pn - 12) * 256 + blk * 32;
}
struct EpiInproj {
    static constexpr bool PERM = false;
    volatile LAS unsigned* MISC; int l;
    __device__ __forceinline__ void operator()(const f32x4 (&acc)[2][2][4][2], const Unit& u, int wr, int wc, int fr, int fq) const {
        auto QA = WSP(bf16, WS_QA); auto QB = WSP(bf16, WS_QB); auto QC = WSP(bf16, WS_QC); auto KA = WSP(bf16, WS_KA); auto VA = WSP(bf16, WS_VA);
        auto KB = WSP(bf16, WS_KB); auto VB = WSP(bf16, WS_VB); auto KC = WSP(bf16, WS_KC); auto VC = WSP(bf16, WS_VC); auto GT = WSP(bf16, WS_GT);
        const LAS float* ropec = (const LAS float*)MISC + (TAB_OFF - MISC_OFF) / 4; const LAS float* ropes = ropec + 1024; const LAS float* qkg = ropec + 2048;
        const int pn = u.pn; const bool ctx = u.pm >= (MLAT / 256);
#pragma unroll
        for (int ai = 0; ai < 2; ++ai)
#pragma unroll
            for (int m = 0; m < 4; ++m) {
                const int r = u.pm * 256 + ai * 128 + wr * 64 + m * 16 + fr;
                int kvrow, t = 0;
                if (!ctx) { t = r & (SEQ - 1); kvrow = (r >> 12) * KVR + t; } else { const int rr = r - MLAT; kvrow = (rr >> 8) * KVR + SEQ + (rr & 255); }
                if (pn <= 8) {
                    float v[2][2][4];
#pragma unroll
                    for (int bj = 0; bj < 2; ++bj)
#pragma unroll
                        for (int n = 0; n < 2; ++n)
#pragma unroll
                            for (int j = 0; j < 4; ++j) v[bj][n][j] = acc[ai][bj][m][n][j];
                    const int hs = pn * 4 + wc;
                    const bool isbq = (pn == 4 || pn == 5), isbk = (pn == 8 && wc < 2);
                    if (isbq || isbk) {
                        float ss = 0.f;
#pragma unroll
                        for (int bj = 0; bj < 2; ++bj)
#pragma unroll
                            for (int n = 0; n < 2; ++n)
#pragma unroll
                                for (int j = 0; j < 4; ++j) ss += v[bj][n][j] * v[bj][n][j];
                        ss += __shfl_xor(ss, 16); ss += __shfl_xor(ss, 32);
                        const float rn = __builtin_amdgcn_rsqf(ss * (1.0f / 64.0f) + EPS);
                        const LAS float* g = qkg + (isbk ? 64 : 0);
#pragma unroll
                        for (int bj = 0; bj < 2; ++bj)
#pragma unroll
                            for (int n = 0; n < 2; ++n) { const f32x4 gv = *(const LAS f32x4*)(g + 32 * bj + 16 * n + 4 * fq);
#pragma unroll
                                for (int j = 0; j < 4; ++j) v[bj][n][j] = v[bj][n][j] * rn * gv[j]; }
                    }
                    if (!ctx) {
#pragma unroll
                        for (int bj = 0; bj < 2; ++bj) { const int pos = bj ? (t & 63) : (t >> 6);
                            const f32x4 cs = *(const LAS f32x4*)(ropec + pos * 16 + 4 * fq), sn = *(const LAS f32x4*)(ropes + pos * 16 + 4 * fq);
#pragma unroll
                            for (int j = 0; j < 4; ++j) { const float x0 = v[bj][0][j], x1 = v[bj][1][j];
                                v[bj][0][j] = x0 * cs[j] - x1 * sn[j]; v[bj][1][j] = x1 * cs[j] + x0 * sn[j]; } }
                    }
                    if (isbq || pn == 6 || pn == 7 || (pn < 2 && !ctx)) {
#pragma unroll
                        for (int bj = 0; bj < 2; ++bj)
#pragma unroll
                            for (int n = 0; n < 2; ++n)
#pragma unroll
                                for (int j = 0; j < 4; ++j) v[bj][n][j] *= att64::C2; }
                    gbp dst;
                    if (pn < 2) dst = QA + (size_t)r * 512 + hs * 64;
                    else if (pn < 4) dst = KA + (size_t)kvrow * 512 + (hs - 8) * 64;
                    else if (pn < 6) dst = QB + (size_t)r * 512 + (hs - 16) * 64;
                    else if (pn < 8) dst = QC + (size_t)r * 512 + (hs - 24) * 64;
                    else if (wc < 2) dst = KB + (size_t)kvrow * 128 + wc * 64;
                    else dst = KC + (size_t)kvrow * 128 + (wc - 2) * 64;
#pragma unroll
                    for (int bj = 0; bj < 2; ++bj) { u32x4 w; w.x = pk2(v[bj][0][0], v[bj][0][1]); w.y = pk2(v[bj][0][2], v[bj][0][3]); w.z = pk2(v[bj][1][0], v[bj][1][1]); w.w = pk2(v[bj][1][2], v[bj][1][3]);
                        *(GAS u32x4*)(dst + 32 * bj + 8 * fq) = w; }
                } else if (pn <= 11) {
#pragma unroll
                    for (int bj = 0; bj < 2; ++bj) { const int c = 128 * bj + 32 * wc + 8 * fq; const f32x4 x = acc[ai][bj][m][0], y = acc[ai][bj][m][1];
                            gbp dst = (pn < 11) ? VA + (size_t)kvrow * 512 + (pn - 9) * 256 + c : ((bj == 0) ? VB : VC) + (size_t)kvrow * 128 + (c & 127);
                            u32x4 w; w.x = pk2(x[0], x[1]); w.y = pk2(x[2], x[3]); w.z = pk2(y[0], y[1]); w.w = pk2(y[2], y[3]); *(GAS u32x4*)dst = w; }
                } else {
#pragma unroll
                    for (int bj = 0; bj < 2; ++bj) { const int c = 128 * bj + 32 * wc + 8 * fq; const f32x4 x = acc[ai][bj][m][0], y = acc[ai][bj][m][1];
                            u32x2 w = {0u, 0u};
#pragma unroll
                            for (int j = 0; j < 4; ++j) { w.x = __builtin_amdgcn_cvt_pk_u8_f32(sigmoid255_(x[j]), (unsigned)j, w.x); w.y = __builtin_amdgcn_cvt_pk_u8_f32(sigmoid255_(y[j]), (unsigned)j, w.y); }
                            *(GAS u32x2*)((GAS unsigned char*)GT + (size_t)r * 3072 + (pn - 12) * 256 + c) = w; }
                }
            }
    }
};

#if defined(EPIDUP_INPROJ)
namespace pg8 { template <> struct epi_dup<::EpiInproj> { static constexpr int v = 1; }; }
#endif
struct MergeOrder {
    int ntiles, G, vcu;
    __device__ __forceinline__ bool next(int i, Unit& u) const { const int rnd = i / 3, sub = i - rnd * 3; const int tl = rnd * G + vcu; if (tl >= ntiles) return false;
        u.pm = sub * (MTOT / 256) + (tl >> 2); u.pn = sub * 4 + (tl & 3); return true; }
    __device__ __forceinline__ unsigned a_row(const Unit&, int) const { return 0u; }
};
struct EpiMerge {
    static constexpr bool PERM = true;
    volatile LAS unsigned* MISC;
    __device__ __forceinline__ bool keep(const Unit& u) const { return (u.pn >> 2) < 2; }
    __device__ __forceinline__ void operator()(f32x4 (&acc)[2][2][4][2], const Unit& u, int wr, int wc, int fr, int fq) const {
        const auto GT = WSP(bf16, WS_GT); auto MG = WSP(bf16, WS_MG);
        const int sub = u.pn >> 2, pnr = u.pn & 3, pmr = u.pm - sub * (MTOT / 256);
        constexpr float GMIN = 1e-24f;
        const int subn = sub < 2 ? sub + 1 : sub;
        const GAS unsigned char* gbase = (const GAS unsigned char*)GT + ((size_t)pmr * 256 + wr * 64 + fr) * 3072 + pnr * 256 + wc * 32 + 8 * fq;
        u32x2 gw[2][4][2], gn[2][4][2];
#pragma unroll
        for (int ai = 0; ai < 2; ++ai)
#pragma unroll
            for (int m = 0; m < 4; ++m)
#pragma unroll
                for (int bj = 0; bj < 2; ++bj) { const GAS unsigned char* p = gbase + (size_t)(ai * 128 + m * 16) * 3072 + bj * 128;
                    gw[ai][m][bj] = *(const GAS u32x2*)(p + sub * 1024); gn[ai][m][bj] = *(const GAS u32x2*)(p + subn * 1024); }
        const float nmin = sub > 0 ? GMIN : 0.0f;
        const bool last = sub == 2;
#pragma unroll
        for (int ai = 0; ai < 2; ++ai)
#pragma unroll
            for (int m = 0; m < 4; ++m)
#pragma unroll
                for (int bj = 0; bj < 2; ++bj) {
                    const u32x2 a = gw[ai][m][bj], b = gn[ai][m][bj];
                    float g[8] = {(float)(a.x & 0xffu), (float)((a.x >> 8) & 0xffu), (float)((a.x >> 16) & 0xffu), (float)(a.x >> 24), (float)(a.y & 0xffu), (float)((a.y >> 8) & 0xffu), (float)((a.y >> 16) & 0xffu), (float)(a.y >> 24)};
                    const float d[8] = {(float)(b.x & 0xffu), (float)((b.x >> 8) & 0xffu), (float)((b.x >> 16) & 0xffu), (float)(b.x >> 24), (float)(b.y & 0xffu), (float)((b.y >> 8) & 0xffu), (float)((b.y >> 16) & 0xffu), (float)(b.y >> 24)};
#pragma unroll
                    for (int k = 0; k < 8; ++k) g[k] = fmaxf(g[k], nmin) * (last ? (1.0f / 255.0f) : __builtin_amdgcn_rcpf(fmaxf(d[k], GMIN)));
                    f32x4 v0 = acc[ai][bj][m][0], v1 = acc[ai][bj][m][1];
                    v0[0] *= g[0]; v0[1] *= g[1]; v0[2] *= g[2]; v0[3] *= g[3]; v1[0] *= g[4]; v1[1] *= g[5]; v1[2] *= g[6]; v1[3] *= g[7];
                    acc[ai][bj][m][0] = v0; acc[ai][bj][m][1] = v1; }
        if (last) {
#pragma unroll
            for (int ai = 0; ai < 2; ++ai)
#pragma unroll
                for (int m = 0; m < 4; ++m) { const size_t row = (size_t)pmr * 256 + ai * 128 + wr * 64 + m * 16 + fr;
#pragma unroll
                    for (int bj = 0; bj < 2; ++bj) { const int col = pnr * 256 + bj * 128 + wc * 32 + 8 * fq; const f32x4 v0 = acc[ai][bj][m][0], v1 = acc[ai][bj][m][1];
                        u32x4 w; w.x = pk2(v0[0], v0[1]); w.y = pk2(v0[2], v0[3]); w.z = pk2(v1[0], v1[1]); w.w = pk2(v1[2], v1[3]); *(GAS u32x4*)(MG + row * 1024 + col) = w; } }
        }
    }
};
namespace pg8 { template <> struct epi_chain<::EpiMerge> { static constexpr bool v = true; }; }
struct EpiOut {
    static constexpr bool PERM = true;
    volatile LAS unsigned* MISC;
    __device__ __forceinline__ void operator()(const f32x4 (&acc)[2][2][4][2], const Unit& u, int wr, int wc, int fr, int fq) const {
        auto Y = WSP(bf16, WS_Y);
#pragma unroll
        for (int ai = 0; ai < 2; ++ai)
#pragma unroll
            for (int m = 0; m < 4; ++m) { gbp rowp = Y + ((size_t)u.pm * 256 + ai * 128 + wr * 64 + m * 16 + fr) * 1024 + u.pn * 256 + wc * 32 + 8 * fq;
#pragma unroll
                for (int bj = 0; bj < 2; ++bj) { const f32x4 v0 = acc[ai][bj][m][0], v1 = acc[ai][bj][m][1];
                    u32x4 w; w.x = pk2(v0[0], v0[1]); w.y = pk2(v0[2], v0[3]); w.z = pk2(v1[0], v1[1]); w.w = pk2(v1[2], v1[3]); *(GAS u32x4*)(rowp + bj * 128) = w; } }
    }
};
template <int NP> struct MoeOrder {
    const LAS int* tb; const LAS int* cn; const GAS int* list; int G, bid, vcu, U, chunk, per;
    __device__ __forceinline__ void init(const LAS int* tb_, const LAS int* cn_, const GAS int* list_, int G_, int bid_) {
        tb = tb_; cn = cn_; list = list_; G = G_; bid = bid_; U = tb_[NE] * NP;
        if (G_ % 8 == 0) { per = G_ / 8; vcu = (bid_ % 8) * per + bid_ / 8; chunk = (U + 7) / 8; } else { per = G_; vcu = bid_; chunk = U; }
    }
    __device__ __forceinline__ bool next(int i, Unit& u) const {
        const int x = vcu / per, j = i * per + (vcu % per); if (j >= chunk) return false;
        const int id = x * chunk + j; if (id >= U) return false;
        const int T = id / NP, pnl = id - T * NP; int e = 0;
#pragma unroll
        for (int q = 1; q < NE; ++q) e += (T >= tb[q]) ? 1 : 0;
        e = __builtin_amdgcn_readfirstlane(e);
        u.pm = T; u.pn = e * NP + pnl; return true;
    }
    __device__ __forceinline__ unsigned a_row(const Unit& u, int r) const {
        const int e = u.pn / NP; int idx = (u.pm - tb[e]) * 256 + r; const int c = cn[e]; idx = idx < c ? idx : c - 1;
        return (unsigned)list[(size_t)e * MTOT + idx];
    }
};
template <bool F8> struct EpiSwiglu {
    static constexpr bool PERM = true;
    volatile LAS unsigned* MISC; int l;
    __device__ __forceinline__ void operator()(const f32x4 (&acc)[2][2][4][2], const Unit& u, int wr, int wc, int fr, int fq) const {
        auto ACT = WSP(bf16, WS_ACT); auto b1 = INP(17) + (size_t)l * NE * 2048;
        const int e = u.pn >> 3, pnl = u.pn & 7; const int col = pnl * 128 + wc * 32 + 8 * fq;
        gcfp bg = b1 + (size_t)e * 2048 + col; gcfp bu = bg + 1024;
        const f32x4 bg0 = *(const GAS f32x4*)bg, bg1 = *(const GAS f32x4*)(bg + 4), bu0 = *(const GAS f32x4*)bu, bu1 = *(const GAS f32x4*)(bu + 4);
#pragma unroll
        for (int ai = 0; ai < 2; ++ai)
#pragma unroll
            for (int m = 0; m < 4; ++m) { const size_t row = (size_t)u.pm * 256 + ai * 128 + wr * 64 + m * 16 + fr;
                float a[8];
#pragma unroll
                for (int n = 0; n < 2; ++n)
#pragma unroll
                    for (int j = 0; j < 4; ++j) { constexpr float SC = F8 ? W8_INV : 1.0f; float gt = acc[ai][0][m][n][j] * SC + (n ? bg1[j] : bg0[j]), up = acc[ai][1][m][n][j] * SC + (n ? bu1[j] : bu0[j]);
                        gt = fminf(gt, 7.0f); up = fminf(fmaxf(up, -7.0f), 7.0f);
                        a[n * 4 + j] = (up + 1.0f) * (gt * sigmoidf_(1.702f * gt)); }
                if constexpr (F8) { u32x2 w; w.x = pk4f8(a[0], a[1], a[2], a[3]); w.y = pk4f8(a[4], a[5], a[6], a[7]); *(GAS u32x2*)((GAS unsigned char*)ACT + row * 1024 + col) = w; }
                else { u32x4 w; w.x = pk2(a[0], a[1]); w.y = pk2(a[2], a[3]); w.z = pk2(a[4], a[5]); w.w = pk2(a[6], a[7]);
                *(GAS u32x4*)(ACT + row * 1024 + col) = w; } }
    }
};
#if defined(EPIDUP_MOE1)
namespace pg8 { template <> struct epi_dup<::EpiSwiglu<true>> { static constexpr int v = 1; }; }
#endif
template <bool F8> struct EpiMoe2 {
    static constexpr bool PERM = true;
    volatile LAS unsigned* MISC; int l;
    __device__ __forceinline__ void operator()(const f32x4 (&acc)[2][2][4][2], const Unit& u, int wr, int wc, int fr, int fq) const {
        auto YS2 = WSP(bf16, WS_YS2); auto b2 = INP(19) + (size_t)l * NE * D;
        const int e = u.pn >> 2, pnl = u.pn & 3;
#pragma unroll
        for (int bj = 0; bj < 2; ++bj) { const int col = pnl * 256 + bj * 128 + wc * 32 + 8 * fq;
            const f32x4 c0 = *(const GAS f32x4*)(b2 + (size_t)e * 1024 + col), c1 = *(const GAS f32x4*)(b2 + (size_t)e * 1024 + col + 4);
#pragma unroll
            for (int ai = 0; ai < 2; ++ai)
#pragma unroll
                for (int m = 0; m < 4; ++m) { const size_t row = (size_t)u.pm * 256 + ai * 128 + wr * 64 + m * 16 + fr;
                    constexpr float SC = F8 ? W8_INV : 1.0f; const f32x4 v0 = acc[ai][bj][m][0] * SC + c0, v1 = acc[ai][bj][m][1] * SC + c1;
                    u32x4 w; w.x = pk2(v0[0], v0[1]); w.y = pk2(v0[2], v0[3]); w.z = pk2(v1[0], v1[1]); w.w = pk2(v1[2], v1[3]);
                    *(GAS u32x4*)(YS2 + row * 1024 + col) = w; } }
    }
};

#if defined(EPIDUP_MOE2)
namespace pg8 { template <> struct epi_dup<::EpiMoe2<true>> { static constexpr int v = 1; }; }
#endif

struct Args { const float* in[20]; float* out; unsigned char* ws; int ph_lo, ph_hi; };

#ifndef MOE_F8_FROM
#define MOE_F8_FROM 0
#endif
__device__ __forceinline__ int sgpr_launder(int x) { asm volatile("" : "+s"(x)); return x; }
#ifndef CVT_SH2
#define CVT_SH2 38
#define CVT_SH4 12
#endif
#ifndef CVT_SH1
#define CVT_SH1 26
#endif
#ifndef CVT_SH6
#define CVT_SH6 4
#endif
#ifndef CVT_SH5
#define CVT_SH5 4
#endif
struct CvtItem { gcfp W; gbp WT; int N, k0, n0, Kd, rowd, f8; };
__device__ __forceinline__ void cvt_load(const CvtItem& I, int lane, float (&v)[32]) {
    const GAS char* base = (const GAS char*)(I.W + (size_t)I.k0 * I.N + I.n0);
    unsigned off = (unsigned)((lane >> 5) * I.N + (lane & 31)) * 4u; const unsigned step = (unsigned)I.N * 8u;
#pragma unroll
    for (int i = 0; i < 32; ++i) { v[i] = __builtin_nontemporal_load((const GAS float*)(base + off)); off += step; }
}
__device__ __forceinline__ void cvt_store(const CvtItem& I, int lane, const float (&v)[32], LAS float* scr) {
#pragma unroll
    for (int i = 0; i < 32; ++i) { const int kk = 2 * i + (lane >> 5); scr[kk * 33 + (lane & 31)] = v[i]; }
    LDS_WAIT(); asm volatile("" ::: "memory");
    const int c = lane & 7;
#pragma unroll
    for (int j = 0; j < 4; ++j) { const int n = (lane >> 3) + 8 * j; const LAS float* s = scr + (8 * c) * 33 + n;
        if (I.f8 & 1) { u32x2 o; o.x = pk4f8(s[0 * 33] * W8_SCALE, s[1 * 33] * W8_SCALE, s[2 * 33] * W8_SCALE, s[3 * 33] * W8_SCALE); o.y = pk4f8(s[4 * 33] * W8_SCALE, s[5 * 33] * W8_SCALE, s[6 * 33] * W8_SCALE, s[7 * 33] * W8_SCALE);
            __builtin_nontemporal_store(o, (GAS u32x2*)((GAS char*)I.WT + (size_t)I.rowd * I.Kd + I.k0 + (unsigned)(n * I.Kd + 8 * c))); }
        else { u32x4 o; o.x = pk2(s[0 * 33], s[1 * 33]); o.y = pk2(s[2 * 33], s[3 * 33]); o.z = pk2(s[4 * 33], s[5 * 33]); o.w = pk2(s[6 * 33], s[7 * 33]);
        const int nd = (I.f8 & 2) ? 16 * ((n >> 2) & 1) + 4 * (n >> 3) + (n & 3) : n;
        __builtin_nontemporal_store(o, (GAS u32x4*)((GAS char*)(I.WT + (size_t)I.rowd * I.Kd + I.k0) + (unsigned)(nd * I.Kd + 8 * c) * 2u)); } }
    LDS_WAIT(); asm volatile("" ::: "memory");
}

__device__ __forceinline__ void ld_row(gcfp p, int lane, f32x4 (&v)[4]) {
#pragma unroll
    for (int j = 0; j < 4; ++j) v[j] = *(const GAS f32x4*)(p + 4 * lane + 256 * j);
}
__device__ __forceinline__ void ld_row_bf(gcbp p, int lane, f32x4 (&v)[4]) {
#pragma unroll
    for (int j = 0; j < 4; ++j) { const u32x2 w = *(const GAS u32x2*)(p + 4 * lane + 256 * j); v[j] = (f32x4){bflo(w.x), bfhi(w.x), bflo(w.y), bfhi(w.y)}; }
}
__device__ __forceinline__ float sumsq_row(const f32x4 (&v)[4]) {
    float s = 0.f;
#pragma unroll
    for (int j = 0; j < 4; ++j) s += (v[j][0] * v[j][0] + v[j][1] * v[j][1]) + (v[j][2] * v[j][2] + v[j][3] * v[j][3]);
    return wave_sum(s);
}
template <bool F8 = false> __device__ __forceinline__ void norm_mod_row(const f32x4 (&x)[4], gcfp g, gcfp sc, gcfp sh, int lane, f32x4 (&h)[4], gbp dst) {
    const float rn = 1.0f / sqrtf(sumsq_row(x) * (1.0f / D) + EPS);
#pragma unroll
    for (int j = 0; j < 4; ++j) { const int c = 4 * lane + 256 * j; const f32x4 gv = *(const GAS f32x4*)(g + c), sv = *(const GAS f32x4*)(sc + c), hv = *(const GAS f32x4*)(sh + c);
        h[j] = (x[j] * rn) * gv * (1.0f + sv) + hv;
        if constexpr (F8) { *(GAS unsigned*)((GAS unsigned char*)dst + c) = pk4f8(h[j][0], h[j][1], h[j][2], h[j][3]); }
        else { u32x2 w; w.x = pk2(h[j][0], h[j][1]); w.y = pk2(h[j][2], h[j][3]); *(GAS u32x2*)(dst + c) = w; } }
}

constexpr int CVT_I_IN = 16 * 192, CVT_I_WB = 3 * 8 * 32, CVT_I_WO = 16 * 32, CVT_I_W1 = NE * 16 * 64, CVT_I_W2 = NE * 16 * 32, CVT_I_L = CVT_I_IN + CVT_I_WB + CVT_I_WO + CVT_I_W1 + CVT_I_W2;
constexpr int CVT_P0_END = CVT_I_IN + CVT_I_WB + CVT_I_WO, CVT_END = DEPTH * CVT_I_L, CVT_REST = CVT_END - CVT_P0_END;
constexpr int CVT_T1_END = CVT_P0_END + (CVT_REST * CVT_SH1) / 100, CVT_T3_END = CVT_T1_END + (CVT_REST * CVT_SH2) / 100, CVT_T6_END = CVT_END - (CVT_REST * CVT_SH6) / 100, CVT_T4_END = CVT_T6_END - (CVT_REST * CVT_SH4) / 100, CVT_T5_END = CVT_T4_END - (CVT_REST * CVT_SH5) / 100;
static_assert(CVT_T3_END >= CVT_I_L, "layer 0's expert weights are converted before its expert GEMMs");
static_assert(CVT_T6_END >= CVT_END - CVT_I_W2, "only layer 1's w2 may wait for layer 1's first expert GEMM");
static_assert(CVT_T5_END >= CVT_I_L + CVT_I_IN + CVT_I_WB + CVT_I_WO && CVT_T5_END >= CVT_T3_END, "only layer 1's expert weights may wait for layer 1's in-projection");
__device__ __forceinline__ void cvt_range(volatile LAS unsigned* MISC, LAS unsigned char* ldsl, int first, int last, int gw, int NGW, int wave, int lane) {
    auto w_in = INP(7); auto w_branch = INP(12); auto w_out = INP(13); auto w1 = INP(16); auto w2 = INP(18);
    auto WIN = WSP(bf16, WS_WIN); auto WB = WSP(bf16, WS_WB); auto WO = WSP(bf16, WS_WO); auto W1 = WSP(bf16, WS_W1); auto W2 = WSP(bf16, WS_W2);
    LAS float* scr = (LAS float*)(ldsl + wave * 16384);
    constexpr int I_IN = CVT_I_IN, I_WB = CVT_I_WB, I_WO = CVT_I_WO, I_W1 = CVT_I_W1, I_W2 = CVT_I_W2, I_L = CVT_I_L;
#define CVT_DECODE(it_, I_) do { const int l_ = (it_) / I_L; int r_ = (it_) - l_ * I_L; \
            if (r_ < I_IN) { const int kb = r_ / 192, nbd = r_ % 192; I_ = CvtItem{w_in + (size_t)l_ * D * NIN, WIN + (size_t)l_ * NIN * D, NIN, 64 * kb, in_src_col(nbd), D, 32 * nbd, (nbd >= 72) ? 2 : 0}; break; } r_ -= I_IN; \
            if (r_ < I_WB) { const int i = r_ / 256, rr = r_ % 256, kb = rr / 32, nb = rr % 32; I_ = CvtItem{w_branch + (size_t)(l_ * 3 + i) * 512 * D, WB + (size_t)(l_ * 3 + i) * D * 512, D, 64 * kb, 32 * nb, 512, 32 * nb, 0}; break; } r_ -= I_WB; \
            if (r_ < I_WO) { const int kb = r_ / 32, nb = r_ % 32; I_ = CvtItem{w_out + (size_t)l_ * D * D, WO + (size_t)l_ * D * D, D, 64 * kb, 32 * nb, D, 32 * nb, 0}; break; } r_ -= I_WO; \
            if (r_ < I_W1) { const int e = r_ / 1024, rr = r_ % 1024, kb = rr / 64, nbd = rr % 64; const int pn = nbd >> 3, blk = nbd & 7, bj = blk >> 2, q = blk & 3; \
                const bool f8_ = (l_ >= MOE_F8_FROM);     \
                I_ = CvtItem{w1 + (size_t)(l_ * NE + e) * D * 2048, f8_ ? (gbp)((GAS char*)(W1 + (size_t)l_ * NE * 2048 * D) + (size_t)e * 2048 * D) : W1 + (size_t)(l_ * NE + e) * 2048 * D, 2048, 64 * kb, bj * 1024 + 128 * pn + 32 * q, D, 32 * nbd, f8_ ? 1 : 0}; break; } r_ -= I_W1; \
            { const int e = r_ / 512, rr = r_ % 512, kb = rr / 32, nb = rr % 32; const bool f8_ = (l_ >= MOE_F8_FROM); \
              I_ = CvtItem{w2 + (size_t)(l_ * NE + e) * D * D, f8_ ? (gbp)((GAS char*)(W2 + (size_t)l_ * NE * D * D) + (size_t)e * D * D) : W2 + (size_t)(l_ * NE + e) * D * D, D, 64 * kb, 32 * nb, D, 32 * nb, f8_ ? 1 : 0}; } } while (0)
        {
            int it = first + gw; CvtItem Iq[4]; float v[4][32];
#define CVT_PRE(k, itx) do { if ((itx) < last) { CVT_DECODE((itx), Iq[k]); cvt_load(Iq[k], lane, v[k]); } } while (0)
#define CVT_STG(k) { CVT_PRE(((k) + 3) & 3, it + 3 * NGW); cvt_store(Iq[k], lane, v[k], scr); it += NGW; if (it >= last) break; }
            CVT_PRE(0, it); CVT_PRE(1, it + NGW); CVT_PRE(2, it + 2 * NGW);
            if (it < last) for (;;) { CVT_STG(0) CVT_STG(1) CVT_STG(2) CVT_STG(3) }
#undef CVT_PRE
#undef CVT_STG
        }
#undef CVT_DECODE
}

#ifndef DISMASK
#define DISMASK 0
#endif
#define EN(k) (((DISMASK >> (k)) & 1) == 0)
#ifndef TOKPROBE
#define TOKPROBE 0
#endif
#ifndef DUPMASK
#ifndef INPROJ_STAGGER
#define INPROJ_STAGGER 2
#endif
#ifndef A128DUP
#define A128DUP 0
#endif
#define DUPMASK 0
#endif
#define REPS(k) ((((DUPMASK) >> (k)) & 1) ? 2 : 1)
__device__ __forceinline__ void ld_prod(gcfp a, gcfp b, int lane, f32x4 (&o)[4]) {
#pragma unroll
    for (int j = 0; j < 4; ++j) o[j] = *(const GAS f32x4*)(a + 4 * lane + 256 * j) * *(const GAS f32x4*)(b + 4 * lane + 256 * j);
}
__device__ __forceinline__ void ld_scale(gcfp g, gcfp sc, int lane, f32x4 (&A)[4]) {
#pragma unroll
    for (int j = 0; j < 4; ++j) A[j] = *(const GAS f32x4*)(g + 4 * lane + 256 * j) * (1.0f + *(const GAS f32x4*)(sc + 4 * lane + 256 * j));
}
template <bool F8 = false> __device__ __forceinline__ void norm_affine_row(const f32x4 (&x)[4], const f32x4 (&A)[4], int lane, f32x4 (&h)[4], gbp dst) {
    const float rn = __builtin_amdgcn_rsqf(sumsq_row(x) * (1.0f / D) + EPS);
#pragma unroll
    for (int j = 0; j < 4; ++j) { const int c = 4 * lane + 256 * j; h[j] = (x[j] * rn) * A[j] + h[j];
        if constexpr (F8) { *(GAS unsigned*)((GAS unsigned char*)dst + c) = pk4f8(h[j][0], h[j][1], h[j][2], h[j][3]); }
        else { u32x2 w; w.x = pk2(h[j][0], h[j][1]); w.y = pk2(h[j][2], h[j][3]); *(GAS u32x2*)(dst + c) = w; } }
}
__global__ void __launch_bounds__(NWAVES * 64, 2) mk_fwd(Args args) {
    extern __shared__ __attribute__((aligned(16))) unsigned char lds[];
    LAS unsigned char* ldsl = (LAS unsigned char*)lds;
    volatile LAS unsigned* MISC = (volatile LAS unsigned*)(ldsl + MISC_OFF);
    const int tid = threadIdx.x; const int wave0 = __builtin_amdgcn_readfirstlane(tid >> 6);
#define TIDNOW() (wave0 * 64 + lane_now())
    const int G = gridDim.x, bid = blockIdx.x;
    const int vcu = (G % 8 == 0) ? (bid % 8) * (G / 8) + bid / 8 : bid;
    const int G0 = G, bid0 = bid, vcu0 = vcu, wave00 = wave0;
#define IDS_NOW const int G = sgpr_launder(G0), bid = sgpr_launder(bid0), vcu = sgpr_launder(vcu0), wave0 = sgpr_launder(wave00); (void)G; (void)bid; (void)vcu; (void)wave0
    unsigned* ctl = (unsigned*)(GAS unsigned*)(args.ws + WS_CTL);
    for (int u = tid; u < (LDS_BYTES - MISC_OFF) / 4; u += NWAVES * 64) MISC[u] = 0u;
    __syncthreads();
    if (tid == 0) {
#pragma unroll
        for (int i = 0; i < 22; ++i) { const unsigned long long pv = i < 20 ? (unsigned long long)args.in[i] : (i == 20 ? (unsigned long long)args.out : (unsigned long long)args.ws);
            MISC[MW_PT + 2 * i] = (unsigned)pv; MISC[MW_PT + 2 * i + 1] = (unsigned)(pv >> 32); }
    }
    __syncthreads();
    XcdBarrier bar = xcd_barrier_post(ctl + CW_BAR, MISC + MW_BAR);
    const int lo = args.ph_lo, hi = args.ph_hi;
#define IN(k) (sgpr_launder(lo) <= (k) && (k) < sgpr_launder(hi))
#define SEAM(k) do { if (IN(k) && IN((k) + 1)) xcd_barrier(bar, TIDNOW()); } while (0)

    const int NGW = G * NWAVES;
#define PHASE_IDS const int lane = lane_now(), tid = wave0 * 64 + lane, wave = wave0, gw = vcu * NWAVES + wave; (void)gw; (void)lane

    for (int rep_ = 0; rep_ < REPS(0); ++rep_) { if (rep_) xcd_barrier(bar, TIDNOW());
    if (IN(0) && EN(0)) {
        IDS_NOW;
        PHASE_IDS;
        auto c_in = INP(1); auto cctx_in = INP(3); auto ada_w = INP(4); auto ada_b = INP(5);
        auto diff_lambda = INP(8);
        auto MOD = WSP(float, WS_MOD); auto ROPEC = WSP(float, WS_ROPEC); auto ROPES = WSP(float, WS_ROPES); auto LAMV = WSP(float, WS_LAM);
        if (bid < 2 * 96) {
            const int l = bid / 96, nb = bid % 96;
            LAS float* sl = (LAS float*)(ldsl + wave * 2560);
            LAS float* part = (LAS float*)(ldsl + 32768);
            { float cvv[10];
#pragma unroll
              for (int t = 0; t < 10; ++t) { const int idx = lane + 64 * t; const int r = idx >> 7, kk = idx & 127, k = wave * 128 + kk; cvv[t] = r < 4 ? c_in[r * D + k] : cctx_in[k]; }
#pragma unroll
              for (int t = 0; t < 10; ++t) sl[lane + 64 * t] = cvv[t] / (1.0f + __expf(-cvv[t])); }
            LDS_WAIT(); asm volatile("" ::: "memory");
            float a[5];
#pragma unroll
            for (int r = 0; r < 5; ++r) a[r] = 0.f;
            gcfp wp = ada_w + ((size_t)l * D + wave * 128) * NIN + nb * 64 + lane;
#pragma unroll 32
            for (int kk = 0; kk < 128; ++kk) { const float wv = wp[(size_t)kk * NIN];
#pragma unroll
                for (int r = 0; r < 5; ++r) a[r] += wv * sl[r * 128 + kk]; }
#pragma unroll
            for (int r = 0; r < 5; ++r) part[(wave * 5 + r) * 64 + lane] = a[r];
            __syncthreads();
            for (int idx = tid; idx < 320; idx += NWAVES * 64) { const int r = idx >> 6, cc = idx & 63; float s = ada_b[l * NIN + nb * 64 + cc];
#pragma unroll
                for (int w = 0; w < 8; ++w) s += part[(w * 5 + r) * 64 + cc];
                MOD[((size_t)l * 5 + r) * NIN + nb * 64 + cc] = s; }
            __syncthreads();
        }
        if (bid == G - 1) {
            for (int idx = tid; idx < 1024; idx += NWAVES * 64) { const int pos = idx >> 4, p = idx & 15; const float inv = powf(10000.0f, -(float)p / 16.0f); const float ang = (float)pos * inv;
                ROPEC[idx] = cosf(ang); ROPES[idx] = sinf(ang); }
            if (wave < 2) { gcfp lv = diff_lambda + wave * 256;
                const float s1 = wave_sum(lv[lane] * lv[64 + lane]), s2 = wave_sum(lv[128 + lane] * lv[192 + lane]);
                const float lam_init = 0.8f - 0.6f * expf(-0.3f * (float)wave);
                if (lane == 0) LAMV[wave] = expf(s1) - expf(s2) + lam_init; }
        }
        cvt_range(MISC, ldsl, 0, CVT_P0_END, gw, NGW, wave, lane);
    }
    }
    SEAM(0);
    if (IN(1) && EN(1)) {
        IDS_NOW;
        PHASE_IDS;
        auto x_in = INP(0); auto ctx_in = INP(2); auto norm_g = INP(6);
        auto MOD = WSP(float, WS_MOD); auto X = WSP(float, WS_X); auto H = WSP(bf16, WS_H);
        {
            auto PV = WSP(float, WS_PV);
            for (int idx = bid * (NWAVES * 64) + tid; idx < DEPTH * 5 * D; idx += G * NWAVES * 64) { const int l_ = idx / (5 * D), mr_ = (idx / D) % 5, d_ = idx % D;
                gcfp md_ = MOD + ((size_t)l_ * 5 + mr_) * NIN; gcfp ng_ = norm_g + (size_t)l_ * 4 * D; gfp pv_ = PV + ((size_t)l_ * 5 + mr_) * 4 * D;
                pv_[d_] = md_[2 * D + d_] * ng_[D + d_]; pv_[D + d_] = ng_[2 * D + d_] * (1.0f + md_[4 * D + d_]); pv_[2 * D + d_] = md_[5 * D + d_] * ng_[3 * D + d_]; pv_[3 * D + d_] = ng_[d_] * (1.0f + md_[D + d_]); }
        }
        {
            const int RPB = (MTOT + G - 1) / G, r0 = bid * RPB;
            int i = wave; bool have = (i < RPB && r0 + i < MTOT); f32x4 xn[4], A2[4]; int mrc = -1;
#define P1SRC(r_) ((r_) < MLAT ? x_in + (size_t)(r_) * D : ctx_in + (size_t)((r_) - MLAT) * D)
            if (have) ld_row(P1SRC(r0 + i), lane, xn);
            while (have) {
                const int r = r0 + i; f32x4 xv[4], hv[4];
#pragma unroll
                for (int j = 0; j < 4; ++j) xv[j] = xn[j];
                const int inx = i + NWAVES; const bool hn = (inx < RPB && r0 + inx < MTOT);
                if (hn) ld_row(P1SRC(r0 + inx), lane, xn);
                const int mr = r < MLAT ? (r >> 12) : 4;
                gcfp md = MOD + (size_t)mr * NIN; ld_row(md, lane, hv);
                if (mr != mrc) { ld_scale(norm_g, md + 1024, lane, A2); mrc = mr; }
                norm_affine_row(xv, A2, lane, hv, H + (size_t)r * D);
                i = inx; have = hn;
            }
#undef P1SRC
        }
    }
    SEAM(1);

    for (int l = 0; l < DEPTH; ++l) {
        const int pb = 2 + 8 * l; const bool lastl = (l == DEPTH - 1);
        const int ML = lastl ? MLAT : MTOT;
        unsigned* cntg = ctl + CW_CNT + l * 32 * 64;
        for (int rep_ = 0; rep_ < (l == 0 ? REPS(2) : 1); ++rep_) { if (rep_) xcd_barrier(bar, TIDNOW());
        if (IN(pb + 0) && EN(2)) {
            IDS_NOW;
            auto H = WSP(bf16, WS_H); auto WIN = WSP(bf16, WS_WIN);
            pg8::Gemm g{(const bf16*)H, (const bf16*)(WIN + (size_t)l * NIN * D), MTOT, NIN, D}; pg8::StaticOrder S; S.init(MTOT, NIN, G, bid);
            { const int tc = TIDNOW(); LAS float* tab = (LAS float*)(ldsl + TAB_OFF); auto rc = WSP(float, WS_ROPEC);
              *(LAS f32x4*)(tab + 4 * tc) = *(const GAS f32x4*)(rc + 4 * tc);
              if (tc < 32) *(LAS f32x4*)(tab + 2048 + 4 * tc) = *(const GAS f32x4*)(INP(10) + l * 128 + 4 * tc);
              __syncthreads(); }
            EpiInproj E{MISC, l};
            { const int c0s = (MTOT / 256) * (NIN / 256) - ((MTOT / 256) * (NIN / 256) / G) * G;
              if (c0s > 0 && bid >= c0s) { const int nsl = INPROJ_STAGGER * (1 + (bid - c0s) % 3); for (int i_ = 0; i_ < nsl; ++i_) __builtin_amdgcn_s_sleep(64); } }
            pg8::gemm_phase<EpiInproj, pg8::StaticOrder, false>(ldsl, g, S, E, wave0);
            { const int nfull = (MTOT / 256) * (NIN / 256) / G, c0 = (MTOT / 256) * (NIN / 256) - nfull * G;
              if (c0 > 0 && bid >= c0) { const int tc = TIDNOW(); const int wv = wave0;
                  cvt_range(MISC, ldsl, l == 0 ? CVT_P0_END : CVT_T4_END, l == 0 ? CVT_T1_END : CVT_T6_END, (bid - c0) * NWAVES + wv, (G - c0) * NWAVES, wv, tc & 63); } }
        }
        }
        SEAM(pb + 0);
        for (int rep_ = 0; rep_ < (l == 0 ? REPS(3) : 1); ++rep_) { if (rep_) xcd_barrier(bar, TIDNOW());
        if (IN(pb + 1) && EN(3)) {
            IDS_NOW;
            auto diff_subln = INP(9); auto sink = INP(11); auto LAMV = WSP(float, WS_LAM);
            auto QA = WSP(bf16, WS_QA); auto QB = WSP(bf16, WS_QB); auto QC = WSP(bf16, WS_QC);
            auto KA = WSP(bf16, WS_KA); auto VA = WSP(bf16, WS_VA); auto KB = WSP(bf16, WS_KB); auto VB = WSP(bf16, WS_VB); auto KC = WSP(bf16, WS_KC); auto VC = WSP(bf16, WS_VC);
            auto YS = WSP(bf16, WS_YS);
            const int NU = lastl ? 1536 : 1632;
            const float lam = LAMV[l]; const float post = 1.0f - (0.8f - 0.6f * expf(-0.3f * (float)l));
            {
                for (int rp_ = 0; rp_ < ((A128DUP && l == 0) ? 2 : 1); ++rp_)
                for (int pr = vcu; pr < 256; pr += G) {
                    const int b = pr >> 6, hh = (pr >> 4) & 3, q0 = b * SEQ + (pr & 15) * 256;
                    const size_t kv0 = (size_t)b * KVR * 512 + hh * 128;
                    for (int mp = 0; mp < 2; ++mp) {
                        __syncthreads();
                        att128::attn_unit<8>((const att64::bf16*)(const bf16*)(QA + (size_t)q0 * 512 + hh * 128 + mp * 64), 512, (const att64::bf16*)(const bf16*)(KA + kv0 + mp * 64), (const att64::bf16*)(const bf16*)(VA + kv0), 512, 68, mp,
                                             lam, diff_subln + l * 128, post, (att64::bf16*)(bf16*)(YS + (size_t)q0 * 512 + hh * 128), 512, (char*)lds, wave0);
                    }
                }
            }
            for (int i = 0;; ++i) {
                const int L = 512 + i * G + vcu; if (L >= NU) break;
                int type, b, hh, qb, qrow; bool isctx;
                if (L < 1536) { type = L / 512; const int idx = L % 512; b = idx >> 7; hh = (idx >> 5) & 3; qb = idx & 31; qrow = b * SEQ + qb * 128; isctx = false; }
                else { const int e = L - 1536; type = e / 32; const int idx = e % 32; b = idx >> 3; hh = (idx >> 1) & 3; qb = idx & 1; qrow = MLAT + b * CTXL + qb * 128; isctx = true; }
                if (type != 0) {
                    __syncthreads();
                    const int idx = isctx ? (L - 1536) % 32 : L % 512;
                    if (type == 1) {
                        const int b1 = isctx ? idx >> 3 : idx >> 7, head = isctx ? idx & 7 : (idx >> 4) & 7, q0 = isctx ? MLAT + b1 * CTXL : b1 * SEQ + (idx & 15) * 256;
                        const size_t kv0 = ((size_t)b1 * KVR + (isctx ? SEQ : 0)) * 128 + (head >> 2) * 64; const int nt = isctx ? 4 : 68;
                        att64::attn_unit<8, false, false>((const att64::bf16*)(const bf16*)(QB + (size_t)q0 * 512 + head * 64), 512, (const att64::bf16*)(const bf16*)(KB + kv0), (const att64::bf16*)(const bf16*)(VB + kv0), 128, nt, nt, 0, 0, 0, 0, 0.f, 0.f,
                                                         (att64::bf16*)(bf16*)(YS + (size_t)MTOT * 512 + (size_t)q0 * 512 + head * 64), 512, (char*)lds, wave0);
                    } else {
                        const int b1 = isctx ? idx >> 3 : idx >> 7, hp = isctx ? (idx >> 1) & 3 : (idx >> 5) & 3, qbl = isctx ? idx & 1 : idx & 31;
                        const int head = 2 * hp, q0 = isctx ? MLAT + b1 * CTXL + qbl * 128 : b1 * SEQ + qbl * 128;
                        const size_t kv0 = ((size_t)b1 * KVR + SEQ) * 128 + (head >> 2) * 64; const float sl2a = sink[l * 8 + head] * 1.4426950408889634f, sl2b = sink[l * 8 + head + 1] * 1.4426950408889634f;
                        const att64::bf16* qp_ = (const att64::bf16*)(const bf16*)(QC + (size_t)q0 * 512 + head * 64); att64::bf16* op_ = (att64::bf16*)(bf16*)(YS + (size_t)2 * MTOT * 512 + (size_t)q0 * 512 + head * 64);
                        if (isctx) att64::attn_unit<8, false, true>(qp_, 512, (const att64::bf16*)(const bf16*)(KC + kv0), (const att64::bf16*)(const bf16*)(VC + kv0), 128, 4, 4, 0, 0, 0, 1, sl2a, sl2b, op_, 512, (char*)lds, wave0);
                        else { const int qpos = qbl * 128; const int klo = qpos - 128 < 0 ? 0 : qpos - 128, khi = qpos + 256 > SEQ ? SEQ : qpos + 256; const int n2 = (khi - klo) / 64;
                            att64::attn_unit<8, true, true>(qp_, 512, (const att64::bf16*)(const bf16*)(KC + kv0), (const att64::bf16*)(const bf16*)(VC + kv0), 128, 4 + n2, 4, klo - SEQ, klo, qpos, 1, sl2a, sl2b, op_, 512, (char*)lds, wave0); }
                    }
                    continue;
                }
                att::UnitArgs A;
                A.s1 = isctx ? SEQ : 0; A.n1 = isctx ? 4 : 68; A.s2 = 0; A.n2 = 0; A.qpos0 = -1; A.use_sink = 0; A.sink0 = 0.f; A.sink1 = 0.f; A.lam = lam; A.post = post; A.subg = diff_subln + l * 128;
                {
                    A.Q = QA + (size_t)qrow * 512 + hh * 128; A.qg1 = 64; A.K = KA + (size_t)b * KVR * 512 + hh * 128; A.V = VA + (size_t)b * KVR * 512 + hh * 128; A.ldk = 512;
                    A.O = YS + (size_t)qrow * 512 + hh * 128; A.og1 = 0;
                    att::attn_unit<true, false>(A, (char*)lds, wave0);
                }
            }
        }
        }
        SEAM(pb + 1);
        for (int rep_ = 0; rep_ < (l == 0 ? REPS(4) : 1); ++rep_) { if (rep_) xcd_barrier(bar, TIDNOW());
        if (IN(pb + 2) && EN(4)) {
            IDS_NOW;
            auto YS = WSP(bf16, WS_YS); auto WB = WSP(bf16, WS_WB);
            pg8::Gemm g{(const bf16*)YS, (const bf16*)(WB + (size_t)l * 3 * D * 512), 3 * MTOT, 3 * D, 512}; MergeOrder S{(ML / 256) * 4, G, vcu};
            EpiMerge E{MISC};
            pg8::gemm_phase<EpiMerge, MergeOrder, false>(ldsl, g, S, E, wave0);
            { const int c0 = (ML / 256) * 4 - G;
              if (l == 0 && c0 > 0 && c0 < G && vcu >= c0) { const int tc = TIDNOW(); const int wv = wave0;
                  cvt_range(MISC, ldsl, CVT_T1_END, CVT_T3_END, (vcu - c0) * NWAVES + wv, (G - c0) * NWAVES, wv, tc & 63); } }
        }
        }
        SEAM(pb + 2);
        for (int rep_ = 0; rep_ < (l == 0 ? REPS(5) : 1); ++rep_) { if (rep_) xcd_barrier(bar, TIDNOW());
        if (IN(pb + 3) && EN(5)) {
            IDS_NOW;
            auto MG = WSP(bf16, WS_MG); auto WO = WSP(bf16, WS_WO);
            pg8::Gemm g{(const bf16*)MG, (const bf16*)(WO + (size_t)l * D * D), ML, D, D}; pg8::StaticOrder S; S.init(ML, D, G, bid);
            EpiOut E{MISC};
            pg8::gemm_phase<EpiOut, pg8::StaticOrder, false>(ldsl, g, S, E, wave0);
            { const int c0 = (ML / 256) * 4 - G;
              if (l == 0 && c0 > 0 && c0 < G && bid >= c0) { const int tc = TIDNOW(); const int wv = wave0;
                  cvt_range(MISC, ldsl, CVT_T3_END, CVT_T5_END, (bid - c0) * NWAVES + wv, (G - c0) * NWAVES, wv, tc & 63); } }
        }
        }
        SEAM(pb + 3);
        if (IN(pb + 4) && EN(6)) {
            IDS_NOW;
            PHASE_IDS;
            auto norm_g = INP(6); auto router_w = INP(14); auto router_b = INP(15);
            gcfp ng = norm_g + (size_t)l * 4 * D; auto modl = WSP(float, WS_MOD) + (size_t)l * 5 * NIN;
            auto Y = WSP(bf16, WS_Y); auto X = WSP(float, WS_X); auto H2 = WSP(bf16, WS_H2); auto x_in0 = INP(0); auto ctx_in0 = INP(2);
            auto SE = WSP(int, WS_SE); auto SR = WSP(int, WS_SR); auto SW = WSP(float, WS_SW); auto LIST = WSP(int, WS_LIST);
            LAS f32x4* rwL = (LAS f32x4*)ldsl;
            gcfp rw = router_w + (size_t)l * D * NE;
            {
                f32x4 tw[16];
#pragma unroll
                for (int k = 0; k < 16; ++k) { const int idx = tid + k * (NWAVES * 64); const int d = idx >> 3, q = idx & 7; tw[k] = *(const GAS f32x4*)(rw + (size_t)d * NE + q * 4); }
#pragma unroll
                for (int k = 0; k < 16; ++k) { const int idx = tid + k * (NWAVES * 64); const int d = idx >> 3, q = idx & 7; const int rowp = (d & 3) * 256 + (d >> 2);
                    rwL[rowp * 8 + (q ^ ((rowp >> 1) & 7))] = tw[k]; }
            }
            volatile LAS unsigned* hist = MISC + MW_HIST; volatile LAS unsigned* gbase = MISC + MW_BASE; volatile LAS unsigned* slotw = MISC + MW_SLOT + wave * (9 * 4 * 3);
            if (tid < NE) hist[tid] = 0u;
            __syncthreads();
            const int RPB = (ML + G - 1) / G; const int r0 = bid * RPB;
            int nti = 0;
#if TOKPROBE & 1
            for (int rep1 = (l == 0) ? 0 : 1; rep1 < 2; ++rep1) { const bool dry1 = rep1 == 0; gfp Xo = dry1 ? (gfp)WSP(float, WS_TMP) : (gfp)X; gbp H2o = dry1 ? (gbp)WSP(bf16, WS_ACT) : (gbp)H2; nti = 0;
#else
            { gfp Xo = (gfp)X; gbp H2o = (gbp)H2; constexpr bool dry1 = false;
#endif
            {
            int i = wave; bool have = (i < RPB && r0 + i < ML);
            u32x2 yn[4]; auto PVl = WSP(float, WS_PV) + (size_t)l * 5 * 4 * D;
#define YLD(r_) do { _Pragma("unroll") for (int j = 0; j < 4; ++j) yn[j] = *(const GAS u32x2*)(Y + (size_t)(r_) * D + 4 * lane + 256 * j); } while (0)
#define XSRC(r_) (l == 0 ? ((r_) < MLAT ? x_in0 + (size_t)(r_) * D : ctx_in0 + (size_t)((r_) - MLAT) * D) : (gcfp)(X + (size_t)(r_) * D))
            if (have) { YLD(r0 + i); }
            while (have) {
                const int r = r0 + i; const int mr = r < MLAT ? (r >> 12) : 4;
                gcfp md = modl + (size_t)mr * NIN; gcfp pv = PVl + (size_t)mr * 4 * D; f32x4 yv[4], xv[4], hv[4], A1[4], A2[4];
                ld_row(XSRC(r), lane, xv); ld_row(pv, lane, A1); ld_row(pv + D, lane, A2); ld_row(md + 3 * D, lane, hv);

#pragma unroll
                for (int j = 0; j < 4; ++j) yv[j] = (f32x4){bflo(yn[j].x), bfhi(yn[j].x), bflo(yn[j].y), bfhi(yn[j].y)};
                const int inx = i + NWAVES; const bool hn = (inx < RPB && r0 + inx < ML);
                if (hn) { YLD(r0 + inx); }
                const float rny = __builtin_amdgcn_rsqf(sumsq_row(yv) * (1.0f / D) + EPS);
#pragma unroll
                for (int j = 0; j < 4; ++j) { const int c = 4 * lane + 256 * j; xv[j] = xv[j] + A1[j] * (yv[j] * rny); *(GAS f32x4*)(Xo + (size_t)r * D + c) = xv[j]; }
                if (l >= MOE_F8_FROM) norm_affine_row<true>(xv, A2, lane, hv, (gbp)((GAS unsigned char*)H2o + (size_t)r * D));
                else norm_affine_row<false>(xv, A2, lane, hv, H2o + (size_t)r * D);
                float a[32];
#pragma unroll
                for (int q = 0; q < 32; ++q) a[q] = 0.f;
                const int sw = (lane >> 1) & 7;
                {
                    f32x4 wA[8], wB[8];
#define RW_LD(W, blk) do { const int rowp_ = ((blk) & 3) * 256 + 64 * ((blk) >> 2) + lane; _Pragma("unroll") for (int q = 0; q < 8; ++q) W[q] = rwL[rowp_ * 8 + (q ^ sw)]; } while (0)
#define RW_FMA(W, blk) do { const float hval_ = hv[(blk) >> 2][(blk) & 3]; _Pragma("unroll") for (int q = 0; q < 8; ++q) { a[4 * q + 0] += hval_ * W[q][0]; a[4 * q + 1] += hval_ * W[q][1]; a[4 * q + 2] += hval_ * W[q][2]; a[4 * q + 3] += hval_ * W[q][3]; } } while (0)
                    RW_LD(wA, 0);
#pragma unroll
                    for (int blk = 0; blk < 16; blk += 2) { RW_LD(wB, blk + 1); RW_FMA(wA, blk); __builtin_amdgcn_sched_barrier(0); if (blk + 2 < 16) RW_LD(wA, blk + 2); RW_FMA(wB, blk + 1); __builtin_amdgcn_sched_barrier(0); }
#undef RW_LD
#undef RW_FMA
                }
#define RS(N, MASK) do { const bool up = (lane & (MASK)) != 0; _Pragma("unroll") for (int q = 0; q < (N) / 2; ++q) { const float keep = up ? a[(N) / 2 + q] : a[q]; const float send = up ? a[q] : a[(N) / 2 + q]; a[q] = keep + __shfl_xor(send, (MASK)); } } while (0)
                RS(32, 32); RS(16, 16); RS(8, 8); RS(4, 4); RS(2, 2);
#undef RS
                const int myE = (lane >> 1) & 31;
                float val = a[0] + dppf<0xB1>(a[0]) + router_b[l * NE + myE];
                float tv[4]; int te[4];
#define BETTER(ov, oe, bv, be) ((ov) > (bv) || ((ov) == (bv) && (oe) < (be)))
#define TSTEP(CTRL) do { const float ov = dppf<CTRL>(bv); const int oe = dppi<CTRL>(be); if (BETTER(ov, oe, bv, be)) { bv = ov; be = oe; } } while (0)
#pragma unroll
                for (int k = 0; k < 4; ++k) { float bv = val; int be = myE;
                    TSTEP(0x4E); TSTEP(0x141); TSTEP(0x140);
                    float v0 = rdl(bv, 0), v1 = rdl(bv, 16), v2 = rdl(bv, 32), v3 = rdl(bv, 48);
                    int e0 = __builtin_amdgcn_readlane(be, 0), e1 = __builtin_amdgcn_readlane(be, 16), e2 = __builtin_amdgcn_readlane(be, 32), e3 = __builtin_amdgcn_readlane(be, 48);
                    if (BETTER(v1, e1, v0, e0)) { v0 = v1; e0 = e1; } if (BETTER(v3, e3, v2, e2)) { v2 = v3; e2 = e3; } if (BETTER(v2, e2, v0, e0)) { v0 = v2; e0 = e2; }
                    tv[k] = v0; te[k] = e0; if (myE == e0) val = -INFINITY; }
#undef TSTEP
#undef BETTER
                const float e1 = __expf(tv[1] - tv[0]), e2 = __expf(tv[2] - tv[0]), e3 = __expf(tv[3] - tv[0]); const float inv = 1.0f / (1.0f + e1 + e2 + e3);
                if (lane < 4) { const int ek = lane == 0 ? te[0] : lane == 1 ? te[1] : lane == 2 ? te[2] : te[3]; const float wk = (lane == 0 ? 1.0f : lane == 1 ? e1 : lane == 2 ? e2 : e3) * inv;
                    const unsigned lr = __hip_atomic_fetch_add((LAS unsigned*)((dry1 ? gbase : hist) + ek), 1u, __ATOMIC_RELAXED, __HIP_MEMORY_SCOPE_WORKGROUP);
                    slotw[(nti * 4 + lane) * 3 + 0] = (unsigned)ek; slotw[(nti * 4 + lane) * 3 + 1] = lr; slotw[(nti * 4 + lane) * 3 + 2] = __builtin_bit_cast(unsigned, wk); }
                i = inx; have = hn; ++nti;
            }
            }
            }
            __syncthreads();
            if (tid < NE) { const unsigned hcount = hist[tid]; gbase[tid] = hcount ? __hip_atomic_fetch_add(cntg + tid * 64, hcount, __ATOMIC_RELAXED, __HIP_MEMORY_SCOPE_AGENT) : 0u; }
            __syncthreads();
            nti = 0;
            for (int i = wave; i < RPB && r0 + i < ML; i += NWAVES, ++nti) {
                const int r = r0 + i;
                if (lane < 4) { const unsigned ek = slotw[(nti * 4 + lane) * 3 + 0], lr = slotw[(nti * 4 + lane) * 3 + 1], wkb = slotw[(nti * 4 + lane) * 3 + 2];
                    const unsigned rank = gbase[ek] + lr;
                    LIST[(size_t)ek * MTOT + rank] = r; SE[r * 4 + lane] = (int)ek; SR[r * 4 + lane] = (int)rank; SW[r * 4 + lane] = __builtin_bit_cast(float, wkb); }
            }
            __syncthreads();
        }
        SEAM(pb + 4);
        LAS int* tb = (LAS int*)(ldsl + MISC_OFF) + MW_TB; LAS int* cn = (LAS int*)(ldsl + MISC_OFF) + MW_CNT;
        if (IN(pb + 5) || IN(pb + 6) || IN(pb + 7)) {
            IDS_NOW;
            __syncthreads();
            const int tid = TIDNOW();
            if (tid < NE) cn[tid] = (int)__hip_atomic_load(cntg + tid * 64, __ATOMIC_RELAXED, __HIP_MEMORY_SCOPE_AGENT);
            __syncthreads();
            if (tid == 0) { int accu = 0; for (int e = 0; e < NE; ++e) { tb[e] = accu; accu += (cn[e] + 255) >> 8; } tb[NE] = accu; }
            __syncthreads();
        }
        for (int rep_ = 0; rep_ < (l == 0 ? REPS(7) : 1); ++rep_) { if (rep_) xcd_barrier(bar, TIDNOW());
        if (IN(pb + 5) && EN(7)) {
            IDS_NOW;
            auto H2 = WSP(bf16, WS_H2); auto W1 = WSP(bf16, WS_W1); auto LIST = WSP(int, WS_LIST);
            MoeOrder<8> S; S.init(tb, cn, LIST, G, bid);
            if (l >= MOE_F8_FROM) { pg8::Gemm g{(const bf16*)H2, (const bf16*)(W1 + (size_t)l * NE * 2048 * D), MTOT, NE * 2048, D / 2}; EpiSwiglu<true> E{MISC, l};
                pg8::gemm_phase<EpiSwiglu<true>, MoeOrder<8>, true, true>(ldsl, g, S, E, wave0); }
            else { pg8::Gemm g{(const bf16*)H2, (const bf16*)(W1 + (size_t)l * NE * 2048 * D), MTOT, NE * 2048, D}; EpiSwiglu<false> E{MISC, l};
                pg8::gemm_phase<EpiSwiglu<false>, MoeOrder<8>, true, false>(ldsl, g, S, E, wave0); }
            if (l == 0 ? CVT_SH5 > 0 : CVT_SH6 > 0) { const int cf = l == 0 ? CVT_T5_END : CVT_T6_END, cl = l == 0 ? CVT_T4_END : CVT_END;
                const int nfull = S.chunk / S.per, rem = S.chunk - nfull * S.per, lc = S.vcu % S.per, xg = S.vcu / S.per, nidle = S.per - rem, ngrp = S.vcu == S.bid && S.per == G ? 1 : 8;
                const int tc = TIDNOW(); const int wv = wave0;
                if (rem == 0) cvt_range(MISC, ldsl, cf, cl, S.vcu * NWAVES + wv, G * NWAVES, wv, tc & 63);
                else if (lc >= rem) cvt_range(MISC, ldsl, cf, cl, (xg * nidle + (lc - rem)) * NWAVES + wv, ngrp * nidle * NWAVES, wv, tc & 63);
            }
        }
        }
        SEAM(pb + 5);
        for (int rep_ = 0; rep_ < (l == 0 ? REPS(8) : 1); ++rep_) { if (rep_) xcd_barrier(bar, TIDNOW());
        if (IN(pb + 6) && EN(8)) {
            IDS_NOW;
            auto ACT = WSP(bf16, WS_ACT); auto W2 = WSP(bf16, WS_W2); auto LIST = WSP(int, WS_LIST);
            MoeOrder<4> S; S.init(tb, cn, LIST, G, bid);
            if (l >= MOE_F8_FROM) { pg8::Gemm g{(const bf16*)ACT, (const bf16*)(W2 + (size_t)l * NE * D * D), MAXTILES * 256, NE * D, D / 2}; EpiMoe2<true> E{MISC, l};
                pg8::gemm_phase<EpiMoe2<true>, MoeOrder<4>, false, true>(ldsl, g, S, E, wave0); }
            else { pg8::Gemm g{(const bf16*)ACT, (const bf16*)(W2 + (size_t)l * NE * D * D), MAXTILES * 256, NE * D, D}; EpiMoe2<false> E{MISC, l};
                pg8::gemm_phase<EpiMoe2<false>, MoeOrder<4>, false, false>(ldsl, g, S, E, wave0); }
        }
        }
        SEAM(pb + 6);
        if (IN(pb + 7) && EN(9)) {
            IDS_NOW;
            PHASE_IDS;
            auto norm_g = INP(6); gcfp ng = norm_g + (size_t)l * 4 * D; auto MOD = WSP(float, WS_MOD); gcfp modl = MOD + (size_t)l * 5 * NIN;
            auto X = WSP(float, WS_X); auto H = WSP(bf16, WS_H); auto YS2 = WSP(bf16, WS_YS2); gfp outp = (gfp)ldp(MISC, 20);
            auto SE = WSP(int, WS_SE); auto SR = WSP(int, WS_SR); auto SW = WSP(float, WS_SW);
            for (int rep2 = ((TOKPROBE & 2) && l == 0) ? 0 : 1; rep2 < 2; ++rep2) { const bool dry2 = rep2 == 0; gfp Xo = dry2 ? (gfp)WSP(float, WS_TMP) : (gfp)X; gbp Ho = dry2 ? (gbp)WSP(bf16, WS_MG) : (gbp)H;
            for (int rb = gw; rb < ML; rb += 16 * NGW) {
                const int myr = rb + (lane >> 2) * NGW; const bool vld = myr < ML;
                const int se = vld ? SE[myr * 4 + (lane & 3)] : 0, sr = vld ? SR[myr * 4 + (lane & 3)] : 0; const float swt = vld ? SW[myr * 4 + (lane & 3)] : 0.f;
                const int yrow = tb[se] * 256 + sr;
                u32x2 yn[4][4]; f32x4 xn[4];
#define T2_LOAD(ri_) do { const int r_ = rb + (ri_) * NGW; _Pragma("unroll") for (int k = 0; k < 4; ++k) { const int yr_ = __builtin_amdgcn_readlane(yrow, (ri_) * 4 + k); gcbp yp = YS2 + (size_t)yr_ * D; \
                    _Pragma("unroll") for (int j = 0; j < 4; ++j) yn[k][j] = *(const GAS u32x2*)(yp + 4 * lane + 256 * j); } ld_row(X + (size_t)r_ * D, lane, xn); } while (0)
                int ri = 0;
                if (rb < ML) T2_LOAD(0);
                while (ri < 16 && rb + ri * NGW < ML) {
                    const int r = rb + ri * NGW; const int mr = r < MLAT ? (r >> 12) : 4; gcfp md = modl + (size_t)mr * NIN;
                    f32x4 yv[4], xv[4];
#pragma unroll
                    for (int j = 0; j < 4; ++j) { yv[j] = (f32x4){0.f, 0.f, 0.f, 0.f}; xv[j] = xn[j]; }
#pragma unroll
                    for (int k = 0; k < 4; ++k) { const float wk = rdl(swt, ri * 4 + k);
#pragma unroll
                        for (int j = 0; j < 4; ++j) { const u32x2 w = yn[k][j]; yv[j][0] += wk * bflo(w.x); yv[j][1] += wk * bfhi(w.x); yv[j][2] += wk * bflo(w.y); yv[j][3] += wk * bfhi(w.y); } }
                    if (ri + 1 < 16 && rb + (ri + 1) * NGW < ML) T2_LOAD(ri + 1);
                    const float rny = 1.0f / sqrtf(sumsq_row(yv) * (1.0f / D) + EPS);
#pragma unroll
                    for (int j = 0; j < 4; ++j) { const int c = 4 * lane + 256 * j; const f32x4 g3 = *(const GAS f32x4*)(ng + 3 * D + c), gf = *(const GAS f32x4*)(md + 5 * D + c);
                        xv[j] = xv[j] + gf * ((yv[j] * rny) * g3);
                        if (lastl) *(GAS f32x4*)(outp + (size_t)r * D + c) = xv[j]; else *(GAS f32x4*)(Xo + (size_t)r * D + c) = xv[j]; }
                    if (!lastl) { f32x4 hv[4]; gcfp mdn = MOD + ((size_t)(l + 1) * 5 + mr) * NIN;
                        norm_mod_row(xv, norm_g + (size_t)(l + 1) * 4 * D, mdn + 1024, mdn, lane, hv, Ho + (size_t)r * D); }
                    ++ri;
                }
#undef T2_LOAD
            }
            if (dry2) { asm volatile("s_waitcnt vmcnt(0)" ::: "memory"); __syncthreads(); } }
        }
        if (!lastl) SEAM(pb + 7);
    }
#undef IN
#undef SEAM
}

constexpr int N_PHASES = 2 + 8 * DEPTH;
#ifndef MK_CUTS
#define MK_CUTS 0
#endif
extern "C" void kernel_launch(void* const* d_in, const int* in_sizes, int n_in, void* d_out, int out_size, void* d_ws, size_t ws_size, hipStream_t stream) {
    static int grid = 0;
    if (grid == 0) {
        if (n_in != 20 || out_size != MLAT * D || ws_size < WS_END) { fprintf(stderr, "kernel_launch: unexpected shapes (n_in %d out %d ws %zu need %zu)\n", n_in, out_size, ws_size, (size_t)WS_END); grid = -1; return; }
        int dev = 0, cus = 0, per_cu = 0;
        if (hipGetDevice(&dev) != hipSuccess || hipDeviceGetAttribute(&cus, hipDeviceAttributeMultiprocessorCount, dev) != hipSuccess) { grid = -1; return; }
        if (hipFuncSetAttribute((const void*)mk_fwd, hipFuncAttributeMaxDynamicSharedMemorySize, LDS_BYTES) != hipSuccess) { fprintf(stderr, "kernel_launch: hipFuncSetAttribute failed\n"); grid = -1; return; }
        if (hipOccupancyMaxActiveBlocksPerMultiprocessor(&per_cu, (const void*)mk_fwd, NWAVES * 64, LDS_BYTES) != hipSuccess || per_cu < 1) { fprintf(stderr, "kernel_launch: occupancy query reports %d\n", per_cu); }
        (void)hipGetLastError();
        grid = cus;
    }
    if (grid < 0) return;
    if (hipMemsetAsync((char*)d_ws + WS_CTL, 0, CTL_BYTES, stream) != hipSuccess) return;
    Args a{};
    for (int i = 0; i < 20; ++i) a.in[i] = (const float*)d_in[i];
    a.out = (float*)d_out; a.ws = (unsigned char*)d_ws;
#if MK_CUTS
    for (int p = 0; p < N_PHASES; ++p) { a.ph_lo = p; a.ph_hi = p + 1; hipLaunchKernelGGL(mk_fwd, dim3(grid), dim3(NWAVES * 64), LDS_BYTES, stream, a); }
#else
    a.ph_lo = 0; a.ph_hi = N_PHASES;
    hipLaunchKernelGGL(mk_fwd, dim3(grid), dim3(NWAVES * 64), LDS_BYTES, stream, a);
#endif
    const hipError_t le = hipPeekAtLastError();
    if (le != hipSuccess) fprintf(stderr, "kernel_launch: launch failed: %s\n", hipGetErrorName(le));
}
```

```cpp
#include <hip/hip_runtime.h>
#include <cstdio>
#include <cstdint>

#define LAS __attribute__((address_space(3)))
#define GAS __attribute__((address_space(1)))

__device__ __forceinline__ int lane_now() { int l = (int)__builtin_amdgcn_mbcnt_hi(~0u, __builtin_amdgcn_mbcnt_lo(~0u, 0u)); asm volatile("" : "+v"(l)); return l; }

namespace pg8 {
#define PG8_LAS __attribute__((address_space(3)))
typedef unsigned short bf16_t;
typedef short bf16x8 __attribute__((ext_vector_type(8)));
typedef float f32x4 __attribute__((ext_vector_type(4)));
typedef float f32x2 __attribute__((ext_vector_type(2)));
typedef unsigned u32x4 __attribute__((ext_vector_type(4)));
typedef unsigned u32x2 __attribute__((ext_vector_type(2)));
constexpr int BM = 256, BK = 64, HALF = 128, HTB = HALF * BK * 2  , STAGE_BYTES = 8 * HTB, NXCD = 8, WGM = 8;

__host__ __device__ __forceinline__ int lds_byte(int r, int c) { const int st = (r >> 4) * 2 + (c >> 5), rr = r & 15, cc = c & 31, ob = rr * 64 + cc * 2; return st * 1024 + (ob ^ (((ob >> 9) & 1) << 5)); }
__host__ __device__ __forceinline__ void stage_rc(int b, int& R, int& C) { const int st = b / 1024, sb = b % 1024, swz = sb ^ (((sb >> 9) & 1) << 5); R = (st >> 1) * 16 + swz / 64; C = (st & 1) * 32 + (swz % 64) / 2; }
__host__ __device__ __forceinline__ int perm32(int rho) { const int n = rho >> 4, i = rho & 15; return 8 * (i >> 2) + 4 * n + (i & 3); }

struct Unit { int pm, pn; };
struct Gemm { const bf16_t* A; const bf16_t* Bt; int M, N, K; };

struct StaticOrder {
    int nM, nN, nwg, G, c;
    __host__ __device__ void init(int M, int N, int G_, int c_) { nM = M / BM; nN = N / BM; nwg = nM * nN; G = G_; c = c_; }
    __host__ __device__ bool next(int i, Unit& u) const {
        const long L = (long)i * G + c; if (L >= nwg) return false;
        int wgid = (int)L; { const int q = nwg / NXCD, r = nwg % NXCD, xcd = wgid % NXCD, off = wgid / NXCD; wgid = (xcd < r ? xcd * (q + 1) : r * (q + 1) + (xcd - r) * q) + off; }
        const int nig = WGM * nN, gid = wgid / nig, fm = gid * WGM, gsz = (nM - fm) < WGM ? (nM - fm) : WGM;
        u.pm = fm + ((wgid % nig) % gsz); u.pn = (wgid % nig) / gsz; return true;
    }
    __device__ __forceinline__ unsigned a_row(const Unit&, int) const { return 0u; }
};

__device__ __forceinline__ unsigned cvt_pk_bf16(float lo, float hi) { unsigned r; asm volatile("v_cvt_pk_bf16_f32 %0, %1, %2" : "=v"(r) : "v"(lo), "v"(hi)); return r; }

typedef int v8i32 __attribute__((ext_vector_type(8)));
typedef int v4i32 __attribute__((ext_vector_type(4)));
__device__ __forceinline__ v8i32 cat8(bf16x8 lo, bf16x8 hi) { const v4i32 a = __builtin_bit_cast(v4i32, lo), b = __builtin_bit_cast(v4i32, hi); return (v8i32){a[0], a[1], a[2], a[3], b[0], b[1], b[2], b[3]}; }
__device__ __forceinline__ void mfma_f8(f32x4& acc, v8i32 a, v8i32 b, int sc) {
    asm volatile("v_mfma_scale_f32_16x16x128_f8f6f4 %0, %1, %2, %0, %3, %3 op_sel_hi:[0,0,0]" : "+v"(acc) : "v"(a), "v"(b), "v"(sc)); }
template <class E> struct epi_chain { static constexpr bool v = false; };
template <class E> struct epi_dup { static constexpr int v = 0; };
template <class Epi, class Sched, bool GATHER, bool FP8 = false>
__device__ __forceinline__ void gemm_phase(PG8_LAS unsigned char* lds, const Gemm g, const Sched& S, const Epi& E, const int wave0) {
    const int lane = lane_now(), tid = wave0 * 64 + lane, wid = wave0, wr = wid >> 2, wc = wid & 3, fr = lane & 15, fq = lane >> 4;
    const int K = g.K, nt = K / BK;
    unsigned voffA[2], voffB[2]; int RA[2], CA[2];
#pragma unroll
    for (int i = 0; i < 2; ++i) { int R, C; stage_rc(tid * 16 + i * 8192, R, C); const int Rb = Epi::PERM ? ((R & ~31) + perm32(R & 31)) : R;
        RA[i] = R; CA[i] = C; voffA[i] = (unsigned)(R * K + C) * 2u; voffB[i] = (unsigned)(Rb * K + C) * 2u; }
    const size_t kstep = (size_t)(BK * 2);
    const size_t hstep = (size_t)HALF * K * 2;
    const size_t tstep = 2 * hstep;
    const unsigned ldsw = (unsigned)wid * 1024u;
    const int aoff = lds_byte(wr * 64 + fr, fq * 8), boff = lds_byte(wc * 32 + fr, fq * 8);
#define PG8_SA(b, h) (((b) * 2 + (h)) * HTB)
#define PG8_SB(b, h) ((4 + (b) * 2 + (h)) * HTB)
#define PG8_STAGE2(bufoff, gbase, o0, o1) do { \
        __builtin_amdgcn_global_load_lds((const unsigned*)((const char*)(gbase) + (o0)), (PG8_LAS unsigned*)(lds + (bufoff) + ldsw), 16, 0, 0); \
        __builtin_amdgcn_global_load_lds((const unsigned*)((const char*)(gbase) + (o1)), (PG8_LAS unsigned*)(lds + (bufoff) + ldsw + 8192), 16, 0, 0); } while (0)
#define PG8_STB(bufoff, gbase) PG8_STAGE2(bufoff, gbase, voffB[0], voffB[1])
#define PG8_STA(bufoff, ptr, h, OC) do { if constexpr (GATHER) PG8_STAGE2(bufoff, ptr, OC[h][0], OC[h][1]); else PG8_STAGE2(bufoff, (ptr) + ((h) ? hstep : (size_t)0), voffA[0], voffA[1]); } while (0)
#define PG8_LDA(dst, b, h) do { _Pragma("unroll") for (int m = 0; m < 4; ++m) _Pragma("unroll") for (int k = 0; k < 2; ++k) dst[m][k] = *(const PG8_LAS bf16x8*)(lds + PG8_SA(b, h) + aoff + m * 2048 + k * 1024); } while (0)
#define PG8_LDB(dst, b, h) do { _Pragma("unroll") for (int n = 0; n < 2; ++n) _Pragma("unroll") for (int k = 0; k < 2; ++k) dst[n][k] = *(const PG8_LAS bf16x8*)(lds + PG8_SB(b, h) + boff + n * 2048 + k * 1024); } while (0)
#define PG8_MMA(ai, bj, At, Bt) do { __builtin_amdgcn_s_setprio(1); \
        if constexpr (FP8) { _Pragma("unroll") for (int m = 0; m < 4; ++m) _Pragma("unroll") for (int n = 0; n < 2; ++n) \
            mfma_f8(acc[ai][bj][m][n], cat8(Bt[n][0], Bt[n][1]), cat8(At[m][0], At[m][1]), sc8); } \
        else { _Pragma("unroll") for (int m = 0; m < 4; ++m) _Pragma("unroll") for (int n = 0; n < 2; ++n) _Pragma("unroll") for (int k = 0; k < 2; ++k) \
            acc[ai][bj][m][n] = __builtin_amdgcn_mfma_f32_16x16x32_bf16(Bt[n][k], At[m][k], acc[ai][bj][m][n], 0, 0, 0); } \
        __builtin_amdgcn_s_setprio(0); } while (0)
#define PG8_WAIT_V(n) asm volatile("s_waitcnt vmcnt(" #n ")" ::: "memory")
#define PG8_WAIT_L(n) asm volatile("s_waitcnt lgkmcnt(" #n ")" ::: "memory")
#define PG8_BAR __builtin_amdgcn_s_barrier()
#define PG8_SCHED __builtin_amdgcn_sched_barrier(0)
    Unit cur, nxt; int ui = 0;
    if (!S.next(0, cur)) return;
    f32x4 acc[2][2][4][2];
#pragma unroll
    for (int a = 0; a < 2; ++a)
#pragma unroll
        for (int b = 0; b < 2; ++b)
#pragma unroll
            for (int m = 0; m < 4; ++m)
#pragma unroll
                for (int n = 0; n < 2; ++n) acc[a][b][m][n] = (f32x4){0.f, 0.f, 0.f, 0.f};
    bf16x8 At[4][2], B0[2][2], B1[2][2];
    int sc8 = 0x7f7f7f7f; asm volatile("" : "+v"(sc8));
    unsigned vC[2][2] = {{0u, 0u}, {0u, 0u}}, vN[2][2] = {{0u, 0u}, {0u, 0u}};
    if constexpr (GATHER) {
#pragma unroll
        for (int h = 0; h < 2; ++h)
#pragma unroll
            for (int i = 0; i < 2; ++i) vC[h][i] = (S.a_row(cur, h * HALF + RA[i]) * (unsigned)K + (unsigned)CA[i]) * 2u;
    }
    const char* Ab = (const char*)g.A;
    const char* cA = GATHER ? Ab : Ab + (size_t)cur.pm * tstep; const char* cB = (const char*)g.Bt + (size_t)cur.pn * tstep;
    PG8_STB(PG8_SB(0, 0), cB); PG8_STB(PG8_SB(0, 1), cB + hstep); PG8_STA(PG8_SA(0, 0), cA, 0, vC); PG8_STA(PG8_SA(0, 1), cA, 1, vC);
    if (wr == 1) PG8_BAR;
    PG8_WAIT_V(2); PG8_BAR;
    PG8_STB(PG8_SB(1, 0), cB + kstep); PG8_STA(PG8_SA(1, 0), cA + kstep, 0, vC); PG8_STB(PG8_SB(1, 1), cB + hstep + kstep);
    PG8_WAIT_V(6); PG8_BAR;
    for (;;) {
        const bool has_next = S.next(ui + 1, nxt);
        const char* nA = GATHER ? Ab : (has_next ? Ab + (size_t)nxt.pm * tstep : cA); const char* nB = has_next ? (const char*)g.Bt + (size_t)nxt.pn * tstep : cB;
        if constexpr (GATHER) {
            if (has_next) {
#pragma unroll
                for (int h = 0; h < 2; ++h)
#pragma unroll
                    for (int i = 0; i < 2; ++i) vN[h][i] = (S.a_row(nxt, h * HALF + RA[i]) * (unsigned)K + (unsigned)CA[i]) * 2u;
            } else {
#pragma unroll
                for (int h = 0; h < 2; ++h)
#pragma unroll
                    for (int i = 0; i < 2; ++i) vN[h][i] = vC[h][i];
            }
        }
        for (int t = 0; t < nt; t += 2) {
            const bool last = (t == nt - 2);
            const char* a1 = cA + (size_t)(t + 1) * kstep;
            const char* a2 = last ? nA : cA + (size_t)(t + 2) * kstep; const char* b2 = last ? nB : cB + (size_t)(t + 2) * kstep;
            const char* a3 = a2 + kstep; const char* b3 = b2 + kstep;
            unsigned v2[2][2];
#pragma unroll
            for (int h = 0; h < 2; ++h)
#pragma unroll
                for (int i = 0; i < 2; ++i) v2[h][i] = last ? vN[h][i] : vC[h][i];
            PG8_LDB(B0, 0, 0); PG8_LDB(B1, 0, 1); PG8_SCHED; PG8_LDA(At, 0, 0); PG8_STA(PG8_SA(1, 1), a1, 1, vC);
            PG8_WAIT_V(8); PG8_WAIT_L(0); PG8_BAR; PG8_MMA(0, 0, At, B0); PG8_MMA(0, 1, At, B1); PG8_BAR; PG8_SCHED;
            PG8_LDA(At, 0, 1); PG8_STB(PG8_SB(0, 0), b2); PG8_STB(PG8_SB(0, 1), b2 + hstep); PG8_STA(PG8_SA(0, 0), a2, 0, v2);
            PG8_WAIT_V(8); PG8_WAIT_L(0); PG8_BAR; PG8_MMA(1, 0, At, B0); PG8_MMA(1, 1, At, B1); PG8_BAR; PG8_SCHED;
            PG8_LDB(B0, 1, 0); PG8_LDB(B1, 1, 1); PG8_SCHED; PG8_LDA(At, 1, 0); PG8_STA(PG8_SA(0, 1), a2, 1, v2);
            PG8_WAIT_V(8); PG8_WAIT_L(0); PG8_BAR; PG8_MMA(0, 0, At, B0); PG8_MMA(0, 1, At, B1); PG8_BAR; PG8_SCHED;
            PG8_LDA(At, 1, 1); PG8_STB(PG8_SB(1, 0), b3); PG8_STB(PG8_SB(1, 1), b3 + hstep); PG8_STA(PG8_SA(1, 0), a3, 0, v2);
            PG8_WAIT_V(8); PG8_WAIT_L(0); PG8_BAR; PG8_MMA(1, 0, At, B0); PG8_MMA(1, 1, At, B1); PG8_BAR; PG8_SCHED;
        }
        if (wr == 0) PG8_BAR;
        if constexpr (FP8) {
            asm volatile("s_nop 15\n\ts_nop 15" ::: "memory");
#pragma unroll
            for (int a = 0; a < 2; ++a)
#pragma unroll
                for (int b = 0; b < 2; ++b)
#pragma unroll
                    for (int m = 0; m < 4; ++m)
#pragma unroll
                        for (int n = 0; n < 2; ++n) asm volatile("" : "+v"(acc[a][b][m][n]));
        }
        E(acc, cur, wr, wc, fr, fq);
        if constexpr (epi_dup<Epi>::v) { asm volatile("" ::: "memory"); E(acc, cur, wr, wc, fr, fq); }
        if (!has_next) break;
        bool keep_acc = false; if constexpr (epi_chain<Epi>::v) keep_acc = E.keep(cur);
        if (!keep_acc) {
#pragma unroll
        for (int a = 0; a < 2; ++a)
#pragma unroll
            for (int b = 0; b < 2; ++b)
#pragma unroll
                for (int m = 0; m < 4; ++m)
#pragma unroll
                    for (int n = 0; n < 2; ++n) acc[a][b][m][n] = (f32x4){0.f, 0.f, 0.f, 0.f};
        }
        cur = nxt; cA = nA; cB = nB; ++ui;
        if constexpr (GATHER) {
#pragma unroll
            for (int h = 0; h < 2; ++h)
#pragma unroll
                for (int i = 0; i < 2; ++i) vC[h][i] = vN[h][i];
        }
        if (wr == 1) PG8_BAR;
    }
    PG8_WAIT_V(0);
    PG8_BAR;
#undef PG8_SA
#undef PG8_SB
#undef PG8_STAGE2
#undef PG8_STB
#undef PG8_STA
#undef PG8_LDA
#undef PG8_LDB
#undef PG8_MMA
#undef PG8_WAIT_V
#undef PG8_WAIT_L
#undef PG8_BAR
#undef PG8_SCHED
}
}

namespace att {
typedef unsigned short bf16_t;
using bf16x8 = __attribute__((ext_vector_type(8))) short;
using s16x4  = __attribute__((ext_vector_type(4))) short;
using f32x16 = __attribute__((ext_vector_type(16))) float;
using u32x4  = __attribute__((ext_vector_type(4))) unsigned;
constexpr int NW = 8, QBLK = 32, KVBLK = 64;
constexpr float SCALE = 0.125f;
#ifndef ATT_SGB
#define ATT_SGB 1
#endif
#ifndef ATT_PROBE
#define ATT_PROBE 0
#endif
constexpr float THR = 8.f;
constexpr int SHM_V = KVBLK * 128 * 2, SHM_K = KVBLK * 128 * 2;
constexpr int SHM_ATTN = 2 * SHM_V + 2 * SHM_K + NW * 64 * 4;
#define KSWZ(row, colB) ((row) * 256 + ((colB) ^ (((row) & 7) << 4)))
#define SBAR() __builtin_amdgcn_sched_barrier(0)
#define SGB(mask, n) __builtin_amdgcn_sched_group_barrier((mask), (n), 0)
#define S1_PIPE() do { if (ATT_SGB) { SGB(0x100, 4); _Pragma("unroll") for (int i_ = 0; i_ < 8; ++i_) { SGB(0x008, 1); SGB(0x002, 13); if ((i_ & 1) && i_ < 5) SGB(0x100, 2); } } } while (0)
__device__ __forceinline__ int crow(int r, int hi) { return (r & 3) + 8 * (r >> 2) + 4 * hi; }
typedef float f32x2_a __attribute__((ext_vector_type(2))); typedef __bf16 bf16x2_a __attribute__((ext_vector_type(2)));
__device__ __forceinline__ unsigned cvtpk(float lo, float hi) { const f32x2_a v = {lo, hi}; const bf16x2_a b = __builtin_convertvector(v, bf16x2_a); return __builtin_bit_cast(unsigned, b); }
__device__ __forceinline__ unsigned short f2bf(float f) { return (unsigned short)(cvtpk(f, 0.f) & 0xffffu); }

__device__ __forceinline__ void partialSM(f32x16& p0, f32x16& p1, float& m_reg, float& mn, float& alpha, bool domask, int dq) {
  constexpr float C = SCALE * 1.4426950408889634f;
  if (domask) {
#pragma unroll
    for (int r = 0; r < 16; ++r) { const int d0 = dq + (r & 3) + 8 * (r >> 2), d1 = d0 + 32;
      if (d0 > 128 || d0 < -128) p0[r] = -1e30f; if (d1 > 128 || d1 < -128) p1[r] = -1e30f; }
  }
  float pmax = p0[0];
#pragma unroll
  for (int r = 1; r < 16; ++r) pmax = fmaxf(pmax, p0[r]);
#pragma unroll
  for (int r = 0; r < 16; ++r) pmax = fmaxf(pmax, p1[r]);
  { auto rr = __builtin_amdgcn_permlane32_swap(__float_as_uint(pmax), __float_as_uint(pmax), false, false);
    pmax = fmaxf(__uint_as_float(rr[0]), __uint_as_float(rr[1])); }
  if (__builtin_expect(__all(pmax - m_reg <= THR / SCALE), 1)) { mn = m_reg; alpha = 1.f; }
  else { mn = fmaxf(m_reg, pmax); alpha = __builtin_amdgcn_exp2f((m_reg - mn) * C); m_reg = mn; }
  const float mnC = -mn * C;
#pragma unroll
  for (int r = 0; r < 16; ++r) p0[r] = fmaf(p0[r], C, mnC);
#pragma unroll
  for (int r = 0; r < 16; ++r) p1[r] = fmaf(p1[r], C, mnC);
#pragma unroll
  for (int r = 0; r < 16; ++r) { if (ATT_PROBE == 3) { float x2 = p0[r]; asm volatile("" : "+v"(x2)); p0[r] = 0.5f * (__builtin_amdgcn_exp2f(p0[r]) + __builtin_amdgcn_exp2f(x2)); } else p0[r] = __builtin_amdgcn_exp2f(p0[r]); }
}
__device__ __forceinline__ void finishSM(f32x16& p0, f32x16& p1, float alpha, float& l_reg, bf16x8& pa0, bf16x8& pa1, bf16x8& pa2, bf16x8& pa3, float pscale = 1.0f) {
#pragma unroll
  for (int r = 0; r < 16; ++r) { if (ATT_PROBE == 3) { float x2 = p1[r]; asm volatile("" : "+v"(x2)); p1[r] = 0.5f * (__builtin_amdgcn_exp2f(p1[r]) + __builtin_amdgcn_exp2f(x2)); } else p1[r] = __builtin_amdgcn_exp2f(p1[r]); }
  float ps = 0;
#pragma unroll
  for (int r = 0; r < 16; ++r) ps += p0[r];
#pragma unroll
  for (int r = 0; r < 16; ++r) ps += p1[r];
  { auto rr = __builtin_amdgcn_permlane32_swap(__float_as_uint(ps), __float_as_uint(ps), false, false);
    ps = __uint_as_float(rr[0]) + __uint_as_float(rr[1]); }
  l_reg = l_reg * alpha + ps;
  if (pscale != 1.0f) {
#pragma unroll
    for (int r = 0; r < 16; ++r) { p0[r] *= pscale; p1[r] *= pscale; } }
#define PK4(P, BASE, OUT) do { unsigned a0 = cvtpk(P[BASE + 0], P[BASE + 1]), a1 = cvtpk(P[BASE + 2], P[BASE + 3]);   \
    unsigned b0 = cvtpk(P[BASE + 4], P[BASE + 5]), b1 = cvtpk(P[BASE + 6], P[BASE + 7]);                              \
    auto r0 = __builtin_amdgcn_permlane32_swap(a0, b0, false, false); auto r1 = __builtin_amdgcn_permlane32_swap(a1, b1, false, false); \
    u32x4 w = {r0[0], r1[0], r0[1], r1[1]}; OUT = *reinterpret_cast<bf16x8*>(&w); } while (0)
  PK4(p0, 0, pa0); PK4(p0, 8, pa1); PK4(p1, 0, pa2); PK4(p1, 8, pa3);
#undef PK4
}
__device__ __forceinline__ void qkt(f32x16& p0, f32x16& p1, const char* Ks, const bf16x8* qr, int r32, int hi, int kcolB) {
  p0 = f32x16{}; p1 = f32x16{};
#pragma unroll
  for (int d0 = 0; d0 < 4; ++d0) { const int cb = kcolB + (d0 * 16 + hi * 8) * 2;
    bf16x8 b0 = *reinterpret_cast<const bf16x8*>(Ks + KSWZ(r32, cb));
    bf16x8 b1 = *reinterpret_cast<const bf16x8*>(Ks + KSWZ(32 + r32, cb));
    p0 = __builtin_amdgcn_mfma_f32_32x32x16_bf16(b0, qr[d0], p0, 0, 0, 0);
    p1 = __builtin_amdgcn_mfma_f32_32x32x16_bf16(b1, qr[d0], p1, 0, 0, 0); }
}
__device__ __forceinline__ int v_st(int k, int c) { const int kk = (k & ~0xC) | ((k & 4) << 1) | ((k & 8) >> 1); return ((kk >> 3) * 4 + (c >> 5)) * 512 + ((kk & 7) * 32 + (c & 31)) * 2; }
__device__ __forceinline__ int v_rd_base(int lane) { return ((lane & 3) << 3) | (((lane >> 2) & 3) << 6) | (((lane >> 4) & 1) << 5) | (((lane >> 5) & 1) << 8); }
constexpr int v_rd_off(int d0, int ks, int half) { return d0 * 512 + ks * 4096 + half * 2048; }
template <int OFF> __device__ __forceinline__ s16x4 tr_read(int vb) {
  s16x4 r; asm volatile("ds_read_b64_tr_b16 %0, %1 offset:%2" : "=&v"(r) : "v"(vb), "i"(OFF) : "memory"); return r;
}
template <int D0> __device__ __forceinline__ void pv_one(f32x16& od, int vb, bf16x8 pa0, bf16x8 pa1, bf16x8 pa2, bf16x8 pa3) {
  const s16x4 l0 = tr_read<v_rd_off(D0, 0, 0)>(vb), h0 = tr_read<v_rd_off(D0, 0, 1)>(vb), l1 = tr_read<v_rd_off(D0, 1, 0)>(vb), h1 = tr_read<v_rd_off(D0, 1, 1)>(vb);
  const s16x4 l2 = tr_read<v_rd_off(D0, 2, 0)>(vb), h2 = tr_read<v_rd_off(D0, 2, 1)>(vb), l3 = tr_read<v_rd_off(D0, 3, 0)>(vb), h3 = tr_read<v_rd_off(D0, 3, 1)>(vb);
  asm volatile("s_waitcnt lgkmcnt(0)" ::: "memory"); SBAR();
#define PK(L, H) (bf16x8){L[0], L[1], L[2], L[3], H[0], H[1], H[2], H[3]}
  od = __builtin_amdgcn_mfma_f32_32x32x16_bf16(pa0, PK(l0, h0), od, 0, 0, 0);
  od = __builtin_amdgcn_mfma_f32_32x32x16_bf16(pa1, PK(l1, h1), od, 0, 0, 0);
  od = __builtin_amdgcn_mfma_f32_32x32x16_bf16(pa2, PK(l2, h2), od, 0, 0, 0);
  od = __builtin_amdgcn_mfma_f32_32x32x16_bf16(pa3, PK(l3, h3), od, 0, 0, 0);
#undef PK
}
template <bool DIFF> __device__ __forceinline__ void pv_all(f32x16* o, int vb, bf16x8 pa0, bf16x8 pa1, bf16x8 pa2, bf16x8 pa3) {
  pv_one<0>(o[0], vb, pa0, pa1, pa2, pa3); pv_one<1>(o[1], vb, pa0, pa1, pa2, pa3);
  if constexpr (DIFF) { pv_one<2>(o[2], vb, pa0, pa1, pa2, pa3); pv_one<3>(o[3], vb, pa0, pa1, pa2, pa3); }
}

struct UnitArgs {
  const GAS bf16_t* Q;
  int qg1;
  const GAS bf16_t* K;
  const GAS bf16_t* V;
  int ldk;
  int s1, n1, s2, n2;
  int qpos0;
  float sink0, sink1;
  int use_sink;
  GAS bf16_t* O;
  int og1;
  float lam, post;
  const GAS float* subg;
};

template <bool DIFF, bool MASK>
__device__ __forceinline__ void attn_unit(const UnitArgs& A, char* lds, const int wave0) {
  constexpr int NO = DIFF ? 4 : 2;
  const int lane = lane_now(), tid = wave0 * 64 + lane, wid = wave0, r32 = lane & 31, hi = lane >> 5;
  const int mg = wid >> 2, wq = wid & 3;
  char* V_lds = lds; char* K_lds = lds + 2 * SHM_V;
  float* ws = (float*)(lds + 2 * SHM_V + 2 * SHM_K) + wid * 64; float* li_l = ws; float* al_l = ws + 32;
  float m_reg = -1e30f, l_reg = 0.f;
  if (!DIFF && A.use_sink) { m_reg = (mg ? A.sink1 : A.sink0) * (1.0f / SCALE); l_reg = 1.f; }
  f32x16 o[NO];
#pragma unroll
  for (int d = 0; d < NO; ++d) o[d] = f32x16{};
  bf16x8 qr[4];
  const GAS bf16_t* Qw = A.Q + (mg ? A.qg1 : 0) + (long)(wq * QBLK + r32) * 512 + hi * 8;
#pragma unroll
  for (int d0 = 0; d0 < 4; ++d0) qr[d0] = *(const GAS bf16x8*)(Qw + d0 * 16);
  const int sr = tid >> 4, sc = (tid & 15) * 8, vst0 = v_st(sr, sc), vst1 = v_st(32 + sr, sc);
  const int vb0 = (int)(uintptr_t)V_lds + v_rd_base(lane) + ((!DIFF && mg) ? 1024 : 0);
  const int kcolB = mg * 128;
  const int ldk = A.ldk;
  const GAS bf16_t* Kh = A.K; const GAS bf16_t* Vh = A.V;
  const int NT = A.n1 + A.n2;
  const int qposl = A.qpos0 + wq * QBLK + r32;
  constexpr bool maskunit = MASK;
#define KST(j) ((j) < A.n1 ? A.s1 + (j) * KVBLK : A.s2 + ((j) - A.n1) * KVBLK)
  struct { bf16x8 vs0, vs1, ks0, ks1; } sr_[2];
#define SLOAD(i, k0) do { const long k0_ = (k0); sr_[i].vs0 = *(const GAS bf16x8*)(&Vh[(k0_ + sr) * ldk + sc]); sr_[i].vs1 = *(const GAS bf16x8*)(&Vh[(k0_ + 32 + sr) * ldk + sc]); \
    sr_[i].ks0 = *(const GAS bf16x8*)(&Kh[(k0_ + sr) * ldk + sc]); sr_[i].ks1 = *(const GAS bf16x8*)(&Kh[(k0_ + 32 + sr) * ldk + sc]); } while (0)
#define SWRITE(b, i) do { *(bf16x8*)(V_lds + (b) * SHM_V + vst0) = sr_[i].vs0;          \
    *(bf16x8*)(V_lds + (b) * SHM_V + vst1) = sr_[i].vs1; const int kc = sc * 2;               \
    *(bf16x8*)(K_lds + (b) * SHM_K + KSWZ(sr, kc)) = sr_[i].ks0;                       \
    *(bf16x8*)(K_lds + (b) * SHM_K + KSWZ(32 + sr, kc)) = sr_[i].ks1; } while (0)
#define SWAIT() asm volatile("s_waitcnt vmcnt(4)" ::: "memory")
#define RESC(a) do { if (__any((a) < 1.f)) { if (hi == 0) al_l[r32] = (a); asm volatile("s_waitcnt lgkmcnt(0)" ::: "memory"); \
    _Pragma("unroll") for (int d = 0; d < NO; ++d) _Pragma("unroll") for (int r = 0; r < 16; ++r) o[d][r] *= al_l[crow(r, hi)]; } } while (0)
#define MASKARGS(j) (maskunit && (j) >= A.n1), (KST(j) - qposl + 4 * hi)
  f32x16 pA0, pA1, pB0, pB1; float mnA, mnB, alA, alB; bf16x8 pa0, pa1, pa2, pa3;
  constexpr int SE = 0, SO = 1;
  __syncthreads();
  SLOAD(SE, KST(0)); asm volatile("s_waitcnt vmcnt(0)" ::: "memory"); SWRITE(0, SE); __syncthreads();
  qkt(pA0, pA1, K_lds, qr, r32, hi, kcolB); partialSM(pA0, pA1, m_reg, mnA, alA, MASKARGS(0));
  SLOAD(SO, KST(1)); if (2 < NT) SLOAD(SE, KST(2));
  SWAIT(); SWRITE(1, SO); __syncthreads();
  for (int j = 1; j + 1 < NT; j += 2) {
    SBAR(); qkt(pB0, pB1, K_lds + SHM_K, qr, r32, hi, kcolB);
    if (ATT_PROBE == 1) { asm volatile("" : "+v"(pB0), "+v"(pB1)); qkt(pB0, pB1, K_lds + SHM_K, qr, r32, hi, kcolB); }
    finishSM(pA0, pA1, alA, l_reg, pa0, pa1, pa2, pa3, ATT_PROBE == 2 ? 0.5f : 1.0f); S1_PIPE(); SBAR();
    SLOAD(SO, KST(j + 2)); SBAR();
    if (ATT_PROBE == 2) pv_all<DIFF>(o, vb0, pa0, pa1, pa2, pa3);
    pv_all<DIFF>(o, vb0, pa0, pa1, pa2, pa3); partialSM(pB0, pB1, m_reg, mnB, alB, MASKARGS(j));
    __syncthreads(); SWAIT(); SWRITE(0, SE); if (ATT_PROBE == 4) { asm volatile("" ::: "memory"); SWRITE(0, SE); }
    RESC(alB); __syncthreads();
    SBAR(); qkt(pA0, pA1, K_lds, qr, r32, hi, kcolB);
    if (ATT_PROBE == 1) { asm volatile("" : "+v"(pA0), "+v"(pA1)); qkt(pA0, pA1, K_lds, qr, r32, hi, kcolB); }
    finishSM(pB0, pB1, alB, l_reg, pa0, pa1, pa2, pa3, ATT_PROBE == 2 ? 0.5f : 1.0f); S1_PIPE(); SBAR();
    if (j + 3 < NT) SLOAD(SE, KST(j + 3)); SBAR();
    if (ATT_PROBE == 2) pv_all<DIFF>(o, vb0 + SHM_V, pa0, pa1, pa2, pa3);
    pv_all<DIFF>(o, vb0 + SHM_V, pa0, pa1, pa2, pa3); partialSM(pA0, pA1, m_reg, mnA, alA, MASKARGS(j + 1));
    __syncthreads(); SWAIT(); SWRITE(1, SO); if (ATT_PROBE == 4) { asm volatile("" ::: "memory"); SWRITE(1, SO); }
    RESC(alA); __syncthreads();
  }
  SBAR(); qkt(pB0, pB1, K_lds + SHM_K, qr, r32, hi, kcolB);
  finishSM(pA0, pA1, alA, l_reg, pa0, pa1, pa2, pa3); SBAR();
  pv_all<DIFF>(o, vb0, pa0, pa1, pa2, pa3); partialSM(pB0, pB1, m_reg, mnB, alB, MASKARGS(NT - 1));
  __syncthreads(); RESC(alB);
  finishSM(pB0, pB1, alB, l_reg, pa0, pa1, pa2, pa3); SBAR();
  pv_all<DIFF>(o, vb0 + SHM_V, pa0, pa1, pa2, pa3);
  if (hi == 0) li_l[r32] = l_reg; asm volatile("s_waitcnt lgkmcnt(0)" ::: "memory");
  float rli[16];
#pragma unroll
  for (int r = 0; r < 16; ++r) rli[r] = __builtin_amdgcn_rcpf(li_l[crow(r, hi)]);
  if constexpr (!DIFF) {
    GAS bf16_t* Ow = A.O + (mg ? A.og1 : 0) + (long)(wq * QBLK) * 512;
#pragma unroll
    for (int r = 0; r < 16; ++r) { const int orow = crow(r, hi);
#pragma unroll
      for (int d0 = 0; d0 < 2; ++d0) Ow[(long)orow * 512 + d0 * 32 + r32] = f2bf(o[d0][r] * rli[r]); }
  } else {
    float* ex = (float*)lds;
    __syncthreads();
    if (mg == 1) {
#pragma unroll
      for (int d0 = 0; d0 < 4; ++d0)
#pragma unroll
        for (int r = 0; r < 16; ++r) ex[(wq * 64 + d0 * 16 + r) * 64 + lane] = o[d0][r] * rli[r];
    }
    __syncthreads();
    if (mg == 0) {
      GAS bf16_t* Ow = A.O + (long)(wq * QBLK) * 512;
      float gsub[4];
#pragma unroll
      for (int d0 = 0; d0 < 4; ++d0) gsub[d0] = A.subg[d0 * 32 + r32] * A.post;
#pragma unroll
      for (int r = 0; r < 16; ++r) {
        float v[4]; float ss = 0.f;
#pragma unroll
        for (int d0 = 0; d0 < 4; ++d0) { v[d0] = o[d0][r] * rli[r] - A.lam * ex[(wq * 64 + d0 * 16 + r) * 64 + lane]; ss += v[d0] * v[d0]; }
        ss += __shfl_xor(ss, 1); ss += __shfl_xor(ss, 2); ss += __shfl_xor(ss, 4); ss += __shfl_xor(ss, 8); ss += __shfl_xor(ss, 16);
        const float rn = __builtin_amdgcn_rsqf(ss * (1.0f / 128.0f) + 1e-6f);
        const int orow = crow(r, hi);
#pragma unroll
        for (int d0 = 0; d0 < 4; ++d0) Ow[(long)orow * 512 + d0 * 32 + r32] = f2bf(v[d0] * rn * gsub[d0]);
      }
    }
  }
#undef KST
#undef SLOAD
#undef SWRITE
#undef SWAIT
#undef RESC
#undef MASKARGS
}
#undef KSWZ
}
#include <hip/hip_bf16.h>
namespace att64 {
using bf16=__hip_bfloat16;
using bf16x8=__attribute__((ext_vector_type(8)))short;
using s16x4=__attribute__((ext_vector_type(4)))short;
using f32x16=__attribute__((ext_vector_type(16)))float;
using u32x4=__attribute__((ext_vector_type(4)))unsigned;
constexpr int D=64;
constexpr int NW=8,QBLK=32,QB=QBLK*NW,KVBLK=64;
__device__ __forceinline__ int crow(int r,int hi){return (r&3)+8*(r>>2)+4*hi;}
#define SBAR() __builtin_amdgcn_sched_barrier(0)
__device__ __forceinline__ void bmask(f32x16&p0,f32x16&p1,int dq){
  const float NEG=-INFINITY;
  #pragma unroll
  for(int r=0;r<16;++r){const int d0=dq+(r&3)+8*(r>>2),d1=d0+32; if(d0>128||d0<-128)p0[r]=NEG; if(d1>128||d1<-128)p1[r]=NEG;}
}
constexpr int NSLOT=3, SLOTB=8192;
constexpr int LDS_K=0, LDS_V=NSLOT*SLOTB, LDS_WS=2*NSLOT*SLOTB, LDS_OST=LDS_WS+NW*64*4, LDS_BYTES=LDS_OST+NW*4096;
constexpr float C2=0.125f*1.4426950408889634f;
__device__ __forceinline__ void glds16(const void*gsrc,unsigned lds_dst){unsigned keep;
  asm volatile("s_mov_b32 %0, m0\n\ts_mov_b32 m0, %2\n\ts_nop 0\n\tglobal_load_lds_dwordx4 %1, off\n\ts_mov_b32 m0, %0":"=&s"(keep):"v"(gsrc),"s"(lds_dst):"memory");}
__device__ __forceinline__ float max3f(float a,float b,float c){float r;asm("v_max3_f32 %0, %1, %2, %3":"=v"(r):"v"(a),"v"(b),"v"(c));return r;}
__device__ __forceinline__ float max2f(float a,float b){float r;asm("v_max_f32_e32 %0, %1, %2":"=v"(r):"v"(a),"v"(b));return r;}
__device__ __forceinline__ float fadd_s(float a,float b){float r;asm("v_add_f32_e32 %0, %1, %2":"=v"(r):"v"(a),"v"(b));return r;}
__device__ __forceinline__ float fsub_s(float a,float b){float r;asm("v_sub_f32_e32 %0, %1, %2":"=v"(r):"v"(a),"v"(b));return r;}
typedef float f32x2_t __attribute__((ext_vector_type(2))); typedef __bf16 bf16x2_t __attribute__((ext_vector_type(2)));
__device__ __forceinline__ unsigned cvtpk_s(float lo,float hi){f32x2_t v={lo,hi};bf16x2_t b=__builtin_convertvector(v,bf16x2_t);return __builtin_bit_cast(unsigned,b);}
#define WAIT_BAR(N) asm volatile("s_waitcnt vmcnt(" #N ") lgkmcnt(0)\n\ts_barrier":::"memory")

__device__ __forceinline__ void qkt(f32x16&p0,f32x16&p1,const char*Kslot,const bf16x8*qr,const f32x16&negm,int r32,int hi){
  const char*kb=Kslot+hi*1024+r32*16;
  #pragma unroll
  for(int d0=0;d0<4;++d0){
    const bf16x8 b0=*reinterpret_cast<const bf16x8*>(kb+d0*2048);
    const bf16x8 b1=*reinterpret_cast<const bf16x8*>(kb+d0*2048+512);
    if(d0==0){p0=__builtin_amdgcn_mfma_f32_32x32x16_bf16(b0,qr[0],negm,0,0,0);p1=__builtin_amdgcn_mfma_f32_32x32x16_bf16(b1,qr[0],negm,0,0,0);}
    else{p0=__builtin_amdgcn_mfma_f32_32x32x16_bf16(b0,qr[d0],p0,0,0,0);p1=__builtin_amdgcn_mfma_f32_32x32x16_bf16(b1,qr[d0],p1,0,0,0);}}
}
typedef __attribute__((address_space(3))) const char* lds_cptr;
typedef short v4i16_t __attribute__((ext_vector_type(4)));
__device__ __forceinline__ void kload8(bf16x8*kf,lds_cptr kp){
  kf[0]=*(const __attribute__((address_space(3))) bf16x8*)(kp);      kf[1]=*(const __attribute__((address_space(3))) bf16x8*)(kp+512);
  kf[2]=*(const __attribute__((address_space(3))) bf16x8*)(kp+2048); kf[3]=*(const __attribute__((address_space(3))) bf16x8*)(kp+2560);
  kf[4]=*(const __attribute__((address_space(3))) bf16x8*)(kp+4096); kf[5]=*(const __attribute__((address_space(3))) bf16x8*)(kp+4608);
  kf[6]=*(const __attribute__((address_space(3))) bf16x8*)(kp+6144); kf[7]=*(const __attribute__((address_space(3))) bf16x8*)(kp+6656);
}
__device__ __forceinline__ void kload2(bf16x8*kf,lds_cptr kp,int j){ kf[2*j]=*(const __attribute__((address_space(3))) bf16x8*)(kp+j*2048); kf[2*j+1]=*(const __attribute__((address_space(3))) bf16x8*)(kp+j*2048+512); }
__device__ __forceinline__ s16x4 vtr(lds_cptr p){ return __builtin_bit_cast(s16x4,__builtin_amdgcn_ds_read_tr16_b64_v4i16((__attribute__((address_space(3))) v4i16_t*)p)); }
__device__ __forceinline__ float rowmax(const f32x16&p0,const f32x16&p1){
  float a=max3f(p0[0],p0[1],p1[0]),b=max3f(p0[2],p0[3],p1[1]);a=max3f(a,p1[2],p1[3]);
  #pragma unroll
  for(int r=4;r<16;r+=4){a=max3f(a,p0[r],p0[r+1]);b=max3f(b,p0[r+2],p0[r+3]);a=max3f(a,p1[r],p1[r+1]);b=max3f(b,p1[r+2],p1[r+3]);}
  const float m=max2f(a,b);
  auto rr=__builtin_amdgcn_permlane32_swap(__float_as_uint(m),__float_as_uint(m),false,false);
  return max2f(__uint_as_float(rr[0]),__uint_as_float(rr[1]));
}
__device__ __forceinline__ void pv(f32x16*o,int vb,bf16x8 pa0,bf16x8 pa1,bf16x8 pa2,bf16x8 pa3){
  #pragma unroll
  for(int d0=0;d0<2;++d0){s16x4 lo[4],hi[4];
    #pragma unroll
    for(int ks=0;ks<4;++ks){
      asm volatile("ds_read_b64_tr_b16 %0,%1 offset:%c2":"=&v"(lo[ks]):"v"(vb),"i"(d0*4096+ks*1024):"memory");
      asm volatile("ds_read_b64_tr_b16 %0,%1 offset:%c2":"=&v"(hi[ks]):"v"(vb),"i"(d0*4096+ks*1024+512):"memory");}
    asm volatile("s_waitcnt lgkmcnt(0)":::"memory");SBAR();
    #define PK(k) (bf16x8){lo[k][0],lo[k][1],lo[k][2],lo[k][3],hi[k][0],hi[k][1],hi[k][2],hi[k][3]}
    o[d0]=__builtin_amdgcn_mfma_f32_32x32x16_bf16(pa0,PK(0),o[d0],0,0,0);
    o[d0]=__builtin_amdgcn_mfma_f32_32x32x16_bf16(pa1,PK(1),o[d0],0,0,0);
    o[d0]=__builtin_amdgcn_mfma_f32_32x32x16_bf16(pa2,PK(2),o[d0],0,0,0);
    o[d0]=__builtin_amdgcn_mfma_f32_32x32x16_bf16(pa3,PK(3),o[d0],0,0,0);
    #undef PK
  }
}

#ifndef ATTN_STORE16
#define ATTN_STORE16(p,v) (*(u32x4*)(p)=(v))
#endif
template<int THRL,bool MASK,bool PAIR> __device__ __forceinline__ void attn_unit(const bf16*Qu,int qp,const bf16*__restrict__ Kh,const bf16*__restrict__ Vh,int kvp,int NT,int n1,int s2,int kpos2,int qpos0,int use_sink,float sink_l2,float sink_l2b,bf16*Ou,int op,char*shm,const int wave0){
  const int lane=lane_now(),tid=wave0*64+lane,r32=lane&31,hi=lane>>5; const int wid=wave0;
  const int wrow=PAIR?(wid&3):wid, whead=PAIR?(wid>>2):0;
  const bf16*Qw=Qu+(long)(wrow*QBLK)*qp+whead*D;
  const unsigned lds0=(unsigned)(uintptr_t)shm;
  float*wsf=(float*)(shm+LDS_WS)+wid*64;
  const bf16*ksrc=Kh+(long)lane*kvp+wid*8;
  const bf16*vsrc=Vh+(long)(16*(wid&3)+(lane>>2))*kvp+(wid>>2)*32+(lane&3)*8;
  const unsigned kdst=lds0+LDS_K+wid*1024, vdst=lds0+LDS_V+wid*1024;
  #define KROW(t) ((t)<n1?(t)*KVBLK:s2+((t)-n1)*KVBLK)
  #define DMA_K(t,slot) glds16(ksrc+(long)KROW(t)*kvp,(unsigned)__builtin_amdgcn_readfirstlane(kdst+(slot)))
  #define DMA_V(t,slot) glds16(vsrc+(long)KROW(t)*kvp,(unsigned)__builtin_amdgcn_readfirstlane(vdst+(slot)))
  const int vb0=(int)(lds0+LDS_V)+((lane>>4)&1)*32+(lane&3)*8+(4*hi+((lane&15)>>2))*64;
  const char*Kbase=shm+LDS_K; bf16x8 kf[8];
  const lds_cptr shm3=(lds_cptr)shm; const lds_cptr kp0=shm3+LDS_K+hi*1024+r32*16; const lds_cptr vp0=shm3+LDS_V+((lane>>4)&1)*32+(lane&3)*8+(4*hi+((lane&15)>>2))*64;
  DMA_K(0,0);DMA_V(0,0);DMA_K(1,SLOTB);
  bf16x8 qr[4];
  #pragma unroll
  for(int d0=0;d0<4;++d0)qr[d0]=*reinterpret_cast<const bf16x8*>(&Qw[(long)r32*qp+d0*16+hi*8]);
  float mhat=0.f,l_reg=0.f;f32x16 o[2];o[0]=f32x16{};o[1]=f32x16{};f32x16 negm=f32x16{};asm volatile("":"+v"(negm));
  const int dqb=kpos2-(qpos0+wrow*QBLK+r32)+4*hi;
  #define CMASK(P0,P1,t) do{ if(MASK&&(t)>=n1) bmask(P0,P1,dqb+((t)-n1)*KVBLK); }while(0)
  bool resc=false;
  #define START(P0,P1) do{ const float rm=rowmax(P0,P1); resc=false; \
    { const float dl=rm; mhat=fadd_s(mhat,dl); \
      _Pragma("unroll") for(int r=0;r<16;++r){P0[r]=fsub_s(P0[r],dl);P1[r]=fsub_s(P1[r],dl);} \
      _Pragma("unroll") for(int r=0;r<16;++r)negm[r]=-mhat; asm volatile("":"+v"(negm)); } \
    _Pragma("unroll") for(int r=0;r<16;++r)P0[r]=__builtin_amdgcn_exp2f(P0[r]); }while(0)
  #define RESC() do{ if(resc){ asm volatile("s_waitcnt lgkmcnt(0)":::"memory"); \
      _Pragma("unroll") for(int d_=0;d_<2;++d_) _Pragma("unroll") for(int r=0;r<16;++r)o[d_][r]*=wsf[crow(r,hi)]; } }while(0)
  f32x16 pA0,pA1,pB0,pB1;
  int sl_prev=0,sl_cur=0,sl_next=SLOTB;
  #define ROT() do{sl_prev=sl_cur;sl_cur=sl_next;sl_next=(sl_next==(NSLOT-1)*SLOTB)?0:sl_next+SLOTB;}while(0)
  DMA_K(2,2*SLOTB);
  WAIT_BAR(3);
  qkt(pA0,pA1,Kbase,qr,f32x16{},r32,hi);asm volatile("s_nop 15\n\ts_nop 7":"+v"(pA0),"+v"(pA1));CMASK(pA0,pA1,0);
  START(pA0,pA1);
  _Pragma("unroll") for(int r=0;r<16;++r)pA1[r]=__builtin_amdgcn_exp2f(pA1[r]);
  WAIT_BAR(0);
  DMA_K(3,0);DMA_V(1,SLOTB);
  ROT();
  kload8(kf,kp0+sl_cur);
  WAIT_BAR(2);
  s16x4 vlo[8],vhi[8]; u32x4 pw0,pw1,pw2,pw3;
  #define PKW(P,B) cvtpk_s(P[B],P[B+1])
  #define PAF(k) __builtin_bit_cast(bf16x8,pw##k)
  #define VFR(i) (bf16x8){vlo[i][0],vlo[i][1],vlo[i][2],vlo[i][3],vhi[i][0],vhi[i][1],vhi[i][2],vhi[i][3]}
  #define PIN(x) asm volatile("":"+v"(x))
  #define MX3(a,b,c) __builtin_fmaxf(__builtin_fmaxf((a),(b)),(c))
  #define GAPA(MF,A0,A1,A2,A3,W0,W1,PW) do{ MF; sacc+=A0; sacc+=A1; sacc+=A2; sacc+=A3; PIN(sacc); W0; W1; PIN(PW); SBAR(); }while(0)
  #define EX(v) __builtin_amdgcn_exp2f(v)
  #define GAPB(MF,X,B) do{ MF; X[B]=EX(X[B]); X[B+1]=EX(X[B+1]); X[B+2]=EX(X[B+2]); X[B+3]=EX(X[B+3]); PIN(X); SBAR(); }while(0)
  #define VRD(i) do{ vlo[i]=vtr(vp_+(((i)>>2)*4096+((i)&3)*1024)); vhi[i]=vtr(vp_+(((i)>>2)*4096+((i)&3)*1024+512)); }while(0)
  #define KRD(G,j) do{ if(G){ kload2(kf,kp0+sl_next,j); SBAR(); } }while(0)
  #define STEP(C0,C1,P0,P1,t,GK,GV,GL) do{ SBAR(); \
    const lds_cptr vp_=vp0+sl_prev; \
    VRD(0); SBAR(); float sacc=(P0[0]+P0[1]); \
    GAPA(C0=__builtin_amdgcn_mfma_f32_32x32x16_bf16(kf[0],qr[0],negm,0,0,0), P0[2],P0[3],P0[4],P0[5],     pw0[0]=PKW(P0,0), pw0[1]=PKW(P0,2), pw0); \
    VRD(4); SBAR(); GAPA(C1=__builtin_amdgcn_mfma_f32_32x32x16_bf16(kf[1],qr[0],negm,0,0,0), P0[6],P0[7],P0[8],P0[9],     pw0[2]=PKW(P0,4), pw0[3]=PKW(P0,6), pw0); \
    VRD(1); SBAR(); GAPA(C0=__builtin_amdgcn_mfma_f32_32x32x16_bf16(kf[2],qr[1],C0,0,0,0),   P0[10],P0[11],P0[12],P0[13], pw1[0]=PKW(P0,8), pw1[1]=PKW(P0,10), pw1); \
    VRD(5); SBAR(); GAPA(C1=__builtin_amdgcn_mfma_f32_32x32x16_bf16(kf[3],qr[1],C1,0,0,0),   P0[14],P0[15],P1[0],P1[1],   pw1[2]=PKW(P0,12),pw1[3]=PKW(P0,14), pw1); \
    VRD(2); SBAR(); GAPA(C0=__builtin_amdgcn_mfma_f32_32x32x16_bf16(kf[4],qr[2],C0,0,0,0),   P1[2],P1[3],P1[4],P1[5],     pw2[0]=PKW(P1,0), pw2[1]=PKW(P1,2), pw2); \
    VRD(6); SBAR(); GAPA(C1=__builtin_amdgcn_mfma_f32_32x32x16_bf16(kf[5],qr[2],C1,0,0,0),   P1[6],P1[7],P1[8],P1[9],     pw2[2]=PKW(P1,4), pw2[3]=PKW(P1,6), pw2); \
    VRD(3); SBAR(); GAPA(C0=__builtin_amdgcn_mfma_f32_32x32x16_bf16(kf[6],qr[3],C0,0,0,0),   P1[10],P1[11],P1[12],P1[13], pw3[0]=PKW(P1,8), pw3[1]=PKW(P1,10), pw3); \
    VRD(7); SBAR(); GAPA(C1=__builtin_amdgcn_mfma_f32_32x32x16_bf16(kf[7],qr[3],C1,0,0,0),   P1[14],P1[15],0.f,0.f,       pw3[2]=PKW(P1,12),pw3[3]=PKW(P1,14), pw3); \
    l_reg+=sacc; \
    if(GK){DMA_K((t)+3,sl_cur);} if(GV){DMA_V((t)+1,sl_next);} \
    CMASK(C0,C1,t); \
    { float a=MX3(C0[0],C0[1],C1[0]),b=MX3(C0[2],C0[3],C1[1]); a=MX3(a,C1[2],C1[3]); \
      _Pragma("unroll") for(int r=4;r<16;r+=4){a=MX3(a,C0[r],C0[r+1]);b=MX3(b,C0[r+2],C0[r+3]);a=MX3(a,C1[r],C1[r+1]);b=MX3(b,C1[r+2],C1[r+3]);} \
      float rm=__builtin_fmaxf(a,b); { auto rr=__builtin_amdgcn_permlane32_swap(__float_as_uint(rm),__float_as_uint(rm),false,false); rm=__builtin_fmaxf(__uint_as_float(rr[0]),__uint_as_float(rr[1])); } \
      resc=false;                                              \
      if(__builtin_expect(__any(rm>(float)THRL),0)){ const float dl=__builtin_fmaxf(rm,0.f); mhat+=dl; \
        _Pragma("unroll") for(int r=0;r<16;++r){C0[r]-=dl;C1[r]-=dl;} \
        _Pragma("unroll") for(int r=0;r<16;++r)negm[r]=-mhat; asm volatile("":"+v"(negm)); \
        const float f=__builtin_amdgcn_exp2f(-dl); l_reg*=f; if(hi==0)wsf[r32]=f; resc=true; } } \
    SBAR(); \
    GAPB(o[0]=__builtin_amdgcn_mfma_f32_32x32x16_bf16(PAF(0),VFR(0),o[0],0,0,0), C0,0); \
    GAPB(o[1]=__builtin_amdgcn_mfma_f32_32x32x16_bf16(PAF(0),VFR(4),o[1],0,0,0), C0,4); \
    KRD(GL,0); GAPB(o[0]=__builtin_amdgcn_mfma_f32_32x32x16_bf16(PAF(1),VFR(1),o[0],0,0,0), C0,8); \
    KRD(GL,1); GAPB(o[1]=__builtin_amdgcn_mfma_f32_32x32x16_bf16(PAF(1),VFR(5),o[1],0,0,0), C0,12); \
    KRD(GL,2); GAPB(o[0]=__builtin_amdgcn_mfma_f32_32x32x16_bf16(PAF(2),VFR(2),o[0],0,0,0), C1,0); \
    KRD(GL,3); GAPB(o[1]=__builtin_amdgcn_mfma_f32_32x32x16_bf16(PAF(2),VFR(6),o[1],0,0,0), C1,4); \
    GAPB(o[0]=__builtin_amdgcn_mfma_f32_32x32x16_bf16(PAF(3),VFR(3),o[0],0,0,0), C1,8); \
    GAPB(o[1]=__builtin_amdgcn_mfma_f32_32x32x16_bf16(PAF(3),VFR(7),o[1],0,0,0), C1,12); \
    }while(0)
  int t=1;
  for(;t+5<NT;t+=2){
    STEP(pB0,pB1,pA0,pA1,t,true,true,true);     WAIT_BAR(2); RESC(); ROT();
    STEP(pA0,pA1,pB0,pB1,t+1,true,true,true);   WAIT_BAR(2); RESC(); ROT();
  }
  #define ENDW(tt) do{ if((tt)+3<NT){WAIT_BAR(2);} else if((tt)+2<NT){WAIT_BAR(1);} else {WAIT_BAR(0);} }while(0)
  for(;t+1<NT;t+=2){
    STEP(pB0,pB1,pA0,pA1,t,(t+3<NT),(t+1<NT),(t+1<NT));       ENDW(t);   RESC(); ROT();
    STEP(pA0,pA1,pB0,pB1,t+1,(t+4<NT),(t+2<NT),(t+2<NT));     ENDW(t+1); RESC(); ROT();
  }
  STEP(pB0,pB1,pA0,pA1,NT-1,false,false,false); RESC();
  { float sacc=pB0[0]+pB0[1]; _Pragma("unroll") for(int r=2;r<16;++r)sacc+=pB0[r]; _Pragma("unroll") for(int r=0;r<16;++r)sacc+=pB1[r]; l_reg+=sacc;
    pw0=(u32x4){PKW(pB0,0),PKW(pB0,2),PKW(pB0,4),PKW(pB0,6)};pw1=(u32x4){PKW(pB0,8),PKW(pB0,10),PKW(pB0,12),PKW(pB0,14)};pw2=(u32x4){PKW(pB1,0),PKW(pB1,2),PKW(pB1,4),PKW(pB1,6)};pw3=(u32x4){PKW(pB1,8),PKW(pB1,10),PKW(pB1,12),PKW(pB1,14)};
    SBAR(); pv(o,vb0+sl_cur,PAF(0),PAF(1),PAF(2),PAF(3)); }
  #undef PKW
  #undef PAF
  #undef VFR
  #undef PIN
  #undef MX3
  #undef GAPA
  #undef GAPB
  #undef EX
  #undef VRD
  #undef KRD
  #undef STEP
  #undef ENDW
  {auto rr=__builtin_amdgcn_permlane32_swap(__float_as_uint(l_reg),__float_as_uint(l_reg),false,false);l_reg=__uint_as_float(rr[0])+__uint_as_float(rr[1]);}
  if(use_sink) l_reg+=__builtin_amdgcn_exp2f(fminf((whead?sink_l2b:sink_l2)-mhat,120.f));
  if(hi==0)wsf[32+r32]=l_reg;asm volatile("s_waitcnt lgkmcnt(0)":::"memory");
  float rli[16];
  #pragma unroll
  for(int r=0;r<16;++r)rli[r]=__builtin_amdgcn_rcpf(wsf[32+crow(r,hi)]);
  bf16*Ow=Ou+(long)(wrow*QBLK)*op+whead*D;
  { bf16*stg=(bf16*)(shm+LDS_OST)+wid*2048;
    #pragma unroll
    for(int r=0;r<16;++r){const int orow=crow(r,hi);
      #pragma unroll
      for(int d0=0;d0<2;++d0)stg[orow*64+d0*32+r32]=__float2bfloat16(o[d0][r]*rli[r]);}
    asm volatile("s_waitcnt lgkmcnt(0)":::"memory");
    #pragma unroll
    for(int i=0;i<4;++i){const int row=i*8+(lane>>3),ch=lane&7; const u32x4 v=*(const u32x4*)(stg+row*64+ch*8); ATTN_STORE16(Ow+(long)row*op+ch*8,v);} }
  asm volatile("s_waitcnt lgkmcnt(0)\n\ts_barrier":::"memory");
  #undef KROW
  #undef DMA_K
  #undef DMA_V
  #undef CMASK
  #undef START
  #undef RESC
  #undef ROT
}
#undef SBAR
#undef WAIT_BAR
}
namespace att128 {
using att64::bf16; using att64::bf16x8; using att64::s16x4; using att64::f32x16; using att64::u32x4; using att64::lds_cptr;
using att64::crow; using att64::glds16; using att64::cvtpk_s; using att64::kload8; using att64::kload2; using att64::vtr; using att64::rowmax; using att64::qkt; using att64::fadd_s; using att64::fsub_s;
typedef float f32x4v __attribute__((ext_vector_type(4)));
constexpr int D=64,NW=8,QBLK=32,KVBLK=64;
constexpr int NSLOT=3, SLOTB=8192;
constexpr int LDS_K=0, LDS_V=NSLOT*SLOTB, LDS_WS=LDS_V+2*NSLOT*SLOTB, LDS_O1=LDS_WS+NW*64*4, LDS_BYTES=LDS_O1+NW*8192;
#define SBAR() __builtin_amdgcn_sched_barrier(0)
#define WAIT_BAR(N) asm volatile("s_waitcnt vmcnt(" #N ") lgkmcnt(0)\n\ts_barrier":::"memory")
__device__ __forceinline__ void pv4(f32x16*o,int vb,bf16x8 pa0,bf16x8 pa1,bf16x8 pa2,bf16x8 pa3){
  #pragma unroll
  for(int d0=0;d0<4;++d0){s16x4 lo[4],hi[4];
    #pragma unroll
    for(int ks=0;ks<4;++ks){
      asm volatile("ds_read_b64_tr_b16 %0,%1 offset:%c2":"=&v"(lo[ks]):"v"(vb),"i"(d0*4096+ks*1024):"memory");
      asm volatile("ds_read_b64_tr_b16 %0,%1 offset:%c2":"=&v"(hi[ks]):"v"(vb),"i"(d0*4096+ks*1024+512):"memory");}
    asm volatile("s_waitcnt lgkmcnt(0)":::"memory");SBAR();
    #define PK(k) (bf16x8){lo[k][0],lo[k][1],lo[k][2],lo[k][3],hi[k][0],hi[k][1],hi[k][2],hi[k][3]}
    o[d0]=__builtin_amdgcn_mfma_f32_32x32x16_bf16(pa0,PK(0),o[d0],0,0,0);
    o[d0]=__builtin_amdgcn_mfma_f32_32x32x16_bf16(pa1,PK(1),o[d0],0,0,0);
    o[d0]=__builtin_amdgcn_mfma_f32_32x32x16_bf16(pa2,PK(2),o[d0],0,0,0);
    o[d0]=__builtin_amdgcn_mfma_f32_32x32x16_bf16(pa3,PK(3),o[d0],0,0,0);
    #undef PK
  }
}
template<int THRL> __device__ __forceinline__ void attn_unit(const bf16*Qu,int qp,const bf16*__restrict__ Kh,const bf16*__restrict__ Vh,int kvp,int NT,int second,float lam,const GAS float*subg,float post,bf16*Ou,int op,char*shm,const int wave0){
  const int lane=lane_now(),r32=lane&31,hi=lane>>5; const int wid=wave0;
  const bf16*Qw=Qu+(long)(wid*QBLK)*qp;
  const unsigned lds0=(unsigned)(uintptr_t)shm;
  float*wsf=(float*)(shm+LDS_WS)+wid*64;
  const bf16*ksrc=Kh+(long)lane*kvp+wid*8;
  const bf16*vsrc=Vh+(long)(16*(wid&3)+(lane>>2))*kvp+(wid>>2)*32+(lane&3)*8;
  const unsigned kdst=lds0+LDS_K+wid*1024, vdst=lds0+LDS_V+wid*1024;
  #define DMA_K(t,slot) glds16(ksrc+(long)((t)*KVBLK)*kvp,(unsigned)__builtin_amdgcn_readfirstlane(kdst+(slot)))
  #define DMA_V(t,slot) do{ glds16(vsrc+(long)((t)*KVBLK)*kvp,(unsigned)__builtin_amdgcn_readfirstlane(vdst+2*(slot))); glds16(vsrc+(long)((t)*KVBLK)*kvp+64,(unsigned)__builtin_amdgcn_readfirstlane(vdst+2*(slot)+8192)); }while(0)
  const int vb0=(int)(lds0+LDS_V)+((lane>>4)&1)*32+(lane&3)*8+(4*hi+((lane&15)>>2))*64;
  const char*Kbase=shm+LDS_K; bf16x8 kf[8];
  const lds_cptr shm3=(lds_cptr)shm; const lds_cptr kp0=shm3+LDS_K+hi*1024+r32*16; const lds_cptr vp0=shm3+LDS_V+((lane>>4)&1)*32+(lane&3)*8+(4*hi+((lane&15)>>2))*64;
  DMA_K(0,0);DMA_V(0,0);DMA_K(1,SLOTB);
  bf16x8 qr[4];
  #pragma unroll
  for(int d0=0;d0<4;++d0)qr[d0]=*reinterpret_cast<const bf16x8*>(&Qw[(long)r32*qp+d0*16+hi*8]);
  float mhat=0.f,l_reg=0.f;f32x16 o[4];o[0]=f32x16{};o[1]=f32x16{};o[2]=f32x16{};o[3]=f32x16{};
  bool resc=false;
  #define START(P0,P1) do{ const float rm=rowmax(P0,P1); resc=false; \
    { const float dl=rm; mhat=fadd_s(mhat,dl); \
      _Pragma("unroll") for(int r=0;r<16;++r){P0[r]=fsub_s(P0[r],dl);P1[r]=fsub_s(P1[r],dl);} \
      } \
    _Pragma("unroll") for(int r=0;r<16;++r)P0[r]=__builtin_amdgcn_exp2f(P0[r]); }while(0)
  #define RESC() do{ if(resc){ asm volatile("s_waitcnt lgkmcnt(0)":::"memory"); \
      _Pragma("unroll") for(int r=0;r<16;++r){ const float f_=wsf[crow(r,hi)]; o[0][r]*=f_;o[1][r]*=f_;o[2][r]*=f_;o[3][r]*=f_; } } }while(0)
  f32x16 pA0,pA1,pB0,pB1;
  int sl_prev=0,sl_cur=0,sl_next=SLOTB;
  #define ROT() do{sl_prev=sl_cur;sl_cur=sl_next;sl_next=(sl_next==(NSLOT-1)*SLOTB)?0:sl_next+SLOTB;}while(0)
  DMA_K(2,2*SLOTB);
  WAIT_BAR(4);
  qkt(pA0,pA1,Kbase,qr,f32x16{},r32,hi);asm volatile("s_nop 15\n\ts_nop 7":"+v"(pA0),"+v"(pA1));
  START(pA0,pA1);
  _Pragma("unroll") for(int r=0;r<16;++r)pA1[r]=__builtin_amdgcn_exp2f(pA1[r]);
  WAIT_BAR(0);
  DMA_K(3,0);DMA_V(1,SLOTB);
  ROT();
  kload8(kf,kp0+sl_cur);
  WAIT_BAR(3);
  s16x4 vlo[16],vhi[16]; u32x4 pw0,pw1,pw2,pw3;
  #define PKW(P,B) cvtpk_s(P[B],P[B+1])
  #define PAF(k) __builtin_bit_cast(bf16x8,pw##k)
  #define VFR(i) (bf16x8){vlo[i][0],vlo[i][1],vlo[i][2],vlo[i][3],vhi[i][0],vhi[i][1],vhi[i][2],vhi[i][3]}
  #define PIN(x) asm volatile("":"+v"(x))
  #define MX3(a,b,c) __builtin_fmaxf(__builtin_fmaxf((a),(b)),(c))
  #define GAPA(MF,A0,A1,A2,A3,W0,W1,PW) do{ MF; sacc+=A0; sacc+=A1; sacc+=A2; sacc+=A3; PIN(sacc); W0; W1; PIN(PW); SBAR(); }while(0)
  #define EX(v) __builtin_amdgcn_exp2f(v)
  #define GAPB(MF,X,B) do{ MF; X[B]=EX(X[B]); X[B+1]=EX(X[B+1]); PIN(X); SBAR(); }while(0)
  #define VRD(n) do{ vlo[n]=vtr(vp_+(((n)&3)*4096+((n)>>2)*1024)); vhi[n]=vtr(vp_+(((n)&3)*4096+((n)>>2)*1024+512)); }while(0)
  #define KRD(G,j) do{ if(G){ kload2(kf,kp0+sl_next,j); SBAR(); } }while(0)
  #define PVM(n,k) o[(n)&3]=__builtin_amdgcn_mfma_f32_32x32x16_bf16(PAF(k),VFR(n),o[(n)&3],0,0,0)
  #define STEP(C0,C1,P0,P1,t,GK,GV,GL) do{ SBAR(); \
    const lds_cptr vp_=vp0+2*sl_prev; \
    VRD(0); SBAR(); float sacc=(P0[0]+P0[1]); \
    GAPA(C0=__builtin_amdgcn_mfma_f32_32x32x16_bf16(kf[0],qr[0],f32x16{},0,0,0), P0[2],P0[3],P0[4],P0[5],     pw0[0]=PKW(P0,0), pw0[1]=PKW(P0,2), pw0); \
    VRD(1); SBAR(); GAPA(C1=__builtin_amdgcn_mfma_f32_32x32x16_bf16(kf[1],qr[0],f32x16{},0,0,0), P0[6],P0[7],P0[8],P0[9],     pw0[2]=PKW(P0,4), pw0[3]=PKW(P0,6), pw0); \
    VRD(2); SBAR(); GAPA(C0=__builtin_amdgcn_mfma_f32_32x32x16_bf16(kf[2],qr[1],C0,0,0,0),   P0[10],P0[11],P0[12],P0[13], pw1[0]=PKW(P0,8), pw1[1]=PKW(P0,10), pw1); \
    VRD(3); SBAR(); GAPA(C1=__builtin_amdgcn_mfma_f32_32x32x16_bf16(kf[3],qr[1],C1,0,0,0),   P0[14],P0[15],P1[0],P1[1],   pw1[2]=PKW(P0,12),pw1[3]=PKW(P0,14), pw1); \
    VRD(4); SBAR(); GAPA(C0=__builtin_amdgcn_mfma_f32_32x32x16_bf16(kf[4],qr[2],C0,0,0,0),   P1[2],P1[3],P1[4],P1[5],     pw2[0]=PKW(P1,0), pw2[1]=PKW(P1,2), pw2); \
    VRD(5); SBAR(); GAPA(C1=__builtin_amdgcn_mfma_f32_32x32x16_bf16(kf[5],qr[2],C1,0,0,0),   P1[6],P1[7],P1[8],P1[9],     pw2[2]=PKW(P1,4), pw2[3]=PKW(P1,6), pw2); \
    VRD(6); SBAR(); GAPA(C0=__builtin_amdgcn_mfma_f32_32x32x16_bf16(kf[6],qr[3],C0,0,0,0),   P1[10],P1[11],P1[12],P1[13], pw3[0]=PKW(P1,8), pw3[1]=PKW(P1,10), pw3); \
    VRD(7); SBAR(); GAPA(C1=__builtin_amdgcn_mfma_f32_32x32x16_bf16(kf[7],qr[3],C1,0,0,0),   P1[14],P1[15],0.f,0.f,       pw3[2]=PKW(P1,12),pw3[3]=PKW(P1,14), pw3); \
    l_reg+=sacc; \
    if(GK){DMA_K((t)+3,sl_cur);} if(GV){DMA_V((t)+1,sl_next);} \
    { float a=MX3(C0[0],C0[1],C1[0]),b=MX3(C0[2],C0[3],C1[1]); a=MX3(a,C1[2],C1[3]); \
      _Pragma("unroll") for(int r=4;r<16;r+=4){a=MX3(a,C0[r],C0[r+1]);b=MX3(b,C0[r+2],C0[r+3]);a=MX3(a,C1[r],C1[r+1]);b=MX3(b,C1[r+2],C1[r+3]);} \
      float rm=__builtin_fmaxf(a,b); { auto rr=__builtin_amdgcn_permlane32_swap(__float_as_uint(rm),__float_as_uint(rm),false,false); rm=__builtin_fmaxf(__uint_as_float(rr[0]),__uint_as_float(rr[1])); } \
      rm-=mhat; \
      resc=false; \
      if(__builtin_expect(__any(rm>(float)THRL),0)){ const float dl=__builtin_fmaxf(rm,0.f); mhat+=dl; \
        const float f=__builtin_amdgcn_exp2f(-dl); l_reg*=f; if(hi==0)wsf[r32]=f; resc=true; } \
      _Pragma("unroll") for(int r=0;r<16;++r){C0[r]-=mhat;C1[r]-=mhat;} } \
    SBAR(); \
    VRD(8);  SBAR(); GAPB(PVM(0,0),C0,0); \
    VRD(9);  SBAR(); GAPB(PVM(1,0),C0,2); \
    VRD(10); SBAR(); GAPB(PVM(2,0),C0,4); \
    VRD(11); SBAR(); GAPB(PVM(3,0),C0,6); \
    VRD(12); SBAR(); GAPB(PVM(4,1),C0,8); \
    VRD(13); SBAR(); GAPB(PVM(5,1),C0,10); \
    VRD(14); SBAR(); GAPB(PVM(6,1),C0,12); \
    VRD(15); SBAR(); GAPB(PVM(7,1),C0,14); \
    KRD(GL,0); GAPB(PVM(8,2),C1,0); \
    KRD(GL,1); GAPB(PVM(9,2),C1,2); \
    KRD(GL,2); GAPB(PVM(10,2),C1,4); \
    KRD(GL,3); GAPB(PVM(11,2),C1,6); \
    GAPB(PVM(12,3),C1,8); \
    GAPB(PVM(13,3),C1,10); \
    GAPB(PVM(14,3),C1,12); \
    GAPB(PVM(15,3),C1,14); \
    }while(0)
  int t=1;
  for(;t+5<NT;t+=2){
    STEP(pB0,pB1,pA0,pA1,t,true,true,true);     WAIT_BAR(3); RESC(); ROT();
    STEP(pA0,pA1,pB0,pB1,t+1,true,true,true);   WAIT_BAR(3); RESC(); ROT();
  }
  #define ENDW(tt) do{ if((tt)+3<NT){WAIT_BAR(3);} else if((tt)+2<NT){WAIT_BAR(2);} else {WAIT_BAR(0);} }while(0)
  for(;t+1<NT;t+=2){
    STEP(pB0,pB1,pA0,pA1,t,(t+3<NT),(t+1<NT),(t+1<NT));       ENDW(t);   RESC(); ROT();
    STEP(pA0,pA1,pB0,pB1,t+1,(t+4<NT),(t+2<NT),(t+2<NT));     ENDW(t+1); RESC(); ROT();
  }
  STEP(pB0,pB1,pA0,pA1,NT-1,false,false,false); RESC();
  { float sacc=pB0[0]+pB0[1]; _Pragma("unroll") for(int r=2;r<16;++r)sacc+=pB0[r]; _Pragma("unroll") for(int r=0;r<16;++r)sacc+=pB1[r]; l_reg+=sacc;
    pw0=(u32x4){PKW(pB0,0),PKW(pB0,2),PKW(pB0,4),PKW(pB0,6)};pw1=(u32x4){PKW(pB0,8),PKW(pB0,10),PKW(pB0,12),PKW(pB0,14)};pw2=(u32x4){PKW(pB1,0),PKW(pB1,2),PKW(pB1,4),PKW(pB1,6)};pw3=(u32x4){PKW(pB1,8),PKW(pB1,10),PKW(pB1,12),PKW(pB1,14)};
    SBAR(); pv4(o,vb0+2*sl_cur,PAF(0),PAF(1),PAF(2),PAF(3)); }
  #undef PKW
  #undef PAF
  #undef VFR
  #undef MX3
  #undef GAPA
  #undef GAPB
  #undef EX
  #undef VRD
  #undef KRD
  #undef PVM
  #undef STEP
  #undef ENDW
  {auto rr=__builtin_amdgcn_permlane32_swap(__float_as_uint(l_reg),__float_as_uint(l_reg),false,false);l_reg=__uint_as_float(rr[0])+__uint_as_float(rr[1]);}
  if(hi==0)wsf[32+r32]=l_reg;asm volatile("s_waitcnt lgkmcnt(0)":::"memory");
  typedef unsigned u32x2v __attribute__((ext_vector_type(2)));
  u32x2v*sp=(u32x2v*)(shm+LDS_O1+wid*8192)+lane;
  if(!second){
    #pragma unroll
    for(int r=0;r<16;++r){ const float rl=__builtin_amdgcn_rcpf(wsf[32+crow(r,hi)]); const u32x2v v={cvtpk_s(o[0][r]*rl,o[1][r]*rl),cvtpk_s(o[2][r]*rl,o[3][r]*rl)}; sp[r*64]=v; }
  } else {
    float g4[4];
    #pragma unroll
    for(int d0=0;d0<4;++d0)g4[d0]=subg[d0*32+r32]*post;
    #pragma unroll
    for(int r=0;r<16;++r){ const float rl=__builtin_amdgcn_rcpf(wsf[32+crow(r,hi)])*lam; const u32x2v av=sp[r*64];
      const float a0=__uint_as_float(av[0]<<16),a1=__uint_as_float(av[0]&0xffff0000u),a2=__uint_as_float(av[1]<<16),a3=__uint_as_float(av[1]&0xffff0000u);
      float v0=a0-o[0][r]*rl,v1=a1-o[1][r]*rl,v2=a2-o[2][r]*rl,v3=a3-o[3][r]*rl; float ss=(v0*v0+v1*v1)+(v2*v2+v3*v3);
      ss+=__shfl_xor(ss,1);ss+=__shfl_xor(ss,2);ss+=__shfl_xor(ss,4);ss+=__shfl_xor(ss,8);ss+=__shfl_xor(ss,16);
      const float rn=__builtin_amdgcn_rsqf(ss*(1.0f/128.0f)+1e-6f);
      o[0][r]=v0*rn*g4[0];o[1][r]=v1*rn*g4[1];o[2][r]=v2*rn*g4[2];o[3][r]=v3*rn*g4[3]; }
    bf16*Ow=Ou+(long)(wid*QBLK)*op;
    bf16*stg=(bf16*)(shm+LDS_O1+wid*8192);
    asm volatile("s_waitcnt lgkmcnt(0)":::"memory");
    #pragma unroll
    for(int r=0;r<16;++r){const int orow=crow(r,hi);
      #pragma unroll
      for(int d0=0;d0<4;++d0)stg[orow*128+d0*32+r32]=__float2bfloat16(o[d0][r]);}
    asm volatile("s_waitcnt lgkmcnt(0)":::"memory");
    #pragma unroll
    for(int i=0;i<8;++i){const int row=i*4+(lane>>4),ch=lane&15; const u32x4 v=*(const u32x4*)(stg+row*128+ch*8); ATTN_STORE16(Ow+(long)row*op+ch*8,v);}
  }
  asm volatile("s_waitcnt lgkmcnt(0)\n\ts_barrier":::"memory");
  #undef PIN
  #undef DMA_K
  #undef DMA_V
  #undef START
  #undef RESC
  #undef ROT
}
#undef SBAR
#undef WAIT_BAR
}

typedef unsigned short bf16;
typedef float f32x4 __attribute__((ext_vector_type(4)));
typedef unsigned u32x4 __attribute__((ext_vector_type(4)));
typedef unsigned u32x2 __attribute__((ext_vector_type(2)));
constexpr int D = 1024, NBATCH = 4, SEQ = 4096, CTXL = 256, DEPTH = 2;
constexpr int MLAT = NBATCH * SEQ, MCTX = NBATCH * CTXL, MTOT = MLAT + MCTX;
constexpr int KVR = SEQ + CTXL;
constexpr int NIN = 6144, NE = 32, TOPK = 4, NWAVES = 8;
constexpr int MAXTILES = 304;
constexpr float EPS = 1e-6f;

constexpr size_t al256(size_t x) { return (x + 255) / 256 * 256; }
constexpr size_t WS_CTL = 0, CTL_BYTES = 1u << 20;
constexpr size_t WS_MOD = WS_CTL + CTL_BYTES;
constexpr size_t WS_ROPEC = WS_MOD + al256((size_t)DEPTH * 5 * NIN * 4);
constexpr size_t WS_ROPES = WS_ROPEC + 4096;
constexpr size_t WS_LAM = WS_ROPES + 4096;
constexpr size_t WS_PV = WS_LAM + 256;
constexpr size_t WS_WIN = WS_PV + (size_t)DEPTH * 5 * 4 * D * 4;
constexpr size_t WS_WB = WS_WIN + (size_t)DEPTH * NIN * D * 2;
constexpr size_t WS_WO = WS_WB + (size_t)DEPTH * 3 * D * 512 * 2;
constexpr size_t WS_W1 = WS_WO + (size_t)DEPTH * D * D * 2;
constexpr size_t WS_W2 = WS_W1 + (size_t)DEPTH * NE * 2048 * D * 2;
constexpr size_t WS_X = WS_W2 + (size_t)DEPTH * NE * D * D * 2;
constexpr size_t WS_H = WS_X + (size_t)MTOT * D * 4;
constexpr size_t WS_QA = WS_H + (size_t)MTOT * D * 2;
constexpr size_t WS_QB = WS_QA + (size_t)MTOT * 512 * 2;
constexpr size_t WS_QC = WS_QB + (size_t)MTOT * 512 * 2;
constexpr size_t WS_KA = WS_QC + (size_t)MTOT * 512 * 2;
constexpr size_t WS_VA = WS_KA + (size_t)NBATCH * KVR * 512 * 2;
constexpr size_t WS_KB = WS_VA + (size_t)NBATCH * KVR * 512 * 2;
constexpr size_t WS_VB = WS_KB + (size_t)NBATCH * KVR * 128 * 2;
constexpr size_t WS_KC = WS_VB + (size_t)NBATCH * KVR * 128 * 2;
constexpr size_t WS_VC = WS_KC + (size_t)NBATCH * KVR * 128 * 2;
constexpr size_t WS_GT = WS_VC + (size_t)NBATCH * KVR * 128 * 2;
constexpr size_t WS_YS = WS_GT + (size_t)MTOT * 3072 * 2;
constexpr size_t WS_TMP = WS_YS + (size_t)3 * MTOT * 512 * 2;
constexpr size_t WS_MG = WS_TMP + (size_t)MTOT * D * 4;
constexpr size_t WS_Y = WS_MG + (size_t)MTOT * D * 2;
constexpr size_t WS_H2 = WS_Y + (size_t)MTOT * D * 4;
constexpr size_t WS_SE = WS_H2 + (size_t)MTOT * D * 2;
constexpr size_t WS_SR = WS_SE + (size_t)MTOT * 4 * 4;
constexpr size_t WS_SW = WS_SR + (size_t)MTOT * 4 * 4;
constexpr size_t WS_LIST = WS_SW + (size_t)MTOT * 4 * 4;
constexpr size_t WS_ACT = WS_LIST + (size_t)NE * MTOT * 4;
constexpr size_t WS_YS2 = WS_ACT + (size_t)MAXTILES * 256 * D * 2;
constexpr size_t WS_EX = WS_YS2 + (size_t)MAXTILES * 256 * D * 2;
constexpr size_t WS_END = WS_EX + (size_t)DEPTH * 256 * 131072;
static_assert(WS_WIN % 256 == 0 && WS_X % 256 == 0 && WS_SE % 256 == 0 && WS_ACT % 256 == 0, "alignment");

constexpr int CW_BAR = 4096;
constexpr int CW_Q = 16384;
constexpr int CW_CNT = 8192;

constexpr int RING_BYTES = 141312, MISC_OFF = RING_BYTES, TAB_OFF = MISC_OFF + 8192, LDS_BYTES = TAB_OFF + 8192 + 512;
constexpr int MW_Q = 12; constexpr int MW_BAR = 0, MW_TB = 16, MW_CNT = 64, MW_HIST = 128, MW_BASE = 160, MW_PT = 192, MW_SLOT = 256;

#define LDS_WAIT() asm volatile("s_waitcnt lgkmcnt(0)" ::: "memory")
#define VM_WAIT() asm volatile("s_waitcnt vmcnt(0)" ::: "memory")
__device__ __forceinline__ unsigned f2bf(float f) { unsigned u = __builtin_bit_cast(unsigned, f); return (u + 0x7fffu + ((u >> 16) & 1u)) >> 16; }
typedef float f32x2_t __attribute__((ext_vector_type(2))); typedef __bf16 bf16x2_t __attribute__((ext_vector_type(2)));
__device__ __forceinline__ unsigned pk2(float lo, float hi) { const f32x2_t v = {lo, hi}; const bf16x2_t b = __builtin_convertvector(v, bf16x2_t); return __builtin_bit_cast(unsigned, b); }
__device__ __forceinline__ unsigned pk4f8(float a, float b, float c, float d) {
    int r = __builtin_amdgcn_cvt_pk_fp8_f32(a, b, 0, false); r = __builtin_amdgcn_cvt_pk_fp8_f32(c, d, r, true); return (unsigned)r; }
constexpr float W8_SCALE = 64.0f, W8_INV = 1.0f / 64.0f;
__device__ __forceinline__ float bflo(unsigned w) { return __builtin_bit_cast(float, w << 16); }
__device__ __forceinline__ float bfhi(unsigned w) { return __builtin_bit_cast(float, w & 0xffff0000u); }
template <int CTRL> __device__ __forceinline__ float dppf(float v) { return __builtin_bit_cast(float, __builtin_amdgcn_update_dpp(0, __builtin_bit_cast(int, v), CTRL, 0xf, 0xf, true)); }
template <int CTRL> __device__ __forceinline__ int dppi(int v) { return __builtin_amdgcn_update_dpp(0, v, CTRL, 0xf, 0xf, true); }
__device__ __forceinline__ float rdl(float v, int l) { return __builtin_bit_cast(float, __builtin_amdgcn_readlane(__builtin_bit_cast(int, v), l)); }
__device__ __forceinline__ float wave_sum(float v) {
    v += dppf<0xB1>(v); v += dppf<0x4E>(v); v += dppf<0x141>(v); v += dppf<0x140>(v);
    return (rdl(v, 0) + rdl(v, 16)) + (rdl(v, 32) + rdl(v, 48));
}
__device__ __forceinline__ float sigmoid255_(float x) { return __builtin_amdgcn_rcpf(__builtin_fmaf(__builtin_amdgcn_exp2f(-1.4426950408889634f * x), 1.0f / 255.0f, 1.0f / 255.0f)); }
__device__ __forceinline__ float sigmoidf_(float x) { return __builtin_amdgcn_rcpf(1.0f + __builtin_amdgcn_exp2f(-1.4426950408889634f * x)); }

__device__ __forceinline__ unsigned char* ldp(volatile LAS unsigned* MISC, int i) {
    const unsigned lo = (unsigned)__builtin_amdgcn_readfirstlane((int)MISC[MW_PT + 2 * i]), hi = (unsigned)__builtin_amdgcn_readfirstlane((int)MISC[MW_PT + 2 * i + 1]);
    return (unsigned char*)(((unsigned long long)hi << 32) | lo);
}
typedef const GAS float* gcfp; typedef GAS float* gfp; typedef const GAS unsigned short* gcbp; typedef GAS unsigned short* gbp;
#define INP(i) ((const GAS float*)ldp(MISC, (i)))
#define WSP(T, off) ((GAS T*)(ldp(MISC, 21) + (off)))
#define XB_TMO      128
#define XB_XCNT(j)  (256  + 64 * (j))
#define XB_XSUB(j)  (1280 + 64 * (j))
#define XB_XGEN(j)  (2304 + 64 * (j))
#define XB_TOP      3328
#define XB_TOPGEN   3392
#define XCD_BAR_WORDS 3456
#define XB_SPIN_CAP (1u << 18)

__device__ __forceinline__ unsigned xb_ld(unsigned* p)              { return __hip_atomic_load(p, __ATOMIC_RELAXED, __HIP_MEMORY_SCOPE_AGENT); }
__device__ __forceinline__ unsigned xb_add(unsigned* p, unsigned v) { return __hip_atomic_fetch_add(p, v, __ATOMIC_RELAXED, __HIP_MEMORY_SCOPE_AGENT); }
__device__ __forceinline__ unsigned xb_xcc_id() { return (unsigned)__builtin_amdgcn_s_getreg((3 << 11) | 20) & 0xFu; }
#define XB_SPIN(cond, bar) do { unsigned _sp = 0; while (cond) { __builtin_amdgcn_s_sleep(1); \
    if ((++_sp & 255u) == 0u) { if (xb_ld(&(bar)[XB_TMO])) break; if (_sp > XB_SPIN_CAP) { atomicAdd(&(bar)[XB_TMO], 1u); break; } } } } while (0)

struct XcdBarrier {
    unsigned* bar; unsigned x;
    volatile LAS unsigned* st;
};

__device__ __forceinline__ XcdBarrier xcd_barrier_post(unsigned* bar, volatile LAS unsigned* st) {
    XcdBarrier b; b.bar = bar; b.x = xb_xcc_id(); b.st = st;
    if (threadIdx.x == 0) (void)xb_add(&bar[XB_XCNT(b.x)], 1u);
    return b;
}
__device__ __forceinline__ void xcd_barrier_complete(unsigned* bar, unsigned x, unsigned& nloc, unsigned& nx) {
    const unsigned G = gridDim.x * gridDim.y * gridDim.z;
    unsigned sum, cnt, mine, sp = 0u;
    for (;;) {
        sum = 0u; cnt = 0u; mine = 0u;
#pragma unroll
        for (unsigned j = 0; j < 16; ++j) { const unsigned c = xb_ld(&bar[XB_XCNT(j)]); sum += c; cnt += (c > 0u) ? 1u : 0u; mine = (j == x) ? c : mine; }
        if (sum == G) break;
        __builtin_amdgcn_s_sleep(1);
        if ((++sp & 255u) == 0u) { if (xb_ld(&bar[XB_TMO])) break; if (sp > XB_SPIN_CAP) { atomicAdd(&bar[XB_TMO], 1u); break; } }
    }
    nloc = mine > 0u ? mine : 1u; nx = cnt > 0u ? cnt : 1u;
}

__device__ __forceinline__ void xcd_barrier(const XcdBarrier& b, const int tid_now) {
    asm volatile("s_waitcnt vmcnt(0)" ::: "memory");
    __syncthreads();
    if (tid_now == 0) {
        unsigned long long bp_ = (unsigned long long)b.bar; asm volatile("" : "+s"(bp_)); unsigned* bar = (unsigned*)bp_;
        unsigned bx_ = b.x; asm volatile("" : "+s"(bx_));
        __builtin_amdgcn_s_waitcnt(0);
        unsigned nloc = b.st[0], nx = b.st[1];
        if (nloc == 0u) { xcd_barrier_complete(bar, bx_, nloc, nx); b.st[0] = nloc; b.st[1] = nx; }
        const unsigned old = xb_add(&bar[XB_XSUB(bx_)], 1u);
        const unsigned gen = old / nloc;
        if (old + 1u == (gen + 1u) * nloc) {
            __builtin_amdgcn_fence(__ATOMIC_RELEASE, "agent");
            asm volatile("s_waitcnt vmcnt(0)" ::: "memory");
            const unsigned og = xb_add(&bar[XB_TOP], 1u);
            const unsigned tg = og / nx;
            if (og + 1u == (tg + 1u) * nx) xb_add(&bar[XB_TOPGEN], 1u);
            else XB_SPIN(xb_ld(&bar[XB_TOPGEN]) == tg, bar);
            __builtin_amdgcn_fence(__ATOMIC_ACQUIRE, "agent");
            xb_add(&bar[XB_XGEN(bx_)], 1u);
            asm volatile("s_waitcnt vmcnt(0)" ::: "memory");
        } else {
            XB_SPIN(xb_ld(&bar[XB_XGEN(bx_)]) == gen, bar);
            __builtin_amdgcn_fence(__ATOMIC_ACQUIRE, "agent");
            asm volatile("s_waitcnt vmcnt(0)" ::: "memory");
        }
    }
    __syncthreads();
}

using pg8::Unit;
__host__ __device__ __forceinline__ int in_src_col(int nbd) {
    const int pn = nbd >> 3, blk = nbd & 7, bj = blk >> 2, wc = blk & 3;
    if (pn <= 8) { const int hs = pn * 4 + wc; int base;
        if (hs < 8) base = hs * 64; else if (hs < 16) base = 512 + (hs - 8) * 64; else if (hs < 24) base = 1536 + (hs - 16) * 64;
        else if (hs < 32) base = 2304 + (hs - 24) * 64; else if (hs < 34) base = 2048 + (hs - 32) * 64; else base = 2816 + (hs - 34) * 64;
        return base + 32 * bj; }
    if (pn <= 10) return 1024 + (pn - 9) * 256 + blk * 32;
    if (pn == 11) return blk < 4 ? 2176 + blk * 32 : 2944 + (blk - 4) * 32;
    return 3072 + (pn - 12) * 256 + blk * 32;
}
struct EpiInproj {
    static constexpr bool PERM = false;
    volatile LAS unsigned* MISC; int l;
    __device__ __forceinline__ void operator()(const f32x4 (&acc)[2][2][4][2], const Unit& u, int wr, int wc, int fr, int fq) const {
        auto QA = WSP(bf16, WS_QA); auto QB = WSP(bf16, WS_QB); auto QC = WSP(bf16, WS_QC); auto KA = WSP(bf16, WS_KA); auto VA = WSP(bf16, WS_VA);
        auto KB = WSP(bf16, WS_KB); auto VB = WSP(bf16, WS_VB); auto KC = WSP(bf16, WS_KC); auto VC = WSP(bf16, WS_VC); auto GT = WSP(bf16, WS_GT);
        const LAS float* ropec = (const LAS float*)MISC + (TAB_OFF - MISC_OFF) / 4; const LAS float* ropes = ropec + 1024; const LAS float* qkg = ropec + 2048;
        const int pn = u.pn; const bool ctx = u.pm >= (MLAT / 256);
#pragma unroll
        for (int ai = 0; ai < 2; ++ai)
#pragma unroll
            for (int m = 0; m < 4; ++m) {
                const int r = u.pm * 256 + ai * 128 + wr * 64 + m * 16 + fr;
                int kvrow, t = 0;
                if (!ctx) { t = r & (SEQ - 1); kvrow = (r >> 12) * KVR + t; } else { const int rr = r - MLAT; kvrow = (rr >> 8) * KVR + SEQ + (rr & 255); }
                if (pn <= 8) {
                    f32x4 v[2][2];
#pragma unroll
                    for (int bj = 0; bj < 2; ++bj)
#pragma unroll
                        for (int n = 0; n < 2; ++n) v[bj][n] = acc[ai][bj][m][n];
                    const int hs = pn * 4 + wc;
                    const bool isbq = (pn == 4 || pn == 5), isbk = (pn == 8 && wc < 2);
                    if (isbq || isbk) {
                        const f32x4 sq = (v[0][0] * v[0][0] + v[0][1] * v[0][1]) + (v[1][0] * v[1][0] + v[1][1] * v[1][1]);
                        float ss = (sq[0] + sq[1]) + (sq[2] + sq[3]);
                        ss += __shfl_xor(ss, 16); ss += __shfl_xor(ss, 32);
                        const float rn = __builtin_amdgcn_rsqf(ss * (1.0f / 64.0f) + EPS);
                        const LAS float* g = qkg + (isbk ? 64 : 0);
#pragma unroll
                        for (int bj = 0; bj < 2; ++bj)
#pragma unroll
                            for (int n = 0; n < 2; ++n) { const f32x4 gv = *(const LAS f32x4*)(g + 32 * bj + 16 * n + 4 * fq); v[bj][n] = v[bj][n] * (gv * rn); }
                    }
                    if (!ctx) {
#pragma unroll
                        for (int bj = 0; bj < 2; ++bj) { const int pos = bj ? (t & 63) : (t >> 6);
                            const f32x4 cs = *(const LAS f32x4*)(ropec + pos * 16 + 4 * fq), sn = *(const LAS f32x4*)(ropes + pos * 16 + 4 * fq);
                            const f32x4 x0 = v[bj][0], x1 = v[bj][1]; v[bj][0] = x0 * cs - x1 * sn; v[bj][1] = x1 * cs + x0 * sn; }
                    }
                    if (isbq || pn == 6 || pn == 7 || (pn < 2 && !ctx)) {
#pragma unroll
                        for (int bj = 0; bj < 2; ++bj)
#pragma unroll
                            for (int n = 0; n < 2; ++n) v[bj][n] = v[bj][n] * att64::C2; }
                    gbp dst;
                    if (pn < 2) dst = QA + (size_t)r * 512 + hs * 64;
                    else if (pn < 4) dst = KA + (size_t)kvrow * 512 + (hs - 8) * 64;
                    else if (pn < 6) dst = QB + (size_t)r * 512 + (hs - 16) * 64;
                    else if (pn < 8) dst = QC + (size_t)r * 512 + (hs - 24) * 64;
                    else if (wc < 2) dst = KB + (size_t)kvrow * 128 + wc * 64;
                    else dst = KC + (size_t)kvrow * 128 + (wc - 2) * 64;
#pragma unroll
                    for (int bj = 0; bj < 2; ++bj) { u32x4 w; w.x = pk2(v[bj][0][0], v[bj][0][1]); w.y = pk2(v[bj][0][2], v[bj][0][3]); w.z = pk2(v[bj][1][0], v[bj][1][1]); w.w = pk2(v[bj][1][2], v[bj][1][3]);
                        *(GAS u32x4*)(dst + 32 * bj + 8 * fq) = w; }
                } else if (pn <= 11) {
#pragma unroll
                    for (int bj = 0; bj < 2; ++bj) { const int c = 128 * bj + 32 * wc + 8 * fq; const f32x4 x = acc[ai][bj][m][0], y = acc[ai][bj][m][1];
                            gbp dst = (pn < 11) ? VA + (size_t)kvrow * 512 + (pn - 9) * 256 + c : ((bj == 0) ? VB : VC) + (size_t)kvrow * 128 + (c & 127);
                            u32x4 w; w.x = pk2(x[0], x[1]); w.y = pk2(x[2], x[3]); w.z = pk2(y[0], y[1]); w.w = pk2(y[2], y[3]); *(GAS u32x4*)dst = w; }
                } else {
#pragma unroll
                    for (int bj = 0; bj < 2; ++bj) { const int c = 128 * bj + 32 * wc + 8 * fq; const f32x4 x = acc[ai][bj][m][0], y = acc[ai][bj][m][1];
                            u32x2 w = {0u, 0u};
                            typedef float f32x2e __attribute__((ext_vector_type(2))); const f32x2e nl2 = {-1.4426950408889634f, -1.4426950408889634f}, i255 = {1.0f / 255.0f, 1.0f / 255.0f};
#pragma unroll
                            for (int j = 0; j < 4; ++j) {
                                f32x2e t = (f32x2e){x[j], y[j]} * nl2; t[0] = __builtin_amdgcn_exp2f(t[0]); t[1] = __builtin_amdgcn_exp2f(t[1]); t = __builtin_elementwise_fma(t, i255, i255);
                                w.x = __builtin_amdgcn_cvt_pk_u8_f32(__builtin_amdgcn_rcpf(t[0]), (unsigned)j, w.x); w.y = __builtin_amdgcn_cvt_pk_u8_f32(__builtin_amdgcn_rcpf(t[1]), (unsigned)j, w.y); }
                            *(GAS u32x2*)((GAS unsigned char*)GT + (size_t)r * 3072 + (pn - 12) * 256 + c) = w; }
                }
            }
    }
};

#if defined(EPIDUP_INPROJ)
namespace pg8 { template <> struct epi_dup<::EpiInproj> { static constexpr int v = 1; }; }
#endif
struct MergeOrder {
    int ntiles, G, vcu;
    __device__ __forceinline__ bool next(int i, Unit& u) const { const int rnd = i / 3, sub = i - rnd * 3; const int tl = rnd * G + vcu; if (tl >= ntiles) return false;
        u.pm = sub * (MTOT / 256) + (tl >> 2); u.pn = sub * 4 + (tl & 3); return true; }
    __device__ __forceinline__ unsigned a_row(const Unit&, int) const { return 0u; }
};
struct EpiMerge {
    static constexpr bool PERM = true;
    volatile LAS unsigned* MISC;
    __device__ __forceinline__ bool keep(const Unit& u) const { return (u.pn >> 2) < 2; }
    __device__ __forceinline__ void operator()(f32x4 (&acc)[2][2][4][2], const Unit& u, int wr, int wc, int fr, int fq) const {
        const auto GT = WSP(bf16, WS_GT); auto MG = WSP(bf16, WS_MG);
        const int sub = u.pn >> 2, pnr = u.pn & 3, pmr = u.pm - sub * (MTOT / 256);
        constexpr float GMIN = 1e-24f;
        const int subn = sub < 2 ? sub + 1 : sub;
        const GAS unsigned char* gbase = (const GAS unsigned char*)GT + ((size_t)pmr * 256 + wr * 64 + fr) * 3072 + pnr * 256 + wc * 32 + 8 * fq;
        u32x2 gw[2][4][2], gn[2][4][2];
#pragma unroll
        for (int ai = 0; ai < 2; ++ai)
#pragma unroll
            for (int m = 0; m < 4; ++m)
#pragma unroll
                for (int bj = 0; bj < 2; ++bj) { const GAS unsigned char* p = gbase + (size_t)(ai * 128 + m * 16) * 3072 + bj * 128;
                    gw[ai][m][bj] = *(const GAS u32x2*)(p + sub * 1024); gn[ai][m][bj] = *(const GAS u32x2*)(p + subn * 1024); }
        const float nmin = sub > 0 ? GMIN : 0.0f;
        const bool last = sub == 2;
#pragma unroll
        for (int ai = 0; ai < 2; ++ai)
#pragma unroll
            for (int m = 0; m < 4; ++m)
#pragma unroll
                for (int bj = 0; bj < 2; ++bj) {
                    const u32x2 a = gw[ai][m][bj], b = gn[ai][m][bj];
                    float g[8] = {(float)(a.x & 0xffu), (float)((a.x >> 8) & 0xffu), (float)((a.x >> 16) & 0xffu), (float)(a.x >> 24), (float)(a.y & 0xffu), (float)((a.y >> 8) & 0xffu), (float)((a.y >> 16) & 0xffu), (float)(a.y >> 24)};
                    const float d[8] = {(float)(b.x & 0xffu), (float)((b.x >> 8) & 0xffu), (float)((b.x >> 16) & 0xffu), (float)(b.x >> 24), (float)(b.y & 0xffu), (float)((b.y >> 8) & 0xffu), (float)((b.y >> 16) & 0xffu), (float)(b.y >> 24)};
                    float rr[8];
#pragma unroll
                    for (int k = 0; k < 8; ++k) { g[k] = fmaxf(g[k], nmin); rr[k] = last ? (1.0f / 255.0f) : __builtin_amdgcn_rcpf(fmaxf(d[k], GMIN)); }
                    const f32x4 G0 = (f32x4){g[0], g[1], g[2], g[3]} * (f32x4){rr[0], rr[1], rr[2], rr[3]}, G1 = (f32x4){g[4], g[5], g[6], g[7]} * (f32x4){rr[4], rr[5], rr[6], rr[7]};
                    acc[ai][bj][m][0] = acc[ai][bj][m][0] * G0; acc[ai][bj][m][1] = acc[ai][bj][m][1] * G1; }
        if (last) {
#pragma unroll
            for (int ai = 0; ai < 2; ++ai)
#pragma unroll
                for (int m = 0; m < 4; ++m) { const size_t row = (size_t)pmr * 256 + ai * 128 + wr * 64 + m * 16 + fr;
#pragma unroll
                    for (int bj = 0; bj < 2; ++bj) { const int col = pnr * 256 + bj * 128 + wc * 32 + 8 * fq; const f32x4 v0 = acc[ai][bj][m][0], v1 = acc[ai][bj][m][1];
                        u32x4 w; w.x = pk2(v0[0], v0[1]); w.y = pk2(v0[2], v0[3]); w.z = pk2(v1[0], v1[1]); w.w = pk2(v1[2], v1[3]); *(GAS u32x4*)(MG + row * 1024 + col) = w; } }
        }
    }
};
namespace pg8 { template <> struct epi_chain<::EpiMerge> { static constexpr bool v = true; }; }
struct EpiOut {
    static constexpr bool PERM = true;
    volatile LAS unsigned* MISC;
    __device__ __forceinline__ void operator()(const f32x4 (&acc)[2][2][4][2], const Unit& u, int wr, int wc, int fr, int fq) const {
        auto Y = WSP(bf16, WS_Y);
#pragma unroll
        for (int ai = 0; ai < 2; ++ai)
#pragma unroll
            for (int m = 0; m < 4; ++m) { gbp rowp = Y + ((size_t)u.pm * 256 + ai * 128 + wr * 64 + m * 16 + fr) * 1024 + u.pn * 256 + wc * 32 + 8 * fq;
#pragma unroll
                for (int bj = 0; bj < 2; ++bj) { const f32x4 v0 = acc[ai][bj][m][0], v1 = acc[ai][bj][m][1];
                    u32x4 w; w.x = pk2(v0[0], v0[1]); w.y = pk2(v0[2], v0[3]); w.z = pk2(v1[0], v1[1]); w.w = pk2(v1[2], v1[3]); *(GAS u32x4*)(rowp + bj * 128) = w; } }
    }
};
template <int NP> struct MoeOrder {
    const LAS int* tb; const LAS int* cn; const GAS int* list; int G, bid, vcu, U, chunk, per;
    __device__ __forceinline__ void init(const LAS int* tb_, const LAS int* cn_, const GAS int* list_, int G_, int bid_) {
        tb = tb_; cn = cn_; list = list_; G = G_; bid = bid_; U = tb_[NE] * NP;
        if (G_ % 8 == 0) { per = G_ / 8; vcu = (bid_ % 8) * per + bid_ / 8; chunk = (U + 7) / 8; } else { per = G_; vcu = bid_; chunk = U; }
    }
    __device__ __forceinline__ bool next(int i, Unit& u) const {
        const int x = vcu / per, j = i * per + (vcu % per); if (j >= chunk) return false;
        const int id = x * chunk + j; if (id >= U) return false;
        const int T = id / NP, pnl = id - T * NP; int e = 0;
#pragma unroll
        for (int q = 1; q < NE; ++q) e += (T >= tb[q]) ? 1 : 0;
        e = __builtin_amdgcn_readfirstlane(e);
        u.pm = T; u.pn = e * NP + pnl; return true;
    }
    __device__ __forceinline__ unsigned a_row(const Unit& u, int r) const {
        const int e = u.pn / NP; int idx = (u.pm - tb[e]) * 256 + r; const int c = cn[e]; idx = idx < c ? idx : c - 1;
        return (unsigned)list[(size_t)e * MTOT + idx];
    }
};
template <bool F8> struct EpiSwiglu {
    static constexpr bool PERM = true;
    volatile LAS unsigned* MISC; int l;
    __device__ __forceinline__ void operator()(const f32x4 (&acc)[2][2][4][2], const Unit& u, int wr, int wc, int fr, int fq) const {
        auto ACT = WSP(bf16, WS_ACT); auto b1 = INP(17) + (size_t)l * NE * 2048;
        const int e = u.pn >> 3, pnl = u.pn & 7; const int col = pnl * 128 + wc * 32 + 8 * fq;
        gcfp bg = b1 + (size_t)e * 2048 + col; gcfp bu = bg + 1024;
        typedef float f32x2e __attribute__((ext_vector_type(2)));
        const f32x4 bg0 = *(const GAS f32x4*)bg, bg1 = *(const GAS f32x4*)(bg + 4), bu0 = *(const GAS f32x4*)bu + 1.0f, bu1 = *(const GAS f32x4*)(bu + 4) + 1.0f;
        constexpr float SC = F8 ? W8_INV : 1.0f; const f32x2e sc2 = {SC, SC}, kx2 = {-1.702f * 1.4426950408889634f, -1.702f * 1.4426950408889634f}, one2 = {1.0f, 1.0f};
#pragma unroll
        for (int ai = 0; ai < 2; ++ai)
#pragma unroll
            for (int m = 0; m < 4; ++m) { const size_t row = (size_t)u.pm * 256 + ai * 128 + wr * 64 + m * 16 + fr;
                float a[8];
#pragma unroll
                for (int n = 0; n < 2; ++n)
#pragma unroll
                    for (int j = 0; j < 4; j += 2) { const f32x4 ag = acc[ai][0][m][n], au = acc[ai][1][m][n]; const f32x4 bgv = n ? bg1 : bg0, buv = n ? bu1 : bu0;
                        f32x2e gt = __builtin_elementwise_fma((f32x2e){ag[j], ag[j + 1]}, sc2, (f32x2e){bgv[j], bgv[j + 1]}), up = __builtin_elementwise_fma((f32x2e){au[j], au[j + 1]}, sc2, (f32x2e){buv[j], buv[j + 1]});
                        gt[0] = fminf(gt[0], 7.0f); gt[1] = fminf(gt[1], 7.0f); up[0] = fminf(fmaxf(up[0], -6.0f), 8.0f); up[1] = fminf(fmaxf(up[1], -6.0f), 8.0f);
                        f32x2e t = gt * kx2; t[0] = __builtin_amdgcn_exp2f(t[0]); t[1] = __builtin_amdgcn_exp2f(t[1]); t = t + one2; t[0] = __builtin_amdgcn_rcpf(t[0]); t[1] = __builtin_amdgcn_rcpf(t[1]);
                        const f32x2e r = up * (gt * t);
                        a[n * 4 + j] = r[0]; a[n * 4 + j + 1] = r[1]; }
                if constexpr (F8) { u32x2 w; w.x = pk4f8(a[0], a[1], a[2], a[3]); w.y = pk4f8(a[4], a[5], a[6], a[7]); *(GAS u32x2*)((GAS unsigned char*)ACT + row * 1024 + col) = w; }
                else { u32x4 w; w.x = pk2(a[0], a[1]); w.y = pk2(a[2], a[3]); w.z = pk2(a[4], a[5]); w.w = pk2(a[6], a[7]);
                *(GAS u32x4*)(ACT + row * 1024 + col) = w; } }
    }
};
#if defined(EPIDUP_MOE1)
namespace pg8 { template <> struct epi_dup<::EpiSwiglu<true>> { static constexpr int v = 1; }; }
#endif
template <bool F8> struct EpiMoe2 {
    static constexpr bool PERM = true;
    volatile LAS unsigned* MISC; int l;
    __device__ __forceinline__ void operator()(const f32x4 (&acc)[2][2][4][2], const Unit& u, int wr, int wc, int fr, int fq) const {
        auto YS2 = WSP(bf16, WS_YS2); auto b2 = INP(19) + (size_t)l * NE * D;
        const int e = u.pn >> 2, pnl = u.pn & 3;
        f32x4 cb[2][2];
#pragma unroll
        for (int bj = 0; bj < 2; ++bj) { const int col = pnl * 256 + bj * 128 + wc * 32 + 8 * fq; cb[bj][0] = *(const GAS f32x4*)(b2 + (size_t)e * 1024 + col); cb[bj][1] = *(const GAS f32x4*)(b2 + (size_t)e * 1024 + col + 4); }
#pragma unroll
        for (int bj = 0; bj < 2; ++bj) { const int col = pnl * 256 + bj * 128 + wc * 32 + 8 * fq;
            const f32x4 c0 = cb[bj][0], c1 = cb[bj][1];
#pragma unroll
            for (int ai = 0; ai < 2; ++ai)
#pragma unroll
                for (int m = 0; m < 4; ++m) { const size_t row = (size_t)u.pm * 256 + ai * 128 + wr * 64 + m * 16 + fr;
                    constexpr float SC = F8 ? W8_INV : 1.0f; const f32x4 v0 = acc[ai][bj][m][0] * SC + c0, v1 = acc[ai][bj][m][1] * SC + c1;
                    u32x4 w; w.x = pk2(v0[0], v0[1]); w.y = pk2(v0[2], v0[3]); w.z = pk2(v1[0], v1[1]); w.w = pk2(v1[2], v1[3]);
                    *(GAS u32x4*)(YS2 + row * 1024 + col) = w; } }
    }
};

#if defined(EPIDUP_MOE2)
namespace pg8 { template <> struct epi_dup<::EpiMoe2<true>> { static constexpr int v = 1; }; }
#endif

struct Args { const float* in[20]; float* out; unsigned char* ws; int ph_lo, ph_hi; };

#ifndef MOE_F8_FROM
#define MOE_F8_FROM 0
#endif
__device__ __forceinline__ int sgpr_launder(int x) { asm volatile("" : "+s"(x)); return x; }
#ifndef CVT_SH2
#define CVT_SH2 38
#define CVT_SH4 12
#endif
#ifndef CVT_SH1
#define CVT_SH1 26
#endif
#ifndef CVT_SH6
#define CVT_SH6 4
#endif
#ifndef CVT_SH5
#define CVT_SH5 4
#endif
struct CvtItem { gcfp W; gbp WT; int N, k0, n0, Kd, rowd, f8; };
__device__ __forceinline__ void cvt_load(const CvtItem& I, int lane, float (&v)[32]) {
    const GAS char* base = (const GAS char*)(I.W + (size_t)I.k0 * I.N + I.n0);
    unsigned off = (unsigned)((lane >> 3) * I.N + 4 * (lane & 7)) * 4u; const unsigned step = (unsigned)I.N * 32u;
#pragma unroll
    for (int i = 0; i < 8; ++i) { const f32x4 t = __builtin_nontemporal_load((const GAS f32x4*)(base + off)); v[4 * i] = t[0]; v[4 * i + 1] = t[1]; v[4 * i + 2] = t[2]; v[4 * i + 3] = t[3]; off += step; }
}
__device__ __forceinline__ void cvt_store(const CvtItem& I, int lane, const float (&v)[32], LAS float* scr) {
#pragma unroll
    for (int i = 0; i < 8; ++i) { LAS float* d = scr + (8 * i + (lane >> 3)) * 33 + 4 * (lane & 7); d[0] = v[4 * i]; d[1] = v[4 * i + 1]; d[2] = v[4 * i + 2]; d[3] = v[4 * i + 3]; }
    LDS_WAIT(); asm volatile("" ::: "memory");
    const int c = lane & 7;
#pragma unroll
    for (int j = 0; j < 4; ++j) { const int n = (lane >> 3) + 8 * j; const LAS float* s = scr + (8 * c) * 33 + n;
        if (I.f8 & 1) { u32x2 o; o.x = pk4f8(s[0 * 33] * W8_SCALE, s[1 * 33] * W8_SCALE, s[2 * 33] * W8_SCALE, s[3 * 33] * W8_SCALE); o.y = pk4f8(s[4 * 33] * W8_SCALE, s[5 * 33] * W8_SCALE, s[6 * 33] * W8_SCALE, s[7 * 33] * W8_SCALE);
            __builtin_nontemporal_store(o, (GAS u32x2*)((GAS char*)I.WT + (size_t)I.rowd * I.Kd + I.k0 + (unsigned)(n * I.Kd + 8 * c))); }
        else { u32x4 o; o.x = pk2(s[0 * 33], s[1 * 33]); o.y = pk2(s[2 * 33], s[3 * 33]); o.z = pk2(s[4 * 33], s[5 * 33]); o.w = pk2(s[6 * 33], s[7 * 33]);
        const int nd = (I.f8 & 2) ? 16 * ((n >> 2) & 1) + 4 * (n >> 3) + (n & 3) : n;
        __builtin_nontemporal_store(o, (GAS u32x4*)((GAS char*)(I.WT + (size_t)I.rowd * I.Kd + I.k0) + (unsigned)(nd * I.Kd + 8 * c) * 2u)); } }
    LDS_WAIT(); asm volatile("" ::: "memory");
}

__device__ __forceinline__ void ld_row(gcfp p, int lane, f32x4 (&v)[4]) {
#pragma unroll
    for (int j = 0; j < 4; ++j) v[j] = *(const GAS f32x4*)(p + 4 * lane + 256 * j);
}
__device__ __forceinline__ void ld_row_bf(gcbp p, int lane, f32x4 (&v)[4]) {
#pragma unroll
    for (int j = 0; j < 4; ++j) { const u32x2 w = *(const GAS u32x2*)(p + 4 * lane + 256 * j); v[j] = (f32x4){bflo(w.x), bfhi(w.x), bflo(w.y), bfhi(w.y)}; }
}
__device__ __forceinline__ float sumsq_row(const f32x4 (&v)[4]) {
    float s = 0.f;
#pragma unroll
    for (int j = 0; j < 4; ++j) s += (v[j][0] * v[j][0] + v[j][1] * v[j][1]) + (v[j][2] * v[j][2] + v[j][3] * v[j][3]);
    return wave_sum(s);
}
__device__ __forceinline__ void st_wt(GAS f32x4* p, f32x4 v) { asm volatile("global_store_dwordx4 %0, %1, off sc1\n\ts_nop 1" :: "v"(p), "v"(v)); }
__device__ __forceinline__ void st_wt(GAS u32x2* p, u32x2 v) { asm volatile("global_store_dwordx2 %0, %1, off sc1" :: "v"(p), "v"(v)); }
__device__ __forceinline__ void st_wt(GAS unsigned* p, unsigned v) { asm volatile("global_store_dword %0, %1, off sc1" :: "v"(p), "v"(v)); }
template <bool F8 = false> __device__ __forceinline__ void norm_mod_row(const f32x4 (&x)[4], gcfp g, gcfp sc, gcfp sh, int lane, f32x4 (&h)[4], gbp dst) {
    const float rn = 1.0f / sqrtf(sumsq_row(x) * (1.0f / D) + EPS);
#pragma unroll
    for (int j = 0; j < 4; ++j) { const int c = 4 * lane + 256 * j; const f32x4 gv = *(const GAS f32x4*)(g + c), sv = *(const GAS f32x4*)(sc + c), hv = *(const GAS f32x4*)(sh + c);
        h[j] = (x[j] * rn) * gv * (1.0f + sv) + hv;
        if constexpr (F8) { *(GAS unsigned*)((GAS unsigned char*)dst + c) = pk4f8(h[j][0], h[j][1], h[j][2], h[j][3]); }
        else { u32x2 w; w.x = pk2(h[j][0], h[j][1]); w.y = pk2(h[j][2], h[j][3]); *(GAS u32x2*)(dst + c) = w; } }
}

constexpr int CVT_I_IN = 16 * 192, CVT_I_WB = 3 * 8 * 32, CVT_I_WO = 16 * 32, CVT_I_W1 = NE * 16 * 64, CVT_I_W2 = NE * 16 * 32, CVT_I_L = CVT_I_IN + CVT_I_WB + CVT_I_WO + CVT_I_W1 + CVT_I_W2;
constexpr int CVT_P0_END = CVT_I_IN + CVT_I_WB + CVT_I_WO, CVT_END = DEPTH * CVT_I_L, CVT_REST = CVT_END - CVT_P0_END;
constexpr int CVT_T1_END = CVT_P0_END + (CVT_REST * CVT_SH1) / 100, CVT_T3_END = CVT_T1_END + (CVT_REST * CVT_SH2) / 100, CVT_T6_END = CVT_END - (CVT_REST * CVT_SH6) / 100, CVT_T4_END = CVT_T6_END - (CVT_REST * CVT_SH4) / 100, CVT_T5_END = CVT_T4_END - (CVT_REST * CVT_SH5) / 100;
static_assert(CVT_T3_END >= CVT_I_L, "layer 0's expert weights are converted before its expert GEMMs");
static_assert(CVT_T6_END >= CVT_END - CVT_I_W2, "only layer 1's w2 may wait for layer 1's first expert GEMM");
static_assert(CVT_T5_END >= CVT_I_L + CVT_I_IN + CVT_I_WB + CVT_I_WO && CVT_T5_END >= CVT_T3_END, "only layer 1's expert weights may wait for layer 1's in-projection");
__device__ __forceinline__ void cvt_range(volatile LAS unsigned* MISC, LAS unsigned char* ldsl, int first, int last, int gw, int NGW, int wave, int lane) {
    auto w_in = INP(7); auto w_branch = INP(12); auto w_out = INP(13); auto w1 = INP(16); auto w2 = INP(18);
    auto WIN = WSP(bf16, WS_WIN); auto WB = WSP(bf16, WS_WB); auto WO = WSP(bf16, WS_WO); auto W1 = WSP(bf16, WS_W1); auto W2 = WSP(bf16, WS_W2);
    LAS float* scr = (LAS float*)(ldsl + wave * 16384);
    constexpr int I_IN = CVT_I_IN, I_WB = CVT_I_WB, I_WO = CVT_I_WO, I_W1 = CVT_I_W1, I_W2 = CVT_I_W2, I_L = CVT_I_L;
#define CVT_DECODE(it_, I_) do { const int l_ = (it_) / I_L; int r_ = (it_) - l_ * I_L; \
            if (r_ < I_IN) { const int kb = r_ / 192, nbd = r_ % 192; I_ = CvtItem{w_in + (size_t)l_ * D * NIN, WIN + (size_t)l_ * NIN * D, NIN, 64 * kb, in_src_col(nbd), D, 32 * nbd, (nbd >= 72) ? 2 : 0}; break; } r_ -= I_IN; \
            if (r_ < I_WB) { const int i = r_ / 256, rr = r_ % 256, kb = rr / 32, nb = rr % 32; I_ = CvtItem{w_branch + (size_t)(l_ * 3 + i) * 512 * D, WB + (size_t)(l_ * 3 + i) * D * 512, D, 64 * kb, 32 * nb, 512, 32 * nb, 0}; break; } r_ -= I_WB; \
            if (r_ < I_WO) { const int kb = r_ / 32, nb = r_ % 32; I_ = CvtItem{w_out + (size_t)l_ * D * D, WO + (size_t)l_ * D * D, D, 64 * kb, 32 * nb, D, 32 * nb, 0}; break; } r_ -= I_WO; \
            if (r_ < I_W1) { const int e = r_ / 1024, rr = r_ % 1024, kb = rr / 64, nbd = rr % 64; const int pn = nbd >> 3, blk = nbd & 7, bj = blk >> 2, q = blk & 3; \
                const bool f8_ = (l_ >= MOE_F8_FROM);     \
                I_ = CvtItem{w1 + (size_t)(l_ * NE + e) * D * 2048, f8_ ? (gbp)((GAS char*)(W1 + (size_t)l_ * NE * 2048 * D) + (size_t)e * 2048 * D) : W1 + (size_t)(l_ * NE + e) * 2048 * D, 2048, 64 * kb, bj * 1024 + 128 * pn + 32 * q, D, 32 * nbd, f8_ ? 1 : 0}; break; } r_ -= I_W1; \
            { const int e = r_ / 512, rr = r_ % 512, kb = rr / 32, nb = rr % 32; const bool f8_ = (l_ >= MOE_F8_FROM); \
              I_ = CvtItem{w2 + (size_t)(l_ * NE + e) * D * D, f8_ ? (gbp)((GAS char*)(W2 + (size_t)l_ * NE * D * D) + (size_t)e * D * D) : W2 + (size_t)(l_ * NE + e) * D * D, D, 64 * kb, 32 * nb, D, 32 * nb, f8_ ? 1 : 0}; } } while (0)
        {
            int it = first + gw; CvtItem Iq[4]; float v[4][32];
#define CVT_PRE(k, itx) do { if ((itx) < last) { CVT_DECODE((itx), Iq[k]); cvt_load(Iq[k], lane, v[k]); } } while (0)
#define CVT_STG(k) { CVT_PRE(((k) + 3) & 3, it + 3 * NGW); cvt_store(Iq[k], lane, v[k], scr); it += NGW; if (it >= last) break; }
            CVT_PRE(0, it); CVT_PRE(1, it + NGW); CVT_PRE(2, it + 2 * NGW);
            if (it < last) for (;;) { CVT_STG(0) CVT_STG(1) CVT_STG(2) CVT_STG(3) }
#undef CVT_PRE
#undef CVT_STG
        }
#undef CVT_DECODE
}

#ifndef DISMASK
#define DISMASK 0
#endif
#define EN(k) (((DISMASK >> (k)) & 1) == 0)
#ifndef TOKPROBE
#define TOKPROBE 0
#endif
#ifndef DUPMASK
#ifndef INPROJ_STAGGER
#define INPROJ_STAGGER 2
#endif
#ifndef A128DUP
#define A128DUP 0
#endif
#define DUPMASK 0
#endif
#define REPS(k) ((((DUPMASK) >> (k)) & 1) ? 2 : 1)
__device__ __forceinline__ void ld_prod(gcfp a, gcfp b, int lane, f32x4 (&o)[4]) {
#pragma unroll
    for (int j = 0; j < 4; ++j) o[j] = *(const GAS f32x4*)(a + 4 * lane + 256 * j) * *(const GAS f32x4*)(b + 4 * lane + 256 * j);
}
__device__ __forceinline__ void ld_scale(gcfp g, gcfp sc, int lane, f32x4 (&A)[4]) {
#pragma unroll
    for (int j = 0; j < 4; ++j) A[j] = *(const GAS f32x4*)(g + 4 * lane + 256 * j) * (1.0f + *(const GAS f32x4*)(sc + 4 * lane + 256 * j));
}
template <bool F8 = false> __device__ __forceinline__ void norm_affine_row(const f32x4 (&x)[4], const f32x4 (&A)[4], int lane, f32x4 (&h)[4], gbp dst) {
    const float rn = __builtin_amdgcn_rsqf(sumsq_row(x) * (1.0f / D) + EPS);
#pragma unroll
    for (int j = 0; j < 4; ++j) { const int c = 4 * lane + 256 * j; h[j] = (x[j] * rn) * A[j] + h[j];
        if constexpr (F8) { st_wt((GAS unsigned*)((GAS unsigned char*)dst + c), pk4f8(h[j][0], h[j][1], h[j][2], h[j][3])); }
        else { u32x2 w; w.x = pk2(h[j][0], h[j][1]); w.y = pk2(h[j][2], h[j][3]); st_wt((GAS u32x2*)(dst + c), w); } }
}
__global__ void __launch_bounds__(NWAVES * 64, 2) mk_fwd(Args args) {
    extern __shared__ __attribute__((aligned(16))) unsigned char lds[];
    LAS unsigned char* ldsl = (LAS unsigned char*)lds;
    volatile LAS unsigned* MISC = (volatile LAS unsigned*)(ldsl + MISC_OFF);
    const int tid = threadIdx.x; const int wave0 = __builtin_amdgcn_readfirstlane(tid >> 6);
#define TIDNOW() (wave0 * 64 + lane_now())
    const int G = gridDim.x, bid = blockIdx.x;
    const int vcu = (G % 8 == 0) ? (bid % 8) * (G / 8) + bid / 8 : bid;
    const int G0 = G, bid0 = bid, vcu0 = vcu, wave00 = wave0;
#define IDS_NOW const int G = sgpr_launder(G0), bid = sgpr_launder(bid0), vcu = sgpr_launder(vcu0), wave0 = sgpr_launder(wave00); (void)G; (void)bid; (void)vcu; (void)wave0
    unsigned* ctl = (unsigned*)(GAS unsigned*)(args.ws + WS_CTL);
    for (int u = tid; u < (LDS_BYTES - MISC_OFF) / 4; u += NWAVES * 64) MISC[u] = 0u;
    __syncthreads();
    if (tid == 0) {
#pragma unroll
        for (int i = 0; i < 22; ++i) { const unsigned long long pv = i < 20 ? (unsigned long long)args.in[i] : (i == 20 ? (unsigned long long)args.out : (unsigned long long)args.ws);
            MISC[MW_PT + 2 * i] = (unsigned)pv; MISC[MW_PT + 2 * i + 1] = (unsigned)(pv >> 32); }
    }
    __syncthreads();
    XcdBarrier bar = xcd_barrier_post(ctl + CW_BAR, MISC + MW_BAR);
    const int lo = args.ph_lo, hi = args.ph_hi;
#define IN(k) (sgpr_launder(lo) <= (k) && (k) < sgpr_launder(hi))
#define SEAM(k) do { if (IN(k) && IN((k) + 1)) xcd_barrier(bar, TIDNOW()); } while (0)

    const int NGW = G * NWAVES;
#define PHASE_IDS const int lane = lane_now(), tid = wave0 * 64 + lane, wave = wave0, gw = vcu * NWAVES + wave; (void)gw; (void)lane

    for (int rep_ = 0; rep_ < REPS(0); ++rep_) { if (rep_) xcd_barrier(bar, TIDNOW());
    if (IN(0) && EN(0)) {
        IDS_NOW;
        PHASE_IDS;
        auto c_in = INP(1); auto cctx_in = INP(3); auto ada_w = INP(4); auto ada_b = INP(5);
        auto diff_lambda = INP(8);
        auto MOD = WSP(float, WS_MOD); auto ROPEC = WSP(float, WS_ROPEC); auto ROPES = WSP(float, WS_ROPES); auto LAMV = WSP(float, WS_LAM);
        if (bid < 2 * 96) {
            const int l = bid / 96, nb = bid % 96;
            LAS float* sl = (LAS float*)(ldsl + wave * 2560);
            LAS float* part = (LAS float*)(ldsl + 32768);
            { float cvv[10];
#pragma unroll
              for (int t = 0; t < 10; ++t) { const int idx = lane + 64 * t; const int r = idx >> 7, kk = idx & 127, k = wave * 128 + kk; cvv[t] = r < 4 ? c_in[r * D + k] : cctx_in[k]; }
#pragma unroll
              for (int t = 0; t < 10; ++t) sl[lane + 64 * t] = cvv[t] / (1.0f + __expf(-cvv[t])); }
            LDS_WAIT(); asm volatile("" ::: "memory");
            float a[5];
#pragma unroll
            for (int r = 0; r < 5; ++r) a[r] = 0.f;
            gcfp wp = ada_w + ((size_t)l * D + wave * 128) * NIN + nb * 64 + lane;
#pragma unroll 32
            for (int kk = 0; kk < 128; ++kk) { const float wv = wp[(size_t)kk * NIN];
#pragma unroll
                for (int r = 0; r < 5; ++r) a[r] += wv * sl[r * 128 + kk]; }
#pragma unroll
            for (int r = 0; r < 5; ++r) part[(wave * 5 + r) * 64 + lane] = a[r];
            __syncthreads();
            for (int idx = tid; idx < 320; idx += NWAVES * 64) { const int r = idx >> 6, cc = idx & 63; float s = ada_b[l * NIN + nb * 64 + cc];
#pragma unroll
                for (int w = 0; w < 8; ++w) s += part[(w * 5 + r) * 64 + cc];
                MOD[((size_t)l * 5 + r) * NIN + nb * 64 + cc] = s; }
            __syncthreads();
        }
        if (bid == G - 1) {
            for (int idx = tid; idx < 1024; idx += NWAVES * 64) { const int pos = idx >> 4, p = idx & 15; const float inv = powf(10000.0f, -(float)p / 16.0f); const float ang = (float)pos * inv;
                ROPEC[idx] = cosf(ang); ROPES[idx] = sinf(ang); }
            if (wave < 2) { gcfp lv = diff_lambda + wave * 256;
                const float s1 = wave_sum(lv[lane] * lv[64 + lane]), s2 = wave_sum(lv[128 + lane] * lv[192 + lane]);
                const float lam_init = 0.8f - 0.6f * expf(-0.3f * (float)wave);
                if (lane == 0) LAMV[wave] = expf(s1) - expf(s2) + lam_init; }
        }
        cvt_range(MISC, ldsl, 0, CVT_P0_END, gw, NGW, wave, lane);
    }
    }
    SEAM(0);
    if (IN(1) && EN(1)) {
        IDS_NOW;
        PHASE_IDS;
        auto x_in = INP(0); auto ctx_in = INP(2); auto norm_g = INP(6);
        auto MOD = WSP(float, WS_MOD); auto X = WSP(float, WS_X); auto H = WSP(bf16, WS_H);
        {
            auto PV = WSP(float, WS_PV);
            for (int idx = bid * (NWAVES * 64) + tid; idx < DEPTH * 5 * D; idx += G * NWAVES * 64) { const int l_ = idx / (5 * D), mr_ = (idx / D) % 5, d_ = idx % D;
                gcfp md_ = MOD + ((size_t)l_ * 5 + mr_) * NIN; gcfp ng_ = norm_g + (size_t)l_ * 4 * D; gfp pv_ = PV + ((size_t)l_ * 5 + mr_) * 4 * D;
                pv_[d_] = md_[2 * D + d_] * ng_[D + d_]; pv_[D + d_] = ng_[2 * D + d_] * (1.0f + md_[4 * D + d_]); pv_[2 * D + d_] = md_[5 * D + d_] * ng_[3 * D + d_]; pv_[3 * D + d_] = ng_[d_] * (1.0f + md_[D + d_]); }
        }
        {
            const int RPB = (MTOT + G - 1) / G, r0 = bid * RPB;
            int i = wave; bool have = (i < RPB && r0 + i < MTOT); f32x4 xn[4], A2[4]; int mrc = -1;
#define P1SRC(r_) ((r_) < MLAT ? x_in + (size_t)(r_) * D : ctx_in + (size_t)((r_) - MLAT) * D)
            if (have) ld_row(P1SRC(r0 + i), lane, xn);
            while (have) {
                const int r = r0 + i; f32x4 xv[4], hv[4];
#pragma unroll
                for (int j = 0; j < 4; ++j) xv[j] = xn[j];
                const int inx = i + NWAVES; const bool hn = (inx < RPB && r0 + inx < MTOT);
                if (hn) ld_row(P1SRC(r0 + inx), lane, xn);
                const int mr = r < MLAT ? (r >> 12) : 4;
                gcfp md = MOD + (size_t)mr * NIN; ld_row(md, lane, hv);
                if (mr != mrc) { ld_scale(norm_g, md + 1024, lane, A2); mrc = mr; }
                norm_affine_row(xv, A2, lane, hv, H + (size_t)r * D);
                i = inx; have = hn;
            }
#undef P1SRC
        }
    }
    SEAM(1);

    for (int l = 0; l < DEPTH; ++l) {
        const int pb = 2 + 8 * l; const bool lastl = (l == DEPTH - 1);
        const int ML = lastl ? MLAT : MTOT;
        unsigned* cntg = ctl + CW_CNT + l * 32 * 64;
        for (int rep_ = 0; rep_ < (l == 0 ? REPS(2) : 1); ++rep_) { if (rep_) xcd_barrier(bar, TIDNOW());
        if (IN(pb + 0) && EN(2)) {
            IDS_NOW;
            auto H = WSP(bf16, WS_H); auto WIN = WSP(bf16, WS_WIN);
            pg8::Gemm g{(const bf16*)H, (const bf16*)(WIN + (size_t)l * NIN * D), MTOT, NIN, D}; pg8::StaticOrder S; S.init(MTOT, NIN, G, bid);
            { const int tc = TIDNOW(); LAS float* tab = (LAS float*)(ldsl + TAB_OFF); auto rc = WSP(float, WS_ROPEC);
              *(LAS f32x4*)(tab + 4 * tc) = *(const GAS f32x4*)(rc + 4 * tc);
              if (tc < 32) *(LAS f32x4*)(tab + 2048 + 4 * tc) = *(const GAS f32x4*)(INP(10) + l * 128 + 4 * tc);
              __syncthreads(); }
            EpiInproj E{MISC, l};
            { const int c0s = (MTOT / 256) * (NIN / 256) - ((MTOT / 256) * (NIN / 256) / G) * G;
              if (c0s > 0 && bid >= c0s) { const int nsl = INPROJ_STAGGER * (1 + (bid - c0s) % 3); for (int i_ = 0; i_ < nsl; ++i_) __builtin_amdgcn_s_sleep(64); } }
            pg8::gemm_phase<EpiInproj, pg8::StaticOrder, false>(ldsl, g, S, E, wave0);
            { const int nfull = (MTOT / 256) * (NIN / 256) / G, c0 = (MTOT / 256) * (NIN / 256) - nfull * G;
              if (c0 > 0 && bid >= c0) { const int tc = TIDNOW(); const int wv = wave0;
                  cvt_range(MISC, ldsl, l == 0 ? CVT_P0_END : CVT_T4_END, l == 0 ? CVT_T1_END : CVT_T6_END, (bid - c0) * NWAVES + wv, (G - c0) * NWAVES, wv, tc & 63); } }
        }
        }
        SEAM(pb + 0);
        for (int rep_ = 0; rep_ < (l == 0 ? REPS(3) : 1); ++rep_) { if (rep_) xcd_barrier(bar, TIDNOW());
        if (IN(pb + 1) && EN(3)) {
            IDS_NOW;
            auto diff_subln = INP(9); auto sink = INP(11); auto LAMV = WSP(float, WS_LAM);
            auto QA = WSP(bf16, WS_QA); auto QB = WSP(bf16, WS_QB); auto QC = WSP(bf16, WS_QC);
            auto KA = WSP(bf16, WS_KA); auto VA = WSP(bf16, WS_VA); auto KB = WSP(bf16, WS_KB); auto VB = WSP(bf16, WS_VB); auto KC = WSP(bf16, WS_KC); auto VC = WSP(bf16, WS_VC);
            auto YS = WSP(bf16, WS_YS);
            const int NU = lastl ? 1536 : 1632;
            const float lam = LAMV[l]; const float post = 1.0f - (0.8f - 0.6f * expf(-0.3f * (float)l));
            {
                for (int rp_ = 0; rp_ < ((A128DUP && l == 0) ? 2 : 1); ++rp_)
                for (int pr = vcu; pr < 256; pr += G) {
                    const int b = pr >> 6, hh = (pr >> 4) & 3, q0 = b * SEQ + (pr & 15) * 256;
                    const size_t kv0 = (size_t)b * KVR * 512 + hh * 128;
                    for (int mp = 0; mp < 2; ++mp) {
                        __syncthreads();
                        att128::attn_unit<8>((const att64::bf16*)(const bf16*)(QA + (size_t)q0 * 512 + hh * 128 + mp * 64), 512, (const att64::bf16*)(const bf16*)(KA + kv0 + mp * 64), (const att64::bf16*)(const bf16*)(VA + kv0), 512, 68, mp,
                                             lam, diff_subln + l * 128, post, (att64::bf16*)(bf16*)(YS + (size_t)q0 * 512 + hh * 128), 512, (char*)lds, wave0);
                    }
                }
            }
            for (int i = 0;; ++i) {
                const int L = 512 + i * G + vcu; if (L >= NU) break;
                int type, b, hh, qb, qrow; bool isctx;
                if (L < 1536) { type = L / 512; const int idx = L % 512; b = idx >> 7; hh = (idx >> 5) & 3; qb = idx & 31; qrow = b * SEQ + qb * 128; isctx = false; }
                else { const int e = L - 1536; type = e / 32; const int idx = e % 32; b = idx >> 3; hh = (idx >> 1) & 3; qb = idx & 1; qrow = MLAT + b * CTXL + qb * 128; isctx = true; }
                if (type != 0) {
                    __syncthreads();
                    const int idx = isctx ? (L - 1536) % 32 : L % 512;
                    if (type == 1) {
                        const int b1 = isctx ? idx >> 3 : idx >> 7, head = isctx ? idx & 7 : (idx >> 4) & 7, q0 = isctx ? MLAT + b1 * CTXL : b1 * SEQ + (idx & 15) * 256;
                        const size_t kv0 = ((size_t)b1 * KVR + (isctx ? SEQ : 0)) * 128 + (head >> 2) * 64; const int nt = isctx ? 4 : 68;
                        att64::attn_unit<8, false, false>((const att64::bf16*)(const bf16*)(QB + (size_t)q0 * 512 + head * 64), 512, (const att64::bf16*)(const bf16*)(KB + kv0), (const att64::bf16*)(const bf16*)(VB + kv0), 128, nt, nt, 0, 0, 0, 0, 0.f, 0.f,
                                                         (att64::bf16*)(bf16*)(YS + (size_t)MTOT * 512 + (size_t)q0 * 512 + head * 64), 512, (char*)lds, wave0);
                    } else {
                        const int b1 = isctx ? idx >> 3 : idx >> 7, hp = isctx ? (idx >> 1) & 3 : (idx >> 5) & 3, qbl = isctx ? idx & 1 : idx & 31;
                        const int head = 2 * hp, q0 = isctx ? MLAT + b1 * CTXL + qbl * 128 : b1 * SEQ + qbl * 128;
                        const size_t kv0 = ((size_t)b1 * KVR + SEQ) * 128 + (head >> 2) * 64; const float sl2a = sink[l * 8 + head] * 1.4426950408889634f, sl2b = sink[l * 8 + head + 1] * 1.4426950408889634f;
                        const att64::bf16* qp_ = (const att64::bf16*)(const bf16*)(QC + (size_t)q0 * 512 + head * 64); att64::bf16* op_ = (att64::bf16*)(bf16*)(YS + (size_t)2 * MTOT * 512 + (size_t)q0 * 512 + head * 64);
                        if (isctx) att64::attn_unit<8, false, true>(qp_, 512, (const att64::bf16*)(const bf16*)(KC + kv0), (const att64::bf16*)(const bf16*)(VC + kv0), 128, 4, 4, 0, 0, 0, 1, sl2a, sl2b, op_, 512, (char*)lds, wave0);
                        else { const int qpos = qbl * 128; const int klo = qpos - 128 < 0 ? 0 : qpos - 128, khi = qpos + 256 > SEQ ? SEQ : qpos + 256; const int n2 = (khi - klo) / 64;
                            att64::attn_unit<8, true, true>(qp_, 512, (const att64::bf16*)(const bf16*)(KC + kv0), (const att64::bf16*)(const bf16*)(VC + kv0), 128, 4 + n2, 4, klo - SEQ, klo, qpos, 1, sl2a, sl2b, op_, 512, (char*)lds, wave0); }
                    }
                    continue;
                }
                att::UnitArgs A;
                A.s1 = isctx ? SEQ : 0; A.n1 = isctx ? 4 : 68; A.s2 = 0; A.n2 = 0; A.qpos0 = -1; A.use_sink = 0; A.sink0 = 0.f; A.sink1 = 0.f; A.lam = lam; A.post = post; A.subg = diff_subln + l * 128;
                {
                    A.Q = QA + (size_t)qrow * 512 + hh * 128; A.qg1 = 64; A.K = KA + (size_t)b * KVR * 512 + hh * 128; A.V = VA + (size_t)b * KVR * 512 + hh * 128; A.ldk = 512;
                    A.O = YS + (size_t)qrow * 512 + hh * 128; A.og1 = 0;
                    att::attn_unit<true, false>(A, (char*)lds, wave0);
                }
            }
        }
        }
        SEAM(pb + 1);
        for (int rep_ = 0; rep_ < (l == 0 ? REPS(4) : 1); ++rep_) { if (rep_) xcd_barrier(bar, TIDNOW());
        if (IN(pb + 2) && EN(4)) {
            IDS_NOW;
            auto YS = WSP(bf16, WS_YS); auto WB = WSP(bf16, WS_WB);
            pg8::Gemm g{(const bf16*)YS, (const bf16*)(WB + (size_t)l * 3 * D * 512), 3 * MTOT, 3 * D, 512}; MergeOrder S{(ML / 256) * 4, G, vcu};
            EpiMerge E{MISC};
            pg8::gemm_phase<EpiMerge, MergeOrder, false>(ldsl, g, S, E, wave0);
            { const int c0 = (ML / 256) * 4 - G;
              if (l == 0 && c0 > 0 && c0 < G && vcu >= c0) { const int tc = TIDNOW(); const int wv = wave0;
                  cvt_range(MISC, ldsl, CVT_T1_END, CVT_T3_END, (vcu - c0) * NWAVES + wv, (G - c0) * NWAVES, wv, tc & 63); } }
        }
        }
        SEAM(pb + 2);
        for (int rep_ = 0; rep_ < (l == 0 ? REPS(5) : 1); ++rep_) { if (rep_) xcd_barrier(bar, TIDNOW());
        if (IN(pb + 3) && EN(5)) {
            IDS_NOW;
            auto MG = WSP(bf16, WS_MG); auto WO = WSP(bf16, WS_WO);
            pg8::Gemm g{(const bf16*)MG, (const bf16*)(WO + (size_t)l * D * D), ML, D, D}; pg8::StaticOrder S; S.init(ML, D, G, bid);
            EpiOut E{MISC};
            pg8::gemm_phase<EpiOut, pg8::StaticOrder, false>(ldsl, g, S, E, wave0);
            { const int c0 = (ML / 256) * 4 - G;
              if (l == 0 && c0 > 0 && c0 < G && bid >= c0) { const int tc = TIDNOW(); const int wv = wave0;
                  cvt_range(MISC, ldsl, CVT_T3_END, CVT_T5_END, (bid - c0) * NWAVES + wv, (G - c0) * NWAVES, wv, tc & 63); } }
        }
        }
        SEAM(pb + 3);
        if (IN(pb + 4) && EN(6)) {
            IDS_NOW;
            PHASE_IDS;
            auto norm_g = INP(6); auto router_w = INP(14); auto router_b = INP(15);
            gcfp ng = norm_g + (size_t)l * 4 * D; auto modl = WSP(float, WS_MOD) + (size_t)l * 5 * NIN;
            auto Y = WSP(bf16, WS_Y); auto X = WSP(float, WS_X); auto H2 = WSP(bf16, WS_H2); auto x_in0 = INP(0); auto ctx_in0 = INP(2);
            auto SE = WSP(int, WS_SE); auto SR = WSP(int, WS_SR); auto SW = WSP(float, WS_SW); auto LIST = WSP(int, WS_LIST);
            LAS f32x4* rwL = (LAS f32x4*)ldsl;
            gcfp rw = router_w + (size_t)l * D * NE;
            {
                f32x4 tw[16];
#pragma unroll
                for (int k = 0; k < 16; ++k) { const int idx = tid + k * (NWAVES * 64); const int d = idx >> 3, q = idx & 7; tw[k] = *(const GAS f32x4*)(rw + (size_t)d * NE + q * 4); }
#pragma unroll
                for (int k = 0; k < 16; ++k) { const int idx = tid + k * (NWAVES * 64); const int d = idx >> 3, q = idx & 7; const int rowp = (d & 3) * 256 + (d >> 2);
                    rwL[rowp * 8 + (q ^ ((rowp >> 1) & 7))] = tw[k]; }
            }
            volatile LAS unsigned* hist = MISC + MW_HIST; volatile LAS unsigned* gbase = MISC + MW_BASE; volatile LAS unsigned* slotw = MISC + MW_SLOT + wave * (9 * 4 * 3);
            if (tid < NE) hist[tid] = 0u;
            const int RPB = (ML + G - 1) / G; const int r0 = bid * RPB;
            const int rf_ = r0 < ML ? r0 : 0; const int mr0 = rf_ < MLAT ? (rf_ >> 12) : 4;
            LAS float* vA = (LAS float*)(ldsl + 131072); LAS float* vH = (LAS float*)(ldsl + TAB_OFF);
            { auto PV0 = WSP(float, WS_PV) + ((size_t)l * 5 + mr0) * 4 * D; gcfp md0 = modl + (size_t)mr0 * NIN;
              for (int idx = tid; idx < D; idx += NWAVES * 64) { vA[idx] = PV0[idx]; vA[D + idx] = PV0[D + idx]; vH[idx] = md0[3 * D + idx]; } }
            __syncthreads();
            int nti = 0;
#if TOKPROBE & 1
            for (int rep1 = (l == 0) ? 0 : 1; rep1 < 2; ++rep1) { const bool dry1 = rep1 == 0; gfp Xo = dry1 ? (gfp)WSP(float, WS_TMP) : (gfp)X; gbp H2o = dry1 ? (gbp)WSP(bf16, WS_ACT) : (gbp)H2; nti = 0;
#else
            { gfp Xo = (gfp)X; gbp H2o = (gbp)H2; constexpr bool dry1 = false;
#endif
            {
            int i = wave; bool have = (i < RPB && r0 + i < ML);
            const float rbias = router_b[l * NE + ((lane >> 1) & 31)];
            u32x2 yn[4]; auto PVl = WSP(float, WS_PV) + (size_t)l * 5 * 4 * D;
#define YLD(r_) do { _Pragma("unroll") for (int j = 0; j < 4; ++j) yn[j] = *(const GAS u32x2*)(Y + (size_t)(r_) * D + 4 * lane + 256 * j); } while (0)
#define XSRC(r_) (l == 0 ? ((r_) < MLAT ? x_in0 + (size_t)(r_) * D : ctx_in0 + (size_t)((r_) - MLAT) * D) : (gcfp)(X + (size_t)(r_) * D))
            f32x4 xn[4];
            if (have) { YLD(r0 + i); ld_row(XSRC(r0 + i), lane, xn); }
            while (have) {
                const int r = r0 + i; const int mr = r < MLAT ? (r >> 12) : 4;
                f32x4 yv[4], xv[4], hv[4], A1[4], A2[4];
                if (mr == mr0) {
#pragma unroll
                    for (int j = 0; j < 4; ++j) { A1[j] = *(const LAS f32x4*)(vA + 4 * lane + 256 * j); A2[j] = *(const LAS f32x4*)(vA + D + 4 * lane + 256 * j); hv[j] = *(const LAS f32x4*)(vH + 4 * lane + 256 * j); }
                } else { gcfp md = modl + (size_t)mr * NIN; gcfp pv = PVl + (size_t)mr * 4 * D; ld_row(pv, lane, A1); ld_row(pv + D, lane, A2); ld_row(md + 3 * D, lane, hv); }
#pragma unroll
                for (int j = 0; j < 4; ++j) { yv[j] = (f32x4){bflo(yn[j].x), bfhi(yn[j].x), bflo(yn[j].y), bfhi(yn[j].y)}; xv[j] = xn[j]; }
                const int inx = i + NWAVES; const bool hn = (inx < RPB && r0 + inx < ML);
                if (hn) { YLD(r0 + inx); ld_row(XSRC(r0 + inx), lane, xn); }
                const float rny = __builtin_amdgcn_rsqf(sumsq_row(yv) * (1.0f / D) + EPS);
#pragma unroll
                for (int j = 0; j < 4; ++j) { const int c = 4 * lane + 256 * j; xv[j] = xv[j] + A1[j] * (yv[j] * rny); st_wt((GAS f32x4*)(Xo + (size_t)r * D + c), xv[j]); }
                if (l >= MOE_F8_FROM) norm_affine_row<true>(xv, A2, lane, hv, (gbp)((GAS unsigned char*)H2o + (size_t)r * D));
                else norm_affine_row<false>(xv, A2, lane, hv, H2o + (size_t)r * D);
                float a[32];
#pragma unroll
                for (int q = 0; q < 32; ++q) a[q] = 0.f;
                const int sw = (lane >> 1) & 7;
                {
                    f32x4 wA[8], wB[8];
#define RW_LD(W, blk) do { const int rowp_ = ((blk) & 3) * 256 + 64 * ((blk) >> 2) + lane; _Pragma("unroll") for (int q = 0; q < 8; ++q) W[q] = rwL[rowp_ * 8 + (q ^ sw)]; } while (0)
#define RW_FMA(W, blk) do { const float hval_ = hv[(blk) >> 2][(blk) & 3]; _Pragma("unroll") for (int q = 0; q < 8; ++q) { a[4 * q + 0] += hval_ * W[q][0]; a[4 * q + 1] += hval_ * W[q][1]; a[4 * q + 2] += hval_ * W[q][2]; a[4 * q + 3] += hval_ * W[q][3]; } } while (0)
                    RW_LD(wA, 0);
#pragma unroll
                    for (int blk = 0; blk < 16; blk += 2) { RW_LD(wB, blk + 1); RW_FMA(wA, blk); __builtin_amdgcn_sched_barrier(0); if (blk + 2 < 16) RW_LD(wA, blk + 2); RW_FMA(wB, blk + 1); __builtin_amdgcn_sched_barrier(0); }
#undef RW_LD
#undef RW_FMA
                }
#define RS(N, MASK) do { const bool up = (lane & (MASK)) != 0; _Pragma("unroll") for (int q = 0; q < (N) / 2; ++q) { const float keep = up ? a[(N) / 2 + q] : a[q]; const float send = up ? a[q] : a[(N) / 2 + q]; a[q] = keep + __shfl_xor(send, (MASK)); } } while (0)
                RS(32, 32); RS(16, 16); RS(8, 8); RS(4, 4); RS(2, 2);
#undef RS
                const int myE = (lane >> 1) & 31;
                float val = a[0] + dppf<0xB1>(a[0]) + rbias;
                float tv[4]; int te[4];
#define BETTER(ov, oe, bv, be) ((ov) > (bv) || ((ov) == (bv) && (oe) < (be)))
#define TSTEP(CTRL) do { const float ov = dppf<CTRL>(bv); const int oe = dppi<CTRL>(be); if (BETTER(ov, oe, bv, be)) { bv = ov; be = oe; } } while (0)
#pragma unroll
                for (int k = 0; k < 4; ++k) { float bv = val; int be = myE;
                    TSTEP(0x4E); TSTEP(0x141); TSTEP(0x140);
                    float v0 = rdl(bv, 0), v1 = rdl(bv, 16), v2 = rdl(bv, 32), v3 = rdl(bv, 48);
                    int e0 = __builtin_amdgcn_readlane(be, 0), e1 = __builtin_amdgcn_readlane(be, 16), e2 = __builtin_amdgcn_readlane(be, 32), e3 = __builtin_amdgcn_readlane(be, 48);
                    if (BETTER(v1, e1, v0, e0)) { v0 = v1; e0 = e1; } if (BETTER(v3, e3, v2, e2)) { v2 = v3; e2 = e3; } if (BETTER(v2, e2, v0, e0)) { v0 = v2; e0 = e2; }
                    tv[k] = v0; te[k] = e0; if (myE == e0) val = -INFINITY; }
#undef TSTEP
#undef BETTER
                const float e1 = __expf(tv[1] - tv[0]), e2 = __expf(tv[2] - tv[0]), e3 = __expf(tv[3] - tv[0]); const float inv = 1.0f / (1.0f + e1 + e2 + e3);
                if (lane < 4) { const int ek = lane == 0 ? te[0] : lane == 1 ? te[1] : lane == 2 ? te[2] : te[3]; const float wk = (lane == 0 ? 1.0f : lane == 1 ? e1 : lane == 2 ? e2 : e3) * inv;
                    const unsigned lr = __hip_atomic_fetch_add((LAS unsigned*)((dry1 ? gbase : hist) + ek), 1u, __ATOMIC_RELAXED, __HIP_MEMORY_SCOPE_WORKGROUP);
                    slotw[(nti * 4 + lane) * 3 + 0] = (unsigned)ek; slotw[(nti * 4 + lane) * 3 + 1] = lr; slotw[(nti * 4 + lane) * 3 + 2] = __builtin_bit_cast(unsigned, wk); }
                i = inx; have = hn; ++nti;
            }
            }
            }
            __syncthreads();
            if (tid < NE) { const unsigned hcount = hist[tid]; gbase[tid] = hcount ? __hip_atomic_fetch_add(cntg + tid * 64, hcount, __ATOMIC_RELAXED, __HIP_MEMORY_SCOPE_AGENT) : 0u; }
            __syncthreads();
            nti = 0;
            for (int i = wave; i < RPB && r0 + i < ML; i += NWAVES, ++nti) {
                const int r = r0 + i;
                if (lane < 4) { const unsigned ek = slotw[(nti * 4 + lane) * 3 + 0], lr = slotw[(nti * 4 + lane) * 3 + 1], wkb = slotw[(nti * 4 + lane) * 3 + 2];
                    const unsigned rank = gbase[ek] + lr;
                    LIST[(size_t)ek * MTOT + rank] = r; SE[r * 4 + lane] = (int)ek; SR[r * 4 + lane] = (int)rank; SW[r * 4 + lane] = __builtin_bit_cast(float, wkb); }
            }
            __syncthreads();
        }
        SEAM(pb + 4);
        LAS int* tb = (LAS int*)(ldsl + MISC_OFF) + MW_TB; LAS int* cn = (LAS int*)(ldsl + MISC_OFF) + MW_CNT;
        if (IN(pb + 5) || IN(pb + 6) || IN(pb + 7)) {
            IDS_NOW;
            __syncthreads();
            const int tid = TIDNOW();
            if (tid < NE) cn[tid] = (int)__hip_atomic_load(cntg + tid * 64, __ATOMIC_RELAXED, __HIP_MEMORY_SCOPE_AGENT);
            __syncthreads();
            if (tid == 0) { int accu = 0; for (int e = 0; e < NE; ++e) { tb[e] = accu; accu += (cn[e] + 255) >> 8; } tb[NE] = accu; }
            __syncthreads();
        }
        for (int rep_ = 0; rep_ < (l == 0 ? REPS(7) : 1); ++rep_) { if (rep_) xcd_barrier(bar, TIDNOW());
        if (IN(pb + 5) && EN(7)) {
            IDS_NOW;
            auto H2 = WSP(bf16, WS_H2); auto W1 = WSP(bf16, WS_W1); auto LIST = WSP(int, WS_LIST);
            MoeOrder<8> S; S.init(tb, cn, LIST, G, bid);
            if (l >= MOE_F8_FROM) { pg8::Gemm g{(const bf16*)H2, (const bf16*)(W1 + (size_t)l * NE * 2048 * D), MTOT, NE * 2048, D / 2}; EpiSwiglu<true> E{MISC, l};
                pg8::gemm_phase<EpiSwiglu<true>, MoeOrder<8>, true, true>(ldsl, g, S, E, wave0); }
            else { pg8::Gemm g{(const bf16*)H2, (const bf16*)(W1 + (size_t)l * NE * 2048 * D), MTOT, NE * 2048, D}; EpiSwiglu<false> E{MISC, l};
                pg8::gemm_phase<EpiSwiglu<false>, MoeOrder<8>, true, false>(ldsl, g, S, E, wave0); }
            if (l == 0 ? CVT_SH5 > 0 : CVT_SH6 > 0) { const int cf = l == 0 ? CVT_T5_END : CVT_T6_END, cl = l == 0 ? CVT_T4_END : CVT_END;
                const int nfull = S.chunk / S.per, rem = S.chunk - nfull * S.per, lc = S.vcu % S.per, xg = S.vcu / S.per, nidle = S.per - rem, ngrp = S.vcu == S.bid && S.per == G ? 1 : 8;
                const int tc = TIDNOW(); const int wv = wave0;
                if (rem == 0) cvt_range(MISC, ldsl, cf, cl, S.vcu * NWAVES + wv, G * NWAVES, wv, tc & 63);
                else if (lc >= rem) cvt_range(MISC, ldsl, cf, cl, (xg * nidle + (lc - rem)) * NWAVES + wv, ngrp * nidle * NWAVES, wv, tc & 63);
            }
        }
        }
        SEAM(pb + 5);
        for (int rep_ = 0; rep_ < (l == 0 ? REPS(8) : 1); ++rep_) { if (rep_) xcd_barrier(bar, TIDNOW());
        if (IN(pb + 6) && EN(8)) {
            IDS_NOW;
            auto ACT = WSP(bf16, WS_ACT); auto W2 = WSP(bf16, WS_W2); auto LIST = WSP(int, WS_LIST);
            MoeOrder<4> S; S.init(tb, cn, LIST, G, bid);
            if (l >= MOE_F8_FROM) { pg8::Gemm g{(const bf16*)ACT, (const bf16*)(W2 + (size_t)l * NE * D * D), MAXTILES * 256, NE * D, D / 2}; EpiMoe2<true> E{MISC, l};
                pg8::gemm_phase<EpiMoe2<true>, MoeOrder<4>, false, true>(ldsl, g, S, E, wave0); }
            else { pg8::Gemm g{(const bf16*)ACT, (const bf16*)(W2 + (size_t)l * NE * D * D), MAXTILES * 256, NE * D, D}; EpiMoe2<false> E{MISC, l};
                pg8::gemm_phase<EpiMoe2<false>, MoeOrder<4>, false, false>(ldsl, g, S, E, wave0); }
        }
        }
        SEAM(pb + 6);
        if (IN(pb + 7) && EN(9)) {
            IDS_NOW;
            PHASE_IDS;
            auto norm_g = INP(6); gcfp ng = norm_g + (size_t)l * 4 * D; auto MOD = WSP(float, WS_MOD); gcfp modl = MOD + (size_t)l * 5 * NIN;
            auto X = WSP(float, WS_X); auto H = WSP(bf16, WS_H); auto YS2 = WSP(bf16, WS_YS2); gfp outp = (gfp)ldp(MISC, 20);
            auto SE = WSP(int, WS_SE); auto SR = WSP(int, WS_SR); auto SW = WSP(float, WS_SW);
            LAS float* VEC = (LAS float*)ldsl;
            for (int idx = tid; idx < 5 * D; idx += NWAVES * 64) { const int mrx = idx >> 10, d = idx & (D - 1); gcfp mdx = modl + (size_t)mrx * NIN;
                VEC[(mrx * 3 + 0) * D + d] = mdx[5 * D + d] * ng[3 * D + d];
                if (!lastl) { gcfp mdn = MOD + ((size_t)(l + 1) * 5 + mrx) * NIN; VEC[(mrx * 3 + 1) * D + d] = norm_g[(size_t)(l + 1) * 4 * D + d] * (1.0f + mdn[D + d]); VEC[(mrx * 3 + 2) * D + d] = mdn[d]; } }
            __syncthreads();
            for (int rep2 = ((TOKPROBE & 2) && l == 0) ? 0 : 1; rep2 < 2; ++rep2) { const bool dry2 = rep2 == 0; gfp Xo = dry2 ? (gfp)WSP(float, WS_TMP) : (gfp)X; gbp Ho = dry2 ? (gbp)WSP(bf16, WS_MG) : (gbp)H;
            for (int rb = gw; rb < ML; rb += 16 * NGW) {
                const int myr = rb + (lane >> 2) * NGW; const bool vld = myr < ML;
                const int se = vld ? SE[myr * 4 + (lane & 3)] : 0, sr = vld ? SR[myr * 4 + (lane & 3)] : 0; const float swt = vld ? SW[myr * 4 + (lane & 3)] : 0.f;
                const int yrow = tb[se] * 256 + sr;
                u32x2 yn[4][4]; f32x4 xn[4];
#define T2_LOAD(ri_) do { const int r_ = rb + (ri_) * NGW; _Pragma("unroll") for (int k = 0; k < 4; ++k) { const int yr_ = __builtin_amdgcn_readlane(yrow, (ri_) * 4 + k); gcbp yp = YS2 + (size_t)yr_ * D; \
                    _Pragma("unroll") for (int j = 0; j < 4; ++j) yn[k][j] = *(const GAS u32x2*)(yp + 4 * lane + 256 * j); } ld_row(X + (size_t)r_ * D, lane, xn); } while (0)
                int ri = 0;
                if (rb < ML) T2_LOAD(0);
                while (ri < 16 && rb + ri * NGW < ML) {
                    const int r = rb + ri * NGW; const int mr = r < MLAT ? (r >> 12) : 4; const LAS float* vec = VEC + mr * 3 * D;
                    f32x4 yv[4], xv[4];
#pragma unroll
                    for (int j = 0; j < 4; ++j) { yv[j] = (f32x4){0.f, 0.f, 0.f, 0.f}; xv[j] = xn[j]; }
#pragma unroll
                    for (int k = 0; k < 4; ++k) { const float wk = rdl(swt, ri * 4 + k);
#pragma unroll
                        for (int j = 0; j < 4; ++j) { const u32x2 w = yn[k][j]; yv[j][0] += wk * bflo(w.x); yv[j][1] += wk * bfhi(w.x); yv[j][2] += wk * bflo(w.y); yv[j][3] += wk * bfhi(w.y); } }
                    if (ri + 1 < 16 && rb + (ri + 1) * NGW < ML) T2_LOAD(ri + 1);
                    const float rny = 1.0f / sqrtf(sumsq_row(yv) * (1.0f / D) + EPS);
#pragma unroll
                    for (int j = 0; j < 4; ++j) { const int c = 4 * lane + 256 * j;
                        xv[j] = xv[j] + *(const LAS f32x4*)(vec + c) * (yv[j] * rny);
                        st_wt((GAS f32x4*)((lastl ? outp : Xo) + (size_t)r * D + c), xv[j]); }
                    if (!lastl) { const float rnx = 1.0f / sqrtf(sumsq_row(xv) * (1.0f / D) + EPS);
#pragma unroll
                        for (int j = 0; j < 4; ++j) { const int c = 4 * lane + 256 * j; const f32x4 h = (xv[j] * rnx) * *(const LAS f32x4*)(vec + D + c) + *(const LAS f32x4*)(vec + 2 * D + c);
                            u32x2 w; w.x = pk2(h[0], h[1]); w.y = pk2(h[2], h[3]); st_wt((GAS u32x2*)(Ho + (size_t)r * D + c), w); } }
                    ++ri;
                }
#undef T2_LOAD
            }
            if (dry2) { asm volatile("s_waitcnt vmcnt(0)" ::: "memory"); __syncthreads(); } }
        }
        if (!lastl) SEAM(pb + 7);
    }
#undef IN
#undef SEAM
}

constexpr int N_PHASES = 2 + 8 * DEPTH;
#ifndef MK_CUTS
#define MK_CUTS 0
#endif
extern "C" void kernel_launch(void* const* d_in, const int* in_sizes, int n_in, void* d_out, int out_size, void* d_ws, size_t ws_size, hipStream_t stream) {
    static int grid = 0;
    if (grid == 0) {
        if (n_in != 20 || out_size != MLAT * D || ws_size < WS_END) { fprintf(stderr, "kernel_launch: unexpected shapes (n_in %d out %d ws %zu need %zu)\n", n_in, out_size, ws_size, (size_t)WS_END); grid = -1; return; }
        int dev = 0, cus = 0, per_cu = 0;
        if (hipGetDevice(&dev) != hipSuccess || hipDeviceGetAttribute(&cus, hipDeviceAttributeMultiprocessorCount, dev) != hipSuccess) { grid = -1; return; }
        if (hipFuncSetAttribute((const void*)mk_fwd, hipFuncAttributeMaxDynamicSharedMemorySize, LDS_BYTES) != hipSuccess) { fprintf(stderr, "kernel_launch: hipFuncSetAttribute failed\n"); grid = -1; return; }
        if (hipOccupancyMaxActiveBlocksPerMultiprocessor(&per_cu, (const void*)mk_fwd, NWAVES * 64, LDS_BYTES) != hipSuccess || per_cu < 1) { fprintf(stderr, "kernel_launch: occupancy query reports %d\n", per_cu); }
        (void)hipGetLastError();
        grid = cus;
    }
    if (grid < 0) return;
    if (hipMemsetAsync((char*)d_ws + WS_CTL, 0, CTL_BYTES, stream) != hipSuccess) return;
    Args a{};
    for (int i = 0; i < 20; ++i) a.in[i] = (const float*)d_in[i];
    a.out = (float*)d_out; a.ws = (unsigned char*)d_ws;
#if MK_CUTS
    for (int p = 0; p < N_PHASES; ++p) { a.ph_lo = p; a.ph_hi = p + 1; hipLaunchKernelGGL(mk_fwd, dim3(grid), dim3(NWAVES * 64), LDS_BYTES, stream, a); }
#else
    a.ph_lo = 0; a.ph_hi = N_PHASES;
    hipLaunchKernelGGL(mk_fwd, dim3(grid), dim3(NWAVES * 64), LDS_BYTES, stream, a);
#endif
    const hipError_t le = hipPeekAtLastError();
    if (le != hipSuccess) fprintf(stderr, "kernel_launch: launch failed: %s\n", hipGetErrorName(le));
}
```
